# Optimizing an MI355X kernel written in HIP

```python
import math
import jax
import jax.numpy as jnp
from jax import lax
import numpy as np

D_MODEL = 2048
BATCH = 1
SEQ = 16384
DEPTH = 4

HEAD_DIM = 128
HEADS_PER_MIXER = D_MODEL // HEAD_DIM // 4
D_MIX = 4 * HEADS_PER_MIXER * HEAD_DIM
Q_BLOCK = 128
GRID_W = 64
NORM_EPS = 1e-6
ROPE_THETA = 10000.0

A_HEADS = HEADS_PER_MIXER
A_HALF = HEAD_DIM // 2
B_HEADS = HEADS_PER_MIXER
B_Q_RANK = 512
B_KV_RANK = 256
B_NOPE = 128
B_ROPE = 64
B_V = HEAD_DIM
C_HEADS = HEADS_PER_MIXER
C_KV_HEADS = C_HEADS // 2
D_HEADS = HEADS_PER_MIXER
D_PATTERNS = ((128, 1), (512, 4), (2048, 16))
D_PAD = max(w // 2 for w, _ in D_PATTERNS)

REL_BUCKETS = 32
REL_MAX_DIST = 1024
REL_HEADS = A_HEADS + D_HEADS

FFN_HIDDEN = -(-(8 * D_MODEL) // (3 * 256)) * 256

A_W = A_HEADS * HEAD_DIM
C_QW = C_HEADS * HEAD_DIM
C_KVW = C_KV_HEADS * HEAD_DIM
D_W = D_HEADS * HEAD_DIM
IN_SIZES = (A_W, A_W, A_W, B_Q_RANK, B_KV_RANK, B_ROPE, C_QW, C_KVW, C_KVW, D_W, D_W, D_W)
IN_COLS = sum(IN_SIZES)
SPLIT_POINTS = tuple(sum(IN_SIZES[:i + 1]) for i in range(len(IN_SIZES) - 1))

kernel_name = 'hybrid_parallel_head_encoder'


def _rmsnorm(x, g):
    xf = x.astype(jnp.float32)
    y = xf * lax.rsqrt(jnp.mean(xf * xf, axis=-1, keepdims=True) + NORM_EPS)
    return (y * g.astype(jnp.float32)).astype(x.dtype)


def _rope_cos_sin(pos, dim):
    inv = ROPE_THETA ** (-jnp.arange(0, dim, 2, dtype=jnp.float32) / dim)
    ang = pos.astype(jnp.float32)[:, None] * inv[None, :]
    return jnp.cos(ang), jnp.sin(ang)


def _apply_rope(x, cos, sin):
    half = x.shape[-1] // 2
    x1 = x[..., :half].astype(jnp.float32)
    x2 = x[..., half:].astype(jnp.float32)
    c = cos[None, :, None, :]
    s = sin[None, :, None, :]
    return jnp.concatenate([x1 * c - x2 * s, x2 * c + x1 * s], axis=-1).astype(x.dtype)


def _axial_rope(x, cos_r, sin_r, cos_c, sin_c):
    half = x.shape[-1] // 2
    return jnp.concatenate([_apply_rope(x[..., :half], cos_r, sin_r),
                            _apply_rope(x[..., half:], cos_c, sin_c)], axis=-1)


def _t5_bucket(rel):
    half = REL_BUCKETS // 2
    max_exact = half // 2
    ret = jnp.where(rel > 0, half, 0)
    n = jnp.abs(rel)
    nf = jnp.maximum(n, max_exact).astype(jnp.float32)
    large = max_exact + (jnp.log(nf / max_exact) / math.log(REL_MAX_DIST / max_exact)
                         * (half - max_exact)).astype(jnp.int32)
    large = jnp.minimum(large, half - 1)
    return ret + jnp.where(n < max_exact, n, large)


def _blocked_attention(q, k, v):
    b, s, hq, dq = q.shape
    hk = k.shape[2]
    g = hq // hk
    nb = s // Q_BLOCK
    scale = dq ** -0.5
    qblocks = jnp.swapaxes(q.reshape(b, nb, Q_BLOCK, hk, g, dq), 0, 1)

    def block(qb):
        logits = jnp.einsum('bqhgd,bkhd->bhgqk', qb, k).astype(jnp.float32) * scale
        p = jax.nn.softmax(logits, axis=-1)
        return jnp.einsum('bhgqk,bkhd->bqhgd', p.astype(v.dtype), v)

    o = lax.map(block, qblocks)
    return jnp.swapaxes(o, 0, 1).reshape(b, s, hq, v.shape[-1])


def _diff_attention(q, k, v, lam, bias_table):
    b, s = q.shape[0], q.shape[1]
    nb = s // Q_BLOCK
    scale = A_HALF ** -0.5
    kpos = jnp.arange(s, dtype=jnp.int32)
    qblocks = jnp.swapaxes(q.reshape(b, nb, Q_BLOCK, A_HEADS, 2, A_HALF), 0, 1)
    starts = jnp.arange(nb, dtype=jnp.int32) * Q_BLOCK

    def block(args):
        qb, start = args
        qpos = start + jnp.arange(Q_BLOCK, dtype=jnp.int32)
        bias = bias_table[_t5_bucket(kpos[None, :] - qpos[:, None])].astype(jnp.float32)
        logits = jnp.einsum('bqhmd,bkhmd->bmhqk', qb, k).astype(jnp.float32) * scale
        logits = logits + jnp.transpose(bias, (2, 0, 1))[None, None]
        p = jax.nn.softmax(logits, axis=-1)
        w = p[:, 0] - lam * p[:, 1]
        return jnp.einsum('bhqk,bkhd->bqhd', w.astype(v.dtype), v)

    o = lax.map(block, (qblocks, starts))
    return jnp.swapaxes(o, 0, 1).reshape(b, s, A_HEADS, HEAD_DIM)


def _dilated_offsets():
    rows = []
    for w, r in D_PATTERNS:
        n = (w // 2) // r
        rows.append(np.arange(-n, n + 1, dtype=np.int32) * r)
    return jnp.asarray(np.stack(rows))


def _dilated_attention(q, k, v, bias_table):
    b, s, h, d = q.shape
    nb = s // Q_BLOCK
    scale = d ** -0.5
    offs = _dilated_offsets()
    bias = jnp.transpose(bias_table[_t5_bucket(offs)], (0, 2, 1)).astype(jnp.float32)
    pad = ((0, 0), (D_PAD, D_PAD), (0, 0), (0, 0))
    kp = jnp.pad(k, pad)
    vp = jnp.pad(v, pad)
    qblocks = jnp.swapaxes(q.reshape(b, nb, Q_BLOCK, h, d), 0, 1)
    starts = jnp.arange(nb, dtype=jnp.int32) * Q_BLOCK

    def block(args):
        qb, start = args
        qpos = start + jnp.arange(Q_BLOCK, dtype=jnp.int32)
        kpos = qpos[:, None, None] + offs[None]
        valid = (kpos >= 0) & (kpos < s)
        kg = kp[:, kpos + D_PAD]
        vg = vp[:, kpos + D_PAD]
        logits = jnp.einsum('bqhd,bqpjhd->bqphj', qb, kg).astype(jnp.float32) * scale + bias[None, None]
        logits = jnp.where(valid[None, :, :, None, :], logits, -jnp.inf)
        lse = jax.nn.logsumexp(logits, axis=-1)
        p = jnp.exp(logits - lse[..., None])
        o = jnp.einsum('bqphj,bqpjhd->bqphd', p.astype(v.dtype), vg)
        alpha = jax.nn.softmax(lse, axis=2)
        return jnp.einsum('bqph,bqphd->bqhd', alpha.astype(v.dtype), o)

    o = lax.map(block, (qblocks, starts))
    return jnp.swapaxes(o, 0, 1).reshape(b, s, h, d)


def setup_inputs(seed: int = 0) -> dict:
    key = jax.random.key(seed)
    ks = jax.random.split(key, 18)
    f32 = jnp.float32

    def nrm(k, shape, scale):
        return jax.random.normal(k, shape, f32) * scale

    def gain(k, shape):
        return 1.0 + 0.02 * jax.random.normal(k, shape, f32)

    return {
        'x': nrm(ks[0], (BATCH, SEQ, D_MODEL), 1.0),
        'rel_bias': nrm(ks[1], (REL_BUCKETS, REL_HEADS), 0.5),
        'norm_mix_pre': gain(ks[2], (DEPTH, D_MODEL)),
        'norm_mix_post': gain(ks[3], (DEPTH, D_MODEL)),
        'norm_ffn_pre': gain(ks[4], (DEPTH, D_MODEL)),
        'norm_ffn_post': gain(ks[5], (DEPTH, D_MODEL)),
        'w_in': nrm(ks[6], (DEPTH, D_MODEL, IN_COLS), D_MODEL ** -0.5),
        'diff_lambda': nrm(ks[7], (DEPTH, 4, A_HALF), 0.1),
        'diff_subln': gain(ks[8], (DEPTH, HEAD_DIM)),
        'mla_q_norm': gain(ks[9], (DEPTH, B_Q_RANK)),
        'mla_kv_norm': gain(ks[10], (DEPTH, B_KV_RANK)),
        'mla_w_uq': nrm(ks[11], (DEPTH, B_Q_RANK, B_HEADS * (B_NOPE + B_ROPE)), B_Q_RANK ** -0.5),
        'mla_w_ukv': nrm(ks[12], (DEPTH, B_KV_RANK, B_HEADS * (B_NOPE + B_V)), B_KV_RANK ** -0.5),
        'gqa_q_norm': gain(ks[13], (DEPTH, HEAD_DIM)),
        'gqa_k_norm': gain(ks[14], (DEPTH, HEAD_DIM)),
        'w_out': nrm(ks[15], (DEPTH, D_MIX, D_MODEL), D_MIX ** -0.5),
        'w_gate_up': nrm(ks[16], (DEPTH, D_MODEL, 2 * FFN_HIDDEN), D_MODEL ** -0.5),
        'w_down': nrm(ks[17], (DEPTH, FFN_HIDDEN, D_MODEL), FFN_HIDDEN ** -0.5),
    }


def reference(x, rel_bias, norm_mix_pre, norm_mix_post, norm_ffn_pre, norm_ffn_post, w_in,
              diff_lambda, diff_subln, mla_q_norm, mla_kv_norm, mla_w_uq, mla_w_ukv,
              gqa_q_norm, gqa_k_norm, w_out, w_gate_up, w_down):
    b, s, _ = x.shape
    rows = s // GRID_W
    pos = jnp.arange(s, dtype=jnp.int32)
    row_idx = jnp.repeat(jnp.arange(rows, dtype=jnp.int32), GRID_W)
    col_idx = pos % GRID_W
    cos_1d, sin_1d = _rope_cos_sin(pos, B_ROPE)
    cos_r, sin_r = _rope_cos_sin(row_idx, HEAD_DIM // 2)
    cos_c, sin_c = _rope_cos_sin(col_idx, HEAD_DIM // 2)
    bias_a = rel_bias[:, :A_HEADS]
    bias_d = rel_bias[:, A_HEADS:]

    for l in range(DEPTH):
        h = _rmsnorm(x, norm_mix_pre[l])
        (a_q, a_k, a_v, b_cq, b_ckv, b_kpe, c_q, c_k, c_v, d_q, d_k, d_v) = jnp.split(
            h @ w_in[l], SPLIT_POINTS, axis=-1)

        lam_init = 0.8 - 0.6 * math.exp(-0.3 * l)
        lv = diff_lambda[l].astype(jnp.float32)
        lam = jnp.exp(jnp.sum(lv[0] * lv[1])) - jnp.exp(jnp.sum(lv[2] * lv[3])) + lam_init
        o_a = _diff_attention(a_q.reshape(b, s, A_HEADS, 2, A_HALF),
                              a_k.reshape(b, s, A_HEADS, 2, A_HALF),
                              a_v.reshape(b, s, A_HEADS, HEAD_DIM), lam, bias_a)
        o_a = _rmsnorm(o_a, diff_subln[l]) * (1.0 - lam_init)

        q_b = (_rmsnorm(b_cq, mla_q_norm[l]) @ mla_w_uq[l]).reshape(b, s, B_HEADS, B_NOPE + B_ROPE)
        kv_b = (_rmsnorm(b_ckv, mla_kv_norm[l]) @ mla_w_ukv[l]).reshape(b, s, B_HEADS, B_NOPE + B_V)
        q_b = jnp.concatenate([q_b[..., :B_NOPE], _apply_rope(q_b[..., B_NOPE:], cos_1d, sin_1d)], axis=-1)
        k_pe = jnp.broadcast_to(_apply_rope(b_kpe[:, :, None, :], cos_1d, sin_1d), (b, s, B_HEADS, B_ROPE))
        k_b = jnp.concatenate([kv_b[..., :B_NOPE], k_pe], axis=-1)
        o_b = _blocked_attention(q_b, k_b, kv_b[..., B_NOPE:])

        q_c = _axial_rope(_rmsnorm(c_q.reshape(b, s, C_HEADS, HEAD_DIM), gqa_q_norm[l]), cos_r, sin_r, cos_c, sin_c)
        k_c = _axial_rope(_rmsnorm(c_k.reshape(b, s, C_KV_HEADS, HEAD_DIM), gqa_k_norm[l]), cos_r, sin_r, cos_c, sin_c)
        o_c = _blocked_attention(q_c, k_c, c_v.reshape(b, s, C_KV_HEADS, HEAD_DIM))

        o_d = _dilated_attention(d_q.reshape(b, s, D_HEADS, HEAD_DIM),
                                 d_k.reshape(b, s, D_HEADS, HEAD_DIM),
                                 d_v.reshape(b, s, D_HEADS, HEAD_DIM), bias_d)

        mix = jnp.concatenate([o_a, o_b, o_c, o_d], axis=2).reshape(b, s, D_MIX)
        x = x + _rmsnorm(mix @ w_out[l], norm_mix_post[l])

        h = _rmsnorm(x, norm_ffn_pre[l])
        gate, up = jnp.split(h @ w_gate_up[l], 2, axis=-1)
        x = x + _rmsnorm((jax.nn.silu(gate) * up) @ w_down[l], norm_ffn_post[l])
    return x
```

```cpp
#include <hip/hip_runtime.h>
#include <hip/hip_cooperative_groups.h>
#include <cstdio>
#include <cstdint>
namespace cg = cooperative_groups;

#ifndef MK_MULTI
#define MK_MULTI 0
#endif
#ifndef MK_PHMASK
#define MK_PHMASK 0xFFFFF
#endif
#define PHON(k) constexpr (((MK_PHMASK) >> (k)) & 1)

typedef unsigned short bf16_t;
typedef short bf16x8 __attribute__((ext_vector_type(8)));
typedef short s16x4 __attribute__((ext_vector_type(4)));
typedef float f32x2 __attribute__((ext_vector_type(2)));
typedef float f32x4 __attribute__((ext_vector_type(4)));
typedef float f32x16 __attribute__((ext_vector_type(16)));
typedef unsigned u32x2 __attribute__((ext_vector_type(2)));
typedef unsigned u32x4 __attribute__((ext_vector_type(4)));
#define LAS __attribute__((address_space(3)))

constexpr int S = 16384, DM = 2048, DEPTH = 4, NPROJ = 4928, LDP = 5120, FF = 5632, NGU = 2 * FF;
constexpr float EPS = 1e-6f;
constexpr int C_AQ = 0, C_AK = 512, C_AV = 1024, C_BCQ = 1536, C_BCKV = 2048, C_BKPE = 2304, C_CQ = 2368, C_CK = 2880, C_CV = 3136, C_DQ = 3392, C_DK = 3904, C_DV = 4416;
constexpr int TOFF = 1408, TBLN = 2824;

constexpr size_t MiB = 1u << 20;
constexpr size_t WS_PAR = 0, WS_TBLA = 1 * MiB, WS_TBLD = 1 * MiB + 65536, WS_COS = 2 * MiB, WS_SIN = 4 * MiB;
constexpr size_t WS_W = 8 * MiB, LW = 96 * MiB;
constexpr size_t W_IN = 0, W_UQ = 20 * MiB, W_UKV = 21 * MiB, W_OUT = 22 * MiB, W_GU = 30 * MiB, W_D = 74 * MiB;
constexpr size_t WS_H = 392 * MiB, WS_PROJ = 456 * MiB, WS_CQN = 616 * MiB, WS_CKVN = 632 * MiB, WS_KPE = 640 * MiB, WS_QC = 642 * MiB, WS_KC = 658 * MiB;
constexpr size_t WS_QB = 666 * MiB, WS_KVB = 690 * MiB, WS_MIX = 722 * MiB, WS_Y = 786 * MiB, WS_HID = 914 * MiB, WS_TMP = 1090 * MiB, WS_END = 1122 * MiB;

constexpr int LDS_BYTES = 147456;

__device__ __forceinline__ float bf2f(unsigned short b) { return __uint_as_float(((unsigned)b) << 16); }
__device__ __forceinline__ unsigned f2bf(float f) { unsigned u = __float_as_uint(f); return (u + 0x7fffu + ((u >> 16) & 1u)) >> 16; }
__device__ __forceinline__ unsigned pk2(float lo, float hi) { return f2bf(lo) | (f2bf(hi) << 16); }
__device__ __forceinline__ unsigned cvt_pk_bf16(float lo, float hi) { unsigned r; asm volatile("v_cvt_pk_bf16_f32 %0, %1, %2" : "=v"(r) : "v"(lo), "v"(hi)); return r; }
__device__ __forceinline__ float wave_sum(float v) {
#pragma unroll
    for (int o = 1; o < 64; o <<= 1) v += __shfl_xor(v, o);
    return v;
}

namespace pg8 {
constexpr int BM = 256, BK = 64, HALF = 128, HTB = HALF * BK * 2, STAGE_BYTES = 8 * HTB, NXCD = 8, WGM = 8;
__host__ __device__ __forceinline__ int lds_byte(int r, int c) { const int st = (r >> 4) * 2 + (c >> 5), rr = r & 15, cc = c & 31, ob = rr * 64 + cc * 2; return st * 1024 + (ob ^ (((ob >> 9) & 1) << 5)); }
__host__ __device__ __forceinline__ void stage_rc(int b, int& R, int& C) { const int st = b / 1024, sb = b % 1024, swz = sb ^ (((sb >> 9) & 1) << 5); R = (st >> 1) * 16 + swz / 64; C = (st & 1) * 32 + (swz % 64) / 2; }
__host__ __device__ __forceinline__ int perm32(int rho) { const int n = rho >> 4, i = rho & 15; return 8 * (i >> 2) + 4 * n + (i & 3); }

struct Unit { int pm, pn; };
struct Gemm { const bf16_t* A; const bf16_t* Bt; int M, N, K; };

struct StaticOrder {
    int nM, nN, nwg, G, c;
    __host__ __device__ void init(int M, int N, int G_, int c_) { nM = M / BM; nN = N / BM; nwg = nM * nN; G = G_; c = c_; }
    __host__ __device__ bool next(int i, Unit& u) const {
        const long L = (long)i * G + c; if (L >= nwg) return false;
        int wgid = (int)L; { const int q = nwg / NXCD, r = nwg % NXCD, xcd = wgid % NXCD, off = wgid / NXCD; wgid = (xcd < r ? xcd * (q + 1) : r * (q + 1) + (xcd - r) * q) + off; }
        const int nig = WGM * nN, gid = wgid / nig, fm = gid * WGM, gsz = (nM - fm) < WGM ? (nM - fm) : WGM;
        u.pm = fm + ((wgid % nig) % gsz); u.pn = (wgid % nig) / gsz; return true;
    }
    __device__ __forceinline__ void a_ready(const Unit&) const {}
    __device__ __forceinline__ void done(const Unit&) const {}
};

struct EpiBf16 {
    static constexpr bool PERM = true, AFTER_DRAIN = false;
    bf16_t* O; int ldc;
    __device__ __forceinline__ void operator()(const f32x4 (&acc)[2][2][4][2], const Unit& u, int wr, int wc, int fr, int fq) const {
        const int row0 = u.pm * BM + wr * 64 + fr; const int col0 = u.pn * BM + wc * 32 + 8 * fq;
#pragma unroll
        for (int ai = 0; ai < 2; ++ai)
#pragma unroll
            for (int m = 0; m < 4; ++m) { bf16_t* rowp = O + (size_t)(row0 + ai * HALF + m * 16) * ldc + col0;
#pragma unroll
                for (int bj = 0; bj < 2; ++bj) { const f32x4 v0 = acc[ai][bj][m][0], v1 = acc[ai][bj][m][1];
                    u32x4 w; w.x = cvt_pk_bf16(v0[0], v0[1]); w.y = cvt_pk_bf16(v0[2], v0[3]); w.z = cvt_pk_bf16(v1[0], v1[1]); w.w = cvt_pk_bf16(v1[2], v1[3]);
                    *(u32x4*)(rowp + bj * HALF) = w; } }
    }
};
struct EpiF32 {
    static constexpr bool PERM = false, AFTER_DRAIN = false;
    float* O; int ldc;
    __device__ __forceinline__ void operator()(const f32x4 (&acc)[2][2][4][2], const Unit& u, int wr, int wc, int fr, int fq) const {
        const int row0 = u.pm * BM + wr * 64 + fr; const int col0 = u.pn * BM + wc * 32 + 4 * fq;
#pragma unroll
        for (int ai = 0; ai < 2; ++ai)
#pragma unroll
            for (int m = 0; m < 4; ++m) { float* rowp = O + (size_t)(row0 + ai * HALF + m * 16) * ldc + col0;
#pragma unroll
                for (int bj = 0; bj < 2; ++bj)
#pragma unroll
                    for (int n = 0; n < 2; ++n) *(f32x4*)(rowp + bj * HALF + n * 16) = acc[ai][bj][m][n]; }
    }
};
__device__ __forceinline__ float silu_mul(float g, float u) {
    const float e = __builtin_amdgcn_exp2f(-g * 1.4426950408889634f);
    return g * __builtin_amdgcn_rcpf(1.0f + e) * u;
}
struct EpiSwiGLU {
    static constexpr bool PERM = true, AFTER_DRAIN = false;
    bf16_t* O; int ldc;
    __device__ __forceinline__ void operator()(const f32x4 (&acc)[2][2][4][2], const Unit& u, int wr, int wc, int fr, int fq) const {
        const int row0 = u.pm * BM + wr * 64 + fr; const int col0 = u.pn * HALF + wc * 32 + 8 * fq;
#pragma unroll
        for (int ai = 0; ai < 2; ++ai)
#pragma unroll
            for (int m = 0; m < 4; ++m) { bf16_t* rowp = O + (size_t)(row0 + ai * HALF + m * 16) * ldc + col0;
                const f32x4 g0 = acc[ai][0][m][0], g1 = acc[ai][0][m][1], u0 = acc[ai][1][m][0], u1 = acc[ai][1][m][1];
                u32x4 w; w.x = cvt_pk_bf16(silu_mul(g0[0], u0[0]), silu_mul(g0[1], u0[1])); w.y = cvt_pk_bf16(silu_mul(g0[2], u0[2]), silu_mul(g0[3], u0[3]));
                w.z = cvt_pk_bf16(silu_mul(g1[0], u1[0]), silu_mul(g1[1], u1[1])); w.w = cvt_pk_bf16(silu_mul(g1[2], u1[2]), silu_mul(g1[3], u1[3]));
                *(u32x4*)rowp = w; }
    }
};

template <class Epi, class Sched, bool ALIGN_EPI = false, bool SP2 = false>
__device__ __forceinline__ void gemm_phase(LAS unsigned char* lds, const Gemm g, const Sched& S, const Epi& E) {
    int tid_ = threadIdx.x; asm volatile("" : "+v"(tid_));
    const int tid = tid_, wid = __builtin_amdgcn_readfirstlane(tid >> 6), lane = tid & 63, wr = wid >> 2, wc = wid & 3, fr = lane & 15, fq = lane >> 4;
    int K_ = g.K; asm volatile("" : "+s"(K_));
    const int K = K_, nt = K / BK;
    unsigned voffA[2], voffB[2];
#pragma unroll
    for (int i = 0; i < 2; ++i) { int R, C; stage_rc(tid * 16 + i * 8192, R, C); const int Rb = Epi::PERM ? ((R & ~31) + perm32(R & 31)) : R;
        voffA[i] = (unsigned)(R * K + C) * 2u; voffB[i] = (unsigned)(Rb * K + C) * 2u; }
    const size_t kstep = (size_t)(BK * 2);
    const size_t hstep = (size_t)HALF * K * 2;
    const size_t tstep = 2 * hstep;
    const unsigned ldsw = (unsigned)wid * 1024u;
    const int aoff = lds_byte(wr * 64 + fr, fq * 8), boff = lds_byte(wc * 32 + fr, fq * 8);
#define PG8_SA(b, h) (((b) * 2 + (h)) * HTB)
#define PG8_SB(b, h) ((4 + (b) * 2 + (h)) * HTB)
#define PG8_STAGE(bufoff, gbase, voff) do { _Pragma("unroll") for (int _i = 0; _i < 2; ++_i) \
        __builtin_amdgcn_global_load_lds((const unsigned*)((const char*)(gbase) + (voff)[_i]), (LAS unsigned*)(lds + (bufoff) + ldsw + _i * 8192), 16, 0, 0); } while (0)
#define PG8_LDA(dst, b, h) do { _Pragma("unroll") for (int m = 0; m < 4; ++m) _Pragma("unroll") for (int k = 0; k < 2; ++k) dst[m][k] = *(const LAS bf16x8*)(lds + PG8_SA(b, h) + aoff + m * 2048 + k * 1024); } while (0)
#define PG8_LDB(dst, b, h) do { _Pragma("unroll") for (int n = 0; n < 2; ++n) _Pragma("unroll") for (int k = 0; k < 2; ++k) dst[n][k] = *(const LAS bf16x8*)(lds + PG8_SB(b, h) + boff + n * 2048 + k * 1024); } while (0)
#define PG8_MMA(ai, bj, At, Bt) do { __builtin_amdgcn_s_setprio(1); _Pragma("unroll") for (int m = 0; m < 4; ++m) _Pragma("unroll") for (int n = 0; n < 2; ++n) _Pragma("unroll") for (int k = 0; k < 2; ++k) \
        acc[ai][bj][m][n] = __builtin_amdgcn_mfma_f32_16x16x32_bf16(Bt[n][k], At[m][k], acc[ai][bj][m][n], 0, 0, 0); __builtin_amdgcn_s_setprio(0); } while (0)
#define PG8_WAIT_V(n) asm volatile("s_waitcnt vmcnt(" #n ")" ::: "memory")
#define PG8_WAIT_L(n) asm volatile("s_waitcnt lgkmcnt(" #n ")" ::: "memory")
#define PG8_BAR __builtin_amdgcn_s_barrier()
#define PG8_SCHED __builtin_amdgcn_sched_barrier(0)
    Unit cur, nxt; int ui = 0;
    if (!S.next(0, cur)) return;
    f32x4 acc[2][2][4][2];
#pragma unroll
    for (int a = 0; a < 2; ++a)
#pragma unroll
        for (int b = 0; b < 2; ++b)
#pragma unroll
            for (int m = 0; m < 4; ++m)
#pragma unroll
                for (int n = 0; n < 2; ++n) acc[a][b][m][n] = (f32x4){0.f, 0.f, 0.f, 0.f};
    bf16x8 At[4][2], B0[2][2], B1[2][2];
    const char* cA = (const char*)g.A + (size_t)cur.pm * tstep; const char* cB = (const char*)g.Bt + (size_t)cur.pn * tstep;
    S.a_ready(cur);
    if constexpr (SP2) {
        PG8_STAGE(PG8_SB(0, 0), cB, voffB); PG8_STAGE(PG8_SB(0, 1), cB + hstep, voffB); PG8_STAGE(PG8_SA(0, 0), cA, voffA); PG8_STAGE(PG8_SA(0, 1), cA + hstep, voffA);
        if (wr == 1) PG8_BAR;
        PG8_WAIT_V(2); PG8_BAR;
        PG8_STAGE(PG8_SB(1, 0), cB + kstep, voffB); PG8_STAGE(PG8_SA(1, 0), cA + kstep, voffA); PG8_STAGE(PG8_SB(1, 1), cB + hstep + kstep, voffB);
        PG8_WAIT_V(6); PG8_BAR;
    } else {
        PG8_STAGE(PG8_SB(0, 0), cB, voffB); PG8_STAGE(PG8_SA(0, 0), cA, voffA); PG8_STAGE(PG8_SB(0, 1), cB + hstep, voffB); PG8_STAGE(PG8_SA(0, 1), cA + hstep, voffA);
        if (wr == 1) PG8_BAR;
        PG8_WAIT_V(4); PG8_BAR;
        PG8_STAGE(PG8_SB(1, 0), cB + kstep, voffB); PG8_STAGE(PG8_SA(1, 0), cA + kstep, voffA); PG8_STAGE(PG8_SB(1, 1), cB + hstep + kstep, voffB);
        PG8_WAIT_V(6); PG8_BAR;
    }
    for (;;) {
        const bool has_next = S.next(ui + 1, nxt);
        const char* nA = has_next ? (const char*)g.A + (size_t)nxt.pm * tstep : cA; const char* nB = has_next ? (const char*)g.Bt + (size_t)nxt.pn * tstep : cB;
        for (int t = 0; t < nt; t += 2) {
            const bool last = (t == nt - 2);
            const char* a1 = cA + (size_t)(t + 1) * kstep;
            const char* a2 = last ? nA : cA + (size_t)(t + 2) * kstep; const char* b2 = last ? nB : cB + (size_t)(t + 2) * kstep;
            const char* a3 = a2 + kstep; const char* b3 = b2 + kstep;
            if (last && has_next) S.a_ready(nxt);
            if constexpr (SP2) {
            PG8_LDB(B0, 0, 0); PG8_LDB(B1, 0, 1); PG8_SCHED; PG8_LDA(At, 0, 0); PG8_STAGE(PG8_SA(1, 1), a1 + hstep, voffA);
            PG8_WAIT_V(8); PG8_WAIT_L(0); PG8_BAR; PG8_MMA(0, 0, At, B0); PG8_MMA(0, 1, At, B1); PG8_BAR; PG8_SCHED;
            PG8_LDA(At, 0, 1); PG8_STAGE(PG8_SB(0, 0), b2, voffB); PG8_STAGE(PG8_SB(0, 1), b2 + hstep, voffB); PG8_STAGE(PG8_SA(0, 0), a2, voffA);
            PG8_WAIT_V(8); PG8_WAIT_L(0); PG8_BAR; PG8_MMA(1, 0, At, B0); PG8_MMA(1, 1, At, B1); PG8_BAR; PG8_SCHED;
            PG8_LDB(B0, 1, 0); PG8_LDB(B1, 1, 1); PG8_SCHED; PG8_LDA(At, 1, 0); PG8_STAGE(PG8_SA(0, 1), a2 + hstep, voffA);
            PG8_WAIT_V(8); PG8_WAIT_L(0); PG8_BAR; PG8_MMA(0, 0, At, B0); PG8_MMA(0, 1, At, B1); PG8_BAR; PG8_SCHED;
            PG8_LDA(At, 1, 1); PG8_STAGE(PG8_SB(1, 0), b3, voffB); PG8_STAGE(PG8_SB(1, 1), b3 + hstep, voffB); PG8_STAGE(PG8_SA(1, 0), a3, voffA);
            PG8_WAIT_V(8); PG8_WAIT_L(0); PG8_BAR; PG8_MMA(1, 0, At, B0); PG8_MMA(1, 1, At, B1); PG8_BAR; PG8_SCHED;
            } else {
            PG8_LDB(B0, 0, 0); PG8_SCHED; PG8_LDA(At, 0, 0); PG8_STAGE(PG8_SA(1, 1), a1 + hstep, voffA);
            PG8_WAIT_L(8); PG8_BAR; PG8_WAIT_L(0); PG8_MMA(0, 0, At, B0); PG8_BAR; PG8_SCHED;
            PG8_LDB(B1, 0, 1); PG8_STAGE(PG8_SB(0, 0), b2, voffB);
            PG8_BAR; PG8_WAIT_L(0); PG8_MMA(0, 1, At, B1); PG8_BAR;
            PG8_LDA(At, 0, 1); PG8_STAGE(PG8_SA(0, 0), a2, voffA);
            PG8_BAR; PG8_WAIT_L(0); PG8_MMA(1, 0, At, B0); PG8_BAR; PG8_SCHED;
            PG8_STAGE(PG8_SB(0, 1), b2 + hstep, voffB);
            PG8_WAIT_V(6); PG8_BAR; PG8_MMA(1, 1, At, B1); PG8_BAR;
            PG8_LDB(B0, 1, 0); PG8_SCHED; PG8_LDA(At, 1, 0); PG8_STAGE(PG8_SA(0, 1), a2 + hstep, voffA);
            PG8_WAIT_L(8); PG8_BAR; PG8_WAIT_L(0); PG8_MMA(0, 0, At, B0); PG8_BAR; PG8_SCHED;
            PG8_LDB(B1, 1, 1); PG8_STAGE(PG8_SB(1, 0), b3, voffB);
            PG8_BAR; PG8_WAIT_L(0); PG8_MMA(0, 1, At, B1); PG8_BAR;
            PG8_LDA(At, 1, 1); PG8_STAGE(PG8_SA(1, 0), a3, voffA);
            PG8_BAR; PG8_WAIT_L(0); PG8_MMA(1, 0, At, B0); PG8_BAR; PG8_SCHED;
            PG8_STAGE(PG8_SB(1, 1), b3 + hstep, voffB);
            PG8_WAIT_V(6); PG8_BAR; PG8_MMA(1, 1, At, B1); PG8_BAR;
            }
        }
        if constexpr (ALIGN_EPI) { if (wr == 0) PG8_BAR; }
        if constexpr (!Epi::AFTER_DRAIN) { E(acc, cur, wr, wc, fr, fq); S.done(cur); }
        if (!has_next) break;
#pragma unroll
        for (int a = 0; a < 2; ++a)
#pragma unroll
            for (int b = 0; b < 2; ++b)
#pragma unroll
                for (int m = 0; m < 4; ++m)
#pragma unroll
                    for (int n = 0; n < 2; ++n) acc[a][b][m][n] = (f32x4){0.f, 0.f, 0.f, 0.f};
        cur = nxt; cA = nA; cB = nB; ++ui;
        if constexpr (ALIGN_EPI) { if (wr == 1) PG8_BAR; }
    }
    PG8_WAIT_V(0);
    if constexpr (!ALIGN_EPI) { if (wr == 0) PG8_BAR; }
    PG8_BAR;
#undef PG8_SA
#undef PG8_SB
#undef PG8_STAGE
#undef PG8_LDA
#undef PG8_LDB
#undef PG8_MMA
#undef PG8_WAIT_V
#undef PG8_WAIT_L
#undef PG8_BAR
#undef PG8_SCHED
}
}

namespace att {
constexpr int NW = 8, QBLK = 32, KVBLK = 64;
constexpr int SHM_V = KVBLK * 128 * 2;
#define SBAR() __builtin_amdgcn_sched_barrier(0)
__device__ __forceinline__ int crow(int r, int hi) { return (r & 3) + 8 * (r >> 2) + 4 * hi; }
__device__ __forceinline__ unsigned cvtpk(float lo, float hi) { unsigned r; asm volatile("v_cvt_pk_bf16_f32 %0, %1, %2" : "=v"(r) : "v"(lo), "v"(hi)); return r; }

__device__ __forceinline__ void partialSM(f32x16& p0, f32x16& p1, float& m_reg, float& mn, float& alpha, const float C, const float thr_raw, const float cb) {
  float pmax = p0[0];
#pragma unroll
  for (int r = 1; r < 16; ++r) pmax = fmaxf(pmax, p0[r]);
#pragma unroll
  for (int r = 0; r < 16; ++r) pmax = fmaxf(pmax, p1[r]);
  { auto rr = __builtin_amdgcn_permlane32_swap(__float_as_uint(pmax), __float_as_uint(pmax), false, false);
    pmax = fmaxf(__uint_as_float(rr[0]), __uint_as_float(rr[1])); }
  pmax += cb;
  if (__builtin_expect(__all(pmax - m_reg <= thr_raw), 1)) { mn = m_reg; alpha = 1.f; }
  else { mn = fmaxf(m_reg, pmax); alpha = __builtin_amdgcn_exp2f((m_reg - mn) * C); m_reg = mn; }
  const float mnC = (cb - mn) * C;
#pragma unroll
  for (int r = 0; r < 16; ++r) p0[r] = fmaf(p0[r], C, mnC);
#pragma unroll
  for (int r = 0; r < 16; ++r) p1[r] = fmaf(p1[r], C, mnC);
#pragma unroll
  for (int r = 0; r < 16; ++r) p0[r] = __builtin_amdgcn_exp2f(p0[r]);
}
__device__ __forceinline__ void finishSM(f32x16& p0, f32x16& p1, float alpha, float& l_reg, bf16x8& pa0, bf16x8& pa1, bf16x8& pa2, bf16x8& pa3) {
#pragma unroll
  for (int r = 0; r < 16; ++r) p1[r] = __builtin_amdgcn_exp2f(p1[r]);
  float ps = 0;
#pragma unroll
  for (int r = 0; r < 16; ++r) ps += p0[r];
#pragma unroll
  for (int r = 0; r < 16; ++r) ps += p1[r];
  { auto rr = __builtin_amdgcn_permlane32_swap(__float_as_uint(ps), __float_as_uint(ps), false, false);
    ps = __uint_as_float(rr[0]) + __uint_as_float(rr[1]); }
  l_reg = l_reg * alpha + ps;
#define PK4(P, BASE, OUT) do { unsigned a0 = cvtpk(P[BASE + 0], P[BASE + 1]), a1 = cvtpk(P[BASE + 2], P[BASE + 3]);   \
    unsigned b0 = cvtpk(P[BASE + 4], P[BASE + 5]), b1 = cvtpk(P[BASE + 6], P[BASE + 7]);                              \
    auto r0 = __builtin_amdgcn_permlane32_swap(a0, b0, false, false); auto r1 = __builtin_amdgcn_permlane32_swap(a1, b1, false, false); \
    u32x4 w = {r0[0], r1[0], r0[1], r1[1]}; OUT = *reinterpret_cast<bf16x8*>(&w); } while (0)
  PK4(p0, 0, pa0); PK4(p0, 8, pa1); PK4(p1, 0, pa2); PK4(p1, 8, pa3);
#undef PK4
}
template <int NDQ, int NQL>
__device__ __forceinline__ void qkt(f32x16& p0, f32x16& p1, const char* Ks, const bf16x8* qr, const char* qls, int r32, int hi) {
  constexpr int ROWB = NDQ * 32, NQR = NDQ - NQL;
  p0 = f32x16{}; p1 = f32x16{};
#pragma unroll
  for (int d0 = 0; d0 < NDQ; ++d0) { const int cb = (d0 * 16 + hi * 8) * 2;
    bf16x8 b0 = *reinterpret_cast<const bf16x8*>(Ks + r32 * ROWB + (cb ^ ((r32 & 7) << 4)));
    bf16x8 b1 = *reinterpret_cast<const bf16x8*>(Ks + (32 + r32) * ROWB + (cb ^ ((r32 & 7) << 4)));
    bf16x8 q;
    if constexpr (NQL > 0) { if (d0 < NQR) q = qr[d0 < NQR ? d0 : 0]; else q = *reinterpret_cast<const bf16x8*>(qls + (d0 - NQR) * 1024); }
    else q = qr[d0];
    p0 = __builtin_amdgcn_mfma_f32_32x32x16_bf16(b0, q, p0, 0, 0, 0);
    p1 = __builtin_amdgcn_mfma_f32_32x32x16_bf16(b1, q, p1, 0, 0, 0); }
}
__device__ __forceinline__ int v_st(int k, int c) { const int kk = (k & ~0xC) | ((k & 4) << 1) | ((k & 8) >> 1); return ((kk >> 3) * 4 + (c >> 5)) * 512 + ((kk & 7) * 32 + (c & 31)) * 2; }
__device__ __forceinline__ int v_rd_base(int lane) { return ((lane & 3) << 3) | (((lane >> 2) & 3) << 6) | (((lane >> 4) & 1) << 5) | (((lane >> 5) & 1) << 8); }
constexpr int v_rd_off(int d0, int ks, int half) { return d0 * 512 + ks * 4096 + half * 2048; }
template <int OFF> __device__ __forceinline__ s16x4 tr_read(int vb) {
  s16x4 r; asm volatile("ds_read_b64_tr_b16 %0, %1 offset:%2" : "=&v"(r) : "v"(vb), "i"(OFF) : "memory"); return r;
}
template <int D0> __device__ __forceinline__ void pv_one(f32x16& od, int vb, bf16x8 pa0, bf16x8 pa1, bf16x8 pa2, bf16x8 pa3) {
  const s16x4 l0 = tr_read<v_rd_off(D0, 0, 0)>(vb), h0 = tr_read<v_rd_off(D0, 0, 1)>(vb), l1 = tr_read<v_rd_off(D0, 1, 0)>(vb), h1 = tr_read<v_rd_off(D0, 1, 1)>(vb);
  const s16x4 l2 = tr_read<v_rd_off(D0, 2, 0)>(vb), h2 = tr_read<v_rd_off(D0, 2, 1)>(vb), l3 = tr_read<v_rd_off(D0, 3, 0)>(vb), h3 = tr_read<v_rd_off(D0, 3, 1)>(vb);
  asm volatile("s_waitcnt lgkmcnt(0)" ::: "memory"); SBAR();
#define PK(L, H) (bf16x8){L[0], L[1], L[2], L[3], H[0], H[1], H[2], H[3]}
  od = __builtin_amdgcn_mfma_f32_32x32x16_bf16(pa0, PK(l0, h0), od, 0, 0, 0);
  od = __builtin_amdgcn_mfma_f32_32x32x16_bf16(pa1, PK(l1, h1), od, 0, 0, 0);
  od = __builtin_amdgcn_mfma_f32_32x32x16_bf16(pa2, PK(l2, h2), od, 0, 0, 0);
  od = __builtin_amdgcn_mfma_f32_32x32x16_bf16(pa3, PK(l3, h3), od, 0, 0, 0);
#undef PK
}
__device__ __forceinline__ void pv_d0(f32x16* o, int vb, bf16x8 pa0, bf16x8 pa1, bf16x8 pa2, bf16x8 pa3) {
  pv_one<0>(o[0], vb, pa0, pa1, pa2, pa3); pv_one<1>(o[1], vb, pa0, pa1, pa2, pa3); pv_one<2>(o[2], vb, pa0, pa1, pa2, pa3); pv_one<3>(o[3], vb, pa0, pa1, pa2, pa3);
}

constexpr int LDS_K_OFF = 2 * SHM_V, LDS_WS_OFF = LDS_K_OFF + 2 * 12 * 2048, LDS_TBL_OFF = LDS_WS_OFF + NW * 64 * 4, LDS_Q_OFF = LDS_TBL_OFF + ((TBLN * 4 + 15) / 16) * 16;
static_assert(LDS_Q_OFF + NW * 4096 <= 131072, "attention LDS map");

template <int NDQ, int BIAS, int EPI, int SDEPTH, int NQL = 0>
__device__ __forceinline__ void attn_unit(const bf16_t* __restrict__ Qb, int ldq, const bf16_t* __restrict__ Kh, int ldk, const bf16_t* __restrict__ K2, int ldk2,
                                          const bf16_t* __restrict__ Vh, int ldv, int kbeg, int nkeys, int q0, const float* __restrict__ tblg, float cb_lo, float cb_hi,
                                          float C, float thr_raw, bf16_t* __restrict__ Obf, int ldo, float* __restrict__ tmp, float lam, const float* __restrict__ subln, float post, char* lds) {
  constexpr int ROWB = NDQ * 32, SHM_K = 64 * ROWB;
  int tid_ = threadIdx.x; asm volatile("" : "+v"(tid_));
  const int tid = tid_, wid = tid >> 6, lane = tid & 63, r32 = lane & 31, hi = lane >> 5;
  char* V_lds = lds; char* K_lds = lds + LDS_K_OFF;
  float* ws = (float*)(lds + LDS_WS_OFF) + wid * 64; float* li_l = ws; float* al_l = ws + 32;
  float* tbl_l = (float*)(lds + LDS_TBL_OFF);
  __syncthreads();
  if constexpr (BIAS) { for (int i = tid; i < TBLN; i += 512) tbl_l[i] = tblg[i]; }
  float m_reg = -1e30f, l_reg = 0; f32x16 o[4] = {}; bf16x8 qr[NDQ - NQL];
  const bf16_t* Qw = Qb + (long)(wid * QBLK + r32) * ldq + hi * 8;
  char* qls = lds + LDS_Q_OFF + wid * 4096 + lane * 16;
#pragma unroll
  for (int d0 = 0; d0 < NDQ - NQL; ++d0) qr[d0] = *reinterpret_cast<const bf16x8*>(Qw + d0 * 16);
#pragma unroll
  for (int d0 = NDQ - NQL; d0 < NDQ; ++d0) *reinterpret_cast<bf16x8*>(qls + (d0 - (NDQ - NQL)) * 1024) = *reinterpret_cast<const bf16x8*>(Qw + d0 * 16);
  const int sr = tid >> 4, sc = (tid & 15) * 8, vst0 = v_st(sr, sc), vst1 = v_st(32 + sr, sc);
  const int sr8 = tid >> 3, sc8 = (tid & 7) * 8;
  const int vb0 = (int)(uintptr_t)V_lds + v_rd_base(lane);
  const int qlane = q0 + wid * QBLK + r32;
  struct { bf16x8 vs0, vs1, ks0, ks1, ks2; } sr_[SDEPTH];
#define KSWZ(row, colB) ((row) * ROWB + ((colB) ^ (((row) & 7) << 4)))
#define SLOAD(i, k0) do { sr_[i].vs0 = *reinterpret_cast<const bf16x8*>(&Vh[(long)((k0) + sr) * ldv + sc]); sr_[i].vs1 = *reinterpret_cast<const bf16x8*>(&Vh[(long)((k0) + 32 + sr) * ldv + sc]); \
    if constexpr (NDQ == 4) { sr_[i].ks0 = *reinterpret_cast<const bf16x8*>(&Kh[(long)((k0) + sr8) * ldk + sc8]); } \
    else { sr_[i].ks0 = *reinterpret_cast<const bf16x8*>(&Kh[(long)((k0) + sr) * ldk + sc]); sr_[i].ks1 = *reinterpret_cast<const bf16x8*>(&Kh[(long)((k0) + 32 + sr) * ldk + sc]); \
      if constexpr (NDQ == 12) { sr_[i].ks2 = *reinterpret_cast<const bf16x8*>(&K2[(long)((k0) + sr8) * ldk2 + sc8]); } } } while (0)
#define SWRITE(b, i) do { *(bf16x8*)(V_lds + (b) * SHM_V + vst0) = sr_[i].vs0; *(bf16x8*)(V_lds + (b) * SHM_V + vst1) = sr_[i].vs1; \
    if constexpr (NDQ == 4) { *(bf16x8*)(K_lds + (b) * SHM_K + KSWZ(sr8, sc8 * 2)) = sr_[i].ks0; } \
    else { *(bf16x8*)(K_lds + (b) * SHM_K + KSWZ(sr, sc * 2)) = sr_[i].ks0; *(bf16x8*)(K_lds + (b) * SHM_K + KSWZ(32 + sr, sc * 2)) = sr_[i].ks1; \
      if constexpr (NDQ == 12) { *(bf16x8*)(K_lds + (b) * SHM_K + KSWZ(sr8, 256 + sc8 * 2)) = sr_[i].ks2; } } } while (0)
#define SWAIT() do { if constexpr (SDEPTH == 2) { if constexpr (NDQ == 4) asm volatile("s_waitcnt vmcnt(3)" ::: "memory"); else if constexpr (NDQ == 8) asm volatile("s_waitcnt vmcnt(4)" ::: "memory"); else asm volatile("s_waitcnt vmcnt(5)" ::: "memory"); } \
    else asm volatile("s_waitcnt vmcnt(0)" ::: "memory"); } while (0)
#define RESC(a) do { if (__any((a) < 1.f)) { if (hi == 0) al_l[r32] = (a); asm volatile("s_waitcnt lgkmcnt(0)" ::: "memory"); \
    _Pragma("unroll") for (int d = 0; d < 4; ++d) _Pragma("unroll") for (int r = 0; r < 16; ++r) o[d][r] *= al_l[crow(r, hi)]; } } while (0)
#define BIASADD(P0, P1, kt0, CB) do { CB = 0.f; if constexpr (BIAS) { const int dlo_ = (kt0) - q0 - 255, dhi_ = (kt0) + 63 - q0; \
    if (dlo_ >= 1024) CB = cb_hi; else if (dhi_ <= -1024) CB = cb_lo; \
    else { const float* tb_ = tbl_l + ((kt0) - qlane + TOFF + 4 * hi); \
      _Pragma("unroll") for (int r = 0; r < 16; ++r) { P0[r] += tb_[(r & 3) + 8 * (r >> 2)]; P1[r] += tb_[32 + (r & 3) + 8 * (r >> 2)]; } } } } while (0)
  f32x16 pA0, pA1, pB0, pB1; float mnA, mnB, alA, alB, cbA, cbB; bf16x8 pa0, pa1, pa2, pa3; const int NT = nkeys / KVBLK;
  constexpr int SE = 0, SO = SDEPTH - 1;
  SLOAD(SE, kbeg); asm volatile("s_waitcnt vmcnt(0)" ::: "memory"); SWRITE(0, SE); __syncthreads();
  qkt<NDQ, NQL>(pA0, pA1, K_lds, qr, qls, r32, hi); BIASADD(pA0, pA1, kbeg, cbA); partialSM(pA0, pA1, m_reg, mnA, alA, C, thr_raw, cbA);
  SLOAD(SO, kbeg + KVBLK); if constexpr (SDEPTH == 2) { if (2 < NT) SLOAD(SE, kbeg + 2 * KVBLK); }
  SWAIT(); SWRITE(1, SO); __syncthreads();
  for (int j = 1; j + 1 < NT; j += 2) {
    SBAR(); qkt<NDQ, NQL>(pB0, pB1, K_lds + SHM_K, qr, qls, r32, hi);
    finishSM(pA0, pA1, alA, l_reg, pa0, pa1, pa2, pa3); SBAR();
    SLOAD(SO, kbeg + (j + SDEPTH) * KVBLK); SBAR();
    pv_d0(o, vb0, pa0, pa1, pa2, pa3); BIASADD(pB0, pB1, kbeg + j * KVBLK, cbB); partialSM(pB0, pB1, m_reg, mnB, alB, C, thr_raw, cbB);
    __syncthreads(); SWAIT(); SWRITE(0, SE);
    RESC(alB); __syncthreads();
    SBAR(); qkt<NDQ, NQL>(pA0, pA1, K_lds, qr, qls, r32, hi);
    finishSM(pB0, pB1, alB, l_reg, pa0, pa1, pa2, pa3); SBAR();
    if (SDEPTH == 1 || j + 3 < NT) SLOAD(SE, kbeg + (j + 1 + SDEPTH) * KVBLK); SBAR();
    pv_d0(o, vb0 + (int)SHM_V, pa0, pa1, pa2, pa3); BIASADD(pA0, pA1, kbeg + (j + 1) * KVBLK, cbA); partialSM(pA0, pA1, m_reg, mnA, alA, C, thr_raw, cbA);
    __syncthreads(); SWAIT(); SWRITE(1, SO);
    RESC(alA); __syncthreads();
  }
  SBAR(); qkt<NDQ, NQL>(pB0, pB1, K_lds + SHM_K, qr, qls, r32, hi);
  finishSM(pA0, pA1, alA, l_reg, pa0, pa1, pa2, pa3); SBAR();
  pv_d0(o, vb0, pa0, pa1, pa2, pa3); BIASADD(pB0, pB1, kbeg + (NT - 1) * KVBLK, cbB); partialSM(pB0, pB1, m_reg, mnB, alB, C, thr_raw, cbB);
  __syncthreads(); RESC(alB);
  finishSM(pB0, pB1, alB, l_reg, pa0, pa1, pa2, pa3); SBAR();
  pv_d0(o, vb0 + (int)SHM_V, pa0, pa1, pa2, pa3);
  if (hi == 0) li_l[r32] = l_reg; asm volatile("s_waitcnt lgkmcnt(0)" ::: "memory");
  float rli[16];
#pragma unroll
  for (int r = 0; r < 16; ++r) rli[r] = __builtin_amdgcn_rcpf(li_l[crow(r, hi)]);
  if constexpr (EPI == 0) {
    bf16_t* Ow = Obf + (long)(wid * QBLK) * ldo;
#pragma unroll
    for (int r = 0; r < 16; ++r) { const int orow = crow(r, hi);
#pragma unroll
      for (int d0 = 0; d0 < 4; ++d0) Ow[(long)orow * ldo + d0 * 32 + r32] = (bf16_t)f2bf(o[d0][r] * rli[r]); }
  } else if constexpr (EPI == 1) {
    float* Tw = tmp + (wid * QBLK) * 128;
#pragma unroll
    for (int r = 0; r < 16; ++r) { const int orow = crow(r, hi);
#pragma unroll
      for (int d0 = 0; d0 < 4; ++d0) Tw[orow * 128 + d0 * 32 + r32] = o[d0][r] * rli[r]; }
  } else {
    const float* Tw = tmp + (wid * QBLK) * 128; bf16_t* Ow = Obf + (long)(wid * QBLK) * ldo;
    float sg[4];
#pragma unroll
    for (int d0 = 0; d0 < 4; ++d0) sg[d0] = subln[d0 * 32 + r32] * post;
#pragma unroll
    for (int r = 0; r < 16; ++r) { const int orow = crow(r, hi); float v[4]; float ss = 0.f;
#pragma unroll
      for (int d0 = 0; d0 < 4; ++d0) { v[d0] = Tw[orow * 128 + d0 * 32 + r32] - lam * (o[d0][r] * rli[r]); ss += v[d0] * v[d0]; }
      ss += __shfl_xor(ss, 1); ss += __shfl_xor(ss, 2); ss += __shfl_xor(ss, 4); ss += __shfl_xor(ss, 8); ss += __shfl_xor(ss, 16);
      const float rs = rsqrtf(ss * (1.0f / 128.0f) + EPS);
#pragma unroll
      for (int d0 = 0; d0 < 4; ++d0) Ow[(long)orow * ldo + d0 * 32 + r32] = (bf16_t)f2bf(v[d0] * rs * sg[d0]); }
  }
#undef KSWZ
#undef SLOAD
#undef SWRITE
#undef SWAIT
#undef RESC
#undef BIASADD
}
}

__device__ __forceinline__ void transpose_item(const float* __restrict__ W, int K, int N, bf16_t* __restrict__ WT, int k0, int n0, int drow0, LAS float* scr, int lane) {
#pragma unroll 8
    for (int i = 0; i < 32; ++i) { const int kk = 2 * i + (lane >> 5); scr[kk * 33 + (lane & 31)] = W[(size_t)(k0 + kk) * N + n0 + (lane & 31)]; }
    asm volatile("s_waitcnt lgkmcnt(0)" ::: "memory");
    const int c = lane & 7;
#pragma unroll
    for (int j = 0; j < 4; ++j) { const int n = (lane >> 3) + 8 * j; const LAS float* s = scr + (8 * c) * 33 + n;
        u32x4 o; o.x = pk2(s[0 * 33], s[1 * 33]); o.y = pk2(s[2 * 33], s[3 * 33]); o.z = pk2(s[4 * 33], s[5 * 33]); o.w = pk2(s[6 * 33], s[7 * 33]);
        *(u32x4*)(WT + (size_t)(drow0 + n) * K + k0 + 8 * c) = o; }
    asm volatile("s_waitcnt lgkmcnt(0)" ::: "memory");
}
template <int MODE>
__device__ __forceinline__ void transpose_matrix(const float* __restrict__ W, int K, int N, bf16_t* __restrict__ WT, LAS float* scr, int lane, int gw, int NGW) {
    const int nblk = N / 32, nitems = (K / 64) * nblk;
    for (int it = gw; it < nitems; it += NGW) { const int kb = it / nblk, nb = it % nblk, n0 = 32 * nb; int drow0 = n0;
        if (MODE == 1) { const int c = n0 < FF ? n0 : n0 - FF; drow0 = 256 * (c / 128) + (c % 128) + (n0 < FF ? 0 : 128); }
        transpose_item(W, K, N, WT, 64 * kb, n0, drow0, scr, lane); }
}
__device__ __forceinline__ int t5_bucket(int d) {
    const int ret = d > 0 ? 16 : 0; const int n = d < 0 ? -d : d;
    if (n < 8) return ret + n;
    const float v = logf((float)n / 8.0f) / 4.852030263919617f * 8.0f;
    int large = 8 + (int)v; if (large > 15) large = 15;
    return ret + large;
}
__device__ __forceinline__ void norm_row(const float* __restrict__ xrow, const float* __restrict__ g, bf16_t* __restrict__ hrow, int lane) {
    f32x4 v[8]; float ss = 0.f;
#pragma unroll
    for (int j = 0; j < 8; ++j) { v[j] = ((const f32x4*)xrow)[lane + 64 * j]; ss += (v[j].x * v[j].x + v[j].y * v[j].y) + (v[j].z * v[j].z + v[j].w * v[j].w); }
    const float rs = rsqrtf(wave_sum(ss) * (1.0f / DM) + EPS);
#pragma unroll
    for (int j = 0; j < 8; ++j) { const f32x4 gg = ((const f32x4*)g)[lane + 64 * j];
        u32x2 w; w.x = pk2(v[j].x * rs * gg.x, v[j].y * rs * gg.y); w.y = pk2(v[j].z * rs * gg.z, v[j].w * rs * gg.w); ((u32x2*)hrow)[lane + 64 * j] = w; }
}
__device__ __forceinline__ void norm_add_row(const float* __restrict__ yrow, const float* __restrict__ xirow, float* __restrict__ xorow, const float* __restrict__ gpost,
                                             const float* __restrict__ gpre, bf16_t* __restrict__ hrow, int lane) {
    f32x4 v[8]; float ss = 0.f;
#pragma unroll
    for (int j = 0; j < 8; ++j) { v[j] = ((const f32x4*)yrow)[lane + 64 * j]; ss += (v[j].x * v[j].x + v[j].y * v[j].y) + (v[j].z * v[j].z + v[j].w * v[j].w); }
    const float rs = rsqrtf(wave_sum(ss) * (1.0f / DM) + EPS);
    float ss2 = 0.f;
#pragma unroll
    for (int j = 0; j < 8; ++j) { const f32x4 gg = ((const f32x4*)gpost)[lane + 64 * j]; const f32x4 xx = ((const f32x4*)xirow)[lane + 64 * j];
        v[j] = xx + v[j] * rs * gg; ((f32x4*)xorow)[lane + 64 * j] = v[j];
        ss2 += (v[j].x * v[j].x + v[j].y * v[j].y) + (v[j].z * v[j].z + v[j].w * v[j].w); }
    if (gpre) {
        const float rs2 = rsqrtf(wave_sum(ss2) * (1.0f / DM) + EPS);
#pragma unroll
        for (int j = 0; j < 8; ++j) { const f32x4 gg = ((const f32x4*)gpre)[lane + 64 * j];
            u32x2 w; w.x = pk2(v[j].x * rs2 * gg.x, v[j].y * rs2 * gg.y); w.y = pk2(v[j].z * rs2 * gg.z, v[j].w * rs2 * gg.w); ((u32x2*)hrow)[lane + 64 * j] = w; }
    }
}

__device__ __forceinline__ void head_norm_axial(const bf16_t* __restrict__ src, bf16_t* __restrict__ dst, const float* __restrict__ g, const float* __restrict__ COS, const float* __restrict__ SIN, int row, int t) {
    float v[8];
#pragma unroll
    for (int s = 0; s < 4; ++s) { const unsigned w = *(const unsigned*)(src + 32 * s + 2 * t); v[2 * s] = bf2f((unsigned short)(w & 0xffff)); v[2 * s + 1] = bf2f((unsigned short)(w >> 16)); }
    float ss = 0.f;
#pragma unroll
    for (int i = 0; i < 8; ++i) ss += v[i] * v[i];
    ss += __shfl_xor(ss, 1); ss += __shfl_xor(ss, 2); ss += __shfl_xor(ss, 4); ss += __shfl_xor(ss, 8);
    const float rs = rsqrtf(ss * (1.0f / 128.0f) + EPS);
#pragma unroll
    for (int s = 0; s < 4; ++s) { v[2 * s] *= rs * g[32 * s + 2 * t]; v[2 * s + 1] *= rs * g[32 * s + 2 * t + 1]; }
    const int pr = row >> 6, pc = row & 63;
    float o[8];
#pragma unroll
    for (int e = 0; e < 2; ++e) { const int i = 2 * t + e;
        { const float c = COS[pr * 32 + i], s = SIN[pr * 32 + i]; const float x1 = v[e], x2 = v[2 + e]; o[e] = x1 * c - x2 * s; o[2 + e] = x2 * c + x1 * s; }
        { const float c = COS[pc * 32 + i], s = SIN[pc * 32 + i]; const float x1 = v[4 + e], x2 = v[6 + e]; o[4 + e] = x1 * c - x2 * s; o[6 + e] = x2 * c + x1 * s; } }
#pragma unroll
    for (int s = 0; s < 4; ++s) *(unsigned*)(dst + 32 * s + 2 * t) = pk2(o[2 * s], o[2 * s + 1]);
}

struct Args { const float* in[18]; float* out; unsigned char* ws; int ph_lo, ph_hi; };

__global__ void __launch_bounds__(512, 2) mega_fwd(Args args) {
    extern __shared__ __attribute__((aligned(16))) unsigned char lds[];
    const int G = gridDim.x, bid = blockIdx.x, NGW = G * 8;
    typedef const __attribute__((address_space(4))) Args* KArgP;
    LAS unsigned char* ldsl = (LAS unsigned char*)lds;
#define x_in (kap->in[0])
#define rel_bias (kap->in[1])
#define norm_mix_pre (kap->in[2])
#define norm_mix_post (kap->in[3])
#define norm_ffn_pre (kap->in[4])
#define norm_ffn_post (kap->in[5])
#define w_in (kap->in[6])
#define diff_lambda (kap->in[7])
#define diff_subln (kap->in[8])
#define mla_q_norm (kap->in[9])
#define mla_kv_norm (kap->in[10])
#define mla_w_uq (kap->in[11])
#define mla_w_ukv (kap->in[12])
#define gqa_q_norm (kap->in[13])
#define gqa_k_norm (kap->in[14])
#define w_out (kap->in[15])
#define w_gate_up (kap->in[16])
#define w_down (kap->in[17])
#define xres (kap->out)
#define ws (kap->ws)
#define PAR ((float*)(ws + WS_PAR))
#define TBLA ((float*)(ws + WS_TBLA))
#define TBLD ((float*)(ws + WS_TBLD))
#define COS ((float*)(ws + WS_COS))
#define SIN ((float*)(ws + WS_SIN))
#define H ((bf16_t*)(ws + WS_H))
#define PROJ ((bf16_t*)(ws + WS_PROJ))
#define CQN ((bf16_t*)(ws + WS_CQN))
#define CKVN ((bf16_t*)(ws + WS_CKVN))
#define KPE ((bf16_t*)(ws + WS_KPE))
#define QC ((bf16_t*)(ws + WS_QC))
#define KC ((bf16_t*)(ws + WS_KC))
#define QB ((bf16_t*)(ws + WS_QB))
#define KVB ((bf16_t*)(ws + WS_KVB))
#define MIX ((bf16_t*)(ws + WS_MIX))
#define Y ((float*)(ws + WS_Y))
#define HID ((bf16_t*)(ws + WS_HID))
#define TMP ((float*)(ws + WS_TMP))
#define wl (ws + WS_W + (size_t)l * LW)

    const int lo = args.ph_lo, hi_ph = args.ph_hi; int ph = 0;
#define PH_BEGIN if (ph >= lo && ph < hi_ph) { KArgP kap = (KArgP)__builtin_amdgcn_kernarg_segment_ptr(); asm volatile("" : "+s"(kap)); \
    int tid_ = threadIdx.x; asm volatile("" : "+v"(tid_)); const int tid = tid_, lane = tid & 63, wave = __builtin_amdgcn_readfirstlane(tid >> 6), gw = bid * 8 + wave; (void)lane; (void)gw;
#define PH_END } if (ph >= lo && ph + 1 < hi_ph) { cg::this_grid().sync(); } ++ph;

    PH_BEGIN
    if PHON(0) {
        LAS float* scr = (LAS float*)(ldsl + wave * 16384);
        for (int l = 0; l < DEPTH; ++l) {
            transpose_matrix<0>(w_in + (size_t)l * DM * NPROJ, DM, NPROJ, (bf16_t*)(wl + W_IN), scr, lane, gw, NGW);
            transpose_matrix<0>(mla_w_uq + (size_t)l * 512 * 768, 512, 768, (bf16_t*)(wl + W_UQ), scr, lane, gw, NGW);
            transpose_matrix<0>(mla_w_ukv + (size_t)l * 256 * 1024, 256, 1024, (bf16_t*)(wl + W_UKV), scr, lane, gw, NGW);
            transpose_matrix<0>(w_out + (size_t)l * DM * DM, DM, DM, (bf16_t*)(wl + W_OUT), scr, lane, gw, NGW);
            transpose_matrix<1>(w_gate_up + (size_t)l * DM * NGU, DM, NGU, (bf16_t*)(wl + W_GU), scr, lane, gw, NGW);
            transpose_matrix<0>(w_down + (size_t)l * FF * DM, FF, DM, (bf16_t*)(wl + W_D), scr, lane, gw, NGW);
            { u32x4* z = (u32x4*)((bf16_t*)(wl + W_IN) + (size_t)NPROJ * DM); const int n16 = (LDP - NPROJ) * DM * 2 / 16;
              for (int i = bid * 512 + tid; i < n16; i += G * 512) z[i] = (u32x4){0u, 0u, 0u, 0u}; }
        }
        const int gt = bid * 512 + tid, NT_ = G * 512;
        for (int i = gt; i < 4 * TBLN; i += NT_) { const int h = i / TBLN, d = (i % TBLN) - TOFF; const int b = t5_bucket(d);
            TBLA[i] = rel_bias[b * 8 + h] * 8.0f;
            const int n = d < 0 ? -d : d; int mult = (n <= 64 ? 1 : 0) + (((n & 3) == 0 && n <= 256) ? 1 : 0) + (((n & 15) == 0 && n <= 1024) ? 1 : 0);
            TBLD[i] = mult ? (rel_bias[b * 8 + 4 + h] + logf((float)mult)) * 11.313708498984761f : -1e30f; }
        for (int i = gt; i < S * 32; i += NT_) { const int pos = i >> 5, f = i & 31;
            const float inv = (float)pow(10000.0, -(double)(2 * f) / 64.0); const float ang = (float)pos * inv;
            COS[i] = (float)cos((double)ang); SIN[i] = (float)sin((double)ang); }
        if (bid == 0 && tid < DEPTH) { const float* lv = diff_lambda + tid * 256; float s1 = 0.f, s2 = 0.f;
            for (int i = 0; i < 64; ++i) { s1 += lv[i] * lv[64 + i]; s2 += lv[128 + i] * lv[192 + i]; }
            const float lam_init = 0.8f - 0.6f * expf(-0.3f * (float)tid);
            PAR[tid] = expf(s1) - expf(s2) + lam_init; PAR[4 + tid] = lam_init; }
        for (int row = gw; row < S; row += NGW) norm_row(x_in + (size_t)row * DM, norm_mix_pre, H + (size_t)row * DM, lane);
    }
    PH_END

    for (int l = 0; l < DEPTH; ++l) {
        PH_BEGIN
        if PHON(1) { pg8::Gemm g{H, (const bf16_t*)(wl + W_IN), S, LDP, DM}; pg8::StaticOrder So; So.init(S, LDP, G, bid);
          pg8::EpiBf16 E{PROJ, LDP};
          pg8::gemm_phase<pg8::EpiBf16, pg8::StaticOrder, true, true>(ldsl, g, So, E); }
        PH_END
        PH_BEGIN
        if PHON(2) for (int row = gw; row < S; row += NGW) {
            const bf16_t* pr = PROJ + (size_t)row * LDP;
            { const u32x4 raw = *(const u32x4*)(pr + C_BCQ + lane * 8); float v[8];
              v[0] = __uint_as_float(raw.x << 16); v[1] = __uint_as_float(raw.x & 0xffff0000u); v[2] = __uint_as_float(raw.y << 16); v[3] = __uint_as_float(raw.y & 0xffff0000u);
              v[4] = __uint_as_float(raw.z << 16); v[5] = __uint_as_float(raw.z & 0xffff0000u); v[6] = __uint_as_float(raw.w << 16); v[7] = __uint_as_float(raw.w & 0xffff0000u);
              float ss = 0.f;
#pragma unroll
              for (int i = 0; i < 8; ++i) ss += v[i] * v[i];
              const float rs = rsqrtf(wave_sum(ss) * (1.0f / 512.0f) + EPS);
              const f32x4 g0 = *(const f32x4*)(mla_q_norm + l * 512 + lane * 8), g1 = *(const f32x4*)(mla_q_norm + l * 512 + lane * 8 + 4);
              u32x4 w; w.x = pk2(v[0] * rs * g0.x, v[1] * rs * g0.y); w.y = pk2(v[2] * rs * g0.z, v[3] * rs * g0.w); w.z = pk2(v[4] * rs * g1.x, v[5] * rs * g1.y); w.w = pk2(v[6] * rs * g1.z, v[7] * rs * g1.w);
              *(u32x4*)(CQN + (size_t)row * 512 + lane * 8) = w; }
            { const u32x2 raw = *(const u32x2*)(pr + C_BCKV + lane * 4); float v[4];
              v[0] = __uint_as_float(raw.x << 16); v[1] = __uint_as_float(raw.x & 0xffff0000u); v[2] = __uint_as_float(raw.y << 16); v[3] = __uint_as_float(raw.y & 0xffff0000u);
              float ss = v[0] * v[0] + v[1] * v[1] + v[2] * v[2] + v[3] * v[3];
              const float rs = rsqrtf(wave_sum(ss) * (1.0f / 256.0f) + EPS);
              const f32x4 g0 = *(const f32x4*)(mla_kv_norm + l * 256 + lane * 4);
              u32x2 w; w.x = pk2(v[0] * rs * g0.x, v[1] * rs * g0.y); w.y = pk2(v[2] * rs * g0.z, v[3] * rs * g0.w);
              *(u32x2*)(CKVN + (size_t)row * 256 + lane * 4) = w; }
            if (lane < 32) { const float x1 = bf2f(pr[C_BKPE + lane]), x2 = bf2f(pr[C_BKPE + 32 + lane]); const float c = COS[row * 32 + lane], s = SIN[row * 32 + lane];
              KPE[(size_t)row * 64 + lane] = (bf16_t)f2bf(x1 * c - x2 * s); KPE[(size_t)row * 64 + 32 + lane] = (bf16_t)f2bf(x2 * c + x1 * s); }
            { const int hd = lane >> 4, t = lane & 15;
              head_norm_axial(pr + C_CQ + hd * 128, QC + (size_t)row * 512 + hd * 128, gqa_q_norm + l * 128, COS, SIN, row, t);
              const int hk = hd & 1;
              if (lane < 32) head_norm_axial(pr + C_CK + hk * 128, KC + (size_t)row * 256 + hk * 128, gqa_k_norm + l * 128, COS, SIN, row, t); }
        }
        PH_END
        PH_BEGIN
        if PHON(3) { pg8::Gemm g{CQN, (const bf16_t*)(wl + W_UQ), S, 768, 512}; pg8::StaticOrder So; So.init(S, 768, G, bid);
          pg8::EpiBf16 E{QB, 768};
          pg8::gemm_phase<pg8::EpiBf16, pg8::StaticOrder, true, true>(ldsl, g, So, E); }
        if PHON(4) { pg8::Gemm g{CKVN, (const bf16_t*)(wl + W_UKV), S, 1024, 256}; pg8::StaticOrder So; So.init(S, 1024, G, bid);
          pg8::EpiBf16 E{KVB, 1024};
          pg8::gemm_phase<pg8::EpiBf16, pg8::StaticOrder, true, true>(ldsl, g, So, E); }
        PH_END
        PH_BEGIN
        if PHON(5) for (int row = gw; row < S; row += NGW) {
#pragma unroll
            for (int e = 0; e < 2; ++e) { const int p = lane + 64 * e, hd = p >> 5, i = p & 31; bf16_t* q = QB + (size_t)row * 768 + hd * 192 + 128 + i;
                const float x1 = bf2f(q[0]), x2 = bf2f(q[32]); const float c = COS[row * 32 + i], s = SIN[row * 32 + i];
                q[0] = (bf16_t)f2bf(x1 * c - x2 * s); q[32] = (bf16_t)f2bf(x2 * c + x1 * s); }
        }
        PH_END
        PH_BEGIN
        {
            const float lam = PAR[l], lam_init = PAR[4 + l];
            const float L2E = 1.4426950408889634f;
            if PHON(6) for (int u = bid; u < 256; u += G) { const int xq = u & 7, hd = xq & 3, qb = (u >> 3) + 32 * (xq >> 2), q0 = qb * 256;
                { const float sc = 0.125f; float* tmpu = TMP + (size_t)u * 256 * 128;
                  const float cb_lo = rel_bias[15 * 8 + hd] * 8.0f, cb_hi = rel_bias[31 * 8 + hd] * 8.0f;
                  att::attn_unit<4, 1, 1, 1>(PROJ + (size_t)q0 * LDP + C_AQ + hd * 128, LDP, PROJ + C_AK + hd * 128, LDP, nullptr, 0, PROJ + C_AV + hd * 128, LDP,
                                           0, S, q0, TBLA + hd * TBLN, cb_lo, cb_hi, sc * L2E, 8.0f / sc, nullptr, 0, tmpu, 0.f, nullptr, 0.f, (char*)lds);
                  att::attn_unit<4, 1, 2, 1>(PROJ + (size_t)q0 * LDP + C_AQ + hd * 128 + 64, LDP, PROJ + C_AK + hd * 128 + 64, LDP, nullptr, 0, PROJ + C_AV + hd * 128, LDP,
                                           0, S, q0, TBLA + hd * TBLN, cb_lo, cb_hi, sc * L2E, 8.0f / sc, MIX + (size_t)q0 * DM + hd * 128, DM, tmpu, lam, diff_subln + l * 128, 1.0f - lam_init, (char*)lds); }
            }
            if PHON(7) for (int u = bid; u < 256; u += G) { const int xq = u & 7, hd = xq & 3, qb = (u >> 3) + 32 * (xq >> 2), q0 = qb * 256;
                { const float sc = 0.07216878364870322f;
                  att::attn_unit<12, 0, 0, 1, 4>(QB + (size_t)q0 * 768 + hd * 192, 768, KVB + hd * 256, 1024, KPE, 64, KVB + hd * 256 + 128, 1024,
                                            0, S, q0, nullptr, 0.f, 0.f, sc * L2E, 8.0f / sc, MIX + (size_t)q0 * DM + 512 + hd * 128, DM, nullptr, 0.f, nullptr, 0.f, (char*)lds); }
            }
            if PHON(8) for (int u = bid; u < 256; u += G) { const int xq = u & 7, hd = xq & 3, qb = (u >> 3) + 32 * (xq >> 2), q0 = qb * 256;
                { const float sc = 0.08838834764831845f;
                  att::attn_unit<8, 0, 0, 1>(QC + (size_t)q0 * 512 + hd * 128, 512, KC + (hd >> 1) * 128, 256, nullptr, 0, PROJ + C_CV + (hd >> 1) * 128, LDP,
                                           0, S, q0, nullptr, 0.f, 0.f, sc * L2E, 8.0f / sc, MIX + (size_t)q0 * DM + 1024 + hd * 128, DM, nullptr, 0.f, nullptr, 0.f, (char*)lds); }
            }
            if PHON(9) for (int u = bid; u < 256; u += G) { const int xq = u & 7, hd = xq & 3, qb = (u >> 3) + 32 * (xq >> 2), q0 = qb * 256;
                { const float sc = 0.08838834764831845f;
                  const int kb = q0 - 1024 < 0 ? 0 : q0 - 1024, ke = q0 + 256 + 1024 > S ? S : q0 + 256 + 1024;
                  att::attn_unit<8, 1, 0, 1>(PROJ + (size_t)q0 * LDP + C_DQ + hd * 128, LDP, PROJ + C_DK + hd * 128, LDP, nullptr, 0, PROJ + C_DV + hd * 128, LDP,
                                           kb, ke - kb, q0, TBLD + hd * TBLN, 0.f, 0.f, sc * L2E, 8.0f / sc, MIX + (size_t)q0 * DM + 1536 + hd * 128, DM, nullptr, 0.f, nullptr, 0.f, (char*)lds); }
            }
            __syncthreads();
        }
        PH_END
        PH_BEGIN
        if PHON(10) { pg8::Gemm g{MIX, (const bf16_t*)(wl + W_OUT), S, DM, DM}; pg8::StaticOrder So; So.init(S, DM, G, bid);
          pg8::EpiF32 E{Y, DM};
          pg8::gemm_phase<pg8::EpiF32, pg8::StaticOrder, true, true>(ldsl, g, So, E); }
        PH_END
        PH_BEGIN
        if PHON(11) for (int row = gw; row < S; row += NGW)
            norm_add_row(Y + (size_t)row * DM, (l == 0 ? x_in : xres) + (size_t)row * DM, xres + (size_t)row * DM, norm_mix_post + l * DM, norm_ffn_pre + l * DM, H + (size_t)row * DM, lane);
        PH_END
        PH_BEGIN
        if PHON(12) { pg8::Gemm g{H, (const bf16_t*)(wl + W_GU), S, NGU, DM}; pg8::StaticOrder So; So.init(S, NGU, G, bid);
          pg8::EpiSwiGLU E{HID, FF};
          pg8::gemm_phase<pg8::EpiSwiGLU, pg8::StaticOrder, true, true>(ldsl, g, So, E); }
        PH_END
        PH_BEGIN
        if PHON(13) { pg8::Gemm g{HID, (const bf16_t*)(wl + W_D), S, DM, FF}; pg8::StaticOrder So; So.init(S, DM, G, bid);
          pg8::EpiF32 E{Y, DM};
          pg8::gemm_phase<pg8::EpiF32, pg8::StaticOrder, true, true>(ldsl, g, So, E); }
        PH_END
        PH_BEGIN
        if PHON(14) for (int row = gw; row < S; row += NGW)
            norm_add_row(Y + (size_t)row * DM, xres + (size_t)row * DM, xres + (size_t)row * DM, norm_ffn_post + l * DM, (l + 1 < DEPTH) ? norm_mix_pre + (l + 1) * DM : nullptr, H + (size_t)row * DM, lane);
        PH_END
    }
#undef PH_BEGIN
#undef PH_END
}
#undef x_in
#undef rel_bias
#undef norm_mix_pre
#undef norm_mix_post
#undef norm_ffn_pre
#undef norm_ffn_post
#undef w_in
#undef diff_lambda
#undef diff_subln
#undef mla_q_norm
#undef mla_kv_norm
#undef mla_w_uq
#undef mla_w_ukv
#undef gqa_q_norm
#undef gqa_k_norm
#undef w_out
#undef w_gate_up
#undef w_down
#undef xres
#undef ws
#undef PAR
#undef TBLA
#undef TBLD
#undef COS
#undef SIN
#undef H
#undef PROJ
#undef CQN
#undef CKVN
#undef KPE
#undef QC
#undef KC
#undef QB
#undef KVB
#undef MIX
#undef Y
#undef HID
#undef TMP
#undef wl

constexpr int N_PHASES = 1 + DEPTH * 10;

extern "C" void kernel_launch(void* const* d_in, const int* in_sizes, int n_in, void* d_out, int out_size, void* d_ws, size_t ws_size, hipStream_t stream) {
    static int grid = 0;
    if (grid == 0) {
        if (n_in != 18 || in_sizes[0] != S * DM || out_size != S * DM || ws_size < WS_END) {
            fprintf(stderr, "kernel_launch: unexpected shapes (n_in %d, in0 %d, out %d, ws %zu < %zu)\n", n_in, n_in > 0 ? in_sizes[0] : -1, out_size, ws_size, (size_t)WS_END); grid = -1; return; }
        int dev = 0, cus = 0, per_cu = 0;
        if (hipGetDevice(&dev) != hipSuccess || hipDeviceGetAttribute(&cus, hipDeviceAttributeMultiprocessorCount, dev) != hipSuccess) { grid = -1; return; }
        if (hipFuncSetAttribute((const void*)mega_fwd, hipFuncAttributeMaxDynamicSharedMemorySize, LDS_BYTES) != hipSuccess) { fprintf(stderr, "kernel_launch: hipFuncSetAttribute failed\n"); grid = -1; return; }
        if (hipOccupancyMaxActiveBlocksPerMultiprocessor(&per_cu, (const void*)mega_fwd, 512, LDS_BYTES) != hipSuccess || per_cu < 1) { fprintf(stderr, "kernel_launch: occupancy query says %d\n", per_cu); per_cu = 1; }
        (void)hipGetLastError();
        grid = cus;
    }
    if (grid < 0) return;
    Args a{};
    for (int i = 0; i < 18; ++i) a.in[i] = (const float*)d_in[i];
    a.out = (float*)d_out; a.ws = (unsigned char*)d_ws;
#if MK_MULTI
    for (int p = 0; p < N_PHASES; ++p) { a.ph_lo = p; a.ph_hi = p + 1; hipLaunchKernelGGL(mega_fwd, dim3(grid), dim3(512), LDS_BYTES, stream, a); }
#else
    a.ph_lo = 0; a.ph_hi = N_PHASES;
    void* kargs[] = {&a};
    hipError_t e = hipLaunchCooperativeKernel((const void*)mega_fwd, dim3(grid), dim3(512), kargs, LDS_BYTES, stream);
    if (e != hipSuccess) fprintf(stderr, "kernel_launch: cooperative launch failed: %s (grid %d)\n", hipGetErrorString(e), grid);
#endif
}
```

```cpp
#include <hip/hip_runtime.h>
#include <hip/hip_cooperative_groups.h>
#include <cstdio>
#include <cstdint>
namespace cg = cooperative_groups;

#ifndef MK_MULTI
#define MK_MULTI 0
#endif
#ifndef MK_PHMASK
#define MK_PHMASK 0xFFFFF
#endif
#define PHON(k) constexpr (((MK_PHMASK) >> (k)) & 1)
#ifndef MK_DUP_GEMM
#define MK_DUP_GEMM 1
#endif
#ifndef MK_DUP_ATT
#define MK_DUP_ATT 1
#endif

typedef unsigned short bf16_t;
typedef short bf16x8 __attribute__((ext_vector_type(8)));
typedef short s16x4 __attribute__((ext_vector_type(4)));
typedef float f32x2 __attribute__((ext_vector_type(2)));
typedef float f32x4 __attribute__((ext_vector_type(4)));
typedef float f32x16 __attribute__((ext_vector_type(16)));
typedef unsigned u32x2 __attribute__((ext_vector_type(2)));
typedef unsigned u32x4 __attribute__((ext_vector_type(4)));
#define LAS __attribute__((address_space(3)))

constexpr int S = 16384, DM = 2048, DEPTH = 4, NPROJ = 4928, LDP = 5120, FF = 5632, NGU = 2 * FF;
constexpr float EPS = 1e-6f;
constexpr int C_AQ = 0, C_AK = 512, C_AV = 1024, C_BCQ = 1536, C_BCKV = 2048, C_BKPE = 2304, C_CQ = 2368, C_CK = 2880, C_CV = 3136, C_DQ = 3392, C_DK = 3904, C_DV = 4416;
constexpr int TOFF = 1408, TBLN = 2824;

constexpr size_t MiB = 1u << 20;
constexpr size_t WS_PAR = 0, WS_TBLA = 1 * MiB, WS_TBLD = 1 * MiB + 65536, WS_COS = 2 * MiB, WS_SIN = 4 * MiB;
constexpr size_t WS_W = 8 * MiB, LW = 96 * MiB;
constexpr size_t W_IN = 0, W_UQ = 20 * MiB, W_UKV = 21 * MiB, W_OUT = 22 * MiB, W_GU = 30 * MiB, W_D = 74 * MiB;
constexpr size_t WS_H = 392 * MiB, WS_PROJ = 456 * MiB, WS_CQN = 616 * MiB, WS_CKVN = 632 * MiB, WS_KPE = 640 * MiB, WS_QC = 642 * MiB, WS_KC = 658 * MiB;
constexpr size_t WS_QB = 666 * MiB, WS_KVB = 690 * MiB, WS_MIX = 722 * MiB, WS_Y = 786 * MiB, WS_HID = 914 * MiB, WS_TMP = 1090 * MiB, WS_END = 1122 * MiB;

constexpr int LDS_BYTES = 163840;

__device__ __forceinline__ float bf2f(unsigned short b) { return __uint_as_float(((unsigned)b) << 16); }
__device__ __forceinline__ unsigned f2bf(float f) { unsigned u = __float_as_uint(f); return (u + 0x7fffu + ((u >> 16) & 1u)) >> 16; }
__device__ __forceinline__ unsigned pk2(float lo, float hi) { return f2bf(lo) | (f2bf(hi) << 16); }
__device__ __forceinline__ unsigned cvt_pk_bf16(float lo, float hi) { unsigned r; asm volatile("v_cvt_pk_bf16_f32 %0, %1, %2" : "=v"(r) : "v"(lo), "v"(hi)); return r; }
__device__ __forceinline__ float wave_sum(float v) {
#pragma unroll
    for (int o = 1; o < 64; o <<= 1) v += __shfl_xor(v, o);
    return v;
}

namespace pg8 {
constexpr int BM = 256, BK = 64, HALF = 128, HTB = HALF * BK * 2, STAGE_BYTES = 8 * HTB, NXCD = 8, WGM = 8;
__host__ __device__ __forceinline__ int lds_byte(int r, int c) { const int st = (r >> 4) * 2 + (c >> 5), rr = r & 15, cc = c & 31, ob = rr * 64 + cc * 2; return st * 1024 + (ob ^ (((ob >> 9) & 1) << 5)); }
__host__ __device__ __forceinline__ void stage_rc(int b, int& R, int& C) { const int st = b / 1024, sb = b % 1024, swz = sb ^ (((sb >> 9) & 1) << 5); R = (st >> 1) * 16 + swz / 64; C = (st & 1) * 32 + (swz % 64) / 2; }
__host__ __device__ __forceinline__ int perm32(int rho) { const int n = rho >> 4, i = rho & 15; return 8 * (i >> 2) + 4 * n + (i & 3); }

struct Unit { int pm, pn; };
struct Gemm { const bf16_t* A; const bf16_t* Bt; int M, N, K; };

struct StaticOrder {
    int nM, nN, nwg, G, c;
    __host__ __device__ void init(int M, int N, int G_, int c_) { nM = M / BM; nN = N / BM; nwg = nM * nN; G = G_; c = c_; }
    __host__ __device__ bool next(int i, Unit& u) const {
        const long L = (long)i * G + c; if (L >= nwg) return false;
        int wgid = (int)L; { const int q = nwg / NXCD, r = nwg % NXCD, xcd = wgid % NXCD, off = wgid / NXCD; wgid = (xcd < r ? xcd * (q + 1) : r * (q + 1) + (xcd - r) * q) + off; }
        const int nig = WGM * nN, gid = wgid / nig, fm = gid * WGM, gsz = (nM - fm) < WGM ? (nM - fm) : WGM;
        u.pm = fm + ((wgid % nig) % gsz); u.pn = (wgid % nig) / gsz; return true;
    }
    __device__ __forceinline__ void a_ready(const Unit&) const {}
    __device__ __forceinline__ void done(const Unit&) const {}
};

struct EpiBf16 {
    static constexpr bool PERM = true, AFTER_DRAIN = false;
    bf16_t* O; int ldc;
    __device__ __forceinline__ void operator()(const f32x4 (&acc)[2][2][4][2], const Unit& u, int wr, int wc, int fr, int fq) const {
        const int row0 = u.pm * BM + wr * 64 + fr; const int col0 = u.pn * BM + wc * 32 + 8 * fq;
#pragma unroll
        for (int ai = 0; ai < 2; ++ai)
#pragma unroll
            for (int m = 0; m < 4; ++m) { bf16_t* rowp = O + (size_t)(row0 + ai * HALF + m * 16) * ldc + col0;
#pragma unroll
                for (int bj = 0; bj < 2; ++bj) { const f32x4 v0 = acc[ai][bj][m][0], v1 = acc[ai][bj][m][1];
                    u32x4 w; w.x = cvt_pk_bf16(v0[0], v0[1]); w.y = cvt_pk_bf16(v0[2], v0[3]); w.z = cvt_pk_bf16(v1[0], v1[1]); w.w = cvt_pk_bf16(v1[2], v1[3]);
                    *(u32x4*)(rowp + bj * HALF) = w; } }
    }
};
struct EpiF32 {
    static constexpr bool PERM = false, AFTER_DRAIN = false;
    float* O; int ldc;
    __device__ __forceinline__ void operator()(const f32x4 (&acc)[2][2][4][2], const Unit& u, int wr, int wc, int fr, int fq) const {
        const int row0 = u.pm * BM + wr * 64 + fr; const int col0 = u.pn * BM + wc * 32 + 4 * fq;
#pragma unroll
        for (int ai = 0; ai < 2; ++ai)
#pragma unroll
            for (int m = 0; m < 4; ++m) { float* rowp = O + (size_t)(row0 + ai * HALF + m * 16) * ldc + col0;
#pragma unroll
                for (int bj = 0; bj < 2; ++bj)
#pragma unroll
                    for (int n = 0; n < 2; ++n) *(f32x4*)(rowp + bj * HALF + n * 16) = acc[ai][bj][m][n]; }
    }
};
__device__ __forceinline__ float silu_mul(float g, float u) {
    const float e = __builtin_amdgcn_exp2f(-g * 1.4426950408889634f);
    return g * __builtin_amdgcn_rcpf(1.0f + e) * u;
}
struct EpiSwiGLU {
    static constexpr bool PERM = true, AFTER_DRAIN = false;
    bf16_t* O; int ldc;
    __device__ __forceinline__ void operator()(const f32x4 (&acc)[2][2][4][2], const Unit& u, int wr, int wc, int fr, int fq) const {
        const int row0 = u.pm * BM + wr * 64 + fr; const int col0 = u.pn * HALF + wc * 32 + 8 * fq;
#pragma unroll
        for (int ai = 0; ai < 2; ++ai)
#pragma unroll
            for (int m = 0; m < 4; ++m) { bf16_t* rowp = O + (size_t)(row0 + ai * HALF + m * 16) * ldc + col0;
                const f32x4 g0 = acc[ai][0][m][0], g1 = acc[ai][0][m][1], u0 = acc[ai][1][m][0], u1 = acc[ai][1][m][1];
                u32x4 w; w.x = cvt_pk_bf16(silu_mul(g0[0], u0[0]), silu_mul(g0[1], u0[1])); w.y = cvt_pk_bf16(silu_mul(g0[2], u0[2]), silu_mul(g0[3], u0[3]));
                w.z = cvt_pk_bf16(silu_mul(g1[0], u1[0]), silu_mul(g1[1], u1[1])); w.w = cvt_pk_bf16(silu_mul(g1[2], u1[2]), silu_mul(g1[3], u1[3]));
                *(u32x4*)rowp = w; }
    }
};

template <class Epi, class Sched, bool ALIGN_EPI = false, bool SP2 = false>
__device__ __forceinline__ void gemm_phase(LAS unsigned char* lds, const Gemm g, const Sched& S, const Epi& E) {
    int tid_ = threadIdx.x; asm volatile("" : "+v"(tid_));
    const int tid = tid_, wid = __builtin_amdgcn_readfirstlane(tid >> 6), lane = tid & 63, wr = wid >> 2, wc = wid & 3, fr = lane & 15, fq = lane >> 4;
    int K_ = g.K; asm volatile("" : "+s"(K_));
    const int K = K_, nt = K / BK;
    unsigned voffA[2], voffB[2];
#pragma unroll
    for (int i = 0; i < 2; ++i) { int R, C; stage_rc(tid * 16 + i * 8192, R, C); const int Rb = Epi::PERM ? ((R & ~31) + perm32(R & 31)) : R;
        voffA[i] = (unsigned)(R * K + C) * 2u; voffB[i] = (unsigned)(Rb * K + C) * 2u; }
    const size_t kstep = (size_t)(BK * 2);
    const size_t hstep = (size_t)HALF * K * 2;
    const size_t tstep = 2 * hstep;
    const unsigned ldsw = (unsigned)wid * 1024u;
    const int aoff = lds_byte(wr * 64 + fr, fq * 8), boff = lds_byte(wc * 32 + fr, fq * 8);
#define PG8_SA(b, h) (((b) * 2 + (h)) * HTB)
#define PG8_SB(b, h) ((4 + (b) * 2 + (h)) * HTB)
#define PG8_STAGE(bufoff, gbase, voff) do { _Pragma("unroll") for (int _i = 0; _i < 2; ++_i) \
        __builtin_amdgcn_global_load_lds((const unsigned*)((const char*)(gbase) + (voff)[_i]), (LAS unsigned*)(lds + (bufoff) + ldsw + _i * 8192), 16, 0, 0); } while (0)
#define PG8_LDA(dst, b, h) do { _Pragma("unroll") for (int m = 0; m < 4; ++m) _Pragma("unroll") for (int k = 0; k < 2; ++k) dst[m][k] = *(const LAS bf16x8*)(lds + PG8_SA(b, h) + aoff + m * 2048 + k * 1024); } while (0)
#define PG8_LDB(dst, b, h) do { _Pragma("unroll") for (int n = 0; n < 2; ++n) _Pragma("unroll") for (int k = 0; k < 2; ++k) dst[n][k] = *(const LAS bf16x8*)(lds + PG8_SB(b, h) + boff + n * 2048 + k * 1024); } while (0)
#define PG8_MMA(ai, bj, At, Bt) do { __builtin_amdgcn_s_setprio(1); _Pragma("unroll") for (int m = 0; m < 4; ++m) _Pragma("unroll") for (int n = 0; n < 2; ++n) _Pragma("unroll") for (int k = 0; k < 2; ++k) \
        acc[ai][bj][m][n] = __builtin_amdgcn_mfma_f32_16x16x32_bf16(Bt[n][k], At[m][k], acc[ai][bj][m][n], 0, 0, 0); __builtin_amdgcn_s_setprio(0); } while (0)
#define PG8_WAIT_V(n) asm volatile("s_waitcnt vmcnt(" #n ")" ::: "memory")
#define PG8_WAIT_L(n) asm volatile("s_waitcnt lgkmcnt(" #n ")" ::: "memory")
#define PG8_BAR __builtin_amdgcn_s_barrier()
#define PG8_SCHED __builtin_amdgcn_sched_barrier(0)
    Unit cur, nxt; int ui = 0;
    if (!S.next(0, cur)) return;
    f32x4 acc[2][2][4][2];
#pragma unroll
    for (int a = 0; a < 2; ++a)
#pragma unroll
        for (int b = 0; b < 2; ++b)
#pragma unroll
            for (int m = 0; m < 4; ++m)
#pragma unroll
                for (int n = 0; n < 2; ++n) acc[a][b][m][n] = (f32x4){0.f, 0.f, 0.f, 0.f};
    bf16x8 At[4][2], B0[2][2], B1[2][2];
    const char* cA = (const char*)g.A + (size_t)cur.pm * tstep; const char* cB = (const char*)g.Bt + (size_t)cur.pn * tstep;
    S.a_ready(cur);
    if constexpr (SP2) {
        PG8_STAGE(PG8_SB(0, 0), cB, voffB); PG8_STAGE(PG8_SB(0, 1), cB + hstep, voffB); PG8_STAGE(PG8_SA(0, 0), cA, voffA); PG8_STAGE(PG8_SA(0, 1), cA + hstep, voffA);
        if (wr == 1) PG8_BAR;
        PG8_WAIT_V(2); PG8_BAR;
        PG8_STAGE(PG8_SB(1, 0), cB + kstep, voffB); PG8_STAGE(PG8_SA(1, 0), cA + kstep, voffA); PG8_STAGE(PG8_SB(1, 1), cB + hstep + kstep, voffB);
        PG8_WAIT_V(6); PG8_BAR;
    } else {
        PG8_STAGE(PG8_SB(0, 0), cB, voffB); PG8_STAGE(PG8_SA(0, 0), cA, voffA); PG8_STAGE(PG8_SB(0, 1), cB + hstep, voffB); PG8_STAGE(PG8_SA(0, 1), cA + hstep, voffA);
        if (wr == 1) PG8_BAR;
        PG8_WAIT_V(4); PG8_BAR;
        PG8_STAGE(PG8_SB(1, 0), cB + kstep, voffB); PG8_STAGE(PG8_SA(1, 0), cA + kstep, voffA); PG8_STAGE(PG8_SB(1, 1), cB + hstep + kstep, voffB);
        PG8_WAIT_V(6); PG8_BAR;
    }
    for (;;) {
        const bool has_next = S.next(ui + 1, nxt);
        const char* nA = has_next ? (const char*)g.A + (size_t)nxt.pm * tstep : cA; const char* nB = has_next ? (const char*)g.Bt + (size_t)nxt.pn * tstep : cB;
        for (int t = 0; t < nt; t += 2) {
            const bool last = (t == nt - 2);
            const char* a1 = cA + (size_t)(t + 1) * kstep;
            const char* a2 = last ? nA : cA + (size_t)(t + 2) * kstep; const char* b2 = last ? nB : cB + (size_t)(t + 2) * kstep;
            const char* a3 = a2 + kstep; const char* b3 = b2 + kstep;
            if (last && has_next) S.a_ready(nxt);
            if constexpr (SP2) {
            PG8_LDB(B0, 0, 0); PG8_LDB(B1, 0, 1); PG8_SCHED; PG8_LDA(At, 0, 0); PG8_STAGE(PG8_SA(1, 1), a1 + hstep, voffA);
            PG8_WAIT_V(8); PG8_WAIT_L(0); PG8_BAR; PG8_MMA(0, 0, At, B0); PG8_MMA(0, 1, At, B1); PG8_BAR; PG8_SCHED;
            PG8_LDA(At, 0, 1); PG8_STAGE(PG8_SB(0, 0), b2, voffB); PG8_STAGE(PG8_SB(0, 1), b2 + hstep, voffB); PG8_STAGE(PG8_SA(0, 0), a2, voffA);
            PG8_WAIT_V(8); PG8_WAIT_L(0); PG8_BAR; PG8_MMA(1, 0, At, B0); PG8_MMA(1, 1, At, B1); PG8_BAR; PG8_SCHED;
            PG8_LDB(B0, 1, 0); PG8_LDB(B1, 1, 1); PG8_SCHED; PG8_LDA(At, 1, 0); PG8_STAGE(PG8_SA(0, 1), a2 + hstep, voffA);
            PG8_WAIT_V(8); PG8_WAIT_L(0); PG8_BAR; PG8_MMA(0, 0, At, B0); PG8_MMA(0, 1, At, B1); PG8_BAR; PG8_SCHED;
            PG8_LDA(At, 1, 1); PG8_STAGE(PG8_SB(1, 0), b3, voffB); PG8_STAGE(PG8_SB(1, 1), b3 + hstep, voffB); PG8_STAGE(PG8_SA(1, 0), a3, voffA);
            PG8_WAIT_V(8); PG8_WAIT_L(0); PG8_BAR; PG8_MMA(1, 0, At, B0); PG8_MMA(1, 1, At, B1); PG8_BAR; PG8_SCHED;
            } else {
            PG8_LDB(B0, 0, 0); PG8_SCHED; PG8_LDA(At, 0, 0); PG8_STAGE(PG8_SA(1, 1), a1 + hstep, voffA);
            PG8_WAIT_L(8); PG8_BAR; PG8_WAIT_L(0); PG8_MMA(0, 0, At, B0); PG8_BAR; PG8_SCHED;
            PG8_LDB(B1, 0, 1); PG8_STAGE(PG8_SB(0, 0), b2, voffB);
            PG8_BAR; PG8_WAIT_L(0); PG8_MMA(0, 1, At, B1); PG8_BAR;
            PG8_LDA(At, 0, 1); PG8_STAGE(PG8_SA(0, 0), a2, voffA);
            PG8_BAR; PG8_WAIT_L(0); PG8_MMA(1, 0, At, B0); PG8_BAR; PG8_SCHED;
            PG8_STAGE(PG8_SB(0, 1), b2 + hstep, voffB);
            PG8_WAIT_V(6); PG8_BAR; PG8_MMA(1, 1, At, B1); PG8_BAR;
            PG8_LDB(B0, 1, 0); PG8_SCHED; PG8_LDA(At, 1, 0); PG8_STAGE(PG8_SA(0, 1), a2 + hstep, voffA);
            PG8_WAIT_L(8); PG8_BAR; PG8_WAIT_L(0); PG8_MMA(0, 0, At, B0); PG8_BAR; PG8_SCHED;
            PG8_LDB(B1, 1, 1); PG8_STAGE(PG8_SB(1, 0), b3, voffB);
            PG8_BAR; PG8_WAIT_L(0); PG8_MMA(0, 1, At, B1); PG8_BAR;
            PG8_LDA(At, 1, 1); PG8_STAGE(PG8_SA(1, 0), a3, voffA);
            PG8_BAR; PG8_WAIT_L(0); PG8_MMA(1, 0, At, B0); PG8_BAR; PG8_SCHED;
            PG8_STAGE(PG8_SB(1, 1), b3 + hstep, voffB);
            PG8_WAIT_V(6); PG8_BAR; PG8_MMA(1, 1, At, B1); PG8_BAR;
            }
        }
        if constexpr (ALIGN_EPI) { if (wr == 0) PG8_BAR; }
        if constexpr (!Epi::AFTER_DRAIN) { E(acc, cur, wr, wc, fr, fq); S.done(cur); }
        if (!has_next) break;
#pragma unroll
        for (int a = 0; a < 2; ++a)
#pragma unroll
            for (int b = 0; b < 2; ++b)
#pragma unroll
                for (int m = 0; m < 4; ++m)
#pragma unroll
                    for (int n = 0; n < 2; ++n) acc[a][b][m][n] = (f32x4){0.f, 0.f, 0.f, 0.f};
        cur = nxt; cA = nA; cB = nB; ++ui;
        if constexpr (ALIGN_EPI) { if (wr == 1) PG8_BAR; }
    }
    PG8_WAIT_V(0);
    if constexpr (!ALIGN_EPI) { if (wr == 0) PG8_BAR; }
    PG8_BAR;
#undef PG8_SA
#undef PG8_SB
#undef PG8_STAGE
#undef PG8_LDA
#undef PG8_LDB
#undef PG8_MMA
#undef PG8_WAIT_V
#undef PG8_WAIT_L
#undef PG8_BAR
#undef PG8_SCHED
}
}

namespace att {
constexpr int NW = 8, QBLK = 32, KVBLK = 64;
constexpr int SHM_V = KVBLK * 128 * 2;
#define SBAR() __builtin_amdgcn_sched_barrier(0)
__device__ __forceinline__ int crow(int r, int hi) { return (r & 3) + 8 * (r >> 2) + 4 * hi; }
__device__ __forceinline__ unsigned cvtpk(float lo, float hi) { unsigned r; asm volatile("v_cvt_pk_bf16_f32 %0, %1, %2" : "=v"(r) : "v"(lo), "v"(hi)); return r; }

constexpr float THR2 = 8.0f * 1.4426950408889634f;
template <bool FIRST>
__device__ __forceinline__ void partialSM(f32x16& p0, f32x16& p1, float& mC, float& alpha) {
  float pmax = p0[0];
#pragma unroll
  for (int r = 1; r < 16; ++r) pmax = fmaxf(pmax, p0[r]);
#pragma unroll
  for (int r = 0; r < 16; ++r) pmax = fmaxf(pmax, p1[r]);
  { auto rr = __builtin_amdgcn_permlane32_swap(__float_as_uint(pmax), __float_as_uint(pmax), false, false);
    pmax = fmaxf(__uint_as_float(rr[0]), __uint_as_float(rr[1])); }
  if (!FIRST && __builtin_expect(__all(pmax <= THR2), 1)) { alpha = 1.f; }
  else { const float delta = FIRST ? fmaxf(pmax, -200.f) : fmaxf(pmax, 0.f); alpha = FIRST ? 1.f : __builtin_amdgcn_exp2f(-delta); mC += delta;
#pragma unroll
    for (int r = 0; r < 16; ++r) p0[r] -= delta;
#pragma unroll
    for (int r = 0; r < 16; ++r) p1[r] -= delta; }
#pragma unroll
  for (int r = 0; r < 16; ++r) p0[r] = __builtin_amdgcn_exp2f(p0[r]);
}
__device__ __forceinline__ void finishSM(f32x16& p0, f32x16& p1, float alpha, float& l_reg, bf16x8& pa0, bf16x8& pa1, bf16x8& pa2, bf16x8& pa3) {
#pragma unroll
  for (int r = 0; r < 16; ++r) p1[r] = __builtin_amdgcn_exp2f(p1[r]);
  float ps = 0;
#pragma unroll
  for (int r = 0; r < 16; ++r) ps += p0[r];
#pragma unroll
  for (int r = 0; r < 16; ++r) ps += p1[r];
  { auto rr = __builtin_amdgcn_permlane32_swap(__float_as_uint(ps), __float_as_uint(ps), false, false);
    ps = __uint_as_float(rr[0]) + __uint_as_float(rr[1]); }
  l_reg = l_reg * alpha + ps;
#define PK4(P, BASE, OUT) do { unsigned a0 = cvtpk(P[BASE + 0], P[BASE + 1]), a1 = cvtpk(P[BASE + 2], P[BASE + 3]);   \
    unsigned b0 = cvtpk(P[BASE + 4], P[BASE + 5]), b1 = cvtpk(P[BASE + 6], P[BASE + 7]);                              \
    auto r0 = __builtin_amdgcn_permlane32_swap(a0, b0, false, false); auto r1 = __builtin_amdgcn_permlane32_swap(a1, b1, false, false); \
    u32x4 w = {r0[0], r1[0], r0[1], r1[1]}; OUT = *reinterpret_cast<bf16x8*>(&w); } while (0)
  PK4(p0, 0, pa0); PK4(p0, 8, pa1); PK4(p1, 0, pa2); PK4(p1, 8, pa3);
#undef PK4
}
template <int NDQ, int NQL>
__device__ __forceinline__ void qkt(f32x16& p0, f32x16& p1, const f32x16& negm, const char* Ks, const bf16x8* qr, const char* qls, int r32, int hi) {
  constexpr int ROWB = NDQ * 32, NQR = NDQ - NQL;
#pragma unroll
  for (int d0 = 0; d0 < NDQ; ++d0) { const int cb = (d0 * 16 + hi * 8) * 2;
    bf16x8 b0 = *reinterpret_cast<const bf16x8*>(Ks + r32 * ROWB + (cb ^ ((r32 & 7) << 4)));
    bf16x8 b1 = *reinterpret_cast<const bf16x8*>(Ks + (32 + r32) * ROWB + (cb ^ ((r32 & 7) << 4)));
    bf16x8 q;
    if constexpr (NQL > 0) { if (d0 < NQR) q = qr[d0 < NQR ? d0 : 0]; else q = *reinterpret_cast<const bf16x8*>(qls + (d0 - NQR) * 1024); }
    else q = qr[d0];
    if (d0 == 0) { p0 = __builtin_amdgcn_mfma_f32_32x32x16_bf16(b0, q, negm, 0, 0, 0); p1 = __builtin_amdgcn_mfma_f32_32x32x16_bf16(b1, q, negm, 0, 0, 0); }
    else { p0 = __builtin_amdgcn_mfma_f32_32x32x16_bf16(b0, q, p0, 0, 0, 0); p1 = __builtin_amdgcn_mfma_f32_32x32x16_bf16(b1, q, p1, 0, 0, 0); } }
}
__device__ __forceinline__ int v_st(int k, int c) { const int kk = (k & ~0xC) | ((k & 4) << 1) | ((k & 8) >> 1); return ((kk >> 3) * 4 + (c >> 5)) * 512 + ((kk & 7) * 32 + (c & 31)) * 2; }
__device__ __forceinline__ int v_rd_base(int lane) { return ((lane & 3) << 3) | (((lane >> 2) & 3) << 6) | (((lane >> 4) & 1) << 5) | (((lane >> 5) & 1) << 8); }
constexpr int v_rd_off(int d0, int ks, int half) { return d0 * 512 + ks * 4096 + half * 2048; }
template <int OFF> __device__ __forceinline__ s16x4 tr_read(int vb) {
  s16x4 r; asm volatile("ds_read_b64_tr_b16 %0, %1 offset:%2" : "=&v"(r) : "v"(vb), "i"(OFF) : "memory"); return r;
}
template <int D0> __device__ __forceinline__ void pv_one(f32x16& od, int vb, bf16x8 pa0, bf16x8 pa1, bf16x8 pa2, bf16x8 pa3) {
  const s16x4 l0 = tr_read<v_rd_off(D0, 0, 0)>(vb), h0 = tr_read<v_rd_off(D0, 0, 1)>(vb), l1 = tr_read<v_rd_off(D0, 1, 0)>(vb), h1 = tr_read<v_rd_off(D0, 1, 1)>(vb);
  const s16x4 l2 = tr_read<v_rd_off(D0, 2, 0)>(vb), h2 = tr_read<v_rd_off(D0, 2, 1)>(vb), l3 = tr_read<v_rd_off(D0, 3, 0)>(vb), h3 = tr_read<v_rd_off(D0, 3, 1)>(vb);
  asm volatile("s_waitcnt lgkmcnt(0)" ::: "memory"); SBAR();
#define PK(L, H) (bf16x8){L[0], L[1], L[2], L[3], H[0], H[1], H[2], H[3]}
  od = __builtin_amdgcn_mfma_f32_32x32x16_bf16(pa0, PK(l0, h0), od, 0, 0, 0);
  od = __builtin_amdgcn_mfma_f32_32x32x16_bf16(pa1, PK(l1, h1), od, 0, 0, 0);
  od = __builtin_amdgcn_mfma_f32_32x32x16_bf16(pa2, PK(l2, h2), od, 0, 0, 0);
  od = __builtin_amdgcn_mfma_f32_32x32x16_bf16(pa3, PK(l3, h3), od, 0, 0, 0);
#undef PK
}
__device__ __forceinline__ void pv_d0(f32x16* o, int vb, bf16x8 pa0, bf16x8 pa1, bf16x8 pa2, bf16x8 pa3) {
  pv_one<0>(o[0], vb, pa0, pa1, pa2, pa3); pv_one<1>(o[1], vb, pa0, pa1, pa2, pa3); pv_one<2>(o[2], vb, pa0, pa1, pa2, pa3); pv_one<3>(o[3], vb, pa0, pa1, pa2, pa3);
}

constexpr int LDS_K_OFF = 2 * SHM_V, LDS_WS_OFF = LDS_K_OFF + 2 * 12 * 2048, LDS_TBL_OFF = LDS_WS_OFF + NW * 64 * 4, LDS_Q_OFF = LDS_TBL_OFF + ((TBLN * 4 + 15) / 16) * 16;
static_assert(LDS_Q_OFF + NW * 8192 <= 163840, "attention LDS map");

template <int NDQ, int BIAS, int EPI, int SDEPTH, int NQL = 0>
__device__ __forceinline__ void attn_unit(const bf16_t* __restrict__ Qb, int ldq, const bf16_t* __restrict__ Kh, int ldk, const bf16_t* __restrict__ K2, int ldk2,
                                          const bf16_t* __restrict__ Vh, int ldv, int kbeg, int nkeys, int q0, const float* __restrict__ tblg, float cb_lo, float cb_hi,
                                          bf16_t* __restrict__ Obf, int ldo, float* __restrict__ tmp, float lam, const float* __restrict__ subln, float post, char* lds) {
  constexpr int ROWB = NDQ * 32, SHM_K = 64 * ROWB;
  int tid_ = threadIdx.x; asm volatile("" : "+v"(tid_));
  const int tid = tid_, wid = tid >> 6, lane = tid & 63, r32 = lane & 31, hi = lane >> 5;
  char* V_lds = lds; char* K_lds = lds + LDS_K_OFF;
  float* ws = (float*)(lds + LDS_WS_OFF) + wid * 64; float* li_l = ws; float* al_l = ws + 32;
  float* tbl_l = (float*)(lds + LDS_TBL_OFF);
  __syncthreads();
  if constexpr (BIAS) { for (int i = tid; i < TBLN; i += 512) tbl_l[i] = tblg[i]; }
  float mC = 0.f, l_reg = 0, nm_cur = 0.f; f32x16 o[4] = {}; f32x16 negm = {}; bf16x8 qr[NDQ - NQL];
  const bf16_t* Qw = Qb + (long)(wid * QBLK + r32) * ldq + hi * 8;
  char* qls = lds + LDS_Q_OFF + wid * 8192 + lane * 16;
#pragma unroll
  for (int d0 = 0; d0 < NDQ - NQL; ++d0) qr[d0] = *reinterpret_cast<const bf16x8*>(Qw + d0 * 16);
#pragma unroll
  for (int d0 = NDQ - NQL; d0 < NDQ; ++d0) *reinterpret_cast<bf16x8*>(qls + (d0 - (NDQ - NQL)) * 1024) = *reinterpret_cast<const bf16x8*>(Qw + d0 * 16);
  const int sr = tid >> 4, sc = (tid & 15) * 8, vst0 = v_st(sr, sc), vst1 = v_st(32 + sr, sc);
  const int sr8 = tid >> 3, sc8 = (tid & 7) * 8;
  const int vb0 = (int)(uintptr_t)V_lds + v_rd_base(lane);
  const int qlane = q0 + wid * QBLK + r32;
  struct { bf16x8 vs0, vs1, ks0, ks1, ks2; } sr_[SDEPTH];
#define KSWZ(row, colB) ((row) * ROWB + ((colB) ^ (((row) & 7) << 4)))
#define SLOAD(i, k0) do { sr_[i].vs0 = *reinterpret_cast<const bf16x8*>(&Vh[(long)((k0) + sr) * ldv + sc]); sr_[i].vs1 = *reinterpret_cast<const bf16x8*>(&Vh[(long)((k0) + 32 + sr) * ldv + sc]); \
    if constexpr (NDQ == 4) { sr_[i].ks0 = *reinterpret_cast<const bf16x8*>(&Kh[(long)((k0) + sr8) * ldk + sc8]); } \
    else { sr_[i].ks0 = *reinterpret_cast<const bf16x8*>(&Kh[(long)((k0) + sr) * ldk + sc]); sr_[i].ks1 = *reinterpret_cast<const bf16x8*>(&Kh[(long)((k0) + 32 + sr) * ldk + sc]); \
      if constexpr (NDQ == 12) { sr_[i].ks2 = *reinterpret_cast<const bf16x8*>(&K2[(long)((k0) + sr8) * ldk2 + sc8]); } } } while (0)
#define SWRITE(b, i) do { *(bf16x8*)(V_lds + (b) * SHM_V + vst0) = sr_[i].vs0; *(bf16x8*)(V_lds + (b) * SHM_V + vst1) = sr_[i].vs1; \
    if constexpr (NDQ == 4) { *(bf16x8*)(K_lds + (b) * SHM_K + KSWZ(sr8, sc8 * 2)) = sr_[i].ks0; } \
    else { *(bf16x8*)(K_lds + (b) * SHM_K + KSWZ(sr, sc * 2)) = sr_[i].ks0; *(bf16x8*)(K_lds + (b) * SHM_K + KSWZ(32 + sr, sc * 2)) = sr_[i].ks1; \
      if constexpr (NDQ == 12) { *(bf16x8*)(K_lds + (b) * SHM_K + KSWZ(sr8, 256 + sc8 * 2)) = sr_[i].ks2; } } } while (0)
#define SWAIT() do { if constexpr (SDEPTH == 2) { if constexpr (NDQ == 4) asm volatile("s_waitcnt vmcnt(3)" ::: "memory"); else if constexpr (NDQ == 8) asm volatile("s_waitcnt vmcnt(4)" ::: "memory"); else asm volatile("s_waitcnt vmcnt(5)" ::: "memory"); } \
    else asm volatile("s_waitcnt vmcnt(0)" ::: "memory"); } while (0)
#define RESC(a) do { if (__any((a) < 1.f)) { if (hi == 0) al_l[r32] = (a); asm volatile("s_waitcnt lgkmcnt(0)" ::: "memory"); \
    _Pragma("unroll") for (int d = 0; d < 4; ++d) _Pragma("unroll") for (int r = 0; r < 16; ++r) o[d][r] *= al_l[crow(r, hi)]; } } while (0)
#define BIASADD(P0, P1, kt0) do { if constexpr (BIAS) { const int dlo_ = (kt0) - q0 - 255, dhi_ = (kt0) + 63 - q0; \
    if (!(dlo_ >= 1024) && !(dhi_ <= -1024)) { const float* tb_ = tbl_l + ((kt0) - qlane + TOFF + 4 * hi); \
      _Pragma("unroll") for (int r = 0; r < 16; ++r) { P0[r] += tb_[(r & 3) + 8 * (r >> 2)]; P1[r] += tb_[32 + (r & 3) + 8 * (r >> 2)]; } } } } while (0)
#define NEGM_UPD(kt0) do { float nmj_ = -mC; if constexpr (BIAS) { const int dlo_ = (kt0) - q0 - 255, dhi_ = (kt0) + 63 - q0; if (dlo_ >= 1024) nmj_ += cb_hi; else if (dhi_ <= -1024) nmj_ += cb_lo; } \
    if (__any(nmj_ != nm_cur)) { nm_cur = nmj_; _Pragma("unroll") for (int r = 0; r < 16; ++r) negm[r] = nmj_; } } while (0)
  f32x16 pA0, pA1, pB0, pB1; float alA, alB; bf16x8 pa0, pa1, pa2, pa3; const int NT = nkeys / KVBLK;
  constexpr int SE = 0, SO = SDEPTH - 1;
  SLOAD(SE, kbeg); asm volatile("s_waitcnt vmcnt(0)" ::: "memory"); SWRITE(0, SE); __syncthreads();
  NEGM_UPD(kbeg); qkt<NDQ, NQL>(pA0, pA1, negm, K_lds, qr, qls, r32, hi); BIASADD(pA0, pA1, kbeg); partialSM<true>(pA0, pA1, mC, alA);
  SLOAD(SO, kbeg + KVBLK); if constexpr (SDEPTH == 2) { if (2 < NT) SLOAD(SE, kbeg + 2 * KVBLK); }
  SWAIT(); SWRITE(1, SO); __syncthreads();
  for (int j = 1; j + 1 < NT; j += 2) {
    NEGM_UPD(kbeg + j * KVBLK); SBAR(); qkt<NDQ, NQL>(pB0, pB1, negm, K_lds + SHM_K, qr, qls, r32, hi);
    finishSM(pA0, pA1, alA, l_reg, pa0, pa1, pa2, pa3); SBAR();
    SLOAD(SO, kbeg + (j + SDEPTH) * KVBLK); SBAR();
    pv_d0(o, vb0, pa0, pa1, pa2, pa3); BIASADD(pB0, pB1, kbeg + j * KVBLK); partialSM<false>(pB0, pB1, mC, alB);
    __syncthreads(); SWAIT(); SWRITE(0, SE);
    RESC(alB); __syncthreads();
    NEGM_UPD(kbeg + (j + 1) * KVBLK); SBAR(); qkt<NDQ, NQL>(pA0, pA1, negm, K_lds, qr, qls, r32, hi);
    finishSM(pB0, pB1, alB, l_reg, pa0, pa1, pa2, pa3); SBAR();
    if (SDEPTH == 1 || j + 3 < NT) SLOAD(SE, kbeg + (j + 1 + SDEPTH) * KVBLK); SBAR();
    pv_d0(o, vb0 + (int)SHM_V, pa0, pa1, pa2, pa3); BIASADD(pA0, pA1, kbeg + (j + 1) * KVBLK); partialSM<false>(pA0, pA1, mC, alA);
    __syncthreads(); SWAIT(); SWRITE(1, SO);
    RESC(alA); __syncthreads();
  }
  NEGM_UPD(kbeg + (NT - 1) * KVBLK); SBAR(); qkt<NDQ, NQL>(pB0, pB1, negm, K_lds + SHM_K, qr, qls, r32, hi);
  finishSM(pA0, pA1, alA, l_reg, pa0, pa1, pa2, pa3); SBAR();
  pv_d0(o, vb0, pa0, pa1, pa2, pa3); BIASADD(pB0, pB1, kbeg + (NT - 1) * KVBLK); partialSM<false>(pB0, pB1, mC, alB);
  __syncthreads(); RESC(alB);
  finishSM(pB0, pB1, alB, l_reg, pa0, pa1, pa2, pa3); SBAR();
  pv_d0(o, vb0 + (int)SHM_V, pa0, pa1, pa2, pa3);
  if (hi == 0) li_l[r32] = l_reg; asm volatile("s_waitcnt lgkmcnt(0)" ::: "memory");
  float rli[16];
#pragma unroll
  for (int r = 0; r < 16; ++r) rli[r] = __builtin_amdgcn_rcpf(li_l[crow(r, hi)]);
  if constexpr (EPI == 0) {
    bf16_t* Ow = Obf + (long)(wid * QBLK) * ldo;
#pragma unroll
    for (int r = 0; r < 16; ++r) { const int orow = crow(r, hi);
#pragma unroll
      for (int d0 = 0; d0 < 4; ++d0) Ow[(long)orow * ldo + d0 * 32 + r32] = (bf16_t)f2bf(o[d0][r] * rli[r]); }
  } else if constexpr (EPI == 1) {
    float* Tw = tmp + (wid * QBLK) * 128;
#pragma unroll
    for (int r = 0; r < 16; ++r) { const int orow = crow(r, hi);
#pragma unroll
      for (int d0 = 0; d0 < 4; ++d0) Tw[orow * 128 + d0 * 32 + r32] = o[d0][r] * rli[r]; }
  } else {
    const float* Tw = tmp + (wid * QBLK) * 128; bf16_t* Ow = Obf + (long)(wid * QBLK) * ldo;
    float sg[4];
#pragma unroll
    for (int d0 = 0; d0 < 4; ++d0) sg[d0] = subln[d0 * 32 + r32] * post;
#pragma unroll
    for (int r = 0; r < 16; ++r) { const int orow = crow(r, hi); float v[4]; float ss = 0.f;
#pragma unroll
      for (int d0 = 0; d0 < 4; ++d0) { v[d0] = Tw[orow * 128 + d0 * 32 + r32] - lam * (o[d0][r] * rli[r]); ss += v[d0] * v[d0]; }
      ss += __shfl_xor(ss, 1); ss += __shfl_xor(ss, 2); ss += __shfl_xor(ss, 4); ss += __shfl_xor(ss, 8); ss += __shfl_xor(ss, 16);
      const float rs = rsqrtf(ss * (1.0f / 128.0f) + EPS);
#pragma unroll
      for (int d0 = 0; d0 < 4; ++d0) Ow[(long)orow * ldo + d0 * 32 + r32] = (bf16_t)f2bf(v[d0] * rs * sg[d0]); }
  }
#undef KSWZ
#undef SLOAD
#undef SWRITE
#undef SWAIT
#undef RESC
#undef BIASADD
#undef NEGM_UPD
}
}

__device__ __forceinline__ void transpose_item(const float* __restrict__ W, int K, int N, bf16_t* __restrict__ WT, int k0, int n0, int drow0, float wscale, LAS float* scr, int lane) {
    float tv[32];
#pragma unroll
    for (int i = 0; i < 32; ++i) { const int kk = 2 * i + (lane >> 5); tv[i] = W[(size_t)(k0 + kk) * N + n0 + (lane & 31)]; }
#pragma unroll
    for (int i = 0; i < 32; ++i) { const int kk = 2 * i + (lane >> 5); scr[kk * 33 + (lane & 31)] = tv[i] * wscale; }
    asm volatile("s_waitcnt lgkmcnt(0)" ::: "memory");
    const int c = lane & 7;
#pragma unroll
    for (int j = 0; j < 4; ++j) { const int n = (lane >> 3) + 8 * j; const LAS float* s = scr + (8 * c) * 33 + n;
        u32x4 o; o.x = pk2(s[0 * 33], s[1 * 33]); o.y = pk2(s[2 * 33], s[3 * 33]); o.z = pk2(s[4 * 33], s[5 * 33]); o.w = pk2(s[6 * 33], s[7 * 33]);
        *(u32x4*)(WT + (size_t)(drow0 + n) * K + k0 + 8 * c) = o; }
    asm volatile("s_waitcnt lgkmcnt(0)" ::: "memory");
}
constexpr float QS_A = 0.125f * 1.4426950408889634f, QS_B = 0.07216878364870322f * 1.4426950408889634f, QS_CD = 0.08838834764831845f * 1.4426950408889634f;
template <int MODE>
__device__ __forceinline__ void transpose_matrix(const float* __restrict__ W, int K, int N, bf16_t* __restrict__ WT, LAS float* scr, int lane, int gw, int NGW) {
    const int nblk = N / 32, nitems = (K / 64) * nblk;
    for (int it = gw; it < nitems; it += NGW) { const int kb = it / nblk, nb = it % nblk, n0 = 32 * nb; int drow0 = n0;
        if (MODE == 1) { const int c = n0 < FF ? n0 : n0 - FF; drow0 = 256 * (c / 128) + (c % 128) + (n0 < FF ? 0 : 128); }
        float wscale = 1.0f;
        if (MODE == 2) { if (n0 < C_AK) wscale = QS_A; else if (n0 >= C_DQ && n0 < C_DK) wscale = QS_CD; }
        if (MODE == 3) wscale = QS_B;
        transpose_item(W, K, N, WT, 64 * kb, n0, drow0, wscale, scr, lane); }
}
__device__ __forceinline__ int t5_bucket(int d) {
    const int ret = d > 0 ? 16 : 0; const int n = d < 0 ? -d : d;
    if (n < 8) return ret + n;
    const float v = logf((float)n / 8.0f) / 4.852030263919617f * 8.0f;
    int large = 8 + (int)v; if (large > 15) large = 15;
    return ret + large;
}
__device__ __forceinline__ void norm_row(const float* __restrict__ xrow, const float* __restrict__ g, bf16_t* __restrict__ hrow, int lane) {
    f32x4 v[8]; float ss = 0.f;
#pragma unroll
    for (int j = 0; j < 8; ++j) { v[j] = ((const f32x4*)xrow)[lane + 64 * j]; ss += (v[j].x * v[j].x + v[j].y * v[j].y) + (v[j].z * v[j].z + v[j].w * v[j].w); }
    const float rs = rsqrtf(wave_sum(ss) * (1.0f / DM) + EPS);
#pragma unroll
    for (int j = 0; j < 8; ++j) { const f32x4 gg = ((const f32x4*)g)[lane + 64 * j];
        u32x2 w; w.x = pk2(v[j].x * rs * gg.x, v[j].y * rs * gg.y); w.y = pk2(v[j].z * rs * gg.z, v[j].w * rs * gg.w); ((u32x2*)hrow)[lane + 64 * j] = w; }
}
template <int NR>
__device__ __forceinline__ void norm_add_rows(const bf16_t* __restrict__ Yb, const float* xi, float* xo, const float* __restrict__ gpost,
                                              const float* __restrict__ gpre, bf16_t* __restrict__ Hb, int row0, int rstride, int lane) {
    u32x2 yb[NR][8]; f32x4 v[NR][8];
#pragma unroll
    for (int q = 0; q < NR; ++q) { const size_t ro = (size_t)(row0 + q * rstride) * DM;
#pragma unroll
        for (int j = 0; j < 8; ++j) yb[q][j] = ((const u32x2*)(Yb + ro))[lane + 64 * j];
#pragma unroll
        for (int j = 0; j < 8; ++j) v[q][j] = ((const f32x4*)(xi + ro))[lane + 64 * j]; }
    f32x4 gp[8];
#pragma unroll
    for (int j = 0; j < 8; ++j) gp[j] = ((const f32x4*)gpost)[lane + 64 * j];
#pragma unroll
    for (int q = 0; q < NR; ++q) { const size_t ro = (size_t)(row0 + q * rstride) * DM;
        f32x4 y[8]; float ss = 0.f;
#pragma unroll
        for (int j = 0; j < 8; ++j) { y[j].x = __uint_as_float(yb[q][j].x << 16); y[j].y = __uint_as_float(yb[q][j].x & 0xffff0000u); y[j].z = __uint_as_float(yb[q][j].y << 16); y[j].w = __uint_as_float(yb[q][j].y & 0xffff0000u);
            ss += (y[j].x * y[j].x + y[j].y * y[j].y) + (y[j].z * y[j].z + y[j].w * y[j].w); }
        const float rs = rsqrtf(wave_sum(ss) * (1.0f / DM) + EPS);
        float ss2 = 0.f;
#pragma unroll
        for (int j = 0; j < 8; ++j) { v[q][j] = v[q][j] + y[j] * rs * gp[j]; ((f32x4*)(xo + ro))[lane + 64 * j] = v[q][j];
            ss2 += (v[q][j].x * v[q][j].x + v[q][j].y * v[q][j].y) + (v[q][j].z * v[q][j].z + v[q][j].w * v[q][j].w); }
        if (gpre) {
            const float rs2 = rsqrtf(wave_sum(ss2) * (1.0f / DM) + EPS);
#pragma unroll
            for (int j = 0; j < 8; ++j) { const f32x4 gg = ((const f32x4*)gpre)[lane + 64 * j];
                u32x2 w; w.x = pk2(v[q][j].x * rs2 * gg.x, v[q][j].y * rs2 * gg.y); w.y = pk2(v[q][j].z * rs2 * gg.z, v[q][j].w * rs2 * gg.w); ((u32x2*)(Hb + ro))[lane + 64 * j] = w; }
        }
    }
}

__device__ __forceinline__ void head_norm_axial(const bf16_t* __restrict__ src, bf16_t* __restrict__ dst, const float* __restrict__ g, const float* __restrict__ COS, const float* __restrict__ SIN, int row, int t, float oscale) {
    float v[8];
#pragma unroll
    for (int s = 0; s < 4; ++s) { const unsigned w = *(const unsigned*)(src + 32 * s + 2 * t); v[2 * s] = bf2f((unsigned short)(w & 0xffff)); v[2 * s + 1] = bf2f((unsigned short)(w >> 16)); }
    float ss = 0.f;
#pragma unroll
    for (int i = 0; i < 8; ++i) ss += v[i] * v[i];
    ss += __shfl_xor(ss, 1); ss += __shfl_xor(ss, 2); ss += __shfl_xor(ss, 4); ss += __shfl_xor(ss, 8);
    const float rs = rsqrtf(ss * (1.0f / 128.0f) + EPS);
#pragma unroll
    for (int s = 0; s < 4; ++s) { v[2 * s] *= rs * oscale * g[32 * s + 2 * t]; v[2 * s + 1] *= rs * oscale * g[32 * s + 2 * t + 1]; }
    const int pr = row >> 6, pc = row & 63;
    float o[8];
#pragma unroll
    for (int e = 0; e < 2; ++e) { const int i = 2 * t + e;
        { const float c = COS[pr * 32 + i], s = SIN[pr * 32 + i]; const float x1 = v[e], x2 = v[2 + e]; o[e] = x1 * c - x2 * s; o[2 + e] = x2 * c + x1 * s; }
        { const float c = COS[pc * 32 + i], s = SIN[pc * 32 + i]; const float x1 = v[4 + e], x2 = v[6 + e]; o[4 + e] = x1 * c - x2 * s; o[6 + e] = x2 * c + x1 * s; } }
#pragma unroll
    for (int s = 0; s < 4; ++s) *(unsigned*)(dst + 32 * s + 2 * t) = pk2(o[2 * s], o[2 * s + 1]);
}

struct Args { const float* in[18]; float* out; unsigned char* ws; int ph_lo, ph_hi; };

__global__ void __launch_bounds__(512, 2) mega_fwd(Args args) {
    extern __shared__ __attribute__((aligned(16))) unsigned char lds[];
    const int G = gridDim.x, bid = blockIdx.x, NGW = G * 8;
    typedef const __attribute__((address_space(4))) Args* KArgP;
    LAS unsigned char* ldsl = (LAS unsigned char*)lds;
#define x_in (kap->in[0])
#define rel_bias (kap->in[1])
#define norm_mix_pre (kap->in[2])
#define norm_mix_post (kap->in[3])
#define norm_ffn_pre (kap->in[4])
#define norm_ffn_post (kap->in[5])
#define w_in (kap->in[6])
#define diff_lambda (kap->in[7])
#define diff_subln (kap->in[8])
#define mla_q_norm (kap->in[9])
#define mla_kv_norm (kap->in[10])
#define mla_w_uq (kap->in[11])
#define mla_w_ukv (kap->in[12])
#define gqa_q_norm (kap->in[13])
#define gqa_k_norm (kap->in[14])
#define w_out (kap->in[15])
#define w_gate_up (kap->in[16])
#define w_down (kap->in[17])
#define xres (kap->out)
#define ws (kap->ws)
#define PAR ((float*)(ws + WS_PAR))
#define TBLA ((float*)(ws + WS_TBLA))
#define TBLD ((float*)(ws + WS_TBLD))
#define COS ((float*)(ws + WS_COS))
#define SIN ((float*)(ws + WS_SIN))
#define H ((bf16_t*)(ws + WS_H))
#define PROJ ((bf16_t*)(ws + WS_PROJ))
#define CQN ((bf16_t*)(ws + WS_CQN))
#define CKVN ((bf16_t*)(ws + WS_CKVN))
#define KPE ((bf16_t*)(ws + WS_KPE))
#define QC ((bf16_t*)(ws + WS_QC))
#define KC ((bf16_t*)(ws + WS_KC))
#define QB ((bf16_t*)(ws + WS_QB))
#define KVB ((bf16_t*)(ws + WS_KVB))
#define MIX ((bf16_t*)(ws + WS_MIX))
#define Y ((bf16_t*)(ws + WS_Y))
#define HID ((bf16_t*)(ws + WS_HID))
#define TMP ((float*)(ws + WS_TMP))
#define wl (ws + WS_W + (size_t)l * LW)

    const int lo = args.ph_lo, hi_ph = args.ph_hi; int ph = 0;
#define PH_BEGIN if (ph >= lo && ph < hi_ph) { KArgP kap = (KArgP)__builtin_amdgcn_kernarg_segment_ptr(); asm volatile("" : "+s"(kap)); \
    int tid_ = threadIdx.x; asm volatile("" : "+v"(tid_)); const int tid = tid_, lane = tid & 63, wave = __builtin_amdgcn_readfirstlane(tid >> 6), gw = bid * 8 + wave; (void)lane; (void)gw;
#define PH_END } if (ph >= lo && ph + 1 < hi_ph) { cg::this_grid().sync(); } ++ph;

    PH_BEGIN
    if PHON(0) {
        LAS float* scr = (LAS float*)(ldsl + wave * 16384);
        for (int l = 0; l < DEPTH; ++l) {
            transpose_matrix<2>(w_in + (size_t)l * DM * NPROJ, DM, NPROJ, (bf16_t*)(wl + W_IN), scr, lane, gw, NGW);
            transpose_matrix<3>(mla_w_uq + (size_t)l * 512 * 768, 512, 768, (bf16_t*)(wl + W_UQ), scr, lane, gw, NGW);
            transpose_matrix<0>(mla_w_ukv + (size_t)l * 256 * 1024, 256, 1024, (bf16_t*)(wl + W_UKV), scr, lane, gw, NGW);
            transpose_matrix<0>(w_out + (size_t)l * DM * DM, DM, DM, (bf16_t*)(wl + W_OUT), scr, lane, gw, NGW);
            transpose_matrix<1>(w_gate_up + (size_t)l * DM * NGU, DM, NGU, (bf16_t*)(wl + W_GU), scr, lane, gw, NGW);
            transpose_matrix<0>(w_down + (size_t)l * FF * DM, FF, DM, (bf16_t*)(wl + W_D), scr, lane, gw, NGW);
            { u32x4* z = (u32x4*)((bf16_t*)(wl + W_IN) + (size_t)NPROJ * DM); const int n16 = (LDP - NPROJ) * DM * 2 / 16;
              for (int i = bid * 512 + tid; i < n16; i += G * 512) z[i] = (u32x4){0u, 0u, 0u, 0u}; }
        }
        const int gt = bid * 512 + tid, NT_ = G * 512;
        for (int i = gt; i < 4 * TBLN; i += NT_) { const int h = i / TBLN, d = (i % TBLN) - TOFF; const int b = t5_bucket(d);
            TBLA[i] = rel_bias[b * 8 + h] * 1.4426950408889634f;
            const int n = d < 0 ? -d : d; int mult = (n <= 64 ? 1 : 0) + (((n & 3) == 0 && n <= 256) ? 1 : 0) + (((n & 15) == 0 && n <= 1024) ? 1 : 0);
            TBLD[i] = mult ? (rel_bias[b * 8 + 4 + h] + logf((float)mult)) * 1.4426950408889634f : -1e30f; }
        for (int i = gt; i < S * 32; i += NT_) { const int pos = i >> 5, f = i & 31;
            const float inv = (float)pow(10000.0, -(double)(2 * f) / 64.0); const float ang = (float)pos * inv;
            COS[i] = (float)cos((double)ang); SIN[i] = (float)sin((double)ang); }
        if (bid == 0 && tid < DEPTH) { const float* lv = diff_lambda + tid * 256; float s1 = 0.f, s2 = 0.f;
            for (int i = 0; i < 64; ++i) { s1 += lv[i] * lv[64 + i]; s2 += lv[128 + i] * lv[192 + i]; }
            const float lam_init = 0.8f - 0.6f * expf(-0.3f * (float)tid);
            PAR[tid] = expf(s1) - expf(s2) + lam_init; PAR[4 + tid] = lam_init; }
        for (int row = gw; row < S; row += NGW) norm_row(x_in + (size_t)row * DM, norm_mix_pre, H + (size_t)row * DM, lane);
    }
    PH_END

    for (int l = 0; l < DEPTH; ++l) {
        PH_BEGIN
        if PHON(1) for (int rep_ = 0; rep_ < MK_DUP_GEMM; ++rep_) { pg8::Gemm g{H, (const bf16_t*)(wl + W_IN), S, LDP, DM}; pg8::StaticOrder So; So.init(S, LDP, G, bid);
          pg8::EpiBf16 E{PROJ, LDP};
          pg8::gemm_phase<pg8::EpiBf16, pg8::StaticOrder, true, true>(ldsl, g, So, E); }
        PH_END
        PH_BEGIN
        if PHON(2) for (int row = gw; row < S; row += NGW) {
            const bf16_t* pr = PROJ + (size_t)row * LDP;
            { const u32x4 raw = *(const u32x4*)(pr + C_BCQ + lane * 8); float v[8];
              v[0] = __uint_as_float(raw.x << 16); v[1] = __uint_as_float(raw.x & 0xffff0000u); v[2] = __uint_as_float(raw.y << 16); v[3] = __uint_as_float(raw.y & 0xffff0000u);
              v[4] = __uint_as_float(raw.z << 16); v[5] = __uint_as_float(raw.z & 0xffff0000u); v[6] = __uint_as_float(raw.w << 16); v[7] = __uint_as_float(raw.w & 0xffff0000u);
              float ss = 0.f;
#pragma unroll
              for (int i = 0; i < 8; ++i) ss += v[i] * v[i];
              const float rs = rsqrtf(wave_sum(ss) * (1.0f / 512.0f) + EPS);
              const f32x4 g0 = *(const f32x4*)(mla_q_norm + l * 512 + lane * 8), g1 = *(const f32x4*)(mla_q_norm + l * 512 + lane * 8 + 4);
              u32x4 w; w.x = pk2(v[0] * rs * g0.x, v[1] * rs * g0.y); w.y = pk2(v[2] * rs * g0.z, v[3] * rs * g0.w); w.z = pk2(v[4] * rs * g1.x, v[5] * rs * g1.y); w.w = pk2(v[6] * rs * g1.z, v[7] * rs * g1.w);
              *(u32x4*)(CQN + (size_t)row * 512 + lane * 8) = w; }
            { const u32x2 raw = *(const u32x2*)(pr + C_BCKV + lane * 4); float v[4];
              v[0] = __uint_as_float(raw.x << 16); v[1] = __uint_as_float(raw.x & 0xffff0000u); v[2] = __uint_as_float(raw.y << 16); v[3] = __uint_as_float(raw.y & 0xffff0000u);
              float ss = v[0] * v[0] + v[1] * v[1] + v[2] * v[2] + v[3] * v[3];
              const float rs = rsqrtf(wave_sum(ss) * (1.0f / 256.0f) + EPS);
              const f32x4 g0 = *(const f32x4*)(mla_kv_norm + l * 256 + lane * 4);
              u32x2 w; w.x = pk2(v[0] * rs * g0.x, v[1] * rs * g0.y); w.y = pk2(v[2] * rs * g0.z, v[3] * rs * g0.w);
              *(u32x2*)(CKVN + (size_t)row * 256 + lane * 4) = w; }
            if (lane < 32) { const float x1 = bf2f(pr[C_BKPE + lane]), x2 = bf2f(pr[C_BKPE + 32 + lane]); const float c = COS[row * 32 + lane], s = SIN[row * 32 + lane];
              KPE[(size_t)row * 64 + lane] = (bf16_t)f2bf(x1 * c - x2 * s); KPE[(size_t)row * 64 + 32 + lane] = (bf16_t)f2bf(x2 * c + x1 * s); }
            { const int hd = lane >> 4, t = lane & 15;
              head_norm_axial(pr + C_CQ + hd * 128, QC + (size_t)row * 512 + hd * 128, gqa_q_norm + l * 128, COS, SIN, row, t, QS_CD);
              const int hk = hd & 1;
              if (lane < 32) head_norm_axial(pr + C_CK + hk * 128, KC + (size_t)row * 256 + hk * 128, gqa_k_norm + l * 128, COS, SIN, row, t, 1.0f); }
        }
        PH_END
        PH_BEGIN
        if PHON(3) { pg8::Gemm g{CQN, (const bf16_t*)(wl + W_UQ), S, 768, 512}; pg8::StaticOrder So; So.init(S, 768, G, bid);
          pg8::EpiBf16 E{QB, 768};
          pg8::gemm_phase<pg8::EpiBf16, pg8::StaticOrder, true, true>(ldsl, g, So, E); }
        if PHON(4) { pg8::Gemm g{CKVN, (const bf16_t*)(wl + W_UKV), S, 1024, 256}; pg8::StaticOrder So; So.init(S, 1024, G, bid);
          pg8::EpiBf16 E{KVB, 1024};
          pg8::gemm_phase<pg8::EpiBf16, pg8::StaticOrder, true, true>(ldsl, g, So, E); }
        PH_END
        PH_BEGIN
        if PHON(5) for (int row = gw; row < S; row += NGW) {
#pragma unroll
            for (int e = 0; e < 2; ++e) { const int p = lane + 64 * e, hd = p >> 5, i = p & 31; bf16_t* q = QB + (size_t)row * 768 + hd * 192 + 128 + i;
                const float x1 = bf2f(q[0]), x2 = bf2f(q[32]); const float c = COS[row * 32 + i], s = SIN[row * 32 + i];
                q[0] = (bf16_t)f2bf(x1 * c - x2 * s); q[32] = (bf16_t)f2bf(x2 * c + x1 * s); }
        }
        PH_END
        PH_BEGIN
        for (int rep_ = 0; rep_ < MK_DUP_ATT; ++rep_) {
            const float lam = PAR[l], lam_init = PAR[4 + l];
            const float L2E = 1.4426950408889634f;
            if PHON(6) for (int u = bid; u < 256; u += G) { const int xq = u & 7, hd = xq & 3, qb = (u >> 3) + 32 * (xq >> 2), q0 = qb * 256;
                { const float sc = 0.125f; float* tmpu = TMP + (size_t)u * 256 * 128;
                  const float cb_lo = rel_bias[15 * 8 + hd] * L2E, cb_hi = rel_bias[31 * 8 + hd] * L2E;
                  att::attn_unit<4, 1, 1, 1>(PROJ + (size_t)q0 * LDP + C_AQ + hd * 128, LDP, PROJ + C_AK + hd * 128, LDP, nullptr, 0, PROJ + C_AV + hd * 128, LDP,
                                           0, S, q0, TBLA + hd * TBLN, cb_lo, cb_hi, nullptr, 0, tmpu, 0.f, nullptr, 0.f, (char*)lds);
                  att::attn_unit<4, 1, 2, 1>(PROJ + (size_t)q0 * LDP + C_AQ + hd * 128 + 64, LDP, PROJ + C_AK + hd * 128 + 64, LDP, nullptr, 0, PROJ + C_AV + hd * 128, LDP,
                                           0, S, q0, TBLA + hd * TBLN, cb_lo, cb_hi, MIX + (size_t)q0 * DM + hd * 128, DM, tmpu, lam, diff_subln + l * 128, 1.0f - lam_init, (char*)lds); }
            }
            if PHON(7) for (int u = bid; u < 256; u += G) { const int xq = u & 7, hd = xq & 3, qb = (u >> 3) + 32 * (xq >> 2), q0 = qb * 256;
                { const float sc = 0.07216878364870322f;
                  att::attn_unit<12, 0, 0, 1, 8>(QB + (size_t)q0 * 768 + hd * 192, 768, KVB + hd * 256, 1024, KPE, 64, KVB + hd * 256 + 128, 1024,
                                            0, S, q0, nullptr, 0.f, 0.f, MIX + (size_t)q0 * DM + 512 + hd * 128, DM, nullptr, 0.f, nullptr, 0.f, (char*)lds); }
            }
            if PHON(8) for (int u = bid; u < 256; u += G) { const int xq = u & 7, hd = xq & 3, qb = (u >> 3) + 32 * (xq >> 2), q0 = qb * 256;
                { const float sc = 0.08838834764831845f;
                  att::attn_unit<8, 0, 0, 1>(QC + (size_t)q0 * 512 + hd * 128, 512, KC + (hd >> 1) * 128, 256, nullptr, 0, PROJ + C_CV + (hd >> 1) * 128, LDP,
                                           0, S, q0, nullptr, 0.f, 0.f, MIX + (size_t)q0 * DM + 1024 + hd * 128, DM, nullptr, 0.f, nullptr, 0.f, (char*)lds); }
            }
            if PHON(9) for (int u = bid; u < 256; u += G) { const int xq = u & 7, hd = xq & 3, qb = (u >> 3) + 32 * (xq >> 2), q0 = qb * 256;
                { const float sc = 0.08838834764831845f;
                  const int kb = q0 - 1024 < 0 ? 0 : q0 - 1024, ke = q0 + 256 + 1024 > S ? S : q0 + 256 + 1024;
                  att::attn_unit<8, 1, 0, 1>(PROJ + (size_t)q0 * LDP + C_DQ + hd * 128, LDP, PROJ + C_DK + hd * 128, LDP, nullptr, 0, PROJ + C_DV + hd * 128, LDP,
                                           kb, ke - kb, q0, TBLD + hd * TBLN, 0.f, 0.f, MIX + (size_t)q0 * DM + 1536 + hd * 128, DM, nullptr, 0.f, nullptr, 0.f, (char*)lds); }
            }
            __syncthreads();
        }
        PH_END
        PH_BEGIN
        if PHON(10) for (int rep_ = 0; rep_ < MK_DUP_GEMM; ++rep_) { pg8::Gemm g{MIX, (const bf16_t*)(wl + W_OUT), S, DM, DM}; pg8::StaticOrder So; So.init(S, DM, G, bid);
          pg8::EpiBf16 E{Y, DM};
          pg8::gemm_phase<pg8::EpiBf16, pg8::StaticOrder, true, true>(ldsl, g, So, E); }
        PH_END
        PH_BEGIN
        if PHON(11) { int row = gw;
            for (; row + NGW < S; row += 2 * NGW) norm_add_rows<2>(Y, (l == 0 ? x_in : xres), xres, norm_mix_post + l * DM, norm_ffn_pre + l * DM, H, row, NGW, lane);
            for (; row < S; row += NGW) norm_add_rows<1>(Y, (l == 0 ? x_in : xres), xres, norm_mix_post + l * DM, norm_ffn_pre + l * DM, H, row, NGW, lane); }
        PH_END
        PH_BEGIN
        if PHON(12) for (int rep_ = 0; rep_ < MK_DUP_GEMM; ++rep_) { pg8::Gemm g{H, (const bf16_t*)(wl + W_GU), S, NGU, DM}; pg8::StaticOrder So; So.init(S, NGU, G, bid);
          pg8::EpiSwiGLU E{HID, FF};
          pg8::gemm_phase<pg8::EpiSwiGLU, pg8::StaticOrder, true, true>(ldsl, g, So, E); }
        PH_END
        PH_BEGIN
        if PHON(13) for (int rep_ = 0; rep_ < MK_DUP_GEMM; ++rep_) { pg8::Gemm g{HID, (const bf16_t*)(wl + W_D), S, DM, FF}; pg8::StaticOrder So; So.init(S, DM, G, bid);
          pg8::EpiBf16 E{Y, DM};
          pg8::gemm_phase<pg8::EpiBf16, pg8::StaticOrder, true, true>(ldsl, g, So, E); }
        PH_END
        PH_BEGIN
        if PHON(14) { int row = gw; const float* gnext = (l + 1 < DEPTH) ? norm_mix_pre + (l + 1) * DM : nullptr;
            for (; row + NGW < S; row += 2 * NGW) norm_add_rows<2>(Y, xres, xres, norm_ffn_post + l * DM, gnext, H, row, NGW, lane);
            for (; row < S; row += NGW) norm_add_rows<1>(Y, xres, xres, norm_ffn_post + l * DM, gnext, H, row, NGW, lane); }
        PH_END
    }
#undef PH_BEGIN
#undef PH_END
}
#undef x_in
#undef rel_bias
#undef norm_mix_pre
#undef norm_mix_post
#undef norm_ffn_pre
#undef norm_ffn_post
#undef w_in
#undef diff_lambda
#undef diff_subln
#undef mla_q_norm
#undef mla_kv_norm
#undef mla_w_uq
#undef mla_w_ukv
#undef gqa_q_norm
#undef gqa_k_norm
#undef w_out
#undef w_gate_up
#undef w_down
#undef xres
#undef ws
#undef PAR
#undef TBLA
#undef TBLD
#undef COS
#undef SIN
#undef H
#undef PROJ
#undef CQN
#undef CKVN
#undef KPE
#undef QC
#undef KC
#undef QB
#undef KVB
#undef MIX
#undef Y
#undef HID
#undef TMP
#undef wl

constexpr int N_PHASES = 1 + DEPTH * 10;

extern "C" void kernel_launch(void* const* d_in, const int* in_sizes, int n_in, void* d_out, int out_size, void* d_ws, size_t ws_size, hipStream_t stream) {
    static int grid = 0;
    if (grid == 0) {
        if (n_in != 18 || in_sizes[0] != S * DM || out_size != S * DM || ws_size < WS_END) {
            fprintf(stderr, "kernel_launch: unexpected shapes (n_in %d, in0 %d, out %d, ws %zu < %zu)\n", n_in, n_in > 0 ? in_sizes[0] : -1, out_size, ws_size, (size_t)WS_END); grid = -1; return; }
        int dev = 0, cus = 0, per_cu = 0;
        if (hipGetDevice(&dev) != hipSuccess || hipDeviceGetAttribute(&cus, hipDeviceAttributeMultiprocessorCount, dev) != hipSuccess) { grid = -1; return; }
        if (hipFuncSetAttribute((const void*)mega_fwd, hipFuncAttributeMaxDynamicSharedMemorySize, LDS_BYTES) != hipSuccess) { fprintf(stderr, "kernel_launch: hipFuncSetAttribute failed\n"); grid = -1; return; }
        if (hipOccupancyMaxActiveBlocksPerMultiprocessor(&per_cu, (const void*)mega_fwd, 512, LDS_BYTES) != hipSuccess || per_cu < 1) { fprintf(stderr, "kernel_launch: occupancy query says %d\n", per_cu); per_cu = 1; }
        (void)hipGetLastError();
        grid = cus;
    }
    if (grid < 0) return;
    Args a{};
    for (int i = 0; i < 18; ++i) a.in[i] = (const float*)d_in[i];
    a.out = (float*)d_out; a.ws = (unsigned char*)d_ws;
#if MK_MULTI
    for (int p = 0; p < N_PHASES; ++p) { a.ph_lo = p; a.ph_hi = p + 1; hipLaunchKernelGGL(mega_fwd, dim3(grid), dim3(512), LDS_BYTES, stream, a); }
#else
    a.ph_lo = 0; a.ph_hi = N_PHASES;
    void* kargs[] = {&a};
    hipError_t e = hipLaunchCooperativeKernel((const void*)mega_fwd, dim3(grid), dim3(512), kargs, LDS_BYTES, stream);
    if (e != hipSuccess) fprintf(stderr, "kernel_launch: cooperative launch failed: %s (grid %d)\n", hipGetErrorString(e), grid);
#endif
}
```

```cpp
#include <hip/hip_runtime.h>
#include <hip/hip_cooperative_groups.h>
#include <cstdio>
#include <cstdint>
namespace cg = cooperative_groups;

#ifndef MK_MULTI
#define MK_MULTI 0
#endif
#ifndef MK_PHMASK
#define MK_PHMASK 0xFFFFF
#endif
#define PHON(k) constexpr (((MK_PHMASK) >> (k)) & 1)
#ifndef MK_DUP_GEMM
#define MK_DUP_GEMM 1
#endif
#ifndef MK_DUP_ATT
#define MK_DUP_ATT 1
#endif

typedef unsigned short bf16_t;
typedef short bf16x8 __attribute__((ext_vector_type(8)));
typedef short s16x4 __attribute__((ext_vector_type(4)));
typedef float f32x2 __attribute__((ext_vector_type(2)));
typedef float f32x4 __attribute__((ext_vector_type(4)));
typedef float f32x16 __attribute__((ext_vector_type(16)));
typedef unsigned u32x2 __attribute__((ext_vector_type(2)));
typedef unsigned u32x4 __attribute__((ext_vector_type(4)));
#define LAS __attribute__((address_space(3)))

constexpr int S = 16384, DM = 2048, DEPTH = 4, NPROJ = 4928, LDP = 5120, FF = 5632, NGU = 2 * FF;
constexpr float EPS = 1e-6f;
constexpr int C_AQ = 0, C_AK = 512, C_AV = 1024, C_BCQ = 1536, C_BCKV = 2048, C_BKPE = 2304, C_CQ = 2368, C_CK = 2880, C_CV = 3136, C_DQ = 3392, C_DK = 3904, C_DV = 4416;
constexpr int TOFF = 1408, TBLN = 2824;

constexpr size_t MiB = 1u << 20;
constexpr size_t WS_PAR = 0, WS_TBLA = 1 * MiB, WS_TBLD = 1 * MiB + 65536, WS_COS = 2 * MiB, WS_SIN = 4 * MiB;
constexpr size_t WS_W = 8 * MiB, LW = 96 * MiB;
constexpr size_t W_IN = 0, W_UQ = 20 * MiB, W_UKV = 21 * MiB, W_OUT = 22 * MiB, W_GU = 30 * MiB, W_D = 74 * MiB;
constexpr size_t WS_H = 392 * MiB, WS_PROJ = 456 * MiB, WS_CQN = 616 * MiB, WS_CKVN = 632 * MiB, WS_KPE = 640 * MiB, WS_QC = 642 * MiB, WS_KC = 658 * MiB;
constexpr size_t WS_QB = 666 * MiB, WS_KVB = 690 * MiB, WS_MIX = 722 * MiB, WS_Y = 786 * MiB, WS_HID = 914 * MiB, WS_TMP = 1090 * MiB, WS_END = 1122 * MiB;

constexpr int LDS_BYTES = 163840;

__device__ __forceinline__ float bf2f(unsigned short b) { return __uint_as_float(((unsigned)b) << 16); }
__device__ __forceinline__ unsigned f2bf(float f) { unsigned u = __float_as_uint(f); return (u + 0x7fffu + ((u >> 16) & 1u)) >> 16; }
__device__ __forceinline__ unsigned pk2(float lo, float hi) { return f2bf(lo) | (f2bf(hi) << 16); }
__device__ __forceinline__ unsigned cvt_pk_bf16(float lo, float hi) { unsigned r; asm volatile("v_cvt_pk_bf16_f32 %0, %1, %2" : "=v"(r) : "v"(lo), "v"(hi)); return r; }
__device__ __forceinline__ int lane_id_v() { int l; asm volatile("v_mbcnt_lo_u32_b32 %0, -1, 0\n\tv_mbcnt_hi_u32_b32 %0, -1, %0" : "=v"(l)); return l; }
template <int M> __device__ __forceinline__ float swz_xor(float v) { return __int_as_float(__builtin_amdgcn_ds_swizzle(__float_as_int(v), (M << 10) | 0x1f)); }
__device__ __forceinline__ float wave_sum(float v) {
    v += swz_xor<1>(v); v += swz_xor<2>(v); v += swz_xor<4>(v); v += swz_xor<8>(v); v += swz_xor<16>(v);
    auto rr = __builtin_amdgcn_permlane32_swap(__float_as_uint(v), __float_as_uint(v), false, false);
    return __uint_as_float(rr[0]) + __uint_as_float(rr[1]);
}

namespace pg8 {
constexpr int BM = 256, BK = 64, HALF = 128, HTB = HALF * BK * 2, STAGE_BYTES = 8 * HTB, NXCD = 8, WGM = 8;
__host__ __device__ __forceinline__ int lds_byte(int r, int c) { const int st = (r >> 4) * 2 + (c >> 5), rr = r & 15, cc = c & 31, ob = rr * 64 + cc * 2; return st * 1024 + (ob ^ (((ob >> 9) & 1) << 5)); }
__host__ __device__ __forceinline__ void stage_rc(int b, int& R, int& C) { const int st = b / 1024, sb = b % 1024, swz = sb ^ (((sb >> 9) & 1) << 5); R = (st >> 1) * 16 + swz / 64; C = (st & 1) * 32 + (swz % 64) / 2; }
__host__ __device__ __forceinline__ int perm32(int rho) { const int n = rho >> 4, i = rho & 15; return 8 * (i >> 2) + 4 * n + (i & 3); }

struct Unit { int pm, pn; };
struct Gemm { const bf16_t* A; const bf16_t* Bt; int M, N, K; };

struct StaticOrder {
    int nM, nN, nwg, G, c;
    __host__ __device__ void init(int M, int N, int G_, int c_) { nM = M / BM; nN = N / BM; nwg = nM * nN; G = G_; c = c_; }
    __host__ __device__ bool next(int i, Unit& u) const {
        const long L = (long)i * G + c; if (L >= nwg) return false;
        int wgid = (int)L; { const int q = nwg / NXCD, r = nwg % NXCD, xcd = wgid % NXCD, off = wgid / NXCD; wgid = (xcd < r ? xcd * (q + 1) : r * (q + 1) + (xcd - r) * q) + off; }
        const int nig = WGM * nN, gid = wgid / nig, fm = gid * WGM, gsz = (nM - fm) < WGM ? (nM - fm) : WGM;
        u.pm = fm + ((wgid % nig) % gsz); u.pn = (wgid % nig) / gsz; return true;
    }
    __device__ __forceinline__ void a_ready(const Unit&) const {}
    __device__ __forceinline__ void done(const Unit&) const {}
};

struct EpiBf16 {
    static constexpr bool PERM = true, AFTER_DRAIN = false;
    bf16_t* O; int ldc;
    __device__ __forceinline__ void operator()(const f32x4 (&acc)[2][2][4][2], const Unit& u, int wr, int wc, int fr, int fq) const {
        const int row0 = u.pm * BM + wr * 64 + fr; const int col0 = u.pn * BM + wc * 32 + 8 * fq;
#pragma unroll
        for (int ai = 0; ai < 2; ++ai)
#pragma unroll
            for (int m = 0; m < 4; ++m) { bf16_t* rowp = O + (size_t)(row0 + ai * HALF + m * 16) * ldc + col0;
#pragma unroll
                for (int bj = 0; bj < 2; ++bj) { const f32x4 v0 = acc[ai][bj][m][0], v1 = acc[ai][bj][m][1];
                    u32x4 w; w.x = cvt_pk_bf16(v0[0], v0[1]); w.y = cvt_pk_bf16(v0[2], v0[3]); w.z = cvt_pk_bf16(v1[0], v1[1]); w.w = cvt_pk_bf16(v1[2], v1[3]);
                    *(u32x4*)(rowp + bj * HALF) = w; } }
    }
};
struct EpiF32 {
    static constexpr bool PERM = false, AFTER_DRAIN = false;
    float* O; int ldc;
    __device__ __forceinline__ void operator()(const f32x4 (&acc)[2][2][4][2], const Unit& u, int wr, int wc, int fr, int fq) const {
        const int row0 = u.pm * BM + wr * 64 + fr; const int col0 = u.pn * BM + wc * 32 + 4 * fq;
#pragma unroll
        for (int ai = 0; ai < 2; ++ai)
#pragma unroll
            for (int m = 0; m < 4; ++m) { float* rowp = O + (size_t)(row0 + ai * HALF + m * 16) * ldc + col0;
#pragma unroll
                for (int bj = 0; bj < 2; ++bj)
#pragma unroll
                    for (int n = 0; n < 2; ++n) *(f32x4*)(rowp + bj * HALF + n * 16) = acc[ai][bj][m][n]; }
    }
};
__device__ __forceinline__ float silu_mul(float g, float u) {
    const float e = __builtin_amdgcn_exp2f(-g * 1.4426950408889634f);
    return g * __builtin_amdgcn_rcpf(1.0f + e) * u;
}
struct EpiSwiGLU {
    static constexpr bool PERM = true, AFTER_DRAIN = false;
    bf16_t* O; int ldc;
    __device__ __forceinline__ void operator()(const f32x4 (&acc)[2][2][4][2], const Unit& u, int wr, int wc, int fr, int fq) const {
        const int row0 = u.pm * BM + wr * 64 + fr; const int col0 = u.pn * HALF + wc * 32 + 8 * fq;
#pragma unroll
        for (int ai = 0; ai < 2; ++ai)
#pragma unroll
            for (int m = 0; m < 4; ++m) { bf16_t* rowp = O + (size_t)(row0 + ai * HALF + m * 16) * ldc + col0;
                const f32x4 g0 = acc[ai][0][m][0], g1 = acc[ai][0][m][1], u0 = acc[ai][1][m][0], u1 = acc[ai][1][m][1];
                u32x4 w; w.x = cvt_pk_bf16(silu_mul(g0[0], u0[0]), silu_mul(g0[1], u0[1])); w.y = cvt_pk_bf16(silu_mul(g0[2], u0[2]), silu_mul(g0[3], u0[3]));
                w.z = cvt_pk_bf16(silu_mul(g1[0], u1[0]), silu_mul(g1[1], u1[1])); w.w = cvt_pk_bf16(silu_mul(g1[2], u1[2]), silu_mul(g1[3], u1[3]));
                *(u32x4*)rowp = w; }
    }
};

template <class Epi, class Sched, bool ALIGN_EPI = false, bool SP2 = false>
__device__ __forceinline__ void gemm_phase(LAS unsigned char* lds, const Gemm g, const Sched& S, const Epi& E, const int wave0) {
    int tid_ = wave0 * 64 + lane_id_v();
    const int tid = tid_, wid = __builtin_amdgcn_readfirstlane(tid >> 6), lane = tid & 63, wr = wid >> 2, wc = wid & 3, fr = lane & 15, fq = lane >> 4;
    int K_ = g.K; asm volatile("" : "+s"(K_));
    const int K = K_, nt = K / BK;
    unsigned voffA[2], voffB[2];
#pragma unroll
    for (int i = 0; i < 2; ++i) { int R, C; stage_rc(tid * 16 + i * 8192, R, C); const int Rb = Epi::PERM ? ((R & ~31) + perm32(R & 31)) : R;
        voffA[i] = (unsigned)(R * K + C) * 2u; voffB[i] = (unsigned)(Rb * K + C) * 2u; }
    const size_t kstep = (size_t)(BK * 2);
    const size_t hstep = (size_t)HALF * K * 2;
    const size_t tstep = 2 * hstep;
    const unsigned ldsw = (unsigned)wid * 1024u;
    const int aoff = lds_byte(wr * 64 + fr, fq * 8), boff = lds_byte(wc * 32 + fr, fq * 8);
#define PG8_SA(b, h) (((b) * 2 + (h)) * HTB)
#define PG8_SB(b, h) ((4 + (b) * 2 + (h)) * HTB)
#define PG8_STAGE(bufoff, gbase, voff) do { _Pragma("unroll") for (int _i = 0; _i < 2; ++_i) \
        __builtin_amdgcn_global_load_lds((const unsigned*)((const char*)(gbase) + (voff)[_i]), (LAS unsigned*)(lds + (bufoff) + ldsw + _i * 8192), 16, 0, 0); } while (0)
#define PG8_LDA(dst, b, h) do { _Pragma("unroll") for (int m = 0; m < 4; ++m) _Pragma("unroll") for (int k = 0; k < 2; ++k) dst[m][k] = *(const LAS bf16x8*)(lds + PG8_SA(b, h) + aoff + m * 2048 + k * 1024); } while (0)
#define PG8_LDB(dst, b, h) do { _Pragma("unroll") for (int n = 0; n < 2; ++n) _Pragma("unroll") for (int k = 0; k < 2; ++k) dst[n][k] = *(const LAS bf16x8*)(lds + PG8_SB(b, h) + boff + n * 2048 + k * 1024); } while (0)
#define PG8_MMA(ai, bj, At, Bt) do { __builtin_amdgcn_s_setprio(1); _Pragma("unroll") for (int m = 0; m < 4; ++m) _Pragma("unroll") for (int n = 0; n < 2; ++n) _Pragma("unroll") for (int k = 0; k < 2; ++k) \
        acc[ai][bj][m][n] = __builtin_amdgcn_mfma_f32_16x16x32_bf16(Bt[n][k], At[m][k], acc[ai][bj][m][n], 0, 0, 0); __builtin_amdgcn_s_setprio(0); } while (0)
#define PG8_WAIT_V(n) asm volatile("s_waitcnt vmcnt(" #n ")" ::: "memory")
#define PG8_WAIT_L(n) asm volatile("s_waitcnt lgkmcnt(" #n ")" ::: "memory")
#define PG8_BAR __builtin_amdgcn_s_barrier()
#define PG8_SCHED __builtin_amdgcn_sched_barrier(0)
    Unit cur, nxt; int ui = 0;
    if (!S.next(0, cur)) return;
    f32x4 acc[2][2][4][2];
#pragma unroll
    for (int a = 0; a < 2; ++a)
#pragma unroll
        for (int b = 0; b < 2; ++b)
#pragma unroll
            for (int m = 0; m < 4; ++m)
#pragma unroll
                for (int n = 0; n < 2; ++n) acc[a][b][m][n] = (f32x4){0.f, 0.f, 0.f, 0.f};
    bf16x8 At[4][2], B0[2][2], B1[2][2];
    const char* cA = (const char*)g.A + (size_t)cur.pm * tstep; const char* cB = (const char*)g.Bt + (size_t)cur.pn * tstep;
    S.a_ready(cur);
    if constexpr (SP2) {
        PG8_STAGE(PG8_SB(0, 0), cB, voffB); PG8_STAGE(PG8_SB(0, 1), cB + hstep, voffB); PG8_STAGE(PG8_SA(0, 0), cA, voffA); PG8_STAGE(PG8_SA(0, 1), cA + hstep, voffA);
        if (wr == 1) PG8_BAR;
        PG8_WAIT_V(2); PG8_BAR;
        PG8_STAGE(PG8_SB(1, 0), cB + kstep, voffB); PG8_STAGE(PG8_SA(1, 0), cA + kstep, voffA); PG8_STAGE(PG8_SB(1, 1), cB + hstep + kstep, voffB);
        PG8_WAIT_V(6); PG8_BAR;
    } else {
        PG8_STAGE(PG8_SB(0, 0), cB, voffB); PG8_STAGE(PG8_SA(0, 0), cA, voffA); PG8_STAGE(PG8_SB(0, 1), cB + hstep, voffB); PG8_STAGE(PG8_SA(0, 1), cA + hstep, voffA);
        if (wr == 1) PG8_BAR;
        PG8_WAIT_V(4); PG8_BAR;
        PG8_STAGE(PG8_SB(1, 0), cB + kstep, voffB); PG8_STAGE(PG8_SA(1, 0), cA + kstep, voffA); PG8_STAGE(PG8_SB(1, 1), cB + hstep + kstep, voffB);
        PG8_WAIT_V(6); PG8_BAR;
    }
    for (;;) {
        const bool has_next = S.next(ui + 1, nxt);
        const char* nA = has_next ? (const char*)g.A + (size_t)nxt.pm * tstep : cA; const char* nB = has_next ? (const char*)g.Bt + (size_t)nxt.pn * tstep : cB;
        for (int t = 0; t < nt; t += 2) {
            const bool last = (t == nt - 2);
            const char* a1 = cA + (size_t)(t + 1) * kstep;
            const char* a2 = last ? nA : cA + (size_t)(t + 2) * kstep; const char* b2 = last ? nB : cB + (size_t)(t + 2) * kstep;
            const char* a3 = a2 + kstep; const char* b3 = b2 + kstep;
            if (last && has_next) S.a_ready(nxt);
            if constexpr (SP2) {
            PG8_LDB(B0, 0, 0); PG8_LDB(B1, 0, 1); PG8_SCHED; PG8_LDA(At, 0, 0); PG8_STAGE(PG8_SA(1, 1), a1 + hstep, voffA);
            PG8_WAIT_V(8); PG8_WAIT_L(0); PG8_BAR; PG8_MMA(0, 0, At, B0); PG8_MMA(0, 1, At, B1); PG8_BAR; PG8_SCHED;
            PG8_LDA(At, 0, 1); PG8_STAGE(PG8_SB(0, 0), b2, voffB); PG8_STAGE(PG8_SB(0, 1), b2 + hstep, voffB); PG8_STAGE(PG8_SA(0, 0), a2, voffA);
            PG8_WAIT_V(8); PG8_WAIT_L(0); PG8_BAR; PG8_MMA(1, 0, At, B0); PG8_MMA(1, 1, At, B1); PG8_BAR; PG8_SCHED;
            PG8_LDB(B0, 1, 0); PG8_LDB(B1, 1, 1); PG8_SCHED; PG8_LDA(At, 1, 0); PG8_STAGE(PG8_SA(0, 1), a2 + hstep, voffA);
            PG8_WAIT_V(8); PG8_WAIT_L(0); PG8_BAR; PG8_MMA(0, 0, At, B0); PG8_MMA(0, 1, At, B1); PG8_BAR; PG8_SCHED;
            PG8_LDA(At, 1, 1); PG8_STAGE(PG8_SB(1, 0), b3, voffB); PG8_STAGE(PG8_SB(1, 1), b3 + hstep, voffB); PG8_STAGE(PG8_SA(1, 0), a3, voffA);
            PG8_WAIT_V(8); PG8_WAIT_L(0); PG8_BAR; PG8_MMA(1, 0, At, B0); PG8_MMA(1, 1, At, B1); PG8_BAR; PG8_SCHED;
            } else {
            PG8_LDB(B0, 0, 0); PG8_SCHED; PG8_LDA(At, 0, 0); PG8_STAGE(PG8_SA(1, 1), a1 + hstep, voffA);
            PG8_WAIT_L(8); PG8_BAR; PG8_WAIT_L(0); PG8_MMA(0, 0, At, B0); PG8_BAR; PG8_SCHED;
            PG8_LDB(B1, 0, 1); PG8_STAGE(PG8_SB(0, 0), b2, voffB);
            PG8_BAR; PG8_WAIT_L(0); PG8_MMA(0, 1, At, B1); PG8_BAR;
            PG8_LDA(At, 0, 1); PG8_STAGE(PG8_SA(0, 0), a2, voffA);
            PG8_BAR; PG8_WAIT_L(0); PG8_MMA(1, 0, At, B0); PG8_BAR; PG8_SCHED;
            PG8_STAGE(PG8_SB(0, 1), b2 + hstep, voffB);
            PG8_WAIT_V(6); PG8_BAR; PG8_MMA(1, 1, At, B1); PG8_BAR;
            PG8_LDB(B0, 1, 0); PG8_SCHED; PG8_LDA(At, 1, 0); PG8_STAGE(PG8_SA(0, 1), a2 + hstep, voffA);
            PG8_WAIT_L(8); PG8_BAR; PG8_WAIT_L(0); PG8_MMA(0, 0, At, B0); PG8_BAR; PG8_SCHED;
            PG8_LDB(B1, 1, 1); PG8_STAGE(PG8_SB(1, 0), b3, voffB);
            PG8_BAR; PG8_WAIT_L(0); PG8_MMA(0, 1, At, B1); PG8_BAR;
            PG8_LDA(At, 1, 1); PG8_STAGE(PG8_SA(1, 0), a3, voffA);
            PG8_BAR; PG8_WAIT_L(0); PG8_MMA(1, 0, At, B0); PG8_BAR; PG8_SCHED;
            PG8_STAGE(PG8_SB(1, 1), b3 + hstep, voffB);
            PG8_WAIT_V(6); PG8_BAR; PG8_MMA(1, 1, At, B1); PG8_BAR;
            }
        }
        if constexpr (ALIGN_EPI) { if (wr == 0) PG8_BAR; }
        if constexpr (!Epi::AFTER_DRAIN) { E(acc, cur, wr, wc, fr, fq); S.done(cur); }
        if (!has_next) break;
#pragma unroll
        for (int a = 0; a < 2; ++a)
#pragma unroll
            for (int b = 0; b < 2; ++b)
#pragma unroll
                for (int m = 0; m < 4; ++m)
#pragma unroll
                    for (int n = 0; n < 2; ++n) acc[a][b][m][n] = (f32x4){0.f, 0.f, 0.f, 0.f};
        cur = nxt; cA = nA; cB = nB; ++ui;
        if constexpr (ALIGN_EPI) { if (wr == 1) PG8_BAR; }
    }
    PG8_WAIT_V(0);
    if constexpr (!ALIGN_EPI) { if (wr == 0) PG8_BAR; }
    PG8_BAR;
#undef PG8_SA
#undef PG8_SB
#undef PG8_STAGE
#undef PG8_LDA
#undef PG8_LDB
#undef PG8_MMA
#undef PG8_WAIT_V
#undef PG8_WAIT_L
#undef PG8_BAR
#undef PG8_SCHED
}
}

namespace att {
constexpr int NW = 8, QBLK = 32, KVBLK = 64;
constexpr int SHM_V = KVBLK * 128 * 2;
#define SBAR() __builtin_amdgcn_sched_barrier(0)
__device__ __forceinline__ int crow(int r, int hi) { return (r & 3) + 8 * (r >> 2) + 4 * hi; }
__device__ __forceinline__ unsigned cvtpk(float lo, float hi) { unsigned r; asm volatile("v_cvt_pk_bf16_f32 %0, %1, %2" : "=v"(r) : "v"(lo), "v"(hi)); return r; }

constexpr float THR2 = 8.0f * 1.4426950408889634f;
template <bool FIRST>
__device__ __forceinline__ void partialSM(f32x16& p0, f32x16& p1, float& mC, float& alpha) {
  float pmax = p0[0];
#pragma unroll
  for (int r = 1; r < 16; ++r) pmax = fmaxf(pmax, p0[r]);
#pragma unroll
  for (int r = 0; r < 16; ++r) pmax = fmaxf(pmax, p1[r]);
  { auto rr = __builtin_amdgcn_permlane32_swap(__float_as_uint(pmax), __float_as_uint(pmax), false, false);
    pmax = fmaxf(__uint_as_float(rr[0]), __uint_as_float(rr[1])); }
  if (!FIRST && __builtin_expect(__all(pmax <= THR2), 1)) { alpha = 1.f; }
  else { const float delta = FIRST ? fmaxf(pmax, -200.f) : fmaxf(pmax, 0.f); alpha = FIRST ? 1.f : __builtin_amdgcn_exp2f(-delta); mC += delta;
#pragma unroll
    for (int r = 0; r < 16; ++r) p0[r] -= delta;
#pragma unroll
    for (int r = 0; r < 16; ++r) p1[r] -= delta; }
#pragma unroll
  for (int r = 0; r < 16; ++r) p0[r] = __builtin_amdgcn_exp2f(p0[r]);
}
__device__ __forceinline__ void finishSM(f32x16& p0, f32x16& p1, float alpha, float& l_reg, bf16x8& pa0, bf16x8& pa1, bf16x8& pa2, bf16x8& pa3) {
#pragma unroll
  for (int r = 0; r < 16; ++r) p1[r] = __builtin_amdgcn_exp2f(p1[r]);
  float ps = 0;
#pragma unroll
  for (int r = 0; r < 16; ++r) ps += p0[r];
#pragma unroll
  for (int r = 0; r < 16; ++r) ps += p1[r];
  { auto rr = __builtin_amdgcn_permlane32_swap(__float_as_uint(ps), __float_as_uint(ps), false, false);
    ps = __uint_as_float(rr[0]) + __uint_as_float(rr[1]); }
  l_reg = l_reg * alpha + ps;
#define PK4(P, BASE, OUT) do { unsigned a0 = cvtpk(P[BASE + 0], P[BASE + 1]), a1 = cvtpk(P[BASE + 2], P[BASE + 3]);   \
    unsigned b0 = cvtpk(P[BASE + 4], P[BASE + 5]), b1 = cvtpk(P[BASE + 6], P[BASE + 7]);                              \
    auto r0 = __builtin_amdgcn_permlane32_swap(a0, b0, false, false); auto r1 = __builtin_amdgcn_permlane32_swap(a1, b1, false, false); \
    u32x4 w = {r0[0], r1[0], r0[1], r1[1]}; OUT = *reinterpret_cast<bf16x8*>(&w); } while (0)
  PK4(p0, 0, pa0); PK4(p0, 8, pa1); PK4(p1, 0, pa2); PK4(p1, 8, pa3);
#undef PK4
}
template <int NDQ, int NQL>
__device__ __forceinline__ void qkt(f32x16& p0, f32x16& p1, const f32x16& negm, const char* Ks, const bf16x8* qr, const char* qls, int r32, int hi) {
  constexpr int ROWB = NDQ * 32, NQR = NDQ - NQL;
#pragma unroll
  for (int d0 = 0; d0 < NDQ; ++d0) { const int cb = (d0 * 16 + hi * 8) * 2;
    bf16x8 b0 = *reinterpret_cast<const bf16x8*>(Ks + r32 * ROWB + (cb ^ ((r32 & 7) << 4)));
    bf16x8 b1 = *reinterpret_cast<const bf16x8*>(Ks + (32 + r32) * ROWB + (cb ^ ((r32 & 7) << 4)));
    bf16x8 q;
    if constexpr (NQL > 0) { if (d0 < NQR) q = qr[d0 < NQR ? d0 : 0]; else q = *reinterpret_cast<const bf16x8*>(qls + (d0 - NQR) * 1024); }
    else q = qr[d0];
    if (d0 == 0) { p0 = __builtin_amdgcn_mfma_f32_32x32x16_bf16(b0, q, negm, 0, 0, 0); p1 = __builtin_amdgcn_mfma_f32_32x32x16_bf16(b1, q, negm, 0, 0, 0); }
    else { p0 = __builtin_amdgcn_mfma_f32_32x32x16_bf16(b0, q, p0, 0, 0, 0); p1 = __builtin_amdgcn_mfma_f32_32x32x16_bf16(b1, q, p1, 0, 0, 0); } }
}
__device__ __forceinline__ int v_st(int k, int c) { const int kk = (k & ~0xC) | ((k & 4) << 1) | ((k & 8) >> 1); return ((kk >> 3) * 4 + (c >> 5)) * 512 + ((kk & 7) * 32 + (c & 31)) * 2; }
__device__ __forceinline__ int v_rd_base(int lane) { return ((lane & 3) << 3) | (((lane >> 2) & 3) << 6) | (((lane >> 4) & 1) << 5) | (((lane >> 5) & 1) << 8); }
constexpr int v_rd_off(int d0, int ks, int half) { return d0 * 512 + ks * 4096 + half * 2048; }
template <int OFF> __device__ __forceinline__ s16x4 tr_read(int vb) {
  s16x4 r; asm volatile("ds_read_b64_tr_b16 %0, %1 offset:%2" : "=&v"(r) : "v"(vb), "i"(OFF) : "memory"); return r;
}
template <int D0> __device__ __forceinline__ void pv_one(f32x16& od, int vb, bf16x8 pa0, bf16x8 pa1, bf16x8 pa2, bf16x8 pa3) {
  const s16x4 l0 = tr_read<v_rd_off(D0, 0, 0)>(vb), h0 = tr_read<v_rd_off(D0, 0, 1)>(vb), l1 = tr_read<v_rd_off(D0, 1, 0)>(vb), h1 = tr_read<v_rd_off(D0, 1, 1)>(vb);
  const s16x4 l2 = tr_read<v_rd_off(D0, 2, 0)>(vb), h2 = tr_read<v_rd_off(D0, 2, 1)>(vb), l3 = tr_read<v_rd_off(D0, 3, 0)>(vb), h3 = tr_read<v_rd_off(D0, 3, 1)>(vb);
  asm volatile("s_waitcnt lgkmcnt(0)" ::: "memory"); SBAR();
#define PK(L, H) (bf16x8){L[0], L[1], L[2], L[3], H[0], H[1], H[2], H[3]}
  od = __builtin_amdgcn_mfma_f32_32x32x16_bf16(pa0, PK(l0, h0), od, 0, 0, 0);
  od = __builtin_amdgcn_mfma_f32_32x32x16_bf16(pa1, PK(l1, h1), od, 0, 0, 0);
  od = __builtin_amdgcn_mfma_f32_32x32x16_bf16(pa2, PK(l2, h2), od, 0, 0, 0);
  od = __builtin_amdgcn_mfma_f32_32x32x16_bf16(pa3, PK(l3, h3), od, 0, 0, 0);
#undef PK
}
__device__ __forceinline__ void pv_d0(f32x16* o, int vb, bf16x8 pa0, bf16x8 pa1, bf16x8 pa2, bf16x8 pa3) {
  pv_one<0>(o[0], vb, pa0, pa1, pa2, pa3); pv_one<1>(o[1], vb, pa0, pa1, pa2, pa3); pv_one<2>(o[2], vb, pa0, pa1, pa2, pa3); pv_one<3>(o[3], vb, pa0, pa1, pa2, pa3);
}

constexpr int LDS_K_OFF = 2 * SHM_V, LDS_WS_OFF = LDS_K_OFF + 2 * 12 * 2048, LDS_TBL_OFF = LDS_WS_OFF + NW * 64 * 4, LDS_Q_OFF = LDS_TBL_OFF + ((TBLN * 4 + 15) / 16) * 16;
static_assert(LDS_Q_OFF + NW * 8192 <= 163840, "attention LDS map");

template <int NDQ, int BIAS, int EPI, int SDEPTH, int NQL = 0, int ROPEQ = 0>
__device__ __forceinline__ void attn_unit(const bf16_t* __restrict__ Qb, int ldq, const bf16_t* __restrict__ Kh, int ldk, const bf16_t* __restrict__ K2, int ldk2,
                                          const bf16_t* __restrict__ Vh, int ldv, int kbeg, int nkeys, int q0, const float* __restrict__ tblg, float cb_lo, float cb_hi,
                                          bf16_t* __restrict__ Obf, int ldo, float* __restrict__ tmp, float lam, const float* __restrict__ subln, float post, char* lds, const int wave0, const float* __restrict__ cosp = nullptr, const float* __restrict__ sinp = nullptr) {
  constexpr int ROWB = NDQ * 32, SHM_K = 64 * ROWB;
  int tid_ = wave0 * 64 + lane_id_v();
  const int tid = tid_, wid = tid >> 6, lane = tid & 63, r32 = lane & 31, hi = lane >> 5;
  char* V_lds = lds; char* K_lds = lds + LDS_K_OFF;
  float* ws = (float*)(lds + LDS_WS_OFF) + wid * 64; float* li_l = ws; float* al_l = ws + 32;
  float* tbl_l = (float*)(lds + LDS_TBL_OFF);
  __syncthreads();
  if constexpr (BIAS) { for (int i = tid; i < TBLN; i += 512) tbl_l[i] = tblg[i]; }
  float mC = 0.f, l_reg = 0, nm_cur = 0.f; f32x16 o[4] = {}; f32x16 negm = {}; bf16x8 qr[NDQ - NQL];
  const bf16_t* Qw = Qb + (long)(wid * QBLK + r32) * ldq + hi * 8;
  char* qls = lds + LDS_Q_OFF + wid * 8192 + lane * 16;
#pragma unroll
  for (int d0 = 0; d0 < NDQ - NQL; ++d0) qr[d0] = *reinterpret_cast<const bf16x8*>(Qw + d0 * 16);
  if constexpr (ROPEQ) {
    static_assert(NDQ == 12 && NQL >= 4, "ROPEQ: MLA layout");
#pragma unroll
    for (int d0 = NDQ - NQL; d0 < 8; ++d0) *reinterpret_cast<bf16x8*>(qls + (d0 - (NDQ - NQL)) * 1024) = *reinterpret_cast<const bf16x8*>(Qw + d0 * 16);
    const int qrow = q0 + wid * QBLK + r32;
#pragma unroll
    for (int pr = 0; pr < 2; ++pr) {
      const bf16x8 xa = *reinterpret_cast<const bf16x8*>(Qw + (8 + pr) * 16), xb = *reinterpret_cast<const bf16x8*>(Qw + (10 + pr) * 16);
      const float* cp = cosp + (size_t)qrow * 32 + pr * 16 + hi * 8; const float* sp = sinp + (size_t)qrow * 32 + pr * 16 + hi * 8;
      const f32x4 c0 = *(const f32x4*)cp, c1 = *(const f32x4*)(cp + 4), s0 = *(const f32x4*)sp, s1 = *(const f32x4*)(sp + 4);
      float ya[8], yb[8];
#pragma unroll
      for (int t = 0; t < 8; ++t) { const float x1 = bf2f((unsigned short)xa[t]), x2 = bf2f((unsigned short)xb[t]); const float c = t < 4 ? c0[t & 3] : c1[t & 3], sn = t < 4 ? s0[t & 3] : s1[t & 3];
        ya[t] = x1 * c - x2 * sn; yb[t] = x2 * c + x1 * sn; }
      u32x4 wa = {pk2(ya[0], ya[1]), pk2(ya[2], ya[3]), pk2(ya[4], ya[5]), pk2(ya[6], ya[7])}, wb = {pk2(yb[0], yb[1]), pk2(yb[2], yb[3]), pk2(yb[4], yb[5]), pk2(yb[6], yb[7])};
      *reinterpret_cast<u32x4*>(qls + (8 + pr - (NDQ - NQL)) * 1024) = wa; *reinterpret_cast<u32x4*>(qls + (10 + pr - (NDQ - NQL)) * 1024) = wb; }
  } else {
#pragma unroll
  for (int d0 = NDQ - NQL; d0 < NDQ; ++d0) *reinterpret_cast<bf16x8*>(qls + (d0 - (NDQ - NQL)) * 1024) = *reinterpret_cast<const bf16x8*>(Qw + d0 * 16);
  }
  const int sr = tid >> 4, sc = (tid & 15) * 8, vst0 = v_st(sr, sc), vst1 = v_st(32 + sr, sc);
  const int sr8 = tid >> 3, sc8 = (tid & 7) * 8;
  const int vb0 = (int)(uintptr_t)V_lds + v_rd_base(lane);
  const int qlane = q0 + wid * QBLK + r32;
  struct { bf16x8 vs0, vs1, ks0, ks1, ks2; } sr_[SDEPTH];
#define KSWZ(row, colB) ((row) * ROWB + ((colB) ^ (((row) & 7) << 4)))
#define SLOAD(i, k0) do { sr_[i].vs0 = *reinterpret_cast<const bf16x8*>(&Vh[(long)((k0) + sr) * ldv + sc]); sr_[i].vs1 = *reinterpret_cast<const bf16x8*>(&Vh[(long)((k0) + 32 + sr) * ldv + sc]); \
    if constexpr (NDQ == 4) { sr_[i].ks0 = *reinterpret_cast<const bf16x8*>(&Kh[(long)((k0) + sr8) * ldk + sc8]); } \
    else { sr_[i].ks0 = *reinterpret_cast<const bf16x8*>(&Kh[(long)((k0) + sr) * ldk + sc]); sr_[i].ks1 = *reinterpret_cast<const bf16x8*>(&Kh[(long)((k0) + 32 + sr) * ldk + sc]); \
      if constexpr (NDQ == 12) { sr_[i].ks2 = *reinterpret_cast<const bf16x8*>(&K2[(long)((k0) + sr8) * ldk2 + sc8]); } } } while (0)
#define SWRITE(b, i) do { *(bf16x8*)(V_lds + (b) * SHM_V + vst0) = sr_[i].vs0; *(bf16x8*)(V_lds + (b) * SHM_V + vst1) = sr_[i].vs1; \
    if constexpr (NDQ == 4) { *(bf16x8*)(K_lds + (b) * SHM_K + KSWZ(sr8, sc8 * 2)) = sr_[i].ks0; } \
    else { *(bf16x8*)(K_lds + (b) * SHM_K + KSWZ(sr, sc * 2)) = sr_[i].ks0; *(bf16x8*)(K_lds + (b) * SHM_K + KSWZ(32 + sr, sc * 2)) = sr_[i].ks1; \
      if constexpr (NDQ == 12) { *(bf16x8*)(K_lds + (b) * SHM_K + KSWZ(sr8, 256 + sc8 * 2)) = sr_[i].ks2; } } } while (0)
#define SWAIT() do { if constexpr (SDEPTH == 2) { if constexpr (NDQ == 4) asm volatile("s_waitcnt vmcnt(3)" ::: "memory"); else if constexpr (NDQ == 8) asm volatile("s_waitcnt vmcnt(4)" ::: "memory"); else asm volatile("s_waitcnt vmcnt(5)" ::: "memory"); } \
    else asm volatile("s_waitcnt vmcnt(0)" ::: "memory"); } while (0)
#define RESC(a) do { if (__any((a) < 1.f)) { if (hi == 0) al_l[r32] = (a); asm volatile("s_waitcnt lgkmcnt(0)" ::: "memory"); \
    _Pragma("unroll") for (int d = 0; d < 4; ++d) _Pragma("unroll") for (int r = 0; r < 16; ++r) o[d][r] *= al_l[crow(r, hi)]; } } while (0)
#define BIASADD(P0, P1, kt0) do { if constexpr (BIAS) { const int dlo_ = (kt0) - q0 - 255, dhi_ = (kt0) + 63 - q0; \
    if (!(dlo_ >= 1024) && !(dhi_ <= -1024)) { const float* tb_ = tbl_l + ((kt0) - qlane + TOFF + 4 * hi); \
      _Pragma("unroll") for (int r = 0; r < 16; ++r) { P0[r] += tb_[(r & 3) + 8 * (r >> 2)]; P1[r] += tb_[32 + (r & 3) + 8 * (r >> 2)]; } } } } while (0)
#define NEGM_UPD(kt0) do { float nmj_ = -mC; if constexpr (BIAS) { const int dlo_ = (kt0) - q0 - 255, dhi_ = (kt0) + 63 - q0; if (dlo_ >= 1024) nmj_ += cb_hi; else if (dhi_ <= -1024) nmj_ += cb_lo; } \
    if (__any(nmj_ != nm_cur)) { nm_cur = nmj_; _Pragma("unroll") for (int r = 0; r < 16; ++r) negm[r] = nmj_; } } while (0)
  f32x16 pA0, pA1, pB0, pB1; float alA, alB; bf16x8 pa0, pa1, pa2, pa3; const int NT = nkeys / KVBLK;
  constexpr int SE = 0, SO = SDEPTH - 1;
  SLOAD(SE, kbeg); asm volatile("s_waitcnt vmcnt(0)" ::: "memory"); SWRITE(0, SE); __syncthreads();
  NEGM_UPD(kbeg); qkt<NDQ, NQL>(pA0, pA1, negm, K_lds, qr, qls, r32, hi); BIASADD(pA0, pA1, kbeg); partialSM<true>(pA0, pA1, mC, alA);
  SLOAD(SO, kbeg + KVBLK); if constexpr (SDEPTH == 2) { if (2 < NT) SLOAD(SE, kbeg + 2 * KVBLK); }
  SWAIT(); SWRITE(1, SO); __syncthreads();
  for (int j = 1; j + 1 < NT; j += 2) {
    NEGM_UPD(kbeg + j * KVBLK); SBAR(); qkt<NDQ, NQL>(pB0, pB1, negm, K_lds + SHM_K, qr, qls, r32, hi);
    finishSM(pA0, pA1, alA, l_reg, pa0, pa1, pa2, pa3); SBAR();
    SLOAD(SO, kbeg + (j + SDEPTH) * KVBLK); SBAR();
    pv_d0(o, vb0, pa0, pa1, pa2, pa3); BIASADD(pB0, pB1, kbeg + j * KVBLK); partialSM<false>(pB0, pB1, mC, alB);
    __syncthreads(); SWAIT(); SWRITE(0, SE);
    RESC(alB); __syncthreads();
    NEGM_UPD(kbeg + (j + 1) * KVBLK); SBAR(); qkt<NDQ, NQL>(pA0, pA1, negm, K_lds, qr, qls, r32, hi);
    finishSM(pB0, pB1, alB, l_reg, pa0, pa1, pa2, pa3); SBAR();
    if (SDEPTH == 1 || j + 3 < NT) SLOAD(SE, kbeg + (j + 1 + SDEPTH) * KVBLK); SBAR();
    pv_d0(o, vb0 + (int)SHM_V, pa0, pa1, pa2, pa3); BIASADD(pA0, pA1, kbeg + (j + 1) * KVBLK); partialSM<false>(pA0, pA1, mC, alA);
    __syncthreads(); SWAIT(); SWRITE(1, SO);
    RESC(alA); __syncthreads();
  }
  NEGM_UPD(kbeg + (NT - 1) * KVBLK); SBAR(); qkt<NDQ, NQL>(pB0, pB1, negm, K_lds + SHM_K, qr, qls, r32, hi);
  finishSM(pA0, pA1, alA, l_reg, pa0, pa1, pa2, pa3); SBAR();
  pv_d0(o, vb0, pa0, pa1, pa2, pa3); BIASADD(pB0, pB1, kbeg + (NT - 1) * KVBLK); partialSM<false>(pB0, pB1, mC, alB);
  __syncthreads(); RESC(alB);
  finishSM(pB0, pB1, alB, l_reg, pa0, pa1, pa2, pa3); SBAR();
  pv_d0(o, vb0 + (int)SHM_V, pa0, pa1, pa2, pa3);
  if (hi == 0) li_l[r32] = l_reg; asm volatile("s_waitcnt lgkmcnt(0)" ::: "memory");
  float rli[16];
#pragma unroll
  for (int r = 0; r < 16; ++r) rli[r] = __builtin_amdgcn_rcpf(li_l[crow(r, hi)]);
  if constexpr (EPI == 0) {
    bf16_t* Ow = Obf + (long)(wid * QBLK) * ldo;
#pragma unroll
    for (int r = 0; r < 16; ++r) { const int orow = crow(r, hi);
#pragma unroll
      for (int d0 = 0; d0 < 4; ++d0) Ow[(long)orow * ldo + d0 * 32 + r32] = (bf16_t)f2bf(o[d0][r] * rli[r]); }
  } else if constexpr (EPI == 1) {
    float* Tw = tmp + (wid * QBLK) * 128;
#pragma unroll
    for (int r = 0; r < 16; ++r) { const int orow = crow(r, hi);
#pragma unroll
      for (int d0 = 0; d0 < 4; ++d0) Tw[orow * 128 + d0 * 32 + r32] = o[d0][r] * rli[r]; }
  } else {
    const float* Tw = tmp + (wid * QBLK) * 128; bf16_t* Ow = Obf + (long)(wid * QBLK) * ldo;
    float sg[4];
#pragma unroll
    for (int d0 = 0; d0 < 4; ++d0) sg[d0] = subln[d0 * 32 + r32] * post;
#pragma unroll
    for (int r = 0; r < 16; ++r) { const int orow = crow(r, hi); float v[4]; float ss = 0.f;
#pragma unroll
      for (int d0 = 0; d0 < 4; ++d0) { v[d0] = Tw[orow * 128 + d0 * 32 + r32] - lam * (o[d0][r] * rli[r]); ss += v[d0] * v[d0]; }
      ss += swz_xor<1>(ss); ss += swz_xor<2>(ss); ss += swz_xor<4>(ss); ss += swz_xor<8>(ss); ss += swz_xor<16>(ss);
      const float rs = rsqrtf(ss * (1.0f / 128.0f) + EPS);
#pragma unroll
      for (int d0 = 0; d0 < 4; ++d0) Ow[(long)orow * ldo + d0 * 32 + r32] = (bf16_t)f2bf(v[d0] * rs * sg[d0]); }
  }
#undef KSWZ
#undef SLOAD
#undef SWRITE
#undef SWAIT
#undef RESC
#undef BIASADD
#undef NEGM_UPD
}

template <int M>
__device__ __forceinline__ void qkt_map(f32x16& p0, f32x16& p1, const char* Ks, const char* qls, int r32, int hi) {
  p0 = f32x16{}; p1 = f32x16{};
#pragma unroll
  for (int d0 = 0; d0 < 4; ++d0) { const int cb = (M * 64 + d0 * 16 + hi * 8) * 2;
    bf16x8 b0 = *reinterpret_cast<const bf16x8*>(Ks + r32 * 256 + (cb ^ ((r32 & 7) << 4)));
    bf16x8 b1 = *reinterpret_cast<const bf16x8*>(Ks + (32 + r32) * 256 + (cb ^ ((r32 & 7) << 4)));
    bf16x8 q = *reinterpret_cast<const bf16x8*>(qls + (M * 4 + d0) * 1024);
    p0 = __builtin_amdgcn_mfma_f32_32x32x16_bf16(b0, q, p0, 0, 0, 0);
    p1 = __builtin_amdgcn_mfma_f32_32x32x16_bf16(b1, q, p1, 0, 0, 0);
    if (d0 == 1) SBAR(); }
}
__device__ __forceinline__ void softmax_tile(f32x16& p0, f32x16& p1, float& m, float& l, float& alpha, float cb, bf16x8& pa0, bf16x8& pa1, bf16x8& pa2, bf16x8& pa3) {
  float pmax = p0[0];
#pragma unroll
  for (int r = 1; r < 16; ++r) pmax = fmaxf(pmax, p0[r]);
#pragma unroll
  for (int r = 0; r < 16; ++r) pmax = fmaxf(pmax, p1[r]);
  { auto rr = __builtin_amdgcn_permlane32_swap(__float_as_uint(pmax), __float_as_uint(pmax), false, false);
    pmax = fmaxf(__uint_as_float(rr[0]), __uint_as_float(rr[1])); }
  pmax += cb;
  float mn;
  if (__builtin_expect(__all(pmax - m <= THR2), 1)) { mn = m; alpha = 1.f; }
  else { mn = fmaxf(m, pmax); alpha = __builtin_amdgcn_exp2f(m - mn); m = mn; }
  const float off = cb - mn;
#pragma unroll
  for (int r = 0; r < 16; ++r) p0[r] = __builtin_amdgcn_exp2f(p0[r] + off);
#pragma unroll
  for (int r = 0; r < 16; ++r) p1[r] = __builtin_amdgcn_exp2f(p1[r] + off);
  float ps = 0;
#pragma unroll
  for (int r = 0; r < 16; ++r) ps += p0[r];
#pragma unroll
  for (int r = 0; r < 16; ++r) ps += p1[r];
  { auto rr = __builtin_amdgcn_permlane32_swap(__float_as_uint(ps), __float_as_uint(ps), false, false);
    ps = __uint_as_float(rr[0]) + __uint_as_float(rr[1]); }
  l = l * alpha + ps;
#define PK4(P, BASE, OUT) do { unsigned a0 = cvtpk(P[BASE + 0], P[BASE + 1]), a1 = cvtpk(P[BASE + 2], P[BASE + 3]);   \
    unsigned b0 = cvtpk(P[BASE + 4], P[BASE + 5]), b1 = cvtpk(P[BASE + 6], P[BASE + 7]);                              \
    auto r0 = __builtin_amdgcn_permlane32_swap(a0, b0, false, false); auto r1 = __builtin_amdgcn_permlane32_swap(a1, b1, false, false); \
    u32x4 w = {r0[0], r1[0], r0[1], r1[1]}; OUT = *reinterpret_cast<bf16x8*>(&w); } while (0)
  PK4(p0, 0, pa0); PK4(p0, 8, pa1); PK4(p1, 0, pa2); PK4(p1, 8, pa3);
#undef PK4
}
template <int D0> __device__ __forceinline__ void pv2_one(f32x16& oa, f32x16& ob, int vb, bf16x8 pa0, bf16x8 pa1, bf16x8 pa2, bf16x8 pa3, bf16x8 pb0, bf16x8 pb1, bf16x8 pb2, bf16x8 pb3) {
  const s16x4 l0 = tr_read<v_rd_off(D0, 0, 0)>(vb), h0 = tr_read<v_rd_off(D0, 0, 1)>(vb), l1 = tr_read<v_rd_off(D0, 1, 0)>(vb), h1 = tr_read<v_rd_off(D0, 1, 1)>(vb);
  const s16x4 l2 = tr_read<v_rd_off(D0, 2, 0)>(vb), h2 = tr_read<v_rd_off(D0, 2, 1)>(vb), l3 = tr_read<v_rd_off(D0, 3, 0)>(vb), h3 = tr_read<v_rd_off(D0, 3, 1)>(vb);
  asm volatile("s_waitcnt lgkmcnt(0)" ::: "memory"); SBAR();
#define PK(L, H) (bf16x8){L[0], L[1], L[2], L[3], H[0], H[1], H[2], H[3]}
  const bf16x8 v0 = PK(l0, h0), v1 = PK(l1, h1), v2 = PK(l2, h2), v3 = PK(l3, h3);
  oa = __builtin_amdgcn_mfma_f32_32x32x16_bf16(pa0, v0, oa, 0, 0, 0);
  ob = __builtin_amdgcn_mfma_f32_32x32x16_bf16(pb0, v0, ob, 0, 0, 0);
  oa = __builtin_amdgcn_mfma_f32_32x32x16_bf16(pa1, v1, oa, 0, 0, 0);
  ob = __builtin_amdgcn_mfma_f32_32x32x16_bf16(pb1, v1, ob, 0, 0, 0);
  oa = __builtin_amdgcn_mfma_f32_32x32x16_bf16(pa2, v2, oa, 0, 0, 0);
  ob = __builtin_amdgcn_mfma_f32_32x32x16_bf16(pb2, v2, ob, 0, 0, 0);
  oa = __builtin_amdgcn_mfma_f32_32x32x16_bf16(pa3, v3, oa, 0, 0, 0);
  ob = __builtin_amdgcn_mfma_f32_32x32x16_bf16(pb3, v3, ob, 0, 0, 0);
#undef PK
}
__device__ __forceinline__ void attn_unit_A2(const bf16_t* __restrict__ Qb, int ldq, const bf16_t* __restrict__ Kh, int ldk, const bf16_t* __restrict__ Vh, int ldv, int nkeys, int q0,
                                             const float* __restrict__ tblg, float cb_lo, float cb_hi, bf16_t* __restrict__ Obf, int ldo, float lam, const float* __restrict__ subln, float post, char* lds, const int wave0) {
  constexpr int ROWB = 256, SHM_K = 64 * ROWB;
  int tid_ = wave0 * 64 + lane_id_v();
  const int tid = tid_, wid = tid >> 6, lane = tid & 63, r32 = lane & 31, hi = lane >> 5;
  char* V_lds = lds; char* K_lds = lds + LDS_K_OFF;
  float* ws = (float*)(lds + LDS_WS_OFF) + wid * 64; float* sl0 = ws; float* sl1 = ws + 32;
  float* tbl_l = (float*)(lds + LDS_TBL_OFF);
  char* qls = lds + LDS_Q_OFF + wid * 8192 + lane * 16;
  __syncthreads();
  for (int i = tid; i < TBLN; i += 512) tbl_l[i] = tblg[i];
  { const bf16_t* Qw = Qb + (long)(wid * QBLK + r32) * ldq + hi * 8;
#pragma unroll
    for (int i = 0; i < 8; ++i) *reinterpret_cast<bf16x8*>(qls + i * 1024) = *reinterpret_cast<const bf16x8*>(Qw + i * 16); }
  float m0 = -1e30f, m1 = -1e30f, l0 = 0.f, l1 = 0.f; f32x16 oa[4] = {}, ob[4] = {};
  const int sr = tid >> 4, sc = (tid & 15) * 8, vst0 = v_st(sr, sc), vst1 = v_st(32 + sr, sc);
  const int vb0 = (int)(uintptr_t)V_lds + v_rd_base(lane);
  const int qlane = q0 + wid * QBLK + r32;
  bf16x8 vs0, vs1, ks0, ks1;
#define KSWZ(row, colB) ((row) * ROWB + ((colB) ^ (((row) & 7) << 4)))
#define SLOAD2(k0) do { vs0 = *reinterpret_cast<const bf16x8*>(&Vh[(long)((k0) + sr) * ldv + sc]); vs1 = *reinterpret_cast<const bf16x8*>(&Vh[(long)((k0) + 32 + sr) * ldv + sc]); \
    ks0 = *reinterpret_cast<const bf16x8*>(&Kh[(long)((k0) + sr) * ldk + sc]); ks1 = *reinterpret_cast<const bf16x8*>(&Kh[(long)((k0) + 32 + sr) * ldk + sc]); } while (0)
#define SWRITE2(b) do { *(bf16x8*)(V_lds + (b) * SHM_V + vst0) = vs0; *(bf16x8*)(V_lds + (b) * SHM_V + vst1) = vs1; \
    *(bf16x8*)(K_lds + (b) * SHM_K + KSWZ(sr, sc * 2)) = ks0; *(bf16x8*)(K_lds + (b) * SHM_K + KSWZ(32 + sr, sc * 2)) = ks1; } while (0)
#define RESC2(O, SL, a) do { if (__any((a) < 1.f)) { if (hi == 0) SL[r32] = (a); asm volatile("s_waitcnt lgkmcnt(0)" ::: "memory"); \
    _Pragma("unroll") for (int d = 0; d < 4; ++d) _Pragma("unroll") for (int r = 0; r < 16; ++r) O[d][r] *= SL[crow(r, hi)]; } } while (0)
  const int NT = nkeys / KVBLK;
  SLOAD2(0); asm volatile("s_waitcnt vmcnt(0)" ::: "memory"); SWRITE2(0); __syncthreads();
  for (int j = 0; j < NT; ++j) {
    const int b = j & 1, kt0 = j * KVBLK;
    const int dlo_ = kt0 - q0 - 255, dhi_ = kt0 + 63 - q0;
    float cb = 0.f; const bool nearb = !(dlo_ >= 1024) && !(dhi_ <= -1024);
    if (dlo_ >= 1024) cb = cb_hi; else if (dhi_ <= -1024) cb = cb_lo;
    const float* tb_ = tbl_l + (kt0 - qlane + TOFF + 4 * hi);
    f32x16 s0, s1; bf16x8 pa0, pa1, pa2, pa3; float al0, al1;
    const int vb = vb0 + b * (int)SHM_V;
    qkt_map<0>(s0, s1, K_lds + b * SHM_K, qls, r32, hi);
    SBAR();
    if (nearb) {
#pragma unroll
      for (int r = 0; r < 8; ++r) { s0[r] += tb_[(r & 3) + 8 * (r >> 2)]; s1[r] += tb_[32 + (r & 3) + 8 * (r >> 2)]; }
      SBAR();
#pragma unroll
      for (int r = 8; r < 16; ++r) { s0[r] += tb_[(r & 3) + 8 * (r >> 2)]; s1[r] += tb_[32 + (r & 3) + 8 * (r >> 2)]; } }
    SBAR();
    softmax_tile(s0, s1, m0, l0, al0, cb, pa0, pa1, pa2, pa3);
    RESC2(oa, sl0, al0);
    SBAR();
    pv_d0(oa, vb, pa0, pa1, pa2, pa3);
    SBAR();
    qkt_map<1>(s0, s1, K_lds + b * SHM_K, qls, r32, hi);
    SBAR();
    if (nearb) {
#pragma unroll
      for (int r = 0; r < 8; ++r) { s0[r] += tb_[(r & 3) + 8 * (r >> 2)]; s1[r] += tb_[32 + (r & 3) + 8 * (r >> 2)]; }
      SBAR();
#pragma unroll
      for (int r = 8; r < 16; ++r) { s0[r] += tb_[(r & 3) + 8 * (r >> 2)]; s1[r] += tb_[32 + (r & 3) + 8 * (r >> 2)]; } }
    SBAR();
    softmax_tile(s0, s1, m1, l1, al1, cb, pa0, pa1, pa2, pa3);
    RESC2(ob, sl1, al1);
    SBAR();
    if (j + 1 < NT) SLOAD2(kt0 + KVBLK);
    SBAR();
    pv_d0(ob, vb, pa0, pa1, pa2, pa3);
    if (j + 1 < NT) { asm volatile("s_waitcnt vmcnt(0)" ::: "memory"); SWRITE2(b ^ 1); }
    __syncthreads();
  }
  const int lane_e = lane_id_v(), r32e = lane_e & 31, hie = lane_e >> 5;
  if (hie == 0) { sl0[r32e] = l0; sl1[r32e] = l1; } asm volatile("s_waitcnt lgkmcnt(0)" ::: "memory");
  bf16_t* Ow = Obf + (long)(wid * QBLK) * ldo;
  float sg[4];
#pragma unroll
  for (int d0 = 0; d0 < 4; ++d0) sg[d0] = subln[d0 * 32 + r32e] * post;
#pragma unroll
  for (int r = 0; r < 16; ++r) { const int orow = crow(r, hie); const float ra = __builtin_amdgcn_rcpf(sl0[orow]), rb = lam * __builtin_amdgcn_rcpf(sl1[orow]); float v[4]; float ss = 0.f;
#pragma unroll
    for (int d0 = 0; d0 < 4; ++d0) { v[d0] = oa[d0][r] * ra - ob[d0][r] * rb; ss += v[d0] * v[d0]; }
    ss += swz_xor<1>(ss); ss += swz_xor<2>(ss); ss += swz_xor<4>(ss); ss += swz_xor<8>(ss); ss += swz_xor<16>(ss);
    const float rs = rsqrtf(ss * (1.0f / 128.0f) + EPS);
#pragma unroll
    for (int d0 = 0; d0 < 4; ++d0) Ow[(long)orow * ldo + d0 * 32 + r32e] = (bf16_t)f2bf(v[d0] * rs * sg[d0]); }
#undef KSWZ
#undef SLOAD2
#undef SWRITE2
#undef RESC2
}
}

__device__ __forceinline__ void transpose_item(const float* __restrict__ W, int K, int N, bf16_t* __restrict__ WT, int k0, int n0, int drow0, float wscale, LAS float* scr, int lane) {
    float tv[32];
#pragma unroll
    for (int i = 0; i < 32; ++i) { const int kk = 2 * i + (lane >> 5); tv[i] = W[(size_t)(k0 + kk) * N + n0 + (lane & 31)]; }
#pragma unroll
    for (int i = 0; i < 32; ++i) { const int kk = 2 * i + (lane >> 5); scr[kk * 33 + (lane & 31)] = tv[i] * wscale; }
    asm volatile("s_waitcnt lgkmcnt(0)" ::: "memory");
    const int c = lane & 7;
#pragma unroll
    for (int j = 0; j < 4; ++j) { const int n = (lane >> 3) + 8 * j; const LAS float* s = scr + (8 * c) * 33 + n;
        u32x4 o; o.x = pk2(s[0 * 33], s[1 * 33]); o.y = pk2(s[2 * 33], s[3 * 33]); o.z = pk2(s[4 * 33], s[5 * 33]); o.w = pk2(s[6 * 33], s[7 * 33]);
        *(u32x4*)(WT + (size_t)(drow0 + n) * K + k0 + 8 * c) = o; }
    asm volatile("s_waitcnt lgkmcnt(0)" ::: "memory");
}
constexpr float QS_A = 0.125f * 1.4426950408889634f, QS_B = 0.07216878364870322f * 1.4426950408889634f, QS_CD = 0.08838834764831845f * 1.4426950408889634f;
template <int MODE>
__device__ __forceinline__ void transpose_matrix(const float* __restrict__ W, int K, int N, bf16_t* __restrict__ WT, LAS float* scr, int lane, int gw, int NGW) {
    const int nblk = N / 32, nitems = (K / 64) * nblk;
    for (int it = gw; it < nitems; it += NGW) { const int kb = it / nblk, nb = it % nblk, n0 = 32 * nb; int drow0 = n0;
        if (MODE == 1) { const int c = n0 < FF ? n0 : n0 - FF; drow0 = 256 * (c / 128) + (c % 128) + (n0 < FF ? 0 : 128); }
        float wscale = 1.0f;
        if (MODE == 2) { if (n0 < C_AK) wscale = QS_A; else if (n0 >= C_DQ && n0 < C_DK) wscale = QS_CD; }
        if (MODE == 3) wscale = QS_B;
        transpose_item(W, K, N, WT, 64 * kb, n0, drow0, wscale, scr, lane); }
}
__device__ __forceinline__ int t5_bucket(int d) {
    const int ret = d > 0 ? 16 : 0; const int n = d < 0 ? -d : d;
    if (n < 8) return ret + n;
    const float v = logf((float)n / 8.0f) / 4.852030263919617f * 8.0f;
    int large = 8 + (int)v; if (large > 15) large = 15;
    return ret + large;
}
__device__ __forceinline__ void norm_row(const float* __restrict__ xrow, const float* __restrict__ g, bf16_t* __restrict__ hrow, int lane) {
    f32x4 v[8]; float ss = 0.f;
#pragma unroll
    for (int j = 0; j < 8; ++j) { v[j] = ((const f32x4*)xrow)[lane + 64 * j]; ss += (v[j].x * v[j].x + v[j].y * v[j].y) + (v[j].z * v[j].z + v[j].w * v[j].w); }
    const float rs = rsqrtf(wave_sum(ss) * (1.0f / DM) + EPS);
#pragma unroll
    for (int j = 0; j < 8; ++j) { const f32x4 gg = ((const f32x4*)g)[lane + 64 * j];
        u32x2 w; w.x = pk2(v[j].x * rs * gg.x, v[j].y * rs * gg.y); w.y = pk2(v[j].z * rs * gg.z, v[j].w * rs * gg.w); ((u32x2*)hrow)[lane + 64 * j] = w; }
}
template <int NR>
__device__ __forceinline__ void norm_add_rows(const bf16_t* __restrict__ Yb, const float* xi, float* xo, const float* __restrict__ gpost,
                                              const float* __restrict__ gpre, bf16_t* __restrict__ Hb, int row0, int rstride, int lane) {
    u32x2 yb[NR][8]; f32x4 v[NR][8];
#pragma unroll
    for (int q = 0; q < NR; ++q) { const size_t ro = (size_t)(row0 + q * rstride) * DM;
#pragma unroll
        for (int j = 0; j < 8; ++j) yb[q][j] = ((const u32x2*)(Yb + ro))[lane + 64 * j];
#pragma unroll
        for (int j = 0; j < 8; ++j) v[q][j] = ((const f32x4*)(xi + ro))[lane + 64 * j]; }
    f32x4 gp[8];
#pragma unroll
    for (int j = 0; j < 8; ++j) gp[j] = ((const f32x4*)gpost)[lane + 64 * j];
#pragma unroll
    for (int q = 0; q < NR; ++q) { const size_t ro = (size_t)(row0 + q * rstride) * DM;
        f32x4 y[8]; float ss = 0.f;
#pragma unroll
        for (int j = 0; j < 8; ++j) { y[j].x = __uint_as_float(yb[q][j].x << 16); y[j].y = __uint_as_float(yb[q][j].x & 0xffff0000u); y[j].z = __uint_as_float(yb[q][j].y << 16); y[j].w = __uint_as_float(yb[q][j].y & 0xffff0000u);
            ss += (y[j].x * y[j].x + y[j].y * y[j].y) + (y[j].z * y[j].z + y[j].w * y[j].w); }
        const float rs = rsqrtf(wave_sum(ss) * (1.0f / DM) + EPS);
        float ss2 = 0.f;
#pragma unroll
        for (int j = 0; j < 8; ++j) { v[q][j] = v[q][j] + y[j] * rs * gp[j]; ((f32x4*)(xo + ro))[lane + 64 * j] = v[q][j];
            ss2 += (v[q][j].x * v[q][j].x + v[q][j].y * v[q][j].y) + (v[q][j].z * v[q][j].z + v[q][j].w * v[q][j].w); }
        if (gpre) {
            const float rs2 = rsqrtf(wave_sum(ss2) * (1.0f / DM) + EPS);
#pragma unroll
            for (int j = 0; j < 8; ++j) { const f32x4 gg = ((const f32x4*)gpre)[lane + 64 * j];
                u32x2 w; w.x = pk2(v[q][j].x * rs2 * gg.x, v[q][j].y * rs2 * gg.y); w.y = pk2(v[q][j].z * rs2 * gg.z, v[q][j].w * rs2 * gg.w); ((u32x2*)(Hb + ro))[lane + 64 * j] = w; }
        }
    }
}

__device__ __forceinline__ void head_norm_axial(const bf16_t* __restrict__ src, bf16_t* __restrict__ dst, const float* __restrict__ g, const float* __restrict__ COS, const float* __restrict__ SIN, int row, int t, float oscale) {
    float v[8];
#pragma unroll
    for (int s = 0; s < 4; ++s) { const unsigned w = *(const unsigned*)(src + 32 * s + 2 * t); v[2 * s] = bf2f((unsigned short)(w & 0xffff)); v[2 * s + 1] = bf2f((unsigned short)(w >> 16)); }
    float ss = 0.f;
#pragma unroll
    for (int i = 0; i < 8; ++i) ss += v[i] * v[i];
    ss += swz_xor<1>(ss); ss += swz_xor<2>(ss); ss += swz_xor<4>(ss); ss += swz_xor<8>(ss);
    const float rs = rsqrtf(ss * (1.0f / 128.0f) + EPS);
#pragma unroll
    for (int s = 0; s < 4; ++s) { v[2 * s] *= rs * oscale * g[32 * s + 2 * t]; v[2 * s + 1] *= rs * oscale * g[32 * s + 2 * t + 1]; }
    const int pr = row >> 6, pc = row & 63;
    float o[8];
#pragma unroll
    for (int e = 0; e < 2; ++e) { const int i = 2 * t + e;
        { const float c = COS[pr * 32 + i], s = SIN[pr * 32 + i]; const float x1 = v[e], x2 = v[2 + e]; o[e] = x1 * c - x2 * s; o[2 + e] = x2 * c + x1 * s; }
        { const float c = COS[pc * 32 + i], s = SIN[pc * 32 + i]; const float x1 = v[4 + e], x2 = v[6 + e]; o[4 + e] = x1 * c - x2 * s; o[6 + e] = x2 * c + x1 * s; } }
#pragma unroll
    for (int s = 0; s < 4; ++s) *(unsigned*)(dst + 32 * s + 2 * t) = pk2(o[2 * s], o[2 * s + 1]);
}

struct Args { const float* in[18]; float* out; unsigned char* ws; int ph_lo, ph_hi; };

__global__ void __launch_bounds__(512, 2) mega_fwd(Args args) {
    extern __shared__ __attribute__((aligned(16))) unsigned char lds[];
    const int G = gridDim.x, bid = blockIdx.x, NGW = G * 8;
    const int wave0 = __builtin_amdgcn_readfirstlane((int)threadIdx.x >> 6);
    typedef const __attribute__((address_space(4))) Args* KArgP;
    LAS unsigned char* ldsl = (LAS unsigned char*)lds;
#define x_in (kap->in[0])
#define rel_bias (kap->in[1])
#define norm_mix_pre (kap->in[2])
#define norm_mix_post (kap->in[3])
#define norm_ffn_pre (kap->in[4])
#define norm_ffn_post (kap->in[5])
#define w_in (kap->in[6])
#define diff_lambda (kap->in[7])
#define diff_subln (kap->in[8])
#define mla_q_norm (kap->in[9])
#define mla_kv_norm (kap->in[10])
#define mla_w_uq (kap->in[11])
#define mla_w_ukv (kap->in[12])
#define gqa_q_norm (kap->in[13])
#define gqa_k_norm (kap->in[14])
#define w_out (kap->in[15])
#define w_gate_up (kap->in[16])
#define w_down (kap->in[17])
#define xres (kap->out)
#define ws (kap->ws)
#define PAR ((float*)(ws + WS_PAR))
#define TBLA ((float*)(ws + WS_TBLA))
#define TBLD ((float*)(ws + WS_TBLD))
#define COS ((float*)(ws + WS_COS))
#define SIN ((float*)(ws + WS_SIN))
#define H ((bf16_t*)(ws + WS_H))
#define PROJ ((bf16_t*)(ws + WS_PROJ))
#define CQN ((bf16_t*)(ws + WS_CQN))
#define CKVN ((bf16_t*)(ws + WS_CKVN))
#define KPE ((bf16_t*)(ws + WS_KPE))
#define QC ((bf16_t*)(ws + WS_QC))
#define KC ((bf16_t*)(ws + WS_KC))
#define QB ((bf16_t*)(ws + WS_QB))
#define KVB ((bf16_t*)(ws + WS_KVB))
#define MIX ((bf16_t*)(ws + WS_MIX))
#define Y ((bf16_t*)(ws + WS_Y))
#define HID ((bf16_t*)(ws + WS_HID))
#define TMP ((float*)(ws + WS_TMP))
#define wl (ws + WS_W + (size_t)l * LW)

    const int lo = args.ph_lo, hi_ph = args.ph_hi; int ph = 0;
#define PH_BEGIN if (ph >= lo && ph < hi_ph) { KArgP kap = (KArgP)__builtin_amdgcn_kernarg_segment_ptr(); asm volatile("" : "+s"(kap)); \
    int tid_ = wave0 * 64 + lane_id_v(); const int tid = tid_, lane = tid & 63, wave = __builtin_amdgcn_readfirstlane(tid >> 6), gw = bid * 8 + wave; (void)lane; (void)gw;
#define PH_END } if (ph >= lo && ph + 1 < hi_ph) { cg::this_grid().sync(); } ++ph;

    PH_BEGIN
    if PHON(0) {
        LAS float* scr = (LAS float*)(ldsl + wave * 16384);
        for (int l = 0; l < DEPTH; ++l) {
            transpose_matrix<2>(w_in + (size_t)l * DM * NPROJ, DM, NPROJ, (bf16_t*)(wl + W_IN), scr, lane, gw, NGW);
            transpose_matrix<3>(mla_w_uq + (size_t)l * 512 * 768, 512, 768, (bf16_t*)(wl + W_UQ), scr, lane, gw, NGW);
            transpose_matrix<0>(mla_w_ukv + (size_t)l * 256 * 1024, 256, 1024, (bf16_t*)(wl + W_UKV), scr, lane, gw, NGW);
            transpose_matrix<0>(w_out + (size_t)l * DM * DM, DM, DM, (bf16_t*)(wl + W_OUT), scr, lane, gw, NGW);
            transpose_matrix<1>(w_gate_up + (size_t)l * DM * NGU, DM, NGU, (bf16_t*)(wl + W_GU), scr, lane, gw, NGW);
            transpose_matrix<0>(w_down + (size_t)l * FF * DM, FF, DM, (bf16_t*)(wl + W_D), scr, lane, gw, NGW);
            { u32x4* z = (u32x4*)((bf16_t*)(wl + W_IN) + (size_t)NPROJ * DM); const int n16 = (LDP - NPROJ) * DM * 2 / 16;
              for (int i = bid * 512 + tid; i < n16; i += G * 512) z[i] = (u32x4){0u, 0u, 0u, 0u}; }
        }
        const int gt = bid * 512 + tid, NT_ = G * 512;
        for (int i = gt; i < 4 * TBLN; i += NT_) { const int h = i / TBLN, d = (i % TBLN) - TOFF; const int b = t5_bucket(d);
            TBLA[i] = rel_bias[b * 8 + h] * 1.4426950408889634f;
            const int n = d < 0 ? -d : d; int mult = (n <= 64 ? 1 : 0) + (((n & 3) == 0 && n <= 256) ? 1 : 0) + (((n & 15) == 0 && n <= 1024) ? 1 : 0);
            TBLD[i] = mult ? (rel_bias[b * 8 + 4 + h] + logf((float)mult)) * 1.4426950408889634f : -1e30f; }
        for (int i = gt; i < S * 32; i += NT_) { const int pos = i >> 5, f = i & 31;
            const float inv = (float)pow(10000.0, -(double)(2 * f) / 64.0); const float ang = (float)pos * inv;
            COS[i] = (float)cos((double)ang); SIN[i] = (float)sin((double)ang); }
        if (bid == 0 && tid < DEPTH) { const float* lv = diff_lambda + tid * 256; float s1 = 0.f, s2 = 0.f;
            for (int i = 0; i < 64; ++i) { s1 += lv[i] * lv[64 + i]; s2 += lv[128 + i] * lv[192 + i]; }
            const float lam_init = 0.8f - 0.6f * expf(-0.3f * (float)tid);
            PAR[tid] = expf(s1) - expf(s2) + lam_init; PAR[4 + tid] = lam_init; }
        for (int row = gw; row < S; row += NGW) norm_row(x_in + (size_t)row * DM, norm_mix_pre, H + (size_t)row * DM, lane);
    }
    PH_END

    for (int l = 0; l < DEPTH; ++l) {
        PH_BEGIN
        if PHON(1) for (int rep_ = 0; rep_ < MK_DUP_GEMM; ++rep_) { pg8::Gemm g{H, (const bf16_t*)(wl + W_IN), S, LDP, DM}; pg8::StaticOrder So; So.init(S, LDP, G, bid);
          pg8::EpiBf16 E{PROJ, LDP};
          pg8::gemm_phase<pg8::EpiBf16, pg8::StaticOrder, true, true>(ldsl, g, So, E, wave0); }
        PH_END
        PH_BEGIN
        if PHON(2) for (int row = gw; row < S; row += NGW) {
            const bf16_t* pr = PROJ + (size_t)row * LDP;
            { const u32x4 raw = *(const u32x4*)(pr + C_BCQ + lane * 8); float v[8];
              v[0] = __uint_as_float(raw.x << 16); v[1] = __uint_as_float(raw.x & 0xffff0000u); v[2] = __uint_as_float(raw.y << 16); v[3] = __uint_as_float(raw.y & 0xffff0000u);
              v[4] = __uint_as_float(raw.z << 16); v[5] = __uint_as_float(raw.z & 0xffff0000u); v[6] = __uint_as_float(raw.w << 16); v[7] = __uint_as_float(raw.w & 0xffff0000u);
              float ss = 0.f;
#pragma unroll
              for (int i = 0; i < 8; ++i) ss += v[i] * v[i];
              const float rs = rsqrtf(wave_sum(ss) * (1.0f / 512.0f) + EPS);
              const f32x4 g0 = *(const f32x4*)(mla_q_norm + l * 512 + lane * 8), g1 = *(const f32x4*)(mla_q_norm + l * 512 + lane * 8 + 4);
              u32x4 w; w.x = pk2(v[0] * rs * g0.x, v[1] * rs * g0.y); w.y = pk2(v[2] * rs * g0.z, v[3] * rs * g0.w); w.z = pk2(v[4] * rs * g1.x, v[5] * rs * g1.y); w.w = pk2(v[6] * rs * g1.z, v[7] * rs * g1.w);
              *(u32x4*)(CQN + (size_t)row * 512 + lane * 8) = w; }
            { const u32x2 raw = *(const u32x2*)(pr + C_BCKV + lane * 4); float v[4];
              v[0] = __uint_as_float(raw.x << 16); v[1] = __uint_as_float(raw.x & 0xffff0000u); v[2] = __uint_as_float(raw.y << 16); v[3] = __uint_as_float(raw.y & 0xffff0000u);
              float ss = v[0] * v[0] + v[1] * v[1] + v[2] * v[2] + v[3] * v[3];
              const float rs = rsqrtf(wave_sum(ss) * (1.0f / 256.0f) + EPS);
              const f32x4 g0 = *(const f32x4*)(mla_kv_norm + l * 256 + lane * 4);
              u32x2 w; w.x = pk2(v[0] * rs * g0.x, v[1] * rs * g0.y); w.y = pk2(v[2] * rs * g0.z, v[3] * rs * g0.w);
              *(u32x2*)(CKVN + (size_t)row * 256 + lane * 4) = w; }
            if (lane < 32) { const float x1 = bf2f(pr[C_BKPE + lane]), x2 = bf2f(pr[C_BKPE + 32 + lane]); const float c = COS[row * 32 + lane], s = SIN[row * 32 + lane];
              KPE[(size_t)row * 64 + lane] = (bf16_t)f2bf(x1 * c - x2 * s); KPE[(size_t)row * 64 + 32 + lane] = (bf16_t)f2bf(x2 * c + x1 * s); }
            { const int hd = lane >> 4, t = lane & 15;
              head_norm_axial(pr + C_CQ + hd * 128, QC + (size_t)row * 512 + hd * 128, gqa_q_norm + l * 128, COS, SIN, row, t, QS_CD);
              const int hk = hd & 1;
              if (lane < 32) head_norm_axial(pr + C_CK + hk * 128, KC + (size_t)row * 256 + hk * 128, gqa_k_norm + l * 128, COS, SIN, row, t, 1.0f); }
        }
        PH_END
        PH_BEGIN
        if PHON(3) { pg8::Gemm g{CQN, (const bf16_t*)(wl + W_UQ), S, 768, 512}; pg8::StaticOrder So; So.init(S, 768, G, bid);
          pg8::EpiBf16 E{QB, 768};
          pg8::gemm_phase<pg8::EpiBf16, pg8::StaticOrder, true, true>(ldsl, g, So, E, wave0); }
        if PHON(4) { pg8::Gemm g{CKVN, (const bf16_t*)(wl + W_UKV), S, 1024, 256}; pg8::StaticOrder So; So.init(S, 1024, G, bid);
          pg8::EpiBf16 E{KVB, 1024};
          pg8::gemm_phase<pg8::EpiBf16, pg8::StaticOrder, true, true>(ldsl, g, So, E, wave0); }
        PH_END
        PH_BEGIN
        for (int rep_ = 0; rep_ < MK_DUP_ATT; ++rep_) {
            const float lam = PAR[l], lam_init = PAR[4 + l];
            const float L2E = 1.4426950408889634f;
            if PHON(6) for (int u = bid; u < 256; u += G) { const int xq = u & 7, hd = xq & 3, qb = (u >> 3) + 32 * (xq >> 2), q0 = qb * 256;
                { const float cb_lo = rel_bias[15 * 8 + hd] * L2E, cb_hi = rel_bias[31 * 8 + hd] * L2E;
                  att::attn_unit_A2(PROJ + (size_t)q0 * LDP + C_AQ + hd * 128, LDP, PROJ + C_AK + hd * 128, LDP, PROJ + C_AV + hd * 128, LDP, S, q0,
                                    TBLA + hd * TBLN, cb_lo, cb_hi, MIX + (size_t)q0 * DM + hd * 128, DM, lam, diff_subln + l * 128, 1.0f - lam_init, (char*)lds, wave0); }
            }
            if PHON(7) for (int u = bid; u < 256; u += G) { const int xq = u & 7, hd = xq & 3, qb = (u >> 3) + 32 * (xq >> 2), q0 = qb * 256;
                { const float sc = 0.07216878364870322f;
                  att::attn_unit<12, 0, 0, 1, 8, 1>(QB + (size_t)q0 * 768 + hd * 192, 768, KVB + hd * 256, 1024, KPE, 64, KVB + hd * 256 + 128, 1024,
                                            0, S, q0, nullptr, 0.f, 0.f, MIX + (size_t)q0 * DM + 512 + hd * 128, DM, nullptr, 0.f, nullptr, 0.f, (char*)lds, wave0, COS, SIN); }
            }
            if PHON(8) for (int u = bid; u < 256; u += G) { const int xq = u & 7, hd = xq & 3, qb = (u >> 3) + 32 * (xq >> 2), q0 = qb * 256;
                { const float sc = 0.08838834764831845f;
                  att::attn_unit<8, 0, 0, 1>(QC + (size_t)q0 * 512 + hd * 128, 512, KC + (hd >> 1) * 128, 256, nullptr, 0, PROJ + C_CV + (hd >> 1) * 128, LDP,
                                           0, S, q0, nullptr, 0.f, 0.f, MIX + (size_t)q0 * DM + 1024 + hd * 128, DM, nullptr, 0.f, nullptr, 0.f, (char*)lds, wave0); }
            }
            if PHON(9) for (int u = bid; u < 256; u += G) { const int xq = u & 7, hd = xq & 3, qb = (u >> 3) + 32 * (xq >> 2), q0 = qb * 256;
                { const float sc = 0.08838834764831845f;
                  const int kb = q0 - 1024 < 0 ? 0 : q0 - 1024, ke = q0 + 256 + 1024 > S ? S : q0 + 256 + 1024;
                  att::attn_unit<8, 1, 0, 1>(PROJ + (size_t)q0 * LDP + C_DQ + hd * 128, LDP, PROJ + C_DK + hd * 128, LDP, nullptr, 0, PROJ + C_DV + hd * 128, LDP,
                                           kb, ke - kb, q0, TBLD + hd * TBLN, 0.f, 0.f, MIX + (size_t)q0 * DM + 1536 + hd * 128, DM, nullptr, 0.f, nullptr, 0.f, (char*)lds, wave0); }
            }
            __syncthreads();
        }
        PH_END
        PH_BEGIN
        if PHON(10) for (int rep_ = 0; rep_ < MK_DUP_GEMM; ++rep_) { pg8::Gemm g{MIX, (const bf16_t*)(wl + W_OUT), S, DM, DM}; pg8::StaticOrder So; So.init(S, DM, G, bid);
          pg8::EpiBf16 E{Y, DM};
          pg8::gemm_phase<pg8::EpiBf16, pg8::StaticOrder, true, true>(ldsl, g, So, E, wave0); }
        PH_END
        PH_BEGIN
        if PHON(11) { int row = gw;
            for (; row + NGW < S; row += 2 * NGW) norm_add_rows<2>(Y, (l == 0 ? x_in : xres), xres, norm_mix_post + l * DM, norm_ffn_pre + l * DM, H, row, NGW, lane);
            for (; row < S; row += NGW) norm_add_rows<1>(Y, (l == 0 ? x_in : xres), xres, norm_mix_post + l * DM, norm_ffn_pre + l * DM, H, row, NGW, lane); }
        PH_END
        PH_BEGIN
        if PHON(12) for (int rep_ = 0; rep_ < MK_DUP_GEMM; ++rep_) { pg8::Gemm g{H, (const bf16_t*)(wl + W_GU), S, NGU, DM}; pg8::StaticOrder So; So.init(S, NGU, G, bid);
          pg8::EpiSwiGLU E{HID, FF};
          pg8::gemm_phase<pg8::EpiSwiGLU, pg8::StaticOrder, true, true>(ldsl, g, So, E, wave0); }
        PH_END
        PH_BEGIN
        if PHON(13) for (int rep_ = 0; rep_ < MK_DUP_GEMM; ++rep_) { pg8::Gemm g{HID, (const bf16_t*)(wl + W_D), S, DM, FF}; pg8::StaticOrder So; So.init(S, DM, G, bid);
          pg8::EpiBf16 E{Y, DM};
          pg8::gemm_phase<pg8::EpiBf16, pg8::StaticOrder, true, true>(ldsl, g, So, E, wave0); }
        PH_END
        PH_BEGIN
        if PHON(14) { int row = gw; const float* gnext = (l + 1 < DEPTH) ? norm_mix_pre + (l + 1) * DM : nullptr;
            for (; row + NGW < S; row += 2 * NGW) norm_add_rows<2>(Y, xres, xres, norm_ffn_post + l * DM, gnext, H, row, NGW, lane);
            for (; row < S; row += NGW) norm_add_rows<1>(Y, xres, xres, norm_ffn_post + l * DM, gnext, H, row, NGW, lane); }
        PH_END
    }
#undef PH_BEGIN
#undef PH_END
}
#undef x_in
#undef rel_bias
#undef norm_mix_pre
#undef norm_mix_post
#undef norm_ffn_pre
#undef norm_ffn_post
#undef w_in
#undef diff_lambda
#undef diff_subln
#undef mla_q_norm
#undef mla_kv_norm
#undef mla_w_uq
#undef mla_w_ukv
#undef gqa_q_norm
#undef gqa_k_norm
#undef w_out
#undef w_gate_up
#undef w_down
#undef xres
#undef ws
#undef PAR
#undef TBLA
#undef TBLD
#undef COS
#undef SIN
#undef H
#undef PROJ
#undef CQN
#undef CKVN
#undef KPE
#undef QC
#undef KC
#undef QB
#undef KVB
#undef MIX
#undef Y
#undef HID
#undef TMP
#undef wl

constexpr int N_PHASES = 1 + DEPTH * 9;

extern "C" void kernel_launch(void* const* d_in, const int* in_sizes, int n_in, void* d_out, int out_size, void* d_ws, size_t ws_size, hipStream_t stream) {
    static int grid = 0;
    if (grid == 0) {
        if (n_in != 18 || in_sizes[0] != S * DM || out_size != S * DM || ws_size < WS_END) {
            fprintf(stderr, "kernel_launch: unexpected shapes (n_in %d, in0 %d, out %d, ws %zu < %zu)\n", n_in, n_in > 0 ? in_sizes[0] : -1, out_size, ws_size, (size_t)WS_END); grid = -1; return; }
        int dev = 0, cus = 0, per_cu = 0;
        if (hipGetDevice(&dev) != hipSuccess || hipDeviceGetAttribute(&cus, hipDeviceAttributeMultiprocessorCount, dev) != hipSuccess) { grid = -1; return; }
        if (hipFuncSetAttribute((const void*)mega_fwd, hipFuncAttributeMaxDynamicSharedMemorySize, LDS_BYTES) != hipSuccess) { fprintf(stderr, "kernel_launch: hipFuncSetAttribute failed\n"); grid = -1; return; }
        if (hipOccupancyMaxActiveBlocksPerMultiprocessor(&per_cu, (const void*)mega_fwd, 512, LDS_BYTES) != hipSuccess || per_cu < 1) { fprintf(stderr, "kernel_launch: occupancy query says %d\n", per_cu); per_cu = 1; }
        (void)hipGetLastError();
        grid = cus;
    }
    if (grid < 0) return;
    Args a{};
    for (int i = 0; i < 18; ++i) a.in[i] = (const float*)d_in[i];
    a.out = (float*)d_out; a.ws = (unsigned char*)d_ws;
#if MK_MULTI
    for (int p = 0; p < N_PHASES; ++p) { a.ph_lo = p; a.ph_hi = p + 1; hipLaunchKernelGGL(mega_fwd, dim3(grid), dim3(512), LDS_BYTES, stream, a); }
#else
    a.ph_lo = 0; a.ph_hi = N_PHASES;
    void* kargs[] = {&a};
    hipError_t e = hipLaunchCooperativeKernel((const void*)mega_fwd, dim3(grid), dim3(512), kargs, LDS_BYTES, stream);
    if (e != hipSuccess) fprintf(stderr, "kernel_launch: cooperative launch failed: %s (grid %d)\n", hipGetErrorString(e), grid);
#endif
}
```

```cpp
#include <hip/hip_runtime.h>
#include <hip/hip_cooperative_groups.h>
#include <cstdio>
#include <cstdint>
namespace cg = cooperative_groups;

#ifndef MK_MULTI
#define MK_MULTI 0
#endif
#ifndef MK_PHMASK
#define MK_PHMASK 0xFFFFF
#endif
#define PHON(k) constexpr (((MK_PHMASK) >> (k)) & 1)
#ifndef MK_DUP_GEMM
#define MK_DUP_GEMM 1
#endif
#ifndef MK_DUP_ATT
#define MK_DUP_ATT 1
#endif

typedef unsigned short bf16_t;
typedef short bf16x8 __attribute__((ext_vector_type(8)));
typedef short s16x4 __attribute__((ext_vector_type(4)));
typedef float f32x2 __attribute__((ext_vector_type(2)));
typedef float f32x4 __attribute__((ext_vector_type(4)));
typedef float f32x16 __attribute__((ext_vector_type(16)));
typedef unsigned u32x2 __attribute__((ext_vector_type(2)));
typedef unsigned u32x4 __attribute__((ext_vector_type(4)));
#define LAS __attribute__((address_space(3)))

constexpr int S = 16384, DM = 2048, DEPTH = 4, NPROJ = 4928, LDP = 5120, FF = 5632, NGU = 2 * FF;
constexpr float EPS = 1e-6f;
constexpr int C_AQ = 0, C_AK = 512, C_AV = 1024, C_BCQ = 1536, C_BCKV = 2048, C_BKPE = 2304, C_CQ = 2368, C_CK = 2880, C_CV = 3136, C_DQ = 3392, C_DK = 3904, C_DV = 4416;
constexpr int TOFF = 1408, TBLN = 2824;

constexpr size_t MiB = 1u << 20;
constexpr size_t WS_PAR = 0, WS_TBLA = 1 * MiB, WS_TBLD = 1 * MiB + 65536, WS_COS = 2 * MiB, WS_SIN = 4 * MiB;
constexpr size_t WS_BAR = 6 * MiB, WS_BAR_BYTES = 16384;
constexpr size_t WS_W = 8 * MiB, LW = 96 * MiB;
constexpr size_t W_IN = 0, W_UQ = 20 * MiB, W_UKV = 21 * MiB, W_OUT = 22 * MiB, W_GU = 30 * MiB, W_D = 74 * MiB;
constexpr size_t WS_H = 392 * MiB, WS_PROJ = 456 * MiB, WS_CQN = 616 * MiB, WS_CKVN = 632 * MiB, WS_KPE = 640 * MiB, WS_QC = 642 * MiB, WS_KC = 658 * MiB;
constexpr size_t WS_QB = 666 * MiB, WS_KVB = 690 * MiB, WS_MIX = 722 * MiB, WS_Y = 786 * MiB, WS_HID = 914 * MiB, WS_TMP = 1090 * MiB, WS_END = 1122 * MiB;

constexpr int LDS_ST_OFF = 163840 - 16;
constexpr int LDS_BYTES = 163840;

__device__ __forceinline__ float bf2f(unsigned short b) { return __uint_as_float(((unsigned)b) << 16); }
__device__ __forceinline__ unsigned f2bf(float f) { unsigned u = __float_as_uint(f); return (u + 0x7fffu + ((u >> 16) & 1u)) >> 16; }
__device__ __forceinline__ unsigned pk2(float lo, float hi) { return f2bf(lo) | (f2bf(hi) << 16); }
__device__ __forceinline__ unsigned cvt_pk_bf16(float lo, float hi) { unsigned r; asm volatile("v_cvt_pk_bf16_f32 %0, %1, %2" : "=v"(r) : "v"(lo), "v"(hi)); return r; }
__device__ __forceinline__ int lane_id_v() { int l; asm volatile("v_mbcnt_lo_u32_b32 %0, -1, 0\n\tv_mbcnt_hi_u32_b32 %0, -1, %0" : "=v"(l)); return l; }
template <int M> __device__ __forceinline__ float swz_xor(float v) { return __int_as_float(__builtin_amdgcn_ds_swizzle(__float_as_int(v), (M << 10) | 0x1f)); }
__device__ __forceinline__ float wave_sum(float v) {
    v += swz_xor<1>(v); v += swz_xor<2>(v); v += swz_xor<4>(v); v += swz_xor<8>(v); v += swz_xor<16>(v);
    auto rr = __builtin_amdgcn_permlane32_swap(__float_as_uint(v), __float_as_uint(v), false, false);
    return __uint_as_float(rr[0]) + __uint_as_float(rr[1]);
}

namespace pg8 {
constexpr int BM = 256, BK = 64, HALF = 128, HTB = HALF * BK * 2, STAGE_BYTES = 8 * HTB, NXCD = 8, WGM = 8;
__host__ __device__ __forceinline__ int lds_byte(int r, int c) { const int st = (r >> 4) * 2 + (c >> 5), rr = r & 15, cc = c & 31, ob = rr * 64 + cc * 2; return st * 1024 + (ob ^ (((ob >> 9) & 1) << 5)); }
__host__ __device__ __forceinline__ void stage_rc(int b, int& R, int& C) { const int st = b / 1024, sb = b % 1024, swz = sb ^ (((sb >> 9) & 1) << 5); R = (st >> 1) * 16 + swz / 64; C = (st & 1) * 32 + (swz % 64) / 2; }
__host__ __device__ __forceinline__ int perm32(int rho) { const int n = rho >> 4, i = rho & 15; return 8 * (i >> 2) + 4 * n + (i & 3); }

struct Unit { int pm, pn; };
struct Gemm { const bf16_t* A; const bf16_t* Bt; int M, N, K; };

struct StaticOrder {
    int nM, nN, nwg, G, c;
    __host__ __device__ void init(int M, int N, int G_, int c_) { nM = M / BM; nN = N / BM; nwg = nM * nN; G = G_; c = c_; }
    __host__ __device__ bool next(int i, Unit& u) const {
        const long L = (long)i * G + c; if (L >= nwg) return false;
        int wgid = (int)L; { const int q = nwg / NXCD, r = nwg % NXCD, xcd = wgid % NXCD, off = wgid / NXCD; wgid = (xcd < r ? xcd * (q + 1) : r * (q + 1) + (xcd - r) * q) + off; }
        const int nig = WGM * nN, gid = wgid / nig, fm = gid * WGM, gsz = (nM - fm) < WGM ? (nM - fm) : WGM;
        u.pm = fm + ((wgid % nig) % gsz); u.pn = (wgid % nig) / gsz; return true;
    }
    __device__ __forceinline__ void a_ready(const Unit&) const {}
    __device__ __forceinline__ void done(const Unit&) const {}
};

struct EpiBf16 {
    static constexpr bool PERM = true, AFTER_DRAIN = false;
    bf16_t* O; int ldc;
    __device__ __forceinline__ void operator()(const f32x4 (&acc)[2][2][4][2], const Unit& u, int wr, int wc, int fr, int fq) const {
        const int row0 = u.pm * BM + wr * 64 + fr; const int col0 = u.pn * BM + wc * 32 + 8 * fq;
#pragma unroll
        for (int ai = 0; ai < 2; ++ai)
#pragma unroll
            for (int m = 0; m < 4; ++m) { bf16_t* rowp = O + (size_t)(row0 + ai * HALF + m * 16) * ldc + col0;
#pragma unroll
                for (int bj = 0; bj < 2; ++bj) { const f32x4 v0 = acc[ai][bj][m][0], v1 = acc[ai][bj][m][1];
                    u32x4 w; w.x = cvt_pk_bf16(v0[0], v0[1]); w.y = cvt_pk_bf16(v0[2], v0[3]); w.z = cvt_pk_bf16(v1[0], v1[1]); w.w = cvt_pk_bf16(v1[2], v1[3]);
                    *(u32x4*)(rowp + bj * HALF) = w; } }
    }
};
struct EpiF32 {
    static constexpr bool PERM = false, AFTER_DRAIN = false;
    float* O; int ldc;
    __device__ __forceinline__ void operator()(const f32x4 (&acc)[2][2][4][2], const Unit& u, int wr, int wc, int fr, int fq) const {
        const int row0 = u.pm * BM + wr * 64 + fr; const int col0 = u.pn * BM + wc * 32 + 4 * fq;
#pragma unroll
        for (int ai = 0; ai < 2; ++ai)
#pragma unroll
            for (int m = 0; m < 4; ++m) { float* rowp = O + (size_t)(row0 + ai * HALF + m * 16) * ldc + col0;
#pragma unroll
                for (int bj = 0; bj < 2; ++bj)
#pragma unroll
                    for (int n = 0; n < 2; ++n) *(f32x4*)(rowp + bj * HALF + n * 16) = acc[ai][bj][m][n]; }
    }
};
__device__ __forceinline__ float silu_mul(float g, float u) {
    const float e = __builtin_amdgcn_exp2f(-g * 1.4426950408889634f);
    return g * __builtin_amdgcn_rcpf(1.0f + e) * u;
}
struct EpiSwiGLU {
    static constexpr bool PERM = true, AFTER_DRAIN = false;
    bf16_t* O; int ldc;
    __device__ __forceinline__ void operator()(const f32x4 (&acc)[2][2][4][2], const Unit& u, int wr, int wc, int fr, int fq) const {
        const int row0 = u.pm * BM + wr * 64 + fr; const int col0 = u.pn * HALF + wc * 32 + 8 * fq;
#pragma unroll
        for (int ai = 0; ai < 2; ++ai)
#pragma unroll
            for (int m = 0; m < 4; ++m) { bf16_t* rowp = O + (size_t)(row0 + ai * HALF + m * 16) * ldc + col0;
                const f32x4 g0 = acc[ai][0][m][0], g1 = acc[ai][0][m][1], u0 = acc[ai][1][m][0], u1 = acc[ai][1][m][1];
                u32x4 w; w.x = cvt_pk_bf16(silu_mul(g0[0], u0[0]), silu_mul(g0[1], u0[1])); w.y = cvt_pk_bf16(silu_mul(g0[2], u0[2]), silu_mul(g0[3], u0[3]));
                w.z = cvt_pk_bf16(silu_mul(g1[0], u1[0]), silu_mul(g1[1], u1[1])); w.w = cvt_pk_bf16(silu_mul(g1[2], u1[2]), silu_mul(g1[3], u1[3]));
                *(u32x4*)rowp = w; }
    }
};

template <class Epi, class Sched, bool ALIGN_EPI = false, bool SP2 = false>
__device__ __forceinline__ void gemm_phase(LAS unsigned char* lds, const Gemm g, const Sched& S, const Epi& E, const int wave0) {
    int tid_ = wave0 * 64 + lane_id_v();
    const int tid = tid_, wid = __builtin_amdgcn_readfirstlane(tid >> 6), lane = tid & 63, wr = wid >> 2, wc = wid & 3, fr = lane & 15, fq = lane >> 4;
    int K_ = g.K; asm volatile("" : "+s"(K_));
    const int K = K_, nt = K / BK;
    unsigned voffA[2], voffB[2];
#pragma unroll
    for (int i = 0; i < 2; ++i) { int R, C; stage_rc(tid * 16 + i * 8192, R, C); const int Rb = Epi::PERM ? ((R & ~31) + perm32(R & 31)) : R;
        voffA[i] = (unsigned)(R * K + C) * 2u; voffB[i] = (unsigned)(Rb * K + C) * 2u; }
    const size_t kstep = (size_t)(BK * 2);
    const size_t hstep = (size_t)HALF * K * 2;
    const size_t tstep = 2 * hstep;
    const unsigned ldsw = (unsigned)wid * 1024u;
    const int aoff = lds_byte(wr * 64 + fr, fq * 8), boff = lds_byte(wc * 32 + fr, fq * 8);
#define PG8_SA(b, h) (((b) * 2 + (h)) * HTB)
#define PG8_SB(b, h) ((4 + (b) * 2 + (h)) * HTB)
#define PG8_STAGE(bufoff, gbase, voff) do { _Pragma("unroll") for (int _i = 0; _i < 2; ++_i) \
        __builtin_amdgcn_global_load_lds((const unsigned*)((const char*)(gbase) + (voff)[_i]), (LAS unsigned*)(lds + (bufoff) + ldsw + _i * 8192), 16, 0, 0); } while (0)
#define PG8_LDA(dst, b, h) do { _Pragma("unroll") for (int m = 0; m < 4; ++m) _Pragma("unroll") for (int k = 0; k < 2; ++k) dst[m][k] = *(const LAS bf16x8*)(lds + PG8_SA(b, h) + aoff + m * 2048 + k * 1024); } while (0)
#define PG8_LDB(dst, b, h) do { _Pragma("unroll") for (int n = 0; n < 2; ++n) _Pragma("unroll") for (int k = 0; k < 2; ++k) dst[n][k] = *(const LAS bf16x8*)(lds + PG8_SB(b, h) + boff + n * 2048 + k * 1024); } while (0)
#define PG8_MMA(ai, bj, At, Bt) do { __builtin_amdgcn_s_setprio(1); _Pragma("unroll") for (int m = 0; m < 4; ++m) _Pragma("unroll") for (int n = 0; n < 2; ++n) _Pragma("unroll") for (int k = 0; k < 2; ++k) \
        acc[ai][bj][m][n] = __builtin_amdgcn_mfma_f32_16x16x32_bf16(Bt[n][k], At[m][k], acc[ai][bj][m][n], 0, 0, 0); __builtin_amdgcn_s_setprio(0); } while (0)
#define PG8_WAIT_V(n) asm volatile("s_waitcnt vmcnt(" #n ")" ::: "memory")
#define PG8_WAIT_L(n) asm volatile("s_waitcnt lgkmcnt(" #n ")" ::: "memory")
#define PG8_BAR __builtin_amdgcn_s_barrier()
#define PG8_SCHED __builtin_amdgcn_sched_barrier(0)
    Unit cur, nxt; int ui = 0;
    if (!S.next(0, cur)) return;
    f32x4 acc[2][2][4][2];
#pragma unroll
    for (int a = 0; a < 2; ++a)
#pragma unroll
        for (int b = 0; b < 2; ++b)
#pragma unroll
            for (int m = 0; m < 4; ++m)
#pragma unroll
                for (int n = 0; n < 2; ++n) acc[a][b][m][n] = (f32x4){0.f, 0.f, 0.f, 0.f};
    bf16x8 At[4][2], B0[2][2], B1[2][2];
    const char* cA = (const char*)g.A + (size_t)cur.pm * tstep; const char* cB = (const char*)g.Bt + (size_t)cur.pn * tstep;
    S.a_ready(cur);
    if constexpr (SP2) {
        PG8_STAGE(PG8_SB(0, 0), cB, voffB); PG8_STAGE(PG8_SB(0, 1), cB + hstep, voffB); PG8_STAGE(PG8_SA(0, 0), cA, voffA); PG8_STAGE(PG8_SA(0, 1), cA + hstep, voffA);
        if (wr == 1) PG8_BAR;
        PG8_WAIT_V(2); PG8_BAR;
        PG8_STAGE(PG8_SB(1, 0), cB + kstep, voffB); PG8_STAGE(PG8_SA(1, 0), cA + kstep, voffA); PG8_STAGE(PG8_SB(1, 1), cB + hstep + kstep, voffB);
        PG8_WAIT_V(6); PG8_BAR;
    } else {
        PG8_STAGE(PG8_SB(0, 0), cB, voffB); PG8_STAGE(PG8_SA(0, 0), cA, voffA); PG8_STAGE(PG8_SB(0, 1), cB + hstep, voffB); PG8_STAGE(PG8_SA(0, 1), cA + hstep, voffA);
        if (wr == 1) PG8_BAR;
        PG8_WAIT_V(4); PG8_BAR;
        PG8_STAGE(PG8_SB(1, 0), cB + kstep, voffB); PG8_STAGE(PG8_SA(1, 0), cA + kstep, voffA); PG8_STAGE(PG8_SB(1, 1), cB + hstep + kstep, voffB);
        PG8_WAIT_V(6); PG8_BAR;
    }
    for (;;) {
        const bool has_next = S.next(ui + 1, nxt);
        const char* nA = has_next ? (const char*)g.A + (size_t)nxt.pm * tstep : cA; const char* nB = has_next ? (const char*)g.Bt + (size_t)nxt.pn * tstep : cB;
        for (int t = 0; t < nt; t += 2) {
            const bool last = (t == nt - 2);
            const char* a1 = cA + (size_t)(t + 1) * kstep;
            const char* a2 = last ? nA : cA + (size_t)(t + 2) * kstep; const char* b2 = last ? nB : cB + (size_t)(t + 2) * kstep;
            const char* a3 = a2 + kstep; const char* b3 = b2 + kstep;
            if (last && has_next) S.a_ready(nxt);
            if constexpr (SP2) {
            PG8_LDB(B0, 0, 0); PG8_LDB(B1, 0, 1); PG8_SCHED; PG8_LDA(At, 0, 0); PG8_STAGE(PG8_SA(1, 1), a1 + hstep, voffA);
            PG8_WAIT_V(8); PG8_WAIT_L(0); PG8_BAR; PG8_MMA(0, 0, At, B0); PG8_MMA(0, 1, At, B1); PG8_BAR; PG8_SCHED;
            PG8_LDA(At, 0, 1); PG8_STAGE(PG8_SB(0, 0), b2, voffB); PG8_STAGE(PG8_SB(0, 1), b2 + hstep, voffB); PG8_STAGE(PG8_SA(0, 0), a2, voffA);
            PG8_WAIT_V(8); PG8_WAIT_L(0); PG8_BAR; PG8_MMA(1, 0, At, B0); PG8_MMA(1, 1, At, B1); PG8_BAR; PG8_SCHED;
            PG8_LDB(B0, 1, 0); PG8_LDB(B1, 1, 1); PG8_SCHED; PG8_LDA(At, 1, 0); PG8_STAGE(PG8_SA(0, 1), a2 + hstep, voffA);
            PG8_WAIT_V(8); PG8_WAIT_L(0); PG8_BAR; PG8_MMA(0, 0, At, B0); PG8_MMA(0, 1, At, B1); PG8_BAR; PG8_SCHED;
            PG8_LDA(At, 1, 1); PG8_STAGE(PG8_SB(1, 0), b3, voffB); PG8_STAGE(PG8_SB(1, 1), b3 + hstep, voffB); PG8_STAGE(PG8_SA(1, 0), a3, voffA);
            PG8_WAIT_V(8); PG8_WAIT_L(0); PG8_BAR; PG8_MMA(1, 0, At, B0); PG8_MMA(1, 1, At, B1); PG8_BAR; PG8_SCHED;
            } else {
            PG8_LDB(B0, 0, 0); PG8_SCHED; PG8_LDA(At, 0, 0); PG8_STAGE(PG8_SA(1, 1), a1 + hstep, voffA);
            PG8_WAIT_L(8); PG8_BAR; PG8_WAIT_L(0); PG8_MMA(0, 0, At, B0); PG8_BAR; PG8_SCHED;
            PG8_LDB(B1, 0, 1); PG8_STAGE(PG8_SB(0, 0), b2, voffB);
            PG8_BAR; PG8_WAIT_L(0); PG8_MMA(0, 1, At, B1); PG8_BAR;
            PG8_LDA(At, 0, 1); PG8_STAGE(PG8_SA(0, 0), a2, voffA);
            PG8_BAR; PG8_WAIT_L(0); PG8_MMA(1, 0, At, B0); PG8_BAR; PG8_SCHED;
            PG8_STAGE(PG8_SB(0, 1), b2 + hstep, voffB);
            PG8_WAIT_V(6); PG8_BAR; PG8_MMA(1, 1, At, B1); PG8_BAR;
            PG8_LDB(B0, 1, 0); PG8_SCHED; PG8_LDA(At, 1, 0); PG8_STAGE(PG8_SA(0, 1), a2 + hstep, voffA);
            PG8_WAIT_L(8); PG8_BAR; PG8_WAIT_L(0); PG8_MMA(0, 0, At, B0); PG8_BAR; PG8_SCHED;
            PG8_LDB(B1, 1, 1); PG8_STAGE(PG8_SB(1, 0), b3, voffB);
            PG8_BAR; PG8_WAIT_L(0); PG8_MMA(0, 1, At, B1); PG8_BAR;
            PG8_LDA(At, 1, 1); PG8_STAGE(PG8_SA(1, 0), a3, voffA);
            PG8_BAR; PG8_WAIT_L(0); PG8_MMA(1, 0, At, B0); PG8_BAR; PG8_SCHED;
            PG8_STAGE(PG8_SB(1, 1), b3 + hstep, voffB);
            PG8_WAIT_V(6); PG8_BAR; PG8_MMA(1, 1, At, B1); PG8_BAR;
            }
        }
        if constexpr (ALIGN_EPI) { if (wr == 0) PG8_BAR; }
        if constexpr (!Epi::AFTER_DRAIN) { E(acc, cur, wr, wc, fr, fq); S.done(cur); }
        if (!has_next) break;
#pragma unroll
        for (int a = 0; a < 2; ++a)
#pragma unroll
            for (int b = 0; b < 2; ++b)
#pragma unroll
                for (int m = 0; m < 4; ++m)
#pragma unroll
                    for (int n = 0; n < 2; ++n) acc[a][b][m][n] = (f32x4){0.f, 0.f, 0.f, 0.f};
        cur = nxt; cA = nA; cB = nB; ++ui;
        if constexpr (ALIGN_EPI) { if (wr == 1) PG8_BAR; }
    }
    PG8_WAIT_V(0);
    if constexpr (!ALIGN_EPI) { if (wr == 0) PG8_BAR; }
    PG8_BAR;
#undef PG8_SA
#undef PG8_SB
#undef PG8_STAGE
#undef PG8_LDA
#undef PG8_LDB
#undef PG8_MMA
#undef PG8_WAIT_V
#undef PG8_WAIT_L
#undef PG8_BAR
#undef PG8_SCHED
}
}

namespace att {
constexpr int NW = 8, QBLK = 32, KVBLK = 64;
constexpr int SHM_V = KVBLK * 128 * 2;
#define SBAR() __builtin_amdgcn_sched_barrier(0)
__device__ __forceinline__ int crow(int r, int hi) { return (r & 3) + 8 * (r >> 2) + 4 * hi; }
__device__ __forceinline__ unsigned cvtpk(float lo, float hi) { unsigned r; asm volatile("v_cvt_pk_bf16_f32 %0, %1, %2" : "=v"(r) : "v"(lo), "v"(hi)); return r; }

constexpr float THR2 = 8.0f * 1.4426950408889634f;
template <bool FIRST>
__device__ __forceinline__ void partialSM(f32x16& p0, f32x16& p1, float& mC, float& alpha) {
  float pmax = p0[0];
#pragma unroll
  for (int r = 1; r < 16; ++r) pmax = fmaxf(pmax, p0[r]);
#pragma unroll
  for (int r = 0; r < 16; ++r) pmax = fmaxf(pmax, p1[r]);
  { auto rr = __builtin_amdgcn_permlane32_swap(__float_as_uint(pmax), __float_as_uint(pmax), false, false);
    pmax = fmaxf(__uint_as_float(rr[0]), __uint_as_float(rr[1])); }
  if (!FIRST && __builtin_expect(__all(pmax <= THR2), 1)) { alpha = 1.f; }
  else { const float delta = FIRST ? fmaxf(pmax, -200.f) : fmaxf(pmax, 0.f); alpha = FIRST ? 1.f : __builtin_amdgcn_exp2f(-delta); mC += delta;
#pragma unroll
    for (int r = 0; r < 16; ++r) p0[r] -= delta;
#pragma unroll
    for (int r = 0; r < 16; ++r) p1[r] -= delta; }
#pragma unroll
  for (int r = 0; r < 16; ++r) p0[r] = __builtin_amdgcn_exp2f(p0[r]);
}
__device__ __forceinline__ void finishSM(f32x16& p0, f32x16& p1, float alpha, float& l_reg, bf16x8& pa0, bf16x8& pa1, bf16x8& pa2, bf16x8& pa3) {
#pragma unroll
  for (int r = 0; r < 16; ++r) p1[r] = __builtin_amdgcn_exp2f(p1[r]);
  float ps = 0;
#pragma unroll
  for (int r = 0; r < 16; ++r) ps += p0[r];
#pragma unroll
  for (int r = 0; r < 16; ++r) ps += p1[r];
  { auto rr = __builtin_amdgcn_permlane32_swap(__float_as_uint(ps), __float_as_uint(ps), false, false);
    ps = __uint_as_float(rr[0]) + __uint_as_float(rr[1]); }
  l_reg = l_reg * alpha + ps;
#define PK4(P, BASE, OUT) do { unsigned a0 = cvtpk(P[BASE + 0], P[BASE + 1]), a1 = cvtpk(P[BASE + 2], P[BASE + 3]);   \
    unsigned b0 = cvtpk(P[BASE + 4], P[BASE + 5]), b1 = cvtpk(P[BASE + 6], P[BASE + 7]);                              \
    auto r0 = __builtin_amdgcn_permlane32_swap(a0, b0, false, false); auto r1 = __builtin_amdgcn_permlane32_swap(a1, b1, false, false); \
    u32x4 w = {r0[0], r1[0], r0[1], r1[1]}; OUT = *reinterpret_cast<bf16x8*>(&w); } while (0)
  PK4(p0, 0, pa0); PK4(p0, 8, pa1); PK4(p1, 0, pa2); PK4(p1, 8, pa3);
#undef PK4
}
template <int NDQ, int NQL>
__device__ __forceinline__ void qkt(f32x16& p0, f32x16& p1, const f32x16& negm, const char* Ks, const bf16x8* qr, const char* qls, int r32, int hi) {
  constexpr int ROWB = NDQ * 32, NQR = NDQ - NQL, SWM = (NDQ == 8) ? 15 : 7;
#pragma unroll
  for (int d0 = 0; d0 < NDQ; ++d0) { const int cb = (d0 * 16 + hi * 8) * 2;
    bf16x8 b0 = *reinterpret_cast<const bf16x8*>(Ks + r32 * ROWB + (cb ^ ((r32 & SWM) << 4)));
    bf16x8 b1 = *reinterpret_cast<const bf16x8*>(Ks + (32 + r32) * ROWB + (cb ^ ((r32 & SWM) << 4)));
    bf16x8 q;
    if constexpr (NQL > 0) { if (d0 < NQR) q = qr[d0 < NQR ? d0 : 0]; else q = *reinterpret_cast<const bf16x8*>(qls + (d0 - NQR) * 1024); }
    else q = qr[d0];
    if (d0 == 0) { p0 = __builtin_amdgcn_mfma_f32_32x32x16_bf16(b0, q, negm, 0, 0, 0); p1 = __builtin_amdgcn_mfma_f32_32x32x16_bf16(b1, q, negm, 0, 0, 0); }
    else { p0 = __builtin_amdgcn_mfma_f32_32x32x16_bf16(b0, q, p0, 0, 0, 0); p1 = __builtin_amdgcn_mfma_f32_32x32x16_bf16(b1, q, p1, 0, 0, 0); } }
}
__device__ __forceinline__ int v_st(int k, int c) { const int kk = (k & ~0xC) | ((k & 4) << 1) | ((k & 8) >> 1); return ((kk >> 3) * 4 + (c >> 5)) * 512 + ((kk & 7) * 32 + (c & 31)) * 2; }
__device__ __forceinline__ int v_rd_base(int lane) { return ((lane & 3) << 3) | (((lane >> 2) & 3) << 6) | (((lane >> 4) & 1) << 5) | (((lane >> 5) & 1) << 8); }
constexpr int v_rd_off(int d0, int ks, int half) { return d0 * 512 + ks * 4096 + half * 2048; }
template <int OFF> __device__ __forceinline__ s16x4 tr_read(int vb) {
  s16x4 r; asm volatile("ds_read_b64_tr_b16 %0, %1 offset:%2" : "=&v"(r) : "v"(vb), "i"(OFF) : "memory"); return r;
}
template <int D0> __device__ __forceinline__ void pv_one(f32x16& od, int vb, bf16x8 pa0, bf16x8 pa1, bf16x8 pa2, bf16x8 pa3) {
  const s16x4 l0 = tr_read<v_rd_off(D0, 0, 0)>(vb), h0 = tr_read<v_rd_off(D0, 0, 1)>(vb), l1 = tr_read<v_rd_off(D0, 1, 0)>(vb), h1 = tr_read<v_rd_off(D0, 1, 1)>(vb);
  const s16x4 l2 = tr_read<v_rd_off(D0, 2, 0)>(vb), h2 = tr_read<v_rd_off(D0, 2, 1)>(vb), l3 = tr_read<v_rd_off(D0, 3, 0)>(vb), h3 = tr_read<v_rd_off(D0, 3, 1)>(vb);
  asm volatile("s_waitcnt lgkmcnt(0)" ::: "memory"); SBAR();
#define PK(L, H) (bf16x8){L[0], L[1], L[2], L[3], H[0], H[1], H[2], H[3]}
  od = __builtin_amdgcn_mfma_f32_32x32x16_bf16(pa0, PK(l0, h0), od, 0, 0, 0);
  od = __builtin_amdgcn_mfma_f32_32x32x16_bf16(pa1, PK(l1, h1), od, 0, 0, 0);
  od = __builtin_amdgcn_mfma_f32_32x32x16_bf16(pa2, PK(l2, h2), od, 0, 0, 0);
  od = __builtin_amdgcn_mfma_f32_32x32x16_bf16(pa3, PK(l3, h3), od, 0, 0, 0);
#undef PK
}
__device__ __forceinline__ void pv_d0(f32x16* o, int vb, bf16x8 pa0, bf16x8 pa1, bf16x8 pa2, bf16x8 pa3) {
  pv_one<0>(o[0], vb, pa0, pa1, pa2, pa3); pv_one<1>(o[1], vb, pa0, pa1, pa2, pa3); pv_one<2>(o[2], vb, pa0, pa1, pa2, pa3); pv_one<3>(o[3], vb, pa0, pa1, pa2, pa3);
}

constexpr int LDS_K_OFF = 2 * SHM_V, LDS_WS_OFF = LDS_K_OFF + 2 * 12 * 2048, LDS_TBL_OFF = LDS_WS_OFF + NW * 64 * 4, LDS_Q_OFF = LDS_TBL_OFF + ((TBLN * 4 + 15) / 16) * 16;
static_assert(LDS_Q_OFF + NW * 8192 <= 163840, "attention LDS map");

template <int NDQ, int BIAS, int EPI, int SDEPTH, int NQL = 0, int ROPEQ = 0>
__device__ __forceinline__ void attn_unit(const bf16_t* __restrict__ Qb, int ldq, const bf16_t* __restrict__ Kh, int ldk, const bf16_t* __restrict__ K2, int ldk2,
                                          const bf16_t* __restrict__ Vh, int ldv, int kbeg, int nkeys, int q0, const float* __restrict__ tblg, float cb_lo, float cb_hi,
                                          bf16_t* __restrict__ Obf, int ldo, float* __restrict__ tmp, float lam, const float* __restrict__ subln, float post, char* lds, const int wave0, const float* __restrict__ cosp = nullptr, const float* __restrict__ sinp = nullptr) {
  constexpr int ROWB = NDQ * 32, SHM_K = 64 * ROWB;
  int tid_ = wave0 * 64 + lane_id_v();
  const int tid = tid_, wid = tid >> 6, lane = tid & 63, r32 = lane & 31, hi = lane >> 5;
  char* V_lds = lds; char* K_lds = lds + LDS_K_OFF;
  float* ws = (float*)(lds + LDS_WS_OFF) + wid * 64; float* li_l = ws; float* al_l = ws + 32;
  float* tbl_l = (float*)(lds + LDS_TBL_OFF);
  __syncthreads();
  if constexpr (BIAS) { for (int i = tid; i < TBLN; i += 512) tbl_l[i] = tblg[i]; }
  float mC = 0.f, l_reg = 0, nm_cur = 0.f; f32x16 o[4] = {}; f32x16 negm = {}; bf16x8 qr[NDQ - NQL];
  const bf16_t* Qw = Qb + (long)(wid * QBLK + r32) * ldq + hi * 8;
  char* qls = lds + LDS_Q_OFF + wid * 8192 + lane * 16;
#pragma unroll
  for (int d0 = 0; d0 < NDQ - NQL; ++d0) qr[d0] = *reinterpret_cast<const bf16x8*>(Qw + d0 * 16);
  if constexpr (ROPEQ) {
    static_assert(NDQ == 12 && NQL >= 4, "ROPEQ: MLA layout");
#pragma unroll
    for (int d0 = NDQ - NQL; d0 < 8; ++d0) *reinterpret_cast<bf16x8*>(qls + (d0 - (NDQ - NQL)) * 1024) = *reinterpret_cast<const bf16x8*>(Qw + d0 * 16);
    const int qrow = q0 + wid * QBLK + r32;
#pragma unroll
    for (int pr = 0; pr < 2; ++pr) {
      const bf16x8 xa = *reinterpret_cast<const bf16x8*>(Qw + (8 + pr) * 16), xb = *reinterpret_cast<const bf16x8*>(Qw + (10 + pr) * 16);
      const float* cp = cosp + (size_t)qrow * 32 + pr * 16 + hi * 8; const float* sp = sinp + (size_t)qrow * 32 + pr * 16 + hi * 8;
      const f32x4 c0 = *(const f32x4*)cp, c1 = *(const f32x4*)(cp + 4), s0 = *(const f32x4*)sp, s1 = *(const f32x4*)(sp + 4);
      float ya[8], yb[8];
#pragma unroll
      for (int t = 0; t < 8; ++t) { const float x1 = bf2f((unsigned short)xa[t]), x2 = bf2f((unsigned short)xb[t]); const float c = t < 4 ? c0[t & 3] : c1[t & 3], sn = t < 4 ? s0[t & 3] : s1[t & 3];
        ya[t] = x1 * c - x2 * sn; yb[t] = x2 * c + x1 * sn; }
      u32x4 wa = {pk2(ya[0], ya[1]), pk2(ya[2], ya[3]), pk2(ya[4], ya[5]), pk2(ya[6], ya[7])}, wb = {pk2(yb[0], yb[1]), pk2(yb[2], yb[3]), pk2(yb[4], yb[5]), pk2(yb[6], yb[7])};
      *reinterpret_cast<u32x4*>(qls + (8 + pr - (NDQ - NQL)) * 1024) = wa; *reinterpret_cast<u32x4*>(qls + (10 + pr - (NDQ - NQL)) * 1024) = wb; }
  } else {
#pragma unroll
  for (int d0 = NDQ - NQL; d0 < NDQ; ++d0) *reinterpret_cast<bf16x8*>(qls + (d0 - (NDQ - NQL)) * 1024) = *reinterpret_cast<const bf16x8*>(Qw + d0 * 16);
  }
  const int sr = tid >> 4, sc = (tid & 15) * 8, vst0 = v_st(sr, sc), vst1 = v_st(32 + sr, sc);
  const int sr8 = tid >> 3, sc8 = (tid & 7) * 8;
  const int vb0 = (int)(uintptr_t)V_lds + v_rd_base(lane);
  const int qlane = q0 + wid * QBLK + r32;
  struct { bf16x8 vs0, vs1, ks0, ks1, ks2; } sr_[SDEPTH];
  constexpr int SWM = (NDQ == 8) ? 15 : 7;
#define KSWZ(row, colB) ((row) * ROWB + ((colB) ^ (((row) & SWM) << 4)))
#define SLOAD(i, k0) do { sr_[i].vs0 = *reinterpret_cast<const bf16x8*>(&Vh[(long)((k0) + sr) * ldv + sc]); sr_[i].vs1 = *reinterpret_cast<const bf16x8*>(&Vh[(long)((k0) + 32 + sr) * ldv + sc]); \
    if constexpr (NDQ == 4) { sr_[i].ks0 = *reinterpret_cast<const bf16x8*>(&Kh[(long)((k0) + sr8) * ldk + sc8]); } \
    else { sr_[i].ks0 = *reinterpret_cast<const bf16x8*>(&Kh[(long)((k0) + sr) * ldk + sc]); sr_[i].ks1 = *reinterpret_cast<const bf16x8*>(&Kh[(long)((k0) + 32 + sr) * ldk + sc]); \
      if constexpr (NDQ == 12) { sr_[i].ks2 = *reinterpret_cast<const bf16x8*>(&K2[(long)((k0) + sr8) * ldk2 + sc8]); } } } while (0)
#define SWRITE(b, i) do { *(bf16x8*)(V_lds + (b) * SHM_V + vst0) = sr_[i].vs0; *(bf16x8*)(V_lds + (b) * SHM_V + vst1) = sr_[i].vs1; \
    if constexpr (NDQ == 4) { *(bf16x8*)(K_lds + (b) * SHM_K + KSWZ(sr8, sc8 * 2)) = sr_[i].ks0; } \
    else { *(bf16x8*)(K_lds + (b) * SHM_K + KSWZ(sr, sc * 2)) = sr_[i].ks0; *(bf16x8*)(K_lds + (b) * SHM_K + KSWZ(32 + sr, sc * 2)) = sr_[i].ks1; \
      if constexpr (NDQ == 12) { *(bf16x8*)(K_lds + (b) * SHM_K + KSWZ(sr8, 256 + sc8 * 2)) = sr_[i].ks2; } } } while (0)
#define SWAIT() do { if constexpr (SDEPTH == 2) { if constexpr (NDQ == 4) asm volatile("s_waitcnt vmcnt(3)" ::: "memory"); else if constexpr (NDQ == 8) asm volatile("s_waitcnt vmcnt(4)" ::: "memory"); else asm volatile("s_waitcnt vmcnt(5)" ::: "memory"); } \
    else asm volatile("s_waitcnt vmcnt(0)" ::: "memory"); } while (0)
#define RESC(a) do { if (__any((a) < 1.f)) { if (hi == 0) al_l[r32] = (a); asm volatile("s_waitcnt lgkmcnt(0)" ::: "memory"); \
    _Pragma("unroll") for (int d = 0; d < 4; ++d) _Pragma("unroll") for (int r = 0; r < 16; ++r) o[d][r] *= al_l[crow(r, hi)]; } } while (0)
#define BIASADD(P0, P1, kt0) do { if constexpr (BIAS) { const int dlo_ = (kt0) - q0 - 255, dhi_ = (kt0) + 63 - q0; \
    if (!(dlo_ >= 1024) && !(dhi_ <= -1024)) { const float* tb_ = tbl_l + ((kt0) - qlane + TOFF + 4 * hi); \
      _Pragma("unroll") for (int r = 0; r < 16; ++r) { P0[r] += tb_[(r & 3) + 8 * (r >> 2)]; P1[r] += tb_[32 + (r & 3) + 8 * (r >> 2)]; } } } } while (0)
#define NEGM_UPD(kt0) do { float nmj_ = -mC; if constexpr (BIAS) { const int dlo_ = (kt0) - q0 - 255, dhi_ = (kt0) + 63 - q0; if (dlo_ >= 1024) nmj_ += cb_hi; else if (dhi_ <= -1024) nmj_ += cb_lo; } \
    if (__any(nmj_ != nm_cur)) { nm_cur = nmj_; _Pragma("unroll") for (int r = 0; r < 16; ++r) negm[r] = nmj_; } } while (0)
  f32x16 pA0, pA1, pB0, pB1; float alA, alB; bf16x8 pa0, pa1, pa2, pa3; const int NT = nkeys / KVBLK;
  constexpr int SE = 0, SO = SDEPTH - 1;
  SLOAD(SE, kbeg); asm volatile("s_waitcnt vmcnt(0)" ::: "memory"); SWRITE(0, SE); __syncthreads();
  NEGM_UPD(kbeg); qkt<NDQ, NQL>(pA0, pA1, negm, K_lds, qr, qls, r32, hi); BIASADD(pA0, pA1, kbeg); partialSM<true>(pA0, pA1, mC, alA);
  SLOAD(SO, kbeg + KVBLK); if constexpr (SDEPTH == 2) { if (2 < NT) SLOAD(SE, kbeg + 2 * KVBLK); }
  SWAIT(); SWRITE(1, SO); __syncthreads();
  for (int j = 1; j + 1 < NT; j += 2) {
    NEGM_UPD(kbeg + j * KVBLK); SBAR(); qkt<NDQ, NQL>(pB0, pB1, negm, K_lds + SHM_K, qr, qls, r32, hi);
    finishSM(pA0, pA1, alA, l_reg, pa0, pa1, pa2, pa3); SBAR();
    SLOAD(SO, kbeg + (j + SDEPTH) * KVBLK); SBAR();
    pv_d0(o, vb0, pa0, pa1, pa2, pa3); BIASADD(pB0, pB1, kbeg + j * KVBLK); partialSM<false>(pB0, pB1, mC, alB);
    __syncthreads(); SWAIT(); SWRITE(0, SE);
    RESC(alB); __syncthreads();
    NEGM_UPD(kbeg + (j + 1) * KVBLK); SBAR(); qkt<NDQ, NQL>(pA0, pA1, negm, K_lds, qr, qls, r32, hi);
    finishSM(pB0, pB1, alB, l_reg, pa0, pa1, pa2, pa3); SBAR();
    if (SDEPTH == 1 || j + 3 < NT) SLOAD(SE, kbeg + (j + 1 + SDEPTH) * KVBLK); SBAR();
    pv_d0(o, vb0 + (int)SHM_V, pa0, pa1, pa2, pa3); BIASADD(pA0, pA1, kbeg + (j + 1) * KVBLK); partialSM<false>(pA0, pA1, mC, alA);
    __syncthreads(); SWAIT(); SWRITE(1, SO);
    RESC(alA); __syncthreads();
  }
  NEGM_UPD(kbeg + (NT - 1) * KVBLK); SBAR(); qkt<NDQ, NQL>(pB0, pB1, negm, K_lds + SHM_K, qr, qls, r32, hi);
  finishSM(pA0, pA1, alA, l_reg, pa0, pa1, pa2, pa3); SBAR();
  pv_d0(o, vb0, pa0, pa1, pa2, pa3); BIASADD(pB0, pB1, kbeg + (NT - 1) * KVBLK); partialSM<false>(pB0, pB1, mC, alB);
  __syncthreads(); RESC(alB);
  finishSM(pB0, pB1, alB, l_reg, pa0, pa1, pa2, pa3); SBAR();
  pv_d0(o, vb0 + (int)SHM_V, pa0, pa1, pa2, pa3);
  if (hi == 0) li_l[r32] = l_reg; asm volatile("s_waitcnt lgkmcnt(0)" ::: "memory");
  float rli[16];
#pragma unroll
  for (int r = 0; r < 16; ++r) rli[r] = __builtin_amdgcn_rcpf(li_l[crow(r, hi)]);
  if constexpr (EPI == 0) {
    bf16_t* Ow = Obf + (long)(wid * QBLK) * ldo;
#pragma unroll
    for (int r = 0; r < 16; ++r) { const int orow = crow(r, hi);
#pragma unroll
      for (int d0 = 0; d0 < 4; ++d0) Ow[(long)orow * ldo + d0 * 32 + r32] = (bf16_t)f2bf(o[d0][r] * rli[r]); }
  } else if constexpr (EPI == 1) {
    float* Tw = tmp + (wid * QBLK) * 128;
#pragma unroll
    for (int r = 0; r < 16; ++r) { const int orow = crow(r, hi);
#pragma unroll
      for (int d0 = 0; d0 < 4; ++d0) Tw[orow * 128 + d0 * 32 + r32] = o[d0][r] * rli[r]; }
  } else {
    const float* Tw = tmp + (wid * QBLK) * 128; bf16_t* Ow = Obf + (long)(wid * QBLK) * ldo;
    float sg[4];
#pragma unroll
    for (int d0 = 0; d0 < 4; ++d0) sg[d0] = subln[d0 * 32 + r32] * post;
#pragma unroll
    for (int r = 0; r < 16; ++r) { const int orow = crow(r, hi); float v[4]; float ss = 0.f;
#pragma unroll
      for (int d0 = 0; d0 < 4; ++d0) { v[d0] = Tw[orow * 128 + d0 * 32 + r32] - lam * (o[d0][r] * rli[r]); ss += v[d0] * v[d0]; }
      ss += swz_xor<1>(ss); ss += swz_xor<2>(ss); ss += swz_xor<4>(ss); ss += swz_xor<8>(ss); ss += swz_xor<16>(ss);
      const float rs = rsqrtf(ss * (1.0f / 128.0f) + EPS);
#pragma unroll
      for (int d0 = 0; d0 < 4; ++d0) Ow[(long)orow * ldo + d0 * 32 + r32] = (bf16_t)f2bf(v[d0] * rs * sg[d0]); }
  }
#undef KSWZ
#undef SLOAD
#undef SWRITE
#undef SWAIT
#undef RESC
#undef BIASADD
#undef NEGM_UPD
}

template <int M>
__device__ __forceinline__ void qkt_map(f32x16& p0, f32x16& p1, const char* Ks, const char* qls, int r32, int hi) {
  p0 = f32x16{}; p1 = f32x16{};
#pragma unroll
  for (int d0 = 0; d0 < 4; ++d0) { const int cb = (M * 64 + d0 * 16 + hi * 8) * 2;
    bf16x8 b0 = *reinterpret_cast<const bf16x8*>(Ks + r32 * 256 + (cb ^ ((r32 & 15) << 4)));
    bf16x8 b1 = *reinterpret_cast<const bf16x8*>(Ks + (32 + r32) * 256 + (cb ^ ((r32 & 15) << 4)));
    bf16x8 q = *reinterpret_cast<const bf16x8*>(qls + (M * 4 + d0) * 1024);
    p0 = __builtin_amdgcn_mfma_f32_32x32x16_bf16(b0, q, p0, 0, 0, 0);
    p1 = __builtin_amdgcn_mfma_f32_32x32x16_bf16(b1, q, p1, 0, 0, 0);
    if (d0 == 1) SBAR(); }
}
__device__ __forceinline__ void softmax_tile(f32x16& p0, f32x16& p1, float& m, float& l, float& alpha, float cb, bf16x8& pa0, bf16x8& pa1, bf16x8& pa2, bf16x8& pa3) {
  float pmax = p0[0];
#pragma unroll
  for (int r = 1; r < 16; ++r) pmax = fmaxf(pmax, p0[r]);
#pragma unroll
  for (int r = 0; r < 16; ++r) pmax = fmaxf(pmax, p1[r]);
  { auto rr = __builtin_amdgcn_permlane32_swap(__float_as_uint(pmax), __float_as_uint(pmax), false, false);
    pmax = fmaxf(__uint_as_float(rr[0]), __uint_as_float(rr[1])); }
  pmax += cb;
  float mn;
  if (__builtin_expect(__all(pmax - m <= THR2), 1)) { mn = m; alpha = 1.f; }
  else { mn = fmaxf(m, pmax); alpha = __builtin_amdgcn_exp2f(m - mn); m = mn; }
  const float off = cb - mn;
#pragma unroll
  for (int r = 0; r < 16; ++r) p0[r] = __builtin_amdgcn_exp2f(p0[r] + off);
#pragma unroll
  for (int r = 0; r < 16; ++r) p1[r] = __builtin_amdgcn_exp2f(p1[r] + off);
  float ps = 0;
#pragma unroll
  for (int r = 0; r < 16; ++r) ps += p0[r];
#pragma unroll
  for (int r = 0; r < 16; ++r) ps += p1[r];
  { auto rr = __builtin_amdgcn_permlane32_swap(__float_as_uint(ps), __float_as_uint(ps), false, false);
    ps = __uint_as_float(rr[0]) + __uint_as_float(rr[1]); }
  l = l * alpha + ps;
#define PK4(P, BASE, OUT) do { unsigned a0 = cvtpk(P[BASE + 0], P[BASE + 1]), a1 = cvtpk(P[BASE + 2], P[BASE + 3]);   \
    unsigned b0 = cvtpk(P[BASE + 4], P[BASE + 5]), b1 = cvtpk(P[BASE + 6], P[BASE + 7]);                              \
    auto r0 = __builtin_amdgcn_permlane32_swap(a0, b0, false, false); auto r1 = __builtin_amdgcn_permlane32_swap(a1, b1, false, false); \
    u32x4 w = {r0[0], r1[0], r0[1], r1[1]}; OUT = *reinterpret_cast<bf16x8*>(&w); } while (0)
  PK4(p0, 0, pa0); PK4(p0, 8, pa1); PK4(p1, 0, pa2); PK4(p1, 8, pa3);
#undef PK4
}
template <int D0> __device__ __forceinline__ void pv2_one(f32x16& oa, f32x16& ob, int vb, bf16x8 pa0, bf16x8 pa1, bf16x8 pa2, bf16x8 pa3, bf16x8 pb0, bf16x8 pb1, bf16x8 pb2, bf16x8 pb3) {
  const s16x4 l0 = tr_read<v_rd_off(D0, 0, 0)>(vb), h0 = tr_read<v_rd_off(D0, 0, 1)>(vb), l1 = tr_read<v_rd_off(D0, 1, 0)>(vb), h1 = tr_read<v_rd_off(D0, 1, 1)>(vb);
  const s16x4 l2 = tr_read<v_rd_off(D0, 2, 0)>(vb), h2 = tr_read<v_rd_off(D0, 2, 1)>(vb), l3 = tr_read<v_rd_off(D0, 3, 0)>(vb), h3 = tr_read<v_rd_off(D0, 3, 1)>(vb);
  asm volatile("s_waitcnt lgkmcnt(0)" ::: "memory"); SBAR();
#define PK(L, H) (bf16x8){L[0], L[1], L[2], L[3], H[0], H[1], H[2], H[3]}
  const bf16x8 v0 = PK(l0, h0), v1 = PK(l1, h1), v2 = PK(l2, h2), v3 = PK(l3, h3);
  oa = __builtin_amdgcn_mfma_f32_32x32x16_bf16(pa0, v0, oa, 0, 0, 0);
  ob = __builtin_amdgcn_mfma_f32_32x32x16_bf16(pb0, v0, ob, 0, 0, 0);
  oa = __builtin_amdgcn_mfma_f32_32x32x16_bf16(pa1, v1, oa, 0, 0, 0);
  ob = __builtin_amdgcn_mfma_f32_32x32x16_bf16(pb1, v1, ob, 0, 0, 0);
  oa = __builtin_amdgcn_mfma_f32_32x32x16_bf16(pa2, v2, oa, 0, 0, 0);
  ob = __builtin_amdgcn_mfma_f32_32x32x16_bf16(pb2, v2, ob, 0, 0, 0);
  oa = __builtin_amdgcn_mfma_f32_32x32x16_bf16(pa3, v3, oa, 0, 0, 0);
  ob = __builtin_amdgcn_mfma_f32_32x32x16_bf16(pb3, v3, ob, 0, 0, 0);
#undef PK
}
__device__ __forceinline__ void attn_unit_A2(const bf16_t* __restrict__ Qb, int ldq, const bf16_t* __restrict__ Kh, int ldk, const bf16_t* __restrict__ Vh, int ldv, int nkeys, int q0,
                                             const float* __restrict__ tblg, float cb_lo, float cb_hi, bf16_t* __restrict__ Obf, int ldo, float lam, const float* __restrict__ subln, float post, char* lds, const int wave0) {
  constexpr int ROWB = 256, SHM_K = 64 * ROWB;
  int tid_ = wave0 * 64 + lane_id_v();
  const int tid = tid_, wid = tid >> 6, lane = tid & 63, r32 = lane & 31, hi = lane >> 5;
  char* V_lds = lds; char* K_lds = lds + LDS_K_OFF;
  float* ws = (float*)(lds + LDS_WS_OFF) + wid * 64; float* sl0 = ws; float* sl1 = ws + 32;
  float* tbl_l = (float*)(lds + LDS_TBL_OFF);
  char* qls = lds + LDS_Q_OFF + wid * 8192 + lane * 16;
  __syncthreads();
  for (int i = tid; i < TBLN; i += 512) tbl_l[i] = tblg[i];
  { const bf16_t* Qw = Qb + (long)(wid * QBLK + r32) * ldq + hi * 8;
#pragma unroll
    for (int i = 0; i < 8; ++i) *reinterpret_cast<bf16x8*>(qls + i * 1024) = *reinterpret_cast<const bf16x8*>(Qw + i * 16); }
  float m0 = -1e30f, m1 = -1e30f, l0 = 0.f, l1 = 0.f; f32x16 oa[4] = {}, ob[4] = {};
  const int sr = tid >> 4, sc = (tid & 15) * 8, vst0 = v_st(sr, sc), vst1 = v_st(32 + sr, sc);
  const int vb0 = (int)(uintptr_t)V_lds + v_rd_base(lane);
  const int qlane = q0 + wid * QBLK + r32;
  bf16x8 vs0, vs1, ks0, ks1;
#define KSWZ(row, colB) ((row) * ROWB + ((colB) ^ (((row) & 15) << 4)))
#define SLOAD2(k0) do { vs0 = *reinterpret_cast<const bf16x8*>(&Vh[(long)((k0) + sr) * ldv + sc]); vs1 = *reinterpret_cast<const bf16x8*>(&Vh[(long)((k0) + 32 + sr) * ldv + sc]); \
    ks0 = *reinterpret_cast<const bf16x8*>(&Kh[(long)((k0) + sr) * ldk + sc]); ks1 = *reinterpret_cast<const bf16x8*>(&Kh[(long)((k0) + 32 + sr) * ldk + sc]); } while (0)
#define SWRITE2(b) do { *(bf16x8*)(V_lds + (b) * SHM_V + vst0) = vs0; *(bf16x8*)(V_lds + (b) * SHM_V + vst1) = vs1; \
    *(bf16x8*)(K_lds + (b) * SHM_K + KSWZ(sr, sc * 2)) = ks0; *(bf16x8*)(K_lds + (b) * SHM_K + KSWZ(32 + sr, sc * 2)) = ks1; } while (0)
#define RESC2(O, SL, a) do { if (__any((a) < 1.f)) { if (hi == 0) SL[r32] = (a); asm volatile("s_waitcnt lgkmcnt(0)" ::: "memory"); \
    _Pragma("unroll") for (int d = 0; d < 4; ++d) _Pragma("unroll") for (int r = 0; r < 16; ++r) O[d][r] *= SL[crow(r, hi)]; } } while (0)
  const int NT = nkeys / KVBLK;
  SLOAD2(0); asm volatile("s_waitcnt vmcnt(0)" ::: "memory"); SWRITE2(0); __syncthreads();
  for (int j = 0; j < NT; ++j) {
    const int b = j & 1, kt0 = j * KVBLK;
    const int dlo_ = kt0 - q0 - 255, dhi_ = kt0 + 63 - q0;
    float cb = 0.f; const bool nearb = !(dlo_ >= 1024) && !(dhi_ <= -1024);
    if (dlo_ >= 1024) cb = cb_hi; else if (dhi_ <= -1024) cb = cb_lo;
    const float* tb_ = tbl_l + (kt0 - qlane + TOFF + 4 * hi);
    f32x16 s0, s1; bf16x8 pa0, pa1, pa2, pa3; float al0, al1;
    const int vb = vb0 + b * (int)SHM_V;
    qkt_map<0>(s0, s1, K_lds + b * SHM_K, qls, r32, hi);
    SBAR();
    if (nearb) {
#pragma unroll
      for (int r = 0; r < 8; ++r) { s0[r] += tb_[(r & 3) + 8 * (r >> 2)]; s1[r] += tb_[32 + (r & 3) + 8 * (r >> 2)]; }
      SBAR();
#pragma unroll
      for (int r = 8; r < 16; ++r) { s0[r] += tb_[(r & 3) + 8 * (r >> 2)]; s1[r] += tb_[32 + (r & 3) + 8 * (r >> 2)]; } }
    SBAR();
    softmax_tile(s0, s1, m0, l0, al0, cb, pa0, pa1, pa2, pa3);
    RESC2(oa, sl0, al0);
    SBAR();
    pv_d0(oa, vb, pa0, pa1, pa2, pa3);
    SBAR();
    qkt_map<1>(s0, s1, K_lds + b * SHM_K, qls, r32, hi);
    SBAR();
    if (nearb) {
#pragma unroll
      for (int r = 0; r < 8; ++r) { s0[r] += tb_[(r & 3) + 8 * (r >> 2)]; s1[r] += tb_[32 + (r & 3) + 8 * (r >> 2)]; }
      SBAR();
#pragma unroll
      for (int r = 8; r < 16; ++r) { s0[r] += tb_[(r & 3) + 8 * (r >> 2)]; s1[r] += tb_[32 + (r & 3) + 8 * (r >> 2)]; } }
    SBAR();
    softmax_tile(s0, s1, m1, l1, al1, cb, pa0, pa1, pa2, pa3);
    RESC2(ob, sl1, al1);
    SBAR();
    if (j + 1 < NT) SLOAD2(kt0 + KVBLK);
    SBAR();
    pv_d0(ob, vb, pa0, pa1, pa2, pa3);
    if (j + 1 < NT) { asm volatile("s_waitcnt vmcnt(0)" ::: "memory"); SWRITE2(b ^ 1); }
    __syncthreads();
  }
  const int lane_e = lane_id_v(), r32e = lane_e & 31, hie = lane_e >> 5;
  if (hie == 0) { sl0[r32e] = l0; sl1[r32e] = l1; } asm volatile("s_waitcnt lgkmcnt(0)" ::: "memory");
  bf16_t* Ow = Obf + (long)(wid * QBLK) * ldo;
  float sg[4];
#pragma unroll
  for (int d0 = 0; d0 < 4; ++d0) sg[d0] = subln[d0 * 32 + r32e] * post;
#pragma unroll
  for (int r = 0; r < 16; ++r) { const int orow = crow(r, hie); const float ra = __builtin_amdgcn_rcpf(sl0[orow]), rb = lam * __builtin_amdgcn_rcpf(sl1[orow]); float v[4]; float ss = 0.f;
#pragma unroll
    for (int d0 = 0; d0 < 4; ++d0) { v[d0] = oa[d0][r] * ra - ob[d0][r] * rb; ss += v[d0] * v[d0]; }
    ss += swz_xor<1>(ss); ss += swz_xor<2>(ss); ss += swz_xor<4>(ss); ss += swz_xor<8>(ss); ss += swz_xor<16>(ss);
    const float rs = rsqrtf(ss * (1.0f / 128.0f) + EPS);
#pragma unroll
    for (int d0 = 0; d0 < 4; ++d0) Ow[(long)orow * ldo + d0 * 32 + r32e] = (bf16_t)f2bf(v[d0] * rs * sg[d0]); }
#undef KSWZ
#undef SLOAD2
#undef SWRITE2
#undef RESC2
}
}

__device__ __forceinline__ void transpose_item(const float* __restrict__ W, int K, int N, bf16_t* __restrict__ WT, int k0, int n0, int drow0, float wscale, LAS float* scr, int lane) {
    float tv[32];
#pragma unroll
    for (int i = 0; i < 32; ++i) { const int kk = 2 * i + (lane >> 5); tv[i] = W[(size_t)(k0 + kk) * N + n0 + (lane & 31)]; }
#pragma unroll
    for (int i = 0; i < 32; ++i) { const int kk = 2 * i + (lane >> 5); scr[kk * 33 + (lane & 31)] = tv[i] * wscale; }
    asm volatile("s_waitcnt lgkmcnt(0)" ::: "memory");
    const int c = lane & 7;
#pragma unroll
    for (int j = 0; j < 4; ++j) { const int n = (lane >> 3) + 8 * j; const LAS float* s = scr + (8 * c) * 33 + n;
        u32x4 o; o.x = pk2(s[0 * 33], s[1 * 33]); o.y = pk2(s[2 * 33], s[3 * 33]); o.z = pk2(s[4 * 33], s[5 * 33]); o.w = pk2(s[6 * 33], s[7 * 33]);
        *(u32x4*)(WT + (size_t)(drow0 + n) * K + k0 + 8 * c) = o; }
    asm volatile("s_waitcnt lgkmcnt(0)" ::: "memory");
}
constexpr float QS_A = 0.125f * 1.4426950408889634f, QS_B = 0.07216878364870322f * 1.4426950408889634f, QS_CD = 0.08838834764831845f * 1.4426950408889634f;
template <int MODE>
__device__ __forceinline__ void transpose_matrix(const float* __restrict__ W, int K, int N, bf16_t* __restrict__ WT, LAS float* scr, int lane, int gw, int NGW) {
    const int nblk = N / 32, nitems = (K / 64) * nblk;
    for (int it = gw; it < nitems; it += NGW) { const int kb = it / nblk, nb = it % nblk, n0 = 32 * nb; int drow0 = n0;
        if (MODE == 1) { const int c = n0 < FF ? n0 : n0 - FF; drow0 = 256 * (c / 128) + (c % 128) + (n0 < FF ? 0 : 128); }
        float wscale = 1.0f;
        if (MODE == 2) { if (n0 < C_AK) wscale = QS_A; else if (n0 >= C_DQ && n0 < C_DK) wscale = QS_CD; }
        if (MODE == 3) wscale = QS_B;
        transpose_item(W, K, N, WT, 64 * kb, n0, drow0, wscale, scr, lane); }
}
__device__ __forceinline__ int t5_bucket(int d) {
    const int ret = d > 0 ? 16 : 0; const int n = d < 0 ? -d : d;
    if (n < 8) return ret + n;
    const float v = logf((float)n / 8.0f) / 4.852030263919617f * 8.0f;
    int large = 8 + (int)v; if (large > 15) large = 15;
    return ret + large;
}
__device__ __forceinline__ void norm_row(const float* __restrict__ xrow, const float* __restrict__ g, bf16_t* __restrict__ hrow, int lane) {
    f32x4 v[8]; float ss = 0.f;
#pragma unroll
    for (int j = 0; j < 8; ++j) { v[j] = ((const f32x4*)xrow)[lane + 64 * j]; ss += (v[j].x * v[j].x + v[j].y * v[j].y) + (v[j].z * v[j].z + v[j].w * v[j].w); }
    const float rs = rsqrtf(wave_sum(ss) * (1.0f / DM) + EPS);
#pragma unroll
    for (int j = 0; j < 8; ++j) { const f32x4 gg = ((const f32x4*)g)[lane + 64 * j];
        u32x2 w; w.x = pk2(v[j].x * rs * gg.x, v[j].y * rs * gg.y); w.y = pk2(v[j].z * rs * gg.z, v[j].w * rs * gg.w); ((u32x2*)hrow)[lane + 64 * j] = w; }
}
template <int NR>
__device__ __forceinline__ void norm_add_rows(const bf16_t* __restrict__ Yb, const float* xi, float* xo, const float* __restrict__ gpost,
                                              const float* __restrict__ gpre, bf16_t* __restrict__ Hb, int row0, int rstride, int lane) {
    u32x2 yb[NR][8]; f32x4 v[NR][8];
#pragma unroll
    for (int q = 0; q < NR; ++q) { const size_t ro = (size_t)(row0 + q * rstride) * DM;
#pragma unroll
        for (int j = 0; j < 8; ++j) yb[q][j] = ((const u32x2*)(Yb + ro))[lane + 64 * j];
#pragma unroll
        for (int j = 0; j < 8; ++j) v[q][j] = ((const f32x4*)(xi + ro))[lane + 64 * j]; }
    f32x4 gp[8];
#pragma unroll
    for (int j = 0; j < 8; ++j) gp[j] = ((const f32x4*)gpost)[lane + 64 * j];
#pragma unroll
    for (int q = 0; q < NR; ++q) { const size_t ro = (size_t)(row0 + q * rstride) * DM;
        f32x4 y[8]; float ss = 0.f;
#pragma unroll
        for (int j = 0; j < 8; ++j) { y[j].x = __uint_as_float(yb[q][j].x << 16); y[j].y = __uint_as_float(yb[q][j].x & 0xffff0000u); y[j].z = __uint_as_float(yb[q][j].y << 16); y[j].w = __uint_as_float(yb[q][j].y & 0xffff0000u);
            ss += (y[j].x * y[j].x + y[j].y * y[j].y) + (y[j].z * y[j].z + y[j].w * y[j].w); }
        const float rs = rsqrtf(wave_sum(ss) * (1.0f / DM) + EPS);
        float ss2 = 0.f;
#pragma unroll
        for (int j = 0; j < 8; ++j) { v[q][j] = v[q][j] + y[j] * rs * gp[j]; ((f32x4*)(xo + ro))[lane + 64 * j] = v[q][j];
            ss2 += (v[q][j].x * v[q][j].x + v[q][j].y * v[q][j].y) + (v[q][j].z * v[q][j].z + v[q][j].w * v[q][j].w); }
        if (gpre) {
            const float rs2 = rsqrtf(wave_sum(ss2) * (1.0f / DM) + EPS);
#pragma unroll
            for (int j = 0; j < 8; ++j) { const f32x4 gg = ((const f32x4*)gpre)[lane + 64 * j];
                u32x2 w; w.x = pk2(v[q][j].x * rs2 * gg.x, v[q][j].y * rs2 * gg.y); w.y = pk2(v[q][j].z * rs2 * gg.z, v[q][j].w * rs2 * gg.w); ((u32x2*)(Hb + ro))[lane + 64 * j] = w; }
        }
    }
}

__device__ __forceinline__ void head_norm_axial(const bf16_t* __restrict__ src, bf16_t* __restrict__ dst, const float* __restrict__ g, const float* __restrict__ COS, const float* __restrict__ SIN, int row, int t, float oscale) {
    float v[8];
#pragma unroll
    for (int s = 0; s < 4; ++s) { const unsigned w = *(const unsigned*)(src + 32 * s + 2 * t); v[2 * s] = bf2f((unsigned short)(w & 0xffff)); v[2 * s + 1] = bf2f((unsigned short)(w >> 16)); }
    float ss = 0.f;
#pragma unroll
    for (int i = 0; i < 8; ++i) ss += v[i] * v[i];
    ss += swz_xor<1>(ss); ss += swz_xor<2>(ss); ss += swz_xor<4>(ss); ss += swz_xor<8>(ss);
    const float rs = rsqrtf(ss * (1.0f / 128.0f) + EPS);
#pragma unroll
    for (int s = 0; s < 4; ++s) { v[2 * s] *= rs * oscale * g[32 * s + 2 * t]; v[2 * s + 1] *= rs * oscale * g[32 * s + 2 * t + 1]; }
    const int pr = row >> 6, pc = row & 63;
    float o[8];
#pragma unroll
    for (int e = 0; e < 2; ++e) { const int i = 2 * t + e;
        { const float c = COS[pr * 32 + i], s = SIN[pr * 32 + i]; const float x1 = v[e], x2 = v[2 + e]; o[e] = x1 * c - x2 * s; o[2 + e] = x2 * c + x1 * s; }
        { const float c = COS[pc * 32 + i], s = SIN[pc * 32 + i]; const float x1 = v[4 + e], x2 = v[6 + e]; o[4 + e] = x1 * c - x2 * s; o[6 + e] = x2 * c + x1 * s; } }
#pragma unroll
    for (int s = 0; s < 4; ++s) *(unsigned*)(dst + 32 * s + 2 * t) = pk2(o[2 * s], o[2 * s + 1]);
}


#define XB_TMO      128
#define XB_XCNT(j)  (256  + 64 * (j))
#define XB_XSUB(j)  (1280 + 64 * (j))
#define XB_XGEN(j)  (2304 + 64 * (j))
#define XB_TOP      3328
#define XB_TOPGEN   3392
#define XCD_BAR_WORDS 3456
#define XB_SPIN_CAP (1u << 18)
__device__ __forceinline__ unsigned xb_ld(unsigned* p)              { return __hip_atomic_load(p, __ATOMIC_RELAXED, __HIP_MEMORY_SCOPE_AGENT); }
__device__ __forceinline__ unsigned xb_add(unsigned* p, unsigned v) { return __hip_atomic_fetch_add(p, v, __ATOMIC_RELAXED, __HIP_MEMORY_SCOPE_AGENT); }
__device__ __forceinline__ unsigned xb_xcc_id() { return (unsigned)__builtin_amdgcn_s_getreg((3 << 11) | 20) & 0xFu; }
#define XB_SPIN(cond, bar) do { unsigned _sp = 0; while (cond) { __builtin_amdgcn_s_sleep(1); \
    if ((++_sp & 255u) == 0u) { if (xb_ld(&(bar)[XB_TMO])) break; if (_sp > XB_SPIN_CAP) { atomicAdd(&(bar)[XB_TMO], 1u); break; } } } } while (0)
__device__ __forceinline__ void xcd_barrier_complete(unsigned* bar, unsigned x, unsigned& nloc, unsigned& nx) {
    const unsigned G = gridDim.x * gridDim.y * gridDim.z;
    unsigned sum, cnt, mine, sp = 0u;
    for (;;) {
        sum = 0u; cnt = 0u; mine = 0u;
#pragma unroll
        for (unsigned j = 0; j < 16; ++j) { const unsigned c = xb_ld(&bar[XB_XCNT(j)]); sum += c; cnt += (c > 0u) ? 1u : 0u; mine = (j == x) ? c : mine; }
        if (sum == G) break;
        __builtin_amdgcn_s_sleep(1);
        if ((++sp & 255u) == 0u) { if (xb_ld(&bar[XB_TMO])) break; if (sp > XB_SPIN_CAP) { atomicAdd(&bar[XB_TMO], 1u); break; } }
    }
    nloc = mine > 0u ? mine : 1u; nx = cnt > 0u ? cnt : 1u;
}
__device__ __forceinline__ void xcd_barrier(unsigned* bar, volatile LAS unsigned* st, bool leader) {
    asm volatile("s_waitcnt vmcnt(0)" ::: "memory");
    __syncthreads();
    if (leader) {
        const unsigned x = xb_xcc_id();
        __builtin_amdgcn_s_waitcnt(0);
        unsigned nloc = st[0], nx = st[1];
        if (nloc == 0u) { xcd_barrier_complete(bar, x, nloc, nx); st[0] = nloc; st[1] = nx; }
        const unsigned old = xb_add(&bar[XB_XSUB(x)], 1u);
        const unsigned gen = old / nloc;
        if (old + 1u == (gen + 1u) * nloc) {
            __builtin_amdgcn_fence(__ATOMIC_RELEASE, "agent");
            asm volatile("s_waitcnt vmcnt(0)" ::: "memory");
            const unsigned og = xb_add(&bar[XB_TOP], 1u);
            const unsigned tg = og / nx;
            if (og + 1u == (tg + 1u) * nx) xb_add(&bar[XB_TOPGEN], 1u);
            else XB_SPIN(xb_ld(&bar[XB_TOPGEN]) == tg, bar);
            __builtin_amdgcn_fence(__ATOMIC_ACQUIRE, "agent");
            xb_add(&bar[XB_XGEN(x)], 1u);
            asm volatile("s_waitcnt vmcnt(0)" ::: "memory");
        } else {
            XB_SPIN(xb_ld(&bar[XB_XGEN(x)]) == gen, bar);
            __builtin_amdgcn_fence(__ATOMIC_ACQUIRE, "agent");
            asm volatile("s_waitcnt vmcnt(0)" ::: "memory");
        }
    }
    __syncthreads();
}

struct Args { const float* in[18]; float* out; unsigned char* wsp; int ph_lo, ph_hi; };

__global__ void __launch_bounds__(512, 2) mega_fwd(Args args) {
    extern __shared__ __attribute__((aligned(16))) unsigned char lds[];
    const int G = gridDim.x, bid = blockIdx.x, NGW = G * 8;
    const int wave0 = __builtin_amdgcn_readfirstlane((int)threadIdx.x >> 6);
    typedef const __attribute__((address_space(4))) Args* KArgP;
    LAS unsigned char* ldsl = (LAS unsigned char*)lds;
#define x_in (kap->in[0])
#define rel_bias (kap->in[1])
#define norm_mix_pre (kap->in[2])
#define norm_mix_post (kap->in[3])
#define norm_ffn_pre (kap->in[4])
#define norm_ffn_post (kap->in[5])
#define w_in (kap->in[6])
#define diff_lambda (kap->in[7])
#define diff_subln (kap->in[8])
#define mla_q_norm (kap->in[9])
#define mla_kv_norm (kap->in[10])
#define mla_w_uq (kap->in[11])
#define mla_w_ukv (kap->in[12])
#define gqa_q_norm (kap->in[13])
#define gqa_k_norm (kap->in[14])
#define w_out (kap->in[15])
#define w_gate_up (kap->in[16])
#define w_down (kap->in[17])
#define xres (kap->out)
#define ws (kap->wsp)
#define PAR ((float*)(ws + WS_PAR))
#define TBLA ((float*)(ws + WS_TBLA))
#define TBLD ((float*)(ws + WS_TBLD))
#define COS ((float*)(ws + WS_COS))
#define SIN ((float*)(ws + WS_SIN))
#define H ((bf16_t*)(ws + WS_H))
#define PROJ ((bf16_t*)(ws + WS_PROJ))
#define CQN ((bf16_t*)(ws + WS_CQN))
#define CKVN ((bf16_t*)(ws + WS_CKVN))
#define KPE ((bf16_t*)(ws + WS_KPE))
#define QC ((bf16_t*)(ws + WS_QC))
#define KC ((bf16_t*)(ws + WS_KC))
#define QB ((bf16_t*)(ws + WS_QB))
#define KVB ((bf16_t*)(ws + WS_KVB))
#define MIX ((bf16_t*)(ws + WS_MIX))
#define Y ((bf16_t*)(ws + WS_Y))
#define HID ((bf16_t*)(ws + WS_HID))
#define TMP ((float*)(ws + WS_TMP))
#define wl (ws + WS_W + (size_t)l * LW)

    volatile LAS unsigned* bst = (volatile LAS unsigned*)(ldsl + LDS_ST_OFF);
    { const bool leader0 = (wave0 == 0) && (lane_id_v() == 0);
      if (leader0) { bst[0] = 0u; bst[1] = 0u; }
      __syncthreads();
      if (leader0 && !MK_MULTI) { KArgP kap0 = (KArgP)__builtin_amdgcn_kernarg_segment_ptr(); (void)xb_add(&((unsigned*)(kap0->wsp + WS_BAR))[XB_XCNT(xb_xcc_id())], 1u); } }
    const int lo = args.ph_lo, hi_ph = args.ph_hi; int ph = 0;
#define PH_BEGIN if (ph >= lo && ph < hi_ph) { KArgP kap = (KArgP)__builtin_amdgcn_kernarg_segment_ptr(); asm volatile("" : "+s"(kap)); \
    int tid_ = wave0 * 64 + lane_id_v(); const int tid = tid_, lane = tid & 63, wave = __builtin_amdgcn_readfirstlane(tid >> 6), gw = bid * 8 + wave; (void)lane; (void)gw;
#define PH_END } if (ph >= lo && ph + 1 < hi_ph) { if (ph == 0) { cg::this_grid().sync(); } else { KArgP kapb = (KArgP)__builtin_amdgcn_kernarg_segment_ptr(); asm volatile("" : "+s"(kapb)); \
      xcd_barrier((unsigned*)(kapb->wsp + WS_BAR), bst, (wave0 == 0) && (lane_id_v() == 0)); } } ++ph;

    PH_BEGIN
    if PHON(0) {
        LAS float* scr = (LAS float*)(ldsl + wave * 16384);
        for (int l = 0; l < DEPTH; ++l) {
            transpose_matrix<2>(w_in + (size_t)l * DM * NPROJ, DM, NPROJ, (bf16_t*)(wl + W_IN), scr, lane, gw, NGW);
            transpose_matrix<3>(mla_w_uq + (size_t)l * 512 * 768, 512, 768, (bf16_t*)(wl + W_UQ), scr, lane, gw, NGW);
            transpose_matrix<0>(mla_w_ukv + (size_t)l * 256 * 1024, 256, 1024, (bf16_t*)(wl + W_UKV), scr, lane, gw, NGW);
            transpose_matrix<0>(w_out + (size_t)l * DM * DM, DM, DM, (bf16_t*)(wl + W_OUT), scr, lane, gw, NGW);
            transpose_matrix<1>(w_gate_up + (size_t)l * DM * NGU, DM, NGU, (bf16_t*)(wl + W_GU), scr, lane, gw, NGW);
            transpose_matrix<0>(w_down + (size_t)l * FF * DM, FF, DM, (bf16_t*)(wl + W_D), scr, lane, gw, NGW);
            { u32x4* z = (u32x4*)((bf16_t*)(wl + W_IN) + (size_t)NPROJ * DM); const int n16 = (LDP - NPROJ) * DM * 2 / 16;
              for (int i = bid * 512 + tid; i < n16; i += G * 512) z[i] = (u32x4){0u, 0u, 0u, 0u}; }
        }
        const int gt = bid * 512 + tid, NT_ = G * 512;
        for (int i = gt; i < 4 * TBLN; i += NT_) { const int h = i / TBLN, d = (i % TBLN) - TOFF; const int b = t5_bucket(d);
            TBLA[i] = rel_bias[b * 8 + h] * 1.4426950408889634f;
            const int n = d < 0 ? -d : d; int mult = (n <= 64 ? 1 : 0) + (((n & 3) == 0 && n <= 256) ? 1 : 0) + (((n & 15) == 0 && n <= 1024) ? 1 : 0);
            TBLD[i] = mult ? (rel_bias[b * 8 + 4 + h] + logf((float)mult)) * 1.4426950408889634f : -1e30f; }
        for (int i = gt; i < S * 32; i += NT_) { const int pos = i >> 5, f = i & 31;
            const float inv = (float)pow(10000.0, -(double)(2 * f) / 64.0); const float ang = (float)pos * inv;
            COS[i] = (float)cos((double)ang); SIN[i] = (float)sin((double)ang); }
        if (bid == 0 && tid < DEPTH) { const float* lv = diff_lambda + tid * 256; float s1 = 0.f, s2 = 0.f;
            for (int i = 0; i < 64; ++i) { s1 += lv[i] * lv[64 + i]; s2 += lv[128 + i] * lv[192 + i]; }
            const float lam_init = 0.8f - 0.6f * expf(-0.3f * (float)tid);
            PAR[tid] = expf(s1) - expf(s2) + lam_init; PAR[4 + tid] = lam_init; }
        for (int row = gw; row < S; row += NGW) norm_row(x_in + (size_t)row * DM, norm_mix_pre, H + (size_t)row * DM, lane);
    }
    PH_END

    for (int l = 0; l < DEPTH; ++l) {
        PH_BEGIN
        if PHON(1) for (int rep_ = 0; rep_ < MK_DUP_GEMM; ++rep_) { pg8::Gemm g{H, (const bf16_t*)(wl + W_IN), S, LDP, DM}; pg8::StaticOrder So; So.init(S, LDP, G, bid);
          pg8::EpiBf16 E{PROJ, LDP};
          pg8::gemm_phase<pg8::EpiBf16, pg8::StaticOrder, true, true>(ldsl, g, So, E, wave0); }
        PH_END
        PH_BEGIN
        if PHON(2) for (int row = gw; row < S; row += NGW) {
            const bf16_t* pr = PROJ + (size_t)row * LDP;
            { const u32x4 raw = *(const u32x4*)(pr + C_BCQ + lane * 8); float v[8];
              v[0] = __uint_as_float(raw.x << 16); v[1] = __uint_as_float(raw.x & 0xffff0000u); v[2] = __uint_as_float(raw.y << 16); v[3] = __uint_as_float(raw.y & 0xffff0000u);
              v[4] = __uint_as_float(raw.z << 16); v[5] = __uint_as_float(raw.z & 0xffff0000u); v[6] = __uint_as_float(raw.w << 16); v[7] = __uint_as_float(raw.w & 0xffff0000u);
              float ss = 0.f;
#pragma unroll
              for (int i = 0; i < 8; ++i) ss += v[i] * v[i];
              const float rs = rsqrtf(wave_sum(ss) * (1.0f / 512.0f) + EPS);
              const f32x4 g0 = *(const f32x4*)(mla_q_norm + l * 512 + lane * 8), g1 = *(const f32x4*)(mla_q_norm + l * 512 + lane * 8 + 4);
              u32x4 w; w.x = pk2(v[0] * rs * g0.x, v[1] * rs * g0.y); w.y = pk2(v[2] * rs * g0.z, v[3] * rs * g0.w); w.z = pk2(v[4] * rs * g1.x, v[5] * rs * g1.y); w.w = pk2(v[6] * rs * g1.z, v[7] * rs * g1.w);
              *(u32x4*)(CQN + (size_t)row * 512 + lane * 8) = w; }
            { const u32x2 raw = *(const u32x2*)(pr + C_BCKV + lane * 4); float v[4];
              v[0] = __uint_as_float(raw.x << 16); v[1] = __uint_as_float(raw.x & 0xffff0000u); v[2] = __uint_as_float(raw.y << 16); v[3] = __uint_as_float(raw.y & 0xffff0000u);
              float ss = v[0] * v[0] + v[1] * v[1] + v[2] * v[2] + v[3] * v[3];
              const float rs = rsqrtf(wave_sum(ss) * (1.0f / 256.0f) + EPS);
              const f32x4 g0 = *(const f32x4*)(mla_kv_norm + l * 256 + lane * 4);
              u32x2 w; w.x = pk2(v[0] * rs * g0.x, v[1] * rs * g0.y); w.y = pk2(v[2] * rs * g0.z, v[3] * rs * g0.w);
              *(u32x2*)(CKVN + (size_t)row * 256 + lane * 4) = w; }
            if (lane < 32) { const float x1 = bf2f(pr[C_BKPE + lane]), x2 = bf2f(pr[C_BKPE + 32 + lane]); const float c = COS[row * 32 + lane], s = SIN[row * 32 + lane];
              KPE[(size_t)row * 64 + lane] = (bf16_t)f2bf(x1 * c - x2 * s); KPE[(size_t)row * 64 + 32 + lane] = (bf16_t)f2bf(x2 * c + x1 * s); }
            { const int hd = lane >> 4, t = lane & 15;
              head_norm_axial(pr + C_CQ + hd * 128, QC + (size_t)row * 512 + hd * 128, gqa_q_norm + l * 128, COS, SIN, row, t, QS_CD);
              const int hk = hd & 1;
              if (lane < 32) head_norm_axial(pr + C_CK + hk * 128, KC + (size_t)row * 256 + hk * 128, gqa_k_norm + l * 128, COS, SIN, row, t, 1.0f); }
        }
        PH_END
        PH_BEGIN
        if PHON(3) { pg8::Gemm g{CQN, (const bf16_t*)(wl + W_UQ), S, 768, 512}; pg8::StaticOrder So; So.init(S, 768, G, bid);
          pg8::EpiBf16 E{QB, 768};
          pg8::gemm_phase<pg8::EpiBf16, pg8::StaticOrder, true, true>(ldsl, g, So, E, wave0); }
        if PHON(4) { pg8::Gemm g{CKVN, (const bf16_t*)(wl + W_UKV), S, 1024, 256}; pg8::StaticOrder So; So.init(S, 1024, G, bid);
          pg8::EpiBf16 E{KVB, 1024};
          pg8::gemm_phase<pg8::EpiBf16, pg8::StaticOrder, true, true>(ldsl, g, So, E, wave0); }
        PH_END
        PH_BEGIN
        for (int rep_ = 0; rep_ < MK_DUP_ATT; ++rep_) {
            const float lam = PAR[l], lam_init = PAR[4 + l];
            const float L2E = 1.4426950408889634f;
            if PHON(6) for (int u = bid; u < 256; u += G) { const int xq = u & 7, hd = xq & 3, qb = (u >> 3) + 32 * (xq >> 2), q0 = qb * 256;
                { const float cb_lo = rel_bias[15 * 8 + hd] * L2E, cb_hi = rel_bias[31 * 8 + hd] * L2E;
                  att::attn_unit_A2(PROJ + (size_t)q0 * LDP + C_AQ + hd * 128, LDP, PROJ + C_AK + hd * 128, LDP, PROJ + C_AV + hd * 128, LDP, S, q0,
                                    TBLA + hd * TBLN, cb_lo, cb_hi, MIX + (size_t)q0 * DM + hd * 128, DM, lam, diff_subln + l * 128, 1.0f - lam_init, (char*)lds, wave0); }
            }
            if PHON(7) for (int u = bid; u < 256; u += G) { const int xq = u & 7, hd = xq & 3, qb = (u >> 3) + 32 * (xq >> 2), q0 = qb * 256;
                { const float sc = 0.07216878364870322f;
                  att::attn_unit<12, 0, 0, 1, 8, 1>(QB + (size_t)q0 * 768 + hd * 192, 768, KVB + hd * 256, 1024, KPE, 64, KVB + hd * 256 + 128, 1024,
                                            0, S, q0, nullptr, 0.f, 0.f, MIX + (size_t)q0 * DM + 512 + hd * 128, DM, nullptr, 0.f, nullptr, 0.f, (char*)lds, wave0, COS, SIN); }
            }
            if PHON(8) for (int u = bid; u < 256; u += G) { const int xq = u & 7, hd = xq & 3, qb = (u >> 3) + 32 * (xq >> 2), q0 = qb * 256;
                { const float sc = 0.08838834764831845f;
                  att::attn_unit<8, 0, 0, 1>(QC + (size_t)q0 * 512 + hd * 128, 512, KC + (hd >> 1) * 128, 256, nullptr, 0, PROJ + C_CV + (hd >> 1) * 128, LDP,
                                           0, S, q0, nullptr, 0.f, 0.f, MIX + (size_t)q0 * DM + 1024 + hd * 128, DM, nullptr, 0.f, nullptr, 0.f, (char*)lds, wave0); }
            }
            if PHON(9) for (int u = bid; u < 256; u += G) { const int xq = u & 7, hd = xq & 3, qb = (u >> 3) + 32 * (xq >> 2), q0 = qb * 256;
                { const float sc = 0.08838834764831845f;
                  const int kb = q0 - 1024 < 0 ? 0 : q0 - 1024, ke = q0 + 256 + 1024 > S ? S : q0 + 256 + 1024;
                  att::attn_unit<8, 1, 0, 1>(PROJ + (size_t)q0 * LDP + C_DQ + hd * 128, LDP, PROJ + C_DK + hd * 128, LDP, nullptr, 0, PROJ + C_DV + hd * 128, LDP,
                                           kb, ke - kb, q0, TBLD + hd * TBLN, 0.f, 0.f, MIX + (size_t)q0 * DM + 1536 + hd * 128, DM, nullptr, 0.f, nullptr, 0.f, (char*)lds, wave0); }
            }
            __syncthreads();
        }
        PH_END
        PH_BEGIN
        if PHON(10) for (int rep_ = 0; rep_ < MK_DUP_GEMM; ++rep_) { pg8::Gemm g{MIX, (const bf16_t*)(wl + W_OUT), S, DM, DM}; pg8::StaticOrder So; So.init(S, DM, G, bid);
          pg8::EpiBf16 E{Y, DM};
          pg8::gemm_phase<pg8::EpiBf16, pg8::StaticOrder, true, true>(ldsl, g, So, E, wave0); }
        PH_END
        PH_BEGIN
        if PHON(11) { int row = gw;
            for (; row + NGW < S; row += 2 * NGW) norm_add_rows<2>(Y, (l == 0 ? x_in : xres), xres, norm_mix_post + l * DM, norm_ffn_pre + l * DM, H, row, NGW, lane);
            for (; row < S; row += NGW) norm_add_rows<1>(Y, (l == 0 ? x_in : xres), xres, norm_mix_post + l * DM, norm_ffn_pre + l * DM, H, row, NGW, lane); }
        PH_END
        PH_BEGIN
        if PHON(12) for (int rep_ = 0; rep_ < MK_DUP_GEMM; ++rep_) { pg8::Gemm g{H, (const bf16_t*)(wl + W_GU), S, NGU, DM}; pg8::StaticOrder So; So.init(S, NGU, G, bid);
          pg8::EpiSwiGLU E{HID, FF};
          pg8::gemm_phase<pg8::EpiSwiGLU, pg8::StaticOrder, true, true>(ldsl, g, So, E, wave0); }
        PH_END
        PH_BEGIN
        if PHON(13) for (int rep_ = 0; rep_ < MK_DUP_GEMM; ++rep_) { pg8::Gemm g{HID, (const bf16_t*)(wl + W_D), S, DM, FF}; pg8::StaticOrder So; So.init(S, DM, G, bid);
          pg8::EpiBf16 E{Y, DM};
          pg8::gemm_phase<pg8::EpiBf16, pg8::StaticOrder, true, true>(ldsl, g, So, E, wave0); }
        PH_END
        PH_BEGIN
        if PHON(14) { int row = gw; const float* gnext = (l + 1 < DEPTH) ? norm_mix_pre + (l + 1) * DM : nullptr;
            for (; row + NGW < S; row += 2 * NGW) norm_add_rows<2>(Y, xres, xres, norm_ffn_post + l * DM, gnext, H, row, NGW, lane);
            for (; row < S; row += NGW) norm_add_rows<1>(Y, xres, xres, norm_ffn_post + l * DM, gnext, H, row, NGW, lane); }
        PH_END
    }
#undef PH_BEGIN
#undef PH_END
}
#undef x_in
#undef rel_bias
#undef norm_mix_pre
#undef norm_mix_post
#undef norm_ffn_pre
#undef norm_ffn_post
#undef w_in
#undef diff_lambda
#undef diff_subln
#undef mla_q_norm
#undef mla_kv_norm
#undef mla_w_uq
#undef mla_w_ukv
#undef gqa_q_norm
#undef gqa_k_norm
#undef w_out
#undef w_gate_up
#undef w_down
#undef xres
#undef ws
#undef PAR
#undef TBLA
#undef TBLD
#undef COS
#undef SIN
#undef H
#undef PROJ
#undef CQN
#undef CKVN
#undef KPE
#undef QC
#undef KC
#undef QB
#undef KVB
#undef MIX
#undef Y
#undef HID
#undef TMP
#undef wl

constexpr int N_PHASES = 1 + DEPTH * 9;

extern "C" void kernel_launch(void* const* d_in, const int* in_sizes, int n_in, void* d_out, int out_size, void* d_ws, size_t ws_size, hipStream_t stream) {
    static int grid = 0;
    if (grid == 0) {
        if (n_in != 18 || in_sizes[0] != S * DM || out_size != S * DM || ws_size < WS_END) {
            fprintf(stderr, "kernel_launch: unexpected shapes (n_in %d, in0 %d, out %d, ws %zu < %zu)\n", n_in, n_in > 0 ? in_sizes[0] : -1, out_size, ws_size, (size_t)WS_END); grid = -1; return; }
        int dev = 0, cus = 0, per_cu = 0;
        if (hipGetDevice(&dev) != hipSuccess || hipDeviceGetAttribute(&cus, hipDeviceAttributeMultiprocessorCount, dev) != hipSuccess) { grid = -1; return; }
        if (hipFuncSetAttribute((const void*)mega_fwd, hipFuncAttributeMaxDynamicSharedMemorySize, LDS_BYTES) != hipSuccess) { fprintf(stderr, "kernel_launch: hipFuncSetAttribute failed\n"); grid = -1; return; }
        if (hipOccupancyMaxActiveBlocksPerMultiprocessor(&per_cu, (const void*)mega_fwd, 512, LDS_BYTES) != hipSuccess || per_cu < 1) { fprintf(stderr, "kernel_launch: occupancy query says %d\n", per_cu); per_cu = 1; }
        (void)hipGetLastError();
        grid = cus;
    }
    if (grid < 0) return;
    if (hipMemsetAsync((char*)d_ws + WS_BAR, 0, WS_BAR_BYTES, stream) != hipSuccess) { fprintf(stderr, "kernel_launch: hipMemsetAsync of the barrier words failed\n"); return; }
    Args a{};
    for (int i = 0; i < 18; ++i) a.in[i] = (const float*)d_in[i];
    a.out = (float*)d_out; a.wsp = (unsigned char*)d_ws;
#if MK_MULTI
    for (int p = 0; p < N_PHASES; ++p) { a.ph_lo = p; a.ph_hi = p + 1; hipLaunchKernelGGL(mega_fwd, dim3(grid), dim3(512), LDS_BYTES, stream, a); }
#else
    a.ph_lo = 0; a.ph_hi = N_PHASES;
    void* kargs[] = {&a};
    hipError_t e = hipLaunchCooperativeKernel((const void*)mega_fwd, dim3(grid), dim3(512), kargs, LDS_BYTES, stream);
    if (e != hipSuccess) fprintf(stderr, "kernel_launch: cooperative launch failed: %s (grid %d)\n", hipGetErrorString(e), grid);
#endif
}
```

```cpp
#include <hip/hip_runtime.h>
#include <hip/hip_cooperative_groups.h>
#include <cstdio>
#include <cstdint>
namespace cg = cooperative_groups;

#ifndef MK_MULTI
#define MK_MULTI 0
#endif
#ifndef MK_PHMASK
#define MK_PHMASK 0xFFFFF
#endif
#define PHON(k) constexpr (((MK_PHMASK) >> (k)) & 1)
#ifndef MK_DUP_GEMM
#define MK_DUP_GEMM 1
#endif
#ifndef MK_DUP_ATT
#define MK_DUP_ATT 1
#endif

typedef unsigned short bf16_t;
typedef short bf16x8 __attribute__((ext_vector_type(8)));
typedef short s16x4 __attribute__((ext_vector_type(4)));
typedef float f32x2 __attribute__((ext_vector_type(2)));
typedef float f32x4 __attribute__((ext_vector_type(4)));
typedef float f32x16 __attribute__((ext_vector_type(16)));
typedef unsigned u32x2 __attribute__((ext_vector_type(2)));
typedef unsigned u32x4 __attribute__((ext_vector_type(4)));
#define LAS __attribute__((address_space(3)))

constexpr int S = 16384, DM = 2048, DEPTH = 4, NPROJ = 4928, LDP = 5120, FF = 5632, NGU = 2 * FF;
constexpr float EPS = 1e-6f;
constexpr int C_AQ = 0, C_AK = 512, C_AV = 1024, C_BCQ = 1536, C_BCKV = 2048, C_BKPE = 2304, C_CQ = 2368, C_CK = 2880, C_CV = 3136, C_DQ = 3392, C_DK = 3904, C_DV = 4416;
constexpr int TOFF = 1408, TBLN = 2824;

constexpr size_t MiB = 1u << 20;
constexpr size_t WS_PAR = 0, WS_TBLA = 1 * MiB, WS_TBLD = 1 * MiB + 65536, WS_COS = 2 * MiB, WS_SIN = 4 * MiB;
constexpr size_t WS_BAR = 6 * MiB, WS_BAR_BYTES = 16384;
constexpr size_t WS_W = 8 * MiB, LW = 96 * MiB;
constexpr size_t W_IN = 0, W_UQ = 20 * MiB, W_UKV = 21 * MiB, W_OUT = 22 * MiB, W_GU = 30 * MiB, W_D = 74 * MiB;
constexpr size_t WS_H = 392 * MiB, WS_PROJ = 456 * MiB, WS_CQN = 616 * MiB, WS_CKVN = 632 * MiB, WS_KPE = 640 * MiB, WS_QC = 642 * MiB, WS_KC = 658 * MiB;
constexpr size_t WS_QB = 666 * MiB, WS_KVB = 690 * MiB, WS_MIX = 722 * MiB, WS_Y = 786 * MiB, WS_HID = 914 * MiB, WS_TMP = 1090 * MiB, WS_END = 1122 * MiB;

constexpr int LDS_ST_OFF = 163840 - 16;
constexpr int LDS_BYTES = 163840;

__device__ __forceinline__ float bf2f(unsigned short b) { return __uint_as_float(((unsigned)b) << 16); }
__device__ __forceinline__ unsigned f2bf(float f) { unsigned u = __float_as_uint(f); return (u + 0x7fffu + ((u >> 16) & 1u)) >> 16; }
__device__ __forceinline__ unsigned pk2(float lo, float hi) { return f2bf(lo) | (f2bf(hi) << 16); }
__device__ __forceinline__ unsigned cvt_pk_bf16(float lo, float hi) { unsigned r; asm volatile("v_cvt_pk_bf16_f32 %0, %1, %2" : "=v"(r) : "v"(lo), "v"(hi)); return r; }
__device__ __forceinline__ int lane_id_v() { int l; asm volatile("v_mbcnt_lo_u32_b32 %0, -1, 0\n\tv_mbcnt_hi_u32_b32 %0, -1, %0" : "=v"(l)); return l; }
template <int M> __device__ __forceinline__ float swz_xor(float v) { return __int_as_float(__builtin_amdgcn_ds_swizzle(__float_as_int(v), (M << 10) | 0x1f)); }
__device__ __forceinline__ float wave_sum(float v) {
    v += swz_xor<1>(v); v += swz_xor<2>(v); v += swz_xor<4>(v); v += swz_xor<8>(v); v += swz_xor<16>(v);
    auto rr = __builtin_amdgcn_permlane32_swap(__float_as_uint(v), __float_as_uint(v), false, false);
    return __uint_as_float(rr[0]) + __uint_as_float(rr[1]);
}

namespace pg8 {
constexpr int BM = 256, BK = 64, HALF = 128, HTB = HALF * BK * 2, STAGE_BYTES = 8 * HTB, NXCD = 8, WGM = 8;
__host__ __device__ __forceinline__ int lds_byte(int r, int c) { const int st = (r >> 4) * 2 + (c >> 5), rr = r & 15, cc = c & 31, ob = rr * 64 + cc * 2; return st * 1024 + (ob ^ (((ob >> 9) & 1) << 5)); }
__host__ __device__ __forceinline__ void stage_rc(int b, int& R, int& C) { const int st = b / 1024, sb = b % 1024, swz = sb ^ (((sb >> 9) & 1) << 5); R = (st >> 1) * 16 + swz / 64; C = (st & 1) * 32 + (swz % 64) / 2; }
__host__ __device__ __forceinline__ int perm32(int rho) { const int n = rho >> 4, i = rho & 15; return 8 * (i >> 2) + 4 * n + (i & 3); }

struct Unit { int pm, pn; };
struct Gemm { const bf16_t* A; const bf16_t* Bt; int M, N, K; };

struct StaticOrder {
    int nM, nN, nwg, G, c;
    __host__ __device__ void init(int M, int N, int G_, int c_) { nM = M / BM; nN = N / BM; nwg = nM * nN; G = G_; c = c_; }
    __host__ __device__ bool next(int i, Unit& u) const {
        const long L = (long)i * G + c; if (L >= nwg) return false;
        int wgid = (int)L; { const int q = nwg / NXCD, r = nwg % NXCD, xcd = wgid % NXCD, off = wgid / NXCD; wgid = (xcd < r ? xcd * (q + 1) : r * (q + 1) + (xcd - r) * q) + off; }
        const int nig = WGM * nN, gid = wgid / nig, fm = gid * WGM, gsz = (nM - fm) < WGM ? (nM - fm) : WGM;
        u.pm = fm + ((wgid % nig) % gsz); u.pn = (wgid % nig) / gsz; return true;
    }
    __device__ __forceinline__ void a_ready(const Unit&) const {}
    __device__ __forceinline__ void done(const Unit&) const {}
};

struct EpiBf16 {
    static constexpr bool PERM = true, AFTER_DRAIN = false;
    bf16_t* O; int ldc;
    __device__ __forceinline__ void operator()(const f32x4 (&acc)[2][2][4][2], const Unit& u, int wr, int wc, int fr, int fq) const {
        const int row0 = u.pm * BM + wr * 64 + fr; const int col0 = u.pn * BM + wc * 32 + 8 * fq;
#pragma unroll
        for (int ai = 0; ai < 2; ++ai)
#pragma unroll
            for (int m = 0; m < 4; ++m) { bf16_t* rowp = O + (size_t)(row0 + ai * HALF + m * 16) * ldc + col0;
#pragma unroll
                for (int bj = 0; bj < 2; ++bj) { const f32x4 v0 = acc[ai][bj][m][0], v1 = acc[ai][bj][m][1];
                    u32x4 w; w.x = cvt_pk_bf16(v0[0], v0[1]); w.y = cvt_pk_bf16(v0[2], v0[3]); w.z = cvt_pk_bf16(v1[0], v1[1]); w.w = cvt_pk_bf16(v1[2], v1[3]);
                    *(u32x4*)(rowp + bj * HALF) = w; } }
    }
};
struct EpiF32 {
    static constexpr bool PERM = false, AFTER_DRAIN = false;
    float* O; int ldc;
    __device__ __forceinline__ void operator()(const f32x4 (&acc)[2][2][4][2], const Unit& u, int wr, int wc, int fr, int fq) const {
        const int row0 = u.pm * BM + wr * 64 + fr; const int col0 = u.pn * BM + wc * 32 + 4 * fq;
#pragma unroll
        for (int ai = 0; ai < 2; ++ai)
#pragma unroll
            for (int m = 0; m < 4; ++m) { float* rowp = O + (size_t)(row0 + ai * HALF + m * 16) * ldc + col0;
#pragma unroll
                for (int bj = 0; bj < 2; ++bj)
#pragma unroll
                    for (int n = 0; n < 2; ++n) *(f32x4*)(rowp + bj * HALF + n * 16) = acc[ai][bj][m][n]; }
    }
};
__device__ __forceinline__ float silu_mul(float g, float u) {
    const float e = __builtin_amdgcn_exp2f(-g * 1.4426950408889634f);
    return g * __builtin_amdgcn_rcpf(1.0f + e) * u;
}
struct EpiSwiGLU {
    static constexpr bool PERM = true, AFTER_DRAIN = false;
    bf16_t* O; int ldc;
    __device__ __forceinline__ void operator()(const f32x4 (&acc)[2][2][4][2], const Unit& u, int wr, int wc, int fr, int fq) const {
        const int row0 = u.pm * BM + wr * 64 + fr; const int col0 = u.pn * HALF + wc * 32 + 8 * fq;
#pragma unroll
        for (int ai = 0; ai < 2; ++ai)
#pragma unroll
            for (int m = 0; m < 4; ++m) { bf16_t* rowp = O + (size_t)(row0 + ai * HALF + m * 16) * ldc + col0;
                const f32x4 g0 = acc[ai][0][m][0], g1 = acc[ai][0][m][1], u0 = acc[ai][1][m][0], u1 = acc[ai][1][m][1];
                u32x4 w; w.x = cvt_pk_bf16(silu_mul(g0[0], u0[0]), silu_mul(g0[1], u0[1])); w.y = cvt_pk_bf16(silu_mul(g0[2], u0[2]), silu_mul(g0[3], u0[3]));
                w.z = cvt_pk_bf16(silu_mul(g1[0], u1[0]), silu_mul(g1[1], u1[1])); w.w = cvt_pk_bf16(silu_mul(g1[2], u1[2]), silu_mul(g1[3], u1[3]));
                *(u32x4*)rowp = w; }
    }
};

template <class Epi, class Sched, bool ALIGN_EPI = false, bool SP2 = false>
__device__ __forceinline__ void gemm_phase(LAS unsigned char* lds, const Gemm g, const Sched& S, const Epi& E, const int wave0) {
    int tid_ = wave0 * 64 + lane_id_v();
    const int tid = tid_, wid = __builtin_amdgcn_readfirstlane(tid >> 6), lane = tid & 63, wr = wid >> 2, wc = wid & 3, fr = lane & 15, fq = lane >> 4;
    int K_ = g.K; asm volatile("" : "+s"(K_));
    const int K = K_, nt = K / BK;
    unsigned voffA[2], voffB[2];
#pragma unroll
    for (int i = 0; i < 2; ++i) { int R, C; stage_rc(tid * 16 + i * 8192, R, C); const int Rb = Epi::PERM ? ((R & ~31) + perm32(R & 31)) : R;
        voffA[i] = (unsigned)(R * K + C) * 2u; voffB[i] = (unsigned)(Rb * K + C) * 2u; }
    const size_t kstep = (size_t)(BK * 2);
    const size_t hstep = (size_t)HALF * K * 2;
    const size_t tstep = 2 * hstep;
    const unsigned ldsw = (unsigned)wid * 1024u;
    const int aoff = lds_byte(wr * 64 + fr, fq * 8), boff = lds_byte(wc * 32 + fr, fq * 8);
#define PG8_SA(b, h) (((b) * 2 + (h)) * HTB)
#define PG8_SB(b, h) ((4 + (b) * 2 + (h)) * HTB)
#define PG8_STAGE(bufoff, gbase, voff) do { _Pragma("unroll") for (int _i = 0; _i < 2; ++_i) \
        __builtin_amdgcn_global_load_lds((const unsigned*)((const char*)(gbase) + (voff)[_i]), (LAS unsigned*)(lds + (bufoff) + ldsw + _i * 8192), 16, 0, 0); } while (0)
#define PG8_LDA(dst, b, h) do { _Pragma("unroll") for (int m = 0; m < 4; ++m) _Pragma("unroll") for (int k = 0; k < 2; ++k) dst[m][k] = *(const LAS bf16x8*)(lds + PG8_SA(b, h) + aoff + m * 2048 + k * 1024); } while (0)
#define PG8_LDB(dst, b, h) do { _Pragma("unroll") for (int n = 0; n < 2; ++n) _Pragma("unroll") for (int k = 0; k < 2; ++k) dst[n][k] = *(const LAS bf16x8*)(lds + PG8_SB(b, h) + boff + n * 2048 + k * 1024); } while (0)
#define PG8_MMA(ai, bj, At, Bt) do { __builtin_amdgcn_s_setprio(1); _Pragma("unroll") for (int m = 0; m < 4; ++m) _Pragma("unroll") for (int n = 0; n < 2; ++n) _Pragma("unroll") for (int k = 0; k < 2; ++k) \
        acc[ai][bj][m][n] = __builtin_amdgcn_mfma_f32_16x16x32_bf16(Bt[n][k], At[m][k], acc[ai][bj][m][n], 0, 0, 0); __builtin_amdgcn_s_setprio(0); } while (0)
#define PG8_WAIT_V(n) asm volatile("s_waitcnt vmcnt(" #n ")" ::: "memory")
#define PG8_WAIT_L(n) asm volatile("s_waitcnt lgkmcnt(" #n ")" ::: "memory")
#define PG8_BAR __builtin_amdgcn_s_barrier()
#define PG8_SCHED __builtin_amdgcn_sched_barrier(0)
    Unit cur, nxt; int ui = 0;
    if (!S.next(0, cur)) return;
    f32x4 acc[2][2][4][2];
#pragma unroll
    for (int a = 0; a < 2; ++a)
#pragma unroll
        for (int b = 0; b < 2; ++b)
#pragma unroll
            for (int m = 0; m < 4; ++m)
#pragma unroll
                for (int n = 0; n < 2; ++n) acc[a][b][m][n] = (f32x4){0.f, 0.f, 0.f, 0.f};
    bf16x8 At[4][2], B0[2][2], B1[2][2];
    const char* cA = (const char*)g.A + (size_t)cur.pm * tstep; const char* cB = (const char*)g.Bt + (size_t)cur.pn * tstep;
    S.a_ready(cur);
    if constexpr (SP2) {
        PG8_STAGE(PG8_SB(0, 0), cB, voffB); PG8_STAGE(PG8_SB(0, 1), cB + hstep, voffB); PG8_STAGE(PG8_SA(0, 0), cA, voffA); PG8_STAGE(PG8_SA(0, 1), cA + hstep, voffA);
        if (wr == 1) PG8_BAR;
        PG8_WAIT_V(2); PG8_BAR;
        PG8_STAGE(PG8_SB(1, 0), cB + kstep, voffB); PG8_STAGE(PG8_SA(1, 0), cA + kstep, voffA); PG8_STAGE(PG8_SB(1, 1), cB + hstep + kstep, voffB);
        PG8_WAIT_V(6); PG8_BAR;
    } else {
        PG8_STAGE(PG8_SB(0, 0), cB, voffB); PG8_STAGE(PG8_SA(0, 0), cA, voffA); PG8_STAGE(PG8_SB(0, 1), cB + hstep, voffB); PG8_STAGE(PG8_SA(0, 1), cA + hstep, voffA);
        if (wr == 1) PG8_BAR;
        PG8_WAIT_V(4); PG8_BAR;
        PG8_STAGE(PG8_SB(1, 0), cB + kstep, voffB); PG8_STAGE(PG8_SA(1, 0), cA + kstep, voffA); PG8_STAGE(PG8_SB(1, 1), cB + hstep + kstep, voffB);
        PG8_WAIT_V(6); PG8_BAR;
    }
    for (;;) {
        const bool has_next = S.next(ui + 1, nxt);
        const char* nA = has_next ? (const char*)g.A + (size_t)nxt.pm * tstep : cA; const char* nB = has_next ? (const char*)g.Bt + (size_t)nxt.pn * tstep : cB;
        for (int t = 0; t < nt; t += 2) {
            const bool last = (t == nt - 2);
            const char* a1 = cA + (size_t)(t + 1) * kstep;
            const char* a2 = last ? nA : cA + (size_t)(t + 2) * kstep; const char* b2 = last ? nB : cB + (size_t)(t + 2) * kstep;
            const char* a3 = a2 + kstep; const char* b3 = b2 + kstep;
            if (last && has_next) S.a_ready(nxt);
            if constexpr (SP2) {
            PG8_LDB(B0, 0, 0); PG8_LDB(B1, 0, 1); PG8_SCHED; PG8_LDA(At, 0, 0); PG8_STAGE(PG8_SA(1, 1), a1 + hstep, voffA);
            PG8_WAIT_V(8); PG8_WAIT_L(0); PG8_BAR; PG8_MMA(0, 0, At, B0); PG8_MMA(0, 1, At, B1); PG8_BAR; PG8_SCHED;
            PG8_LDA(At, 0, 1); PG8_STAGE(PG8_SB(0, 0), b2, voffB); PG8_STAGE(PG8_SB(0, 1), b2 + hstep, voffB); PG8_STAGE(PG8_SA(0, 0), a2, voffA);
            PG8_WAIT_V(8); PG8_WAIT_L(0); PG8_BAR; PG8_MMA(1, 0, At, B0); PG8_MMA(1, 1, At, B1); PG8_BAR; PG8_SCHED;
            PG8_LDB(B0, 1, 0); PG8_LDB(B1, 1, 1); PG8_SCHED; PG8_LDA(At, 1, 0); PG8_STAGE(PG8_SA(0, 1), a2 + hstep, voffA);
            PG8_WAIT_V(8); PG8_WAIT_L(0); PG8_BAR; PG8_MMA(0, 0, At, B0); PG8_MMA(0, 1, At, B1); PG8_BAR; PG8_SCHED;
            PG8_LDA(At, 1, 1); PG8_STAGE(PG8_SB(1, 0), b3, voffB); PG8_STAGE(PG8_SB(1, 1), b3 + hstep, voffB); PG8_STAGE(PG8_SA(1, 0), a3, voffA);
            PG8_WAIT_V(8); PG8_WAIT_L(0); PG8_BAR; PG8_MMA(1, 0, At, B0); PG8_MMA(1, 1, At, B1); PG8_BAR; PG8_SCHED;
            } else {
            PG8_LDB(B0, 0, 0); PG8_SCHED; PG8_LDA(At, 0, 0); PG8_STAGE(PG8_SA(1, 1), a1 + hstep, voffA);
            PG8_WAIT_L(8); PG8_BAR; PG8_WAIT_L(0); PG8_MMA(0, 0, At, B0); PG8_BAR; PG8_SCHED;
            PG8_LDB(B1, 0, 1); PG8_STAGE(PG8_SB(0, 0), b2, voffB);
            PG8_BAR; PG8_WAIT_L(0); PG8_MMA(0, 1, At, B1); PG8_BAR;
            PG8_LDA(At, 0, 1); PG8_STAGE(PG8_SA(0, 0), a2, voffA);
            PG8_BAR; PG8_WAIT_L(0); PG8_MMA(1, 0, At, B0); PG8_BAR; PG8_SCHED;
            PG8_STAGE(PG8_SB(0, 1), b2 + hstep, voffB);
            PG8_WAIT_V(6); PG8_BAR; PG8_MMA(1, 1, At, B1); PG8_BAR;
            PG8_LDB(B0, 1, 0); PG8_SCHED; PG8_LDA(At, 1, 0); PG8_STAGE(PG8_SA(0, 1), a2 + hstep, voffA);
            PG8_WAIT_L(8); PG8_BAR; PG8_WAIT_L(0); PG8_MMA(0, 0, At, B0); PG8_BAR; PG8_SCHED;
            PG8_LDB(B1, 1, 1); PG8_STAGE(PG8_SB(1, 0), b3, voffB);
            PG8_BAR; PG8_WAIT_L(0); PG8_MMA(0, 1, At, B1); PG8_BAR;
            PG8_LDA(At, 1, 1); PG8_STAGE(PG8_SA(1, 0), a3, voffA);
            PG8_BAR; PG8_WAIT_L(0); PG8_MMA(1, 0, At, B0); PG8_BAR; PG8_SCHED;
            PG8_STAGE(PG8_SB(1, 1), b3 + hstep, voffB);
            PG8_WAIT_V(6); PG8_BAR; PG8_MMA(1, 1, At, B1); PG8_BAR;
            }
        }
        if constexpr (ALIGN_EPI) { if (wr == 0) PG8_BAR; }
        if constexpr (!Epi::AFTER_DRAIN) { E(acc, cur, wr, wc, fr, fq); S.done(cur); }
        if (!has_next) break;
#pragma unroll
        for (int a = 0; a < 2; ++a)
#pragma unroll
            for (int b = 0; b < 2; ++b)
#pragma unroll
                for (int m = 0; m < 4; ++m)
#pragma unroll
                    for (int n = 0; n < 2; ++n) acc[a][b][m][n] = (f32x4){0.f, 0.f, 0.f, 0.f};
        cur = nxt; cA = nA; cB = nB; ++ui;
        if constexpr (ALIGN_EPI) { if (wr == 1) PG8_BAR; }
    }
    PG8_WAIT_V(0);
    if constexpr (!ALIGN_EPI) { if (wr == 0) PG8_BAR; }
    PG8_BAR;
#undef PG8_SA
#undef PG8_SB
#undef PG8_STAGE
#undef PG8_LDA
#undef PG8_LDB
#undef PG8_MMA
#undef PG8_WAIT_V
#undef PG8_WAIT_L
#undef PG8_BAR
#undef PG8_SCHED
}
}

namespace att {
constexpr int NW = 8, QBLK = 32, KVBLK = 64;
constexpr int SHM_V = KVBLK * 128 * 2;
#define SBAR() __builtin_amdgcn_sched_barrier(0)
__device__ __forceinline__ int crow(int r, int hi) { return (r & 3) + 8 * (r >> 2) + 4 * hi; }
__device__ __forceinline__ unsigned cvtpk(float lo, float hi) { unsigned r; asm volatile("v_cvt_pk_bf16_f32 %0, %1, %2" : "=v"(r) : "v"(lo), "v"(hi)); return r; }

constexpr float THR2 = 8.0f * 1.4426950408889634f;
template <bool FIRST>
__device__ __forceinline__ void partialSM(f32x16& p0, f32x16& p1, float& mC, float& alpha) {
  float mx_[4] = {p0[0], p0[1], p0[2], p0[3]};
#pragma unroll
  for (int r = 4; r < 16; ++r) mx_[r & 3] = fmaxf(mx_[r & 3], p0[r]);
#pragma unroll
  for (int r = 0; r < 16; ++r) mx_[r & 3] = fmaxf(mx_[r & 3], p1[r]);
  float pmax = fmaxf(fmaxf(mx_[0], mx_[1]), fmaxf(mx_[2], mx_[3]));
  { auto rr = __builtin_amdgcn_permlane32_swap(__float_as_uint(pmax), __float_as_uint(pmax), false, false);
    pmax = fmaxf(__uint_as_float(rr[0]), __uint_as_float(rr[1])); }
  if (!FIRST && __builtin_expect(__all(pmax <= THR2), 1)) { alpha = 1.f; }
  else { const float delta = FIRST ? fmaxf(pmax, -200.f) : fmaxf(pmax, 0.f); alpha = FIRST ? 1.f : __builtin_amdgcn_exp2f(-delta); mC += delta;
#pragma unroll
    for (int r = 0; r < 16; ++r) p0[r] -= delta;
#pragma unroll
    for (int r = 0; r < 16; ++r) p1[r] -= delta; }
#pragma unroll
  for (int r = 0; r < 16; ++r) p0[r] = __builtin_amdgcn_exp2f(p0[r]);
}
__device__ __forceinline__ void finishSM(f32x16& p0, f32x16& p1, float alpha, float& l_reg, bf16x8& pa0, bf16x8& pa1, bf16x8& pa2, bf16x8& pa3) {
#pragma unroll
  for (int r = 0; r < 16; ++r) p1[r] = __builtin_amdgcn_exp2f(p1[r]);
  float sm_[4] = {p0[0], p0[1], p0[2], p0[3]};
#pragma unroll
  for (int r = 4; r < 16; ++r) sm_[r & 3] += p0[r];
#pragma unroll
  for (int r = 0; r < 16; ++r) sm_[r & 3] += p1[r];
  float ps = (sm_[0] + sm_[1]) + (sm_[2] + sm_[3]);
  { auto rr = __builtin_amdgcn_permlane32_swap(__float_as_uint(ps), __float_as_uint(ps), false, false);
    ps = __uint_as_float(rr[0]) + __uint_as_float(rr[1]); }
  l_reg = l_reg * alpha + ps;
#define PK4(P, BASE, OUT) do { unsigned a0 = cvtpk(P[BASE + 0], P[BASE + 1]), a1 = cvtpk(P[BASE + 2], P[BASE + 3]);   \
    unsigned b0 = cvtpk(P[BASE + 4], P[BASE + 5]), b1 = cvtpk(P[BASE + 6], P[BASE + 7]);                              \
    auto r0 = __builtin_amdgcn_permlane32_swap(a0, b0, false, false); auto r1 = __builtin_amdgcn_permlane32_swap(a1, b1, false, false); \
    u32x4 w = {r0[0], r1[0], r0[1], r1[1]}; OUT = *reinterpret_cast<bf16x8*>(&w); } while (0)
  PK4(p0, 0, pa0); PK4(p0, 8, pa1); PK4(p1, 0, pa2); PK4(p1, 8, pa3);
#undef PK4
}
template <int NDQ, int NQL>
__device__ __forceinline__ void qkt(f32x16& p0, f32x16& p1, const f32x16& negm, const char* Ks, const bf16x8* qr, const char* qls, int r32, int hi) {
  constexpr int ROWB = NDQ * 32, NQR = NDQ - NQL, SWM = (NDQ == 8) ? 15 : 7;
#pragma unroll
  for (int d0 = 0; d0 < NDQ; ++d0) { const int cb = (d0 * 16 + hi * 8) * 2;
    bf16x8 b0 = *reinterpret_cast<const bf16x8*>(Ks + r32 * ROWB + (cb ^ ((r32 & SWM) << 4)));
    bf16x8 b1 = *reinterpret_cast<const bf16x8*>(Ks + (32 + r32) * ROWB + (cb ^ ((r32 & SWM) << 4)));
    bf16x8 q;
    if constexpr (NQL > 0) { if (d0 < NQR) q = qr[d0 < NQR ? d0 : 0]; else q = *reinterpret_cast<const bf16x8*>(qls + (d0 - NQR) * 1024); }
    else q = qr[d0];
    if (d0 == 0) { p0 = __builtin_amdgcn_mfma_f32_32x32x16_bf16(b0, q, negm, 0, 0, 0); p1 = __builtin_amdgcn_mfma_f32_32x32x16_bf16(b1, q, negm, 0, 0, 0); }
    else { p0 = __builtin_amdgcn_mfma_f32_32x32x16_bf16(b0, q, p0, 0, 0, 0); p1 = __builtin_amdgcn_mfma_f32_32x32x16_bf16(b1, q, p1, 0, 0, 0); } }
}
__device__ __forceinline__ int v_st(int k, int c) { const int kk = (k & ~0xC) | ((k & 4) << 1) | ((k & 8) >> 1); return ((kk >> 3) * 4 + (c >> 5)) * 512 + ((kk & 7) * 32 + (c & 31)) * 2; }
__device__ __forceinline__ int v_rd_base(int lane) { return ((lane & 3) << 3) | (((lane >> 2) & 3) << 6) | (((lane >> 4) & 1) << 5) | (((lane >> 5) & 1) << 8); }
constexpr int v_rd_off(int d0, int ks, int half) { return d0 * 512 + ks * 4096 + half * 2048; }
template <int OFF> __device__ __forceinline__ s16x4 tr_read(int vb) {
  s16x4 r; asm volatile("ds_read_b64_tr_b16 %0, %1 offset:%2" : "=&v"(r) : "v"(vb), "i"(OFF) : "memory"); return r;
}
template <int D0> __device__ __forceinline__ void pv_one(f32x16& od, int vb, bf16x8 pa0, bf16x8 pa1, bf16x8 pa2, bf16x8 pa3) {
  const s16x4 l0 = tr_read<v_rd_off(D0, 0, 0)>(vb), h0 = tr_read<v_rd_off(D0, 0, 1)>(vb), l1 = tr_read<v_rd_off(D0, 1, 0)>(vb), h1 = tr_read<v_rd_off(D0, 1, 1)>(vb);
  const s16x4 l2 = tr_read<v_rd_off(D0, 2, 0)>(vb), h2 = tr_read<v_rd_off(D0, 2, 1)>(vb), l3 = tr_read<v_rd_off(D0, 3, 0)>(vb), h3 = tr_read<v_rd_off(D0, 3, 1)>(vb);
  asm volatile("s_waitcnt lgkmcnt(0)" ::: "memory"); SBAR();
#define PK(L, H) (bf16x8){L[0], L[1], L[2], L[3], H[0], H[1], H[2], H[3]}
  od = __builtin_amdgcn_mfma_f32_32x32x16_bf16(pa0, PK(l0, h0), od, 0, 0, 0);
  od = __builtin_amdgcn_mfma_f32_32x32x16_bf16(pa1, PK(l1, h1), od, 0, 0, 0);
  od = __builtin_amdgcn_mfma_f32_32x32x16_bf16(pa2, PK(l2, h2), od, 0, 0, 0);
  od = __builtin_amdgcn_mfma_f32_32x32x16_bf16(pa3, PK(l3, h3), od, 0, 0, 0);
#undef PK
}
__device__ __forceinline__ void pv_d0(f32x16* o, int vb, bf16x8 pa0, bf16x8 pa1, bf16x8 pa2, bf16x8 pa3) {
#define PK(L, H) (bf16x8){L[0], L[1], L[2], L[3], H[0], H[1], H[2], H[3]}
  const s16x4 l0 = tr_read<v_rd_off(0, 0, 0)>(vb), h0 = tr_read<v_rd_off(0, 0, 1)>(vb);
  const s16x4 l1 = tr_read<v_rd_off(0, 1, 0)>(vb), h1 = tr_read<v_rd_off(0, 1, 1)>(vb);
  const s16x4 l2 = tr_read<v_rd_off(0, 2, 0)>(vb), h2 = tr_read<v_rd_off(0, 2, 1)>(vb);
  const s16x4 l3 = tr_read<v_rd_off(0, 3, 0)>(vb), h3 = tr_read<v_rd_off(0, 3, 1)>(vb);
  const s16x4 l4 = tr_read<v_rd_off(1, 0, 0)>(vb), h4 = tr_read<v_rd_off(1, 0, 1)>(vb);
  asm volatile("s_waitcnt lgkmcnt(8)" ::: "memory"); SBAR();
  o[0] = __builtin_amdgcn_mfma_f32_32x32x16_bf16(pa0, PK(l0, h0), o[0], 0, 0, 0);
  const s16x4 l5 = tr_read<v_rd_off(1, 1, 0)>(vb), h5 = tr_read<v_rd_off(1, 1, 1)>(vb);
  asm volatile("s_waitcnt lgkmcnt(8)" ::: "memory"); SBAR();
  o[0] = __builtin_amdgcn_mfma_f32_32x32x16_bf16(pa1, PK(l1, h1), o[0], 0, 0, 0);
  const s16x4 l6 = tr_read<v_rd_off(1, 2, 0)>(vb), h6 = tr_read<v_rd_off(1, 2, 1)>(vb);
  asm volatile("s_waitcnt lgkmcnt(8)" ::: "memory"); SBAR();
  o[0] = __builtin_amdgcn_mfma_f32_32x32x16_bf16(pa2, PK(l2, h2), o[0], 0, 0, 0);
  const s16x4 l7 = tr_read<v_rd_off(1, 3, 0)>(vb), h7 = tr_read<v_rd_off(1, 3, 1)>(vb);
  asm volatile("s_waitcnt lgkmcnt(8)" ::: "memory"); SBAR();
  o[0] = __builtin_amdgcn_mfma_f32_32x32x16_bf16(pa3, PK(l3, h3), o[0], 0, 0, 0);
  const s16x4 l8 = tr_read<v_rd_off(2, 0, 0)>(vb), h8 = tr_read<v_rd_off(2, 0, 1)>(vb);
  asm volatile("s_waitcnt lgkmcnt(8)" ::: "memory"); SBAR();
  o[1] = __builtin_amdgcn_mfma_f32_32x32x16_bf16(pa0, PK(l4, h4), o[1], 0, 0, 0);
  const s16x4 l9 = tr_read<v_rd_off(2, 1, 0)>(vb), h9 = tr_read<v_rd_off(2, 1, 1)>(vb);
  asm volatile("s_waitcnt lgkmcnt(8)" ::: "memory"); SBAR();
  o[1] = __builtin_amdgcn_mfma_f32_32x32x16_bf16(pa1, PK(l5, h5), o[1], 0, 0, 0);
  const s16x4 l10 = tr_read<v_rd_off(2, 2, 0)>(vb), h10 = tr_read<v_rd_off(2, 2, 1)>(vb);
  asm volatile("s_waitcnt lgkmcnt(8)" ::: "memory"); SBAR();
  o[1] = __builtin_amdgcn_mfma_f32_32x32x16_bf16(pa2, PK(l6, h6), o[1], 0, 0, 0);
  const s16x4 l11 = tr_read<v_rd_off(2, 3, 0)>(vb), h11 = tr_read<v_rd_off(2, 3, 1)>(vb);
  asm volatile("s_waitcnt lgkmcnt(8)" ::: "memory"); SBAR();
  o[1] = __builtin_amdgcn_mfma_f32_32x32x16_bf16(pa3, PK(l7, h7), o[1], 0, 0, 0);
  const s16x4 l12 = tr_read<v_rd_off(3, 0, 0)>(vb), h12 = tr_read<v_rd_off(3, 0, 1)>(vb);
  asm volatile("s_waitcnt lgkmcnt(8)" ::: "memory"); SBAR();
  o[2] = __builtin_amdgcn_mfma_f32_32x32x16_bf16(pa0, PK(l8, h8), o[2], 0, 0, 0);
  const s16x4 l13 = tr_read<v_rd_off(3, 1, 0)>(vb), h13 = tr_read<v_rd_off(3, 1, 1)>(vb);
  asm volatile("s_waitcnt lgkmcnt(8)" ::: "memory"); SBAR();
  o[2] = __builtin_amdgcn_mfma_f32_32x32x16_bf16(pa1, PK(l9, h9), o[2], 0, 0, 0);
  const s16x4 l14 = tr_read<v_rd_off(3, 2, 0)>(vb), h14 = tr_read<v_rd_off(3, 2, 1)>(vb);
  asm volatile("s_waitcnt lgkmcnt(8)" ::: "memory"); SBAR();
  o[2] = __builtin_amdgcn_mfma_f32_32x32x16_bf16(pa2, PK(l10, h10), o[2], 0, 0, 0);
  const s16x4 l15 = tr_read<v_rd_off(3, 3, 0)>(vb), h15 = tr_read<v_rd_off(3, 3, 1)>(vb);
  asm volatile("s_waitcnt lgkmcnt(8)" ::: "memory"); SBAR();
  o[2] = __builtin_amdgcn_mfma_f32_32x32x16_bf16(pa3, PK(l11, h11), o[2], 0, 0, 0);
  asm volatile("s_waitcnt lgkmcnt(6)" ::: "memory"); SBAR();
  o[3] = __builtin_amdgcn_mfma_f32_32x32x16_bf16(pa0, PK(l12, h12), o[3], 0, 0, 0);
  asm volatile("s_waitcnt lgkmcnt(4)" ::: "memory"); SBAR();
  o[3] = __builtin_amdgcn_mfma_f32_32x32x16_bf16(pa1, PK(l13, h13), o[3], 0, 0, 0);
  asm volatile("s_waitcnt lgkmcnt(2)" ::: "memory"); SBAR();
  o[3] = __builtin_amdgcn_mfma_f32_32x32x16_bf16(pa2, PK(l14, h14), o[3], 0, 0, 0);
  asm volatile("s_waitcnt lgkmcnt(0)" ::: "memory"); SBAR();
  o[3] = __builtin_amdgcn_mfma_f32_32x32x16_bf16(pa3, PK(l15, h15), o[3], 0, 0, 0);
#undef PK
}

constexpr int LDS_K_OFF = 2 * SHM_V, LDS_WS_OFF = LDS_K_OFF + 2 * 12 * 2048, LDS_TBL_OFF = LDS_WS_OFF + NW * 64 * 4, LDS_Q_OFF = LDS_TBL_OFF + ((TBLN * 4 + 15) / 16) * 16;
static_assert(LDS_Q_OFF + NW * 8192 <= 163840, "attention LDS map");

template <int NDQ, int BIAS, int EPI, int SDEPTH, int NQL = 0, int ROPEQ = 0>
__device__ __forceinline__ void attn_unit(const bf16_t* __restrict__ Qb, int ldq, const bf16_t* __restrict__ Kh, int ldk, const bf16_t* __restrict__ K2, int ldk2,
                                          const bf16_t* __restrict__ Vh, int ldv, int kbeg, int nkeys, int q0, const float* __restrict__ tblg, float cb_lo, float cb_hi,
                                          bf16_t* __restrict__ Obf, int ldo, float* __restrict__ tmp, float lam, const float* __restrict__ subln, float post, char* lds, const int wave0, const float* __restrict__ cosp = nullptr, const float* __restrict__ sinp = nullptr) {
  constexpr int ROWB = NDQ * 32, SHM_K = 64 * ROWB;
  int tid_ = wave0 * 64 + lane_id_v();
  const int tid = tid_, wid = tid >> 6, lane = tid & 63, r32 = lane & 31, hi = lane >> 5;
  char* V_lds = lds; char* K_lds = lds + LDS_K_OFF;
  float* ws = (float*)(lds + LDS_WS_OFF) + wid * 64; float* li_l = ws; float* al_l = ws + 32;
  float* tbl_l = (float*)(lds + LDS_TBL_OFF);
  __syncthreads();
  if constexpr (BIAS) { for (int i = tid; i < TBLN; i += 512) tbl_l[i] = tblg[i]; }
  float mC = 0.f, l_reg = 0, nm_cur = 0.f; f32x16 o[4] = {}; f32x16 negm = {}; bf16x8 qr[NDQ - NQL];
  const bf16_t* Qw = Qb + (long)(wid * QBLK + r32) * ldq + hi * 8;
  char* qls = lds + LDS_Q_OFF + wid * 8192 + lane * 16;
#pragma unroll
  for (int d0 = 0; d0 < NDQ - NQL; ++d0) qr[d0] = *reinterpret_cast<const bf16x8*>(Qw + d0 * 16);
  if constexpr (ROPEQ) {
    static_assert(NDQ == 12 && NQL >= 4, "ROPEQ: MLA layout");
#pragma unroll
    for (int d0 = NDQ - NQL; d0 < 8; ++d0) *reinterpret_cast<bf16x8*>(qls + (d0 - (NDQ - NQL)) * 1024) = *reinterpret_cast<const bf16x8*>(Qw + d0 * 16);
    const int qrow = q0 + wid * QBLK + r32;
#pragma unroll
    for (int pr = 0; pr < 2; ++pr) {
      const bf16x8 xa = *reinterpret_cast<const bf16x8*>(Qw + (8 + pr) * 16), xb = *reinterpret_cast<const bf16x8*>(Qw + (10 + pr) * 16);
      const float* cp = cosp + (size_t)qrow * 32 + pr * 16 + hi * 8; const float* sp = sinp + (size_t)qrow * 32 + pr * 16 + hi * 8;
      const f32x4 c0 = *(const f32x4*)cp, c1 = *(const f32x4*)(cp + 4), s0 = *(const f32x4*)sp, s1 = *(const f32x4*)(sp + 4);
      float ya[8], yb[8];
#pragma unroll
      for (int t = 0; t < 8; ++t) { const float x1 = bf2f((unsigned short)xa[t]), x2 = bf2f((unsigned short)xb[t]); const float c = t < 4 ? c0[t & 3] : c1[t & 3], sn = t < 4 ? s0[t & 3] : s1[t & 3];
        ya[t] = x1 * c - x2 * sn; yb[t] = x2 * c + x1 * sn; }
      u32x4 wa = {pk2(ya[0], ya[1]), pk2(ya[2], ya[3]), pk2(ya[4], ya[5]), pk2(ya[6], ya[7])}, wb = {pk2(yb[0], yb[1]), pk2(yb[2], yb[3]), pk2(yb[4], yb[5]), pk2(yb[6], yb[7])};
      *reinterpret_cast<u32x4*>(qls + (8 + pr - (NDQ - NQL)) * 1024) = wa; *reinterpret_cast<u32x4*>(qls + (10 + pr - (NDQ - NQL)) * 1024) = wb; }
  } else {
#pragma unroll
  for (int d0 = NDQ - NQL; d0 < NDQ; ++d0) *reinterpret_cast<bf16x8*>(qls + (d0 - (NDQ - NQL)) * 1024) = *reinterpret_cast<const bf16x8*>(Qw + d0 * 16);
  }
  const int sr = tid >> 4, sc = (tid & 15) * 8, vst0 = v_st(sr, sc), vst1 = v_st(32 + sr, sc);
  const int sr8 = tid >> 3, sc8 = (tid & 7) * 8;
  const int vb0 = (int)(uintptr_t)V_lds + v_rd_base(lane);
  const int qlane = q0 + wid * QBLK + r32;
  struct { bf16x8 vs0, vs1, ks0, ks1, ks2; } sr_[SDEPTH];
  constexpr int SWM = (NDQ == 8) ? 15 : 7;
#define KSWZ(row, colB) ((row) * ROWB + ((colB) ^ (((row) & SWM) << 4)))
#define SLOAD(i, k0) do { sr_[i].vs0 = *reinterpret_cast<const bf16x8*>(&Vh[(long)((k0) + sr) * ldv + sc]); sr_[i].vs1 = *reinterpret_cast<const bf16x8*>(&Vh[(long)((k0) + 32 + sr) * ldv + sc]); \
    if constexpr (NDQ == 4) { sr_[i].ks0 = *reinterpret_cast<const bf16x8*>(&Kh[(long)((k0) + sr8) * ldk + sc8]); } \
    else { sr_[i].ks0 = *reinterpret_cast<const bf16x8*>(&Kh[(long)((k0) + sr) * ldk + sc]); sr_[i].ks1 = *reinterpret_cast<const bf16x8*>(&Kh[(long)((k0) + 32 + sr) * ldk + sc]); \
      if constexpr (NDQ == 12) { sr_[i].ks2 = *reinterpret_cast<const bf16x8*>(&K2[(long)((k0) + sr8) * ldk2 + sc8]); } } } while (0)
#define SWRITE(b, i) do { *(bf16x8*)(V_lds + (b) * SHM_V + vst0) = sr_[i].vs0; *(bf16x8*)(V_lds + (b) * SHM_V + vst1) = sr_[i].vs1; \
    if constexpr (NDQ == 4) { *(bf16x8*)(K_lds + (b) * SHM_K + KSWZ(sr8, sc8 * 2)) = sr_[i].ks0; } \
    else { *(bf16x8*)(K_lds + (b) * SHM_K + KSWZ(sr, sc * 2)) = sr_[i].ks0; *(bf16x8*)(K_lds + (b) * SHM_K + KSWZ(32 + sr, sc * 2)) = sr_[i].ks1; \
      if constexpr (NDQ == 12) { *(bf16x8*)(K_lds + (b) * SHM_K + KSWZ(sr8, 256 + sc8 * 2)) = sr_[i].ks2; } } } while (0)
#define SWAIT() do { if constexpr (SDEPTH == 2) { if constexpr (NDQ == 4) asm volatile("s_waitcnt vmcnt(3)" ::: "memory"); else if constexpr (NDQ == 8) asm volatile("s_waitcnt vmcnt(4)" ::: "memory"); else asm volatile("s_waitcnt vmcnt(5)" ::: "memory"); } \
    else asm volatile("s_waitcnt vmcnt(0)" ::: "memory"); } while (0)
#define RESC(a) do { if (__any((a) < 1.f)) { if (hi == 0) al_l[r32] = (a); asm volatile("s_waitcnt lgkmcnt(0)" ::: "memory"); \
    _Pragma("unroll") for (int d = 0; d < 4; ++d) _Pragma("unroll") for (int r = 0; r < 16; ++r) o[d][r] *= al_l[crow(r, hi)]; } } while (0)
#define BIASADD(P0, P1, kt0) do { if constexpr (BIAS) { const int dlo_ = (kt0) - q0 - 255, dhi_ = (kt0) + 63 - q0; \
    if (!(dlo_ >= 1024) && !(dhi_ <= -1024)) { const float* tb_ = tbl_l + ((kt0) - qlane + TOFF + 4 * hi); \
      _Pragma("unroll") for (int r = 0; r < 16; ++r) { P0[r] += tb_[(r & 3) + 8 * (r >> 2)]; P1[r] += tb_[32 + (r & 3) + 8 * (r >> 2)]; } } } } while (0)
#define NEGM_UPD(kt0) do { float nmj_ = -mC; if constexpr (BIAS) { const int dlo_ = (kt0) - q0 - 255, dhi_ = (kt0) + 63 - q0; if (dlo_ >= 1024) nmj_ += cb_hi; else if (dhi_ <= -1024) nmj_ += cb_lo; } \
    if (__any(nmj_ != nm_cur)) { nm_cur = nmj_; _Pragma("unroll") for (int r = 0; r < 16; ++r) negm[r] = nmj_; } } while (0)
  f32x16 pA0, pA1, pB0, pB1; float alA, alB; bf16x8 pa0, pa1, pa2, pa3; const int NT = nkeys / KVBLK;
  constexpr int SE = 0, SO = SDEPTH - 1;
  SLOAD(SE, kbeg); asm volatile("s_waitcnt vmcnt(0)" ::: "memory"); SWRITE(0, SE); __syncthreads();
  NEGM_UPD(kbeg); qkt<NDQ, NQL>(pA0, pA1, negm, K_lds, qr, qls, r32, hi); BIASADD(pA0, pA1, kbeg); partialSM<true>(pA0, pA1, mC, alA);
  SLOAD(SO, kbeg + KVBLK); if constexpr (SDEPTH == 2) { if (2 < NT) SLOAD(SE, kbeg + 2 * KVBLK); }
  SWAIT(); SWRITE(1, SO); __syncthreads();
  for (int j = 1; j + 1 < NT; j += 2) {
    NEGM_UPD(kbeg + j * KVBLK); SBAR(); qkt<NDQ, NQL>(pB0, pB1, negm, K_lds + SHM_K, qr, qls, r32, hi);
    finishSM(pA0, pA1, alA, l_reg, pa0, pa1, pa2, pa3); SBAR();
    SLOAD(SO, kbeg + (j + SDEPTH) * KVBLK); SBAR();
    pv_d0(o, vb0, pa0, pa1, pa2, pa3); BIASADD(pB0, pB1, kbeg + j * KVBLK); partialSM<false>(pB0, pB1, mC, alB);
    __syncthreads(); SWAIT(); SWRITE(0, SE);
    RESC(alB); __syncthreads();
    NEGM_UPD(kbeg + (j + 1) * KVBLK); SBAR(); qkt<NDQ, NQL>(pA0, pA1, negm, K_lds, qr, qls, r32, hi);
    finishSM(pB0, pB1, alB, l_reg, pa0, pa1, pa2, pa3); SBAR();
    if (SDEPTH == 1 || j + 3 < NT) SLOAD(SE, kbeg + (j + 1 + SDEPTH) * KVBLK); SBAR();
    pv_d0(o, vb0 + (int)SHM_V, pa0, pa1, pa2, pa3); BIASADD(pA0, pA1, kbeg + (j + 1) * KVBLK); partialSM<false>(pA0, pA1, mC, alA);
    __syncthreads(); SWAIT(); SWRITE(1, SO);
    RESC(alA); __syncthreads();
  }
  NEGM_UPD(kbeg + (NT - 1) * KVBLK); SBAR(); qkt<NDQ, NQL>(pB0, pB1, negm, K_lds + SHM_K, qr, qls, r32, hi);
  finishSM(pA0, pA1, alA, l_reg, pa0, pa1, pa2, pa3); SBAR();
  pv_d0(o, vb0, pa0, pa1, pa2, pa3); BIASADD(pB0, pB1, kbeg + (NT - 1) * KVBLK); partialSM<false>(pB0, pB1, mC, alB);
  __syncthreads(); RESC(alB);
  finishSM(pB0, pB1, alB, l_reg, pa0, pa1, pa2, pa3); SBAR();
  pv_d0(o, vb0 + (int)SHM_V, pa0, pa1, pa2, pa3);
  if (hi == 0) li_l[r32] = l_reg; asm volatile("s_waitcnt lgkmcnt(0)" ::: "memory");
  float rli[16];
#pragma unroll
  for (int r = 0; r < 16; ++r) rli[r] = __builtin_amdgcn_rcpf(li_l[crow(r, hi)]);
  if constexpr (EPI == 0) {
    bf16_t* Ow = Obf + (long)(wid * QBLK) * ldo;
#pragma unroll
    for (int r = 0; r < 16; ++r) { const int orow = crow(r, hi);
#pragma unroll
      for (int d0 = 0; d0 < 4; ++d0) Ow[(long)orow * ldo + d0 * 32 + r32] = (bf16_t)f2bf(o[d0][r] * rli[r]); }
  } else if constexpr (EPI == 1) {
    float* Tw = tmp + (wid * QBLK) * 128;
#pragma unroll
    for (int r = 0; r < 16; ++r) { const int orow = crow(r, hi);
#pragma unroll
      for (int d0 = 0; d0 < 4; ++d0) Tw[orow * 128 + d0 * 32 + r32] = o[d0][r] * rli[r]; }
  } else {
    const float* Tw = tmp + (wid * QBLK) * 128; bf16_t* Ow = Obf + (long)(wid * QBLK) * ldo;
    float sg[4];
#pragma unroll
    for (int d0 = 0; d0 < 4; ++d0) sg[d0] = subln[d0 * 32 + r32] * post;
#pragma unroll
    for (int r = 0; r < 16; ++r) { const int orow = crow(r, hi); float v[4]; float ss = 0.f;
#pragma unroll
      for (int d0 = 0; d0 < 4; ++d0) { v[d0] = Tw[orow * 128 + d0 * 32 + r32] - lam * (o[d0][r] * rli[r]); ss += v[d0] * v[d0]; }
      ss += swz_xor<1>(ss); ss += swz_xor<2>(ss); ss += swz_xor<4>(ss); ss += swz_xor<8>(ss); ss += swz_xor<16>(ss);
      const float rs = rsqrtf(ss * (1.0f / 128.0f) + EPS);
#pragma unroll
      for (int d0 = 0; d0 < 4; ++d0) Ow[(long)orow * ldo + d0 * 32 + r32] = (bf16_t)f2bf(v[d0] * rs * sg[d0]); }
  }
#undef KSWZ
#undef SLOAD
#undef SWRITE
#undef SWAIT
#undef RESC
#undef BIASADD
#undef NEGM_UPD
}

template <int M>
__device__ __forceinline__ void qkt_map(f32x16& p0, f32x16& p1, const char* Ks, const char* qls, int r32, int hi) {
  p0 = f32x16{}; p1 = f32x16{};
#pragma unroll
  for (int d0 = 0; d0 < 4; ++d0) { const int cb = (M * 64 + d0 * 16 + hi * 8) * 2;
    bf16x8 b0 = *reinterpret_cast<const bf16x8*>(Ks + r32 * 256 + (cb ^ ((r32 & 15) << 4)));
    bf16x8 b1 = *reinterpret_cast<const bf16x8*>(Ks + (32 + r32) * 256 + (cb ^ ((r32 & 15) << 4)));
    bf16x8 q = *reinterpret_cast<const bf16x8*>(qls + (M * 4 + d0) * 1024);
    p0 = __builtin_amdgcn_mfma_f32_32x32x16_bf16(b0, q, p0, 0, 0, 0);
    p1 = __builtin_amdgcn_mfma_f32_32x32x16_bf16(b1, q, p1, 0, 0, 0);
    if (d0 == 1) SBAR(); }
}
__device__ __forceinline__ void softmax_tile(f32x16& p0, f32x16& p1, float& m, float& l, float& alpha, float cb, bf16x8& pa0, bf16x8& pa1, bf16x8& pa2, bf16x8& pa3) {
  float mx_[4] = {p0[0], p0[1], p0[2], p0[3]};
#pragma unroll
  for (int r = 4; r < 16; ++r) mx_[r & 3] = fmaxf(mx_[r & 3], p0[r]);
#pragma unroll
  for (int r = 0; r < 16; ++r) mx_[r & 3] = fmaxf(mx_[r & 3], p1[r]);
  float pmax = fmaxf(fmaxf(mx_[0], mx_[1]), fmaxf(mx_[2], mx_[3]));
  { auto rr = __builtin_amdgcn_permlane32_swap(__float_as_uint(pmax), __float_as_uint(pmax), false, false);
    pmax = fmaxf(__uint_as_float(rr[0]), __uint_as_float(rr[1])); }
  pmax += cb;
  float mn;
  if (__builtin_expect(__all(pmax - m <= THR2), 1)) { mn = m; alpha = 1.f; }
  else { mn = fmaxf(m, pmax); alpha = __builtin_amdgcn_exp2f(m - mn); m = mn; }
  const float off = cb - mn;
#pragma unroll
  for (int r = 0; r < 16; ++r) p0[r] = __builtin_amdgcn_exp2f(p0[r] + off);
#pragma unroll
  for (int r = 0; r < 16; ++r) p1[r] = __builtin_amdgcn_exp2f(p1[r] + off);
  float sm_[4] = {p0[0], p0[1], p0[2], p0[3]};
#pragma unroll
  for (int r = 4; r < 16; ++r) sm_[r & 3] += p0[r];
#pragma unroll
  for (int r = 0; r < 16; ++r) sm_[r & 3] += p1[r];
  float ps = (sm_[0] + sm_[1]) + (sm_[2] + sm_[3]);
  { auto rr = __builtin_amdgcn_permlane32_swap(__float_as_uint(ps), __float_as_uint(ps), false, false);
    ps = __uint_as_float(rr[0]) + __uint_as_float(rr[1]); }
  l = l * alpha + ps;
#define PK4(P, BASE, OUT) do { unsigned a0 = cvtpk(P[BASE + 0], P[BASE + 1]), a1 = cvtpk(P[BASE + 2], P[BASE + 3]);   \
    unsigned b0 = cvtpk(P[BASE + 4], P[BASE + 5]), b1 = cvtpk(P[BASE + 6], P[BASE + 7]);                              \
    auto r0 = __builtin_amdgcn_permlane32_swap(a0, b0, false, false); auto r1 = __builtin_amdgcn_permlane32_swap(a1, b1, false, false); \
    u32x4 w = {r0[0], r1[0], r0[1], r1[1]}; OUT = *reinterpret_cast<bf16x8*>(&w); } while (0)
  PK4(p0, 0, pa0); PK4(p0, 8, pa1); PK4(p1, 0, pa2); PK4(p1, 8, pa3);
#undef PK4
}
template <int D0> __device__ __forceinline__ void pv2_one(f32x16& oa, f32x16& ob, int vb, bf16x8 pa0, bf16x8 pa1, bf16x8 pa2, bf16x8 pa3, bf16x8 pb0, bf16x8 pb1, bf16x8 pb2, bf16x8 pb3) {
  const s16x4 l0 = tr_read<v_rd_off(D0, 0, 0)>(vb), h0 = tr_read<v_rd_off(D0, 0, 1)>(vb), l1 = tr_read<v_rd_off(D0, 1, 0)>(vb), h1 = tr_read<v_rd_off(D0, 1, 1)>(vb);
  const s16x4 l2 = tr_read<v_rd_off(D0, 2, 0)>(vb), h2 = tr_read<v_rd_off(D0, 2, 1)>(vb), l3 = tr_read<v_rd_off(D0, 3, 0)>(vb), h3 = tr_read<v_rd_off(D0, 3, 1)>(vb);
  asm volatile("s_waitcnt lgkmcnt(0)" ::: "memory"); SBAR();
#define PK(L, H) (bf16x8){L[0], L[1], L[2], L[3], H[0], H[1], H[2], H[3]}
  const bf16x8 v0 = PK(l0, h0), v1 = PK(l1, h1), v2 = PK(l2, h2), v3 = PK(l3, h3);
  oa = __builtin_amdgcn_mfma_f32_32x32x16_bf16(pa0, v0, oa, 0, 0, 0);
  ob = __builtin_amdgcn_mfma_f32_32x32x16_bf16(pb0, v0, ob, 0, 0, 0);
  oa = __builtin_amdgcn_mfma_f32_32x32x16_bf16(pa1, v1, oa, 0, 0, 0);
  ob = __builtin_amdgcn_mfma_f32_32x32x16_bf16(pb1, v1, ob, 0, 0, 0);
  oa = __builtin_amdgcn_mfma_f32_32x32x16_bf16(pa2, v2, oa, 0, 0, 0);
  ob = __builtin_amdgcn_mfma_f32_32x32x16_bf16(pb2, v2, ob, 0, 0, 0);
  oa = __builtin_amdgcn_mfma_f32_32x32x16_bf16(pa3, v3, oa, 0, 0, 0);
  ob = __builtin_amdgcn_mfma_f32_32x32x16_bf16(pb3, v3, ob, 0, 0, 0);
#undef PK
}
__device__ __forceinline__ void attn_unit_A2(const bf16_t* __restrict__ Qb, int ldq, const bf16_t* __restrict__ Kh, int ldk, const bf16_t* __restrict__ Vh, int ldv, int nkeys, int q0,
                                             const float* __restrict__ tblg, float cb_lo, float cb_hi, bf16_t* __restrict__ Obf, int ldo, float lam, const float* __restrict__ subln, float post, char* lds, const int wave0) {
  constexpr int ROWB = 256, SHM_K = 64 * ROWB;
  int tid_ = wave0 * 64 + lane_id_v();
  const int tid = tid_, wid = tid >> 6, lane = tid & 63, r32 = lane & 31, hi = lane >> 5;
  char* V_lds = lds; char* K_lds = lds + LDS_K_OFF;
  float* ws = (float*)(lds + LDS_WS_OFF) + wid * 64; float* sl0 = ws; float* sl1 = ws + 32;
  float* tbl_l = (float*)(lds + LDS_TBL_OFF);
  char* qls = lds + LDS_Q_OFF + wid * 8192 + lane * 16;
  __syncthreads();
  for (int i = tid; i < TBLN; i += 512) tbl_l[i] = tblg[i];
  { const bf16_t* Qw = Qb + (long)(wid * QBLK + r32) * ldq + hi * 8;
#pragma unroll
    for (int i = 0; i < 8; ++i) *reinterpret_cast<bf16x8*>(qls + i * 1024) = *reinterpret_cast<const bf16x8*>(Qw + i * 16); }
  float m0 = -1e30f, m1 = -1e30f, l0 = 0.f, l1 = 0.f; f32x16 oa[4] = {}, ob[4] = {};
  const int sr = tid >> 4, sc = (tid & 15) * 8, vst0 = v_st(sr, sc), vst1 = v_st(32 + sr, sc);
  const int vb0 = (int)(uintptr_t)V_lds + v_rd_base(lane);
  const int qlane = q0 + wid * QBLK + r32;
  bf16x8 vs0, vs1, ks0, ks1;
#define KSWZ(row, colB) ((row) * ROWB + ((colB) ^ (((row) & 15) << 4)))
#define SLOAD2(k0) do { vs0 = *reinterpret_cast<const bf16x8*>(&Vh[(long)((k0) + sr) * ldv + sc]); vs1 = *reinterpret_cast<const bf16x8*>(&Vh[(long)((k0) + 32 + sr) * ldv + sc]); \
    ks0 = *reinterpret_cast<const bf16x8*>(&Kh[(long)((k0) + sr) * ldk + sc]); ks1 = *reinterpret_cast<const bf16x8*>(&Kh[(long)((k0) + 32 + sr) * ldk + sc]); } while (0)
#define SWRITE2(b) do { *(bf16x8*)(V_lds + (b) * SHM_V + vst0) = vs0; *(bf16x8*)(V_lds + (b) * SHM_V + vst1) = vs1; \
    *(bf16x8*)(K_lds + (b) * SHM_K + KSWZ(sr, sc * 2)) = ks0; *(bf16x8*)(K_lds + (b) * SHM_K + KSWZ(32 + sr, sc * 2)) = ks1; } while (0)
#define RESC2(O, SL, a) do { if (__any((a) < 1.f)) { if (hi == 0) SL[r32] = (a); asm volatile("s_waitcnt lgkmcnt(0)" ::: "memory"); \
    _Pragma("unroll") for (int d = 0; d < 4; ++d) _Pragma("unroll") for (int r = 0; r < 16; ++r) O[d][r] *= SL[crow(r, hi)]; } } while (0)
  const int NT = nkeys / KVBLK;
  SLOAD2(0); asm volatile("s_waitcnt vmcnt(0)" ::: "memory"); SWRITE2(0); __syncthreads();
  for (int j = 0; j < NT; ++j) {
    const int b = j & 1, kt0 = j * KVBLK;
    const int dlo_ = kt0 - q0 - 255, dhi_ = kt0 + 63 - q0;
    float cb = 0.f; const bool nearb = !(dlo_ >= 1024) && !(dhi_ <= -1024);
    if (dlo_ >= 1024) cb = cb_hi; else if (dhi_ <= -1024) cb = cb_lo;
    const float* tb_ = tbl_l + (kt0 - qlane + TOFF + 4 * hi);
    f32x16 s0, s1; bf16x8 pa0, pa1, pa2, pa3; float al0, al1;
    const int vb = vb0 + b * (int)SHM_V;
    qkt_map<0>(s0, s1, K_lds + b * SHM_K, qls, r32, hi);
    SBAR();
    if (nearb) {
#pragma unroll
      for (int r = 0; r < 8; ++r) { s0[r] += tb_[(r & 3) + 8 * (r >> 2)]; s1[r] += tb_[32 + (r & 3) + 8 * (r >> 2)]; }
      SBAR();
#pragma unroll
      for (int r = 8; r < 16; ++r) { s0[r] += tb_[(r & 3) + 8 * (r >> 2)]; s1[r] += tb_[32 + (r & 3) + 8 * (r >> 2)]; } }
    SBAR();
    softmax_tile(s0, s1, m0, l0, al0, cb, pa0, pa1, pa2, pa3);
    RESC2(oa, sl0, al0);
    SBAR();
    pv_d0(oa, vb, pa0, pa1, pa2, pa3);
    SBAR();
    qkt_map<1>(s0, s1, K_lds + b * SHM_K, qls, r32, hi);
    SBAR();
    if (nearb) {
#pragma unroll
      for (int r = 0; r < 8; ++r) { s0[r] += tb_[(r & 3) + 8 * (r >> 2)]; s1[r] += tb_[32 + (r & 3) + 8 * (r >> 2)]; }
      SBAR();
#pragma unroll
      for (int r = 8; r < 16; ++r) { s0[r] += tb_[(r & 3) + 8 * (r >> 2)]; s1[r] += tb_[32 + (r & 3) + 8 * (r >> 2)]; } }
    SBAR();
    softmax_tile(s0, s1, m1, l1, al1, cb, pa0, pa1, pa2, pa3);
    RESC2(ob, sl1, al1);
    SBAR();
    if (j + 1 < NT) SLOAD2(kt0 + KVBLK);
    SBAR();
    pv_d0(ob, vb, pa0, pa1, pa2, pa3);
    if (j + 1 < NT) { asm volatile("s_waitcnt vmcnt(0)" ::: "memory"); SWRITE2(b ^ 1); }
    __syncthreads();
  }
  const int lane_e = lane_id_v(), r32e = lane_e & 31, hie = lane_e >> 5;
  if (hie == 0) { sl0[r32e] = l0; sl1[r32e] = l1; } asm volatile("s_waitcnt lgkmcnt(0)" ::: "memory");
  bf16_t* Ow = Obf + (long)(wid * QBLK) * ldo;
  float sg[4];
#pragma unroll
  for (int d0 = 0; d0 < 4; ++d0) sg[d0] = subln[d0 * 32 + r32e] * post;
#pragma unroll
  for (int r = 0; r < 16; ++r) { const int orow = crow(r, hie); const float ra = __builtin_amdgcn_rcpf(sl0[orow]), rb = lam * __builtin_amdgcn_rcpf(sl1[orow]); float v[4]; float ss = 0.f;
#pragma unroll
    for (int d0 = 0; d0 < 4; ++d0) { v[d0] = oa[d0][r] * ra - ob[d0][r] * rb; ss += v[d0] * v[d0]; }
    ss += swz_xor<1>(ss); ss += swz_xor<2>(ss); ss += swz_xor<4>(ss); ss += swz_xor<8>(ss); ss += swz_xor<16>(ss);
    const float rs = rsqrtf(ss * (1.0f / 128.0f) + EPS);
#pragma unroll
    for (int d0 = 0; d0 < 4; ++d0) Ow[(long)orow * ldo + d0 * 32 + r32e] = (bf16_t)f2bf(v[d0] * rs * sg[d0]); }
#undef KSWZ
#undef SLOAD2
#undef SWRITE2
#undef RESC2
}
}

__device__ __forceinline__ void transpose_item(const float* __restrict__ W, int K, int N, bf16_t* __restrict__ WT, int k0, int n0, int drow0, float wscale, LAS float* scr, int lane) {
    float tv[32];
#pragma unroll
    for (int i = 0; i < 32; ++i) { const int kk = 2 * i + (lane >> 5); tv[i] = W[(size_t)(k0 + kk) * N + n0 + (lane & 31)]; }
#pragma unroll
    for (int i = 0; i < 32; ++i) { const int kk = 2 * i + (lane >> 5); scr[kk * 33 + (lane & 31)] = tv[i] * wscale; }
    asm volatile("s_waitcnt lgkmcnt(0)" ::: "memory");
    const int c = lane & 7;
#pragma unroll
    for (int j = 0; j < 4; ++j) { const int n = (lane >> 3) + 8 * j; const LAS float* s = scr + (8 * c) * 33 + n;
        u32x4 o; o.x = pk2(s[0 * 33], s[1 * 33]); o.y = pk2(s[2 * 33], s[3 * 33]); o.z = pk2(s[4 * 33], s[5 * 33]); o.w = pk2(s[6 * 33], s[7 * 33]);
        *(u32x4*)(WT + (size_t)(drow0 + n) * K + k0 + 8 * c) = o; }
    asm volatile("s_waitcnt lgkmcnt(0)" ::: "memory");
}
constexpr float QS_A = 0.125f * 1.4426950408889634f, QS_B = 0.07216878364870322f * 1.4426950408889634f, QS_CD = 0.08838834764831845f * 1.4426950408889634f;
template <int MODE>
__device__ __forceinline__ void transpose_matrix(const float* __restrict__ W, int K, int N, bf16_t* __restrict__ WT, LAS float* scr, int lane, int gw, int NGW) {
    const int nblk = N / 32, nitems = (K / 64) * nblk;
    for (int it = gw; it < nitems; it += NGW) { const int kb = it / nblk, nb = it % nblk, n0 = 32 * nb; int drow0 = n0;
        if (MODE == 1) { const int c = n0 < FF ? n0 : n0 - FF; drow0 = 256 * (c / 128) + (c % 128) + (n0 < FF ? 0 : 128); }
        float wscale = 1.0f;
        if (MODE == 2) { if (n0 < C_AK) wscale = QS_A; else if (n0 >= C_DQ && n0 < C_DK) wscale = QS_CD; }
        if (MODE == 3) wscale = QS_B;
        transpose_item(W, K, N, WT, 64 * kb, n0, drow0, wscale, scr, lane); }
}
__device__ __forceinline__ int t5_bucket(int d) {
    const int ret = d > 0 ? 16 : 0; const int n = d < 0 ? -d : d;
    if (n < 8) return ret + n;
    const float v = logf((float)n / 8.0f) / 4.852030263919617f * 8.0f;
    int large = 8 + (int)v; if (large > 15) large = 15;
    return ret + large;
}
__device__ __forceinline__ void norm_row(const float* __restrict__ xrow, const float* __restrict__ g, bf16_t* __restrict__ hrow, int lane) {
    f32x4 v[8]; float ss = 0.f;
#pragma unroll
    for (int j = 0; j < 8; ++j) { v[j] = ((const f32x4*)xrow)[lane + 64 * j]; ss += (v[j].x * v[j].x + v[j].y * v[j].y) + (v[j].z * v[j].z + v[j].w * v[j].w); }
    const float rs = rsqrtf(wave_sum(ss) * (1.0f / DM) + EPS);
#pragma unroll
    for (int j = 0; j < 8; ++j) { const f32x4 gg = ((const f32x4*)g)[lane + 64 * j];
        u32x2 w; w.x = pk2(v[j].x * rs * gg.x, v[j].y * rs * gg.y); w.y = pk2(v[j].z * rs * gg.z, v[j].w * rs * gg.w); ((u32x2*)hrow)[lane + 64 * j] = w; }
}
template <int NR>
__device__ __forceinline__ void norm_add_rows(const bf16_t* __restrict__ Yb, const float* xi, float* xo, const float* __restrict__ gpost,
                                              const float* __restrict__ gpre, bf16_t* __restrict__ Hb, int row0, int rstride, int lane) {
    u32x2 yb[NR][8]; f32x4 v[NR][8];
#pragma unroll
    for (int q = 0; q < NR; ++q) { const size_t ro = (size_t)(row0 + q * rstride) * DM;
#pragma unroll
        for (int j = 0; j < 8; ++j) yb[q][j] = ((const u32x2*)(Yb + ro))[lane + 64 * j];
#pragma unroll
        for (int j = 0; j < 8; ++j) v[q][j] = ((const f32x4*)(xi + ro))[lane + 64 * j]; }
    f32x4 gp[8];
#pragma unroll
    for (int j = 0; j < 8; ++j) gp[j] = ((const f32x4*)gpost)[lane + 64 * j];
#pragma unroll
    for (int q = 0; q < NR; ++q) { const size_t ro = (size_t)(row0 + q * rstride) * DM;
        f32x4 y[8]; float ss = 0.f;
#pragma unroll
        for (int j = 0; j < 8; ++j) { y[j].x = __uint_as_float(yb[q][j].x << 16); y[j].y = __uint_as_float(yb[q][j].x & 0xffff0000u); y[j].z = __uint_as_float(yb[q][j].y << 16); y[j].w = __uint_as_float(yb[q][j].y & 0xffff0000u);
            ss += (y[j].x * y[j].x + y[j].y * y[j].y) + (y[j].z * y[j].z + y[j].w * y[j].w); }
        const float rs = rsqrtf(wave_sum(ss) * (1.0f / DM) + EPS);
        float ss2 = 0.f;
#pragma unroll
        for (int j = 0; j < 8; ++j) { v[q][j] = v[q][j] + y[j] * rs * gp[j]; ((f32x4*)(xo + ro))[lane + 64 * j] = v[q][j];
            ss2 += (v[q][j].x * v[q][j].x + v[q][j].y * v[q][j].y) + (v[q][j].z * v[q][j].z + v[q][j].w * v[q][j].w); }
        if (gpre) {
            const float rs2 = rsqrtf(wave_sum(ss2) * (1.0f / DM) + EPS);
#pragma unroll
            for (int j = 0; j < 8; ++j) { const f32x4 gg = ((const f32x4*)gpre)[lane + 64 * j];
                u32x2 w; w.x = pk2(v[q][j].x * rs2 * gg.x, v[q][j].y * rs2 * gg.y); w.y = pk2(v[q][j].z * rs2 * gg.z, v[q][j].w * rs2 * gg.w); ((u32x2*)(Hb + ro))[lane + 64 * j] = w; }
        }
    }
}

__device__ __forceinline__ void head_norm_axial(const bf16_t* __restrict__ src, bf16_t* __restrict__ dst, const float* __restrict__ g, const float* __restrict__ COS, const float* __restrict__ SIN, int row, int t, float oscale) {
    float v[8];
#pragma unroll
    for (int s = 0; s < 4; ++s) { const unsigned w = *(const unsigned*)(src + 32 * s + 2 * t); v[2 * s] = bf2f((unsigned short)(w & 0xffff)); v[2 * s + 1] = bf2f((unsigned short)(w >> 16)); }
    float ss = 0.f;
#pragma unroll
    for (int i = 0; i < 8; ++i) ss += v[i] * v[i];
    ss += swz_xor<1>(ss); ss += swz_xor<2>(ss); ss += swz_xor<4>(ss); ss += swz_xor<8>(ss);
    const float rs = rsqrtf(ss * (1.0f / 128.0f) + EPS);
#pragma unroll
    for (int s = 0; s < 4; ++s) { v[2 * s] *= rs * oscale * g[32 * s + 2 * t]; v[2 * s + 1] *= rs * oscale * g[32 * s + 2 * t + 1]; }
    const int pr = row >> 6, pc = row & 63;
    float o[8];
#pragma unroll
    for (int e = 0; e < 2; ++e) { const int i = 2 * t + e;
        { const float c = COS[pr * 32 + i], s = SIN[pr * 32 + i]; const float x1 = v[e], x2 = v[2 + e]; o[e] = x1 * c - x2 * s; o[2 + e] = x2 * c + x1 * s; }
        { const float c = COS[pc * 32 + i], s = SIN[pc * 32 + i]; const float x1 = v[4 + e], x2 = v[6 + e]; o[4 + e] = x1 * c - x2 * s; o[6 + e] = x2 * c + x1 * s; } }
#pragma unroll
    for (int s = 0; s < 4; ++s) *(unsigned*)(dst + 32 * s + 2 * t) = pk2(o[2 * s], o[2 * s + 1]);
}


#define XB_TMO      128
#define XB_XCNT(j)  (256  + 64 * (j))
#define XB_XSUB(j)  (1280 + 64 * (j))
#define XB_XGEN(j)  (2304 + 64 * (j))
#define XB_TOP      3328
#define XB_TOPGEN   3392
#define XCD_BAR_WORDS 3456
#define XB_SPIN_CAP (1u << 18)
__device__ __forceinline__ unsigned xb_ld(unsigned* p)              { return __hip_atomic_load(p, __ATOMIC_RELAXED, __HIP_MEMORY_SCOPE_AGENT); }
__device__ __forceinline__ unsigned xb_add(unsigned* p, unsigned v) { return __hip_atomic_fetch_add(p, v, __ATOMIC_RELAXED, __HIP_MEMORY_SCOPE_AGENT); }
__device__ __forceinline__ unsigned xb_xcc_id() { return (unsigned)__builtin_amdgcn_s_getreg((3 << 11) | 20) & 0xFu; }
#define XB_SPIN(cond, bar) do { unsigned _sp = 0; while (cond) { __builtin_amdgcn_s_sleep(1); \
    if ((++_sp & 255u) == 0u) { if (xb_ld(&(bar)[XB_TMO])) break; if (_sp > XB_SPIN_CAP) { atomicAdd(&(bar)[XB_TMO], 1u); break; } } } } while (0)
__device__ __forceinline__ void xcd_barrier_complete(unsigned* bar, unsigned x, unsigned& nloc, unsigned& nx) {
    const unsigned G = gridDim.x * gridDim.y * gridDim.z;
    unsigned sum, cnt, mine, sp = 0u;
    for (;;) {
        sum = 0u; cnt = 0u; mine = 0u;
#pragma unroll
        for (unsigned j = 0; j < 16; ++j) { const unsigned c = xb_ld(&bar[XB_XCNT(j)]); sum += c; cnt += (c > 0u) ? 1u : 0u; mine = (j == x) ? c : mine; }
        if (sum == G) break;
        __builtin_amdgcn_s_sleep(1);
        if ((++sp & 255u) == 0u) { if (xb_ld(&bar[XB_TMO])) break; if (sp > XB_SPIN_CAP) { atomicAdd(&bar[XB_TMO], 1u); break; } }
    }
    nloc = mine > 0u ? mine : 1u; nx = cnt > 0u ? cnt : 1u;
}
__device__ __forceinline__ void xcd_barrier(unsigned* bar, volatile LAS unsigned* st, bool leader) {
    asm volatile("s_waitcnt vmcnt(0)" ::: "memory");
    __syncthreads();
    if (leader) {
        const unsigned x = xb_xcc_id();
        __builtin_amdgcn_s_waitcnt(0);
        unsigned nloc = st[0], nx = st[1];
        if (nloc == 0u) { xcd_barrier_complete(bar, x, nloc, nx); st[0] = nloc; st[1] = nx; }
        const unsigned old = xb_add(&bar[XB_XSUB(x)], 1u);
        const unsigned gen = old / nloc;
        if (old + 1u == (gen + 1u) * nloc) {
            __builtin_amdgcn_fence(__ATOMIC_RELEASE, "agent");
            asm volatile("s_waitcnt vmcnt(0)" ::: "memory");
            const unsigned og = xb_add(&bar[XB_TOP], 1u);
            const unsigned tg = og / nx;
            if (og + 1u == (tg + 1u) * nx) xb_add(&bar[XB_TOPGEN], 1u);
            else XB_SPIN(xb_ld(&bar[XB_TOPGEN]) == tg, bar);
            __builtin_amdgcn_fence(__ATOMIC_ACQUIRE, "agent");
            xb_add(&bar[XB_XGEN(x)], 1u);
            asm volatile("s_waitcnt vmcnt(0)" ::: "memory");
        } else {
            XB_SPIN(xb_ld(&bar[XB_XGEN(x)]) == gen, bar);
            __builtin_amdgcn_fence(__ATOMIC_ACQUIRE, "agent");
            asm volatile("s_waitcnt vmcnt(0)" ::: "memory");
        }
    }
    __syncthreads();
}

struct Args { const float* in[18]; float* out; unsigned char* wsp; int ph_lo, ph_hi; };

__global__ void __launch_bounds__(512, 2) mega_fwd(Args args) {
    extern __shared__ __attribute__((aligned(16))) unsigned char lds[];
    const int G = gridDim.x, bid = blockIdx.x, NGW = G * 8;
    const int wave0 = __builtin_amdgcn_readfirstlane((int)threadIdx.x >> 6);
    typedef const __attribute__((address_space(4))) Args* KArgP;
    LAS unsigned char* ldsl = (LAS unsigned char*)lds;
#define x_in (kap->in[0])
#define rel_bias (kap->in[1])
#define norm_mix_pre (kap->in[2])
#define norm_mix_post (kap->in[3])
#define norm_ffn_pre (kap->in[4])
#define norm_ffn_post (kap->in[5])
#define w_in (kap->in[6])
#define diff_lambda (kap->in[7])
#define diff_subln (kap->in[8])
#define mla_q_norm (kap->in[9])
#define mla_kv_norm (kap->in[10])
#define mla_w_uq (kap->in[11])
#define mla_w_ukv (kap->in[12])
#define gqa_q_norm (kap->in[13])
#define gqa_k_norm (kap->in[14])
#define w_out (kap->in[15])
#define w_gate_up (kap->in[16])
#define w_down (kap->in[17])
#define xres (kap->out)
#define ws (kap->wsp)
#define PAR ((float*)(ws + WS_PAR))
#define TBLA ((float*)(ws + WS_TBLA))
#define TBLD ((float*)(ws + WS_TBLD))
#define COS ((float*)(ws + WS_COS))
#define SIN ((float*)(ws + WS_SIN))
#define H ((bf16_t*)(ws + WS_H))
#define PROJ ((bf16_t*)(ws + WS_PROJ))
#define CQN ((bf16_t*)(ws + WS_CQN))
#define CKVN ((bf16_t*)(ws + WS_CKVN))
#define KPE ((bf16_t*)(ws + WS_KPE))
#define QC ((bf16_t*)(ws + WS_QC))
#define KC ((bf16_t*)(ws + WS_KC))
#define QB ((bf16_t*)(ws + WS_QB))
#define KVB ((bf16_t*)(ws + WS_KVB))
#define MIX ((bf16_t*)(ws + WS_MIX))
#define Y ((bf16_t*)(ws + WS_Y))
#define HID ((bf16_t*)(ws + WS_HID))
#define TMP ((float*)(ws + WS_TMP))
#define wl (ws + WS_W + (size_t)l * LW)

    volatile LAS unsigned* bst = (volatile LAS unsigned*)(ldsl + LDS_ST_OFF);
    { const bool leader0 = (wave0 == 0) && (lane_id_v() == 0);
      if (leader0) { bst[0] = 0u; bst[1] = 0u; }
      __syncthreads();
      if (leader0 && !MK_MULTI) { KArgP kap0 = (KArgP)__builtin_amdgcn_kernarg_segment_ptr(); (void)xb_add(&((unsigned*)(kap0->wsp + WS_BAR))[XB_XCNT(xb_xcc_id())], 1u); } }
    const int lo = args.ph_lo, hi_ph = args.ph_hi; int ph = 0;
#define PH_BEGIN if (ph >= lo && ph < hi_ph) { KArgP kap = (KArgP)__builtin_amdgcn_kernarg_segment_ptr(); asm volatile("" : "+s"(kap)); \
    int tid_ = wave0 * 64 + lane_id_v(); const int tid = tid_, lane = tid & 63, wave = __builtin_amdgcn_readfirstlane(tid >> 6), gw = bid * 8 + wave; (void)lane; (void)gw;
#define PH_END } if (ph >= lo && ph + 1 < hi_ph) { if (ph == 0) { cg::this_grid().sync(); } else { KArgP kapb = (KArgP)__builtin_amdgcn_kernarg_segment_ptr(); asm volatile("" : "+s"(kapb)); \
      xcd_barrier((unsigned*)(kapb->wsp + WS_BAR), bst, (wave0 == 0) && (lane_id_v() == 0)); } } ++ph;

    PH_BEGIN
    if PHON(0) {
        LAS float* scr = (LAS float*)(ldsl + wave * 16384);
        for (int l = 0; l < DEPTH; ++l) {
            transpose_matrix<2>(w_in + (size_t)l * DM * NPROJ, DM, NPROJ, (bf16_t*)(wl + W_IN), scr, lane, gw, NGW);
            transpose_matrix<3>(mla_w_uq + (size_t)l * 512 * 768, 512, 768, (bf16_t*)(wl + W_UQ), scr, lane, gw, NGW);
            transpose_matrix<0>(mla_w_ukv + (size_t)l * 256 * 1024, 256, 1024, (bf16_t*)(wl + W_UKV), scr, lane, gw, NGW);
            transpose_matrix<0>(w_out + (size_t)l * DM * DM, DM, DM, (bf16_t*)(wl + W_OUT), scr, lane, gw, NGW);
            transpose_matrix<1>(w_gate_up + (size_t)l * DM * NGU, DM, NGU, (bf16_t*)(wl + W_GU), scr, lane, gw, NGW);
            transpose_matrix<0>(w_down + (size_t)l * FF * DM, FF, DM, (bf16_t*)(wl + W_D), scr, lane, gw, NGW);
            { u32x4* z = (u32x4*)((bf16_t*)(wl + W_IN) + (size_t)NPROJ * DM); const int n16 = (LDP - NPROJ) * DM * 2 / 16;
              for (int i = bid * 512 + tid; i < n16; i += G * 512) z[i] = (u32x4){0u, 0u, 0u, 0u}; }
        }
        const int gt = bid * 512 + tid, NT_ = G * 512;
        for (int i = gt; i < 4 * TBLN; i += NT_) { const int h = i / TBLN, d = (i % TBLN) - TOFF; const int b = t5_bucket(d);
            TBLA[i] = rel_bias[b * 8 + h] * 1.4426950408889634f;
            const int n = d < 0 ? -d : d; int mult = (n <= 64 ? 1 : 0) + (((n & 3) == 0 && n <= 256) ? 1 : 0) + (((n & 15) == 0 && n <= 1024) ? 1 : 0);
            TBLD[i] = mult ? (rel_bias[b * 8 + 4 + h] + logf((float)mult)) * 1.4426950408889634f : -1e30f; }
        for (int i = gt; i < S * 32; i += NT_) { const int pos = i >> 5, f = i & 31;
            const float inv = (float)pow(10000.0, -(double)(2 * f) / 64.0); const float ang = (float)pos * inv;
            COS[i] = (float)cos((double)ang); SIN[i] = (float)sin((double)ang); }
        if (bid == 0 && tid < DEPTH) { const float* lv = diff_lambda + tid * 256; float s1 = 0.f, s2 = 0.f;
            for (int i = 0; i < 64; ++i) { s1 += lv[i] * lv[64 + i]; s2 += lv[128 + i] * lv[192 + i]; }
            const float lam_init = 0.8f - 0.6f * expf(-0.3f * (float)tid);
            PAR[tid] = expf(s1) - expf(s2) + lam_init; PAR[4 + tid] = lam_init; }
        for (int row = gw; row < S; row += NGW) norm_row(x_in + (size_t)row * DM, norm_mix_pre, H + (size_t)row * DM, lane);
    }
    PH_END

    for (int l = 0; l < DEPTH; ++l) {
        PH_BEGIN
        if PHON(1) for (int rep_ = 0; rep_ < MK_DUP_GEMM; ++rep_) { pg8::Gemm g{H, (const bf16_t*)(wl + W_IN), S, LDP, DM}; pg8::StaticOrder So; So.init(S, LDP, G, bid);
          pg8::EpiBf16 E{PROJ, LDP};
          pg8::gemm_phase<pg8::EpiBf16, pg8::StaticOrder, true, true>(ldsl, g, So, E, wave0); }
        PH_END
        PH_BEGIN
        if PHON(2) for (int row = gw; row < S; row += NGW) {
            const bf16_t* pr = PROJ + (size_t)row * LDP;
            { const u32x4 raw = *(const u32x4*)(pr + C_BCQ + lane * 8); float v[8];
              v[0] = __uint_as_float(raw.x << 16); v[1] = __uint_as_float(raw.x & 0xffff0000u); v[2] = __uint_as_float(raw.y << 16); v[3] = __uint_as_float(raw.y & 0xffff0000u);
              v[4] = __uint_as_float(raw.z << 16); v[5] = __uint_as_float(raw.z & 0xffff0000u); v[6] = __uint_as_float(raw.w << 16); v[7] = __uint_as_float(raw.w & 0xffff0000u);
              float ss = 0.f;
#pragma unroll
              for (int i = 0; i < 8; ++i) ss += v[i] * v[i];
              const float rs = rsqrtf(wave_sum(ss) * (1.0f / 512.0f) + EPS);
              const f32x4 g0 = *(const f32x4*)(mla_q_norm + l * 512 + lane * 8), g1 = *(const f32x4*)(mla_q_norm + l * 512 + lane * 8 + 4);
              u32x4 w; w.x = pk2(v[0] * rs * g0.x, v[1] * rs * g0.y); w.y = pk2(v[2] * rs * g0.z, v[3] * rs * g0.w); w.z = pk2(v[4] * rs * g1.x, v[5] * rs * g1.y); w.w = pk2(v[6] * rs * g1.z, v[7] * rs * g1.w);
              *(u32x4*)(CQN + (size_t)row * 512 + lane * 8) = w; }
            { const u32x2 raw = *(const u32x2*)(pr + C_BCKV + lane * 4); float v[4];
              v[0] = __uint_as_float(raw.x << 16); v[1] = __uint_as_float(raw.x & 0xffff0000u); v[2] = __uint_as_float(raw.y << 16); v[3] = __uint_as_float(raw.y & 0xffff0000u);
              float ss = v[0] * v[0] + v[1] * v[1] + v[2] * v[2] + v[3] * v[3];
              const float rs = rsqrtf(wave_sum(ss) * (1.0f / 256.0f) + EPS);
              const f32x4 g0 = *(const f32x4*)(mla_kv_norm + l * 256 + lane * 4);
              u32x2 w; w.x = pk2(v[0] * rs * g0.x, v[1] * rs * g0.y); w.y = pk2(v[2] * rs * g0.z, v[3] * rs * g0.w);
              *(u32x2*)(CKVN + (size_t)row * 256 + lane * 4) = w; }
            if (lane < 32) { const float x1 = bf2f(pr[C_BKPE + lane]), x2 = bf2f(pr[C_BKPE + 32 + lane]); const float c = COS[row * 32 + lane], s = SIN[row * 32 + lane];
              KPE[(size_t)row * 64 + lane] = (bf16_t)f2bf(x1 * c - x2 * s); KPE[(size_t)row * 64 + 32 + lane] = (bf16_t)f2bf(x2 * c + x1 * s); }
            { const int hd = lane >> 4, t = lane & 15;
              head_norm_axial(pr + C_CQ + hd * 128, QC + (size_t)row * 512 + hd * 128, gqa_q_norm + l * 128, COS, SIN, row, t, QS_CD);
              const int hk = hd & 1;
              if (lane < 32) head_norm_axial(pr + C_CK + hk * 128, KC + (size_t)row * 256 + hk * 128, gqa_k_norm + l * 128, COS, SIN, row, t, 1.0f); }
        }
        PH_END
        PH_BEGIN
        if PHON(3) { pg8::Gemm g{CQN, (const bf16_t*)(wl + W_UQ), S, 768, 512}; pg8::StaticOrder So; So.init(S, 768, G, bid);
          pg8::EpiBf16 E{QB, 768};
          pg8::gemm_phase<pg8::EpiBf16, pg8::StaticOrder, true, true>(ldsl, g, So, E, wave0); }
        if PHON(4) { pg8::Gemm g{CKVN, (const bf16_t*)(wl + W_UKV), S, 1024, 256}; pg8::StaticOrder So; So.init(S, 1024, G, bid);
          pg8::EpiBf16 E{KVB, 1024};
          pg8::gemm_phase<pg8::EpiBf16, pg8::StaticOrder, true, true>(ldsl, g, So, E, wave0); }
        PH_END
        PH_BEGIN
        for (int rep_ = 0; rep_ < MK_DUP_ATT; ++rep_) {
            const float lam = PAR[l], lam_init = PAR[4 + l];
            const float L2E = 1.4426950408889634f;
            if PHON(6) for (int u = bid; u < 256; u += G) { const int xq = u & 7, hd = xq & 3, qb = (u >> 3) + 32 * (xq >> 2), q0 = qb * 256;
                { const float cb_lo = rel_bias[15 * 8 + hd] * L2E, cb_hi = rel_bias[31 * 8 + hd] * L2E;
                  att::attn_unit_A2(PROJ + (size_t)q0 * LDP + C_AQ + hd * 128, LDP, PROJ + C_AK + hd * 128, LDP, PROJ + C_AV + hd * 128, LDP, S, q0,
                                    TBLA + hd * TBLN, cb_lo, cb_hi, MIX + (size_t)q0 * DM + hd * 128, DM, lam, diff_subln + l * 128, 1.0f - lam_init, (char*)lds, wave0); }
            }
            if PHON(7) for (int u = bid; u < 256; u += G) { const int xq = u & 7, hd = xq & 3, qb = (u >> 3) + 32 * (xq >> 2), q0 = qb * 256;
                { const float sc = 0.07216878364870322f;
                  att::attn_unit<12, 0, 0, 1, 8, 1>(QB + (size_t)q0 * 768 + hd * 192, 768, KVB + hd * 256, 1024, KPE, 64, KVB + hd * 256 + 128, 1024,
                                            0, S, q0, nullptr, 0.f, 0.f, MIX + (size_t)q0 * DM + 512 + hd * 128, DM, nullptr, 0.f, nullptr, 0.f, (char*)lds, wave0, COS, SIN); }
            }
            if PHON(8) for (int u = bid; u < 256; u += G) { const int xq = u & 7, hd = xq & 3, qb = (u >> 3) + 32 * (xq >> 2), q0 = qb * 256;
                { const float sc = 0.08838834764831845f;
                  att::attn_unit<8, 0, 0, 1>(QC + (size_t)q0 * 512 + hd * 128, 512, KC + (hd >> 1) * 128, 256, nullptr, 0, PROJ + C_CV + (hd >> 1) * 128, LDP,
                                           0, S, q0, nullptr, 0.f, 0.f, MIX + (size_t)q0 * DM + 1024 + hd * 128, DM, nullptr, 0.f, nullptr, 0.f, (char*)lds, wave0); }
            }
            if PHON(9) for (int u = bid; u < 256; u += G) { const int xq = u & 7, hd = xq & 3, qb = (u >> 3) + 32 * (xq >> 2), q0 = qb * 256;
                { const float sc = 0.08838834764831845f;
                  const int kb = q0 - 1024 < 0 ? 0 : q0 - 1024, ke = q0 + 256 + 1024 > S ? S : q0 + 256 + 1024;
                  att::attn_unit<8, 1, 0, 1>(PROJ + (size_t)q0 * LDP + C_DQ + hd * 128, LDP, PROJ + C_DK + hd * 128, LDP, nullptr, 0, PROJ + C_DV + hd * 128, LDP,
                                           kb, ke - kb, q0, TBLD + hd * TBLN, 0.f, 0.f, MIX + (size_t)q0 * DM + 1536 + hd * 128, DM, nullptr, 0.f, nullptr, 0.f, (char*)lds, wave0); }
            }
            __syncthreads();
        }
        PH_END
        PH_BEGIN
        if PHON(10) for (int rep_ = 0; rep_ < MK_DUP_GEMM; ++rep_) { pg8::Gemm g{MIX, (const bf16_t*)(wl + W_OUT), S, DM, DM}; pg8::StaticOrder So; So.init(S, DM, G, bid);
          pg8::EpiBf16 E{Y, DM};
          pg8::gemm_phase<pg8::EpiBf16, pg8::StaticOrder, true, true>(ldsl, g, So, E, wave0); }
        PH_END
        PH_BEGIN
        if PHON(11) { int row = gw;
            for (; row + NGW < S; row += 2 * NGW) norm_add_rows<2>(Y, (l == 0 ? x_in : xres), xres, norm_mix_post + l * DM, norm_ffn_pre + l * DM, H, row, NGW, lane);
            for (; row < S; row += NGW) norm_add_rows<1>(Y, (l == 0 ? x_in : xres), xres, norm_mix_post + l * DM, norm_ffn_pre + l * DM, H, row, NGW, lane); }
        PH_END
        PH_BEGIN
        if PHON(12) for (int rep_ = 0; rep_ < MK_DUP_GEMM; ++rep_) { pg8::Gemm g{H, (const bf16_t*)(wl + W_GU), S, NGU, DM}; pg8::StaticOrder So; So.init(S, NGU, G, bid);
          pg8::EpiSwiGLU E{HID, FF};
          pg8::gemm_phase<pg8::EpiSwiGLU, pg8::StaticOrder, true, true>(ldsl, g, So, E, wave0); }
        PH_END
        PH_BEGIN
        if PHON(13) for (int rep_ = 0; rep_ < MK_DUP_GEMM; ++rep_) { pg8::Gemm g{HID, (const bf16_t*)(wl + W_D), S, DM, FF}; pg8::StaticOrder So; So.init(S, DM, G, bid);
          pg8::EpiBf16 E{Y, DM};
          pg8::gemm_phase<pg8::EpiBf16, pg8::StaticOrder, true, true>(ldsl, g, So, E, wave0); }
        PH_END
        PH_BEGIN
        if PHON(14) { int row = gw; const float* gnext = (l + 1 < DEPTH) ? norm_mix_pre + (l + 1) * DM : nullptr;
            for (; row + NGW < S; row += 2 * NGW) norm_add_rows<2>(Y, xres, xres, norm_ffn_post + l * DM, gnext, H, row, NGW, lane);
            for (; row < S; row += NGW) norm_add_rows<1>(Y, xres, xres, norm_ffn_post + l * DM, gnext, H, row, NGW, lane); }
        PH_END
    }
#undef PH_BEGIN
#undef PH_END
}
#undef x_in
#undef rel_bias
#undef norm_mix_pre
#undef norm_mix_post
#undef norm_ffn_pre
#undef norm_ffn_post
#undef w_in
#undef diff_lambda
#undef diff_subln
#undef mla_q_norm
#undef mla_kv_norm
#undef mla_w_uq
#undef mla_w_ukv
#undef gqa_q_norm
#undef gqa_k_norm
#undef w_out
#undef w_gate_up
#undef w_down
#undef xres
#undef ws
#undef PAR
#undef TBLA
#undef TBLD
#undef COS
#undef SIN
#undef H
#undef PROJ
#undef CQN
#undef CKVN
#undef KPE
#undef QC
#undef KC
#undef QB
#undef KVB
#undef MIX
#undef Y
#undef HID
#undef TMP
#undef wl

constexpr int N_PHASES = 1 + DEPTH * 9;

extern "C" void kernel_launch(void* const* d_in, const int* in_sizes, int n_in, void* d_out, int out_size, void* d_ws, size_t ws_size, hipStream_t stream) {
    static int grid = 0;
    if (grid == 0) {
        if (n_in != 18 || in_sizes[0] != S * DM || out_size != S * DM || ws_size < WS_END) {
            fprintf(stderr, "kernel_launch: unexpected shapes (n_in %d, in0 %d, out %d, ws %zu < %zu)\n", n_in, n_in > 0 ? in_sizes[0] : -1, out_size, ws_size, (size_t)WS_END); grid = -1; return; }
        int dev = 0, cus = 0, per_cu = 0;
        if (hipGetDevice(&dev) != hipSuccess || hipDeviceGetAttribute(&cus, hipDeviceAttributeMultiprocessorCount, dev) != hipSuccess) { grid = -1; return; }
        if (hipFuncSetAttribute((const void*)mega_fwd, hipFuncAttributeMaxDynamicSharedMemorySize, LDS_BYTES) != hipSuccess) { fprintf(stderr, "kernel_launch: hipFuncSetAttribute failed\n"); grid = -1; return; }
        if (hipOccupancyMaxActiveBlocksPerMultiprocessor(&per_cu, (const void*)mega_fwd, 512, LDS_BYTES) != hipSuccess || per_cu < 1) { fprintf(stderr, "kernel_launch: occupancy query says %d\n", per_cu); per_cu = 1; }
        (void)hipGetLastError();
        grid = cus;
    }
    if (grid < 0) return;
    if (hipMemsetAsync((char*)d_ws + WS_BAR, 0, WS_BAR_BYTES, stream) != hipSuccess) { fprintf(stderr, "kernel_launch: hipMemsetAsync of the barrier words failed\n"); return; }
    Args a{};
    for (int i = 0; i < 18; ++i) a.in[i] = (const float*)d_in[i];
    a.out = (float*)d_out; a.wsp = (unsigned char*)d_ws;
#if MK_MULTI
    for (int p = 0; p < N_PHASES; ++p) { a.ph_lo = p; a.ph_hi = p + 1; hipLaunchKernelGGL(mega_fwd, dim3(grid), dim3(512), LDS_BYTES, stream, a); }
#else
    a.ph_lo = 0; a.ph_hi = N_PHASES;
    void* kargs[] = {&a};
    hipError_t e = hipLaunchCooperativeKernel((const void*)mega_fwd, dim3(grid), dim3(512), kargs, LDS_BYTES, stream);
    if (e != hipSuccess) fprintf(stderr, "kernel_launch: cooperative launch failed: %s (grid %d)\n", hipGetErrorString(e), grid);
#endif
}
```

```cpp
#include <hip/hip_runtime.h>
#include <hip/hip_cooperative_groups.h>
#include <cstdio>
#include <cstdint>
namespace cg = cooperative_groups;

#ifndef MK_MULTI
#define MK_MULTI 0
#endif
#ifndef MK_PHMASK
#define MK_PHMASK 0xFFFFF
#endif
#define PHON(k) constexpr (((MK_PHMASK) >> (k)) & 1)
#ifndef MK_DUP_GEMM
#define MK_DUP_GEMM 1
#endif
#ifndef MK_DUP_ATT
#define MK_DUP_ATT 1
#endif

typedef unsigned short bf16_t;
typedef short bf16x8 __attribute__((ext_vector_type(8)));
typedef short s16x4 __attribute__((ext_vector_type(4)));
typedef float f32x2 __attribute__((ext_vector_type(2)));
typedef float f32x4 __attribute__((ext_vector_type(4)));
typedef float f32x16 __attribute__((ext_vector_type(16)));
typedef unsigned u32x2 __attribute__((ext_vector_type(2)));
typedef unsigned u32x4 __attribute__((ext_vector_type(4)));
#define LAS __attribute__((address_space(3)))

constexpr int S = 16384, DM = 2048, DEPTH = 4, NPROJ = 4928, LDP = 5120, FF = 5632, NGU = 2 * FF;
constexpr float EPS = 1e-6f;
constexpr int C_AQ = 0, C_AK = 512, C_AV = 1024, C_BCQ = 1536, C_BCKV = 2048, C_BKPE = 2304, C_CQ = 2368, C_CK = 2880, C_CV = 3136, C_DQ = 3392, C_DK = 3904, C_DV = 4416;
constexpr int TOFF = 1408, TBLN = 2824;

constexpr size_t MiB = 1u << 20;
constexpr size_t WS_PAR = 0, WS_TBLA = 1 * MiB, WS_TBLD = 1 * MiB + 65536, WS_COS = 2 * MiB, WS_SIN = 4 * MiB;
constexpr size_t WS_BAR = 6 * MiB, WS_BAR_BYTES = 16384;
constexpr size_t WS_W = 8 * MiB, LW = 96 * MiB;
constexpr size_t W_IN = 0, W_UQ = 20 * MiB, W_UKV = 21 * MiB, W_OUT = 22 * MiB, W_GU = 30 * MiB, W_D = 74 * MiB;
constexpr size_t WS_H = 392 * MiB, WS_PROJ = 456 * MiB, WS_CQN = 616 * MiB, WS_CKVN = 632 * MiB, WS_KPE = 640 * MiB, WS_QC = 642 * MiB, WS_KC = 658 * MiB;
constexpr size_t WS_QB = 666 * MiB, WS_KVB = 690 * MiB, WS_MIX = 722 * MiB, WS_Y = 786 * MiB, WS_HID = 914 * MiB, WS_TMP = 1090 * MiB, WS_END = 1122 * MiB;

constexpr int LDS_ST_OFF = 163840 - 16;
constexpr int LDS_BYTES = 163840;

__device__ __forceinline__ float bf2f(unsigned short b) { return __uint_as_float(((unsigned)b) << 16); }
__device__ __forceinline__ unsigned f2bf(float f) { unsigned u = __float_as_uint(f); return (u + 0x7fffu + ((u >> 16) & 1u)) >> 16; }
__device__ __forceinline__ unsigned pk2(float lo, float hi) { return f2bf(lo) | (f2bf(hi) << 16); }
__device__ __forceinline__ unsigned cvt_pk_bf16(float lo, float hi) { unsigned r; asm volatile("v_cvt_pk_bf16_f32 %0, %1, %2" : "=v"(r) : "v"(lo), "v"(hi)); return r; }
__device__ __forceinline__ int lane_id_v() { int l; asm volatile("v_mbcnt_lo_u32_b32 %0, -1, 0\n\tv_mbcnt_hi_u32_b32 %0, -1, %0" : "=v"(l)); return l; }
template <int M> __device__ __forceinline__ float swz_xor(float v) { return __int_as_float(__builtin_amdgcn_ds_swizzle(__float_as_int(v), (M << 10) | 0x1f)); }
__device__ __forceinline__ float wave_sum(float v) {
    v += swz_xor<1>(v); v += swz_xor<2>(v); v += swz_xor<4>(v); v += swz_xor<8>(v); v += swz_xor<16>(v);
    auto rr = __builtin_amdgcn_permlane32_swap(__float_as_uint(v), __float_as_uint(v), false, false);
    return __uint_as_float(rr[0]) + __uint_as_float(rr[1]);
}

namespace pg8 {
constexpr int BM = 256, BK = 64, HALF = 128, HTB = HALF * BK * 2, STAGE_BYTES = 8 * HTB, NXCD = 8, WGM = 8;
__host__ __device__ __forceinline__ int lds_byte(int r, int c) { const int st = (r >> 4) * 2 + (c >> 5), rr = r & 15, cc = c & 31, ob = rr * 64 + cc * 2; return st * 1024 + (ob ^ (((ob >> 9) & 1) << 5)); }
__host__ __device__ __forceinline__ void stage_rc(int b, int& R, int& C) { const int st = b / 1024, sb = b % 1024, swz = sb ^ (((sb >> 9) & 1) << 5); R = (st >> 1) * 16 + swz / 64; C = (st & 1) * 32 + (swz % 64) / 2; }
__host__ __device__ __forceinline__ int perm32(int rho) { const int n = rho >> 4, i = rho & 15; return 8 * (i >> 2) + 4 * n + (i & 3); }

struct Unit { int pm, pn; };
struct Gemm { const bf16_t* A; const bf16_t* Bt; int M, N, K; };

struct StaticOrder {
    int nM, nN, nwg, G, c;
    __host__ __device__ void init(int M, int N, int G_, int c_) { nM = M / BM; nN = N / BM; nwg = nM * nN; G = G_; c = c_; }
    __host__ __device__ bool next(int i, Unit& u) const {
        const long L = (long)i * G + c; if (L >= nwg) return false;
        int wgid = (int)L; { const int q = nwg / NXCD, r = nwg % NXCD, xcd = wgid % NXCD, off = wgid / NXCD; wgid = (xcd < r ? xcd * (q + 1) : r * (q + 1) + (xcd - r) * q) + off; }
        const int nig = WGM * nN, gid = wgid / nig, fm = gid * WGM, gsz = (nM - fm) < WGM ? (nM - fm) : WGM;
        u.pm = fm + ((wgid % nig) % gsz); u.pn = (wgid % nig) / gsz; return true;
    }
    __device__ __forceinline__ void a_ready(const Unit&) const {}
    __device__ __forceinline__ void done(const Unit&) const {}
};

struct EpiBf16 {
    static constexpr bool PERM = true, AFTER_DRAIN = false;
    bf16_t* O; int ldc;
    __device__ __forceinline__ void operator()(const f32x4 (&acc)[2][2][4][2], const Unit& u, int wr, int wc, int fr, int fq) const {
        const int row0 = u.pm * BM + wr * 64 + fr; const int col0 = u.pn * BM + wc * 32 + 8 * fq;
#pragma unroll
        for (int ai = 0; ai < 2; ++ai)
#pragma unroll
            for (int m = 0; m < 4; ++m) { bf16_t* rowp = O + (size_t)(row0 + ai * HALF + m * 16) * ldc + col0;
#pragma unroll
                for (int bj = 0; bj < 2; ++bj) { const f32x4 v0 = acc[ai][bj][m][0], v1 = acc[ai][bj][m][1];
                    u32x4 w; w.x = cvt_pk_bf16(v0[0], v0[1]); w.y = cvt_pk_bf16(v0[2], v0[3]); w.z = cvt_pk_bf16(v1[0], v1[1]); w.w = cvt_pk_bf16(v1[2], v1[3]);
                    *(u32x4*)(rowp + bj * HALF) = w; } }
    }
};
struct EpiF32 {
    static constexpr bool PERM = false, AFTER_DRAIN = false;
    float* O; int ldc;
    __device__ __forceinline__ void operator()(const f32x4 (&acc)[2][2][4][2], const Unit& u, int wr, int wc, int fr, int fq) const {
        const int row0 = u.pm * BM + wr * 64 + fr; const int col0 = u.pn * BM + wc * 32 + 4 * fq;
#pragma unroll
        for (int ai = 0; ai < 2; ++ai)
#pragma unroll
            for (int m = 0; m < 4; ++m) { float* rowp = O + (size_t)(row0 + ai * HALF + m * 16) * ldc + col0;
#pragma unroll
                for (int bj = 0; bj < 2; ++bj)
#pragma unroll
                    for (int n = 0; n < 2; ++n) *(f32x4*)(rowp + bj * HALF + n * 16) = acc[ai][bj][m][n]; }
    }
};
__device__ __forceinline__ float silu_mul(float g, float u) {
    const float e = __builtin_amdgcn_exp2f(-g * 1.4426950408889634f);
    return g * __builtin_amdgcn_rcpf(1.0f + e) * u;
}
struct EpiSwiGLU {
    static constexpr bool PERM = true, AFTER_DRAIN = false;
    bf16_t* O; int ldc;
    __device__ __forceinline__ void operator()(const f32x4 (&acc)[2][2][4][2], const Unit& u, int wr, int wc, int fr, int fq) const {
        const int row0 = u.pm * BM + wr * 64 + fr; const int col0 = u.pn * HALF + wc * 32 + 8 * fq;
#pragma unroll
        for (int ai = 0; ai < 2; ++ai)
#pragma unroll
            for (int m = 0; m < 4; ++m) { bf16_t* rowp = O + (size_t)(row0 + ai * HALF + m * 16) * ldc + col0;
                const f32x4 g0 = acc[ai][0][m][0], g1 = acc[ai][0][m][1], u0 = acc[ai][1][m][0], u1 = acc[ai][1][m][1];
                u32x4 w; w.x = cvt_pk_bf16(silu_mul(g0[0], u0[0]), silu_mul(g0[1], u0[1])); w.y = cvt_pk_bf16(silu_mul(g0[2], u0[2]), silu_mul(g0[3], u0[3]));
                w.z = cvt_pk_bf16(silu_mul(g1[0], u1[0]), silu_mul(g1[1], u1[1])); w.w = cvt_pk_bf16(silu_mul(g1[2], u1[2]), silu_mul(g1[3], u1[3]));
                *(u32x4*)rowp = w; }
    }
};

template <class Epi, class Sched, bool ALIGN_EPI = false, bool SP2 = false>
__device__ __forceinline__ void gemm_phase(LAS unsigned char* lds, const Gemm g, const Sched& S, const Epi& E, const int wave0) {
    int tid_ = wave0 * 64 + lane_id_v();
    const int tid = tid_, wid = __builtin_amdgcn_readfirstlane(tid >> 6), lane = tid & 63, wr = wid >> 2, wc = wid & 3, fr = lane & 15, fq = lane >> 4;
    int K_ = g.K; asm volatile("" : "+s"(K_));
    const int K = K_, nt = K / BK;
    unsigned voffA[2], voffB[2];
#pragma unroll
    for (int i = 0; i < 2; ++i) { int R, C; stage_rc(tid * 16 + i * 8192, R, C); const int Rb = Epi::PERM ? ((R & ~31) + perm32(R & 31)) : R;
        voffA[i] = (unsigned)(R * K + C) * 2u; voffB[i] = (unsigned)(Rb * K + C) * 2u; }
    const size_t kstep = (size_t)(BK * 2);
    const size_t hstep = (size_t)HALF * K * 2;
    const size_t tstep = 2 * hstep;
    const unsigned ldsw = (unsigned)wid * 1024u;
    const int aoff = lds_byte(wr * 64 + fr, fq * 8), boff = lds_byte(wc * 32 + fr, fq * 8);
#define PG8_SA(b, h) (((b) * 2 + (h)) * HTB)
#define PG8_SB(b, h) ((4 + (b) * 2 + (h)) * HTB)
#define PG8_STAGE(bufoff, gbase, voff) do { _Pragma("unroll") for (int _i = 0; _i < 2; ++_i) \
        __builtin_amdgcn_global_load_lds((const unsigned*)((const char*)(gbase) + (voff)[_i]), (LAS unsigned*)(lds + (bufoff) + ldsw + _i * 8192), 16, 0, 0); } while (0)
#define PG8_LDA(dst, b, h) do { _Pragma("unroll") for (int m = 0; m < 4; ++m) _Pragma("unroll") for (int k = 0; k < 2; ++k) dst[m][k] = *(const LAS bf16x8*)(lds + PG8_SA(b, h) + aoff + m * 2048 + k * 1024); } while (0)
#define PG8_LDB(dst, b, h) do { _Pragma("unroll") for (int n = 0; n < 2; ++n) _Pragma("unroll") for (int k = 0; k < 2; ++k) dst[n][k] = *(const LAS bf16x8*)(lds + PG8_SB(b, h) + boff + n * 2048 + k * 1024); } while (0)
#define PG8_MMA(ai, bj, At, Bt) do { __builtin_amdgcn_s_setprio(1); _Pragma("unroll") for (int m = 0; m < 4; ++m) _Pragma("unroll") for (int n = 0; n < 2; ++n) _Pragma("unroll") for (int k = 0; k < 2; ++k) \
        acc[ai][bj][m][n] = __builtin_amdgcn_mfma_f32_16x16x32_bf16(Bt[n][k], At[m][k], acc[ai][bj][m][n], 0, 0, 0); __builtin_amdgcn_s_setprio(0); } while (0)
#define PG8_WAIT_V(n) asm volatile("s_waitcnt vmcnt(" #n ")" ::: "memory")
#define PG8_WAIT_L(n) asm volatile("s_waitcnt lgkmcnt(" #n ")" ::: "memory")
#define PG8_BAR __builtin_amdgcn_s_barrier()
#define PG8_SCHED __builtin_amdgcn_sched_barrier(0)
    Unit cur, nxt; int ui = 0;
    if (!S.next(0, cur)) return;
    f32x4 acc[2][2][4][2];
#pragma unroll
    for (int a = 0; a < 2; ++a)
#pragma unroll
        for (int b = 0; b < 2; ++b)
#pragma unroll
            for (int m = 0; m < 4; ++m)
#pragma unroll
                for (int n = 0; n < 2; ++n) acc[a][b][m][n] = (f32x4){0.f, 0.f, 0.f, 0.f};
    bf16x8 At[4][2], B0[2][2], B1[2][2];
    const char* cA = (const char*)g.A + (size_t)cur.pm * tstep; const char* cB = (const char*)g.Bt + (size_t)cur.pn * tstep;
    S.a_ready(cur);
    if constexpr (SP2) {
        PG8_STAGE(PG8_SB(0, 0), cB, voffB); PG8_STAGE(PG8_SB(0, 1), cB + hstep, voffB); PG8_STAGE(PG8_SA(0, 0), cA, voffA); PG8_STAGE(PG8_SA(0, 1), cA + hstep, voffA);
        if (wr == 1) PG8_BAR;
        PG8_WAIT_V(2); PG8_BAR;
        PG8_STAGE(PG8_SB(1, 0), cB + kstep, voffB); PG8_STAGE(PG8_SA(1, 0), cA + kstep, voffA); PG8_STAGE(PG8_SB(1, 1), cB + hstep + kstep, voffB);
        PG8_WAIT_V(6); PG8_BAR;
    } else {
        PG8_STAGE(PG8_SB(0, 0), cB, voffB); PG8_STAGE(PG8_SA(0, 0), cA, voffA); PG8_STAGE(PG8_SB(0, 1), cB + hstep, voffB); PG8_STAGE(PG8_SA(0, 1), cA + hstep, voffA);
        if (wr == 1) PG8_BAR;
        PG8_WAIT_V(4); PG8_BAR;
        PG8_STAGE(PG8_SB(1, 0), cB + kstep, voffB); PG8_STAGE(PG8_SA(1, 0), cA + kstep, voffA); PG8_STAGE(PG8_SB(1, 1), cB + hstep + kstep, voffB);
        PG8_WAIT_V(6); PG8_BAR;
    }
    for (;;) {
        const bool has_next = S.next(ui + 1, nxt);
        const char* nA = has_next ? (const char*)g.A + (size_t)nxt.pm * tstep : cA; const char* nB = has_next ? (const char*)g.Bt + (size_t)nxt.pn * tstep : cB;
        for (int t = 0; t < nt; t += 2) {
            const bool last = (t == nt - 2);
            const char* a1 = cA + (size_t)(t + 1) * kstep;
            const char* a2 = last ? nA : cA + (size_t)(t + 2) * kstep; const char* b2 = last ? nB : cB + (size_t)(t + 2) * kstep;
            const char* a3 = a2 + kstep; const char* b3 = b2 + kstep;
            if (last && has_next) S.a_ready(nxt);
            if constexpr (SP2) {
            PG8_LDB(B0, 0, 0); PG8_LDB(B1, 0, 1); PG8_SCHED; PG8_LDA(At, 0, 0); PG8_STAGE(PG8_SA(1, 1), a1 + hstep, voffA);
            PG8_WAIT_V(8); PG8_WAIT_L(0); PG8_BAR; PG8_MMA(0, 0, At, B0); PG8_MMA(0, 1, At, B1); PG8_BAR; PG8_SCHED;
            PG8_LDA(At, 0, 1); PG8_STAGE(PG8_SB(0, 0), b2, voffB); PG8_STAGE(PG8_SB(0, 1), b2 + hstep, voffB); PG8_STAGE(PG8_SA(0, 0), a2, voffA);
            PG8_WAIT_V(8); PG8_WAIT_L(0); PG8_BAR; PG8_MMA(1, 0, At, B0); PG8_MMA(1, 1, At, B1); PG8_BAR; PG8_SCHED;
            PG8_LDB(B0, 1, 0); PG8_LDB(B1, 1, 1); PG8_SCHED; PG8_LDA(At, 1, 0); PG8_STAGE(PG8_SA(0, 1), a2 + hstep, voffA);
            PG8_WAIT_V(8); PG8_WAIT_L(0); PG8_BAR; PG8_MMA(0, 0, At, B0); PG8_MMA(0, 1, At, B1); PG8_BAR; PG8_SCHED;
            PG8_LDA(At, 1, 1); PG8_STAGE(PG8_SB(1, 0), b3, voffB); PG8_STAGE(PG8_SB(1, 1), b3 + hstep, voffB); PG8_STAGE(PG8_SA(1, 0), a3, voffA);
            PG8_WAIT_V(8); PG8_WAIT_L(0); PG8_BAR; PG8_MMA(1, 0, At, B0); PG8_MMA(1, 1, At, B1); PG8_BAR; PG8_SCHED;
            } else {
            PG8_LDB(B0, 0, 0); PG8_SCHED; PG8_LDA(At, 0, 0); PG8_STAGE(PG8_SA(1, 1), a1 + hstep, voffA);
            PG8_WAIT_L(8); PG8_BAR; PG8_WAIT_L(0); PG8_MMA(0, 0, At, B0); PG8_BAR; PG8_SCHED;
            PG8_LDB(B1, 0, 1); PG8_STAGE(PG8_SB(0, 0), b2, voffB);
            PG8_BAR; PG8_WAIT_L(0); PG8_MMA(0, 1, At, B1); PG8_BAR;
            PG8_LDA(At, 0, 1); PG8_STAGE(PG8_SA(0, 0), a2, voffA);
            PG8_BAR; PG8_WAIT_L(0); PG8_MMA(1, 0, At, B0); PG8_BAR; PG8_SCHED;
            PG8_STAGE(PG8_SB(0, 1), b2 + hstep, voffB);
            PG8_WAIT_V(6); PG8_BAR; PG8_MMA(1, 1, At, B1); PG8_BAR;
            PG8_LDB(B0, 1, 0); PG8_SCHED; PG8_LDA(At, 1, 0); PG8_STAGE(PG8_SA(0, 1), a2 + hstep, voffA);
            PG8_WAIT_L(8); PG8_BAR; PG8_WAIT_L(0); PG8_MMA(0, 0, At, B0); PG8_BAR; PG8_SCHED;
            PG8_LDB(B1, 1, 1); PG8_STAGE(PG8_SB(1, 0), b3, voffB);
            PG8_BAR; PG8_WAIT_L(0); PG8_MMA(0, 1, At, B1); PG8_BAR;
            PG8_LDA(At, 1, 1); PG8_STAGE(PG8_SA(1, 0), a3, voffA);
            PG8_BAR; PG8_WAIT_L(0); PG8_MMA(1, 0, At, B0); PG8_BAR; PG8_SCHED;
            PG8_STAGE(PG8_SB(1, 1), b3 + hstep, voffB);
            PG8_WAIT_V(6); PG8_BAR; PG8_MMA(1, 1, At, B1); PG8_BAR;
            }
        }
        if constexpr (ALIGN_EPI) { if (wr == 0) PG8_BAR; }
        if constexpr (!Epi::AFTER_DRAIN) { E(acc, cur, wr, wc, fr, fq); S.done(cur); }
        if (!has_next) break;
#pragma unroll
        for (int a = 0; a < 2; ++a)
#pragma unroll
            for (int b = 0; b < 2; ++b)
#pragma unroll
                for (int m = 0; m < 4; ++m)
#pragma unroll
                    for (int n = 0; n < 2; ++n) acc[a][b][m][n] = (f32x4){0.f, 0.f, 0.f, 0.f};
        cur = nxt; cA = nA; cB = nB; ++ui;
        if constexpr (ALIGN_EPI) { if (wr == 1) PG8_BAR; }
    }
    PG8_WAIT_V(0);
    if constexpr (!ALIGN_EPI) { if (wr == 0) PG8_BAR; }
    PG8_BAR;
#undef PG8_SA
#undef PG8_SB
#undef PG8_STAGE
#undef PG8_LDA
#undef PG8_LDB
#undef PG8_MMA
#undef PG8_WAIT_V
#undef PG8_WAIT_L
#undef PG8_BAR
#undef PG8_SCHED
}
}

namespace att {
constexpr int NW = 8, QBLK = 32, KVBLK = 64;
constexpr int SHM_V = KVBLK * 128 * 2;
#define SBAR() __builtin_amdgcn_sched_barrier(0)
__device__ __forceinline__ int crow(int r, int hi) { return (r & 3) + 8 * (r >> 2) + 4 * hi; }
__device__ __forceinline__ unsigned cvtpk(float lo, float hi) { unsigned r; asm volatile("v_cvt_pk_bf16_f32 %0, %1, %2" : "=v"(r) : "v"(lo), "v"(hi)); return r; }

constexpr float THR2 = 8.0f * 1.4426950408889634f;
template <bool FIRST>
__device__ __forceinline__ void partialSM(f32x16& p0, f32x16& p1, float& mC, float& alpha) {
  float mx_[4] = {p0[0], p0[1], p0[2], p0[3]};
#pragma unroll
  for (int r = 4; r < 16; ++r) mx_[r & 3] = fmaxf(mx_[r & 3], p0[r]);
#pragma unroll
  for (int r = 0; r < 16; ++r) mx_[r & 3] = fmaxf(mx_[r & 3], p1[r]);
  float pmax = fmaxf(fmaxf(mx_[0], mx_[1]), fmaxf(mx_[2], mx_[3]));
  { auto rr = __builtin_amdgcn_permlane32_swap(__float_as_uint(pmax), __float_as_uint(pmax), false, false);
    pmax = fmaxf(__uint_as_float(rr[0]), __uint_as_float(rr[1])); }
  if (!FIRST && __builtin_expect(__all(pmax <= THR2), 1)) { alpha = 1.f; }
  else { const float delta = FIRST ? fmaxf(pmax, -200.f) : fmaxf(pmax, 0.f); alpha = FIRST ? 1.f : __builtin_amdgcn_exp2f(-delta); mC += delta;
#pragma unroll
    for (int r = 0; r < 16; ++r) p0[r] -= delta;
#pragma unroll
    for (int r = 0; r < 16; ++r) p1[r] -= delta; }
#pragma unroll
  for (int r = 0; r < 16; ++r) p0[r] = __builtin_amdgcn_exp2f(p0[r]);
}
template <bool EXP1 = true>
__device__ __forceinline__ void finishSM(f32x16& p0, f32x16& p1, float alpha, float& l_reg, bf16x8& pa0, bf16x8& pa1, bf16x8& pa2, bf16x8& pa3) {
  if constexpr (EXP1) {
#pragma unroll
  for (int r = 0; r < 16; ++r) p1[r] = __builtin_amdgcn_exp2f(p1[r]);
  }
  float sm_[4] = {p0[0], p0[1], p0[2], p0[3]};
#pragma unroll
  for (int r = 4; r < 16; ++r) sm_[r & 3] += p0[r];
#pragma unroll
  for (int r = 0; r < 16; ++r) sm_[r & 3] += p1[r];
  float ps = (sm_[0] + sm_[1]) + (sm_[2] + sm_[3]);
  { auto rr = __builtin_amdgcn_permlane32_swap(__float_as_uint(ps), __float_as_uint(ps), false, false);
    ps = __uint_as_float(rr[0]) + __uint_as_float(rr[1]); }
  l_reg = l_reg * alpha + ps;
#define PK4(P, BASE, OUT) do { unsigned a0 = cvtpk(P[BASE + 0], P[BASE + 1]), a1 = cvtpk(P[BASE + 2], P[BASE + 3]);   \
    unsigned b0 = cvtpk(P[BASE + 4], P[BASE + 5]), b1 = cvtpk(P[BASE + 6], P[BASE + 7]);                              \
    auto r0 = __builtin_amdgcn_permlane32_swap(a0, b0, false, false); auto r1 = __builtin_amdgcn_permlane32_swap(a1, b1, false, false); \
    u32x4 w = {r0[0], r1[0], r0[1], r1[1]}; OUT = *reinterpret_cast<bf16x8*>(&w); } while (0)
  PK4(p0, 0, pa0); PK4(p0, 8, pa1); PK4(p1, 0, pa2); PK4(p1, 8, pa3);
#undef PK4
}
template <int NDQ, int NQL>
__device__ __forceinline__ void qkt(f32x16& p0, f32x16& p1, const f32x16& negm, const char* Ks, const bf16x8* qr, const char* qls, int r32, int hi) {
  constexpr int ROWB = NDQ * 32, NQR = NDQ - NQL, SWM = (NDQ == 8) ? 15 : 7;
#pragma unroll
  for (int d0 = 0; d0 < NDQ; ++d0) { const int cb = (d0 * 16 + hi * 8) * 2;
    bf16x8 b0 = *reinterpret_cast<const bf16x8*>(Ks + r32 * ROWB + (cb ^ ((r32 & SWM) << 4)));
    bf16x8 b1 = *reinterpret_cast<const bf16x8*>(Ks + (32 + r32) * ROWB + (cb ^ ((r32 & SWM) << 4)));
    bf16x8 q;
    if constexpr (NQL > 0) { if (d0 < NQR) q = qr[d0 < NQR ? d0 : 0]; else q = *reinterpret_cast<const bf16x8*>(qls + (d0 - NQR) * 1024); }
    else q = qr[d0];
    if (d0 == 0) { p0 = __builtin_amdgcn_mfma_f32_32x32x16_bf16(b0, q, negm, 0, 0, 0); p1 = __builtin_amdgcn_mfma_f32_32x32x16_bf16(b1, q, negm, 0, 0, 0); }
    else { p0 = __builtin_amdgcn_mfma_f32_32x32x16_bf16(b0, q, p0, 0, 0, 0); p1 = __builtin_amdgcn_mfma_f32_32x32x16_bf16(b1, q, p1, 0, 0, 0); } }
}
template <int OFF> __device__ __forceinline__ bf16x8 lds_rd128(int a) { bf16x8 r; asm volatile("ds_read_b128 %0, %1 offset:%2" : "=&v"(r) : "v"(a), "i"(OFF) : "memory"); return r; }
#define SBAR_M() __builtin_amdgcn_sched_barrier(0)
__device__ __forceinline__ void qkt8_roll(f32x16& p0, f32x16& p1, const f32x16& negm, int kb, const bf16x8* qr) {
  const int a0 = kb ^ (0 << 5); const bf16x8 x0 = lds_rd128<0>(a0), y0 = lds_rd128<8192>(a0);
  const int a1 = kb ^ (1 << 5); const bf16x8 x1 = lds_rd128<0>(a1), y1 = lds_rd128<8192>(a1);
  const int a2 = kb ^ (2 << 5); const bf16x8 x2 = lds_rd128<0>(a2), y2 = lds_rd128<8192>(a2);
  asm volatile("s_waitcnt lgkmcnt(4)" ::: "memory"); SBAR_M();
  p0 = __builtin_amdgcn_mfma_f32_32x32x16_bf16(x0, qr[0], negm, 0, 0, 0); p1 = __builtin_amdgcn_mfma_f32_32x32x16_bf16(y0, qr[0], negm, 0, 0, 0);
  const int a3 = kb ^ (3 << 5); const bf16x8 x3 = lds_rd128<0>(a3), y3 = lds_rd128<8192>(a3);
  asm volatile("s_waitcnt lgkmcnt(4)" ::: "memory"); SBAR_M();
  p0 = __builtin_amdgcn_mfma_f32_32x32x16_bf16(x1, qr[1], p0, 0, 0, 0); p1 = __builtin_amdgcn_mfma_f32_32x32x16_bf16(y1, qr[1], p1, 0, 0, 0);
  const int a4 = kb ^ (4 << 5); const bf16x8 x4 = lds_rd128<0>(a4), y4 = lds_rd128<8192>(a4);
  asm volatile("s_waitcnt lgkmcnt(4)" ::: "memory"); SBAR_M();
  p0 = __builtin_amdgcn_mfma_f32_32x32x16_bf16(x2, qr[2], p0, 0, 0, 0); p1 = __builtin_amdgcn_mfma_f32_32x32x16_bf16(y2, qr[2], p1, 0, 0, 0);
  const int a5 = kb ^ (5 << 5); const bf16x8 x5 = lds_rd128<0>(a5), y5 = lds_rd128<8192>(a5);
  asm volatile("s_waitcnt lgkmcnt(4)" ::: "memory"); SBAR_M();
  p0 = __builtin_amdgcn_mfma_f32_32x32x16_bf16(x3, qr[3], p0, 0, 0, 0); p1 = __builtin_amdgcn_mfma_f32_32x32x16_bf16(y3, qr[3], p1, 0, 0, 0);
  const int a6 = kb ^ (6 << 5); const bf16x8 x6 = lds_rd128<0>(a6), y6 = lds_rd128<8192>(a6);
  asm volatile("s_waitcnt lgkmcnt(4)" ::: "memory"); SBAR_M();
  p0 = __builtin_amdgcn_mfma_f32_32x32x16_bf16(x4, qr[4], p0, 0, 0, 0); p1 = __builtin_amdgcn_mfma_f32_32x32x16_bf16(y4, qr[4], p1, 0, 0, 0);
  const int a7 = kb ^ (7 << 5); const bf16x8 x7 = lds_rd128<0>(a7), y7 = lds_rd128<8192>(a7);
  asm volatile("s_waitcnt lgkmcnt(4)" ::: "memory"); SBAR_M();
  p0 = __builtin_amdgcn_mfma_f32_32x32x16_bf16(x5, qr[5], p0, 0, 0, 0); p1 = __builtin_amdgcn_mfma_f32_32x32x16_bf16(y5, qr[5], p1, 0, 0, 0);
  asm volatile("s_waitcnt lgkmcnt(2)" ::: "memory"); SBAR_M();
  p0 = __builtin_amdgcn_mfma_f32_32x32x16_bf16(x6, qr[6], p0, 0, 0, 0); p1 = __builtin_amdgcn_mfma_f32_32x32x16_bf16(y6, qr[6], p1, 0, 0, 0);
  asm volatile("s_waitcnt lgkmcnt(0)" ::: "memory"); SBAR_M();
  p0 = __builtin_amdgcn_mfma_f32_32x32x16_bf16(x7, qr[7], p0, 0, 0, 0); p1 = __builtin_amdgcn_mfma_f32_32x32x16_bf16(y7, qr[7], p1, 0, 0, 0);
}

#define PK4S(P, BASE, OUT) do { unsigned a0 = cvtpk(P[BASE + 0], P[BASE + 1]), a1 = cvtpk(P[BASE + 2], P[BASE + 3]);   \
    unsigned b0 = cvtpk(P[BASE + 4], P[BASE + 5]), b1 = cvtpk(P[BASE + 6], P[BASE + 7]);                              \
    auto r0 = __builtin_amdgcn_permlane32_swap(a0, b0, false, false); auto r1 = __builtin_amdgcn_permlane32_swap(a1, b1, false, false); \
    u32x4 w = {r0[0], r1[0], r0[1], r1[1]}; OUT = *reinterpret_cast<bf16x8*>(&w); } while (0)
template <int K>
__device__ __forceinline__ void fsm_slice(f32x16& p0, f32x16& p1, float alpha, float& l_reg, bf16x8& pa0, bf16x8& pa1, bf16x8& pa2, bf16x8& pa3, float (&sm)[4]) {
  if constexpr (K == 2) {
    sm[0] = p0[0]; sm[1] = p0[1]; sm[2] = p0[2]; sm[3] = p0[3];
#pragma unroll
    for (int r = 4; r < 16; ++r) sm[r & 3] += p0[r];
  } else if constexpr (K == 3) {
#pragma unroll
    for (int r = 0; r < 16; ++r) sm[r & 3] += p1[r];
  } else if constexpr (K == 4) {
    float ps = (sm[0] + sm[1]) + (sm[2] + sm[3]);
    { auto rr = __builtin_amdgcn_permlane32_swap(__float_as_uint(ps), __float_as_uint(ps), false, false);
      ps = __uint_as_float(rr[0]) + __uint_as_float(rr[1]); }
    l_reg = l_reg * alpha + ps;
    PK4S(p0, 0, pa0);
  } else if constexpr (K == 5) { PK4S(p0, 8, pa1);
  } else if constexpr (K == 6) { PK4S(p1, 0, pa2);
  } else if constexpr (K == 7) { PK4S(p1, 8, pa3); }
}
template <int K>
__device__ __forceinline__ void psm_slice(f32x16& p0, f32x16& p1, float& mC, float& alpha, float (&mx)[4]) {
  if constexpr (K == 0) { mx[0] = p0[0]; mx[1] = p0[1]; mx[2] = p0[2]; mx[3] = p0[3]; }
  else if constexpr (K >= 1 && K <= 3) {
#pragma unroll
    for (int r = 4 * K; r < 4 * K + 4; ++r) mx[r & 3] = fmaxf(mx[r & 3], p0[r]);
  } else if constexpr (K >= 4 && K <= 7) {
#pragma unroll
    for (int r = 4 * (K - 4); r < 4 * (K - 4) + 4; ++r) mx[r & 3] = fmaxf(mx[r & 3], p1[r]);
  } else if constexpr (K == 8) {
    float pmax = fmaxf(fmaxf(mx[0], mx[1]), fmaxf(mx[2], mx[3]));
    { auto rr = __builtin_amdgcn_permlane32_swap(__float_as_uint(pmax), __float_as_uint(pmax), false, false);
      pmax = fmaxf(__uint_as_float(rr[0]), __uint_as_float(rr[1])); }
    if (__builtin_expect(__all(pmax <= THR2), 1)) { alpha = 1.f; }
    else { const float delta = fmaxf(pmax, 0.f); alpha = __builtin_amdgcn_exp2f(-delta); mC += delta;
#pragma unroll
      for (int r = 0; r < 16; ++r) p0[r] -= delta;
#pragma unroll
      for (int r = 0; r < 16; ++r) p1[r] -= delta; }
  } else if constexpr (K >= 9 && K <= 12) {
#pragma unroll
    for (int r = 4 * (K - 9); r < 4 * (K - 9) + 4; ++r) p0[r] = __builtin_amdgcn_exp2f(p0[r]);
  } else if constexpr (K >= 13 && K <= 15) {
#pragma unroll
    for (int r = (K == 13 ? 0 : K == 14 ? 6 : 11); r < (K == 13 ? 6 : K == 14 ? 11 : 16); ++r) p1[r] = __builtin_amdgcn_exp2f(p1[r]);
  }
}
__device__ __forceinline__ int v_st(int k, int c) { const int kk = (k & ~0xC) | ((k & 4) << 1) | ((k & 8) >> 1); return ((kk >> 3) * 4 + (c >> 5)) * 512 + ((kk & 7) * 32 + (c & 31)) * 2; }
__device__ __forceinline__ int v_rd_base(int lane) { return ((lane & 3) << 3) | (((lane >> 2) & 3) << 6) | (((lane >> 4) & 1) << 5) | (((lane >> 5) & 1) << 8); }
constexpr int v_rd_off(int d0, int ks, int half) { return d0 * 512 + ks * 4096 + half * 2048; }
template <int OFF> __device__ __forceinline__ s16x4 tr_read(int vb) {
  s16x4 r; asm volatile("ds_read_b64_tr_b16 %0, %1 offset:%2" : "=&v"(r) : "v"(vb), "i"(OFF) : "memory"); return r;
}
template <int D0> __device__ __forceinline__ void pv_one(f32x16& od, int vb, bf16x8 pa0, bf16x8 pa1, bf16x8 pa2, bf16x8 pa3) {
  const s16x4 l0 = tr_read<v_rd_off(D0, 0, 0)>(vb), h0 = tr_read<v_rd_off(D0, 0, 1)>(vb), l1 = tr_read<v_rd_off(D0, 1, 0)>(vb), h1 = tr_read<v_rd_off(D0, 1, 1)>(vb);
  const s16x4 l2 = tr_read<v_rd_off(D0, 2, 0)>(vb), h2 = tr_read<v_rd_off(D0, 2, 1)>(vb), l3 = tr_read<v_rd_off(D0, 3, 0)>(vb), h3 = tr_read<v_rd_off(D0, 3, 1)>(vb);
  asm volatile("s_waitcnt lgkmcnt(0)" ::: "memory"); SBAR();
#define PK(L, H) (bf16x8){L[0], L[1], L[2], L[3], H[0], H[1], H[2], H[3]}
  od = __builtin_amdgcn_mfma_f32_32x32x16_bf16(pa0, PK(l0, h0), od, 0, 0, 0);
  od = __builtin_amdgcn_mfma_f32_32x32x16_bf16(pa1, PK(l1, h1), od, 0, 0, 0);
  od = __builtin_amdgcn_mfma_f32_32x32x16_bf16(pa2, PK(l2, h2), od, 0, 0, 0);
  od = __builtin_amdgcn_mfma_f32_32x32x16_bf16(pa3, PK(l3, h3), od, 0, 0, 0);
#undef PK
}
__device__ __forceinline__ void pv_d0(f32x16* o, int vb, bf16x8 pa0, bf16x8 pa1, bf16x8 pa2, bf16x8 pa3) {
#define PK(L, H) (bf16x8){L[0], L[1], L[2], L[3], H[0], H[1], H[2], H[3]}
  const s16x4 l0 = tr_read<v_rd_off(0, 0, 0)>(vb), h0 = tr_read<v_rd_off(0, 0, 1)>(vb);
  const s16x4 l1 = tr_read<v_rd_off(0, 1, 0)>(vb), h1 = tr_read<v_rd_off(0, 1, 1)>(vb);
  const s16x4 l2 = tr_read<v_rd_off(0, 2, 0)>(vb), h2 = tr_read<v_rd_off(0, 2, 1)>(vb);
  const s16x4 l3 = tr_read<v_rd_off(0, 3, 0)>(vb), h3 = tr_read<v_rd_off(0, 3, 1)>(vb);
  const s16x4 l4 = tr_read<v_rd_off(1, 0, 0)>(vb), h4 = tr_read<v_rd_off(1, 0, 1)>(vb);
  asm volatile("s_waitcnt lgkmcnt(8)" ::: "memory"); SBAR();
  o[0] = __builtin_amdgcn_mfma_f32_32x32x16_bf16(pa0, PK(l0, h0), o[0], 0, 0, 0);
  const s16x4 l5 = tr_read<v_rd_off(1, 1, 0)>(vb), h5 = tr_read<v_rd_off(1, 1, 1)>(vb);
  asm volatile("s_waitcnt lgkmcnt(8)" ::: "memory"); SBAR();
  o[0] = __builtin_amdgcn_mfma_f32_32x32x16_bf16(pa1, PK(l1, h1), o[0], 0, 0, 0);
  const s16x4 l6 = tr_read<v_rd_off(1, 2, 0)>(vb), h6 = tr_read<v_rd_off(1, 2, 1)>(vb);
  asm volatile("s_waitcnt lgkmcnt(8)" ::: "memory"); SBAR();
  o[0] = __builtin_amdgcn_mfma_f32_32x32x16_bf16(pa2, PK(l2, h2), o[0], 0, 0, 0);
  const s16x4 l7 = tr_read<v_rd_off(1, 3, 0)>(vb), h7 = tr_read<v_rd_off(1, 3, 1)>(vb);
  asm volatile("s_waitcnt lgkmcnt(8)" ::: "memory"); SBAR();
  o[0] = __builtin_amdgcn_mfma_f32_32x32x16_bf16(pa3, PK(l3, h3), o[0], 0, 0, 0);
  const s16x4 l8 = tr_read<v_rd_off(2, 0, 0)>(vb), h8 = tr_read<v_rd_off(2, 0, 1)>(vb);
  asm volatile("s_waitcnt lgkmcnt(8)" ::: "memory"); SBAR();
  o[1] = __builtin_amdgcn_mfma_f32_32x32x16_bf16(pa0, PK(l4, h4), o[1], 0, 0, 0);
  const s16x4 l9 = tr_read<v_rd_off(2, 1, 0)>(vb), h9 = tr_read<v_rd_off(2, 1, 1)>(vb);
  asm volatile("s_waitcnt lgkmcnt(8)" ::: "memory"); SBAR();
  o[1] = __builtin_amdgcn_mfma_f32_32x32x16_bf16(pa1, PK(l5, h5), o[1], 0, 0, 0);
  const s16x4 l10 = tr_read<v_rd_off(2, 2, 0)>(vb), h10 = tr_read<v_rd_off(2, 2, 1)>(vb);
  asm volatile("s_waitcnt lgkmcnt(8)" ::: "memory"); SBAR();
  o[1] = __builtin_amdgcn_mfma_f32_32x32x16_bf16(pa2, PK(l6, h6), o[1], 0, 0, 0);
  const s16x4 l11 = tr_read<v_rd_off(2, 3, 0)>(vb), h11 = tr_read<v_rd_off(2, 3, 1)>(vb);
  asm volatile("s_waitcnt lgkmcnt(8)" ::: "memory"); SBAR();
  o[1] = __builtin_amdgcn_mfma_f32_32x32x16_bf16(pa3, PK(l7, h7), o[1], 0, 0, 0);
  const s16x4 l12 = tr_read<v_rd_off(3, 0, 0)>(vb), h12 = tr_read<v_rd_off(3, 0, 1)>(vb);
  asm volatile("s_waitcnt lgkmcnt(8)" ::: "memory"); SBAR();
  o[2] = __builtin_amdgcn_mfma_f32_32x32x16_bf16(pa0, PK(l8, h8), o[2], 0, 0, 0);
  const s16x4 l13 = tr_read<v_rd_off(3, 1, 0)>(vb), h13 = tr_read<v_rd_off(3, 1, 1)>(vb);
  asm volatile("s_waitcnt lgkmcnt(8)" ::: "memory"); SBAR();
  o[2] = __builtin_amdgcn_mfma_f32_32x32x16_bf16(pa1, PK(l9, h9), o[2], 0, 0, 0);
  const s16x4 l14 = tr_read<v_rd_off(3, 2, 0)>(vb), h14 = tr_read<v_rd_off(3, 2, 1)>(vb);
  asm volatile("s_waitcnt lgkmcnt(8)" ::: "memory"); SBAR();
  o[2] = __builtin_amdgcn_mfma_f32_32x32x16_bf16(pa2, PK(l10, h10), o[2], 0, 0, 0);
  const s16x4 l15 = tr_read<v_rd_off(3, 3, 0)>(vb), h15 = tr_read<v_rd_off(3, 3, 1)>(vb);
  asm volatile("s_waitcnt lgkmcnt(8)" ::: "memory"); SBAR();
  o[2] = __builtin_amdgcn_mfma_f32_32x32x16_bf16(pa3, PK(l11, h11), o[2], 0, 0, 0);
  asm volatile("s_waitcnt lgkmcnt(6)" ::: "memory"); SBAR();
  o[3] = __builtin_amdgcn_mfma_f32_32x32x16_bf16(pa0, PK(l12, h12), o[3], 0, 0, 0);
  asm volatile("s_waitcnt lgkmcnt(4)" ::: "memory"); SBAR();
  o[3] = __builtin_amdgcn_mfma_f32_32x32x16_bf16(pa1, PK(l13, h13), o[3], 0, 0, 0);
  asm volatile("s_waitcnt lgkmcnt(2)" ::: "memory"); SBAR();
  o[3] = __builtin_amdgcn_mfma_f32_32x32x16_bf16(pa2, PK(l14, h14), o[3], 0, 0, 0);
  asm volatile("s_waitcnt lgkmcnt(0)" ::: "memory"); SBAR();
  o[3] = __builtin_amdgcn_mfma_f32_32x32x16_bf16(pa3, PK(l15, h15), o[3], 0, 0, 0);
#undef PK
}

__device__ __forceinline__ void qkt8_fsm(f32x16& p0, f32x16& p1, const f32x16& negm, int kb, const bf16x8* qr, f32x16& q0p, f32x16& q1p, float alpha, float& l_reg, bf16x8& pa0, bf16x8& pa1, bf16x8& pa2, bf16x8& pa3) {
  float sm[4];
  const int a0 = kb ^ (0 << 5); const bf16x8 x0 = lds_rd128<0>(a0), y0 = lds_rd128<8192>(a0);
  const int a1 = kb ^ (1 << 5); const bf16x8 x1 = lds_rd128<0>(a1), y1 = lds_rd128<8192>(a1);
  const int a2 = kb ^ (2 << 5); const bf16x8 x2 = lds_rd128<0>(a2), y2 = lds_rd128<8192>(a2);
  asm volatile("s_waitcnt lgkmcnt(4)" ::: "memory"); SBAR();
  p0 = __builtin_amdgcn_mfma_f32_32x32x16_bf16(x0, qr[0], negm, 0, 0, 0); p1 = __builtin_amdgcn_mfma_f32_32x32x16_bf16(y0, qr[0], negm, 0, 0, 0);
  fsm_slice<0>(q0p, q1p, alpha, l_reg, pa0, pa1, pa2, pa3, sm); SBAR();
  const int a3 = kb ^ (3 << 5); const bf16x8 x3 = lds_rd128<0>(a3), y3 = lds_rd128<8192>(a3);
  asm volatile("s_waitcnt lgkmcnt(4)" ::: "memory"); SBAR();
  p0 = __builtin_amdgcn_mfma_f32_32x32x16_bf16(x1, qr[1], p0, 0, 0, 0); p1 = __builtin_amdgcn_mfma_f32_32x32x16_bf16(y1, qr[1], p1, 0, 0, 0);
  fsm_slice<1>(q0p, q1p, alpha, l_reg, pa0, pa1, pa2, pa3, sm); SBAR();
  const int a4 = kb ^ (4 << 5); const bf16x8 x4 = lds_rd128<0>(a4), y4 = lds_rd128<8192>(a4);
  asm volatile("s_waitcnt lgkmcnt(4)" ::: "memory"); SBAR();
  p0 = __builtin_amdgcn_mfma_f32_32x32x16_bf16(x2, qr[2], p0, 0, 0, 0); p1 = __builtin_amdgcn_mfma_f32_32x32x16_bf16(y2, qr[2], p1, 0, 0, 0);
  fsm_slice<2>(q0p, q1p, alpha, l_reg, pa0, pa1, pa2, pa3, sm); SBAR();
  const int a5 = kb ^ (5 << 5); const bf16x8 x5 = lds_rd128<0>(a5), y5 = lds_rd128<8192>(a5);
  asm volatile("s_waitcnt lgkmcnt(4)" ::: "memory"); SBAR();
  p0 = __builtin_amdgcn_mfma_f32_32x32x16_bf16(x3, qr[3], p0, 0, 0, 0); p1 = __builtin_amdgcn_mfma_f32_32x32x16_bf16(y3, qr[3], p1, 0, 0, 0);
  fsm_slice<3>(q0p, q1p, alpha, l_reg, pa0, pa1, pa2, pa3, sm); SBAR();
  const int a6 = kb ^ (6 << 5); const bf16x8 x6 = lds_rd128<0>(a6), y6 = lds_rd128<8192>(a6);
  asm volatile("s_waitcnt lgkmcnt(4)" ::: "memory"); SBAR();
  p0 = __builtin_amdgcn_mfma_f32_32x32x16_bf16(x4, qr[4], p0, 0, 0, 0); p1 = __builtin_amdgcn_mfma_f32_32x32x16_bf16(y4, qr[4], p1, 0, 0, 0);
  fsm_slice<4>(q0p, q1p, alpha, l_reg, pa0, pa1, pa2, pa3, sm); SBAR();
  const int a7 = kb ^ (7 << 5); const bf16x8 x7 = lds_rd128<0>(a7), y7 = lds_rd128<8192>(a7);
  asm volatile("s_waitcnt lgkmcnt(4)" ::: "memory"); SBAR();
  p0 = __builtin_amdgcn_mfma_f32_32x32x16_bf16(x5, qr[5], p0, 0, 0, 0); p1 = __builtin_amdgcn_mfma_f32_32x32x16_bf16(y5, qr[5], p1, 0, 0, 0);
  fsm_slice<5>(q0p, q1p, alpha, l_reg, pa0, pa1, pa2, pa3, sm); SBAR();
  asm volatile("s_waitcnt lgkmcnt(2)" ::: "memory"); SBAR();
  p0 = __builtin_amdgcn_mfma_f32_32x32x16_bf16(x6, qr[6], p0, 0, 0, 0); p1 = __builtin_amdgcn_mfma_f32_32x32x16_bf16(y6, qr[6], p1, 0, 0, 0);
  fsm_slice<6>(q0p, q1p, alpha, l_reg, pa0, pa1, pa2, pa3, sm); SBAR();
  asm volatile("s_waitcnt lgkmcnt(0)" ::: "memory"); SBAR();
  p0 = __builtin_amdgcn_mfma_f32_32x32x16_bf16(x7, qr[7], p0, 0, 0, 0); p1 = __builtin_amdgcn_mfma_f32_32x32x16_bf16(y7, qr[7], p1, 0, 0, 0);
  fsm_slice<7>(q0p, q1p, alpha, l_reg, pa0, pa1, pa2, pa3, sm); SBAR();
}
__device__ __forceinline__ void pv_psm(f32x16* o, int vb, bf16x8 pa0, bf16x8 pa1, bf16x8 pa2, bf16x8 pa3, f32x16& n0, f32x16& n1, float& mC, float& alpha) {
  float mx[4];
#define PK(L, H) (bf16x8){L[0], L[1], L[2], L[3], H[0], H[1], H[2], H[3]}
  const s16x4 l0 = tr_read<v_rd_off(0, 0, 0)>(vb), h0 = tr_read<v_rd_off(0, 0, 1)>(vb);
  const s16x4 l1 = tr_read<v_rd_off(0, 1, 0)>(vb), h1 = tr_read<v_rd_off(0, 1, 1)>(vb);
  const s16x4 l2 = tr_read<v_rd_off(0, 2, 0)>(vb), h2 = tr_read<v_rd_off(0, 2, 1)>(vb);
  const s16x4 l3 = tr_read<v_rd_off(0, 3, 0)>(vb), h3 = tr_read<v_rd_off(0, 3, 1)>(vb);
  asm volatile("s_waitcnt lgkmcnt(6)" ::: "memory"); SBAR();
  o[0] = __builtin_amdgcn_mfma_f32_32x32x16_bf16(pa0, PK(l0, h0), o[0], 0, 0, 0);
  psm_slice<0>(n0, n1, mC, alpha, mx); SBAR();
  const s16x4 l4 = tr_read<v_rd_off(1, 0, 0)>(vb), h4 = tr_read<v_rd_off(1, 0, 1)>(vb);
  asm volatile("s_waitcnt lgkmcnt(6)" ::: "memory"); SBAR();
  o[0] = __builtin_amdgcn_mfma_f32_32x32x16_bf16(pa1, PK(l1, h1), o[0], 0, 0, 0);
  psm_slice<1>(n0, n1, mC, alpha, mx); SBAR();
  const s16x4 l5 = tr_read<v_rd_off(1, 1, 0)>(vb), h5 = tr_read<v_rd_off(1, 1, 1)>(vb);
  asm volatile("s_waitcnt lgkmcnt(6)" ::: "memory"); SBAR();
  o[0] = __builtin_amdgcn_mfma_f32_32x32x16_bf16(pa2, PK(l2, h2), o[0], 0, 0, 0);
  psm_slice<2>(n0, n1, mC, alpha, mx); SBAR();
  const s16x4 l6 = tr_read<v_rd_off(1, 2, 0)>(vb), h6 = tr_read<v_rd_off(1, 2, 1)>(vb);
  asm volatile("s_waitcnt lgkmcnt(6)" ::: "memory"); SBAR();
  o[0] = __builtin_amdgcn_mfma_f32_32x32x16_bf16(pa3, PK(l3, h3), o[0], 0, 0, 0);
  psm_slice<3>(n0, n1, mC, alpha, mx); SBAR();
  const s16x4 l7 = tr_read<v_rd_off(1, 3, 0)>(vb), h7 = tr_read<v_rd_off(1, 3, 1)>(vb);
  asm volatile("s_waitcnt lgkmcnt(6)" ::: "memory"); SBAR();
  o[1] = __builtin_amdgcn_mfma_f32_32x32x16_bf16(pa0, PK(l4, h4), o[1], 0, 0, 0);
  psm_slice<4>(n0, n1, mC, alpha, mx); SBAR();
  const s16x4 l8 = tr_read<v_rd_off(2, 0, 0)>(vb), h8 = tr_read<v_rd_off(2, 0, 1)>(vb);
  asm volatile("s_waitcnt lgkmcnt(6)" ::: "memory"); SBAR();
  o[1] = __builtin_amdgcn_mfma_f32_32x32x16_bf16(pa1, PK(l5, h5), o[1], 0, 0, 0);
  psm_slice<5>(n0, n1, mC, alpha, mx); SBAR();
  const s16x4 l9 = tr_read<v_rd_off(2, 1, 0)>(vb), h9 = tr_read<v_rd_off(2, 1, 1)>(vb);
  asm volatile("s_waitcnt lgkmcnt(6)" ::: "memory"); SBAR();
  o[1] = __builtin_amdgcn_mfma_f32_32x32x16_bf16(pa2, PK(l6, h6), o[1], 0, 0, 0);
  psm_slice<6>(n0, n1, mC, alpha, mx); SBAR();
  const s16x4 l10 = tr_read<v_rd_off(2, 2, 0)>(vb), h10 = tr_read<v_rd_off(2, 2, 1)>(vb);
  asm volatile("s_waitcnt lgkmcnt(6)" ::: "memory"); SBAR();
  o[1] = __builtin_amdgcn_mfma_f32_32x32x16_bf16(pa3, PK(l7, h7), o[1], 0, 0, 0);
  psm_slice<7>(n0, n1, mC, alpha, mx); SBAR();
  const s16x4 l11 = tr_read<v_rd_off(2, 3, 0)>(vb), h11 = tr_read<v_rd_off(2, 3, 1)>(vb);
  asm volatile("s_waitcnt lgkmcnt(6)" ::: "memory"); SBAR();
  o[2] = __builtin_amdgcn_mfma_f32_32x32x16_bf16(pa0, PK(l8, h8), o[2], 0, 0, 0);
  psm_slice<8>(n0, n1, mC, alpha, mx); SBAR();
  const s16x4 l12 = tr_read<v_rd_off(3, 0, 0)>(vb), h12 = tr_read<v_rd_off(3, 0, 1)>(vb);
  asm volatile("s_waitcnt lgkmcnt(6)" ::: "memory"); SBAR();
  o[2] = __builtin_amdgcn_mfma_f32_32x32x16_bf16(pa1, PK(l9, h9), o[2], 0, 0, 0);
  psm_slice<9>(n0, n1, mC, alpha, mx); SBAR();
  const s16x4 l13 = tr_read<v_rd_off(3, 1, 0)>(vb), h13 = tr_read<v_rd_off(3, 1, 1)>(vb);
  asm volatile("s_waitcnt lgkmcnt(6)" ::: "memory"); SBAR();
  o[2] = __builtin_amdgcn_mfma_f32_32x32x16_bf16(pa2, PK(l10, h10), o[2], 0, 0, 0);
  psm_slice<10>(n0, n1, mC, alpha, mx); SBAR();
  const s16x4 l14 = tr_read<v_rd_off(3, 2, 0)>(vb), h14 = tr_read<v_rd_off(3, 2, 1)>(vb);
  asm volatile("s_waitcnt lgkmcnt(6)" ::: "memory"); SBAR();
  o[2] = __builtin_amdgcn_mfma_f32_32x32x16_bf16(pa3, PK(l11, h11), o[2], 0, 0, 0);
  psm_slice<11>(n0, n1, mC, alpha, mx); SBAR();
  const s16x4 l15 = tr_read<v_rd_off(3, 3, 0)>(vb), h15 = tr_read<v_rd_off(3, 3, 1)>(vb);
  asm volatile("s_waitcnt lgkmcnt(6)" ::: "memory"); SBAR();
  o[3] = __builtin_amdgcn_mfma_f32_32x32x16_bf16(pa0, PK(l12, h12), o[3], 0, 0, 0);
  psm_slice<12>(n0, n1, mC, alpha, mx); SBAR();
  asm volatile("s_waitcnt lgkmcnt(4)" ::: "memory"); SBAR();
  o[3] = __builtin_amdgcn_mfma_f32_32x32x16_bf16(pa1, PK(l13, h13), o[3], 0, 0, 0);
  psm_slice<13>(n0, n1, mC, alpha, mx); SBAR();
  asm volatile("s_waitcnt lgkmcnt(2)" ::: "memory"); SBAR();
  o[3] = __builtin_amdgcn_mfma_f32_32x32x16_bf16(pa2, PK(l14, h14), o[3], 0, 0, 0);
  psm_slice<14>(n0, n1, mC, alpha, mx); SBAR();
  asm volatile("s_waitcnt lgkmcnt(0)" ::: "memory"); SBAR();
  o[3] = __builtin_amdgcn_mfma_f32_32x32x16_bf16(pa3, PK(l15, h15), o[3], 0, 0, 0);
  psm_slice<15>(n0, n1, mC, alpha, mx); SBAR();
#undef PK
}
constexpr int LDS_K_OFF = 2 * SHM_V, LDS_WS_OFF = LDS_K_OFF + 2 * 12 * 2048, LDS_TBL_OFF = LDS_WS_OFF + NW * 64 * 4, LDS_Q_OFF = LDS_TBL_OFF + ((TBLN * 4 + 15) / 16) * 16;
static_assert(LDS_Q_OFF + NW * 8192 <= 163840, "attention LDS map");

template <int NDQ, int BIAS, int EPI, int SDEPTH, int NQL = 0, int ROPEQ = 0, int ORD = 0>
__device__ __forceinline__ void attn_unit(const bf16_t* __restrict__ Qb, int ldq, const bf16_t* __restrict__ Kh, int ldk, const bf16_t* __restrict__ K2, int ldk2,
                                          const bf16_t* __restrict__ Vh, int ldv, int kbeg, int nkeys, int q0, const float* __restrict__ tblg, float cb_lo, float cb_hi,
                                          bf16_t* __restrict__ Obf, int ldo, float* __restrict__ tmp, float lam, const float* __restrict__ subln, float post, char* lds, const int wave0, const float* __restrict__ cosp = nullptr, const float* __restrict__ sinp = nullptr) {
  constexpr int ROWB = NDQ * 32, SHM_K = 64 * ROWB;
  int tid_ = wave0 * 64 + lane_id_v();
  const int tid = tid_, wid = tid >> 6, lane = tid & 63, r32 = lane & 31, hi = lane >> 5;
  char* V_lds = lds; char* K_lds = lds + LDS_K_OFF;
  float* ws = (float*)(lds + LDS_WS_OFF) + wid * 64; float* li_l = ws; float* al_l = ws + 32;
  float* tbl_l = (float*)(lds + LDS_TBL_OFF);
  __syncthreads();
  if constexpr (BIAS) { for (int i = tid; i < TBLN; i += 512) tbl_l[i] = tblg[i]; }
  float mC = 0.f, l_reg = 0, nm_cur = 0.f; f32x16 o[4] = {}; f32x16 negm = {}; bf16x8 qr[NDQ - NQL];
  const bf16_t* Qw = Qb + (long)(wid * QBLK + r32) * ldq + hi * 8;
  char* qls = lds + LDS_Q_OFF + wid * 8192 + lane * 16;
#pragma unroll
  for (int d0 = 0; d0 < NDQ - NQL; ++d0) qr[d0] = *reinterpret_cast<const bf16x8*>(Qw + d0 * 16);
  if constexpr (ROPEQ) {
    static_assert(NDQ == 12 && NQL >= 4, "ROPEQ: MLA layout");
#pragma unroll
    for (int d0 = NDQ - NQL; d0 < 8; ++d0) *reinterpret_cast<bf16x8*>(qls + (d0 - (NDQ - NQL)) * 1024) = *reinterpret_cast<const bf16x8*>(Qw + d0 * 16);
    const int qrow = q0 + wid * QBLK + r32;
#pragma unroll
    for (int pr = 0; pr < 2; ++pr) {
      const bf16x8 xa = *reinterpret_cast<const bf16x8*>(Qw + (8 + pr) * 16), xb = *reinterpret_cast<const bf16x8*>(Qw + (10 + pr) * 16);
      const float* cp = cosp + (size_t)qrow * 32 + pr * 16 + hi * 8; const float* sp = sinp + (size_t)qrow * 32 + pr * 16 + hi * 8;
      const f32x4 c0 = *(const f32x4*)cp, c1 = *(const f32x4*)(cp + 4), s0 = *(const f32x4*)sp, s1 = *(const f32x4*)(sp + 4);
      float ya[8], yb[8];
#pragma unroll
      for (int t = 0; t < 8; ++t) { const float x1 = bf2f((unsigned short)xa[t]), x2 = bf2f((unsigned short)xb[t]); const float c = t < 4 ? c0[t & 3] : c1[t & 3], sn = t < 4 ? s0[t & 3] : s1[t & 3];
        ya[t] = x1 * c - x2 * sn; yb[t] = x2 * c + x1 * sn; }
      u32x4 wa = {pk2(ya[0], ya[1]), pk2(ya[2], ya[3]), pk2(ya[4], ya[5]), pk2(ya[6], ya[7])}, wb = {pk2(yb[0], yb[1]), pk2(yb[2], yb[3]), pk2(yb[4], yb[5]), pk2(yb[6], yb[7])};
      *reinterpret_cast<u32x4*>(qls + (8 + pr - (NDQ - NQL)) * 1024) = wa; *reinterpret_cast<u32x4*>(qls + (10 + pr - (NDQ - NQL)) * 1024) = wb; }
  } else {
#pragma unroll
  for (int d0 = NDQ - NQL; d0 < NDQ; ++d0) *reinterpret_cast<bf16x8*>(qls + (d0 - (NDQ - NQL)) * 1024) = *reinterpret_cast<const bf16x8*>(Qw + d0 * 16);
  }
  const int sr = tid >> 4, sc = (tid & 15) * 8, vst0 = v_st(sr, sc), vst1 = v_st(32 + sr, sc);
  const int sr8 = tid >> 3, sc8 = (tid & 7) * 8;
  const int vb0 = (int)(uintptr_t)V_lds + v_rd_base(lane);
  const int qlane = q0 + wid * QBLK + r32;
  struct { bf16x8 vs0, vs1, ks0, ks1, ks2; } sr_[SDEPTH];
  constexpr int SWM = (NDQ == 8) ? 15 : 7;
#define KSWZ(row, colB) ((row) * ROWB + ((colB) ^ (((row) & SWM) << 4)))
#define SLOAD(i, k0) do { sr_[i].vs0 = *reinterpret_cast<const bf16x8*>(&Vh[(long)((k0) + sr) * ldv + sc]); sr_[i].vs1 = *reinterpret_cast<const bf16x8*>(&Vh[(long)((k0) + 32 + sr) * ldv + sc]); \
    if constexpr (NDQ == 4) { sr_[i].ks0 = *reinterpret_cast<const bf16x8*>(&Kh[(long)((k0) + sr8) * ldk + sc8]); } \
    else { sr_[i].ks0 = *reinterpret_cast<const bf16x8*>(&Kh[(long)((k0) + sr) * ldk + sc]); sr_[i].ks1 = *reinterpret_cast<const bf16x8*>(&Kh[(long)((k0) + 32 + sr) * ldk + sc]); \
      if constexpr (NDQ == 12) { sr_[i].ks2 = *reinterpret_cast<const bf16x8*>(&K2[(long)((k0) + sr8) * ldk2 + sc8]); } } } while (0)
#define SWRITE(b, i) do { *(bf16x8*)(V_lds + (b) * SHM_V + vst0) = sr_[i].vs0; *(bf16x8*)(V_lds + (b) * SHM_V + vst1) = sr_[i].vs1; \
    if constexpr (NDQ == 4) { *(bf16x8*)(K_lds + (b) * SHM_K + KSWZ(sr8, sc8 * 2)) = sr_[i].ks0; } \
    else { *(bf16x8*)(K_lds + (b) * SHM_K + KSWZ(sr, sc * 2)) = sr_[i].ks0; *(bf16x8*)(K_lds + (b) * SHM_K + KSWZ(32 + sr, sc * 2)) = sr_[i].ks1; \
      if constexpr (NDQ == 12) { *(bf16x8*)(K_lds + (b) * SHM_K + KSWZ(sr8, 256 + sc8 * 2)) = sr_[i].ks2; } } } while (0)
#define SWAIT() do { if constexpr (SDEPTH == 2) { if constexpr (NDQ == 4) asm volatile("s_waitcnt vmcnt(3)" ::: "memory"); else if constexpr (NDQ == 8) asm volatile("s_waitcnt vmcnt(4)" ::: "memory"); else asm volatile("s_waitcnt vmcnt(5)" ::: "memory"); } \
    else asm volatile("s_waitcnt vmcnt(0)" ::: "memory"); } while (0)
#define RESC(a) do { if (__any((a) < 1.f)) { if (hi == 0) al_l[r32] = (a); asm volatile("s_waitcnt lgkmcnt(0)" ::: "memory"); \
    _Pragma("unroll") for (int d = 0; d < 4; ++d) _Pragma("unroll") for (int r = 0; r < 16; ++r) o[d][r] *= al_l[crow(r, hi)]; } } while (0)
#define BIASADD(P0, P1, kt0) do { if constexpr (BIAS) { const int dlo_ = (kt0) - q0 - 255, dhi_ = (kt0) + 63 - q0; \
    if (!(dlo_ >= 1024) && !(dhi_ <= -1024)) { const float* tb_ = tbl_l + ((kt0) - qlane + TOFF + 4 * hi); \
      _Pragma("unroll") for (int r = 0; r < 16; ++r) { P0[r] += tb_[(r & 3) + 8 * (r >> 2)]; P1[r] += tb_[32 + (r & 3) + 8 * (r >> 2)]; } } } } while (0)
#define NEGM_UPD(kt0) do { float nmj_ = -mC; if constexpr (BIAS) { const int dlo_ = (kt0) - q0 - 255, dhi_ = (kt0) + 63 - q0; if (dlo_ >= 1024) nmj_ += cb_hi; else if (dhi_ <= -1024) nmj_ += cb_lo; } \
    if (__any(nmj_ != nm_cur)) { nm_cur = nmj_; _Pragma("unroll") for (int r = 0; r < 16; ++r) negm[r] = nmj_; } } while (0)
  f32x16 pA0, pA1, pB0, pB1; float alA, alB; bf16x8 pa0, pa1, pa2, pa3; const int NT = nkeys / KVBLK;
  const int kb0 = (int)(uintptr_t)K_lds + r32 * ROWB + (((r32 & 15) << 4) ^ (hi << 4));
#define QKT(P0, P1, KOFF) do { if constexpr (NDQ == 8 && NQL == 0) qkt8_roll(P0, P1, negm, kb0 + (KOFF), qr); else qkt<NDQ, NQL>(P0, P1, negm, K_lds + (KOFF), qr, qls, r32, hi); } while (0)
  constexpr int SE = 0, SO = SDEPTH - 1;
  SLOAD(SE, kbeg); asm volatile("s_waitcnt vmcnt(0)" ::: "memory"); SWRITE(0, SE); __syncthreads();
  constexpr bool SLICED = (NDQ == 8 && NQL == 0);
  NEGM_UPD(kbeg); QKT(pA0, pA1, 0); BIASADD(pA0, pA1, kbeg); partialSM<true>(pA0, pA1, mC, alA);
  if constexpr (SLICED) {
#pragma unroll
    for (int r = 0; r < 16; ++r) pA1[r] = __builtin_amdgcn_exp2f(pA1[r]); }
  SLOAD(SO, kbeg + KVBLK); if constexpr (SDEPTH == 2) { if (2 < NT) SLOAD(SE, kbeg + 2 * KVBLK); }
  SWAIT(); SWRITE(1, SO); __syncthreads();
  if constexpr (NDQ == 8 && NQL == 0) {
  for (int j = 1; j + 1 < NT; j += 2) {
    if constexpr (ORD == 0) {
    NEGM_UPD(kbeg + j * KVBLK); SBAR();
    qkt8_fsm(pB0, pB1, negm, kb0 + SHM_K, qr, pA0, pA1, alA, l_reg, pa0, pa1, pa2, pa3);
    SLOAD(SO, kbeg + (j + SDEPTH) * KVBLK); SBAR();
    BIASADD(pB0, pB1, kbeg + j * KVBLK); SBAR();
    pv_psm(o, vb0, pa0, pa1, pa2, pa3, pB0, pB1, mC, alB);
    } else {
    finishSM<false>(pA0, pA1, alA, l_reg, pa0, pa1, pa2, pa3); SBAR();
    NEGM_UPD(kbeg + j * KVBLK); SBAR(); qkt8_roll(pB0, pB1, negm, kb0 + SHM_K, qr); SBAR();
    SLOAD(SO, kbeg + (j + SDEPTH) * KVBLK); SBAR();
    BIASADD(pB0, pB1, kbeg + j * KVBLK); partialSM<false>(pB0, pB1, mC, alB);
    _Pragma("unroll") for (int r = 0; r < 16; ++r) pB1[r] = __builtin_amdgcn_exp2f(pB1[r]);
    SBAR(); pv_d0(o, vb0, pa0, pa1, pa2, pa3);
    }
    __syncthreads(); SWAIT(); SWRITE(0, SE);
    RESC(alB); __syncthreads();
    if constexpr (ORD == 0) {
    NEGM_UPD(kbeg + (j + 1) * KVBLK); SBAR();
    qkt8_fsm(pA0, pA1, negm, kb0, qr, pB0, pB1, alB, l_reg, pa0, pa1, pa2, pa3);
    if (SDEPTH == 1 || j + 3 < NT) SLOAD(SE, kbeg + (j + 1 + SDEPTH) * KVBLK); SBAR();
    BIASADD(pA0, pA1, kbeg + (j + 1) * KVBLK); SBAR();
    pv_psm(o, vb0 + (int)SHM_V, pa0, pa1, pa2, pa3, pA0, pA1, mC, alA);
    } else {
    finishSM<false>(pB0, pB1, alB, l_reg, pa0, pa1, pa2, pa3); SBAR();
    NEGM_UPD(kbeg + (j + 1) * KVBLK); SBAR(); qkt8_roll(pA0, pA1, negm, kb0, qr); SBAR();
    if (SDEPTH == 1 || j + 3 < NT) SLOAD(SE, kbeg + (j + 1 + SDEPTH) * KVBLK); SBAR();
    BIASADD(pA0, pA1, kbeg + (j + 1) * KVBLK); partialSM<false>(pA0, pA1, mC, alA);
    _Pragma("unroll") for (int r = 0; r < 16; ++r) pA1[r] = __builtin_amdgcn_exp2f(pA1[r]);
    SBAR(); pv_d0(o, vb0 + (int)SHM_V, pa0, pa1, pa2, pa3);
    }
    __syncthreads(); SWAIT(); SWRITE(1, SO);
    RESC(alA); __syncthreads();
  }
  } else {
  for (int j = 1; j + 1 < NT; j += 2) {
    NEGM_UPD(kbeg + j * KVBLK); SBAR(); QKT(pB0, pB1, SHM_K);
    finishSM(pA0, pA1, alA, l_reg, pa0, pa1, pa2, pa3); SBAR();
    SLOAD(SO, kbeg + (j + SDEPTH) * KVBLK); SBAR();
    pv_d0(o, vb0, pa0, pa1, pa2, pa3); BIASADD(pB0, pB1, kbeg + j * KVBLK); partialSM<false>(pB0, pB1, mC, alB);
    __syncthreads(); SWAIT(); SWRITE(0, SE);
    RESC(alB); __syncthreads();
    NEGM_UPD(kbeg + (j + 1) * KVBLK); SBAR(); QKT(pA0, pA1, 0);
    finishSM(pB0, pB1, alB, l_reg, pa0, pa1, pa2, pa3); SBAR();
    if (SDEPTH == 1 || j + 3 < NT) SLOAD(SE, kbeg + (j + 1 + SDEPTH) * KVBLK); SBAR();
    pv_d0(o, vb0 + (int)SHM_V, pa0, pa1, pa2, pa3); BIASADD(pA0, pA1, kbeg + (j + 1) * KVBLK); partialSM<false>(pA0, pA1, mC, alA);
    __syncthreads(); SWAIT(); SWRITE(1, SO);
    RESC(alA); __syncthreads();
  }
  }
  NEGM_UPD(kbeg + (NT - 1) * KVBLK); SBAR(); QKT(pB0, pB1, SHM_K);
  finishSM<!SLICED>(pA0, pA1, alA, l_reg, pa0, pa1, pa2, pa3); SBAR();
  pv_d0(o, vb0, pa0, pa1, pa2, pa3); BIASADD(pB0, pB1, kbeg + (NT - 1) * KVBLK); partialSM<false>(pB0, pB1, mC, alB);
  __syncthreads(); RESC(alB);
  finishSM(pB0, pB1, alB, l_reg, pa0, pa1, pa2, pa3); SBAR();
  pv_d0(o, vb0 + (int)SHM_V, pa0, pa1, pa2, pa3);
  if (hi == 0) li_l[r32] = l_reg; asm volatile("s_waitcnt lgkmcnt(0)" ::: "memory");
  float rli[16];
#pragma unroll
  for (int r = 0; r < 16; ++r) rli[r] = __builtin_amdgcn_rcpf(li_l[crow(r, hi)]);
  if constexpr (EPI == 0) {
    bf16_t* Ow = Obf + (long)(wid * QBLK) * ldo;
#pragma unroll
    for (int r = 0; r < 16; ++r) { const int orow = crow(r, hi);
#pragma unroll
      for (int d0 = 0; d0 < 4; ++d0) Ow[(long)orow * ldo + d0 * 32 + r32] = (bf16_t)f2bf(o[d0][r] * rli[r]); }
  } else if constexpr (EPI == 1) {
    float* Tw = tmp + (wid * QBLK) * 128;
#pragma unroll
    for (int r = 0; r < 16; ++r) { const int orow = crow(r, hi);
#pragma unroll
      for (int d0 = 0; d0 < 4; ++d0) Tw[orow * 128 + d0 * 32 + r32] = o[d0][r] * rli[r]; }
  } else {
    const float* Tw = tmp + (wid * QBLK) * 128; bf16_t* Ow = Obf + (long)(wid * QBLK) * ldo;
    float sg[4];
#pragma unroll
    for (int d0 = 0; d0 < 4; ++d0) sg[d0] = subln[d0 * 32 + r32] * post;
#pragma unroll
    for (int r = 0; r < 16; ++r) { const int orow = crow(r, hi); float v[4]; float ss = 0.f;
#pragma unroll
      for (int d0 = 0; d0 < 4; ++d0) { v[d0] = Tw[orow * 128 + d0 * 32 + r32] - lam * (o[d0][r] * rli[r]); ss += v[d0] * v[d0]; }
      ss += swz_xor<1>(ss); ss += swz_xor<2>(ss); ss += swz_xor<4>(ss); ss += swz_xor<8>(ss); ss += swz_xor<16>(ss);
      const float rs = rsqrtf(ss * (1.0f / 128.0f) + EPS);
#pragma unroll
      for (int d0 = 0; d0 < 4; ++d0) Ow[(long)orow * ldo + d0 * 32 + r32] = (bf16_t)f2bf(v[d0] * rs * sg[d0]); }
  }
#undef KSWZ
#undef SLOAD
#undef SWRITE
#undef SWAIT
#undef RESC
#undef BIASADD
#undef NEGM_UPD
#undef QKT
}

template <int M>
__device__ __forceinline__ void qkt_map(f32x16& p0, f32x16& p1, const char* Ks, const char* qls, int r32, int hi) {
  p0 = f32x16{}; p1 = f32x16{};
#pragma unroll
  for (int d0 = 0; d0 < 4; ++d0) { const int cb = (M * 64 + d0 * 16 + hi * 8) * 2;
    bf16x8 b0 = *reinterpret_cast<const bf16x8*>(Ks + r32 * 256 + (cb ^ ((r32 & 15) << 4)));
    bf16x8 b1 = *reinterpret_cast<const bf16x8*>(Ks + (32 + r32) * 256 + (cb ^ ((r32 & 15) << 4)));
    bf16x8 q = *reinterpret_cast<const bf16x8*>(qls + (M * 4 + d0) * 1024);
    p0 = __builtin_amdgcn_mfma_f32_32x32x16_bf16(b0, q, p0, 0, 0, 0);
    p1 = __builtin_amdgcn_mfma_f32_32x32x16_bf16(b1, q, p1, 0, 0, 0);
    if (d0 == 1) SBAR(); }
}
__device__ __forceinline__ void softmax_tile(f32x16& p0, f32x16& p1, float& m, float& l, float& alpha, float cb, bf16x8& pa0, bf16x8& pa1, bf16x8& pa2, bf16x8& pa3) {
  float mx_[4] = {p0[0], p0[1], p0[2], p0[3]};
#pragma unroll
  for (int r = 4; r < 16; ++r) mx_[r & 3] = fmaxf(mx_[r & 3], p0[r]);
#pragma unroll
  for (int r = 0; r < 16; ++r) mx_[r & 3] = fmaxf(mx_[r & 3], p1[r]);
  float pmax = fmaxf(fmaxf(mx_[0], mx_[1]), fmaxf(mx_[2], mx_[3]));
  { auto rr = __builtin_amdgcn_permlane32_swap(__float_as_uint(pmax), __float_as_uint(pmax), false, false);
    pmax = fmaxf(__uint_as_float(rr[0]), __uint_as_float(rr[1])); }
  pmax += cb;
  float mn;
  if (__builtin_expect(__all(pmax - m <= THR2), 1)) { mn = m; alpha = 1.f; }
  else { mn = fmaxf(m, pmax); alpha = __builtin_amdgcn_exp2f(m - mn); m = mn; }
  const float off = cb - mn;
#pragma unroll
  for (int r = 0; r < 16; ++r) p0[r] = __builtin_amdgcn_exp2f(p0[r] + off);
#pragma unroll
  for (int r = 0; r < 16; ++r) p1[r] = __builtin_amdgcn_exp2f(p1[r] + off);
  float sm_[4] = {p0[0], p0[1], p0[2], p0[3]};
#pragma unroll
  for (int r = 4; r < 16; ++r) sm_[r & 3] += p0[r];
#pragma unroll
  for (int r = 0; r < 16; ++r) sm_[r & 3] += p1[r];
  float ps = (sm_[0] + sm_[1]) + (sm_[2] + sm_[3]);
  { auto rr = __builtin_amdgcn_permlane32_swap(__float_as_uint(ps), __float_as_uint(ps), false, false);
    ps = __uint_as_float(rr[0]) + __uint_as_float(rr[1]); }
  l = l * alpha + ps;
#define PK4(P, BASE, OUT) do { unsigned a0 = cvtpk(P[BASE + 0], P[BASE + 1]), a1 = cvtpk(P[BASE + 2], P[BASE + 3]);   \
    unsigned b0 = cvtpk(P[BASE + 4], P[BASE + 5]), b1 = cvtpk(P[BASE + 6], P[BASE + 7]);                              \
    auto r0 = __builtin_amdgcn_permlane32_swap(a0, b0, false, false); auto r1 = __builtin_amdgcn_permlane32_swap(a1, b1, false, false); \
    u32x4 w = {r0[0], r1[0], r0[1], r1[1]}; OUT = *reinterpret_cast<bf16x8*>(&w); } while (0)
  PK4(p0, 0, pa0); PK4(p0, 8, pa1); PK4(p1, 0, pa2); PK4(p1, 8, pa3);
#undef PK4
}
template <int D0> __device__ __forceinline__ void pv2_one(f32x16& oa, f32x16& ob, int vb, bf16x8 pa0, bf16x8 pa1, bf16x8 pa2, bf16x8 pa3, bf16x8 pb0, bf16x8 pb1, bf16x8 pb2, bf16x8 pb3) {
  const s16x4 l0 = tr_read<v_rd_off(D0, 0, 0)>(vb), h0 = tr_read<v_rd_off(D0, 0, 1)>(vb), l1 = tr_read<v_rd_off(D0, 1, 0)>(vb), h1 = tr_read<v_rd_off(D0, 1, 1)>(vb);
  const s16x4 l2 = tr_read<v_rd_off(D0, 2, 0)>(vb), h2 = tr_read<v_rd_off(D0, 2, 1)>(vb), l3 = tr_read<v_rd_off(D0, 3, 0)>(vb), h3 = tr_read<v_rd_off(D0, 3, 1)>(vb);
  asm volatile("s_waitcnt lgkmcnt(0)" ::: "memory"); SBAR();
#define PK(L, H) (bf16x8){L[0], L[1], L[2], L[3], H[0], H[1], H[2], H[3]}
  const bf16x8 v0 = PK(l0, h0), v1 = PK(l1, h1), v2 = PK(l2, h2), v3 = PK(l3, h3);
  oa = __builtin_amdgcn_mfma_f32_32x32x16_bf16(pa0, v0, oa, 0, 0, 0);
  ob = __builtin_amdgcn_mfma_f32_32x32x16_bf16(pb0, v0, ob, 0, 0, 0);
  oa = __builtin_amdgcn_mfma_f32_32x32x16_bf16(pa1, v1, oa, 0, 0, 0);
  ob = __builtin_amdgcn_mfma_f32_32x32x16_bf16(pb1, v1, ob, 0, 0, 0);
  oa = __builtin_amdgcn_mfma_f32_32x32x16_bf16(pa2, v2, oa, 0, 0, 0);
  ob = __builtin_amdgcn_mfma_f32_32x32x16_bf16(pb2, v2, ob, 0, 0, 0);
  oa = __builtin_amdgcn_mfma_f32_32x32x16_bf16(pa3, v3, oa, 0, 0, 0);
  ob = __builtin_amdgcn_mfma_f32_32x32x16_bf16(pb3, v3, ob, 0, 0, 0);
#undef PK
}
__device__ __forceinline__ void attn_unit_A2(const bf16_t* __restrict__ Qb, int ldq, const bf16_t* __restrict__ Kh, int ldk, const bf16_t* __restrict__ Vh, int ldv, int nkeys, int q0,
                                             const float* __restrict__ tblg, float cb_lo, float cb_hi, bf16_t* __restrict__ Obf, int ldo, float lam, const float* __restrict__ subln, float post, char* lds, const int wave0) {
  constexpr int ROWB = 256, SHM_K = 64 * ROWB;
  int tid_ = wave0 * 64 + lane_id_v();
  const int tid = tid_, wid = tid >> 6, lane = tid & 63, r32 = lane & 31, hi = lane >> 5;
  char* V_lds = lds; char* K_lds = lds + LDS_K_OFF;
  float* ws = (float*)(lds + LDS_WS_OFF) + wid * 64; float* sl0 = ws; float* sl1 = ws + 32;
  float* tbl_l = (float*)(lds + LDS_TBL_OFF);
  char* qls = lds + LDS_Q_OFF + wid * 8192 + lane * 16;
  __syncthreads();
  for (int i = tid; i < TBLN; i += 512) tbl_l[i] = tblg[i];
  { const bf16_t* Qw = Qb + (long)(wid * QBLK + r32) * ldq + hi * 8;
#pragma unroll
    for (int i = 0; i < 8; ++i) *reinterpret_cast<bf16x8*>(qls + i * 1024) = *reinterpret_cast<const bf16x8*>(Qw + i * 16); }
  float m0 = -1e30f, m1 = -1e30f, l0 = 0.f, l1 = 0.f; f32x16 oa[4] = {}, ob[4] = {};
  const int sr = tid >> 4, sc = (tid & 15) * 8, vst0 = v_st(sr, sc), vst1 = v_st(32 + sr, sc);
  const int vb0 = (int)(uintptr_t)V_lds + v_rd_base(lane);
  const int qlane = q0 + wid * QBLK + r32;
  bf16x8 vs0, vs1, ks0, ks1;
#define KSWZ(row, colB) ((row) * ROWB + ((colB) ^ (((row) & 15) << 4)))
#define SLOAD2(k0) do { vs0 = *reinterpret_cast<const bf16x8*>(&Vh[(long)((k0) + sr) * ldv + sc]); vs1 = *reinterpret_cast<const bf16x8*>(&Vh[(long)((k0) + 32 + sr) * ldv + sc]); \
    ks0 = *reinterpret_cast<const bf16x8*>(&Kh[(long)((k0) + sr) * ldk + sc]); ks1 = *reinterpret_cast<const bf16x8*>(&Kh[(long)((k0) + 32 + sr) * ldk + sc]); } while (0)
#define SWRITE2(b) do { *(bf16x8*)(V_lds + (b) * SHM_V + vst0) = vs0; *(bf16x8*)(V_lds + (b) * SHM_V + vst1) = vs1; \
    *(bf16x8*)(K_lds + (b) * SHM_K + KSWZ(sr, sc * 2)) = ks0; *(bf16x8*)(K_lds + (b) * SHM_K + KSWZ(32 + sr, sc * 2)) = ks1; } while (0)
#define RESC2(O, SL, a) do { if (__any((a) < 1.f)) { if (hi == 0) SL[r32] = (a); asm volatile("s_waitcnt lgkmcnt(0)" ::: "memory"); \
    _Pragma("unroll") for (int d = 0; d < 4; ++d) _Pragma("unroll") for (int r = 0; r < 16; ++r) O[d][r] *= SL[crow(r, hi)]; } } while (0)
  const int NT = nkeys / KVBLK;
  SLOAD2(0); asm volatile("s_waitcnt vmcnt(0)" ::: "memory"); SWRITE2(0); __syncthreads();
  for (int j = 0; j < NT; ++j) {
    const int b = j & 1, kt0 = j * KVBLK;
    const int dlo_ = kt0 - q0 - 255, dhi_ = kt0 + 63 - q0;
    float cb = 0.f; const bool nearb = !(dlo_ >= 1024) && !(dhi_ <= -1024);
    if (dlo_ >= 1024) cb = cb_hi; else if (dhi_ <= -1024) cb = cb_lo;
    const float* tb_ = tbl_l + (kt0 - qlane + TOFF + 4 * hi);
    f32x16 s0, s1; bf16x8 pa0, pa1, pa2, pa3; float al0, al1;
    const int vb = vb0 + b * (int)SHM_V;
    qkt_map<0>(s0, s1, K_lds + b * SHM_K, qls, r32, hi);
    SBAR();
    if (nearb) {
#pragma unroll
      for (int r = 0; r < 8; ++r) { s0[r] += tb_[(r & 3) + 8 * (r >> 2)]; s1[r] += tb_[32 + (r & 3) + 8 * (r >> 2)]; }
      SBAR();
#pragma unroll
      for (int r = 8; r < 16; ++r) { s0[r] += tb_[(r & 3) + 8 * (r >> 2)]; s1[r] += tb_[32 + (r & 3) + 8 * (r >> 2)]; } }
    SBAR();
    softmax_tile(s0, s1, m0, l0, al0, cb, pa0, pa1, pa2, pa3);
    RESC2(oa, sl0, al0);
    SBAR();
    pv_d0(oa, vb, pa0, pa1, pa2, pa3);
    SBAR();
    qkt_map<1>(s0, s1, K_lds + b * SHM_K, qls, r32, hi);
    SBAR();
    if (nearb) {
#pragma unroll
      for (int r = 0; r < 8; ++r) { s0[r] += tb_[(r & 3) + 8 * (r >> 2)]; s1[r] += tb_[32 + (r & 3) + 8 * (r >> 2)]; }
      SBAR();
#pragma unroll
      for (int r = 8; r < 16; ++r) { s0[r] += tb_[(r & 3) + 8 * (r >> 2)]; s1[r] += tb_[32 + (r & 3) + 8 * (r >> 2)]; } }
    SBAR();
    softmax_tile(s0, s1, m1, l1, al1, cb, pa0, pa1, pa2, pa3);
    RESC2(ob, sl1, al1);
    SBAR();
    if (j + 1 < NT) SLOAD2(kt0 + KVBLK);
    SBAR();
    pv_d0(ob, vb, pa0, pa1, pa2, pa3);
    if (j + 1 < NT) { asm volatile("s_waitcnt vmcnt(0)" ::: "memory"); SWRITE2(b ^ 1); }
    __syncthreads();
  }
  const int lane_e = lane_id_v(), r32e = lane_e & 31, hie = lane_e >> 5;
  if (hie == 0) { sl0[r32e] = l0; sl1[r32e] = l1; } asm volatile("s_waitcnt lgkmcnt(0)" ::: "memory");
  bf16_t* Ow = Obf + (long)(wid * QBLK) * ldo;
  float sg[4];
#pragma unroll
  for (int d0 = 0; d0 < 4; ++d0) sg[d0] = subln[d0 * 32 + r32e] * post;
#pragma unroll
  for (int r = 0; r < 16; ++r) { const int orow = crow(r, hie); const float ra = __builtin_amdgcn_rcpf(sl0[orow]), rb = lam * __builtin_amdgcn_rcpf(sl1[orow]); float v[4]; float ss = 0.f;
#pragma unroll
    for (int d0 = 0; d0 < 4; ++d0) { v[d0] = oa[d0][r] * ra - ob[d0][r] * rb; ss += v[d0] * v[d0]; }
    ss += swz_xor<1>(ss); ss += swz_xor<2>(ss); ss += swz_xor<4>(ss); ss += swz_xor<8>(ss); ss += swz_xor<16>(ss);
    const float rs = rsqrtf(ss * (1.0f / 128.0f) + EPS);
#pragma unroll
    for (int d0 = 0; d0 < 4; ++d0) Ow[(long)orow * ldo + d0 * 32 + r32e] = (bf16_t)f2bf(v[d0] * rs * sg[d0]); }
#undef KSWZ
#undef SLOAD2
#undef SWRITE2
#undef RESC2
}
}

__device__ __forceinline__ void transpose_item(const float* __restrict__ W, int K, int N, bf16_t* __restrict__ WT, int k0, int n0, int drow0, float wscale, LAS float* scr, int lane) {
    float tv[32];
#pragma unroll
    for (int i = 0; i < 32; ++i) { const int kk = 2 * i + (lane >> 5); tv[i] = W[(size_t)(k0 + kk) * N + n0 + (lane & 31)]; }
#pragma unroll
    for (int i = 0; i < 32; ++i) { const int kk = 2 * i + (lane >> 5); scr[kk * 33 + (lane & 31)] = tv[i] * wscale; }
    asm volatile("s_waitcnt lgkmcnt(0)" ::: "memory");
    const int c = lane & 7;
#pragma unroll
    for (int j = 0; j < 4; ++j) { const int n = (lane >> 3) + 8 * j; const LAS float* s = scr + (8 * c) * 33 + n;
        u32x4 o; o.x = pk2(s[0 * 33], s[1 * 33]); o.y = pk2(s[2 * 33], s[3 * 33]); o.z = pk2(s[4 * 33], s[5 * 33]); o.w = pk2(s[6 * 33], s[7 * 33]);
        *(u32x4*)(WT + (size_t)(drow0 + n) * K + k0 + 8 * c) = o; }
    asm volatile("s_waitcnt lgkmcnt(0)" ::: "memory");
}
constexpr float QS_A = 0.125f * 1.4426950408889634f, QS_B = 0.07216878364870322f * 1.4426950408889634f, QS_CD = 0.08838834764831845f * 1.4426950408889634f;
template <int MODE>
__device__ __forceinline__ void transpose_matrix(const float* __restrict__ W, int K, int N, bf16_t* __restrict__ WT, LAS float* scr, int lane, int gw, int NGW) {
    const int nblk = N / 32, nitems = (K / 64) * nblk;
    for (int it = gw; it < nitems; it += NGW) { const int kb = it / nblk, nb = it % nblk, n0 = 32 * nb; int drow0 = n0;
        if (MODE == 1) { const int c = n0 < FF ? n0 : n0 - FF; drow0 = 256 * (c / 128) + (c % 128) + (n0 < FF ? 0 : 128); }
        float wscale = 1.0f;
        if (MODE == 2) { if (n0 < C_AK) wscale = QS_A; else if (n0 >= C_DQ && n0 < C_DK) wscale = QS_CD; }
        if (MODE == 3) wscale = QS_B;
        transpose_item(W, K, N, WT, 64 * kb, n0, drow0, wscale, scr, lane); }
}
__device__ __forceinline__ int t5_bucket(int d) {
    const int ret = d > 0 ? 16 : 0; const int n = d < 0 ? -d : d;
    if (n < 8) return ret + n;
    const float v = logf((float)n / 8.0f) / 4.852030263919617f * 8.0f;
    int large = 8 + (int)v; if (large > 15) large = 15;
    return ret + large;
}
__device__ __forceinline__ void norm_row(const float* __restrict__ xrow, const float* __restrict__ g, bf16_t* __restrict__ hrow, int lane) {
    f32x4 v[8]; float ss = 0.f;
#pragma unroll
    for (int j = 0; j < 8; ++j) { v[j] = ((const f32x4*)xrow)[lane + 64 * j]; ss += (v[j].x * v[j].x + v[j].y * v[j].y) + (v[j].z * v[j].z + v[j].w * v[j].w); }
    const float rs = rsqrtf(wave_sum(ss) * (1.0f / DM) + EPS);
#pragma unroll
    for (int j = 0; j < 8; ++j) { const f32x4 gg = ((const f32x4*)g)[lane + 64 * j];
        u32x2 w; w.x = pk2(v[j].x * rs * gg.x, v[j].y * rs * gg.y); w.y = pk2(v[j].z * rs * gg.z, v[j].w * rs * gg.w); ((u32x2*)hrow)[lane + 64 * j] = w; }
}
template <int NR>
__device__ __forceinline__ void norm_add_rows(const bf16_t* __restrict__ Yb, const float* xi, float* xo, const float* __restrict__ gpost,
                                              const float* __restrict__ gpre, bf16_t* __restrict__ Hb, int row0, int rstride, int lane) {
    u32x2 yb[NR][8]; f32x4 v[NR][8];
#pragma unroll
    for (int q = 0; q < NR; ++q) { const size_t ro = (size_t)(row0 + q * rstride) * DM;
#pragma unroll
        for (int j = 0; j < 8; ++j) yb[q][j] = ((const u32x2*)(Yb + ro))[lane + 64 * j];
#pragma unroll
        for (int j = 0; j < 8; ++j) v[q][j] = ((const f32x4*)(xi + ro))[lane + 64 * j]; }
    f32x4 gp[8];
#pragma unroll
    for (int j = 0; j < 8; ++j) gp[j] = ((const f32x4*)gpost)[lane + 64 * j];
#pragma unroll
    for (int q = 0; q < NR; ++q) { const size_t ro = (size_t)(row0 + q * rstride) * DM;
        f32x4 y[8]; float ss = 0.f;
#pragma unroll
        for (int j = 0; j < 8; ++j) { y[j].x = __uint_as_float(yb[q][j].x << 16); y[j].y = __uint_as_float(yb[q][j].x & 0xffff0000u); y[j].z = __uint_as_float(yb[q][j].y << 16); y[j].w = __uint_as_float(yb[q][j].y & 0xffff0000u);
            ss += (y[j].x * y[j].x + y[j].y * y[j].y) + (y[j].z * y[j].z + y[j].w * y[j].w); }
        const float rs = rsqrtf(wave_sum(ss) * (1.0f / DM) + EPS);
        float ss2 = 0.f;
#pragma unroll
        for (int j = 0; j < 8; ++j) { v[q][j] = v[q][j] + y[j] * rs * gp[j]; ((f32x4*)(xo + ro))[lane + 64 * j] = v[q][j];
            ss2 += (v[q][j].x * v[q][j].x + v[q][j].y * v[q][j].y) + (v[q][j].z * v[q][j].z + v[q][j].w * v[q][j].w); }
        if (gpre) {
            const float rs2 = rsqrtf(wave_sum(ss2) * (1.0f / DM) + EPS);
#pragma unroll
            for (int j = 0; j < 8; ++j) { const f32x4 gg = ((const f32x4*)gpre)[lane + 64 * j];
                u32x2 w; w.x = pk2(v[q][j].x * rs2 * gg.x, v[q][j].y * rs2 * gg.y); w.y = pk2(v[q][j].z * rs2 * gg.z, v[q][j].w * rs2 * gg.w); ((u32x2*)(Hb + ro))[lane + 64 * j] = w; }
        }
    }
}

__device__ __forceinline__ void head_norm_axial(const bf16_t* __restrict__ src, bf16_t* __restrict__ dst, const float* __restrict__ g, const float* __restrict__ COS, const float* __restrict__ SIN, int row, int t, float oscale) {
    float v[8];
#pragma unroll
    for (int s = 0; s < 4; ++s) { const unsigned w = *(const unsigned*)(src + 32 * s + 2 * t); v[2 * s] = bf2f((unsigned short)(w & 0xffff)); v[2 * s + 1] = bf2f((unsigned short)(w >> 16)); }
    float ss = 0.f;
#pragma unroll
    for (int i = 0; i < 8; ++i) ss += v[i] * v[i];
    ss += swz_xor<1>(ss); ss += swz_xor<2>(ss); ss += swz_xor<4>(ss); ss += swz_xor<8>(ss);
    const float rs = rsqrtf(ss * (1.0f / 128.0f) + EPS);
#pragma unroll
    for (int s = 0; s < 4; ++s) { v[2 * s] *= rs * oscale * g[32 * s + 2 * t]; v[2 * s + 1] *= rs * oscale * g[32 * s + 2 * t + 1]; }
    const int pr = row >> 6, pc = row & 63;
    float o[8];
#pragma unroll
    for (int e = 0; e < 2; ++e) { const int i = 2 * t + e;
        { const float c = COS[pr * 32 + i], s = SIN[pr * 32 + i]; const float x1 = v[e], x2 = v[2 + e]; o[e] = x1 * c - x2 * s; o[2 + e] = x2 * c + x1 * s; }
        { const float c = COS[pc * 32 + i], s = SIN[pc * 32 + i]; const float x1 = v[4 + e], x2 = v[6 + e]; o[4 + e] = x1 * c - x2 * s; o[6 + e] = x2 * c + x1 * s; } }
#pragma unroll
    for (int s = 0; s < 4; ++s) *(unsigned*)(dst + 32 * s + 2 * t) = pk2(o[2 * s], o[2 * s + 1]);
}


#define XB_TMO      128
#define XB_XCNT(j)  (256  + 64 * (j))
#define XB_XSUB(j)  (1280 + 64 * (j))
#define XB_XGEN(j)  (2304 + 64 * (j))
#define XB_TOP      3328
#define XB_TOPGEN   3392
#define XCD_BAR_WORDS 3456
#define XB_SPIN_CAP (1u << 18)
__device__ __forceinline__ unsigned xb_ld(unsigned* p)              { return __hip_atomic_load(p, __ATOMIC_RELAXED, __HIP_MEMORY_SCOPE_AGENT); }
__device__ __forceinline__ unsigned xb_add(unsigned* p, unsigned v) { return __hip_atomic_fetch_add(p, v, __ATOMIC_RELAXED, __HIP_MEMORY_SCOPE_AGENT); }
__device__ __forceinline__ unsigned xb_xcc_id() { return (unsigned)__builtin_amdgcn_s_getreg((3 << 11) | 20) & 0xFu; }
#define XB_SPIN(cond, bar) do { unsigned _sp = 0; while (cond) { __builtin_amdgcn_s_sleep(1); \
    if ((++_sp & 255u) == 0u) { if (xb_ld(&(bar)[XB_TMO])) break; if (_sp > XB_SPIN_CAP) { atomicAdd(&(bar)[XB_TMO], 1u); break; } } } } while (0)
__device__ __forceinline__ void xcd_barrier_complete(unsigned* bar, unsigned x, unsigned& nloc, unsigned& nx) {
    const unsigned G = gridDim.x * gridDim.y * gridDim.z;
    unsigned sum, cnt, mine, sp = 0u;
    for (;;) {
        sum = 0u; cnt = 0u; mine = 0u;
#pragma unroll
        for (unsigned j = 0; j < 16; ++j) { const unsigned c = xb_ld(&bar[XB_XCNT(j)]); sum += c; cnt += (c > 0u) ? 1u : 0u; mine = (j == x) ? c : mine; }
        if (sum == G) break;
        __builtin_amdgcn_s_sleep(1);
        if ((++sp & 255u) == 0u) { if (xb_ld(&bar[XB_TMO])) break; if (sp > XB_SPIN_CAP) { atomicAdd(&bar[XB_TMO], 1u); break; } }
    }
    nloc = mine > 0u ? mine : 1u; nx = cnt > 0u ? cnt : 1u;
}
__device__ __forceinline__ void xcd_barrier(unsigned* bar, volatile LAS unsigned* st, bool leader) {
    asm volatile("s_waitcnt vmcnt(0)" ::: "memory");
    __syncthreads();
    if (leader) {
        const unsigned x = xb_xcc_id();
        __builtin_amdgcn_s_waitcnt(0);
        unsigned nloc = st[0], nx = st[1];
        if (nloc == 0u) { xcd_barrier_complete(bar, x, nloc, nx); st[0] = nloc; st[1] = nx; }
        const unsigned old = xb_add(&bar[XB_XSUB(x)], 1u);
        const unsigned gen = old / nloc;
        if (old + 1u == (gen + 1u) * nloc) {
            __builtin_amdgcn_fence(__ATOMIC_RELEASE, "agent");
            asm volatile("s_waitcnt vmcnt(0)" ::: "memory");
            const unsigned og = xb_add(&bar[XB_TOP], 1u);
            const unsigned tg = og / nx;
            if (og + 1u == (tg + 1u) * nx) xb_add(&bar[XB_TOPGEN], 1u);
            else XB_SPIN(xb_ld(&bar[XB_TOPGEN]) == tg, bar);
            __builtin_amdgcn_fence(__ATOMIC_ACQUIRE, "agent");
            xb_add(&bar[XB_XGEN(x)], 1u);
            asm volatile("s_waitcnt vmcnt(0)" ::: "memory");
        } else {
            XB_SPIN(xb_ld(&bar[XB_XGEN(x)]) == gen, bar);
            __builtin_amdgcn_fence(__ATOMIC_ACQUIRE, "agent");
            asm volatile("s_waitcnt vmcnt(0)" ::: "memory");
        }
    }
    __syncthreads();
}

struct Args { const float* in[18]; float* out; unsigned char* wsp; int ph_lo, ph_hi; };

__global__ void __launch_bounds__(512, 2) mega_fwd(Args args) {
    extern __shared__ __attribute__((aligned(16))) unsigned char lds[];
    const int G = gridDim.x, bid = blockIdx.x, NGW = G * 8;
    const int wave0 = __builtin_amdgcn_readfirstlane((int)threadIdx.x >> 6);
    typedef const __attribute__((address_space(4))) Args* KArgP;
    LAS unsigned char* ldsl = (LAS unsigned char*)lds;
#define x_in (kap->in[0])
#define rel_bias (kap->in[1])
#define norm_mix_pre (kap->in[2])
#define norm_mix_post (kap->in[3])
#define norm_ffn_pre (kap->in[4])
#define norm_ffn_post (kap->in[5])
#define w_in (kap->in[6])
#define diff_lambda (kap->in[7])
#define diff_subln (kap->in[8])
#define mla_q_norm (kap->in[9])
#define mla_kv_norm (kap->in[10])
#define mla_w_uq (kap->in[11])
#define mla_w_ukv (kap->in[12])
#define gqa_q_norm (kap->in[13])
#define gqa_k_norm (kap->in[14])
#define w_out (kap->in[15])
#define w_gate_up (kap->in[16])
#define w_down (kap->in[17])
#define xres (kap->out)
#define ws (kap->wsp)
#define PAR ((float*)(ws + WS_PAR))
#define TBLA ((float*)(ws + WS_TBLA))
#define TBLD ((float*)(ws + WS_TBLD))
#define COS ((float*)(ws + WS_COS))
#define SIN ((float*)(ws + WS_SIN))
#define H ((bf16_t*)(ws + WS_H))
#define PROJ ((bf16_t*)(ws + WS_PROJ))
#define CQN ((bf16_t*)(ws + WS_CQN))
#define CKVN ((bf16_t*)(ws + WS_CKVN))
#define KPE ((bf16_t*)(ws + WS_KPE))
#define QC ((bf16_t*)(ws + WS_QC))
#define KC ((bf16_t*)(ws + WS_KC))
#define QB ((bf16_t*)(ws + WS_QB))
#define KVB ((bf16_t*)(ws + WS_KVB))
#define MIX ((bf16_t*)(ws + WS_MIX))
#define Y ((bf16_t*)(ws + WS_Y))
#define HID ((bf16_t*)(ws + WS_HID))
#define TMP ((float*)(ws + WS_TMP))
#define wl (ws + WS_W + (size_t)l * LW)

    volatile LAS unsigned* bst = (volatile LAS unsigned*)(ldsl + LDS_ST_OFF);
    { const bool leader0 = (wave0 == 0) && (lane_id_v() == 0);
      if (leader0) { bst[0] = 0u; bst[1] = 0u; }
      __syncthreads();
      if (leader0 && !MK_MULTI) { KArgP kap0 = (KArgP)__builtin_amdgcn_kernarg_segment_ptr(); (void)xb_add(&((unsigned*)(kap0->wsp + WS_BAR))[XB_XCNT(xb_xcc_id())], 1u); } }
    const int lo = args.ph_lo, hi_ph = args.ph_hi; int ph = 0;
#define PH_BEGIN if (ph >= lo && ph < hi_ph) { KArgP kap = (KArgP)__builtin_amdgcn_kernarg_segment_ptr(); asm volatile("" : "+s"(kap)); \
    int tid_ = wave0 * 64 + lane_id_v(); const int tid = tid_, lane = tid & 63, wave = __builtin_amdgcn_readfirstlane(tid >> 6), gw = bid * 8 + wave; (void)lane; (void)gw;
#define PH_END } if (ph >= lo && ph + 1 < hi_ph) { if (ph == 0) { cg::this_grid().sync(); } else { KArgP kapb = (KArgP)__builtin_amdgcn_kernarg_segment_ptr(); asm volatile("" : "+s"(kapb)); \
      xcd_barrier((unsigned*)(kapb->wsp + WS_BAR), bst, (wave0 == 0) && (lane_id_v() == 0)); } } ++ph;

    PH_BEGIN
    if PHON(0) {
        LAS float* scr = (LAS float*)(ldsl + wave * 16384);
        for (int l = 0; l < DEPTH; ++l) {
            transpose_matrix<2>(w_in + (size_t)l * DM * NPROJ, DM, NPROJ, (bf16_t*)(wl + W_IN), scr, lane, gw, NGW);
            transpose_matrix<3>(mla_w_uq + (size_t)l * 512 * 768, 512, 768, (bf16_t*)(wl + W_UQ), scr, lane, gw, NGW);
            transpose_matrix<0>(mla_w_ukv + (size_t)l * 256 * 1024, 256, 1024, (bf16_t*)(wl + W_UKV), scr, lane, gw, NGW);
            transpose_matrix<0>(w_out + (size_t)l * DM * DM, DM, DM, (bf16_t*)(wl + W_OUT), scr, lane, gw, NGW);
            transpose_matrix<1>(w_gate_up + (size_t)l * DM * NGU, DM, NGU, (bf16_t*)(wl + W_GU), scr, lane, gw, NGW);
            transpose_matrix<0>(w_down + (size_t)l * FF * DM, FF, DM, (bf16_t*)(wl + W_D), scr, lane, gw, NGW);
            { u32x4* z = (u32x4*)((bf16_t*)(wl + W_IN) + (size_t)NPROJ * DM); const int n16 = (LDP - NPROJ) * DM * 2 / 16;
              for (int i = bid * 512 + tid; i < n16; i += G * 512) z[i] = (u32x4){0u, 0u, 0u, 0u}; }
        }
        const int gt = bid * 512 + tid, NT_ = G * 512;
        for (int i = gt; i < 4 * TBLN; i += NT_) { const int h = i / TBLN, d = (i % TBLN) - TOFF; const int b = t5_bucket(d);
            TBLA[i] = rel_bias[b * 8 + h] * 1.4426950408889634f;
            const int n = d < 0 ? -d : d; int mult = (n <= 64 ? 1 : 0) + (((n & 3) == 0 && n <= 256) ? 1 : 0) + (((n & 15) == 0 && n <= 1024) ? 1 : 0);
            TBLD[i] = mult ? (rel_bias[b * 8 + 4 + h] + logf((float)mult)) * 1.4426950408889634f : -1e30f; }
        for (int i = gt; i < S * 32; i += NT_) { const int pos = i >> 5, f = i & 31;
            const float inv = (float)pow(10000.0, -(double)(2 * f) / 64.0); const float ang = (float)pos * inv;
            COS[i] = (float)cos((double)ang); SIN[i] = (float)sin((double)ang); }
        if (bid == 0 && tid < DEPTH) { const float* lv = diff_lambda + tid * 256; float s1 = 0.f, s2 = 0.f;
            for (int i = 0; i < 64; ++i) { s1 += lv[i] * lv[64 + i]; s2 += lv[128 + i] * lv[192 + i]; }
            const float lam_init = 0.8f - 0.6f * expf(-0.3f * (float)tid);
            PAR[tid] = expf(s1) - expf(s2) + lam_init; PAR[4 + tid] = lam_init; }
        for (int row = gw; row < S; row += NGW) norm_row(x_in + (size_t)row * DM, norm_mix_pre, H + (size_t)row * DM, lane);
    }
    PH_END

    for (int l = 0; l < DEPTH; ++l) {
        PH_BEGIN
        if PHON(1) for (int rep_ = 0; rep_ < MK_DUP_GEMM; ++rep_) { pg8::Gemm g{H, (const bf16_t*)(wl + W_IN), S, LDP, DM}; pg8::StaticOrder So; So.init(S, LDP, G, bid);
          pg8::EpiBf16 E{PROJ, LDP};
          pg8::gemm_phase<pg8::EpiBf16, pg8::StaticOrder, true, true>(ldsl, g, So, E, wave0); }
        PH_END
        PH_BEGIN
        if PHON(2) for (int row = gw; row < S; row += NGW) {
            const bf16_t* pr = PROJ + (size_t)row * LDP;
            { const u32x4 raw = *(const u32x4*)(pr + C_BCQ + lane * 8); float v[8];
              v[0] = __uint_as_float(raw.x << 16); v[1] = __uint_as_float(raw.x & 0xffff0000u); v[2] = __uint_as_float(raw.y << 16); v[3] = __uint_as_float(raw.y & 0xffff0000u);
              v[4] = __uint_as_float(raw.z << 16); v[5] = __uint_as_float(raw.z & 0xffff0000u); v[6] = __uint_as_float(raw.w << 16); v[7] = __uint_as_float(raw.w & 0xffff0000u);
              float ss = 0.f;
#pragma unroll
              for (int i = 0; i < 8; ++i) ss += v[i] * v[i];
              const float rs = rsqrtf(wave_sum(ss) * (1.0f / 512.0f) + EPS);
              const f32x4 g0 = *(const f32x4*)(mla_q_norm + l * 512 + lane * 8), g1 = *(const f32x4*)(mla_q_norm + l * 512 + lane * 8 + 4);
              u32x4 w; w.x = pk2(v[0] * rs * g0.x, v[1] * rs * g0.y); w.y = pk2(v[2] * rs * g0.z, v[3] * rs * g0.w); w.z = pk2(v[4] * rs * g1.x, v[5] * rs * g1.y); w.w = pk2(v[6] * rs * g1.z, v[7] * rs * g1.w);
              *(u32x4*)(CQN + (size_t)row * 512 + lane * 8) = w; }
            { const u32x2 raw = *(const u32x2*)(pr + C_BCKV + lane * 4); float v[4];
              v[0] = __uint_as_float(raw.x << 16); v[1] = __uint_as_float(raw.x & 0xffff0000u); v[2] = __uint_as_float(raw.y << 16); v[3] = __uint_as_float(raw.y & 0xffff0000u);
              float ss = v[0] * v[0] + v[1] * v[1] + v[2] * v[2] + v[3] * v[3];
              const float rs = rsqrtf(wave_sum(ss) * (1.0f / 256.0f) + EPS);
              const f32x4 g0 = *(const f32x4*)(mla_kv_norm + l * 256 + lane * 4);
              u32x2 w; w.x = pk2(v[0] * rs * g0.x, v[1] * rs * g0.y); w.y = pk2(v[2] * rs * g0.z, v[3] * rs * g0.w);
              *(u32x2*)(CKVN + (size_t)row * 256 + lane * 4) = w; }
            if (lane < 32) { const float x1 = bf2f(pr[C_BKPE + lane]), x2 = bf2f(pr[C_BKPE + 32 + lane]); const float c = COS[row * 32 + lane], s = SIN[row * 32 + lane];
              KPE[(size_t)row * 64 + lane] = (bf16_t)f2bf(x1 * c - x2 * s); KPE[(size_t)row * 64 + 32 + lane] = (bf16_t)f2bf(x2 * c + x1 * s); }
            { const int hd = lane >> 4, t = lane & 15;
              head_norm_axial(pr + C_CQ + hd * 128, QC + (size_t)row * 512 + hd * 128, gqa_q_norm + l * 128, COS, SIN, row, t, QS_CD);
              const int hk = hd & 1;
              if (lane < 32) head_norm_axial(pr + C_CK + hk * 128, KC + (size_t)row * 256 + hk * 128, gqa_k_norm + l * 128, COS, SIN, row, t, 1.0f); }
        }
        PH_END
        PH_BEGIN
        if PHON(3) { pg8::Gemm g{CQN, (const bf16_t*)(wl + W_UQ), S, 768, 512}; pg8::StaticOrder So; So.init(S, 768, G, bid);
          pg8::EpiBf16 E{QB, 768};
          pg8::gemm_phase<pg8::EpiBf16, pg8::StaticOrder, true, true>(ldsl, g, So, E, wave0); }
        if PHON(4) { pg8::Gemm g{CKVN, (const bf16_t*)(wl + W_UKV), S, 1024, 256}; pg8::StaticOrder So; So.init(S, 1024, G, bid);
          pg8::EpiBf16 E{KVB, 1024};
          pg8::gemm_phase<pg8::EpiBf16, pg8::StaticOrder, true, true>(ldsl, g, So, E, wave0); }
        PH_END
        PH_BEGIN
        for (int rep_ = 0; rep_ < MK_DUP_ATT; ++rep_) {
            const float lam = __int_as_float(__builtin_amdgcn_readfirstlane(__float_as_int(PAR[l]))), lam_init = __int_as_float(__builtin_amdgcn_readfirstlane(__float_as_int(PAR[4 + l])));
            const float L2E = 1.4426950408889634f;
            if PHON(6) for (int u = bid; u < 256; u += G) { const int xq = u & 7, hd = xq & 3, qb = (u >> 3) + 32 * (xq >> 2), q0 = qb * 256;
                { const float cb_lo = rel_bias[15 * 8 + hd] * L2E, cb_hi = rel_bias[31 * 8 + hd] * L2E;
                  att::attn_unit_A2(PROJ + (size_t)q0 * LDP + C_AQ + hd * 128, LDP, PROJ + C_AK + hd * 128, LDP, PROJ + C_AV + hd * 128, LDP, S, q0,
                                    TBLA + hd * TBLN, cb_lo, cb_hi, MIX + (size_t)q0 * DM + hd * 128, DM, lam, diff_subln + l * 128, 1.0f - lam_init, (char*)lds, wave0); }
            }
            if PHON(7) for (int u = bid; u < 256; u += G) { const int xq = u & 7, hd = xq & 3, qb = (u >> 3) + 32 * (xq >> 2), q0 = qb * 256;
                { const float sc = 0.07216878364870322f;
                  att::attn_unit<12, 0, 0, 1, 8, 1>(QB + (size_t)q0 * 768 + hd * 192, 768, KVB + hd * 256, 1024, KPE, 64, KVB + hd * 256 + 128, 1024,
                                            0, S, q0, nullptr, 0.f, 0.f, MIX + (size_t)q0 * DM + 512 + hd * 128, DM, nullptr, 0.f, nullptr, 0.f, (char*)lds, wave0, COS, SIN); }
            }
            if PHON(8) for (int u = bid; u < 256; u += G) { const int xq = u & 7, hd = xq & 3, qb = (u >> 3) + 32 * (xq >> 2), q0 = qb * 256;
                { const float sc = 0.08838834764831845f;
                  if (wave0 < 4) att::attn_unit<8, 0, 0, 1, 0, 0, 0>(QC + (size_t)q0 * 512 + hd * 128, 512, KC + (hd >> 1) * 128, 256, nullptr, 0, PROJ + C_CV + (hd >> 1) * 128, LDP,
                                           0, S, q0, nullptr, 0.f, 0.f, MIX + (size_t)q0 * DM + 1024 + hd * 128, DM, nullptr, 0.f, nullptr, 0.f, (char*)lds, wave0); else att::attn_unit<8, 0, 0, 1, 0, 0, 1>(QC + (size_t)q0 * 512 + hd * 128, 512, KC + (hd >> 1) * 128, 256, nullptr, 0, PROJ + C_CV + (hd >> 1) * 128, LDP,
                                           0, S, q0, nullptr, 0.f, 0.f, MIX + (size_t)q0 * DM + 1024 + hd * 128, DM, nullptr, 0.f, nullptr, 0.f, (char*)lds, wave0); }
            }
            if PHON(9) for (int u = bid; u < 256; u += G) { const int xq = u & 7, hd = xq & 3, qb = (u >> 3) + 32 * (xq >> 2), q0 = qb * 256;
                { const float sc = 0.08838834764831845f;
                  const int kb = q0 - 1024 < 0 ? 0 : q0 - 1024, ke = q0 + 256 + 1024 > S ? S : q0 + 256 + 1024;
                  att::attn_unit<8, 1, 0, 1>(PROJ + (size_t)q0 * LDP + C_DQ + hd * 128, LDP, PROJ + C_DK + hd * 128, LDP, nullptr, 0, PROJ + C_DV + hd * 128, LDP,
                                           kb, ke - kb, q0, TBLD + hd * TBLN, 0.f, 0.f, MIX + (size_t)q0 * DM + 1536 + hd * 128, DM, nullptr, 0.f, nullptr, 0.f, (char*)lds, wave0); }
            }
            __syncthreads();
        }
        PH_END
        PH_BEGIN
        if PHON(10) for (int rep_ = 0; rep_ < MK_DUP_GEMM; ++rep_) { pg8::Gemm g{MIX, (const bf16_t*)(wl + W_OUT), S, DM, DM}; pg8::StaticOrder So; So.init(S, DM, G, bid);
          pg8::EpiBf16 E{Y, DM};
          pg8::gemm_phase<pg8::EpiBf16, pg8::StaticOrder, true, true>(ldsl, g, So, E, wave0); }
        PH_END
        PH_BEGIN
        if PHON(11) { int row = gw;
            for (; row + NGW < S; row += 2 * NGW) norm_add_rows<2>(Y, (l == 0 ? x_in : xres), xres, norm_mix_post + l * DM, norm_ffn_pre + l * DM, H, row, NGW, lane);
            for (; row < S; row += NGW) norm_add_rows<1>(Y, (l == 0 ? x_in : xres), xres, norm_mix_post + l * DM, norm_ffn_pre + l * DM, H, row, NGW, lane); }
        PH_END
        PH_BEGIN
        if PHON(12) for (int rep_ = 0; rep_ < MK_DUP_GEMM; ++rep_) { pg8::Gemm g{H, (const bf16_t*)(wl + W_GU), S, NGU, DM}; pg8::StaticOrder So; So.init(S, NGU, G, bid);
          pg8::EpiSwiGLU E{HID, FF};
          pg8::gemm_phase<pg8::EpiSwiGLU, pg8::StaticOrder, true, true>(ldsl, g, So, E, wave0); }
        PH_END
        PH_BEGIN
        if PHON(13) for (int rep_ = 0; rep_ < MK_DUP_GEMM; ++rep_) { pg8::Gemm g{HID, (const bf16_t*)(wl + W_D), S, DM, FF}; pg8::StaticOrder So; So.init(S, DM, G, bid);
          pg8::EpiBf16 E{Y, DM};
          pg8::gemm_phase<pg8::EpiBf16, pg8::StaticOrder, true, true>(ldsl, g, So, E, wave0); }
        PH_END
        PH_BEGIN
        if PHON(14) { int row = gw; const float* gnext = (l + 1 < DEPTH) ? norm_mix_pre + (l + 1) * DM : nullptr;
            for (; row + NGW < S; row += 2 * NGW) norm_add_rows<2>(Y, xres, xres, norm_ffn_post + l * DM, gnext, H, row, NGW, lane);
            for (; row < S; row += NGW) norm_add_rows<1>(Y, xres, xres, norm_ffn_post + l * DM, gnext, H, row, NGW, lane); }
        PH_END
    }
#undef PH_BEGIN
#undef PH_END
}
#undef x_in
#undef rel_bias
#undef norm_mix_pre
#undef norm_mix_post
#undef norm_ffn_pre
#undef norm_ffn_post
#undef w_in
#undef diff_lambda
#undef diff_subln
#undef mla_q_norm
#undef mla_kv_norm
#undef mla_w_uq
#undef mla_w_ukv
#undef gqa_q_norm
#undef gqa_k_norm
#undef w_out
#undef w_gate_up
#undef w_down
#undef xres
#undef ws
#undef PAR
#undef TBLA
#undef TBLD
#undef COS
#undef SIN
#undef H
#undef PROJ
#undef CQN
#undef CKVN
#undef KPE
#undef QC
#undef KC
#undef QB
#undef KVB
#undef MIX
#undef Y
#undef HID
#undef TMP
#undef wl

constexpr int N_PHASES = 1 + DEPTH * 9;

extern "C" void kernel_launch(void* const* d_in, const int* in_sizes, int n_in, void* d_out, int out_size, void* d_ws, size_t ws_size, hipStream_t stream) {
    static int grid = 0;
    if (grid == 0) {
        if (n_in != 18 || in_sizes[0] != S * DM || out_size != S * DM || ws_size < WS_END) {
            fprintf(stderr, "kernel_launch: unexpected shapes (n_in %d, in0 %d, out %d, ws %zu < %zu)\n", n_in, n_in > 0 ? in_sizes[0] : -1, out_size, ws_size, (size_t)WS_END); grid = -1; return; }
        int dev = 0, cus = 0, per_cu = 0;
        if (hipGetDevice(&dev) != hipSuccess || hipDeviceGetAttribute(&cus, hipDeviceAttributeMultiprocessorCount, dev) != hipSuccess) { grid = -1; return; }
        if (hipFuncSetAttribute((const void*)mega_fwd, hipFuncAttributeMaxDynamicSharedMemorySize, LDS_BYTES) != hipSuccess) { fprintf(stderr, "kernel_launch: hipFuncSetAttribute failed\n"); grid = -1; return; }
        if (hipOccupancyMaxActiveBlocksPerMultiprocessor(&per_cu, (const void*)mega_fwd, 512, LDS_BYTES) != hipSuccess || per_cu < 1) { fprintf(stderr, "kernel_launch: occupancy query says %d\n", per_cu); per_cu = 1; }
        (void)hipGetLastError();
        grid = cus;
    }
    if (grid < 0) return;
    if (hipMemsetAsync((char*)d_ws + WS_BAR, 0, WS_BAR_BYTES, stream) != hipSuccess) { fprintf(stderr, "kernel_launch: hipMemsetAsync of the barrier words failed\n"); return; }
    Args a{};
    for (int i = 0; i < 18; ++i) a.in[i] = (const float*)d_in[i];
    a.out = (float*)d_out; a.wsp = (unsigned char*)d_ws;
#if MK_MULTI
    for (int p = 0; p < N_PHASES; ++p) { a.ph_lo = p; a.ph_hi = p + 1; hipLaunchKernelGGL(mega_fwd, dim3(grid), dim3(512), LDS_BYTES, stream, a); }
#else
    a.ph_lo = 0; a.ph_hi = N_PHASES;
    void* kargs[] = {&a};
    hipError_t e = hipLaunchCooperativeKernel((const void*)mega_fwd, dim3(grid), dim3(512), kargs, LDS_BYTES, stream);
    if (e != hipSuccess) fprintf(stderr, "kernel_launch: cooperative launch failed: %s (grid %d)\n", hipGetErrorString(e), grid);
#endif
}
```

```cpp
#include <hip/hip_runtime.h>
#include <hip/hip_cooperative_groups.h>
#include <cstdio>
#include <cstdint>
namespace cg = cooperative_groups;

#ifndef MK_MULTI
#define MK_MULTI 0
#endif
#ifndef MK_PHMASK
#define MK_PHMASK 0xFFFFF
#endif
#define PHON(k) constexpr (((MK_PHMASK) >> (k)) & 1)
#ifndef MK_DUP_GEMM
#define MK_DUP_GEMM 1
#endif
#ifndef MK_DUP_ATT
#define MK_DUP_ATT 1
#endif

typedef unsigned short bf16_t;
typedef short bf16x8 __attribute__((ext_vector_type(8)));
typedef short s16x4 __attribute__((ext_vector_type(4)));
typedef float f32x2 __attribute__((ext_vector_type(2)));
typedef float f32x4 __attribute__((ext_vector_type(4)));
typedef float f32x16 __attribute__((ext_vector_type(16)));
typedef unsigned u32x2 __attribute__((ext_vector_type(2)));
typedef unsigned u32x4 __attribute__((ext_vector_type(4)));
#define LAS __attribute__((address_space(3)))

constexpr int S = 16384, DM = 2048, DEPTH = 4, NPROJ = 4928, LDP = 5120, FF = 5632, NGU = 2 * FF;
constexpr float EPS = 1e-6f;
constexpr int C_AQ = 0, C_AK = 512, C_AV = 1024, C_BCQ = 1536, C_BCKV = 2048, C_BKPE = 2304, C_CQ = 2368, C_CK = 2880, C_CV = 3136, C_DQ = 3392, C_DK = 3904, C_DV = 4416;
constexpr int TOFF = 1408, TBLN = 2824;

constexpr size_t MiB = 1u << 20;
constexpr size_t WS_PAR = 0, WS_TBLA = 1 * MiB, WS_TBLD = 1 * MiB + 65536, WS_COS = 2 * MiB, WS_SIN = 4 * MiB;
constexpr size_t WS_BAR = 6 * MiB, WS_BAR_BYTES = 16384;
constexpr size_t WS_W = 8 * MiB, LW = 96 * MiB;
constexpr size_t W_IN = 0, W_UQ = 20 * MiB, W_UKV = 21 * MiB, W_OUT = 22 * MiB, W_GU = 30 * MiB, W_D = 74 * MiB;
constexpr size_t WS_H = 392 * MiB, WS_PROJ = 456 * MiB, WS_CQN = 616 * MiB, WS_CKVN = 632 * MiB, WS_KPE = 640 * MiB, WS_QC = 642 * MiB, WS_KC = 658 * MiB;
constexpr size_t WS_QB = 666 * MiB, WS_KVB = 690 * MiB, WS_MIX = 722 * MiB, WS_Y = 786 * MiB, WS_HID = 914 * MiB, WS_TMP = 1090 * MiB, WS_END = 1122 * MiB;

constexpr int LDS_ST_OFF = 163840 - 16;
constexpr int LDS_BYTES = 163840;

__device__ __forceinline__ float bf2f(unsigned short b) { return __uint_as_float(((unsigned)b) << 16); }
__device__ __forceinline__ unsigned f2bf(float f) { unsigned u = __float_as_uint(f); return (u + 0x7fffu + ((u >> 16) & 1u)) >> 16; }
__device__ __forceinline__ unsigned pk2(float lo, float hi) { return f2bf(lo) | (f2bf(hi) << 16); }
__device__ __forceinline__ unsigned cvt_pk_bf16(float lo, float hi) { unsigned r; asm volatile("v_cvt_pk_bf16_f32 %0, %1, %2" : "=v"(r) : "v"(lo), "v"(hi)); return r; }
__device__ __forceinline__ int lane_id_v() { int l; asm volatile("v_mbcnt_lo_u32_b32 %0, -1, 0\n\tv_mbcnt_hi_u32_b32 %0, -1, %0" : "=v"(l)); return l; }
template <int M> __device__ __forceinline__ float swz_xor(float v) { return __int_as_float(__builtin_amdgcn_ds_swizzle(__float_as_int(v), (M << 10) | 0x1f)); }
__device__ __forceinline__ float wave_sum(float v) {
    v += swz_xor<1>(v); v += swz_xor<2>(v); v += swz_xor<4>(v); v += swz_xor<8>(v); v += swz_xor<16>(v);
    auto rr = __builtin_amdgcn_permlane32_swap(__float_as_uint(v), __float_as_uint(v), false, false);
    return __uint_as_float(rr[0]) + __uint_as_float(rr[1]);
}

namespace pg8 {
constexpr int BM = 256, BK = 64, HALF = 128, HTB = HALF * BK * 2, STAGE_BYTES = 8 * HTB, NXCD = 8, WGM = 8;
__host__ __device__ __forceinline__ int lds_byte(int r, int c) { const int st = (r >> 4) * 2 + (c >> 5), rr = r & 15, cc = c & 31, ob = rr * 64 + cc * 2; return st * 1024 + (ob ^ (((ob >> 9) & 1) << 5)); }
__host__ __device__ __forceinline__ void stage_rc(int b, int& R, int& C) { const int st = b / 1024, sb = b % 1024, swz = sb ^ (((sb >> 9) & 1) << 5); R = (st >> 1) * 16 + swz / 64; C = (st & 1) * 32 + (swz % 64) / 2; }
__host__ __device__ __forceinline__ int perm32(int rho) { const int n = rho >> 4, i = rho & 15; return 8 * (i >> 2) + 4 * n + (i & 3); }

struct Unit { int pm, pn; };
struct Gemm { const bf16_t* A; const bf16_t* Bt; int M, N, K; };

struct StaticOrder {
    int nM, nN, nwg, G, c;
    __host__ __device__ void init(int M, int N, int G_, int c_) { nM = M / BM; nN = N / BM; nwg = nM * nN; G = G_; c = c_; }
    __host__ __device__ bool next(int i, Unit& u) const {
        const long L = (long)i * G + c; if (L >= nwg) return false;
        int wgid = (int)L; { const int q = nwg / NXCD, r = nwg % NXCD, xcd = wgid % NXCD, off = wgid / NXCD; wgid = (xcd < r ? xcd * (q + 1) : r * (q + 1) + (xcd - r) * q) + off; }
        const int nig = WGM * nN, gid = wgid / nig, fm = gid * WGM, gsz = (nM - fm) < WGM ? (nM - fm) : WGM;
        u.pm = fm + ((wgid % nig) % gsz); u.pn = (wgid % nig) / gsz; return true;
    }
    __device__ __forceinline__ void a_ready(const Unit&) const {}
    __device__ __forceinline__ void done(const Unit&) const {}
};

struct EpiBf16 {
    static constexpr bool PERM = true, AFTER_DRAIN = false;
    bf16_t* O; int ldc;
    __device__ __forceinline__ void operator()(const f32x4 (&acc)[2][2][4][2], const Unit& u, int wr, int wc, int fr, int fq) const {
        const int row0 = u.pm * BM + wr * 64 + fr; const int col0 = u.pn * BM + wc * 32 + 8 * fq;
#pragma unroll
        for (int ai = 0; ai < 2; ++ai)
#pragma unroll
            for (int m = 0; m < 4; ++m) { bf16_t* rowp = O + (size_t)(row0 + ai * HALF + m * 16) * ldc + col0;
#pragma unroll
                for (int bj = 0; bj < 2; ++bj) { const f32x4 v0 = acc[ai][bj][m][0], v1 = acc[ai][bj][m][1];
                    u32x4 w; w.x = cvt_pk_bf16(v0[0], v0[1]); w.y = cvt_pk_bf16(v0[2], v0[3]); w.z = cvt_pk_bf16(v1[0], v1[1]); w.w = cvt_pk_bf16(v1[2], v1[3]);
                    *(u32x4*)(rowp + bj * HALF) = w; } }
    }
};
struct EpiF32 {
    static constexpr bool PERM = false, AFTER_DRAIN = false;
    float* O; int ldc;
    __device__ __forceinline__ void operator()(const f32x4 (&acc)[2][2][4][2], const Unit& u, int wr, int wc, int fr, int fq) const {
        const int row0 = u.pm * BM + wr * 64 + fr; const int col0 = u.pn * BM + wc * 32 + 4 * fq;
#pragma unroll
        for (int ai = 0; ai < 2; ++ai)
#pragma unroll
            for (int m = 0; m < 4; ++m) { float* rowp = O + (size_t)(row0 + ai * HALF + m * 16) * ldc + col0;
#pragma unroll
                for (int bj = 0; bj < 2; ++bj)
#pragma unroll
                    for (int n = 0; n < 2; ++n) *(f32x4*)(rowp + bj * HALF + n * 16) = acc[ai][bj][m][n]; }
    }
};
__device__ __forceinline__ float silu_mul(float g, float u) {
    const float e = __builtin_amdgcn_exp2f(-g * 1.4426950408889634f);
    return g * __builtin_amdgcn_rcpf(1.0f + e) * u;
}
struct EpiSwiGLU {
    static constexpr bool PERM = true, AFTER_DRAIN = false;
    bf16_t* O; int ldc;
    __device__ __forceinline__ void operator()(const f32x4 (&acc)[2][2][4][2], const Unit& u, int wr, int wc, int fr, int fq) const {
        const int row0 = u.pm * BM + wr * 64 + fr; const int col0 = u.pn * HALF + wc * 32 + 8 * fq;
#pragma unroll
        for (int ai = 0; ai < 2; ++ai)
#pragma unroll
            for (int m = 0; m < 4; ++m) { bf16_t* rowp = O + (size_t)(row0 + ai * HALF + m * 16) * ldc + col0;
                const f32x4 g0 = acc[ai][0][m][0], g1 = acc[ai][0][m][1], u0 = acc[ai][1][m][0], u1 = acc[ai][1][m][1];
                u32x4 w; w.x = cvt_pk_bf16(silu_mul(g0[0], u0[0]), silu_mul(g0[1], u0[1])); w.y = cvt_pk_bf16(silu_mul(g0[2], u0[2]), silu_mul(g0[3], u0[3]));
                w.z = cvt_pk_bf16(silu_mul(g1[0], u1[0]), silu_mul(g1[1], u1[1])); w.w = cvt_pk_bf16(silu_mul(g1[2], u1[2]), silu_mul(g1[3], u1[3]));
                *(u32x4*)rowp = w; }
    }
};

template <class Epi, class Sched, bool ALIGN_EPI = false, bool SP2 = false>
__device__ __forceinline__ void gemm_phase(LAS unsigned char* lds, const Gemm g, const Sched& S, const Epi& E, const int wave0) {
    int tid_ = wave0 * 64 + lane_id_v();
    const int tid = tid_, wid = __builtin_amdgcn_readfirstlane(tid >> 6), lane = tid & 63, wr = wid >> 2, wc = wid & 3, fr = lane & 15, fq = lane >> 4;
    int K_ = g.K; asm volatile("" : "+s"(K_));
    const int K = K_, nt = K / BK;
    unsigned voffA[2], voffB[2];
#pragma unroll
    for (int i = 0; i < 2; ++i) { int R, C; stage_rc(tid * 16 + i * 8192, R, C); const int Rb = Epi::PERM ? ((R & ~31) + perm32(R & 31)) : R;
        voffA[i] = (unsigned)(R * K + C) * 2u; voffB[i] = (unsigned)(Rb * K + C) * 2u; }
    const size_t kstep = (size_t)(BK * 2);
    const size_t hstep = (size_t)HALF * K * 2;
    const size_t tstep = 2 * hstep;
    const unsigned ldsw = (unsigned)wid * 1024u;
    const int aoff = lds_byte(wr * 64 + fr, fq * 8), boff = lds_byte(wc * 32 + fr, fq * 8);
#define PG8_SA(b, h) (((b) * 2 + (h)) * HTB)
#define PG8_SB(b, h) ((4 + (b) * 2 + (h)) * HTB)
#define PG8_STAGE(bufoff, gbase, voff) do { _Pragma("unroll") for (int _i = 0; _i < 2; ++_i) \
        __builtin_amdgcn_global_load_lds((const unsigned*)((const char*)(gbase) + (voff)[_i]), (LAS unsigned*)(lds + (bufoff) + ldsw + _i * 8192), 16, 0, 0); } while (0)
#define PG8_LDA(dst, b, h) do { _Pragma("unroll") for (int m = 0; m < 4; ++m) _Pragma("unroll") for (int k = 0; k < 2; ++k) dst[m][k] = *(const LAS bf16x8*)(lds + PG8_SA(b, h) + aoff + m * 2048 + k * 1024); } while (0)
#define PG8_LDB(dst, b, h) do { _Pragma("unroll") for (int n = 0; n < 2; ++n) _Pragma("unroll") for (int k = 0; k < 2; ++k) dst[n][k] = *(const LAS bf16x8*)(lds + PG8_SB(b, h) + boff + n * 2048 + k * 1024); } while (0)
#define PG8_MMA(ai, bj, At, Bt) do { __builtin_amdgcn_s_setprio(1); _Pragma("unroll") for (int m = 0; m < 4; ++m) _Pragma("unroll") for (int n = 0; n < 2; ++n) _Pragma("unroll") for (int k = 0; k < 2; ++k) \
        acc[ai][bj][m][n] = __builtin_amdgcn_mfma_f32_16x16x32_bf16(Bt[n][k], At[m][k], acc[ai][bj][m][n], 0, 0, 0); __builtin_amdgcn_s_setprio(0); } while (0)
#define PG8_WAIT_V(n) asm volatile("s_waitcnt vmcnt(" #n ")" ::: "memory")
#define PG8_WAIT_L(n) asm volatile("s_waitcnt lgkmcnt(" #n ")" ::: "memory")
#define PG8_BAR __builtin_amdgcn_s_barrier()
#define PG8_SCHED __builtin_amdgcn_sched_barrier(0)
    Unit cur, nxt; int ui = 0;
    if (!S.next(0, cur)) return;
    f32x4 acc[2][2][4][2];
#pragma unroll
    for (int a = 0; a < 2; ++a)
#pragma unroll
        for (int b = 0; b < 2; ++b)
#pragma unroll
            for (int m = 0; m < 4; ++m)
#pragma unroll
                for (int n = 0; n < 2; ++n) acc[a][b][m][n] = (f32x4){0.f, 0.f, 0.f, 0.f};
    bf16x8 At[4][2], B0[2][2], B1[2][2];
    const char* cA = (const char*)g.A + (size_t)cur.pm * tstep; const char* cB = (const char*)g.Bt + (size_t)cur.pn * tstep;
    S.a_ready(cur);
    if constexpr (SP2) {
        PG8_STAGE(PG8_SB(0, 0), cB, voffB); PG8_STAGE(PG8_SB(0, 1), cB + hstep, voffB); PG8_STAGE(PG8_SA(0, 0), cA, voffA); PG8_STAGE(PG8_SA(0, 1), cA + hstep, voffA);
        if (wr == 1) PG8_BAR;
        PG8_WAIT_V(2); PG8_BAR;
        PG8_STAGE(PG8_SB(1, 0), cB + kstep, voffB); PG8_STAGE(PG8_SA(1, 0), cA + kstep, voffA); PG8_STAGE(PG8_SB(1, 1), cB + hstep + kstep, voffB);
        PG8_WAIT_V(6); PG8_BAR;
    } else {
        PG8_STAGE(PG8_SB(0, 0), cB, voffB); PG8_STAGE(PG8_SA(0, 0), cA, voffA); PG8_STAGE(PG8_SB(0, 1), cB + hstep, voffB); PG8_STAGE(PG8_SA(0, 1), cA + hstep, voffA);
        if (wr == 1) PG8_BAR;
        PG8_WAIT_V(4); PG8_BAR;
        PG8_STAGE(PG8_SB(1, 0), cB + kstep, voffB); PG8_STAGE(PG8_SA(1, 0), cA + kstep, voffA); PG8_STAGE(PG8_SB(1, 1), cB + hstep + kstep, voffB);
        PG8_WAIT_V(6); PG8_BAR;
    }
    for (;;) {
        const bool has_next = S.next(ui + 1, nxt);
        const char* nA = has_next ? (const char*)g.A + (size_t)nxt.pm * tstep : cA; const char* nB = has_next ? (const char*)g.Bt + (size_t)nxt.pn * tstep : cB;
        for (int t = 0; t < nt; t += 2) {
            const bool last = (t == nt - 2);
            const char* a1 = cA + (size_t)(t + 1) * kstep;
            const char* a2 = last ? nA : cA + (size_t)(t + 2) * kstep; const char* b2 = last ? nB : cB + (size_t)(t + 2) * kstep;
            const char* a3 = a2 + kstep; const char* b3 = b2 + kstep;
            if (last && has_next) S.a_ready(nxt);
            if constexpr (SP2) {
            PG8_LDB(B0, 0, 0); PG8_LDB(B1, 0, 1); PG8_SCHED; PG8_LDA(At, 0, 0); PG8_STAGE(PG8_SA(1, 1), a1 + hstep, voffA);
            PG8_WAIT_V(8); PG8_WAIT_L(0); PG8_BAR; PG8_MMA(0, 0, At, B0); PG8_MMA(0, 1, At, B1); PG8_BAR; PG8_SCHED;
            PG8_LDA(At, 0, 1); PG8_STAGE(PG8_SB(0, 0), b2, voffB); PG8_STAGE(PG8_SB(0, 1), b2 + hstep, voffB); PG8_STAGE(PG8_SA(0, 0), a2, voffA);
            PG8_WAIT_V(8); PG8_WAIT_L(0); PG8_BAR; PG8_MMA(1, 0, At, B0); PG8_MMA(1, 1, At, B1); PG8_BAR; PG8_SCHED;
            PG8_LDB(B0, 1, 0); PG8_LDB(B1, 1, 1); PG8_SCHED; PG8_LDA(At, 1, 0); PG8_STAGE(PG8_SA(0, 1), a2 + hstep, voffA);
            PG8_WAIT_V(8); PG8_WAIT_L(0); PG8_BAR; PG8_MMA(0, 0, At, B0); PG8_MMA(0, 1, At, B1); PG8_BAR; PG8_SCHED;
            PG8_LDA(At, 1, 1); PG8_STAGE(PG8_SB(1, 0), b3, voffB); PG8_STAGE(PG8_SB(1, 1), b3 + hstep, voffB); PG8_STAGE(PG8_SA(1, 0), a3, voffA);
            PG8_WAIT_V(8); PG8_WAIT_L(0); PG8_BAR; PG8_MMA(1, 0, At, B0); PG8_MMA(1, 1, At, B1); PG8_BAR; PG8_SCHED;
            } else {
            PG8_LDB(B0, 0, 0); PG8_SCHED; PG8_LDA(At, 0, 0); PG8_STAGE(PG8_SA(1, 1), a1 + hstep, voffA);
            PG8_WAIT_L(8); PG8_BAR; PG8_WAIT_L(0); PG8_MMA(0, 0, At, B0); PG8_BAR; PG8_SCHED;
            PG8_LDB(B1, 0, 1); PG8_STAGE(PG8_SB(0, 0), b2, voffB);
            PG8_BAR; PG8_WAIT_L(0); PG8_MMA(0, 1, At, B1); PG8_BAR;
            PG8_LDA(At, 0, 1); PG8_STAGE(PG8_SA(0, 0), a2, voffA);
            PG8_BAR; PG8_WAIT_L(0); PG8_MMA(1, 0, At, B0); PG8_BAR; PG8_SCHED;
            PG8_STAGE(PG8_SB(0, 1), b2 + hstep, voffB);
            PG8_WAIT_V(6); PG8_BAR; PG8_MMA(1, 1, At, B1); PG8_BAR;
            PG8_LDB(B0, 1, 0); PG8_SCHED; PG8_LDA(At, 1, 0); PG8_STAGE(PG8_SA(0, 1), a2 + hstep, voffA);
            PG8_WAIT_L(8); PG8_BAR; PG8_WAIT_L(0); PG8_MMA(0, 0, At, B0); PG8_BAR; PG8_SCHED;
            PG8_LDB(B1, 1, 1); PG8_STAGE(PG8_SB(1, 0), b3, voffB);
            PG8_BAR; PG8_WAIT_L(0); PG8_MMA(0, 1, At, B1); PG8_BAR;
            PG8_LDA(At, 1, 1); PG8_STAGE(PG8_SA(1, 0), a3, voffA);
            PG8_BAR; PG8_WAIT_L(0); PG8_MMA(1, 0, At, B0); PG8_BAR; PG8_SCHED;
            PG8_STAGE(PG8_SB(1, 1), b3 + hstep, voffB);
            PG8_WAIT_V(6); PG8_BAR; PG8_MMA(1, 1, At, B1); PG8_BAR;
            }
        }
        if constexpr (ALIGN_EPI) { if (wr == 0) PG8_BAR; }
        if constexpr (!Epi::AFTER_DRAIN) { E(acc, cur, wr, wc, fr, fq); S.done(cur); }
        if (!has_next) break;
#pragma unroll
        for (int a = 0; a < 2; ++a)
#pragma unroll
            for (int b = 0; b < 2; ++b)
#pragma unroll
                for (int m = 0; m < 4; ++m)
#pragma unroll
                    for (int n = 0; n < 2; ++n) acc[a][b][m][n] = (f32x4){0.f, 0.f, 0.f, 0.f};
        cur = nxt; cA = nA; cB = nB; ++ui;
        if constexpr (ALIGN_EPI) { if (wr == 1) PG8_BAR; }
    }
    PG8_WAIT_V(0);
    if constexpr (!ALIGN_EPI) { if (wr == 0) PG8_BAR; }
    PG8_BAR;
#undef PG8_SA
#undef PG8_SB
#undef PG8_STAGE
#undef PG8_LDA
#undef PG8_LDB
#undef PG8_MMA
#undef PG8_WAIT_V
#undef PG8_WAIT_L
#undef PG8_BAR
#undef PG8_SCHED
}
}

namespace att {
constexpr int NW = 8, QBLK = 32, KVBLK = 64;
constexpr int SHM_V = KVBLK * 128 * 2;
#define SBAR() __builtin_amdgcn_sched_barrier(0)
__device__ __forceinline__ int crow(int r, int hi) { return (r & 3) + 8 * (r >> 2) + 4 * hi; }
__device__ __forceinline__ unsigned cvtpk(float lo, float hi) { unsigned r; asm volatile("v_cvt_pk_bf16_f32 %0, %1, %2" : "=v"(r) : "v"(lo), "v"(hi)); return r; }

constexpr float THR2 = 8.0f * 1.4426950408889634f;
template <bool FIRST>
__device__ __forceinline__ void partialSM(f32x16& p0, f32x16& p1, float& mC, float& alpha) {
  float mx_[4] = {p0[0], p0[1], p0[2], p0[3]};
#pragma unroll
  for (int r = 4; r < 16; ++r) mx_[r & 3] = fmaxf(mx_[r & 3], p0[r]);
#pragma unroll
  for (int r = 0; r < 16; ++r) mx_[r & 3] = fmaxf(mx_[r & 3], p1[r]);
  float pmax = fmaxf(fmaxf(mx_[0], mx_[1]), fmaxf(mx_[2], mx_[3]));
  { auto rr = __builtin_amdgcn_permlane32_swap(__float_as_uint(pmax), __float_as_uint(pmax), false, false);
    pmax = fmaxf(__uint_as_float(rr[0]), __uint_as_float(rr[1])); }
  if (!FIRST && __builtin_expect(__all(pmax <= THR2), 1)) { alpha = 1.f; }
  else { const float delta = FIRST ? fmaxf(pmax, -200.f) : fmaxf(pmax, 0.f); alpha = FIRST ? 1.f : __builtin_amdgcn_exp2f(-delta); mC += delta;
#pragma unroll
    for (int r = 0; r < 16; ++r) p0[r] -= delta;
#pragma unroll
    for (int r = 0; r < 16; ++r) p1[r] -= delta; }
#pragma unroll
  for (int r = 0; r < 16; ++r) p0[r] = __builtin_amdgcn_exp2f(p0[r]);
}
template <bool EXP1 = true>
__device__ __forceinline__ void finishSM(f32x16& p0, f32x16& p1, float alpha, float& l_reg, bf16x8& pa0, bf16x8& pa1, bf16x8& pa2, bf16x8& pa3) {
  if constexpr (EXP1) {
#pragma unroll
  for (int r = 0; r < 16; ++r) p1[r] = __builtin_amdgcn_exp2f(p1[r]);
  }
  float sm_[4] = {p0[0], p0[1], p0[2], p0[3]};
#pragma unroll
  for (int r = 4; r < 16; ++r) sm_[r & 3] += p0[r];
#pragma unroll
  for (int r = 0; r < 16; ++r) sm_[r & 3] += p1[r];
  float ps = (sm_[0] + sm_[1]) + (sm_[2] + sm_[3]);
  { auto rr = __builtin_amdgcn_permlane32_swap(__float_as_uint(ps), __float_as_uint(ps), false, false);
    ps = __uint_as_float(rr[0]) + __uint_as_float(rr[1]); }
  l_reg = l_reg * alpha + ps;
#define PK4(P, BASE, OUT) do { unsigned a0 = cvtpk(P[BASE + 0], P[BASE + 1]), a1 = cvtpk(P[BASE + 2], P[BASE + 3]);   \
    unsigned b0 = cvtpk(P[BASE + 4], P[BASE + 5]), b1 = cvtpk(P[BASE + 6], P[BASE + 7]);                              \
    auto r0 = __builtin_amdgcn_permlane32_swap(a0, b0, false, false); auto r1 = __builtin_amdgcn_permlane32_swap(a1, b1, false, false); \
    u32x4 w = {r0[0], r1[0], r0[1], r1[1]}; OUT = *reinterpret_cast<bf16x8*>(&w); } while (0)
  PK4(p0, 0, pa0); PK4(p0, 8, pa1); PK4(p1, 0, pa2); PK4(p1, 8, pa3);
#undef PK4
}
template <int NDQ, int NQL>
__device__ __forceinline__ void qkt(f32x16& p0, f32x16& p1, const f32x16& negm, const char* Ks, const bf16x8* qr, const char* qls, int r32, int hi) {
  constexpr int ROWB = NDQ * 32, NQR = NDQ - NQL, SWM = (NDQ == 8) ? 15 : 7;
#pragma unroll
  for (int d0 = 0; d0 < NDQ; ++d0) { const int cb = (d0 * 16 + hi * 8) * 2;
    bf16x8 b0 = *reinterpret_cast<const bf16x8*>(Ks + r32 * ROWB + (cb ^ ((r32 & SWM) << 4)));
    bf16x8 b1 = *reinterpret_cast<const bf16x8*>(Ks + (32 + r32) * ROWB + (cb ^ ((r32 & SWM) << 4)));
    bf16x8 q;
    if constexpr (NQL > 0) { if (d0 < NQR) q = qr[d0 < NQR ? d0 : 0]; else q = *reinterpret_cast<const bf16x8*>(qls + (d0 - NQR) * 1024); }
    else q = qr[d0];
    if (d0 == 0) { p0 = __builtin_amdgcn_mfma_f32_32x32x16_bf16(b0, q, negm, 0, 0, 0); p1 = __builtin_amdgcn_mfma_f32_32x32x16_bf16(b1, q, negm, 0, 0, 0); }
    else { p0 = __builtin_amdgcn_mfma_f32_32x32x16_bf16(b0, q, p0, 0, 0, 0); p1 = __builtin_amdgcn_mfma_f32_32x32x16_bf16(b1, q, p1, 0, 0, 0); } }
}
template <int OFF> __device__ __forceinline__ bf16x8 lds_rd128(int a) { bf16x8 r; asm volatile("ds_read_b128 %0, %1 offset:%2" : "=&v"(r) : "v"(a), "i"(OFF) : "memory"); return r; }
#define SBAR_M() __builtin_amdgcn_sched_barrier(0)
__device__ __forceinline__ void qkt8_roll(f32x16& p0, f32x16& p1, const f32x16& negm, int kb, const bf16x8* qr) {
  const int a0 = kb ^ (0 << 5); const bf16x8 x0 = lds_rd128<0>(a0), y0 = lds_rd128<8192>(a0);
  const int a1 = kb ^ (1 << 5); const bf16x8 x1 = lds_rd128<0>(a1), y1 = lds_rd128<8192>(a1);
  const int a2 = kb ^ (2 << 5); const bf16x8 x2 = lds_rd128<0>(a2), y2 = lds_rd128<8192>(a2);
  asm volatile("s_waitcnt lgkmcnt(4)" ::: "memory"); SBAR_M();
  p0 = __builtin_amdgcn_mfma_f32_32x32x16_bf16(x0, qr[0], negm, 0, 0, 0); p1 = __builtin_amdgcn_mfma_f32_32x32x16_bf16(y0, qr[0], negm, 0, 0, 0);
  const int a3 = kb ^ (3 << 5); const bf16x8 x3 = lds_rd128<0>(a3), y3 = lds_rd128<8192>(a3);
  asm volatile("s_waitcnt lgkmcnt(4)" ::: "memory"); SBAR_M();
  p0 = __builtin_amdgcn_mfma_f32_32x32x16_bf16(x1, qr[1], p0, 0, 0, 0); p1 = __builtin_amdgcn_mfma_f32_32x32x16_bf16(y1, qr[1], p1, 0, 0, 0);
  const int a4 = kb ^ (4 << 5); const bf16x8 x4 = lds_rd128<0>(a4), y4 = lds_rd128<8192>(a4);
  asm volatile("s_waitcnt lgkmcnt(4)" ::: "memory"); SBAR_M();
  p0 = __builtin_amdgcn_mfma_f32_32x32x16_bf16(x2, qr[2], p0, 0, 0, 0); p1 = __builtin_amdgcn_mfma_f32_32x32x16_bf16(y2, qr[2], p1, 0, 0, 0);
  const int a5 = kb ^ (5 << 5); const bf16x8 x5 = lds_rd128<0>(a5), y5 = lds_rd128<8192>(a5);
  asm volatile("s_waitcnt lgkmcnt(4)" ::: "memory"); SBAR_M();
  p0 = __builtin_amdgcn_mfma_f32_32x32x16_bf16(x3, qr[3], p0, 0, 0, 0); p1 = __builtin_amdgcn_mfma_f32_32x32x16_bf16(y3, qr[3], p1, 0, 0, 0);
  const int a6 = kb ^ (6 << 5); const bf16x8 x6 = lds_rd128<0>(a6), y6 = lds_rd128<8192>(a6);
  asm volatile("s_waitcnt lgkmcnt(4)" ::: "memory"); SBAR_M();
  p0 = __builtin_amdgcn_mfma_f32_32x32x16_bf16(x4, qr[4], p0, 0, 0, 0); p1 = __builtin_amdgcn_mfma_f32_32x32x16_bf16(y4, qr[4], p1, 0, 0, 0);
  const int a7 = kb ^ (7 << 5); const bf16x8 x7 = lds_rd128<0>(a7), y7 = lds_rd128<8192>(a7);
  asm volatile("s_waitcnt lgkmcnt(4)" ::: "memory"); SBAR_M();
  p0 = __builtin_amdgcn_mfma_f32_32x32x16_bf16(x5, qr[5], p0, 0, 0, 0); p1 = __builtin_amdgcn_mfma_f32_32x32x16_bf16(y5, qr[5], p1, 0, 0, 0);
  asm volatile("s_waitcnt lgkmcnt(2)" ::: "memory"); SBAR_M();
  p0 = __builtin_amdgcn_mfma_f32_32x32x16_bf16(x6, qr[6], p0, 0, 0, 0); p1 = __builtin_amdgcn_mfma_f32_32x32x16_bf16(y6, qr[6], p1, 0, 0, 0);
  asm volatile("s_waitcnt lgkmcnt(0)" ::: "memory"); SBAR_M();
  p0 = __builtin_amdgcn_mfma_f32_32x32x16_bf16(x7, qr[7], p0, 0, 0, 0); p1 = __builtin_amdgcn_mfma_f32_32x32x16_bf16(y7, qr[7], p1, 0, 0, 0);
}

#define PK4S(P, BASE, OUT) do { unsigned a0 = cvtpk(P[BASE + 0], P[BASE + 1]), a1 = cvtpk(P[BASE + 2], P[BASE + 3]);   \
    unsigned b0 = cvtpk(P[BASE + 4], P[BASE + 5]), b1 = cvtpk(P[BASE + 6], P[BASE + 7]);                              \
    auto r0 = __builtin_amdgcn_permlane32_swap(a0, b0, false, false); auto r1 = __builtin_amdgcn_permlane32_swap(a1, b1, false, false); \
    u32x4 w = {r0[0], r1[0], r0[1], r1[1]}; OUT = *reinterpret_cast<bf16x8*>(&w); } while (0)
template <int K>
__device__ __forceinline__ void fsm_slice(f32x16& p0, f32x16& p1, float alpha, float& l_reg, bf16x8& pa0, bf16x8& pa1, bf16x8& pa2, bf16x8& pa3, float (&sm)[4]) {
  if constexpr (K == 2) {
    sm[0] = p0[0]; sm[1] = p0[1]; sm[2] = p0[2]; sm[3] = p0[3];
#pragma unroll
    for (int r = 4; r < 16; ++r) sm[r & 3] += p0[r];
  } else if constexpr (K == 3) {
#pragma unroll
    for (int r = 0; r < 16; ++r) sm[r & 3] += p1[r];
  } else if constexpr (K == 4) {
    float ps = (sm[0] + sm[1]) + (sm[2] + sm[3]);
    { auto rr = __builtin_amdgcn_permlane32_swap(__float_as_uint(ps), __float_as_uint(ps), false, false);
      ps = __uint_as_float(rr[0]) + __uint_as_float(rr[1]); }
    l_reg = l_reg * alpha + ps;
    PK4S(p0, 0, pa0);
  } else if constexpr (K == 5) { PK4S(p0, 8, pa1);
  } else if constexpr (K == 6) { PK4S(p1, 0, pa2);
  } else if constexpr (K == 7) { PK4S(p1, 8, pa3); }
}
template <int K>
__device__ __forceinline__ void psm_slice(f32x16& p0, f32x16& p1, float& mC, float& alpha, float (&mx)[4]) {
  if constexpr (K == 0) { mx[0] = p0[0]; mx[1] = p0[1]; mx[2] = p0[2]; mx[3] = p0[3]; }
  else if constexpr (K >= 1 && K <= 3) {
#pragma unroll
    for (int r = 4 * K; r < 4 * K + 4; ++r) mx[r & 3] = fmaxf(mx[r & 3], p0[r]);
  } else if constexpr (K >= 4 && K <= 7) {
#pragma unroll
    for (int r = 4 * (K - 4); r < 4 * (K - 4) + 4; ++r) mx[r & 3] = fmaxf(mx[r & 3], p1[r]);
  } else if constexpr (K == 8) {
    float pmax = fmaxf(fmaxf(mx[0], mx[1]), fmaxf(mx[2], mx[3]));
    { auto rr = __builtin_amdgcn_permlane32_swap(__float_as_uint(pmax), __float_as_uint(pmax), false, false);
      pmax = fmaxf(__uint_as_float(rr[0]), __uint_as_float(rr[1])); }
    if (__builtin_expect(__all(pmax <= THR2), 1)) { alpha = 1.f; }
    else { const float delta = fmaxf(pmax, 0.f); alpha = __builtin_amdgcn_exp2f(-delta); mC += delta;
#pragma unroll
      for (int r = 0; r < 16; ++r) p0[r] -= delta;
#pragma unroll
      for (int r = 0; r < 16; ++r) p1[r] -= delta; }
  } else if constexpr (K >= 9 && K <= 12) {
#pragma unroll
    for (int r = 4 * (K - 9); r < 4 * (K - 9) + 4; ++r) p0[r] = __builtin_amdgcn_exp2f(p0[r]);
  } else if constexpr (K >= 13 && K <= 15) {
#pragma unroll
    for (int r = (K == 13 ? 0 : K == 14 ? 6 : 11); r < (K == 13 ? 6 : K == 14 ? 11 : 16); ++r) p1[r] = __builtin_amdgcn_exp2f(p1[r]);
  }
}
__device__ __forceinline__ int v_st(int k, int c) { const int kk = (k & ~0xC) | ((k & 4) << 1) | ((k & 8) >> 1); return ((kk >> 3) * 4 + (c >> 5)) * 512 + ((kk & 7) * 32 + (c & 31)) * 2; }
__device__ __forceinline__ int v_rd_base(int lane) { return ((lane & 3) << 3) | (((lane >> 2) & 3) << 6) | (((lane >> 4) & 1) << 5) | (((lane >> 5) & 1) << 8); }
constexpr int v_rd_off(int d0, int ks, int half) { return d0 * 512 + ks * 4096 + half * 2048; }
template <int OFF> __device__ __forceinline__ s16x4 tr_read(int vb) {
  s16x4 r; asm volatile("ds_read_b64_tr_b16 %0, %1 offset:%2" : "=&v"(r) : "v"(vb), "i"(OFF) : "memory"); return r;
}
template <int D0> __device__ __forceinline__ void pv_one(f32x16& od, int vb, bf16x8 pa0, bf16x8 pa1, bf16x8 pa2, bf16x8 pa3) {
  const s16x4 l0 = tr_read<v_rd_off(D0, 0, 0)>(vb), h0 = tr_read<v_rd_off(D0, 0, 1)>(vb), l1 = tr_read<v_rd_off(D0, 1, 0)>(vb), h1 = tr_read<v_rd_off(D0, 1, 1)>(vb);
  const s16x4 l2 = tr_read<v_rd_off(D0, 2, 0)>(vb), h2 = tr_read<v_rd_off(D0, 2, 1)>(vb), l3 = tr_read<v_rd_off(D0, 3, 0)>(vb), h3 = tr_read<v_rd_off(D0, 3, 1)>(vb);
  asm volatile("s_waitcnt lgkmcnt(0)" ::: "memory"); SBAR();
#define PK(L, H) (bf16x8){L[0], L[1], L[2], L[3], H[0], H[1], H[2], H[3]}
  od = __builtin_amdgcn_mfma_f32_32x32x16_bf16(pa0, PK(l0, h0), od, 0, 0, 0);
  od = __builtin_amdgcn_mfma_f32_32x32x16_bf16(pa1, PK(l1, h1), od, 0, 0, 0);
  od = __builtin_amdgcn_mfma_f32_32x32x16_bf16(pa2, PK(l2, h2), od, 0, 0, 0);
  od = __builtin_amdgcn_mfma_f32_32x32x16_bf16(pa3, PK(l3, h3), od, 0, 0, 0);
#undef PK
}
__device__ __forceinline__ void pv_d0(f32x16* o, int vb, bf16x8 pa0, bf16x8 pa1, bf16x8 pa2, bf16x8 pa3) {
#define PK(L, H) (bf16x8){L[0], L[1], L[2], L[3], H[0], H[1], H[2], H[3]}
  const s16x4 l0 = tr_read<v_rd_off(0, 0, 0)>(vb), h0 = tr_read<v_rd_off(0, 0, 1)>(vb);
  const s16x4 l1 = tr_read<v_rd_off(0, 1, 0)>(vb), h1 = tr_read<v_rd_off(0, 1, 1)>(vb);
  const s16x4 l2 = tr_read<v_rd_off(0, 2, 0)>(vb), h2 = tr_read<v_rd_off(0, 2, 1)>(vb);
  const s16x4 l3 = tr_read<v_rd_off(0, 3, 0)>(vb), h3 = tr_read<v_rd_off(0, 3, 1)>(vb);
  const s16x4 l4 = tr_read<v_rd_off(1, 0, 0)>(vb), h4 = tr_read<v_rd_off(1, 0, 1)>(vb);
  asm volatile("s_waitcnt lgkmcnt(8)" ::: "memory"); SBAR();
  o[0] = __builtin_amdgcn_mfma_f32_32x32x16_bf16(pa0, PK(l0, h0), o[0], 0, 0, 0);
  const s16x4 l5 = tr_read<v_rd_off(1, 1, 0)>(vb), h5 = tr_read<v_rd_off(1, 1, 1)>(vb);
  asm volatile("s_waitcnt lgkmcnt(8)" ::: "memory"); SBAR();
  o[0] = __builtin_amdgcn_mfma_f32_32x32x16_bf16(pa1, PK(l1, h1), o[0], 0, 0, 0);
  const s16x4 l6 = tr_read<v_rd_off(1, 2, 0)>(vb), h6 = tr_read<v_rd_off(1, 2, 1)>(vb);
  asm volatile("s_waitcnt lgkmcnt(8)" ::: "memory"); SBAR();
  o[0] = __builtin_amdgcn_mfma_f32_32x32x16_bf16(pa2, PK(l2, h2), o[0], 0, 0, 0);
  const s16x4 l7 = tr_read<v_rd_off(1, 3, 0)>(vb), h7 = tr_read<v_rd_off(1, 3, 1)>(vb);
  asm volatile("s_waitcnt lgkmcnt(8)" ::: "memory"); SBAR();
  o[0] = __builtin_amdgcn_mfma_f32_32x32x16_bf16(pa3, PK(l3, h3), o[0], 0, 0, 0);
  const s16x4 l8 = tr_read<v_rd_off(2, 0, 0)>(vb), h8 = tr_read<v_rd_off(2, 0, 1)>(vb);
  asm volatile("s_waitcnt lgkmcnt(8)" ::: "memory"); SBAR();
  o[1] = __builtin_amdgcn_mfma_f32_32x32x16_bf16(pa0, PK(l4, h4), o[1], 0, 0, 0);
  const s16x4 l9 = tr_read<v_rd_off(2, 1, 0)>(vb), h9 = tr_read<v_rd_off(2, 1, 1)>(vb);
  asm volatile("s_waitcnt lgkmcnt(8)" ::: "memory"); SBAR();
  o[1] = __builtin_amdgcn_mfma_f32_32x32x16_bf16(pa1, PK(l5, h5), o[1], 0, 0, 0);
  const s16x4 l10 = tr_read<v_rd_off(2, 2, 0)>(vb), h10 = tr_read<v_rd_off(2, 2, 1)>(vb);
  asm volatile("s_waitcnt lgkmcnt(8)" ::: "memory"); SBAR();
  o[1] = __builtin_amdgcn_mfma_f32_32x32x16_bf16(pa2, PK(l6, h6), o[1], 0, 0, 0);
  const s16x4 l11 = tr_read<v_rd_off(2, 3, 0)>(vb), h11 = tr_read<v_rd_off(2, 3, 1)>(vb);
  asm volatile("s_waitcnt lgkmcnt(8)" ::: "memory"); SBAR();
  o[1] = __builtin_amdgcn_mfma_f32_32x32x16_bf16(pa3, PK(l7, h7), o[1], 0, 0, 0);
  const s16x4 l12 = tr_read<v_rd_off(3, 0, 0)>(vb), h12 = tr_read<v_rd_off(3, 0, 1)>(vb);
  asm volatile("s_waitcnt lgkmcnt(8)" ::: "memory"); SBAR();
  o[2] = __builtin_amdgcn_mfma_f32_32x32x16_bf16(pa0, PK(l8, h8), o[2], 0, 0, 0);
  const s16x4 l13 = tr_read<v_rd_off(3, 1, 0)>(vb), h13 = tr_read<v_rd_off(3, 1, 1)>(vb);
  asm volatile("s_waitcnt lgkmcnt(8)" ::: "memory"); SBAR();
  o[2] = __builtin_amdgcn_mfma_f32_32x32x16_bf16(pa1, PK(l9, h9), o[2], 0, 0, 0);
  const s16x4 l14 = tr_read<v_rd_off(3, 2, 0)>(vb), h14 = tr_read<v_rd_off(3, 2, 1)>(vb);
  asm volatile("s_waitcnt lgkmcnt(8)" ::: "memory"); SBAR();
  o[2] = __builtin_amdgcn_mfma_f32_32x32x16_bf16(pa2, PK(l10, h10), o[2], 0, 0, 0);
  const s16x4 l15 = tr_read<v_rd_off(3, 3, 0)>(vb), h15 = tr_read<v_rd_off(3, 3, 1)>(vb);
  asm volatile("s_waitcnt lgkmcnt(8)" ::: "memory"); SBAR();
  o[2] = __builtin_amdgcn_mfma_f32_32x32x16_bf16(pa3, PK(l11, h11), o[2], 0, 0, 0);
  asm volatile("s_waitcnt lgkmcnt(6)" ::: "memory"); SBAR();
  o[3] = __builtin_amdgcn_mfma_f32_32x32x16_bf16(pa0, PK(l12, h12), o[3], 0, 0, 0);
  asm volatile("s_waitcnt lgkmcnt(4)" ::: "memory"); SBAR();
  o[3] = __builtin_amdgcn_mfma_f32_32x32x16_bf16(pa1, PK(l13, h13), o[3], 0, 0, 0);
  asm volatile("s_waitcnt lgkmcnt(2)" ::: "memory"); SBAR();
  o[3] = __builtin_amdgcn_mfma_f32_32x32x16_bf16(pa2, PK(l14, h14), o[3], 0, 0, 0);
  asm volatile("s_waitcnt lgkmcnt(0)" ::: "memory"); SBAR();
  o[3] = __builtin_amdgcn_mfma_f32_32x32x16_bf16(pa3, PK(l15, h15), o[3], 0, 0, 0);
#undef PK
}

__device__ __forceinline__ void qkt8_fsm(f32x16& p0, f32x16& p1, const f32x16& negm, int kb, const bf16x8* qr, f32x16& q0p, f32x16& q1p, float alpha, float& l_reg, bf16x8& pa0, bf16x8& pa1, bf16x8& pa2, bf16x8& pa3) {
  float sm[4];
  const int a0 = kb ^ (0 << 5); const bf16x8 x0 = lds_rd128<0>(a0), y0 = lds_rd128<8192>(a0);
  const int a1 = kb ^ (1 << 5); const bf16x8 x1 = lds_rd128<0>(a1), y1 = lds_rd128<8192>(a1);
  const int a2 = kb ^ (2 << 5); const bf16x8 x2 = lds_rd128<0>(a2), y2 = lds_rd128<8192>(a2);
  asm volatile("s_waitcnt lgkmcnt(4)" ::: "memory"); SBAR();
  p0 = __builtin_amdgcn_mfma_f32_32x32x16_bf16(x0, qr[0], negm, 0, 0, 0); p1 = __builtin_amdgcn_mfma_f32_32x32x16_bf16(y0, qr[0], negm, 0, 0, 0);
  fsm_slice<0>(q0p, q1p, alpha, l_reg, pa0, pa1, pa2, pa3, sm); SBAR();
  const int a3 = kb ^ (3 << 5); const bf16x8 x3 = lds_rd128<0>(a3), y3 = lds_rd128<8192>(a3);
  asm volatile("s_waitcnt lgkmcnt(4)" ::: "memory"); SBAR();
  p0 = __builtin_amdgcn_mfma_f32_32x32x16_bf16(x1, qr[1], p0, 0, 0, 0); p1 = __builtin_amdgcn_mfma_f32_32x32x16_bf16(y1, qr[1], p1, 0, 0, 0);
  fsm_slice<1>(q0p, q1p, alpha, l_reg, pa0, pa1, pa2, pa3, sm); SBAR();
  const int a4 = kb ^ (4 << 5); const bf16x8 x4 = lds_rd128<0>(a4), y4 = lds_rd128<8192>(a4);
  asm volatile("s_waitcnt lgkmcnt(4)" ::: "memory"); SBAR();
  p0 = __builtin_amdgcn_mfma_f32_32x32x16_bf16(x2, qr[2], p0, 0, 0, 0); p1 = __builtin_amdgcn_mfma_f32_32x32x16_bf16(y2, qr[2], p1, 0, 0, 0);
  fsm_slice<2>(q0p, q1p, alpha, l_reg, pa0, pa1, pa2, pa3, sm); SBAR();
  const int a5 = kb ^ (5 << 5); const bf16x8 x5 = lds_rd128<0>(a5), y5 = lds_rd128<8192>(a5);
  asm volatile("s_waitcnt lgkmcnt(4)" ::: "memory"); SBAR();
  p0 = __builtin_amdgcn_mfma_f32_32x32x16_bf16(x3, qr[3], p0, 0, 0, 0); p1 = __builtin_amdgcn_mfma_f32_32x32x16_bf16(y3, qr[3], p1, 0, 0, 0);
  fsm_slice<3>(q0p, q1p, alpha, l_reg, pa0, pa1, pa2, pa3, sm); SBAR();
  const int a6 = kb ^ (6 << 5); const bf16x8 x6 = lds_rd128<0>(a6), y6 = lds_rd128<8192>(a6);
  asm volatile("s_waitcnt lgkmcnt(4)" ::: "memory"); SBAR();
  p0 = __builtin_amdgcn_mfma_f32_32x32x16_bf16(x4, qr[4], p0, 0, 0, 0); p1 = __builtin_amdgcn_mfma_f32_32x32x16_bf16(y4, qr[4], p1, 0, 0, 0);
  fsm_slice<4>(q0p, q1p, alpha, l_reg, pa0, pa1, pa2, pa3, sm); SBAR();
  const int a7 = kb ^ (7 << 5); const bf16x8 x7 = lds_rd128<0>(a7), y7 = lds_rd128<8192>(a7);
  asm volatile("s_waitcnt lgkmcnt(4)" ::: "memory"); SBAR();
  p0 = __builtin_amdgcn_mfma_f32_32x32x16_bf16(x5, qr[5], p0, 0, 0, 0); p1 = __builtin_amdgcn_mfma_f32_32x32x16_bf16(y5, qr[5], p1, 0, 0, 0);
  fsm_slice<5>(q0p, q1p, alpha, l_reg, pa0, pa1, pa2, pa3, sm); SBAR();
  asm volatile("s_waitcnt lgkmcnt(2)" ::: "memory"); SBAR();
  p0 = __builtin_amdgcn_mfma_f32_32x32x16_bf16(x6, qr[6], p0, 0, 0, 0); p1 = __builtin_amdgcn_mfma_f32_32x32x16_bf16(y6, qr[6], p1, 0, 0, 0);
  fsm_slice<6>(q0p, q1p, alpha, l_reg, pa0, pa1, pa2, pa3, sm); SBAR();
  asm volatile("s_waitcnt lgkmcnt(0)" ::: "memory"); SBAR();
  p0 = __builtin_amdgcn_mfma_f32_32x32x16_bf16(x7, qr[7], p0, 0, 0, 0); p1 = __builtin_amdgcn_mfma_f32_32x32x16_bf16(y7, qr[7], p1, 0, 0, 0);
  fsm_slice<7>(q0p, q1p, alpha, l_reg, pa0, pa1, pa2, pa3, sm); SBAR();
}
__device__ __forceinline__ void pv_psm(f32x16* o, int vb, bf16x8 pa0, bf16x8 pa1, bf16x8 pa2, bf16x8 pa3, f32x16& n0, f32x16& n1, float& mC, float& alpha) {
  float mx[4];
#define PK(L, H) (bf16x8){L[0], L[1], L[2], L[3], H[0], H[1], H[2], H[3]}
  const s16x4 l0 = tr_read<v_rd_off(0, 0, 0)>(vb), h0 = tr_read<v_rd_off(0, 0, 1)>(vb);
  const s16x4 l1 = tr_read<v_rd_off(0, 1, 0)>(vb), h1 = tr_read<v_rd_off(0, 1, 1)>(vb);
  const s16x4 l2 = tr_read<v_rd_off(0, 2, 0)>(vb), h2 = tr_read<v_rd_off(0, 2, 1)>(vb);
  const s16x4 l3 = tr_read<v_rd_off(0, 3, 0)>(vb), h3 = tr_read<v_rd_off(0, 3, 1)>(vb);
  asm volatile("s_waitcnt lgkmcnt(6)" ::: "memory"); SBAR();
  o[0] = __builtin_amdgcn_mfma_f32_32x32x16_bf16(pa0, PK(l0, h0), o[0], 0, 0, 0);
  psm_slice<0>(n0, n1, mC, alpha, mx); SBAR();
  const s16x4 l4 = tr_read<v_rd_off(1, 0, 0)>(vb), h4 = tr_read<v_rd_off(1, 0, 1)>(vb);
  asm volatile("s_waitcnt lgkmcnt(6)" ::: "memory"); SBAR();
  o[0] = __builtin_amdgcn_mfma_f32_32x32x16_bf16(pa1, PK(l1, h1), o[0], 0, 0, 0);
  psm_slice<1>(n0, n1, mC, alpha, mx); SBAR();
  const s16x4 l5 = tr_read<v_rd_off(1, 1, 0)>(vb), h5 = tr_read<v_rd_off(1, 1, 1)>(vb);
  asm volatile("s_waitcnt lgkmcnt(6)" ::: "memory"); SBAR();
  o[0] = __builtin_amdgcn_mfma_f32_32x32x16_bf16(pa2, PK(l2, h2), o[0], 0, 0, 0);
  psm_slice<2>(n0, n1, mC, alpha, mx); SBAR();
  const s16x4 l6 = tr_read<v_rd_off(1, 2, 0)>(vb), h6 = tr_read<v_rd_off(1, 2, 1)>(vb);
  asm volatile("s_waitcnt lgkmcnt(6)" ::: "memory"); SBAR();
  o[0] = __builtin_amdgcn_mfma_f32_32x32x16_bf16(pa3, PK(l3, h3), o[0], 0, 0, 0);
  psm_slice<3>(n0, n1, mC, alpha, mx); SBAR();
  const s16x4 l7 = tr_read<v_rd_off(1, 3, 0)>(vb), h7 = tr_read<v_rd_off(1, 3, 1)>(vb);
  asm volatile("s_waitcnt lgkmcnt(6)" ::: "memory"); SBAR();
  o[1] = __builtin_amdgcn_mfma_f32_32x32x16_bf16(pa0, PK(l4, h4), o[1], 0, 0, 0);
  psm_slice<4>(n0, n1, mC, alpha, mx); SBAR();
  const s16x4 l8 = tr_read<v_rd_off(2, 0, 0)>(vb), h8 = tr_read<v_rd_off(2, 0, 1)>(vb);
  asm volatile("s_waitcnt lgkmcnt(6)" ::: "memory"); SBAR();
  o[1] = __builtin_amdgcn_mfma_f32_32x32x16_bf16(pa1, PK(l5, h5), o[1], 0, 0, 0);
  psm_slice<5>(n0, n1, mC, alpha, mx); SBAR();
  const s16x4 l9 = tr_read<v_rd_off(2, 1, 0)>(vb), h9 = tr_read<v_rd_off(2, 1, 1)>(vb);
  asm volatile("s_waitcnt lgkmcnt(6)" ::: "memory"); SBAR();
  o[1] = __builtin_amdgcn_mfma_f32_32x32x16_bf16(pa2, PK(l6, h6), o[1], 0, 0, 0);
  psm_slice<6>(n0, n1, mC, alpha, mx); SBAR();
  const s16x4 l10 = tr_read<v_rd_off(2, 2, 0)>(vb), h10 = tr_read<v_rd_off(2, 2, 1)>(vb);
  asm volatile("s_waitcnt lgkmcnt(6)" ::: "memory"); SBAR();
  o[1] = __builtin_amdgcn_mfma_f32_32x32x16_bf16(pa3, PK(l7, h7), o[1], 0, 0, 0);
  psm_slice<7>(n0, n1, mC, alpha, mx); SBAR();
  const s16x4 l11 = tr_read<v_rd_off(2, 3, 0)>(vb), h11 = tr_read<v_rd_off(2, 3, 1)>(vb);
  asm volatile("s_waitcnt lgkmcnt(6)" ::: "memory"); SBAR();
  o[2] = __builtin_amdgcn_mfma_f32_32x32x16_bf16(pa0, PK(l8, h8), o[2], 0, 0, 0);
  psm_slice<8>(n0, n1, mC, alpha, mx); SBAR();
  const s16x4 l12 = tr_read<v_rd_off(3, 0, 0)>(vb), h12 = tr_read<v_rd_off(3, 0, 1)>(vb);
  asm volatile("s_waitcnt lgkmcnt(6)" ::: "memory"); SBAR();
  o[2] = __builtin_amdgcn_mfma_f32_32x32x16_bf16(pa1, PK(l9, h9), o[2], 0, 0, 0);
  psm_slice<9>(n0, n1, mC, alpha, mx); SBAR();
  const s16x4 l13 = tr_read<v_rd_off(3, 1, 0)>(vb), h13 = tr_read<v_rd_off(3, 1, 1)>(vb);
  asm volatile("s_waitcnt lgkmcnt(6)" ::: "memory"); SBAR();
  o[2] = __builtin_amdgcn_mfma_f32_32x32x16_bf16(pa2, PK(l10, h10), o[2], 0, 0, 0);
  psm_slice<10>(n0, n1, mC, alpha, mx); SBAR();
  const s16x4 l14 = tr_read<v_rd_off(3, 2, 0)>(vb), h14 = tr_read<v_rd_off(3, 2, 1)>(vb);
  asm volatile("s_waitcnt lgkmcnt(6)" ::: "memory"); SBAR();
  o[2] = __builtin_amdgcn_mfma_f32_32x32x16_bf16(pa3, PK(l11, h11), o[2], 0, 0, 0);
  psm_slice<11>(n0, n1, mC, alpha, mx); SBAR();
  const s16x4 l15 = tr_read<v_rd_off(3, 3, 0)>(vb), h15 = tr_read<v_rd_off(3, 3, 1)>(vb);
  asm volatile("s_waitcnt lgkmcnt(6)" ::: "memory"); SBAR();
  o[3] = __builtin_amdgcn_mfma_f32_32x32x16_bf16(pa0, PK(l12, h12), o[3], 0, 0, 0);
  psm_slice<12>(n0, n1, mC, alpha, mx); SBAR();
  asm volatile("s_waitcnt lgkmcnt(4)" ::: "memory"); SBAR();
  o[3] = __builtin_amdgcn_mfma_f32_32x32x16_bf16(pa1, PK(l13, h13), o[3], 0, 0, 0);
  psm_slice<13>(n0, n1, mC, alpha, mx); SBAR();
  asm volatile("s_waitcnt lgkmcnt(2)" ::: "memory"); SBAR();
  o[3] = __builtin_amdgcn_mfma_f32_32x32x16_bf16(pa2, PK(l14, h14), o[3], 0, 0, 0);
  psm_slice<14>(n0, n1, mC, alpha, mx); SBAR();
  asm volatile("s_waitcnt lgkmcnt(0)" ::: "memory"); SBAR();
  o[3] = __builtin_amdgcn_mfma_f32_32x32x16_bf16(pa3, PK(l15, h15), o[3], 0, 0, 0);
  psm_slice<15>(n0, n1, mC, alpha, mx); SBAR();
#undef PK
}
constexpr int LDS_K_OFF = 2 * SHM_V, LDS_WS_OFF = LDS_K_OFF + 2 * 12 * 2048, LDS_TBL_OFF = LDS_WS_OFF + NW * 64 * 4, LDS_Q_OFF = LDS_TBL_OFF + ((TBLN * 4 + 15) / 16) * 16;
static_assert(LDS_Q_OFF + NW * 8192 <= 163840, "attention LDS map");

template <int NDQ, int BIAS, int EPI, int SDEPTH, int NQL = 0, int ROPEQ = 0, int ORD = 0>
__device__ __forceinline__ void attn_unit(const bf16_t* __restrict__ Qb, int ldq, const bf16_t* __restrict__ Kh, int ldk, const bf16_t* __restrict__ K2, int ldk2,
                                          const bf16_t* __restrict__ Vh, int ldv, int kbeg, int nkeys, int q0, const float* __restrict__ tblg, float cb_lo, float cb_hi,
                                          bf16_t* __restrict__ Obf, int ldo, float* __restrict__ tmp, float lam, const float* __restrict__ subln, float post, char* lds, const int wave0, const float* __restrict__ cosp = nullptr, const float* __restrict__ sinp = nullptr) {
  constexpr int ROWB = NDQ * 32, SHM_K = 64 * ROWB;
  int tid_ = wave0 * 64 + lane_id_v();
  const int tid = tid_, wid = tid >> 6, lane = tid & 63, r32 = lane & 31, hi = lane >> 5;
  char* V_lds = lds; char* K_lds = lds + LDS_K_OFF;
  float* ws = (float*)(lds + LDS_WS_OFF) + wid * 64; float* li_l = ws; float* al_l = ws + 32;
  float* tbl_l = (float*)(lds + LDS_TBL_OFF);
  __syncthreads();
  if constexpr (BIAS) { for (int i = tid; i < TBLN; i += 512) tbl_l[i] = tblg[i]; }
  float mC = 0.f, l_reg = 0, nm_cur = 0.f; f32x16 o[4] = {}; f32x16 negm = {}; bf16x8 qr[NDQ - NQL];
  const bf16_t* Qw = Qb + (long)(wid * QBLK + r32) * ldq + hi * 8;
  char* qls = lds + LDS_Q_OFF + wid * 8192 + lane * 16;
#pragma unroll
  for (int d0 = 0; d0 < NDQ - NQL; ++d0) qr[d0] = *reinterpret_cast<const bf16x8*>(Qw + d0 * 16);
  if constexpr (ROPEQ) {
    static_assert(NDQ == 12 && NQL >= 4, "ROPEQ: MLA layout");
#pragma unroll
    for (int d0 = NDQ - NQL; d0 < 8; ++d0) *reinterpret_cast<bf16x8*>(qls + (d0 - (NDQ - NQL)) * 1024) = *reinterpret_cast<const bf16x8*>(Qw + d0 * 16);
    const int qrow = q0 + wid * QBLK + r32;
#pragma unroll
    for (int pr = 0; pr < 2; ++pr) {
      const bf16x8 xa = *reinterpret_cast<const bf16x8*>(Qw + (8 + pr) * 16), xb = *reinterpret_cast<const bf16x8*>(Qw + (10 + pr) * 16);
      const float* cp = cosp + (size_t)qrow * 32 + pr * 16 + hi * 8; const float* sp = sinp + (size_t)qrow * 32 + pr * 16 + hi * 8;
      const f32x4 c0 = *(const f32x4*)cp, c1 = *(const f32x4*)(cp + 4), s0 = *(const f32x4*)sp, s1 = *(const f32x4*)(sp + 4);
      float ya[8], yb[8];
#pragma unroll
      for (int t = 0; t < 8; ++t) { const float x1 = bf2f((unsigned short)xa[t]), x2 = bf2f((unsigned short)xb[t]); const float c = t < 4 ? c0[t & 3] : c1[t & 3], sn = t < 4 ? s0[t & 3] : s1[t & 3];
        ya[t] = x1 * c - x2 * sn; yb[t] = x2 * c + x1 * sn; }
      u32x4 wa = {pk2(ya[0], ya[1]), pk2(ya[2], ya[3]), pk2(ya[4], ya[5]), pk2(ya[6], ya[7])}, wb = {pk2(yb[0], yb[1]), pk2(yb[2], yb[3]), pk2(yb[4], yb[5]), pk2(yb[6], yb[7])};
      *reinterpret_cast<u32x4*>(qls + (8 + pr - (NDQ - NQL)) * 1024) = wa; *reinterpret_cast<u32x4*>(qls + (10 + pr - (NDQ - NQL)) * 1024) = wb; }
  } else {
#pragma unroll
  for (int d0 = NDQ - NQL; d0 < NDQ; ++d0) *reinterpret_cast<bf16x8*>(qls + (d0 - (NDQ - NQL)) * 1024) = *reinterpret_cast<const bf16x8*>(Qw + d0 * 16);
  }
  const int sr = tid >> 4, sc = (tid & 15) * 8, vst0 = v_st(sr, sc), vst1 = v_st(32 + sr, sc);
  const int sr8 = tid >> 3, sc8 = (tid & 7) * 8;
  const int vb0 = (int)(uintptr_t)V_lds + v_rd_base(lane);
  const int qlane = q0 + wid * QBLK + r32;
  struct { bf16x8 vs0, vs1, ks0, ks1, ks2; } sr_[SDEPTH];
  constexpr int SWM = (NDQ == 8) ? 15 : 7;
#define KSWZ(row, colB) ((row) * ROWB + ((colB) ^ (((row) & SWM) << 4)))
#define SLOAD(i, k0) do { sr_[i].vs0 = *reinterpret_cast<const bf16x8*>(&Vh[(long)((k0) + sr) * ldv + sc]); sr_[i].vs1 = *reinterpret_cast<const bf16x8*>(&Vh[(long)((k0) + 32 + sr) * ldv + sc]); \
    if constexpr (NDQ == 4) { sr_[i].ks0 = *reinterpret_cast<const bf16x8*>(&Kh[(long)((k0) + sr8) * ldk + sc8]); } \
    else { sr_[i].ks0 = *reinterpret_cast<const bf16x8*>(&Kh[(long)((k0) + sr) * ldk + sc]); sr_[i].ks1 = *reinterpret_cast<const bf16x8*>(&Kh[(long)((k0) + 32 + sr) * ldk + sc]); \
      if constexpr (NDQ == 12) { sr_[i].ks2 = *reinterpret_cast<const bf16x8*>(&K2[(long)((k0) + sr8) * ldk2 + sc8]); } } } while (0)
#define SWRITE(b, i) do { *(bf16x8*)(V_lds + (b) * SHM_V + vst0) = sr_[i].vs0; *(bf16x8*)(V_lds + (b) * SHM_V + vst1) = sr_[i].vs1; \
    if constexpr (NDQ == 4) { *(bf16x8*)(K_lds + (b) * SHM_K + KSWZ(sr8, sc8 * 2)) = sr_[i].ks0; } \
    else { *(bf16x8*)(K_lds + (b) * SHM_K + KSWZ(sr, sc * 2)) = sr_[i].ks0; *(bf16x8*)(K_lds + (b) * SHM_K + KSWZ(32 + sr, sc * 2)) = sr_[i].ks1; \
      if constexpr (NDQ == 12) { *(bf16x8*)(K_lds + (b) * SHM_K + KSWZ(sr8, 256 + sc8 * 2)) = sr_[i].ks2; } } } while (0)
#define SWAIT() do { if constexpr (SDEPTH == 2) { if constexpr (NDQ == 4) asm volatile("s_waitcnt vmcnt(3)" ::: "memory"); else if constexpr (NDQ == 8) asm volatile("s_waitcnt vmcnt(4)" ::: "memory"); else asm volatile("s_waitcnt vmcnt(5)" ::: "memory"); } \
    else asm volatile("s_waitcnt vmcnt(0)" ::: "memory"); } while (0)
#define RESC(a) do { if (__any((a) < 1.f)) { if (hi == 0) al_l[r32] = (a); asm volatile("s_waitcnt lgkmcnt(0)" ::: "memory"); \
    _Pragma("unroll") for (int d = 0; d < 4; ++d) _Pragma("unroll") for (int r = 0; r < 16; ++r) o[d][r] *= al_l[crow(r, hi)]; } } while (0)
#define BIASADD(P0, P1, kt0) do { if constexpr (BIAS) { const int dlo_ = (kt0) - q0 - 255, dhi_ = (kt0) + 63 - q0; \
    if (!(dlo_ >= 1024) && !(dhi_ <= -1024)) { const float* tb_ = tbl_l + ((kt0) - qlane + TOFF + 4 * hi); \
      _Pragma("unroll") for (int r = 0; r < 16; ++r) { P0[r] += tb_[(r & 3) + 8 * (r >> 2)]; P1[r] += tb_[32 + (r & 3) + 8 * (r >> 2)]; } } } } while (0)
#define NEGM_UPD(kt0) do { float nmj_ = -mC; if constexpr (BIAS) { const int dlo_ = (kt0) - q0 - 255, dhi_ = (kt0) + 63 - q0; if (dlo_ >= 1024) nmj_ += cb_hi; else if (dhi_ <= -1024) nmj_ += cb_lo; } \
    if (__any(nmj_ != nm_cur)) { nm_cur = nmj_; _Pragma("unroll") for (int r = 0; r < 16; ++r) negm[r] = nmj_; } } while (0)
  f32x16 pA0, pA1, pB0, pB1; float alA, alB; bf16x8 pa0, pa1, pa2, pa3; const int NT = nkeys / KVBLK;
  const int kb0 = (int)(uintptr_t)K_lds + r32 * ROWB + (((r32 & 15) << 4) ^ (hi << 4));
#define QKT(P0, P1, KOFF) do { if constexpr (NDQ == 8 && NQL == 0) qkt8_roll(P0, P1, negm, kb0 + (KOFF), qr); else qkt<NDQ, NQL>(P0, P1, negm, K_lds + (KOFF), qr, qls, r32, hi); } while (0)
  constexpr int SE = 0, SO = SDEPTH - 1;
  SLOAD(SE, kbeg); asm volatile("s_waitcnt vmcnt(0)" ::: "memory"); SWRITE(0, SE); __syncthreads();
  constexpr bool SLICED = (NDQ == 8 && NQL == 0);
  NEGM_UPD(kbeg); QKT(pA0, pA1, 0); BIASADD(pA0, pA1, kbeg); partialSM<true>(pA0, pA1, mC, alA);
  if constexpr (SLICED) {
#pragma unroll
    for (int r = 0; r < 16; ++r) pA1[r] = __builtin_amdgcn_exp2f(pA1[r]); }
  SLOAD(SO, kbeg + KVBLK); if constexpr (SDEPTH == 2) { if (2 < NT) SLOAD(SE, kbeg + 2 * KVBLK); }
  SWAIT(); SWRITE(1, SO); __syncthreads();
  if constexpr (NDQ == 8 && NQL == 0) {
  for (int j = 1; j + 1 < NT; j += 2) {
    if constexpr (ORD == 0) {
    NEGM_UPD(kbeg + j * KVBLK); SBAR();
    qkt8_fsm(pB0, pB1, negm, kb0 + SHM_K, qr, pA0, pA1, alA, l_reg, pa0, pa1, pa2, pa3);
    SLOAD(SO, kbeg + (j + SDEPTH) * KVBLK); SBAR();
    BIASADD(pB0, pB1, kbeg + j * KVBLK); SBAR();
    pv_psm(o, vb0, pa0, pa1, pa2, pa3, pB0, pB1, mC, alB);
    } else {
    finishSM<false>(pA0, pA1, alA, l_reg, pa0, pa1, pa2, pa3); SBAR();
    NEGM_UPD(kbeg + j * KVBLK); SBAR(); qkt8_roll(pB0, pB1, negm, kb0 + SHM_K, qr); SBAR();
    SLOAD(SO, kbeg + (j + SDEPTH) * KVBLK); SBAR();
    BIASADD(pB0, pB1, kbeg + j * KVBLK); partialSM<false>(pB0, pB1, mC, alB);
    _Pragma("unroll") for (int r = 0; r < 16; ++r) pB1[r] = __builtin_amdgcn_exp2f(pB1[r]);
    SBAR(); pv_d0(o, vb0, pa0, pa1, pa2, pa3);
    }
    __syncthreads(); SWAIT(); SWRITE(0, SE);
    RESC(alB); __syncthreads();
    if constexpr (ORD == 0) {
    NEGM_UPD(kbeg + (j + 1) * KVBLK); SBAR();
    qkt8_fsm(pA0, pA1, negm, kb0, qr, pB0, pB1, alB, l_reg, pa0, pa1, pa2, pa3);
    if (SDEPTH == 1 || j + 3 < NT) SLOAD(SE, kbeg + (j + 1 + SDEPTH) * KVBLK); SBAR();
    BIASADD(pA0, pA1, kbeg + (j + 1) * KVBLK); SBAR();
    pv_psm(o, vb0 + (int)SHM_V, pa0, pa1, pa2, pa3, pA0, pA1, mC, alA);
    } else {
    finishSM<false>(pB0, pB1, alB, l_reg, pa0, pa1, pa2, pa3); SBAR();
    NEGM_UPD(kbeg + (j + 1) * KVBLK); SBAR(); qkt8_roll(pA0, pA1, negm, kb0, qr); SBAR();
    if (SDEPTH == 1 || j + 3 < NT) SLOAD(SE, kbeg + (j + 1 + SDEPTH) * KVBLK); SBAR();
    BIASADD(pA0, pA1, kbeg + (j + 1) * KVBLK); partialSM<false>(pA0, pA1, mC, alA);
    _Pragma("unroll") for (int r = 0; r < 16; ++r) pA1[r] = __builtin_amdgcn_exp2f(pA1[r]);
    SBAR(); pv_d0(o, vb0 + (int)SHM_V, pa0, pa1, pa2, pa3);
    }
    __syncthreads(); SWAIT(); SWRITE(1, SO);
    RESC(alA); __syncthreads();
  }
  } else {
  for (int j = 1; j + 1 < NT; j += 2) {
    NEGM_UPD(kbeg + j * KVBLK); SBAR(); QKT(pB0, pB1, SHM_K);
    finishSM(pA0, pA1, alA, l_reg, pa0, pa1, pa2, pa3); SBAR();
    SLOAD(SO, kbeg + (j + SDEPTH) * KVBLK); SBAR();
    pv_d0(o, vb0, pa0, pa1, pa2, pa3); BIASADD(pB0, pB1, kbeg + j * KVBLK); partialSM<false>(pB0, pB1, mC, alB);
    __syncthreads(); SWAIT(); SWRITE(0, SE);
    RESC(alB); __syncthreads();
    NEGM_UPD(kbeg + (j + 1) * KVBLK); SBAR(); QKT(pA0, pA1, 0);
    finishSM(pB0, pB1, alB, l_reg, pa0, pa1, pa2, pa3); SBAR();
    if (SDEPTH == 1 || j + 3 < NT) SLOAD(SE, kbeg + (j + 1 + SDEPTH) * KVBLK); SBAR();
    pv_d0(o, vb0 + (int)SHM_V, pa0, pa1, pa2, pa3); BIASADD(pA0, pA1, kbeg + (j + 1) * KVBLK); partialSM<false>(pA0, pA1, mC, alA);
    __syncthreads(); SWAIT(); SWRITE(1, SO);
    RESC(alA); __syncthreads();
  }
  }
  NEGM_UPD(kbeg + (NT - 1) * KVBLK); SBAR(); QKT(pB0, pB1, SHM_K);
  finishSM<!SLICED>(pA0, pA1, alA, l_reg, pa0, pa1, pa2, pa3); SBAR();
  pv_d0(o, vb0, pa0, pa1, pa2, pa3); BIASADD(pB0, pB1, kbeg + (NT - 1) * KVBLK); partialSM<false>(pB0, pB1, mC, alB);
  __syncthreads(); RESC(alB);
  finishSM(pB0, pB1, alB, l_reg, pa0, pa1, pa2, pa3); SBAR();
  pv_d0(o, vb0 + (int)SHM_V, pa0, pa1, pa2, pa3);
  if (hi == 0) li_l[r32] = l_reg; asm volatile("s_waitcnt lgkmcnt(0)" ::: "memory");
  float rli[16];
#pragma unroll
  for (int r = 0; r < 16; ++r) rli[r] = __builtin_amdgcn_rcpf(li_l[crow(r, hi)]);
  if constexpr (EPI == 0) {
    bf16_t* Ow = Obf + (long)(wid * QBLK) * ldo;
#pragma unroll
    for (int r = 0; r < 16; ++r) { const int orow = crow(r, hi);
#pragma unroll
      for (int d0 = 0; d0 < 4; ++d0) Ow[(long)orow * ldo + d0 * 32 + r32] = (bf16_t)f2bf(o[d0][r] * rli[r]); }
  } else if constexpr (EPI == 1) {
    float* Tw = tmp + (wid * QBLK) * 128;
#pragma unroll
    for (int r = 0; r < 16; ++r) { const int orow = crow(r, hi);
#pragma unroll
      for (int d0 = 0; d0 < 4; ++d0) Tw[orow * 128 + d0 * 32 + r32] = o[d0][r] * rli[r]; }
  } else {
    const float* Tw = tmp + (wid * QBLK) * 128; bf16_t* Ow = Obf + (long)(wid * QBLK) * ldo;
    float sg[4];
#pragma unroll
    for (int d0 = 0; d0 < 4; ++d0) sg[d0] = subln[d0 * 32 + r32] * post;
#pragma unroll
    for (int r = 0; r < 16; ++r) { const int orow = crow(r, hi); float v[4]; float ss = 0.f;
#pragma unroll
      for (int d0 = 0; d0 < 4; ++d0) { v[d0] = Tw[orow * 128 + d0 * 32 + r32] - lam * (o[d0][r] * rli[r]); ss += v[d0] * v[d0]; }
      ss += swz_xor<1>(ss); ss += swz_xor<2>(ss); ss += swz_xor<4>(ss); ss += swz_xor<8>(ss); ss += swz_xor<16>(ss);
      const float rs = rsqrtf(ss * (1.0f / 128.0f) + EPS);
#pragma unroll
      for (int d0 = 0; d0 < 4; ++d0) Ow[(long)orow * ldo + d0 * 32 + r32] = (bf16_t)f2bf(v[d0] * rs * sg[d0]); }
  }
#undef KSWZ
#undef SLOAD
#undef SWRITE
#undef SWAIT
#undef RESC
#undef BIASADD
#undef NEGM_UPD
#undef QKT
}

template <int M>
__device__ __forceinline__ void qkt_map(f32x16& p0, f32x16& p1, const char* Ks, const char* qls, int r32, int hi) {
  p0 = f32x16{}; p1 = f32x16{};
#pragma unroll
  for (int d0 = 0; d0 < 4; ++d0) { const int cb = (M * 64 + d0 * 16 + hi * 8) * 2;
    bf16x8 b0 = *reinterpret_cast<const bf16x8*>(Ks + r32 * 256 + (cb ^ ((r32 & 15) << 4)));
    bf16x8 b1 = *reinterpret_cast<const bf16x8*>(Ks + (32 + r32) * 256 + (cb ^ ((r32 & 15) << 4)));
    bf16x8 q = *reinterpret_cast<const bf16x8*>(qls + (M * 4 + d0) * 1024);
    p0 = __builtin_amdgcn_mfma_f32_32x32x16_bf16(b0, q, p0, 0, 0, 0);
    p1 = __builtin_amdgcn_mfma_f32_32x32x16_bf16(b1, q, p1, 0, 0, 0);
    if (d0 == 1) SBAR(); }
}
template <int M>
__device__ __forceinline__ void qkt_map_roll(f32x16& p0, f32x16& p1, int kb, int qa) {
  p0 = f32x16{}; p1 = f32x16{};
  const int a0 = kb ^ ((M << 7) | (0 << 5)); const bf16x8 x0 = lds_rd128<0>(a0), y0 = lds_rd128<8192>(a0); const bf16x8 z0 = (M == 0) ? lds_rd128<0>(qa) : lds_rd128<4096>(qa);
  const int a1 = kb ^ ((M << 7) | (1 << 5)); const bf16x8 x1 = lds_rd128<0>(a1), y1 = lds_rd128<8192>(a1); const bf16x8 z1 = (M == 0) ? lds_rd128<1024>(qa) : lds_rd128<5120>(qa);
  asm volatile("s_waitcnt lgkmcnt(3)" ::: "memory"); SBAR();
  p0 = __builtin_amdgcn_mfma_f32_32x32x16_bf16(x0, z0, p0, 0, 0, 0); p1 = __builtin_amdgcn_mfma_f32_32x32x16_bf16(y0, z0, p1, 0, 0, 0);
  const int a2 = kb ^ ((M << 7) | (2 << 5)); const bf16x8 x2 = lds_rd128<0>(a2), y2 = lds_rd128<8192>(a2); const bf16x8 z2 = (M == 0) ? lds_rd128<2048>(qa) : lds_rd128<6144>(qa);
  asm volatile("s_waitcnt lgkmcnt(3)" ::: "memory"); SBAR();
  p0 = __builtin_amdgcn_mfma_f32_32x32x16_bf16(x1, z1, p0, 0, 0, 0); p1 = __builtin_amdgcn_mfma_f32_32x32x16_bf16(y1, z1, p1, 0, 0, 0);
  const int a3 = kb ^ ((M << 7) | (3 << 5)); const bf16x8 x3 = lds_rd128<0>(a3), y3 = lds_rd128<8192>(a3); const bf16x8 z3 = (M == 0) ? lds_rd128<3072>(qa) : lds_rd128<7168>(qa);
  asm volatile("s_waitcnt lgkmcnt(3)" ::: "memory"); SBAR();
  p0 = __builtin_amdgcn_mfma_f32_32x32x16_bf16(x2, z2, p0, 0, 0, 0); p1 = __builtin_amdgcn_mfma_f32_32x32x16_bf16(y2, z2, p1, 0, 0, 0);
  asm volatile("s_waitcnt lgkmcnt(0)" ::: "memory"); SBAR();
  p0 = __builtin_amdgcn_mfma_f32_32x32x16_bf16(x3, z3, p0, 0, 0, 0); p1 = __builtin_amdgcn_mfma_f32_32x32x16_bf16(y3, z3, p1, 0, 0, 0);
  SBAR();
}
__device__ __forceinline__ void softmax_tile(f32x16& p0, f32x16& p1, float& m, float& l, float& alpha, float cb, bf16x8& pa0, bf16x8& pa1, bf16x8& pa2, bf16x8& pa3) {
  float mx_[4] = {p0[0], p0[1], p0[2], p0[3]};
#pragma unroll
  for (int r = 4; r < 16; ++r) mx_[r & 3] = fmaxf(mx_[r & 3], p0[r]);
#pragma unroll
  for (int r = 0; r < 16; ++r) mx_[r & 3] = fmaxf(mx_[r & 3], p1[r]);
  float pmax = fmaxf(fmaxf(mx_[0], mx_[1]), fmaxf(mx_[2], mx_[3]));
  { auto rr = __builtin_amdgcn_permlane32_swap(__float_as_uint(pmax), __float_as_uint(pmax), false, false);
    pmax = fmaxf(__uint_as_float(rr[0]), __uint_as_float(rr[1])); }
  pmax += cb;
  float mn;
  if (__builtin_expect(__all(pmax - m <= THR2), 1)) { mn = m; alpha = 1.f; }
  else { mn = fmaxf(m, pmax); alpha = __builtin_amdgcn_exp2f(m - mn); m = mn; }
  const float off = cb - mn;
#pragma unroll
  for (int r = 0; r < 16; ++r) p0[r] = __builtin_amdgcn_exp2f(p0[r] + off);
#pragma unroll
  for (int r = 0; r < 16; ++r) p1[r] = __builtin_amdgcn_exp2f(p1[r] + off);
  float sm_[4] = {p0[0], p0[1], p0[2], p0[3]};
#pragma unroll
  for (int r = 4; r < 16; ++r) sm_[r & 3] += p0[r];
#pragma unroll
  for (int r = 0; r < 16; ++r) sm_[r & 3] += p1[r];
  float ps = (sm_[0] + sm_[1]) + (sm_[2] + sm_[3]);
  { auto rr = __builtin_amdgcn_permlane32_swap(__float_as_uint(ps), __float_as_uint(ps), false, false);
    ps = __uint_as_float(rr[0]) + __uint_as_float(rr[1]); }
  l = l * alpha + ps;
#define PK4(P, BASE, OUT) do { unsigned a0 = cvtpk(P[BASE + 0], P[BASE + 1]), a1 = cvtpk(P[BASE + 2], P[BASE + 3]);   \
    unsigned b0 = cvtpk(P[BASE + 4], P[BASE + 5]), b1 = cvtpk(P[BASE + 6], P[BASE + 7]);                              \
    auto r0 = __builtin_amdgcn_permlane32_swap(a0, b0, false, false); auto r1 = __builtin_amdgcn_permlane32_swap(a1, b1, false, false); \
    u32x4 w = {r0[0], r1[0], r0[1], r1[1]}; OUT = *reinterpret_cast<bf16x8*>(&w); } while (0)
  PK4(p0, 0, pa0); PK4(p0, 8, pa1); PK4(p1, 0, pa2); PK4(p1, 8, pa3);
#undef PK4
}
template <int D0> __device__ __forceinline__ void pv2_one(f32x16& oa, f32x16& ob, int vb, bf16x8 pa0, bf16x8 pa1, bf16x8 pa2, bf16x8 pa3, bf16x8 pb0, bf16x8 pb1, bf16x8 pb2, bf16x8 pb3) {
  const s16x4 l0 = tr_read<v_rd_off(D0, 0, 0)>(vb), h0 = tr_read<v_rd_off(D0, 0, 1)>(vb), l1 = tr_read<v_rd_off(D0, 1, 0)>(vb), h1 = tr_read<v_rd_off(D0, 1, 1)>(vb);
  const s16x4 l2 = tr_read<v_rd_off(D0, 2, 0)>(vb), h2 = tr_read<v_rd_off(D0, 2, 1)>(vb), l3 = tr_read<v_rd_off(D0, 3, 0)>(vb), h3 = tr_read<v_rd_off(D0, 3, 1)>(vb);
  asm volatile("s_waitcnt lgkmcnt(0)" ::: "memory"); SBAR();
#define PK(L, H) (bf16x8){L[0], L[1], L[2], L[3], H[0], H[1], H[2], H[3]}
  const bf16x8 v0 = PK(l0, h0), v1 = PK(l1, h1), v2 = PK(l2, h2), v3 = PK(l3, h3);
  oa = __builtin_amdgcn_mfma_f32_32x32x16_bf16(pa0, v0, oa, 0, 0, 0);
  ob = __builtin_amdgcn_mfma_f32_32x32x16_bf16(pb0, v0, ob, 0, 0, 0);
  oa = __builtin_amdgcn_mfma_f32_32x32x16_bf16(pa1, v1, oa, 0, 0, 0);
  ob = __builtin_amdgcn_mfma_f32_32x32x16_bf16(pb1, v1, ob, 0, 0, 0);
  oa = __builtin_amdgcn_mfma_f32_32x32x16_bf16(pa2, v2, oa, 0, 0, 0);
  ob = __builtin_amdgcn_mfma_f32_32x32x16_bf16(pb2, v2, ob, 0, 0, 0);
  oa = __builtin_amdgcn_mfma_f32_32x32x16_bf16(pa3, v3, oa, 0, 0, 0);
  ob = __builtin_amdgcn_mfma_f32_32x32x16_bf16(pb3, v3, ob, 0, 0, 0);
#undef PK
}
__device__ __forceinline__ void attn_unit_A2(const bf16_t* __restrict__ Qb, int ldq, const bf16_t* __restrict__ Kh, int ldk, const bf16_t* __restrict__ Vh, int ldv, int nkeys, int q0,
                                             const float* __restrict__ tblg, float cb_lo, float cb_hi, bf16_t* __restrict__ Obf, int ldo, float lam, const float* __restrict__ subln, float post, char* lds, const int wave0) {
  constexpr int ROWB = 256, SHM_K = 64 * ROWB;
  int tid_ = wave0 * 64 + lane_id_v();
  const int tid = tid_, wid = tid >> 6, lane = tid & 63, r32 = lane & 31, hi = lane >> 5;
  char* V_lds = lds; char* K_lds = lds + LDS_K_OFF;
  float* ws = (float*)(lds + LDS_WS_OFF) + wid * 64; float* sl0 = ws; float* sl1 = ws + 32;
  float* tbl_l = (float*)(lds + LDS_TBL_OFF);
  char* qls = lds + LDS_Q_OFF + wid * 8192 + lane * 16;
  __syncthreads();
  for (int i = tid; i < TBLN; i += 512) tbl_l[i] = tblg[i];
  { const bf16_t* Qw = Qb + (long)(wid * QBLK + r32) * ldq + hi * 8;
#pragma unroll
    for (int i = 0; i < 8; ++i) *reinterpret_cast<bf16x8*>(qls + i * 1024) = *reinterpret_cast<const bf16x8*>(Qw + i * 16); }
  float m0 = -1e30f, m1 = -1e30f, l0 = 0.f, l1 = 0.f; f32x16 oa[4] = {}, ob[4] = {};
  const int sr = tid >> 4, sc = (tid & 15) * 8, vst0 = v_st(sr, sc), vst1 = v_st(32 + sr, sc);
  const int vb0 = (int)(uintptr_t)V_lds + v_rd_base(lane);
  const int qlane = q0 + wid * QBLK + r32;
  bf16x8 vs0, vs1, ks0, ks1;
#define KSWZ(row, colB) ((row) * ROWB + ((colB) ^ (((row) & 15) << 4)))
#define SLOAD2(k0) do { vs0 = *reinterpret_cast<const bf16x8*>(&Vh[(long)((k0) + sr) * ldv + sc]); vs1 = *reinterpret_cast<const bf16x8*>(&Vh[(long)((k0) + 32 + sr) * ldv + sc]); \
    ks0 = *reinterpret_cast<const bf16x8*>(&Kh[(long)((k0) + sr) * ldk + sc]); ks1 = *reinterpret_cast<const bf16x8*>(&Kh[(long)((k0) + 32 + sr) * ldk + sc]); } while (0)
#define SWRITE2(b) do { *(bf16x8*)(V_lds + (b) * SHM_V + vst0) = vs0; *(bf16x8*)(V_lds + (b) * SHM_V + vst1) = vs1; \
    *(bf16x8*)(K_lds + (b) * SHM_K + KSWZ(sr, sc * 2)) = ks0; *(bf16x8*)(K_lds + (b) * SHM_K + KSWZ(32 + sr, sc * 2)) = ks1; } while (0)
#define RESC2(O, SL, a) do { if (__any((a) < 1.f)) { if (hi == 0) SL[r32] = (a); asm volatile("s_waitcnt lgkmcnt(0)" ::: "memory"); \
    _Pragma("unroll") for (int d = 0; d < 4; ++d) _Pragma("unroll") for (int r = 0; r < 16; ++r) O[d][r] *= SL[crow(r, hi)]; } } while (0)
  const int NT = nkeys / KVBLK;
  const int kbA = (int)(uintptr_t)K_lds + r32 * 256 + (((r32 & 15) << 4) ^ (hi << 4)), qaA = (int)(uintptr_t)qls;
  SLOAD2(0); asm volatile("s_waitcnt vmcnt(0)" ::: "memory"); SWRITE2(0); __syncthreads();
  for (int j = 0; j < NT; ++j) {
    const int b = j & 1, kt0 = j * KVBLK;
    const int dlo_ = kt0 - q0 - 255, dhi_ = kt0 + 63 - q0;
    float cb = 0.f; const bool nearb = !(dlo_ >= 1024) && !(dhi_ <= -1024);
    if (dlo_ >= 1024) cb = cb_hi; else if (dhi_ <= -1024) cb = cb_lo;
    const float* tb_ = tbl_l + (kt0 - qlane + TOFF + 4 * hi);
    f32x16 s0, s1; bf16x8 pa0, pa1, pa2, pa3; float al0, al1;
    const int vb = vb0 + b * (int)SHM_V;
    qkt_map_roll<0>(s0, s1, kbA + b * SHM_K, qaA);
    SBAR();
    if (nearb) {
#pragma unroll
      for (int r = 0; r < 8; ++r) { s0[r] += tb_[(r & 3) + 8 * (r >> 2)]; s1[r] += tb_[32 + (r & 3) + 8 * (r >> 2)]; }
      SBAR();
#pragma unroll
      for (int r = 8; r < 16; ++r) { s0[r] += tb_[(r & 3) + 8 * (r >> 2)]; s1[r] += tb_[32 + (r & 3) + 8 * (r >> 2)]; } }
    SBAR();
    softmax_tile(s0, s1, m0, l0, al0, cb, pa0, pa1, pa2, pa3);
    RESC2(oa, sl0, al0);
    SBAR();
    pv_d0(oa, vb, pa0, pa1, pa2, pa3);
    SBAR();
    qkt_map_roll<1>(s0, s1, kbA + b * SHM_K, qaA);
    SBAR();
    if (nearb) {
#pragma unroll
      for (int r = 0; r < 8; ++r) { s0[r] += tb_[(r & 3) + 8 * (r >> 2)]; s1[r] += tb_[32 + (r & 3) + 8 * (r >> 2)]; }
      SBAR();
#pragma unroll
      for (int r = 8; r < 16; ++r) { s0[r] += tb_[(r & 3) + 8 * (r >> 2)]; s1[r] += tb_[32 + (r & 3) + 8 * (r >> 2)]; } }
    SBAR();
    softmax_tile(s0, s1, m1, l1, al1, cb, pa0, pa1, pa2, pa3);
    RESC2(ob, sl1, al1);
    SBAR();
    if (j + 1 < NT) SLOAD2(kt0 + KVBLK);
    SBAR();
    pv_d0(ob, vb, pa0, pa1, pa2, pa3);
    if (j + 1 < NT) { asm volatile("s_waitcnt vmcnt(0)" ::: "memory"); SWRITE2(b ^ 1); }
    __syncthreads();
  }
  const int lane_e = lane_id_v(), r32e = lane_e & 31, hie = lane_e >> 5;
  if (hie == 0) { sl0[r32e] = l0; sl1[r32e] = l1; } asm volatile("s_waitcnt lgkmcnt(0)" ::: "memory");
  bf16_t* Ow = Obf + (long)(wid * QBLK) * ldo;
  float sg[4];
#pragma unroll
  for (int d0 = 0; d0 < 4; ++d0) sg[d0] = subln[d0 * 32 + r32e] * post;
#pragma unroll
  for (int r = 0; r < 16; ++r) { const int orow = crow(r, hie); const float ra = __builtin_amdgcn_rcpf(sl0[orow]), rb = lam * __builtin_amdgcn_rcpf(sl1[orow]); float v[4]; float ss = 0.f;
#pragma unroll
    for (int d0 = 0; d0 < 4; ++d0) { v[d0] = oa[d0][r] * ra - ob[d0][r] * rb; ss += v[d0] * v[d0]; }
    ss += swz_xor<1>(ss); ss += swz_xor<2>(ss); ss += swz_xor<4>(ss); ss += swz_xor<8>(ss); ss += swz_xor<16>(ss);
    const float rs = rsqrtf(ss * (1.0f / 128.0f) + EPS);
#pragma unroll
    for (int d0 = 0; d0 < 4; ++d0) Ow[(long)orow * ldo + d0 * 32 + r32e] = (bf16_t)f2bf(v[d0] * rs * sg[d0]); }
#undef KSWZ
#undef SLOAD2
#undef SWRITE2
#undef RESC2
}
}

__device__ __forceinline__ void transpose_item(const float* __restrict__ W, int K, int N, bf16_t* __restrict__ WT, int k0, int n0, int drow0, float wscale, LAS float* scr, int lane) {
    float tv[32];
#pragma unroll
    for (int i = 0; i < 32; ++i) { const int kk = 2 * i + (lane >> 5); tv[i] = W[(size_t)(k0 + kk) * N + n0 + (lane & 31)]; }
#pragma unroll
    for (int i = 0; i < 32; ++i) { const int kk = 2 * i + (lane >> 5); scr[kk * 33 + (lane & 31)] = tv[i] * wscale; }
    asm volatile("s_waitcnt lgkmcnt(0)" ::: "memory");
    const int c = lane & 7;
#pragma unroll
    for (int j = 0; j < 4; ++j) { const int n = (lane >> 3) + 8 * j; const LAS float* s = scr + (8 * c) * 33 + n;
        u32x4 o; o.x = pk2(s[0 * 33], s[1 * 33]); o.y = pk2(s[2 * 33], s[3 * 33]); o.z = pk2(s[4 * 33], s[5 * 33]); o.w = pk2(s[6 * 33], s[7 * 33]);
        *(u32x4*)(WT + (size_t)(drow0 + n) * K + k0 + 8 * c) = o; }
    asm volatile("s_waitcnt lgkmcnt(0)" ::: "memory");
}
constexpr float QS_A = 0.125f * 1.4426950408889634f, QS_B = 0.07216878364870322f * 1.4426950408889634f, QS_CD = 0.08838834764831845f * 1.4426950408889634f;
template <int MODE>
__device__ __forceinline__ void transpose_matrix(const float* __restrict__ W, int K, int N, bf16_t* __restrict__ WT, LAS float* scr, int lane, int gw, int NGW) {
    const int nblk = N / 32, nitems = (K / 64) * nblk;
    for (int it = gw; it < nitems; it += NGW) { const int kb = it / nblk, nb = it % nblk, n0 = 32 * nb; int drow0 = n0;
        if (MODE == 1) { const int c = n0 < FF ? n0 : n0 - FF; drow0 = 256 * (c / 128) + (c % 128) + (n0 < FF ? 0 : 128); }
        float wscale = 1.0f;
        if (MODE == 2) { if (n0 < C_AK) wscale = QS_A; else if (n0 >= C_DQ && n0 < C_DK) wscale = QS_CD; }
        if (MODE == 3) wscale = QS_B;
        transpose_item(W, K, N, WT, 64 * kb, n0, drow0, wscale, scr, lane); }
}
__device__ __forceinline__ int t5_bucket(int d) {
    const int ret = d > 0 ? 16 : 0; const int n = d < 0 ? -d : d;
    if (n < 8) return ret + n;
    const float v = logf((float)n / 8.0f) / 4.852030263919617f * 8.0f;
    int large = 8 + (int)v; if (large > 15) large = 15;
    return ret + large;
}
__device__ __forceinline__ void norm_row(const float* __restrict__ xrow, const float* __restrict__ g, bf16_t* __restrict__ hrow, int lane) {
    f32x4 v[8]; float ss = 0.f;
#pragma unroll
    for (int j = 0; j < 8; ++j) { v[j] = ((const f32x4*)xrow)[lane + 64 * j]; ss += (v[j].x * v[j].x + v[j].y * v[j].y) + (v[j].z * v[j].z + v[j].w * v[j].w); }
    const float rs = rsqrtf(wave_sum(ss) * (1.0f / DM) + EPS);
#pragma unroll
    for (int j = 0; j < 8; ++j) { const f32x4 gg = ((const f32x4*)g)[lane + 64 * j];
        u32x2 w; w.x = pk2(v[j].x * rs * gg.x, v[j].y * rs * gg.y); w.y = pk2(v[j].z * rs * gg.z, v[j].w * rs * gg.w); ((u32x2*)hrow)[lane + 64 * j] = w; }
}
template <int NR>
__device__ __forceinline__ void norm_add_rows(const bf16_t* __restrict__ Yb, const float* xi, float* xo, const float* __restrict__ gpost,
                                              const float* __restrict__ gpre, bf16_t* __restrict__ Hb, int row0, int rstride, int lane) {
    u32x2 yb[NR][8]; f32x4 v[NR][8];
#pragma unroll
    for (int q = 0; q < NR; ++q) { const size_t ro = (size_t)(row0 + q * rstride) * DM;
#pragma unroll
        for (int j = 0; j < 8; ++j) yb[q][j] = ((const u32x2*)(Yb + ro))[lane + 64 * j];
#pragma unroll
        for (int j = 0; j < 8; ++j) v[q][j] = ((const f32x4*)(xi + ro))[lane + 64 * j]; }
    f32x4 gp[8];
#pragma unroll
    for (int j = 0; j < 8; ++j) gp[j] = ((const f32x4*)gpost)[lane + 64 * j];
#pragma unroll
    for (int q = 0; q < NR; ++q) { const size_t ro = (size_t)(row0 + q * rstride) * DM;
        f32x4 y[8]; float ss = 0.f;
#pragma unroll
        for (int j = 0; j < 8; ++j) { y[j].x = __uint_as_float(yb[q][j].x << 16); y[j].y = __uint_as_float(yb[q][j].x & 0xffff0000u); y[j].z = __uint_as_float(yb[q][j].y << 16); y[j].w = __uint_as_float(yb[q][j].y & 0xffff0000u);
            ss += (y[j].x * y[j].x + y[j].y * y[j].y) + (y[j].z * y[j].z + y[j].w * y[j].w); }
        const float rs = rsqrtf(wave_sum(ss) * (1.0f / DM) + EPS);
        float ss2 = 0.f;
#pragma unroll
        for (int j = 0; j < 8; ++j) { v[q][j] = v[q][j] + y[j] * rs * gp[j]; ((f32x4*)(xo + ro))[lane + 64 * j] = v[q][j];
            ss2 += (v[q][j].x * v[q][j].x + v[q][j].y * v[q][j].y) + (v[q][j].z * v[q][j].z + v[q][j].w * v[q][j].w); }
        if (gpre) {
            const float rs2 = rsqrtf(wave_sum(ss2) * (1.0f / DM) + EPS);
#pragma unroll
            for (int j = 0; j < 8; ++j) { const f32x4 gg = ((const f32x4*)gpre)[lane + 64 * j];
                u32x2 w; w.x = pk2(v[q][j].x * rs2 * gg.x, v[q][j].y * rs2 * gg.y); w.y = pk2(v[q][j].z * rs2 * gg.z, v[q][j].w * rs2 * gg.w); ((u32x2*)(Hb + ro))[lane + 64 * j] = w; }
        }
    }
}

__device__ __forceinline__ void head_norm_axial(const bf16_t* __restrict__ src, bf16_t* __restrict__ dst, const float* __restrict__ g, const float* __restrict__ COS, const float* __restrict__ SIN, int row, int t, float oscale) {
    float v[8];
#pragma unroll
    for (int s = 0; s < 4; ++s) { const unsigned w = *(const unsigned*)(src + 32 * s + 2 * t); v[2 * s] = bf2f((unsigned short)(w & 0xffff)); v[2 * s + 1] = bf2f((unsigned short)(w >> 16)); }
    float ss = 0.f;
#pragma unroll
    for (int i = 0; i < 8; ++i) ss += v[i] * v[i];
    ss += swz_xor<1>(ss); ss += swz_xor<2>(ss); ss += swz_xor<4>(ss); ss += swz_xor<8>(ss);
    const float rs = rsqrtf(ss * (1.0f / 128.0f) + EPS);
#pragma unroll
    for (int s = 0; s < 4; ++s) { v[2 * s] *= rs * oscale * g[32 * s + 2 * t]; v[2 * s + 1] *= rs * oscale * g[32 * s + 2 * t + 1]; }
    const int pr = row >> 6, pc = row & 63;
    float o[8];
#pragma unroll
    for (int e = 0; e < 2; ++e) { const int i = 2 * t + e;
        { const float c = COS[pr * 32 + i], s = SIN[pr * 32 + i]; const float x1 = v[e], x2 = v[2 + e]; o[e] = x1 * c - x2 * s; o[2 + e] = x2 * c + x1 * s; }
        { const float c = COS[pc * 32 + i], s = SIN[pc * 32 + i]; const float x1 = v[4 + e], x2 = v[6 + e]; o[4 + e] = x1 * c - x2 * s; o[6 + e] = x2 * c + x1 * s; } }
#pragma unroll
    for (int s = 0; s < 4; ++s) *(unsigned*)(dst + 32 * s + 2 * t) = pk2(o[2 * s], o[2 * s + 1]);
}


#define XB_TMO      128
#define XB_XCNT(j)  (256  + 64 * (j))
#define XB_XSUB(j)  (1280 + 64 * (j))
#define XB_XGEN(j)  (2304 + 64 * (j))
#define XB_TOP      3328
#define XB_TOPGEN   3392
#define XCD_BAR_WORDS 3456
#define XB_SPIN_CAP (1u << 18)
__device__ __forceinline__ unsigned xb_ld(unsigned* p)              { return __hip_atomic_load(p, __ATOMIC_RELAXED, __HIP_MEMORY_SCOPE_AGENT); }
__device__ __forceinline__ unsigned xb_add(unsigned* p, unsigned v) { return __hip_atomic_fetch_add(p, v, __ATOMIC_RELAXED, __HIP_MEMORY_SCOPE_AGENT); }
__device__ __forceinline__ unsigned xb_xcc_id() { return (unsigned)__builtin_amdgcn_s_getreg((3 << 11) | 20) & 0xFu; }
#define XB_SPIN(cond, bar) do { unsigned _sp = 0; while (cond) { __builtin_amdgcn_s_sleep(1); \
    if ((++_sp & 255u) == 0u) { if (xb_ld(&(bar)[XB_TMO])) break; if (_sp > XB_SPIN_CAP) { atomicAdd(&(bar)[XB_TMO], 1u); break; } } } } while (0)
__device__ __forceinline__ void xcd_barrier_complete(unsigned* bar, unsigned x, unsigned& nloc, unsigned& nx) {
    const unsigned G = gridDim.x * gridDim.y * gridDim.z;
    unsigned sum, cnt, mine, sp = 0u;
    for (;;) {
        sum = 0u; cnt = 0u; mine = 0u;
#pragma unroll
        for (unsigned j = 0; j < 16; ++j) { const unsigned c = xb_ld(&bar[XB_XCNT(j)]); sum += c; cnt += (c > 0u) ? 1u : 0u; mine = (j == x) ? c : mine; }
        if (sum == G) break;
        __builtin_amdgcn_s_sleep(1);
        if ((++sp & 255u) == 0u) { if (xb_ld(&bar[XB_TMO])) break; if (sp > XB_SPIN_CAP) { atomicAdd(&bar[XB_TMO], 1u); break; } }
    }
    nloc = mine > 0u ? mine : 1u; nx = cnt > 0u ? cnt : 1u;
}
__device__ __forceinline__ void xcd_barrier(unsigned* bar, volatile LAS unsigned* st, bool leader) {
    asm volatile("s_waitcnt vmcnt(0)" ::: "memory");
    __syncthreads();
    if (leader) {
        const unsigned x = xb_xcc_id();
        __builtin_amdgcn_s_waitcnt(0);
        unsigned nloc = st[0], nx = st[1];
        if (nloc == 0u) { xcd_barrier_complete(bar, x, nloc, nx); st[0] = nloc; st[1] = nx; }
        const unsigned old = xb_add(&bar[XB_XSUB(x)], 1u);
        const unsigned gen = old / nloc;
        if (old + 1u == (gen + 1u) * nloc) {
            __builtin_amdgcn_fence(__ATOMIC_RELEASE, "agent");
            asm volatile("s_waitcnt vmcnt(0)" ::: "memory");
            const unsigned og = xb_add(&bar[XB_TOP], 1u);
            const unsigned tg = og / nx;
            if (og + 1u == (tg + 1u) * nx) xb_add(&bar[XB_TOPGEN], 1u);
            else XB_SPIN(xb_ld(&bar[XB_TOPGEN]) == tg, bar);
            __builtin_amdgcn_fence(__ATOMIC_ACQUIRE, "agent");
            xb_add(&bar[XB_XGEN(x)], 1u);
            asm volatile("s_waitcnt vmcnt(0)" ::: "memory");
        } else {
            XB_SPIN(xb_ld(&bar[XB_XGEN(x)]) == gen, bar);
            __builtin_amdgcn_fence(__ATOMIC_ACQUIRE, "agent");
            asm volatile("s_waitcnt vmcnt(0)" ::: "memory");
        }
    }
    __syncthreads();
}

struct Args { const float* in[18]; float* out; unsigned char* wsp; int ph_lo, ph_hi; };

__global__ void __launch_bounds__(512, 2) mega_fwd(Args args) {
    extern __shared__ __attribute__((aligned(16))) unsigned char lds[];
    const int G = gridDim.x, bid = blockIdx.x, NGW = G * 8;
    const int wave0 = __builtin_amdgcn_readfirstlane((int)threadIdx.x >> 6);
    typedef const __attribute__((address_space(4))) Args* KArgP;
    LAS unsigned char* ldsl = (LAS unsigned char*)lds;
#define x_in (kap->in[0])
#define rel_bias (kap->in[1])
#define norm_mix_pre (kap->in[2])
#define norm_mix_post (kap->in[3])
#define norm_ffn_pre (kap->in[4])
#define norm_ffn_post (kap->in[5])
#define w_in (kap->in[6])
#define diff_lambda (kap->in[7])
#define diff_subln (kap->in[8])
#define mla_q_norm (kap->in[9])
#define mla_kv_norm (kap->in[10])
#define mla_w_uq (kap->in[11])
#define mla_w_ukv (kap->in[12])
#define gqa_q_norm (kap->in[13])
#define gqa_k_norm (kap->in[14])
#define w_out (kap->in[15])
#define w_gate_up (kap->in[16])
#define w_down (kap->in[17])
#define xres (kap->out)
#define ws (kap->wsp)
#define PAR ((float*)(ws + WS_PAR))
#define TBLA ((float*)(ws + WS_TBLA))
#define TBLD ((float*)(ws + WS_TBLD))
#define COS ((float*)(ws + WS_COS))
#define SIN ((float*)(ws + WS_SIN))
#define H ((bf16_t*)(ws + WS_H))
#define PROJ ((bf16_t*)(ws + WS_PROJ))
#define CQN ((bf16_t*)(ws + WS_CQN))
#define CKVN ((bf16_t*)(ws + WS_CKVN))
#define KPE ((bf16_t*)(ws + WS_KPE))
#define QC ((bf16_t*)(ws + WS_QC))
#define KC ((bf16_t*)(ws + WS_KC))
#define QB ((bf16_t*)(ws + WS_QB))
#define KVB ((bf16_t*)(ws + WS_KVB))
#define MIX ((bf16_t*)(ws + WS_MIX))
#define Y ((bf16_t*)(ws + WS_Y))
#define HID ((bf16_t*)(ws + WS_HID))
#define TMP ((float*)(ws + WS_TMP))
#define wl (ws + WS_W + (size_t)l * LW)

    volatile LAS unsigned* bst = (volatile LAS unsigned*)(ldsl + LDS_ST_OFF);
    { const bool leader0 = (wave0 == 0) && (lane_id_v() == 0);
      if (leader0) { bst[0] = 0u; bst[1] = 0u; }
      __syncthreads();
      if (leader0 && !MK_MULTI) { KArgP kap0 = (KArgP)__builtin_amdgcn_kernarg_segment_ptr(); (void)xb_add(&((unsigned*)(kap0->wsp + WS_BAR))[XB_XCNT(xb_xcc_id())], 1u); } }
    const int lo = args.ph_lo, hi_ph = args.ph_hi; int ph = 0;
#define PH_BEGIN if (ph >= lo && ph < hi_ph) { KArgP kap = (KArgP)__builtin_amdgcn_kernarg_segment_ptr(); asm volatile("" : "+s"(kap)); \
    int tid_ = wave0 * 64 + lane_id_v(); const int tid = tid_, lane = tid & 63, wave = __builtin_amdgcn_readfirstlane(tid >> 6), gw = bid * 8 + wave; (void)lane; (void)gw;
#define PH_END } if (ph >= lo && ph + 1 < hi_ph) { if (ph == 0) { cg::this_grid().sync(); } else { KArgP kapb = (KArgP)__builtin_amdgcn_kernarg_segment_ptr(); asm volatile("" : "+s"(kapb)); \
      xcd_barrier((unsigned*)(kapb->wsp + WS_BAR), bst, (wave0 == 0) && (lane_id_v() == 0)); } } ++ph;

    PH_BEGIN
    if PHON(0) {
        LAS float* scr = (LAS float*)(ldsl + wave * 16384);
        for (int l = 0; l < DEPTH; ++l) {
            transpose_matrix<2>(w_in + (size_t)l * DM * NPROJ, DM, NPROJ, (bf16_t*)(wl + W_IN), scr, lane, gw, NGW);
            transpose_matrix<3>(mla_w_uq + (size_t)l * 512 * 768, 512, 768, (bf16_t*)(wl + W_UQ), scr, lane, gw, NGW);
            transpose_matrix<0>(mla_w_ukv + (size_t)l * 256 * 1024, 256, 1024, (bf16_t*)(wl + W_UKV), scr, lane, gw, NGW);
            transpose_matrix<0>(w_out + (size_t)l * DM * DM, DM, DM, (bf16_t*)(wl + W_OUT), scr, lane, gw, NGW);
            transpose_matrix<1>(w_gate_up + (size_t)l * DM * NGU, DM, NGU, (bf16_t*)(wl + W_GU), scr, lane, gw, NGW);
            transpose_matrix<0>(w_down + (size_t)l * FF * DM, FF, DM, (bf16_t*)(wl + W_D), scr, lane, gw, NGW);
            { u32x4* z = (u32x4*)((bf16_t*)(wl + W_IN) + (size_t)NPROJ * DM); const int n16 = (LDP - NPROJ) * DM * 2 / 16;
              for (int i = bid * 512 + tid; i < n16; i += G * 512) z[i] = (u32x4){0u, 0u, 0u, 0u}; }
        }
        const int gt = bid * 512 + tid, NT_ = G * 512;
        for (int i = gt; i < 4 * TBLN; i += NT_) { const int h = i / TBLN, d = (i % TBLN) - TOFF; const int b = t5_bucket(d);
            TBLA[i] = rel_bias[b * 8 + h] * 1.4426950408889634f;
            const int n = d < 0 ? -d : d; int mult = (n <= 64 ? 1 : 0) + (((n & 3) == 0 && n <= 256) ? 1 : 0) + (((n & 15) == 0 && n <= 1024) ? 1 : 0);
            TBLD[i] = mult ? (rel_bias[b * 8 + 4 + h] + logf((float)mult)) * 1.4426950408889634f : -1e30f; }
        for (int i = gt; i < S * 32; i += NT_) { const int pos = i >> 5, f = i & 31;
            const float inv = (float)pow(10000.0, -(double)(2 * f) / 64.0); const float ang = (float)pos * inv;
            COS[i] = (float)cos((double)ang); SIN[i] = (float)sin((double)ang); }
        if (bid == 0 && tid < DEPTH) { const float* lv = diff_lambda + tid * 256; float s1 = 0.f, s2 = 0.f;
            for (int i = 0; i < 64; ++i) { s1 += lv[i] * lv[64 + i]; s2 += lv[128 + i] * lv[192 + i]; }
            const float lam_init = 0.8f - 0.6f * expf(-0.3f * (float)tid);
            PAR[tid] = expf(s1) - expf(s2) + lam_init; PAR[4 + tid] = lam_init; }
        for (int row = gw; row < S; row += NGW) norm_row(x_in + (size_t)row * DM, norm_mix_pre, H + (size_t)row * DM, lane);
    }
    PH_END

    for (int l = 0; l < DEPTH; ++l) {
        PH_BEGIN
        if PHON(1) for (int rep_ = 0; rep_ < MK_DUP_GEMM; ++rep_) { pg8::Gemm g{H, (const bf16_t*)(wl + W_IN), S, LDP, DM}; pg8::StaticOrder So; So.init(S, LDP, G, bid);
          pg8::EpiBf16 E{PROJ, LDP};
          pg8::gemm_phase<pg8::EpiBf16, pg8::StaticOrder, true, true>(ldsl, g, So, E, wave0); }
        PH_END
        PH_BEGIN
        if PHON(2) for (int row = gw; row < S; row += NGW) {
            const bf16_t* pr = PROJ + (size_t)row * LDP;
            { const u32x4 raw = *(const u32x4*)(pr + C_BCQ + lane * 8); float v[8];
              v[0] = __uint_as_float(raw.x << 16); v[1] = __uint_as_float(raw.x & 0xffff0000u); v[2] = __uint_as_float(raw.y << 16); v[3] = __uint_as_float(raw.y & 0xffff0000u);
              v[4] = __uint_as_float(raw.z << 16); v[5] = __uint_as_float(raw.z & 0xffff0000u); v[6] = __uint_as_float(raw.w << 16); v[7] = __uint_as_float(raw.w & 0xffff0000u);
              float ss = 0.f;
#pragma unroll
              for (int i = 0; i < 8; ++i) ss += v[i] * v[i];
              const float rs = rsqrtf(wave_sum(ss) * (1.0f / 512.0f) + EPS);
              const f32x4 g0 = *(const f32x4*)(mla_q_norm + l * 512 + lane * 8), g1 = *(const f32x4*)(mla_q_norm + l * 512 + lane * 8 + 4);
              u32x4 w; w.x = pk2(v[0] * rs * g0.x, v[1] * rs * g0.y); w.y = pk2(v[2] * rs * g0.z, v[3] * rs * g0.w); w.z = pk2(v[4] * rs * g1.x, v[5] * rs * g1.y); w.w = pk2(v[6] * rs * g1.z, v[7] * rs * g1.w);
              *(u32x4*)(CQN + (size_t)row * 512 + lane * 8) = w; }
            { const u32x2 raw = *(const u32x2*)(pr + C_BCKV + lane * 4); float v[4];
              v[0] = __uint_as_float(raw.x << 16); v[1] = __uint_as_float(raw.x & 0xffff0000u); v[2] = __uint_as_float(raw.y << 16); v[3] = __uint_as_float(raw.y & 0xffff0000u);
              float ss = v[0] * v[0] + v[1] * v[1] + v[2] * v[2] + v[3] * v[3];
              const float rs = rsqrtf(wave_sum(ss) * (1.0f / 256.0f) + EPS);
              const f32x4 g0 = *(const f32x4*)(mla_kv_norm + l * 256 + lane * 4);
              u32x2 w; w.x = pk2(v[0] * rs * g0.x, v[1] * rs * g0.y); w.y = pk2(v[2] * rs * g0.z, v[3] * rs * g0.w);
              *(u32x2*)(CKVN + (size_t)row * 256 + lane * 4) = w; }
            if (lane < 32) { const float x1 = bf2f(pr[C_BKPE + lane]), x2 = bf2f(pr[C_BKPE + 32 + lane]); const float c = COS[row * 32 + lane], s = SIN[row * 32 + lane];
              KPE[(size_t)row * 64 + lane] = (bf16_t)f2bf(x1 * c - x2 * s); KPE[(size_t)row * 64 + 32 + lane] = (bf16_t)f2bf(x2 * c + x1 * s); }
            { const int hd = lane >> 4, t = lane & 15;
              head_norm_axial(pr + C_CQ + hd * 128, QC + (size_t)row * 512 + hd * 128, gqa_q_norm + l * 128, COS, SIN, row, t, QS_CD);
              const int hk = hd & 1;
              if (lane < 32) head_norm_axial(pr + C_CK + hk * 128, KC + (size_t)row * 256 + hk * 128, gqa_k_norm + l * 128, COS, SIN, row, t, 1.0f); }
        }
        PH_END
        PH_BEGIN
        if PHON(3) { pg8::Gemm g{CQN, (const bf16_t*)(wl + W_UQ), S, 768, 512}; pg8::StaticOrder So; So.init(S, 768, G, bid);
          pg8::EpiBf16 E{QB, 768};
          pg8::gemm_phase<pg8::EpiBf16, pg8::StaticOrder, true, true>(ldsl, g, So, E, wave0); }
        if PHON(4) { pg8::Gemm g{CKVN, (const bf16_t*)(wl + W_UKV), S, 1024, 256}; pg8::StaticOrder So; So.init(S, 1024, G, bid);
          pg8::EpiBf16 E{KVB, 1024};
          pg8::gemm_phase<pg8::EpiBf16, pg8::StaticOrder, true, true>(ldsl, g, So, E, wave0); }
        PH_END
        PH_BEGIN
        for (int rep_ = 0; rep_ < MK_DUP_ATT; ++rep_) {
            const float lam = __int_as_float(__builtin_amdgcn_readfirstlane(__float_as_int(PAR[l]))), lam_init = __int_as_float(__builtin_amdgcn_readfirstlane(__float_as_int(PAR[4 + l])));
            const float L2E = 1.4426950408889634f;
            if PHON(6) for (int u = bid; u < 256; u += G) { const int xq = u & 7, hd = xq & 3, qb = (u >> 3) + 32 * (xq >> 2), q0 = qb * 256;
                { const float cb_lo = rel_bias[15 * 8 + hd] * L2E, cb_hi = rel_bias[31 * 8 + hd] * L2E;
                  att::attn_unit_A2(PROJ + (size_t)q0 * LDP + C_AQ + hd * 128, LDP, PROJ + C_AK + hd * 128, LDP, PROJ + C_AV + hd * 128, LDP, S, q0,
                                    TBLA + hd * TBLN, cb_lo, cb_hi, MIX + (size_t)q0 * DM + hd * 128, DM, lam, diff_subln + l * 128, 1.0f - lam_init, (char*)lds, wave0); }
            }
            if PHON(7) for (int u = bid; u < 256; u += G) { const int xq = u & 7, hd = xq & 3, qb = (u >> 3) + 32 * (xq >> 2), q0 = qb * 256;
                { const float sc = 0.07216878364870322f;
                  att::attn_unit<12, 0, 0, 1, 8, 1>(QB + (size_t)q0 * 768 + hd * 192, 768, KVB + hd * 256, 1024, KPE, 64, KVB + hd * 256 + 128, 1024,
                                            0, S, q0, nullptr, 0.f, 0.f, MIX + (size_t)q0 * DM + 512 + hd * 128, DM, nullptr, 0.f, nullptr, 0.f, (char*)lds, wave0, COS, SIN); }
            }
            if PHON(8) for (int u = bid; u < 256; u += G) { const int xq = u & 7, hd = xq & 3, qb = (u >> 3) + 32 * (xq >> 2), q0 = qb * 256;
                { const float sc = 0.08838834764831845f;
                  if (wave0 < 4) att::attn_unit<8, 0, 0, 1, 0, 0, 0>(QC + (size_t)q0 * 512 + hd * 128, 512, KC + (hd >> 1) * 128, 256, nullptr, 0, PROJ + C_CV + (hd >> 1) * 128, LDP,
                                           0, S, q0, nullptr, 0.f, 0.f, MIX + (size_t)q0 * DM + 1024 + hd * 128, DM, nullptr, 0.f, nullptr, 0.f, (char*)lds, wave0); else att::attn_unit<8, 0, 0, 1, 0, 0, 1>(QC + (size_t)q0 * 512 + hd * 128, 512, KC + (hd >> 1) * 128, 256, nullptr, 0, PROJ + C_CV + (hd >> 1) * 128, LDP,
                                           0, S, q0, nullptr, 0.f, 0.f, MIX + (size_t)q0 * DM + 1024 + hd * 128, DM, nullptr, 0.f, nullptr, 0.f, (char*)lds, wave0); }
            }
            if PHON(9) for (int u = bid; u < 256; u += G) { const int xq = u & 7, hd = xq & 3, qb = (u >> 3) + 32 * (xq >> 2), q0 = qb * 256;
                { const float sc = 0.08838834764831845f;
                  const int kb = q0 - 1024 < 0 ? 0 : q0 - 1024, ke = q0 + 256 + 1024 > S ? S : q0 + 256 + 1024;
                  att::attn_unit<8, 1, 0, 1>(PROJ + (size_t)q0 * LDP + C_DQ + hd * 128, LDP, PROJ + C_DK + hd * 128, LDP, nullptr, 0, PROJ + C_DV + hd * 128, LDP,
                                           kb, ke - kb, q0, TBLD + hd * TBLN, 0.f, 0.f, MIX + (size_t)q0 * DM + 1536 + hd * 128, DM, nullptr, 0.f, nullptr, 0.f, (char*)lds, wave0); }
            }
            __syncthreads();
        }
        PH_END
        PH_BEGIN
        if PHON(10) for (int rep_ = 0; rep_ < MK_DUP_GEMM; ++rep_) { pg8::Gemm g{MIX, (const bf16_t*)(wl + W_OUT), S, DM, DM}; pg8::StaticOrder So; So.init(S, DM, G, bid);
          pg8::EpiBf16 E{Y, DM};
          pg8::gemm_phase<pg8::EpiBf16, pg8::StaticOrder, true, true>(ldsl, g, So, E, wave0); }
        PH_END
        PH_BEGIN
        if PHON(11) { int row = gw;
            for (; row + NGW < S; row += 2 * NGW) norm_add_rows<2>(Y, (l == 0 ? x_in : xres), xres, norm_mix_post + l * DM, norm_ffn_pre + l * DM, H, row, NGW, lane);
            for (; row < S; row += NGW) norm_add_rows<1>(Y, (l == 0 ? x_in : xres), xres, norm_mix_post + l * DM, norm_ffn_pre + l * DM, H, row, NGW, lane); }
        PH_END
        PH_BEGIN
        if PHON(12) for (int rep_ = 0; rep_ < MK_DUP_GEMM; ++rep_) { pg8::Gemm g{H, (const bf16_t*)(wl + W_GU), S, NGU, DM}; pg8::StaticOrder So; So.init(S, NGU, G, bid);
          pg8::EpiSwiGLU E{HID, FF};
          pg8::gemm_phase<pg8::EpiSwiGLU, pg8::StaticOrder, true, true>(ldsl, g, So, E, wave0); }
        PH_END
        PH_BEGIN
        if PHON(13) for (int rep_ = 0; rep_ < MK_DUP_GEMM; ++rep_) { pg8::Gemm g{HID, (const bf16_t*)(wl + W_D), S, DM, FF}; pg8::StaticOrder So; So.init(S, DM, G, bid);
          pg8::EpiBf16 E{Y, DM};
          pg8::gemm_phase<pg8::EpiBf16, pg8::StaticOrder, true, true>(ldsl, g, So, E, wave0); }
        PH_END
        PH_BEGIN
        if PHON(14) { int row = gw; const float* gnext = (l + 1 < DEPTH) ? norm_mix_pre + (l + 1) * DM : nullptr;
            for (; row + NGW < S; row += 2 * NGW) norm_add_rows<2>(Y, xres, xres, norm_ffn_post + l * DM, gnext, H, row, NGW, lane);
            for (; row < S; row += NGW) norm_add_rows<1>(Y, xres, xres, norm_ffn_post + l * DM, gnext, H, row, NGW, lane); }
        PH_END
    }
#undef PH_BEGIN
#undef PH_END
}
#undef x_in
#undef rel_bias
#undef norm_mix_pre
#undef norm_mix_post
#undef norm_ffn_pre
#undef norm_ffn_post
#undef w_in
#undef diff_lambda
#undef diff_subln
#undef mla_q_norm
#undef mla_kv_norm
#undef mla_w_uq
#undef mla_w_ukv
#undef gqa_q_norm
#undef gqa_k_norm
#undef w_out
#undef w_gate_up
#undef w_down
#undef xres
#undef ws
#undef PAR
#undef TBLA
#undef TBLD
#undef COS
#undef SIN
#undef H
#undef PROJ
#undef CQN
#undef CKVN
#undef KPE
#undef QC
#undef KC
#undef QB
#undef KVB
#undef MIX
#undef Y
#undef HID
#undef TMP
#undef wl

constexpr int N_PHASES = 1 + DEPTH * 9;

extern "C" void kernel_launch(void* const* d_in, const int* in_sizes, int n_in, void* d_out, int out_size, void* d_ws, size_t ws_size, hipStream_t stream) {
    static int grid = 0;
    if (grid == 0) {
        if (n_in != 18 || in_sizes[0] != S * DM || out_size != S * DM || ws_size < WS_END) {
            fprintf(stderr, "kernel_launch: unexpected shapes (n_in %d, in0 %d, out %d, ws %zu < %zu)\n", n_in, n_in > 0 ? in_sizes[0] : -1, out_size, ws_size, (size_t)WS_END); grid = -1; return; }
        int dev = 0, cus = 0, per_cu = 0;
        if (hipGetDevice(&dev) != hipSuccess || hipDeviceGetAttribute(&cus, hipDeviceAttributeMultiprocessorCount, dev) != hipSuccess) { grid = -1; return; }
        if (hipFuncSetAttribute((const void*)mega_fwd, hipFuncAttributeMaxDynamicSharedMemorySize, LDS_BYTES) != hipSuccess) { fprintf(stderr, "kernel_launch: hipFuncSetAttribute failed\n"); grid = -1; return; }
        if (hipOccupancyMaxActiveBlocksPerMultiprocessor(&per_cu, (const void*)mega_fwd, 512, LDS_BYTES) != hipSuccess || per_cu < 1) { fprintf(stderr, "kernel_launch: occupancy query says %d\n", per_cu); per_cu = 1; }
        (void)hipGetLastError();
        grid = cus;
    }
    if (grid < 0) return;
    if (hipMemsetAsync((char*)d_ws + WS_BAR, 0, WS_BAR_BYTES, stream) != hipSuccess) { fprintf(stderr, "kernel_launch: hipMemsetAsync of the barrier words failed\n"); return; }
    Args a{};
    for (int i = 0; i < 18; ++i) a.in[i] = (const float*)d_in[i];
    a.out = (float*)d_out; a.wsp = (unsigned char*)d_ws;
#if MK_MULTI
    for (int p = 0; p < N_PHASES; ++p) { a.ph_lo = p; a.ph_hi = p + 1; hipLaunchKernelGGL(mega_fwd, dim3(grid), dim3(512), LDS_BYTES, stream, a); }
#else
    a.ph_lo = 0; a.ph_hi = N_PHASES;
    void* kargs[] = {&a};
    hipError_t e = hipLaunchCooperativeKernel((const void*)mega_fwd, dim3(grid), dim3(512), kargs, LDS_BYTES, stream);
    if (e != hipSuccess) fprintf(stderr, "kernel_launch: cooperative launch failed: %s (grid %d)\n", hipGetErrorString(e), grid);
#endif
}
```

```cpp
#include <hip/hip_runtime.h>
#include <hip/hip_cooperative_groups.h>
#include <cstdio>
#include <cstdint>
namespace cg = cooperative_groups;

#ifndef MK_MULTI
#define MK_MULTI 0
#endif
#ifndef MK_PHMASK
#define MK_PHMASK 0xFFFFF
#endif
#define PHON(k) constexpr (((MK_PHMASK) >> (k)) & 1)
#ifndef MK_DUP_GEMM
#define MK_DUP_GEMM 1
#endif
#ifndef MK_DUP_ATT
#define MK_DUP_ATT 1
#endif

typedef unsigned short bf16_t;
typedef short bf16x8 __attribute__((ext_vector_type(8)));
typedef short s16x4 __attribute__((ext_vector_type(4)));
typedef float f32x2 __attribute__((ext_vector_type(2)));
typedef float f32x4 __attribute__((ext_vector_type(4)));
typedef float f32x16 __attribute__((ext_vector_type(16)));
typedef unsigned u32x2 __attribute__((ext_vector_type(2)));
typedef unsigned u32x4 __attribute__((ext_vector_type(4)));
#define LAS __attribute__((address_space(3)))

constexpr int S = 16384, DM = 2048, DEPTH = 4, NPROJ = 4928, LDP = 5120, FF = 5632, NGU = 2 * FF;
constexpr float EPS = 1e-6f;
constexpr int C_AQ = 0, C_AK = 512, C_AV = 1024, C_BCQ = 1536, C_BCKV = 2048, C_BKPE = 2304, C_CQ = 2368, C_CK = 2880, C_CV = 3136, C_DQ = 3392, C_DK = 3904, C_DV = 4416;
constexpr int TOFF = 1408, TBLN = 2824;

constexpr size_t MiB = 1u << 20;
constexpr size_t WS_PAR = 0, WS_TBLA = 1 * MiB, WS_TBLD = 1 * MiB + 65536, WS_COS = 2 * MiB, WS_SIN = 4 * MiB;
constexpr size_t WS_BAR = 6 * MiB, WS_BAR_BYTES = 16384;
constexpr size_t WS_W = 8 * MiB, LW = 96 * MiB;
constexpr size_t W_IN = 0, W_UQ = 20 * MiB, W_UKV = 21 * MiB, W_OUT = 22 * MiB, W_GU = 30 * MiB, W_D = 74 * MiB;
constexpr size_t WS_H = 392 * MiB, WS_PROJ = 456 * MiB, WS_CQN = 616 * MiB, WS_CKVN = 632 * MiB, WS_KPE = 640 * MiB, WS_QC = 642 * MiB, WS_KC = 658 * MiB;
constexpr size_t WS_QB = 666 * MiB, WS_KVB = 690 * MiB, WS_MIX = 722 * MiB, WS_Y = 786 * MiB, WS_HID = 914 * MiB, WS_TMP = 1090 * MiB, WS_END = 1122 * MiB;

constexpr int LDS_ST_OFF = 163840 - 16;
constexpr int LDS_BYTES = 163840;

__device__ __forceinline__ float bf2f(unsigned short b) { return __uint_as_float(((unsigned)b) << 16); }
__device__ __forceinline__ unsigned f2bf(float f) { unsigned u = __float_as_uint(f); return (u + 0x7fffu + ((u >> 16) & 1u)) >> 16; }
__device__ __forceinline__ unsigned pk2(float lo, float hi) { return f2bf(lo) | (f2bf(hi) << 16); }
__device__ __forceinline__ unsigned cvt_pk_bf16(float lo, float hi) { unsigned r; asm volatile("v_cvt_pk_bf16_f32 %0, %1, %2" : "=v"(r) : "v"(lo), "v"(hi)); return r; }
__device__ __forceinline__ int lane_id_v() { int l; asm volatile("v_mbcnt_lo_u32_b32 %0, -1, 0\n\tv_mbcnt_hi_u32_b32 %0, -1, %0" : "=v"(l)); return l; }
template <int M> __device__ __forceinline__ float swz_xor(float v) { return __int_as_float(__builtin_amdgcn_ds_swizzle(__float_as_int(v), (M << 10) | 0x1f)); }
__device__ __forceinline__ float wave_sum(float v) {
    v += swz_xor<1>(v); v += swz_xor<2>(v); v += swz_xor<4>(v); v += swz_xor<8>(v); v += swz_xor<16>(v);
    auto rr = __builtin_amdgcn_permlane32_swap(__float_as_uint(v), __float_as_uint(v), false, false);
    return __uint_as_float(rr[0]) + __uint_as_float(rr[1]);
}

namespace pg8 {
constexpr int BM = 256, BK = 64, HALF = 128, HTB = HALF * BK * 2, STAGE_BYTES = 8 * HTB, NXCD = 8, WGM = 8;
__host__ __device__ __forceinline__ int lds_byte(int r, int c) { const int st = (r >> 4) * 2 + (c >> 5), rr = r & 15, cc = c & 31, ob = rr * 64 + cc * 2; return st * 1024 + (ob ^ (((ob >> 9) & 1) << 5)); }
__host__ __device__ __forceinline__ void stage_rc(int b, int& R, int& C) { const int st = b / 1024, sb = b % 1024, swz = sb ^ (((sb >> 9) & 1) << 5); R = (st >> 1) * 16 + swz / 64; C = (st & 1) * 32 + (swz % 64) / 2; }
__host__ __device__ __forceinline__ int perm32(int rho) { const int n = rho >> 4, i = rho & 15; return 8 * (i >> 2) + 4 * n + (i & 3); }

struct Unit { int pm, pn; };
struct Gemm { const bf16_t* A; const bf16_t* Bt; int M, N, K; };

struct StaticOrder {
    int nM, nN, nwg, G, c;
    __host__ __device__ void init(int M, int N, int G_, int c_) { nM = M / BM; nN = N / BM; nwg = nM * nN; G = G_; c = c_; }
    __host__ __device__ bool next(int i, Unit& u) const {
        const long L = (long)i * G + c; if (L >= nwg) return false;
        int wgid = (int)L; { const int q = nwg / NXCD, r = nwg % NXCD, xcd = wgid % NXCD, off = wgid / NXCD; wgid = (xcd < r ? xcd * (q + 1) : r * (q + 1) + (xcd - r) * q) + off; }
        const int nig = WGM * nN, gid = wgid / nig, fm = gid * WGM, gsz = (nM - fm) < WGM ? (nM - fm) : WGM;
        u.pm = fm + ((wgid % nig) % gsz); u.pn = (wgid % nig) / gsz; return true;
    }
    __device__ __forceinline__ void a_ready(const Unit&) const {}
    __device__ __forceinline__ void done(const Unit&) const {}
};

struct EpiBf16 {
    static constexpr bool PERM = true, AFTER_DRAIN = false;
    bf16_t* O; int ldc;
    __device__ __forceinline__ void operator()(const f32x4 (&acc)[2][2][4][2], const Unit& u, int wr, int wc, int fr, int fq) const {
        const int row0 = u.pm * BM + wr * 64 + fr; const int col0 = u.pn * BM + wc * 32 + 8 * fq;
#pragma unroll
        for (int ai = 0; ai < 2; ++ai)
#pragma unroll
            for (int m = 0; m < 4; ++m) { bf16_t* rowp = O + (size_t)(row0 + ai * HALF + m * 16) * ldc + col0;
#pragma unroll
                for (int bj = 0; bj < 2; ++bj) { const f32x4 v0 = acc[ai][bj][m][0], v1 = acc[ai][bj][m][1];
                    u32x4 w; w.x = cvt_pk_bf16(v0[0], v0[1]); w.y = cvt_pk_bf16(v0[2], v0[3]); w.z = cvt_pk_bf16(v1[0], v1[1]); w.w = cvt_pk_bf16(v1[2], v1[3]);
                    *(u32x4*)(rowp + bj * HALF) = w; } }
    }
};
struct EpiF32 {
    static constexpr bool PERM = false, AFTER_DRAIN = false;
    float* O; int ldc;
    __device__ __forceinline__ void operator()(const f32x4 (&acc)[2][2][4][2], const Unit& u, int wr, int wc, int fr, int fq) const {
        const int row0 = u.pm * BM + wr * 64 + fr; const int col0 = u.pn * BM + wc * 32 + 4 * fq;
#pragma unroll
        for (int ai = 0; ai < 2; ++ai)
#pragma unroll
            for (int m = 0; m < 4; ++m) { float* rowp = O + (size_t)(row0 + ai * HALF + m * 16) * ldc + col0;
#pragma unroll
                for (int bj = 0; bj < 2; ++bj)
#pragma unroll
                    for (int n = 0; n < 2; ++n) *(f32x4*)(rowp + bj * HALF + n * 16) = acc[ai][bj][m][n]; }
    }
};
__device__ __forceinline__ float silu_mul(float g, float u) {
    const float e = __builtin_amdgcn_exp2f(-g * 1.4426950408889634f);
    return g * __builtin_amdgcn_rcpf(1.0f + e) * u;
}
struct EpiSwiGLU {
    static constexpr bool PERM = true, AFTER_DRAIN = false;
    bf16_t* O; int ldc;
    __device__ __forceinline__ void operator()(const f32x4 (&acc)[2][2][4][2], const Unit& u, int wr, int wc, int fr, int fq) const {
        const int row0 = u.pm * BM + wr * 64 + fr; const int col0 = u.pn * HALF + wc * 32 + 8 * fq;
#pragma unroll
        for (int ai = 0; ai < 2; ++ai)
#pragma unroll
            for (int m = 0; m < 4; ++m) { bf16_t* rowp = O + (size_t)(row0 + ai * HALF + m * 16) * ldc + col0;
                const f32x4 g0 = acc[ai][0][m][0], g1 = acc[ai][0][m][1], u0 = acc[ai][1][m][0], u1 = acc[ai][1][m][1];
                u32x4 w; w.x = cvt_pk_bf16(silu_mul(g0[0], u0[0]), silu_mul(g0[1], u0[1])); w.y = cvt_pk_bf16(silu_mul(g0[2], u0[2]), silu_mul(g0[3], u0[3]));
                w.z = cvt_pk_bf16(silu_mul(g1[0], u1[0]), silu_mul(g1[1], u1[1])); w.w = cvt_pk_bf16(silu_mul(g1[2], u1[2]), silu_mul(g1[3], u1[3]));
                *(u32x4*)rowp = w; }
    }
};

template <class Epi, class Sched, bool ALIGN_EPI = false, bool SP2 = false>
__device__ __forceinline__ void gemm_phase(LAS unsigned char* lds, const Gemm g, const Sched& S, const Epi& E, const int wave0) {
    int tid_ = wave0 * 64 + lane_id_v();
    const int tid = tid_, wid = __builtin_amdgcn_readfirstlane(tid >> 6), lane = tid & 63, wr = wid >> 2, wc = wid & 3, fr = lane & 15, fq = lane >> 4;
    int K_ = g.K; asm volatile("" : "+s"(K_));
    const int K = K_, nt = K / BK;
    unsigned voffA[2], voffB[2];
#pragma unroll
    for (int i = 0; i < 2; ++i) { int R, C; stage_rc(tid * 16 + i * 8192, R, C); const int Rb = Epi::PERM ? ((R & ~31) + perm32(R & 31)) : R;
        voffA[i] = (unsigned)(R * K + C) * 2u; voffB[i] = (unsigned)(Rb * K + C) * 2u; }
    const size_t kstep = (size_t)(BK * 2);
    const size_t hstep = (size_t)HALF * K * 2;
    const size_t tstep = 2 * hstep;
    const unsigned ldsw = (unsigned)wid * 1024u;
    const int aoff = lds_byte(wr * 64 + fr, fq * 8), boff = lds_byte(wc * 32 + fr, fq * 8);
#define PG8_SA(b, h) (((b) * 2 + (h)) * HTB)
#define PG8_SB(b, h) ((4 + (b) * 2 + (h)) * HTB)
#define PG8_STAGE(bufoff, gbase, voff) do { _Pragma("unroll") for (int _i = 0; _i < 2; ++_i) \
        __builtin_amdgcn_global_load_lds((const unsigned*)((const char*)(gbase) + (voff)[_i]), (LAS unsigned*)(lds + (bufoff) + ldsw + _i * 8192), 16, 0, 0); } while (0)
#define PG8_LDA(dst, b, h) do { _Pragma("unroll") for (int m = 0; m < 4; ++m) _Pragma("unroll") for (int k = 0; k < 2; ++k) dst[m][k] = *(const LAS bf16x8*)(lds + PG8_SA(b, h) + aoff + m * 2048 + k * 1024); } while (0)
#define PG8_LDB(dst, b, h) do { _Pragma("unroll") for (int n = 0; n < 2; ++n) _Pragma("unroll") for (int k = 0; k < 2; ++k) dst[n][k] = *(const LAS bf16x8*)(lds + PG8_SB(b, h) + boff + n * 2048 + k * 1024); } while (0)
#define PG8_MMA(ai, bj, At, Bt) do { __builtin_amdgcn_s_setprio(1); _Pragma("unroll") for (int m = 0; m < 4; ++m) _Pragma("unroll") for (int n = 0; n < 2; ++n) _Pragma("unroll") for (int k = 0; k < 2; ++k) \
        acc[ai][bj][m][n] = __builtin_amdgcn_mfma_f32_16x16x32_bf16(Bt[n][k], At[m][k], acc[ai][bj][m][n], 0, 0, 0); __builtin_amdgcn_s_setprio(0); } while (0)
#define PG8_WAIT_V(n) asm volatile("s_waitcnt vmcnt(" #n ")" ::: "memory")
#define PG8_WAIT_L(n) asm volatile("s_waitcnt lgkmcnt(" #n ")" ::: "memory")
#define PG8_BAR __builtin_amdgcn_s_barrier()
#define PG8_SCHED __builtin_amdgcn_sched_barrier(0)
    Unit cur, nxt; int ui = 0;
    if (!S.next(0, cur)) return;
    f32x4 acc[2][2][4][2];
#pragma unroll
    for (int a = 0; a < 2; ++a)
#pragma unroll
        for (int b = 0; b < 2; ++b)
#pragma unroll
            for (int m = 0; m < 4; ++m)
#pragma unroll
                for (int n = 0; n < 2; ++n) acc[a][b][m][n] = (f32x4){0.f, 0.f, 0.f, 0.f};
    bf16x8 At[4][2], B0[2][2], B1[2][2];
    const char* cA = (const char*)g.A + (size_t)cur.pm * tstep; const char* cB = (const char*)g.Bt + (size_t)cur.pn * tstep;
    S.a_ready(cur);
    if constexpr (SP2) {
        PG8_STAGE(PG8_SB(0, 0), cB, voffB); PG8_STAGE(PG8_SB(0, 1), cB + hstep, voffB); PG8_STAGE(PG8_SA(0, 0), cA, voffA); PG8_STAGE(PG8_SA(0, 1), cA + hstep, voffA);
        if (wr == 1) PG8_BAR;
        PG8_WAIT_V(2); PG8_BAR;
        PG8_STAGE(PG8_SB(1, 0), cB + kstep, voffB); PG8_STAGE(PG8_SA(1, 0), cA + kstep, voffA); PG8_STAGE(PG8_SB(1, 1), cB + hstep + kstep, voffB);
        PG8_WAIT_V(6); PG8_BAR;
    } else {
        PG8_STAGE(PG8_SB(0, 0), cB, voffB); PG8_STAGE(PG8_SA(0, 0), cA, voffA); PG8_STAGE(PG8_SB(0, 1), cB + hstep, voffB); PG8_STAGE(PG8_SA(0, 1), cA + hstep, voffA);
        if (wr == 1) PG8_BAR;
        PG8_WAIT_V(4); PG8_BAR;
        PG8_STAGE(PG8_SB(1, 0), cB + kstep, voffB); PG8_STAGE(PG8_SA(1, 0), cA + kstep, voffA); PG8_STAGE(PG8_SB(1, 1), cB + hstep + kstep, voffB);
        PG8_WAIT_V(6); PG8_BAR;
    }
    for (;;) {
        const bool has_next = S.next(ui + 1, nxt);
        const char* nA = has_next ? (const char*)g.A + (size_t)nxt.pm * tstep : cA; const char* nB = has_next ? (const char*)g.Bt + (size_t)nxt.pn * tstep : cB;
        for (int t = 0; t < nt; t += 2) {
            const bool last = (t == nt - 2);
            const char* a1 = cA + (size_t)(t + 1) * kstep;
            const char* a2 = last ? nA : cA + (size_t)(t + 2) * kstep; const char* b2 = last ? nB : cB + (size_t)(t + 2) * kstep;
            const char* a3 = a2 + kstep; const char* b3 = b2 + kstep;
            if (last && has_next) S.a_ready(nxt);
            if constexpr (SP2) {
            PG8_LDB(B0, 0, 0); PG8_LDB(B1, 0, 1); PG8_SCHED; PG8_LDA(At, 0, 0); PG8_STAGE(PG8_SA(1, 1), a1 + hstep, voffA);
            PG8_WAIT_V(8); PG8_WAIT_L(0); PG8_BAR; PG8_MMA(0, 0, At, B0); PG8_MMA(0, 1, At, B1); PG8_BAR; PG8_SCHED;
            PG8_LDA(At, 0, 1); PG8_STAGE(PG8_SB(0, 0), b2, voffB); PG8_STAGE(PG8_SB(0, 1), b2 + hstep, voffB); PG8_STAGE(PG8_SA(0, 0), a2, voffA);
            PG8_WAIT_V(8); PG8_WAIT_L(0); PG8_BAR; PG8_MMA(1, 0, At, B0); PG8_MMA(1, 1, At, B1); PG8_BAR; PG8_SCHED;
            PG8_LDB(B0, 1, 0); PG8_LDB(B1, 1, 1); PG8_SCHED; PG8_LDA(At, 1, 0); PG8_STAGE(PG8_SA(0, 1), a2 + hstep, voffA);
            PG8_WAIT_V(8); PG8_WAIT_L(0); PG8_BAR; PG8_MMA(0, 0, At, B0); PG8_MMA(0, 1, At, B1); PG8_BAR; PG8_SCHED;
            PG8_LDA(At, 1, 1); PG8_STAGE(PG8_SB(1, 0), b3, voffB); PG8_STAGE(PG8_SB(1, 1), b3 + hstep, voffB); PG8_STAGE(PG8_SA(1, 0), a3, voffA);
            PG8_WAIT_V(8); PG8_WAIT_L(0); PG8_BAR; PG8_MMA(1, 0, At, B0); PG8_MMA(1, 1, At, B1); PG8_BAR; PG8_SCHED;
            } else {
            PG8_LDB(B0, 0, 0); PG8_SCHED; PG8_LDA(At, 0, 0); PG8_STAGE(PG8_SA(1, 1), a1 + hstep, voffA);
            PG8_WAIT_L(8); PG8_BAR; PG8_WAIT_L(0); PG8_MMA(0, 0, At, B0); PG8_BAR; PG8_SCHED;
            PG8_LDB(B1, 0, 1); PG8_STAGE(PG8_SB(0, 0), b2, voffB);
            PG8_BAR; PG8_WAIT_L(0); PG8_MMA(0, 1, At, B1); PG8_BAR;
            PG8_LDA(At, 0, 1); PG8_STAGE(PG8_SA(0, 0), a2, voffA);
            PG8_BAR; PG8_WAIT_L(0); PG8_MMA(1, 0, At, B0); PG8_BAR; PG8_SCHED;
            PG8_STAGE(PG8_SB(0, 1), b2 + hstep, voffB);
            PG8_WAIT_V(6); PG8_BAR; PG8_MMA(1, 1, At, B1); PG8_BAR;
            PG8_LDB(B0, 1, 0); PG8_SCHED; PG8_LDA(At, 1, 0); PG8_STAGE(PG8_SA(0, 1), a2 + hstep, voffA);
            PG8_WAIT_L(8); PG8_BAR; PG8_WAIT_L(0); PG8_MMA(0, 0, At, B0); PG8_BAR; PG8_SCHED;
            PG8_LDB(B1, 1, 1); PG8_STAGE(PG8_SB(1, 0), b3, voffB);
            PG8_BAR; PG8_WAIT_L(0); PG8_MMA(0, 1, At, B1); PG8_BAR;
            PG8_LDA(At, 1, 1); PG8_STAGE(PG8_SA(1, 0), a3, voffA);
            PG8_BAR; PG8_WAIT_L(0); PG8_MMA(1, 0, At, B0); PG8_BAR; PG8_SCHED;
            PG8_STAGE(PG8_SB(1, 1), b3 + hstep, voffB);
            PG8_WAIT_V(6); PG8_BAR; PG8_MMA(1, 1, At, B1); PG8_BAR;
            }
        }
        if constexpr (ALIGN_EPI) { if (wr == 0) PG8_BAR; }
        if constexpr (!Epi::AFTER_DRAIN) { E(acc, cur, wr, wc, fr, fq); S.done(cur); }
        if (!has_next) break;
#pragma unroll
        for (int a = 0; a < 2; ++a)
#pragma unroll
            for (int b = 0; b < 2; ++b)
#pragma unroll
                for (int m = 0; m < 4; ++m)
#pragma unroll
                    for (int n = 0; n < 2; ++n) acc[a][b][m][n] = (f32x4){0.f, 0.f, 0.f, 0.f};
        cur = nxt; cA = nA; cB = nB; ++ui;
        if constexpr (ALIGN_EPI) { if (wr == 1) PG8_BAR; }
    }
    PG8_WAIT_V(0);
    if constexpr (!ALIGN_EPI) { if (wr == 0) PG8_BAR; }
    PG8_BAR;
#undef PG8_SA
#undef PG8_SB
#undef PG8_STAGE
#undef PG8_LDA
#undef PG8_LDB
#undef PG8_MMA
#undef PG8_WAIT_V
#undef PG8_WAIT_L
#undef PG8_BAR
#undef PG8_SCHED
}
}

namespace att {
constexpr int NW = 8, QBLK = 32, KVBLK = 64;
constexpr int SHM_V = KVBLK * 128 * 2;
#define SBAR() __builtin_amdgcn_sched_barrier(0)
__device__ __forceinline__ int crow(int r, int hi) { return (r & 3) + 8 * (r >> 2) + 4 * hi; }
__device__ __forceinline__ unsigned cvtpk(float lo, float hi) { unsigned r; asm volatile("v_cvt_pk_bf16_f32 %0, %1, %2" : "=v"(r) : "v"(lo), "v"(hi)); return r; }

constexpr float THR2 = 8.0f * 1.4426950408889634f;
template <bool FIRST>
__device__ __forceinline__ void partialSM(f32x16& p0, f32x16& p1, float& mC, float& alpha) {
  float mx_[4] = {p0[0], p0[1], p0[2], p0[3]};
#pragma unroll
  for (int r = 4; r < 16; ++r) mx_[r & 3] = fmaxf(mx_[r & 3], p0[r]);
#pragma unroll
  for (int r = 0; r < 16; ++r) mx_[r & 3] = fmaxf(mx_[r & 3], p1[r]);
  float pmax = fmaxf(fmaxf(mx_[0], mx_[1]), fmaxf(mx_[2], mx_[3]));
  { auto rr = __builtin_amdgcn_permlane32_swap(__float_as_uint(pmax), __float_as_uint(pmax), false, false);
    pmax = fmaxf(__uint_as_float(rr[0]), __uint_as_float(rr[1])); }
  if (!FIRST && __builtin_expect(__all(pmax <= THR2), 1)) { alpha = 1.f; }
  else { const float delta = FIRST ? fmaxf(pmax, -200.f) : fmaxf(pmax, 0.f); alpha = FIRST ? 1.f : __builtin_amdgcn_exp2f(-delta); mC += delta;
#pragma unroll
    for (int r = 0; r < 16; ++r) p0[r] -= delta;
#pragma unroll
    for (int r = 0; r < 16; ++r) p1[r] -= delta; }
#pragma unroll
  for (int r = 0; r < 16; ++r) p0[r] = __builtin_amdgcn_exp2f(p0[r]);
}
template <bool EXP1 = true>
__device__ __forceinline__ void finishSM(f32x16& p0, f32x16& p1, float alpha, float& l_reg, bf16x8& pa0, bf16x8& pa1, bf16x8& pa2, bf16x8& pa3) {
  if constexpr (EXP1) {
#pragma unroll
  for (int r = 0; r < 16; ++r) p1[r] = __builtin_amdgcn_exp2f(p1[r]);
  }
  float sm_[4] = {p0[0], p0[1], p0[2], p0[3]};
#pragma unroll
  for (int r = 4; r < 16; ++r) sm_[r & 3] += p0[r];
#pragma unroll
  for (int r = 0; r < 16; ++r) sm_[r & 3] += p1[r];
  float ps = (sm_[0] + sm_[1]) + (sm_[2] + sm_[3]);
  { auto rr = __builtin_amdgcn_permlane32_swap(__float_as_uint(ps), __float_as_uint(ps), false, false);
    ps = __uint_as_float(rr[0]) + __uint_as_float(rr[1]); }
  l_reg = l_reg * alpha + ps;
#define PK4(P, BASE, OUT) do { unsigned a0 = cvtpk(P[BASE + 0], P[BASE + 1]), a1 = cvtpk(P[BASE + 2], P[BASE + 3]);   \
    unsigned b0 = cvtpk(P[BASE + 4], P[BASE + 5]), b1 = cvtpk(P[BASE + 6], P[BASE + 7]);                              \
    auto r0 = __builtin_amdgcn_permlane32_swap(a0, b0, false, false); auto r1 = __builtin_amdgcn_permlane32_swap(a1, b1, false, false); \
    u32x4 w = {r0[0], r1[0], r0[1], r1[1]}; OUT = *reinterpret_cast<bf16x8*>(&w); } while (0)
  PK4(p0, 0, pa0); PK4(p0, 8, pa1); PK4(p1, 0, pa2); PK4(p1, 8, pa3);
#undef PK4
}
template <int NDQ, int NQL>
__device__ __forceinline__ void qkt(f32x16& p0, f32x16& p1, const f32x16& negm, const char* Ks, const bf16x8* qr, const char* qls, int r32, int hi) {
  constexpr int ROWB = NDQ * 32, NQR = NDQ - NQL, SWM = (NDQ == 8) ? 15 : 7;
#pragma unroll
  for (int d0 = 0; d0 < NDQ; ++d0) { const int cb = (d0 * 16 + hi * 8) * 2;
    bf16x8 b0 = *reinterpret_cast<const bf16x8*>(Ks + r32 * ROWB + (cb ^ ((r32 & SWM) << 4)));
    bf16x8 b1 = *reinterpret_cast<const bf16x8*>(Ks + (32 + r32) * ROWB + (cb ^ ((r32 & SWM) << 4)));
    bf16x8 q;
    if constexpr (NQL > 0) { if (d0 < NQR) q = qr[d0 < NQR ? d0 : 0]; else q = *reinterpret_cast<const bf16x8*>(qls + (d0 - NQR) * 1024); }
    else q = qr[d0];
    if (d0 == 0) { p0 = __builtin_amdgcn_mfma_f32_32x32x16_bf16(b0, q, negm, 0, 0, 0); p1 = __builtin_amdgcn_mfma_f32_32x32x16_bf16(b1, q, negm, 0, 0, 0); }
    else { p0 = __builtin_amdgcn_mfma_f32_32x32x16_bf16(b0, q, p0, 0, 0, 0); p1 = __builtin_amdgcn_mfma_f32_32x32x16_bf16(b1, q, p1, 0, 0, 0); } }
}
template <int OFF> __device__ __forceinline__ bf16x8 lds_rd128(int a) { bf16x8 r; asm volatile("ds_read_b128 %0, %1 offset:%2" : "=&v"(r) : "v"(a), "i"(OFF) : "memory"); return r; }
#define SBAR_M() __builtin_amdgcn_sched_barrier(0)
__device__ __forceinline__ void qkt8_roll(f32x16& p0, f32x16& p1, const f32x16& negm, int kb, const bf16x8* qr) {
  const int a0 = kb ^ (0 << 5); const bf16x8 x0 = lds_rd128<0>(a0), y0 = lds_rd128<8192>(a0);
  const int a1 = kb ^ (1 << 5); const bf16x8 x1 = lds_rd128<0>(a1), y1 = lds_rd128<8192>(a1);
  const int a2 = kb ^ (2 << 5); const bf16x8 x2 = lds_rd128<0>(a2), y2 = lds_rd128<8192>(a2);
  asm volatile("s_waitcnt lgkmcnt(4)" ::: "memory"); SBAR_M();
  p0 = __builtin_amdgcn_mfma_f32_32x32x16_bf16(x0, qr[0], negm, 0, 0, 0); p1 = __builtin_amdgcn_mfma_f32_32x32x16_bf16(y0, qr[0], negm, 0, 0, 0);
  const int a3 = kb ^ (3 << 5); const bf16x8 x3 = lds_rd128<0>(a3), y3 = lds_rd128<8192>(a3);
  asm volatile("s_waitcnt lgkmcnt(4)" ::: "memory"); SBAR_M();
  p0 = __builtin_amdgcn_mfma_f32_32x32x16_bf16(x1, qr[1], p0, 0, 0, 0); p1 = __builtin_amdgcn_mfma_f32_32x32x16_bf16(y1, qr[1], p1, 0, 0, 0);
  const int a4 = kb ^ (4 << 5); const bf16x8 x4 = lds_rd128<0>(a4), y4 = lds_rd128<8192>(a4);
  asm volatile("s_waitcnt lgkmcnt(4)" ::: "memory"); SBAR_M();
  p0 = __builtin_amdgcn_mfma_f32_32x32x16_bf16(x2, qr[2], p0, 0, 0, 0); p1 = __builtin_amdgcn_mfma_f32_32x32x16_bf16(y2, qr[2], p1, 0, 0, 0);
  const int a5 = kb ^ (5 << 5); const bf16x8 x5 = lds_rd128<0>(a5), y5 = lds_rd128<8192>(a5);
  asm volatile("s_waitcnt lgkmcnt(4)" ::: "memory"); SBAR_M();
  p0 = __builtin_amdgcn_mfma_f32_32x32x16_bf16(x3, qr[3], p0, 0, 0, 0); p1 = __builtin_amdgcn_mfma_f32_32x32x16_bf16(y3, qr[3], p1, 0, 0, 0);
  const int a6 = kb ^ (6 << 5); const bf16x8 x6 = lds_rd128<0>(a6), y6 = lds_rd128<8192>(a6);
  asm volatile("s_waitcnt lgkmcnt(4)" ::: "memory"); SBAR_M();
  p0 = __builtin_amdgcn_mfma_f32_32x32x16_bf16(x4, qr[4], p0, 0, 0, 0); p1 = __builtin_amdgcn_mfma_f32_32x32x16_bf16(y4, qr[4], p1, 0, 0, 0);
  const int a7 = kb ^ (7 << 5); const bf16x8 x7 = lds_rd128<0>(a7), y7 = lds_rd128<8192>(a7);
  asm volatile("s_waitcnt lgkmcnt(4)" ::: "memory"); SBAR_M();
  p0 = __builtin_amdgcn_mfma_f32_32x32x16_bf16(x5, qr[5], p0, 0, 0, 0); p1 = __builtin_amdgcn_mfma_f32_32x32x16_bf16(y5, qr[5], p1, 0, 0, 0);
  asm volatile("s_waitcnt lgkmcnt(2)" ::: "memory"); SBAR_M();
  p0 = __builtin_amdgcn_mfma_f32_32x32x16_bf16(x6, qr[6], p0, 0, 0, 0); p1 = __builtin_amdgcn_mfma_f32_32x32x16_bf16(y6, qr[6], p1, 0, 0, 0);
  asm volatile("s_waitcnt lgkmcnt(0)" ::: "memory"); SBAR_M();
  p0 = __builtin_amdgcn_mfma_f32_32x32x16_bf16(x7, qr[7], p0, 0, 0, 0); p1 = __builtin_amdgcn_mfma_f32_32x32x16_bf16(y7, qr[7], p1, 0, 0, 0);
}

#define PK4S(P, BASE, OUT) do { unsigned a0 = cvtpk(P[BASE + 0], P[BASE + 1]), a1 = cvtpk(P[BASE + 2], P[BASE + 3]);   \
    unsigned b0 = cvtpk(P[BASE + 4], P[BASE + 5]), b1 = cvtpk(P[BASE + 6], P[BASE + 7]);                              \
    auto r0 = __builtin_amdgcn_permlane32_swap(a0, b0, false, false); auto r1 = __builtin_amdgcn_permlane32_swap(a1, b1, false, false); \
    u32x4 w = {r0[0], r1[0], r0[1], r1[1]}; OUT = *reinterpret_cast<bf16x8*>(&w); } while (0)
template <int K>
__device__ __forceinline__ void fsm_slice(f32x16& p0, f32x16& p1, float alpha, float& l_reg, bf16x8& pa0, bf16x8& pa1, bf16x8& pa2, bf16x8& pa3, float (&sm)[4]) {
  if constexpr (K == 2) {
    sm[0] = p0[0]; sm[1] = p0[1]; sm[2] = p0[2]; sm[3] = p0[3];
#pragma unroll
    for (int r = 4; r < 16; ++r) sm[r & 3] += p0[r];
  } else if constexpr (K == 3) {
#pragma unroll
    for (int r = 0; r < 16; ++r) sm[r & 3] += p1[r];
  } else if constexpr (K == 4) {
    float ps = (sm[0] + sm[1]) + (sm[2] + sm[3]);
    { auto rr = __builtin_amdgcn_permlane32_swap(__float_as_uint(ps), __float_as_uint(ps), false, false);
      ps = __uint_as_float(rr[0]) + __uint_as_float(rr[1]); }
    l_reg = l_reg * alpha + ps;
    PK4S(p0, 0, pa0);
  } else if constexpr (K == 5) { PK4S(p0, 8, pa1);
  } else if constexpr (K == 6) { PK4S(p1, 0, pa2);
  } else if constexpr (K == 7) { PK4S(p1, 8, pa3); }
}
template <int K>
__device__ __forceinline__ void psm_slice(f32x16& p0, f32x16& p1, float& mC, float& alpha, float (&mx)[4]) {
  if constexpr (K == 0) { mx[0] = p0[0]; mx[1] = p0[1]; mx[2] = p0[2]; mx[3] = p0[3]; }
  else if constexpr (K >= 1 && K <= 3) {
#pragma unroll
    for (int r = 4 * K; r < 4 * K + 4; ++r) mx[r & 3] = fmaxf(mx[r & 3], p0[r]);
  } else if constexpr (K >= 4 && K <= 7) {
#pragma unroll
    for (int r = 4 * (K - 4); r < 4 * (K - 4) + 4; ++r) mx[r & 3] = fmaxf(mx[r & 3], p1[r]);
  } else if constexpr (K == 8) {
    float pmax = fmaxf(fmaxf(mx[0], mx[1]), fmaxf(mx[2], mx[3]));
    { auto rr = __builtin_amdgcn_permlane32_swap(__float_as_uint(pmax), __float_as_uint(pmax), false, false);
      pmax = fmaxf(__uint_as_float(rr[0]), __uint_as_float(rr[1])); }
    if (__builtin_expect(__all(pmax <= THR2), 1)) { alpha = 1.f; }
    else { const float delta = fmaxf(pmax, 0.f); alpha = __builtin_amdgcn_exp2f(-delta); mC += delta;
#pragma unroll
      for (int r = 0; r < 16; ++r) p0[r] -= delta;
#pragma unroll
      for (int r = 0; r < 16; ++r) p1[r] -= delta; }
  } else if constexpr (K >= 9 && K <= 12) {
#pragma unroll
    for (int r = 4 * (K - 9); r < 4 * (K - 9) + 4; ++r) p0[r] = __builtin_amdgcn_exp2f(p0[r]);
  } else if constexpr (K >= 13 && K <= 15) {
#pragma unroll
    for (int r = (K == 13 ? 0 : K == 14 ? 6 : 11); r < (K == 13 ? 6 : K == 14 ? 11 : 16); ++r) p1[r] = __builtin_amdgcn_exp2f(p1[r]);
  }
}
__device__ __forceinline__ int v_st(int k, int c) { const int kk = (k & ~0xC) | ((k & 4) << 1) | ((k & 8) >> 1); return ((kk >> 3) * 4 + (c >> 5)) * 512 + ((kk & 7) * 32 + (c & 31)) * 2; }
__device__ __forceinline__ int v_rd_base(int lane) { return ((lane & 3) << 3) | (((lane >> 2) & 3) << 6) | (((lane >> 4) & 1) << 5) | (((lane >> 5) & 1) << 8); }
constexpr int v_rd_off(int d0, int ks, int half) { return d0 * 512 + ks * 4096 + half * 2048; }
template <int OFF> __device__ __forceinline__ s16x4 tr_read(int vb) {
  s16x4 r; asm volatile("ds_read_b64_tr_b16 %0, %1 offset:%2" : "=&v"(r) : "v"(vb), "i"(OFF) : "memory"); return r;
}
template <int D0> __device__ __forceinline__ void pv_one(f32x16& od, int vb, bf16x8 pa0, bf16x8 pa1, bf16x8 pa2, bf16x8 pa3) {
  const s16x4 l0 = tr_read<v_rd_off(D0, 0, 0)>(vb), h0 = tr_read<v_rd_off(D0, 0, 1)>(vb), l1 = tr_read<v_rd_off(D0, 1, 0)>(vb), h1 = tr_read<v_rd_off(D0, 1, 1)>(vb);
  const s16x4 l2 = tr_read<v_rd_off(D0, 2, 0)>(vb), h2 = tr_read<v_rd_off(D0, 2, 1)>(vb), l3 = tr_read<v_rd_off(D0, 3, 0)>(vb), h3 = tr_read<v_rd_off(D0, 3, 1)>(vb);
  asm volatile("s_waitcnt lgkmcnt(0)" ::: "memory"); SBAR();
#define PK(L, H) (bf16x8){L[0], L[1], L[2], L[3], H[0], H[1], H[2], H[3]}
  od = __builtin_amdgcn_mfma_f32_32x32x16_bf16(pa0, PK(l0, h0), od, 0, 0, 0);
  od = __builtin_amdgcn_mfma_f32_32x32x16_bf16(pa1, PK(l1, h1), od, 0, 0, 0);
  od = __builtin_amdgcn_mfma_f32_32x32x16_bf16(pa2, PK(l2, h2), od, 0, 0, 0);
  od = __builtin_amdgcn_mfma_f32_32x32x16_bf16(pa3, PK(l3, h3), od, 0, 0, 0);
#undef PK
}
__device__ __forceinline__ void pv_d0(f32x16* o, int vb, bf16x8 pa0, bf16x8 pa1, bf16x8 pa2, bf16x8 pa3) {
#define PK(L, H) (bf16x8){L[0], L[1], L[2], L[3], H[0], H[1], H[2], H[3]}
  const s16x4 l0 = tr_read<v_rd_off(0, 0, 0)>(vb), h0 = tr_read<v_rd_off(0, 0, 1)>(vb);
  const s16x4 l1 = tr_read<v_rd_off(0, 1, 0)>(vb), h1 = tr_read<v_rd_off(0, 1, 1)>(vb);
  const s16x4 l2 = tr_read<v_rd_off(0, 2, 0)>(vb), h2 = tr_read<v_rd_off(0, 2, 1)>(vb);
  const s16x4 l3 = tr_read<v_rd_off(0, 3, 0)>(vb), h3 = tr_read<v_rd_off(0, 3, 1)>(vb);
  const s16x4 l4 = tr_read<v_rd_off(1, 0, 0)>(vb), h4 = tr_read<v_rd_off(1, 0, 1)>(vb);
  asm volatile("s_waitcnt lgkmcnt(8)" ::: "memory"); SBAR();
  o[0] = __builtin_amdgcn_mfma_f32_32x32x16_bf16(pa0, PK(l0, h0), o[0], 0, 0, 0);
  const s16x4 l5 = tr_read<v_rd_off(1, 1, 0)>(vb), h5 = tr_read<v_rd_off(1, 1, 1)>(vb);
  asm volatile("s_waitcnt lgkmcnt(8)" ::: "memory"); SBAR();
  o[0] = __builtin_amdgcn_mfma_f32_32x32x16_bf16(pa1, PK(l1, h1), o[0], 0, 0, 0);
  const s16x4 l6 = tr_read<v_rd_off(1, 2, 0)>(vb), h6 = tr_read<v_rd_off(1, 2, 1)>(vb);
  asm volatile("s_waitcnt lgkmcnt(8)" ::: "memory"); SBAR();
  o[0] = __builtin_amdgcn_mfma_f32_32x32x16_bf16(pa2, PK(l2, h2), o[0], 0, 0, 0);
  const s16x4 l7 = tr_read<v_rd_off(1, 3, 0)>(vb), h7 = tr_read<v_rd_off(1, 3, 1)>(vb);
  asm volatile("s_waitcnt lgkmcnt(8)" ::: "memory"); SBAR();
  o[0] = __builtin_amdgcn_mfma_f32_32x32x16_bf16(pa3, PK(l3, h3), o[0], 0, 0, 0);
  const s16x4 l8 = tr_read<v_rd_off(2, 0, 0)>(vb), h8 = tr_read<v_rd_off(2, 0, 1)>(vb);
  asm volatile("s_waitcnt lgkmcnt(8)" ::: "memory"); SBAR();
  o[1] = __builtin_amdgcn_mfma_f32_32x32x16_bf16(pa0, PK(l4, h4), o[1], 0, 0, 0);
  const s16x4 l9 = tr_read<v_rd_off(2, 1, 0)>(vb), h9 = tr_read<v_rd_off(2, 1, 1)>(vb);
  asm volatile("s_waitcnt lgkmcnt(8)" ::: "memory"); SBAR();
  o[1] = __builtin_amdgcn_mfma_f32_32x32x16_bf16(pa1, PK(l5, h5), o[1], 0, 0, 0);
  const s16x4 l10 = tr_read<v_rd_off(2, 2, 0)>(vb), h10 = tr_read<v_rd_off(2, 2, 1)>(vb);
  asm volatile("s_waitcnt lgkmcnt(8)" ::: "memory"); SBAR();
  o[1] = __builtin_amdgcn_mfma_f32_32x32x16_bf16(pa2, PK(l6, h6), o[1], 0, 0, 0);
  const s16x4 l11 = tr_read<v_rd_off(2, 3, 0)>(vb), h11 = tr_read<v_rd_off(2, 3, 1)>(vb);
  asm volatile("s_waitcnt lgkmcnt(8)" ::: "memory"); SBAR();
  o[1] = __builtin_amdgcn_mfma_f32_32x32x16_bf16(pa3, PK(l7, h7), o[1], 0, 0, 0);
  const s16x4 l12 = tr_read<v_rd_off(3, 0, 0)>(vb), h12 = tr_read<v_rd_off(3, 0, 1)>(vb);
  asm volatile("s_waitcnt lgkmcnt(8)" ::: "memory"); SBAR();
  o[2] = __builtin_amdgcn_mfma_f32_32x32x16_bf16(pa0, PK(l8, h8), o[2], 0, 0, 0);
  const s16x4 l13 = tr_read<v_rd_off(3, 1, 0)>(vb), h13 = tr_read<v_rd_off(3, 1, 1)>(vb);
  asm volatile("s_waitcnt lgkmcnt(8)" ::: "memory"); SBAR();
  o[2] = __builtin_amdgcn_mfma_f32_32x32x16_bf16(pa1, PK(l9, h9), o[2], 0, 0, 0);
  const s16x4 l14 = tr_read<v_rd_off(3, 2, 0)>(vb), h14 = tr_read<v_rd_off(3, 2, 1)>(vb);
  asm volatile("s_waitcnt lgkmcnt(8)" ::: "memory"); SBAR();
  o[2] = __builtin_amdgcn_mfma_f32_32x32x16_bf16(pa2, PK(l10, h10), o[2], 0, 0, 0);
  const s16x4 l15 = tr_read<v_rd_off(3, 3, 0)>(vb), h15 = tr_read<v_rd_off(3, 3, 1)>(vb);
  asm volatile("s_waitcnt lgkmcnt(8)" ::: "memory"); SBAR();
  o[2] = __builtin_amdgcn_mfma_f32_32x32x16_bf16(pa3, PK(l11, h11), o[2], 0, 0, 0);
  asm volatile("s_waitcnt lgkmcnt(6)" ::: "memory"); SBAR();
  o[3] = __builtin_amdgcn_mfma_f32_32x32x16_bf16(pa0, PK(l12, h12), o[3], 0, 0, 0);
  asm volatile("s_waitcnt lgkmcnt(4)" ::: "memory"); SBAR();
  o[3] = __builtin_amdgcn_mfma_f32_32x32x16_bf16(pa1, PK(l13, h13), o[3], 0, 0, 0);
  asm volatile("s_waitcnt lgkmcnt(2)" ::: "memory"); SBAR();
  o[3] = __builtin_amdgcn_mfma_f32_32x32x16_bf16(pa2, PK(l14, h14), o[3], 0, 0, 0);
  asm volatile("s_waitcnt lgkmcnt(0)" ::: "memory"); SBAR();
  o[3] = __builtin_amdgcn_mfma_f32_32x32x16_bf16(pa3, PK(l15, h15), o[3], 0, 0, 0);
#undef PK
}

__device__ __forceinline__ void qkt8_fsm(f32x16& p0, f32x16& p1, const f32x16& negm, int kb, const bf16x8* qr, f32x16& q0p, f32x16& q1p, float alpha, float& l_reg, bf16x8& pa0, bf16x8& pa1, bf16x8& pa2, bf16x8& pa3) {
  float sm[4];
  const int a0 = kb ^ (0 << 5); const bf16x8 x0 = lds_rd128<0>(a0), y0 = lds_rd128<8192>(a0);
  const int a1 = kb ^ (1 << 5); const bf16x8 x1 = lds_rd128<0>(a1), y1 = lds_rd128<8192>(a1);
  const int a2 = kb ^ (2 << 5); const bf16x8 x2 = lds_rd128<0>(a2), y2 = lds_rd128<8192>(a2);
  asm volatile("s_waitcnt lgkmcnt(4)" ::: "memory"); SBAR();
  p0 = __builtin_amdgcn_mfma_f32_32x32x16_bf16(x0, qr[0], negm, 0, 0, 0); p1 = __builtin_amdgcn_mfma_f32_32x32x16_bf16(y0, qr[0], negm, 0, 0, 0);
  fsm_slice<0>(q0p, q1p, alpha, l_reg, pa0, pa1, pa2, pa3, sm); SBAR();
  const int a3 = kb ^ (3 << 5); const bf16x8 x3 = lds_rd128<0>(a3), y3 = lds_rd128<8192>(a3);
  asm volatile("s_waitcnt lgkmcnt(4)" ::: "memory"); SBAR();
  p0 = __builtin_amdgcn_mfma_f32_32x32x16_bf16(x1, qr[1], p0, 0, 0, 0); p1 = __builtin_amdgcn_mfma_f32_32x32x16_bf16(y1, qr[1], p1, 0, 0, 0);
  fsm_slice<1>(q0p, q1p, alpha, l_reg, pa0, pa1, pa2, pa3, sm); SBAR();
  const int a4 = kb ^ (4 << 5); const bf16x8 x4 = lds_rd128<0>(a4), y4 = lds_rd128<8192>(a4);
  asm volatile("s_waitcnt lgkmcnt(4)" ::: "memory"); SBAR();
  p0 = __builtin_amdgcn_mfma_f32_32x32x16_bf16(x2, qr[2], p0, 0, 0, 0); p1 = __builtin_amdgcn_mfma_f32_32x32x16_bf16(y2, qr[2], p1, 0, 0, 0);
  fsm_slice<2>(q0p, q1p, alpha, l_reg, pa0, pa1, pa2, pa3, sm); SBAR();
  const int a5 = kb ^ (5 << 5); const bf16x8 x5 = lds_rd128<0>(a5), y5 = lds_rd128<8192>(a5);
  asm volatile("s_waitcnt lgkmcnt(4)" ::: "memory"); SBAR();
  p0 = __builtin_amdgcn_mfma_f32_32x32x16_bf16(x3, qr[3], p0, 0, 0, 0); p1 = __builtin_amdgcn_mfma_f32_32x32x16_bf16(y3, qr[3], p1, 0, 0, 0);
  fsm_slice<3>(q0p, q1p, alpha, l_reg, pa0, pa1, pa2, pa3, sm); SBAR();
  const int a6 = kb ^ (6 << 5); const bf16x8 x6 = lds_rd128<0>(a6), y6 = lds_rd128<8192>(a6);
  asm volatile("s_waitcnt lgkmcnt(4)" ::: "memory"); SBAR();
  p0 = __builtin_amdgcn_mfma_f32_32x32x16_bf16(x4, qr[4], p0, 0, 0, 0); p1 = __builtin_amdgcn_mfma_f32_32x32x16_bf16(y4, qr[4], p1, 0, 0, 0);
  fsm_slice<4>(q0p, q1p, alpha, l_reg, pa0, pa1, pa2, pa3, sm); SBAR();
  const int a7 = kb ^ (7 << 5); const bf16x8 x7 = lds_rd128<0>(a7), y7 = lds_rd128<8192>(a7);
  asm volatile("s_waitcnt lgkmcnt(4)" ::: "memory"); SBAR();
  p0 = __builtin_amdgcn_mfma_f32_32x32x16_bf16(x5, qr[5], p0, 0, 0, 0); p1 = __builtin_amdgcn_mfma_f32_32x32x16_bf16(y5, qr[5], p1, 0, 0, 0);
  fsm_slice<5>(q0p, q1p, alpha, l_reg, pa0, pa1, pa2, pa3, sm); SBAR();
  asm volatile("s_waitcnt lgkmcnt(2)" ::: "memory"); SBAR();
  p0 = __builtin_amdgcn_mfma_f32_32x32x16_bf16(x6, qr[6], p0, 0, 0, 0); p1 = __builtin_amdgcn_mfma_f32_32x32x16_bf16(y6, qr[6], p1, 0, 0, 0);
  fsm_slice<6>(q0p, q1p, alpha, l_reg, pa0, pa1, pa2, pa3, sm); SBAR();
  asm volatile("s_waitcnt lgkmcnt(0)" ::: "memory"); SBAR();
  p0 = __builtin_amdgcn_mfma_f32_32x32x16_bf16(x7, qr[7], p0, 0, 0, 0); p1 = __builtin_amdgcn_mfma_f32_32x32x16_bf16(y7, qr[7], p1, 0, 0, 0);
  fsm_slice<7>(q0p, q1p, alpha, l_reg, pa0, pa1, pa2, pa3, sm); SBAR();
}
__device__ __forceinline__ void pv_psm(f32x16* o, int vb, bf16x8 pa0, bf16x8 pa1, bf16x8 pa2, bf16x8 pa3, f32x16& n0, f32x16& n1, float& mC, float& alpha) {
  float mx[4];
#define PK(L, H) (bf16x8){L[0], L[1], L[2], L[3], H[0], H[1], H[2], H[3]}
  const s16x4 l0 = tr_read<v_rd_off(0, 0, 0)>(vb), h0 = tr_read<v_rd_off(0, 0, 1)>(vb);
  const s16x4 l1 = tr_read<v_rd_off(0, 1, 0)>(vb), h1 = tr_read<v_rd_off(0, 1, 1)>(vb);
  const s16x4 l2 = tr_read<v_rd_off(0, 2, 0)>(vb), h2 = tr_read<v_rd_off(0, 2, 1)>(vb);
  const s16x4 l3 = tr_read<v_rd_off(0, 3, 0)>(vb), h3 = tr_read<v_rd_off(0, 3, 1)>(vb);
  asm volatile("s_waitcnt lgkmcnt(6)" ::: "memory"); SBAR();
  o[0] = __builtin_amdgcn_mfma_f32_32x32x16_bf16(pa0, PK(l0, h0), o[0], 0, 0, 0);
  psm_slice<0>(n0, n1, mC, alpha, mx); SBAR();
  const s16x4 l4 = tr_read<v_rd_off(1, 0, 0)>(vb), h4 = tr_read<v_rd_off(1, 0, 1)>(vb);
  asm volatile("s_waitcnt lgkmcnt(6)" ::: "memory"); SBAR();
  o[0] = __builtin_amdgcn_mfma_f32_32x32x16_bf16(pa1, PK(l1, h1), o[0], 0, 0, 0);
  psm_slice<1>(n0, n1, mC, alpha, mx); SBAR();
  const s16x4 l5 = tr_read<v_rd_off(1, 1, 0)>(vb), h5 = tr_read<v_rd_off(1, 1, 1)>(vb);
  asm volatile("s_waitcnt lgkmcnt(6)" ::: "memory"); SBAR();
  o[0] = __builtin_amdgcn_mfma_f32_32x32x16_bf16(pa2, PK(l2, h2), o[0], 0, 0, 0);
  psm_slice<2>(n0, n1, mC, alpha, mx); SBAR();
  const s16x4 l6 = tr_read<v_rd_off(1, 2, 0)>(vb), h6 = tr_read<v_rd_off(1, 2, 1)>(vb);
  asm volatile("s_waitcnt lgkmcnt(6)" ::: "memory"); SBAR();
  o[0] = __builtin_amdgcn_mfma_f32_32x32x16_bf16(pa3, PK(l3, h3), o[0], 0, 0, 0);
  psm_slice<3>(n0, n1, mC, alpha, mx); SBAR();
  const s16x4 l7 = tr_read<v_rd_off(1, 3, 0)>(vb), h7 = tr_read<v_rd_off(1, 3, 1)>(vb);
  asm volatile("s_waitcnt lgkmcnt(6)" ::: "memory"); SBAR();
  o[1] = __builtin_amdgcn_mfma_f32_32x32x16_bf16(pa0, PK(l4, h4), o[1], 0, 0, 0);
  psm_slice<4>(n0, n1, mC, alpha, mx); SBAR();
  const s16x4 l8 = tr_read<v_rd_off(2, 0, 0)>(vb), h8 = tr_read<v_rd_off(2, 0, 1)>(vb);
  asm volatile("s_waitcnt lgkmcnt(6)" ::: "memory"); SBAR();
  o[1] = __builtin_amdgcn_mfma_f32_32x32x16_bf16(pa1, PK(l5, h5), o[1], 0, 0, 0);
  psm_slice<5>(n0, n1, mC, alpha, mx); SBAR();
  const s16x4 l9 = tr_read<v_rd_off(2, 1, 0)>(vb), h9 = tr_read<v_rd_off(2, 1, 1)>(vb);
  asm volatile("s_waitcnt lgkmcnt(6)" ::: "memory"); SBAR();
  o[1] = __builtin_amdgcn_mfma_f32_32x32x16_bf16(pa2, PK(l6, h6), o[1], 0, 0, 0);
  psm_slice<6>(n0, n1, mC, alpha, mx); SBAR();
  const s16x4 l10 = tr_read<v_rd_off(2, 2, 0)>(vb), h10 = tr_read<v_rd_off(2, 2, 1)>(vb);
  asm volatile("s_waitcnt lgkmcnt(6)" ::: "memory"); SBAR();
  o[1] = __builtin_amdgcn_mfma_f32_32x32x16_bf16(pa3, PK(l7, h7), o[1], 0, 0, 0);
  psm_slice<7>(n0, n1, mC, alpha, mx); SBAR();
  const s16x4 l11 = tr_read<v_rd_off(2, 3, 0)>(vb), h11 = tr_read<v_rd_off(2, 3, 1)>(vb);
  asm volatile("s_waitcnt lgkmcnt(6)" ::: "memory"); SBAR();
  o[2] = __builtin_amdgcn_mfma_f32_32x32x16_bf16(pa0, PK(l8, h8), o[2], 0, 0, 0);
  psm_slice<8>(n0, n1, mC, alpha, mx); SBAR();
  const s16x4 l12 = tr_read<v_rd_off(3, 0, 0)>(vb), h12 = tr_read<v_rd_off(3, 0, 1)>(vb);
  asm volatile("s_waitcnt lgkmcnt(6)" ::: "memory"); SBAR();
  o[2] = __builtin_amdgcn_mfma_f32_32x32x16_bf16(pa1, PK(l9, h9), o[2], 0, 0, 0);
  psm_slice<9>(n0, n1, mC, alpha, mx); SBAR();
  const s16x4 l13 = tr_read<v_rd_off(3, 1, 0)>(vb), h13 = tr_read<v_rd_off(3, 1, 1)>(vb);
  asm volatile("s_waitcnt lgkmcnt(6)" ::: "memory"); SBAR();
  o[2] = __builtin_amdgcn_mfma_f32_32x32x16_bf16(pa2, PK(l10, h10), o[2], 0, 0, 0);
  psm_slice<10>(n0, n1, mC, alpha, mx); SBAR();
  const s16x4 l14 = tr_read<v_rd_off(3, 2, 0)>(vb), h14 = tr_read<v_rd_off(3, 2, 1)>(vb);
  asm volatile("s_waitcnt lgkmcnt(6)" ::: "memory"); SBAR();
  o[2] = __builtin_amdgcn_mfma_f32_32x32x16_bf16(pa3, PK(l11, h11), o[2], 0, 0, 0);
  psm_slice<11>(n0, n1, mC, alpha, mx); SBAR();
  const s16x4 l15 = tr_read<v_rd_off(3, 3, 0)>(vb), h15 = tr_read<v_rd_off(3, 3, 1)>(vb);
  asm volatile("s_waitcnt lgkmcnt(6)" ::: "memory"); SBAR();
  o[3] = __builtin_amdgcn_mfma_f32_32x32x16_bf16(pa0, PK(l12, h12), o[3], 0, 0, 0);
  psm_slice<12>(n0, n1, mC, alpha, mx); SBAR();
  asm volatile("s_waitcnt lgkmcnt(4)" ::: "memory"); SBAR();
  o[3] = __builtin_amdgcn_mfma_f32_32x32x16_bf16(pa1, PK(l13, h13), o[3], 0, 0, 0);
  psm_slice<13>(n0, n1, mC, alpha, mx); SBAR();
  asm volatile("s_waitcnt lgkmcnt(2)" ::: "memory"); SBAR();
  o[3] = __builtin_amdgcn_mfma_f32_32x32x16_bf16(pa2, PK(l14, h14), o[3], 0, 0, 0);
  psm_slice<14>(n0, n1, mC, alpha, mx); SBAR();
  asm volatile("s_waitcnt lgkmcnt(0)" ::: "memory"); SBAR();
  o[3] = __builtin_amdgcn_mfma_f32_32x32x16_bf16(pa3, PK(l15, h15), o[3], 0, 0, 0);
  psm_slice<15>(n0, n1, mC, alpha, mx); SBAR();
#undef PK
}
constexpr int LDS_K_OFF = 2 * SHM_V, LDS_WS_OFF = LDS_K_OFF + 2 * 12 * 2048, LDS_TBL_OFF = LDS_WS_OFF + NW * 64 * 4, LDS_Q_OFF = LDS_TBL_OFF + ((TBLN * 4 + 15) / 16) * 16;
static_assert(LDS_Q_OFF + NW * 8192 <= 163840, "attention LDS map");

template <int NDQ, int BIAS, int EPI, int SDEPTH, int NQL = 0, int ROPEQ = 0, int ORD = 0>
__device__ __forceinline__ void attn_unit(const bf16_t* __restrict__ Qb, int ldq, const bf16_t* __restrict__ Kh, int ldk, const bf16_t* __restrict__ K2, int ldk2,
                                          const bf16_t* __restrict__ Vh, int ldv, int kbeg, int nkeys, int q0, const float* __restrict__ tblg, float cb_lo, float cb_hi,
                                          bf16_t* __restrict__ Obf, int ldo, float* __restrict__ tmp, float lam, const float* __restrict__ subln, float post, char* lds, const int wave0, const float* __restrict__ cosp = nullptr, const float* __restrict__ sinp = nullptr) {
  constexpr int ROWB = NDQ * 32, SHM_K = 64 * ROWB;
  int tid_ = wave0 * 64 + lane_id_v();
  const int tid = tid_, wid = tid >> 6, lane = tid & 63, r32 = lane & 31, hi = lane >> 5;
  char* V_lds = lds; char* K_lds = lds + LDS_K_OFF;
  float* ws = (float*)(lds + LDS_WS_OFF) + wid * 64; float* li_l = ws; float* al_l = ws + 32;
  float* tbl_l = (float*)(lds + LDS_TBL_OFF);
  __syncthreads();
  if constexpr (BIAS) { for (int i = tid; i < TBLN; i += 512) tbl_l[i] = tblg[i]; }
  float mC = 0.f, l_reg = 0, nm_cur = 0.f; f32x16 o[4] = {}; f32x16 negm = {}; bf16x8 qr[NDQ - NQL];
  const bf16_t* Qw = Qb + (long)(wid * QBLK + r32) * ldq + hi * 8;
  char* qls = lds + LDS_Q_OFF + wid * 8192 + lane * 16;
#pragma unroll
  for (int d0 = 0; d0 < NDQ - NQL; ++d0) qr[d0] = *reinterpret_cast<const bf16x8*>(Qw + d0 * 16);
  if constexpr (ROPEQ) {
    static_assert(NDQ == 12 && NQL >= 4, "ROPEQ: MLA layout");
#pragma unroll
    for (int d0 = NDQ - NQL; d0 < 8; ++d0) *reinterpret_cast<bf16x8*>(qls + (d0 - (NDQ - NQL)) * 1024) = *reinterpret_cast<const bf16x8*>(Qw + d0 * 16);
    const int qrow = q0 + wid * QBLK + r32;
#pragma unroll
    for (int pr = 0; pr < 2; ++pr) {
      const bf16x8 xa = *reinterpret_cast<const bf16x8*>(Qw + (8 + pr) * 16), xb = *reinterpret_cast<const bf16x8*>(Qw + (10 + pr) * 16);
      const float* cp = cosp + (size_t)qrow * 32 + pr * 16 + hi * 8; const float* sp = sinp + (size_t)qrow * 32 + pr * 16 + hi * 8;
      const f32x4 c0 = *(const f32x4*)cp, c1 = *(const f32x4*)(cp + 4), s0 = *(const f32x4*)sp, s1 = *(const f32x4*)(sp + 4);
      float ya[8], yb[8];
#pragma unroll
      for (int t = 0; t < 8; ++t) { const float x1 = bf2f((unsigned short)xa[t]), x2 = bf2f((unsigned short)xb[t]); const float c = t < 4 ? c0[t & 3] : c1[t & 3], sn = t < 4 ? s0[t & 3] : s1[t & 3];
        ya[t] = x1 * c - x2 * sn; yb[t] = x2 * c + x1 * sn; }
      u32x4 wa = {pk2(ya[0], ya[1]), pk2(ya[2], ya[3]), pk2(ya[4], ya[5]), pk2(ya[6], ya[7])}, wb = {pk2(yb[0], yb[1]), pk2(yb[2], yb[3]), pk2(yb[4], yb[5]), pk2(yb[6], yb[7])};
      *reinterpret_cast<u32x4*>(qls + (8 + pr - (NDQ - NQL)) * 1024) = wa; *reinterpret_cast<u32x4*>(qls + (10 + pr - (NDQ - NQL)) * 1024) = wb; }
  } else {
#pragma unroll
  for (int d0 = NDQ - NQL; d0 < NDQ; ++d0) *reinterpret_cast<bf16x8*>(qls + (d0 - (NDQ - NQL)) * 1024) = *reinterpret_cast<const bf16x8*>(Qw + d0 * 16);
  }
  const int sr = tid >> 4, sc = (tid & 15) * 8, vst0 = v_st(sr, sc), vst1 = v_st(32 + sr, sc);
  const int sr8 = tid >> 3, sc8 = (tid & 7) * 8;
  const int vb0 = (int)(uintptr_t)V_lds + v_rd_base(lane);
  const int qlane = q0 + wid * QBLK + r32;
  struct { bf16x8 vs0, vs1, ks0, ks1, ks2; } sr_[SDEPTH];
  constexpr int SWM = (NDQ == 8) ? 15 : 7;
#define KSWZ(row, colB) ((row) * ROWB + ((colB) ^ (((row) & SWM) << 4)))
#define SLOAD(i, k0) do { sr_[i].vs0 = *reinterpret_cast<const bf16x8*>(&Vh[(long)((k0) + sr) * ldv + sc]); sr_[i].vs1 = *reinterpret_cast<const bf16x8*>(&Vh[(long)((k0) + 32 + sr) * ldv + sc]); \
    if constexpr (NDQ == 4) { sr_[i].ks0 = *reinterpret_cast<const bf16x8*>(&Kh[(long)((k0) + sr8) * ldk + sc8]); } \
    else { sr_[i].ks0 = *reinterpret_cast<const bf16x8*>(&Kh[(long)((k0) + sr) * ldk + sc]); sr_[i].ks1 = *reinterpret_cast<const bf16x8*>(&Kh[(long)((k0) + 32 + sr) * ldk + sc]); \
      if constexpr (NDQ == 12) { sr_[i].ks2 = *reinterpret_cast<const bf16x8*>(&K2[(long)((k0) + sr8) * ldk2 + sc8]); } } } while (0)
#define SWRITE(b, i) do { *(bf16x8*)(V_lds + (b) * SHM_V + vst0) = sr_[i].vs0; *(bf16x8*)(V_lds + (b) * SHM_V + vst1) = sr_[i].vs1; \
    if constexpr (NDQ == 4) { *(bf16x8*)(K_lds + (b) * SHM_K + KSWZ(sr8, sc8 * 2)) = sr_[i].ks0; } \
    else { *(bf16x8*)(K_lds + (b) * SHM_K + KSWZ(sr, sc * 2)) = sr_[i].ks0; *(bf16x8*)(K_lds + (b) * SHM_K + KSWZ(32 + sr, sc * 2)) = sr_[i].ks1; \
      if constexpr (NDQ == 12) { *(bf16x8*)(K_lds + (b) * SHM_K + KSWZ(sr8, 256 + sc8 * 2)) = sr_[i].ks2; } } } while (0)
#define SWAIT() do { if constexpr (SDEPTH == 2) { if constexpr (NDQ == 4) asm volatile("s_waitcnt vmcnt(3)" ::: "memory"); else if constexpr (NDQ == 8) asm volatile("s_waitcnt vmcnt(4)" ::: "memory"); else asm volatile("s_waitcnt vmcnt(5)" ::: "memory"); } \
    else asm volatile("s_waitcnt vmcnt(0)" ::: "memory"); } while (0)
#define RESC(a) do { if (__any((a) < 1.f)) { if (hi == 0) al_l[r32] = (a); asm volatile("s_waitcnt lgkmcnt(0)" ::: "memory"); \
    _Pragma("unroll") for (int d = 0; d < 4; ++d) _Pragma("unroll") for (int r = 0; r < 16; ++r) o[d][r] *= al_l[crow(r, hi)]; } } while (0)
#define BIASADD(P0, P1, kt0) do { if constexpr (BIAS) { const int dlo_ = (kt0) - q0 - 255, dhi_ = (kt0) + 63 - q0; \
    if (!(dlo_ >= 1024) && !(dhi_ <= -1024)) { const float* tb_ = tbl_l + ((kt0) - qlane + TOFF + 4 * hi); \
      _Pragma("unroll") for (int r = 0; r < 16; ++r) { P0[r] += tb_[(r & 3) + 8 * (r >> 2)]; P1[r] += tb_[32 + (r & 3) + 8 * (r >> 2)]; } } } } while (0)
#define NEGM_UPD(kt0) do { float nmj_ = -mC; if constexpr (BIAS) { const int dlo_ = (kt0) - q0 - 255, dhi_ = (kt0) + 63 - q0; if (dlo_ >= 1024) nmj_ += cb_hi; else if (dhi_ <= -1024) nmj_ += cb_lo; } \
    if (__any(nmj_ != nm_cur)) { nm_cur = nmj_; _Pragma("unroll") for (int r = 0; r < 16; ++r) negm[r] = nmj_; } } while (0)
  f32x16 pA0, pA1, pB0, pB1; float alA, alB; bf16x8 pa0, pa1, pa2, pa3; const int NT = nkeys / KVBLK;
  const int kb0 = (int)(uintptr_t)K_lds + r32 * ROWB + (((r32 & 15) << 4) ^ (hi << 4));
#define QKT(P0, P1, KOFF) do { if constexpr (NDQ == 8 && NQL == 0) qkt8_roll(P0, P1, negm, kb0 + (KOFF), qr); else qkt<NDQ, NQL>(P0, P1, negm, K_lds + (KOFF), qr, qls, r32, hi); } while (0)
  constexpr int SE = 0, SO = SDEPTH - 1;
  SLOAD(SE, kbeg); asm volatile("s_waitcnt vmcnt(0)" ::: "memory"); SWRITE(0, SE); __syncthreads();
  constexpr bool SLICED = (NDQ == 8 && NQL == 0);
  NEGM_UPD(kbeg); QKT(pA0, pA1, 0); BIASADD(pA0, pA1, kbeg); partialSM<true>(pA0, pA1, mC, alA);
  if constexpr (SLICED) {
#pragma unroll
    for (int r = 0; r < 16; ++r) pA1[r] = __builtin_amdgcn_exp2f(pA1[r]); }
  SLOAD(SO, kbeg + KVBLK); if constexpr (SDEPTH == 2) { if (2 < NT) SLOAD(SE, kbeg + 2 * KVBLK); }
  SWAIT(); SWRITE(1, SO); __syncthreads();
  if constexpr (NDQ == 8 && NQL == 0) {
  for (int j = 1; j + 1 < NT; j += 2) {
    if constexpr (ORD == 0) {
    NEGM_UPD(kbeg + j * KVBLK); SBAR();
    qkt8_fsm(pB0, pB1, negm, kb0 + SHM_K, qr, pA0, pA1, alA, l_reg, pa0, pa1, pa2, pa3);
    SLOAD(SO, kbeg + (j + SDEPTH) * KVBLK); SBAR();
    BIASADD(pB0, pB1, kbeg + j * KVBLK); SBAR();
    pv_psm(o, vb0, pa0, pa1, pa2, pa3, pB0, pB1, mC, alB);
    } else {
    finishSM<false>(pA0, pA1, alA, l_reg, pa0, pa1, pa2, pa3); SBAR();
    NEGM_UPD(kbeg + j * KVBLK); SBAR(); qkt8_roll(pB0, pB1, negm, kb0 + SHM_K, qr); SBAR();
    SLOAD(SO, kbeg + (j + SDEPTH) * KVBLK); SBAR();
    BIASADD(pB0, pB1, kbeg + j * KVBLK); partialSM<false>(pB0, pB1, mC, alB);
    _Pragma("unroll") for (int r = 0; r < 16; ++r) pB1[r] = __builtin_amdgcn_exp2f(pB1[r]);
    SBAR(); pv_d0(o, vb0, pa0, pa1, pa2, pa3);
    }
    __syncthreads(); SWAIT(); SWRITE(0, SE);
    RESC(alB); __syncthreads();
    if constexpr (ORD == 0) {
    NEGM_UPD(kbeg + (j + 1) * KVBLK); SBAR();
    qkt8_fsm(pA0, pA1, negm, kb0, qr, pB0, pB1, alB, l_reg, pa0, pa1, pa2, pa3);
    if (SDEPTH == 1 || j + 3 < NT) SLOAD(SE, kbeg + (j + 1 + SDEPTH) * KVBLK); SBAR();
    BIASADD(pA0, pA1, kbeg + (j + 1) * KVBLK); SBAR();
    pv_psm(o, vb0 + (int)SHM_V, pa0, pa1, pa2, pa3, pA0, pA1, mC, alA);
    } else {
    finishSM<false>(pB0, pB1, alB, l_reg, pa0, pa1, pa2, pa3); SBAR();
    NEGM_UPD(kbeg + (j + 1) * KVBLK); SBAR(); qkt8_roll(pA0, pA1, negm, kb0, qr); SBAR();
    if (SDEPTH == 1 || j + 3 < NT) SLOAD(SE, kbeg + (j + 1 + SDEPTH) * KVBLK); SBAR();
    BIASADD(pA0, pA1, kbeg + (j + 1) * KVBLK); partialSM<false>(pA0, pA1, mC, alA);
    _Pragma("unroll") for (int r = 0; r < 16; ++r) pA1[r] = __builtin_amdgcn_exp2f(pA1[r]);
    SBAR(); pv_d0(o, vb0 + (int)SHM_V, pa0, pa1, pa2, pa3);
    }
    __syncthreads(); SWAIT(); SWRITE(1, SO);
    RESC(alA); __syncthreads();
  }
  } else {
  for (int j = 1; j + 1 < NT; j += 2) {
    NEGM_UPD(kbeg + j * KVBLK); SBAR(); QKT(pB0, pB1, SHM_K);
    finishSM(pA0, pA1, alA, l_reg, pa0, pa1, pa2, pa3); SBAR();
    SLOAD(SO, kbeg + (j + SDEPTH) * KVBLK); SBAR();
    pv_d0(o, vb0, pa0, pa1, pa2, pa3); BIASADD(pB0, pB1, kbeg + j * KVBLK); partialSM<false>(pB0, pB1, mC, alB);
    __syncthreads(); SWAIT(); SWRITE(0, SE);
    RESC(alB); __syncthreads();
    NEGM_UPD(kbeg + (j + 1) * KVBLK); SBAR(); QKT(pA0, pA1, 0);
    finishSM(pB0, pB1, alB, l_reg, pa0, pa1, pa2, pa3); SBAR();
    if (SDEPTH == 1 || j + 3 < NT) SLOAD(SE, kbeg + (j + 1 + SDEPTH) * KVBLK); SBAR();
    pv_d0(o, vb0 + (int)SHM_V, pa0, pa1, pa2, pa3); BIASADD(pA0, pA1, kbeg + (j + 1) * KVBLK); partialSM<false>(pA0, pA1, mC, alA);
    __syncthreads(); SWAIT(); SWRITE(1, SO);
    RESC(alA); __syncthreads();
  }
  }
  NEGM_UPD(kbeg + (NT - 1) * KVBLK); SBAR(); QKT(pB0, pB1, SHM_K);
  finishSM<!SLICED>(pA0, pA1, alA, l_reg, pa0, pa1, pa2, pa3); SBAR();
  pv_d0(o, vb0, pa0, pa1, pa2, pa3); BIASADD(pB0, pB1, kbeg + (NT - 1) * KVBLK); partialSM<false>(pB0, pB1, mC, alB);
  __syncthreads(); RESC(alB);
  finishSM(pB0, pB1, alB, l_reg, pa0, pa1, pa2, pa3); SBAR();
  pv_d0(o, vb0 + (int)SHM_V, pa0, pa1, pa2, pa3);
  if (hi == 0) li_l[r32] = l_reg; asm volatile("s_waitcnt lgkmcnt(0)" ::: "memory");
  float rli[16];
#pragma unroll
  for (int r = 0; r < 16; ++r) rli[r] = __builtin_amdgcn_rcpf(li_l[crow(r, hi)]);
  if constexpr (EPI == 0) {
    bf16_t* Ow = Obf + (long)(wid * QBLK) * ldo;
#pragma unroll
    for (int r = 0; r < 16; ++r) { const int orow = crow(r, hi);
#pragma unroll
      for (int d0 = 0; d0 < 4; ++d0) Ow[(long)orow * ldo + d0 * 32 + r32] = (bf16_t)f2bf(o[d0][r] * rli[r]); }
  } else if constexpr (EPI == 1) {
    float* Tw = tmp + (wid * QBLK) * 128;
#pragma unroll
    for (int r = 0; r < 16; ++r) { const int orow = crow(r, hi);
#pragma unroll
      for (int d0 = 0; d0 < 4; ++d0) Tw[orow * 128 + d0 * 32 + r32] = o[d0][r] * rli[r]; }
  } else {
    const float* Tw = tmp + (wid * QBLK) * 128; bf16_t* Ow = Obf + (long)(wid * QBLK) * ldo;
    float sg[4];
#pragma unroll
    for (int d0 = 0; d0 < 4; ++d0) sg[d0] = subln[d0 * 32 + r32] * post;
#pragma unroll
    for (int r = 0; r < 16; ++r) { const int orow = crow(r, hi); float v[4]; float ss = 0.f;
#pragma unroll
      for (int d0 = 0; d0 < 4; ++d0) { v[d0] = Tw[orow * 128 + d0 * 32 + r32] - lam * (o[d0][r] * rli[r]); ss += v[d0] * v[d0]; }
      ss += swz_xor<1>(ss); ss += swz_xor<2>(ss); ss += swz_xor<4>(ss); ss += swz_xor<8>(ss); ss += swz_xor<16>(ss);
      const float rs = rsqrtf(ss * (1.0f / 128.0f) + EPS);
#pragma unroll
      for (int d0 = 0; d0 < 4; ++d0) Ow[(long)orow * ldo + d0 * 32 + r32] = (bf16_t)f2bf(v[d0] * rs * sg[d0]); }
  }
#undef KSWZ
#undef SLOAD
#undef SWRITE
#undef SWAIT
#undef RESC
#undef BIASADD
#undef NEGM_UPD
#undef QKT
}

template <int M>
__device__ __forceinline__ void qkt_map(f32x16& p0, f32x16& p1, const char* Ks, const char* qls, int r32, int hi) {
  p0 = f32x16{}; p1 = f32x16{};
#pragma unroll
  for (int d0 = 0; d0 < 4; ++d0) { const int cb = (M * 64 + d0 * 16 + hi * 8) * 2;
    bf16x8 b0 = *reinterpret_cast<const bf16x8*>(Ks + r32 * 256 + (cb ^ ((r32 & 15) << 4)));
    bf16x8 b1 = *reinterpret_cast<const bf16x8*>(Ks + (32 + r32) * 256 + (cb ^ ((r32 & 15) << 4)));
    bf16x8 q = *reinterpret_cast<const bf16x8*>(qls + (M * 4 + d0) * 1024);
    p0 = __builtin_amdgcn_mfma_f32_32x32x16_bf16(b0, q, p0, 0, 0, 0);
    p1 = __builtin_amdgcn_mfma_f32_32x32x16_bf16(b1, q, p1, 0, 0, 0);
    if (d0 == 1) SBAR(); }
}
template <int M>
__device__ __forceinline__ void qkt_map_roll(f32x16& p0, f32x16& p1, int kb, int qa) {
  p0 = f32x16{}; p1 = f32x16{};
  const int a0 = kb ^ ((M << 7) | (0 << 5)); const bf16x8 x0 = lds_rd128<0>(a0), y0 = lds_rd128<8192>(a0); const bf16x8 z0 = (M == 0) ? lds_rd128<0>(qa) : lds_rd128<4096>(qa);
  const int a1 = kb ^ ((M << 7) | (1 << 5)); const bf16x8 x1 = lds_rd128<0>(a1), y1 = lds_rd128<8192>(a1); const bf16x8 z1 = (M == 0) ? lds_rd128<1024>(qa) : lds_rd128<5120>(qa);
  asm volatile("s_waitcnt lgkmcnt(3)" ::: "memory"); SBAR();
  p0 = __builtin_amdgcn_mfma_f32_32x32x16_bf16(x0, z0, p0, 0, 0, 0); p1 = __builtin_amdgcn_mfma_f32_32x32x16_bf16(y0, z0, p1, 0, 0, 0);
  const int a2 = kb ^ ((M << 7) | (2 << 5)); const bf16x8 x2 = lds_rd128<0>(a2), y2 = lds_rd128<8192>(a2); const bf16x8 z2 = (M == 0) ? lds_rd128<2048>(qa) : lds_rd128<6144>(qa);
  asm volatile("s_waitcnt lgkmcnt(3)" ::: "memory"); SBAR();
  p0 = __builtin_amdgcn_mfma_f32_32x32x16_bf16(x1, z1, p0, 0, 0, 0); p1 = __builtin_amdgcn_mfma_f32_32x32x16_bf16(y1, z1, p1, 0, 0, 0);
  const int a3 = kb ^ ((M << 7) | (3 << 5)); const bf16x8 x3 = lds_rd128<0>(a3), y3 = lds_rd128<8192>(a3); const bf16x8 z3 = (M == 0) ? lds_rd128<3072>(qa) : lds_rd128<7168>(qa);
  asm volatile("s_waitcnt lgkmcnt(3)" ::: "memory"); SBAR();
  p0 = __builtin_amdgcn_mfma_f32_32x32x16_bf16(x2, z2, p0, 0, 0, 0); p1 = __builtin_amdgcn_mfma_f32_32x32x16_bf16(y2, z2, p1, 0, 0, 0);
  asm volatile("s_waitcnt lgkmcnt(0)" ::: "memory"); SBAR();
  p0 = __builtin_amdgcn_mfma_f32_32x32x16_bf16(x3, z3, p0, 0, 0, 0); p1 = __builtin_amdgcn_mfma_f32_32x32x16_bf16(y3, z3, p1, 0, 0, 0);
  SBAR();
}
__device__ __forceinline__ void softmax_tile(f32x16& p0, f32x16& p1, float& m, float& l, float& alpha, float cb, bf16x8& pa0, bf16x8& pa1, bf16x8& pa2, bf16x8& pa3) {
  float mx_[4] = {p0[0], p0[1], p0[2], p0[3]};
#pragma unroll
  for (int r = 4; r < 16; ++r) mx_[r & 3] = fmaxf(mx_[r & 3], p0[r]);
#pragma unroll
  for (int r = 0; r < 16; ++r) mx_[r & 3] = fmaxf(mx_[r & 3], p1[r]);
  float pmax = fmaxf(fmaxf(mx_[0], mx_[1]), fmaxf(mx_[2], mx_[3]));
  { auto rr = __builtin_amdgcn_permlane32_swap(__float_as_uint(pmax), __float_as_uint(pmax), false, false);
    pmax = fmaxf(__uint_as_float(rr[0]), __uint_as_float(rr[1])); }
  pmax += cb;
  float mn;
  if (__builtin_expect(__all(pmax - m <= THR2), 1)) { mn = m; alpha = 1.f; }
  else { mn = fmaxf(m, pmax); alpha = __builtin_amdgcn_exp2f(m - mn); m = mn; }
  const float off = cb - mn;
#pragma unroll
  for (int r = 0; r < 16; ++r) p0[r] = __builtin_amdgcn_exp2f(p0[r] + off);
#pragma unroll
  for (int r = 0; r < 16; ++r) p1[r] = __builtin_amdgcn_exp2f(p1[r] + off);
  float sm_[4] = {p0[0], p0[1], p0[2], p0[3]};
#pragma unroll
  for (int r = 4; r < 16; ++r) sm_[r & 3] += p0[r];
#pragma unroll
  for (int r = 0; r < 16; ++r) sm_[r & 3] += p1[r];
  float ps = (sm_[0] + sm_[1]) + (sm_[2] + sm_[3]);
  { auto rr = __builtin_amdgcn_permlane32_swap(__float_as_uint(ps), __float_as_uint(ps), false, false);
    ps = __uint_as_float(rr[0]) + __uint_as_float(rr[1]); }
  l = l * alpha + ps;
#define PK4(P, BASE, OUT) do { unsigned a0 = cvtpk(P[BASE + 0], P[BASE + 1]), a1 = cvtpk(P[BASE + 2], P[BASE + 3]);   \
    unsigned b0 = cvtpk(P[BASE + 4], P[BASE + 5]), b1 = cvtpk(P[BASE + 6], P[BASE + 7]);                              \
    auto r0 = __builtin_amdgcn_permlane32_swap(a0, b0, false, false); auto r1 = __builtin_amdgcn_permlane32_swap(a1, b1, false, false); \
    u32x4 w = {r0[0], r1[0], r0[1], r1[1]}; OUT = *reinterpret_cast<bf16x8*>(&w); } while (0)
  PK4(p0, 0, pa0); PK4(p0, 8, pa1); PK4(p1, 0, pa2); PK4(p1, 8, pa3);
#undef PK4
}
template <int D0> __device__ __forceinline__ void pv2_one(f32x16& oa, f32x16& ob, int vb, bf16x8 pa0, bf16x8 pa1, bf16x8 pa2, bf16x8 pa3, bf16x8 pb0, bf16x8 pb1, bf16x8 pb2, bf16x8 pb3) {
  const s16x4 l0 = tr_read<v_rd_off(D0, 0, 0)>(vb), h0 = tr_read<v_rd_off(D0, 0, 1)>(vb), l1 = tr_read<v_rd_off(D0, 1, 0)>(vb), h1 = tr_read<v_rd_off(D0, 1, 1)>(vb);
  const s16x4 l2 = tr_read<v_rd_off(D0, 2, 0)>(vb), h2 = tr_read<v_rd_off(D0, 2, 1)>(vb), l3 = tr_read<v_rd_off(D0, 3, 0)>(vb), h3 = tr_read<v_rd_off(D0, 3, 1)>(vb);
  asm volatile("s_waitcnt lgkmcnt(0)" ::: "memory"); SBAR();
#define PK(L, H) (bf16x8){L[0], L[1], L[2], L[3], H[0], H[1], H[2], H[3]}
  const bf16x8 v0 = PK(l0, h0), v1 = PK(l1, h1), v2 = PK(l2, h2), v3 = PK(l3, h3);
  oa = __builtin_amdgcn_mfma_f32_32x32x16_bf16(pa0, v0, oa, 0, 0, 0);
  ob = __builtin_amdgcn_mfma_f32_32x32x16_bf16(pb0, v0, ob, 0, 0, 0);
  oa = __builtin_amdgcn_mfma_f32_32x32x16_bf16(pa1, v1, oa, 0, 0, 0);
  ob = __builtin_amdgcn_mfma_f32_32x32x16_bf16(pb1, v1, ob, 0, 0, 0);
  oa = __builtin_amdgcn_mfma_f32_32x32x16_bf16(pa2, v2, oa, 0, 0, 0);
  ob = __builtin_amdgcn_mfma_f32_32x32x16_bf16(pb2, v2, ob, 0, 0, 0);
  oa = __builtin_amdgcn_mfma_f32_32x32x16_bf16(pa3, v3, oa, 0, 0, 0);
  ob = __builtin_amdgcn_mfma_f32_32x32x16_bf16(pb3, v3, ob, 0, 0, 0);
#undef PK
}
__device__ __forceinline__ void attn_unit_A2(const bf16_t* __restrict__ Qb, int ldq, const bf16_t* __restrict__ Kh, int ldk, const bf16_t* __restrict__ Vh, int ldv, int nkeys, int q0,
                                             const float* __restrict__ tblg, float cb_lo, float cb_hi, bf16_t* __restrict__ Obf, int ldo, float lam, const float* __restrict__ subln, float post, char* lds, const int wave0) {
  constexpr int ROWB = 256, SHM_K = 64 * ROWB;
  int tid_ = wave0 * 64 + lane_id_v();
  const int tid = tid_, wid = tid >> 6, lane = tid & 63, r32 = lane & 31, hi = lane >> 5;
  char* V_lds = lds; char* K_lds = lds + LDS_K_OFF;
  float* ws = (float*)(lds + LDS_WS_OFF) + wid * 64; float* sl0 = ws; float* sl1 = ws + 32;
  float* tbl_l = (float*)(lds + LDS_TBL_OFF);
  char* qls = lds + LDS_Q_OFF + wid * 8192 + lane * 16;
  __syncthreads();
  for (int i = tid; i < TBLN; i += 512) tbl_l[i] = tblg[i];
  { const bf16_t* Qw = Qb + (long)(wid * QBLK + r32) * ldq + hi * 8;
#pragma unroll
    for (int i = 0; i < 8; ++i) *reinterpret_cast<bf16x8*>(qls + i * 1024) = *reinterpret_cast<const bf16x8*>(Qw + i * 16); }
  float m0 = -1e30f, m1 = -1e30f, l0 = 0.f, l1 = 0.f; f32x16 oa[4] = {}, ob[4] = {};
  const int sr = tid >> 4, sc = (tid & 15) * 8, vst0 = v_st(sr, sc), vst1 = v_st(32 + sr, sc);
  const int vb0 = (int)(uintptr_t)V_lds + v_rd_base(lane);
  const int qlane = q0 + wid * QBLK + r32;
  bf16x8 vs0, vs1, ks0, ks1;
#define KSWZ(row, colB) ((row) * ROWB + ((colB) ^ (((row) & 15) << 4)))
#define SLOAD2(k0) do { vs0 = *reinterpret_cast<const bf16x8*>(&Vh[(long)((k0) + sr) * ldv + sc]); vs1 = *reinterpret_cast<const bf16x8*>(&Vh[(long)((k0) + 32 + sr) * ldv + sc]); \
    ks0 = *reinterpret_cast<const bf16x8*>(&Kh[(long)((k0) + sr) * ldk + sc]); ks1 = *reinterpret_cast<const bf16x8*>(&Kh[(long)((k0) + 32 + sr) * ldk + sc]); } while (0)
#define SWRITE2(b) do { *(bf16x8*)(V_lds + (b) * SHM_V + vst0) = vs0; *(bf16x8*)(V_lds + (b) * SHM_V + vst1) = vs1; \
    *(bf16x8*)(K_lds + (b) * SHM_K + KSWZ(sr, sc * 2)) = ks0; *(bf16x8*)(K_lds + (b) * SHM_K + KSWZ(32 + sr, sc * 2)) = ks1; } while (0)
#define RESC2(O, SL, a) do { if (__any((a) < 1.f)) { if (hi == 0) SL[r32] = (a); asm volatile("s_waitcnt lgkmcnt(0)" ::: "memory"); \
    _Pragma("unroll") for (int d = 0; d < 4; ++d) _Pragma("unroll") for (int r = 0; r < 16; ++r) O[d][r] *= SL[crow(r, hi)]; } } while (0)
  const int NT = nkeys / KVBLK;
  const int kbA = (int)(uintptr_t)K_lds + r32 * 256 + (((r32 & 15) << 4) ^ (hi << 4)), qaA = (int)(uintptr_t)qls;
  SLOAD2(0); asm volatile("s_waitcnt vmcnt(0)" ::: "memory"); SWRITE2(0); __syncthreads();
  for (int j = 0; j < NT; ++j) {
    const int b = j & 1, kt0 = j * KVBLK;
    const int dlo_ = kt0 - q0 - 255, dhi_ = kt0 + 63 - q0;
    float cb = 0.f; const bool nearb = !(dlo_ >= 1024) && !(dhi_ <= -1024);
    if (dlo_ >= 1024) cb = cb_hi; else if (dhi_ <= -1024) cb = cb_lo;
    const float* tb_ = tbl_l + (kt0 - qlane + TOFF + 4 * hi);
    f32x16 s0, s1; bf16x8 pa0, pa1, pa2, pa3; float al0, al1;
    const int vb = vb0 + b * (int)SHM_V;
    qkt_map_roll<0>(s0, s1, kbA + b * SHM_K, qaA);
    SBAR();
    if (nearb) {
#pragma unroll
      for (int r = 0; r < 8; ++r) { s0[r] += tb_[(r & 3) + 8 * (r >> 2)]; s1[r] += tb_[32 + (r & 3) + 8 * (r >> 2)]; }
      SBAR();
#pragma unroll
      for (int r = 8; r < 16; ++r) { s0[r] += tb_[(r & 3) + 8 * (r >> 2)]; s1[r] += tb_[32 + (r & 3) + 8 * (r >> 2)]; } }
    SBAR();
    softmax_tile(s0, s1, m0, l0, al0, cb, pa0, pa1, pa2, pa3);
    RESC2(oa, sl0, al0);
    SBAR();
    pv_d0(oa, vb, pa0, pa1, pa2, pa3);
    SBAR();
    qkt_map_roll<1>(s0, s1, kbA + b * SHM_K, qaA);
    SBAR();
    if (nearb) {
#pragma unroll
      for (int r = 0; r < 8; ++r) { s0[r] += tb_[(r & 3) + 8 * (r >> 2)]; s1[r] += tb_[32 + (r & 3) + 8 * (r >> 2)]; }
      SBAR();
#pragma unroll
      for (int r = 8; r < 16; ++r) { s0[r] += tb_[(r & 3) + 8 * (r >> 2)]; s1[r] += tb_[32 + (r & 3) + 8 * (r >> 2)]; } }
    SBAR();
    softmax_tile(s0, s1, m1, l1, al1, cb, pa0, pa1, pa2, pa3);
    RESC2(ob, sl1, al1);
    SBAR();
    if (j + 1 < NT) SLOAD2(kt0 + KVBLK);
    SBAR();
    pv_d0(ob, vb, pa0, pa1, pa2, pa3);
    if (j + 1 < NT) { asm volatile("s_waitcnt vmcnt(0)" ::: "memory"); SWRITE2(b ^ 1); }
    __syncthreads();
  }
  const int lane_e = lane_id_v(), r32e = lane_e & 31, hie = lane_e >> 5;
  if (hie == 0) { sl0[r32e] = l0; sl1[r32e] = l1; } asm volatile("s_waitcnt lgkmcnt(0)" ::: "memory");
  bf16_t* Ow = Obf + (long)(wid * QBLK) * ldo;
  float sg[4];
#pragma unroll
  for (int d0 = 0; d0 < 4; ++d0) sg[d0] = subln[d0 * 32 + r32e] * post;
#pragma unroll
  for (int r = 0; r < 16; ++r) { const int orow = crow(r, hie); const float ra = __builtin_amdgcn_rcpf(sl0[orow]), rb = lam * __builtin_amdgcn_rcpf(sl1[orow]); float v[4]; float ss = 0.f;
#pragma unroll
    for (int d0 = 0; d0 < 4; ++d0) { v[d0] = oa[d0][r] * ra - ob[d0][r] * rb; ss += v[d0] * v[d0]; }
    ss += swz_xor<1>(ss); ss += swz_xor<2>(ss); ss += swz_xor<4>(ss); ss += swz_xor<8>(ss); ss += swz_xor<16>(ss);
    const float rs = rsqrtf(ss * (1.0f / 128.0f) + EPS);
#pragma unroll
    for (int d0 = 0; d0 < 4; ++d0) Ow[(long)orow * ldo + d0 * 32 + r32e] = (bf16_t)f2bf(v[d0] * rs * sg[d0]); }
#undef KSWZ
#undef SLOAD2
#undef SWRITE2
#undef RESC2
}
}

__device__ __forceinline__ void transpose_item(const float* __restrict__ W, int K, int N, bf16_t* __restrict__ WT, int k0, int n0, int drow0, float wscale, LAS float* scr, int lane) {
    float tv[32];
#pragma unroll
    for (int i = 0; i < 32; ++i) { const int kk = 2 * i + (lane >> 5); tv[i] = W[(size_t)(k0 + kk) * N + n0 + (lane & 31)]; }
#pragma unroll
    for (int i = 0; i < 32; ++i) { const int kk = 2 * i + (lane >> 5); scr[kk * 33 + (lane & 31)] = tv[i] * wscale; }
    asm volatile("s_waitcnt lgkmcnt(0)" ::: "memory");
    const int c = lane & 7;
#pragma unroll
    for (int j = 0; j < 4; ++j) { const int n = (lane >> 3) + 8 * j; const LAS float* s = scr + (8 * c) * 33 + n;
        u32x4 o; o.x = pk2(s[0 * 33], s[1 * 33]); o.y = pk2(s[2 * 33], s[3 * 33]); o.z = pk2(s[4 * 33], s[5 * 33]); o.w = pk2(s[6 * 33], s[7 * 33]);
        *(u32x4*)(WT + (size_t)(drow0 + n) * K + k0 + 8 * c) = o; }
    asm volatile("s_waitcnt lgkmcnt(0)" ::: "memory");
}
constexpr float QS_A = 0.125f * 1.4426950408889634f, QS_B = 0.07216878364870322f * 1.4426950408889634f, QS_CD = 0.08838834764831845f * 1.4426950408889634f;
template <int MODE>
__device__ __forceinline__ void transpose_matrix(const float* __restrict__ W, int K, int N, bf16_t* __restrict__ WT, LAS float* scr, int lane, int gw, int NGW) {
    const int nblk = N / 32, nitems = (K / 64) * nblk;
    for (int it = gw; it < nitems; it += NGW) { const int kb = it / nblk, nb = it % nblk, n0 = 32 * nb; int drow0 = n0;
        if (MODE == 1) { const int c = n0 < FF ? n0 : n0 - FF; drow0 = 256 * (c / 128) + (c % 128) + (n0 < FF ? 0 : 128); }
        float wscale = 1.0f;
        if (MODE == 2) { if (n0 < C_AK) wscale = QS_A; else if (n0 >= C_DQ && n0 < C_DK) wscale = QS_CD; }
        if (MODE == 3) wscale = QS_B;
        transpose_item(W, K, N, WT, 64 * kb, n0, drow0, wscale, scr, lane); }
}
__device__ __forceinline__ int t5_bucket(int d) {
    const int ret = d > 0 ? 16 : 0; const int n = d < 0 ? -d : d;
    if (n < 8) return ret + n;
    const float v = logf((float)n / 8.0f) / 4.852030263919617f * 8.0f;
    int large = 8 + (int)v; if (large > 15) large = 15;
    return ret + large;
}
__device__ __forceinline__ void norm_row(const float* __restrict__ xrow, const float* __restrict__ g, bf16_t* __restrict__ hrow, int lane) {
    f32x4 v[8]; float ss = 0.f;
#pragma unroll
    for (int j = 0; j < 8; ++j) { v[j] = ((const f32x4*)xrow)[lane + 64 * j]; ss += (v[j].x * v[j].x + v[j].y * v[j].y) + (v[j].z * v[j].z + v[j].w * v[j].w); }
    const float rs = rsqrtf(wave_sum(ss) * (1.0f / DM) + EPS);
#pragma unroll
    for (int j = 0; j < 8; ++j) { const f32x4 gg = ((const f32x4*)g)[lane + 64 * j];
        u32x2 w; w.x = pk2(v[j].x * rs * gg.x, v[j].y * rs * gg.y); w.y = pk2(v[j].z * rs * gg.z, v[j].w * rs * gg.w); ((u32x2*)hrow)[lane + 64 * j] = w; }
}
template <int NR>
__device__ __forceinline__ void norm_add_rows(const bf16_t* __restrict__ Yb, const float* xi, float* xo, const float* __restrict__ gpost,
                                              const float* __restrict__ gpre, bf16_t* __restrict__ Hb, int row0, int rstride, int lane) {
    u32x2 yb[NR][8]; f32x4 v[NR][8];
#pragma unroll
    for (int q = 0; q < NR; ++q) { const size_t ro = (size_t)(row0 + q * rstride) * DM;
#pragma unroll
        for (int j = 0; j < 8; ++j) yb[q][j] = ((const u32x2*)(Yb + ro))[lane + 64 * j];
#pragma unroll
        for (int j = 0; j < 8; ++j) v[q][j] = ((const f32x4*)(xi + ro))[lane + 64 * j]; }
    f32x4 gp[8];
#pragma unroll
    for (int j = 0; j < 8; ++j) gp[j] = ((const f32x4*)gpost)[lane + 64 * j];
#pragma unroll
    for (int q = 0; q < NR; ++q) { const size_t ro = (size_t)(row0 + q * rstride) * DM;
        f32x4 y[8]; float ss = 0.f;
#pragma unroll
        for (int j = 0; j < 8; ++j) { y[j].x = __uint_as_float(yb[q][j].x << 16); y[j].y = __uint_as_float(yb[q][j].x & 0xffff0000u); y[j].z = __uint_as_float(yb[q][j].y << 16); y[j].w = __uint_as_float(yb[q][j].y & 0xffff0000u);
            ss += (y[j].x * y[j].x + y[j].y * y[j].y) + (y[j].z * y[j].z + y[j].w * y[j].w); }
        const float rs = rsqrtf(wave_sum(ss) * (1.0f / DM) + EPS);
        float ss2 = 0.f;
#pragma unroll
        for (int j = 0; j < 8; ++j) { v[q][j] = v[q][j] + y[j] * rs * gp[j]; ((f32x4*)(xo + ro))[lane + 64 * j] = v[q][j];
            ss2 += (v[q][j].x * v[q][j].x + v[q][j].y * v[q][j].y) + (v[q][j].z * v[q][j].z + v[q][j].w * v[q][j].w); }
        if (gpre) {
            const float rs2 = rsqrtf(wave_sum(ss2) * (1.0f / DM) + EPS);
#pragma unroll
            for (int j = 0; j < 8; ++j) { const f32x4 gg = ((const f32x4*)gpre)[lane + 64 * j];
                u32x2 w; w.x = pk2(v[q][j].x * rs2 * gg.x, v[q][j].y * rs2 * gg.y); w.y = pk2(v[q][j].z * rs2 * gg.z, v[q][j].w * rs2 * gg.w); ((u32x2*)(Hb + ro))[lane + 64 * j] = w; }
        }
    }
}

__device__ __forceinline__ void head_norm_axial(const bf16_t* __restrict__ src, bf16_t* __restrict__ dst, const float* __restrict__ g, const float* __restrict__ COS, const float* __restrict__ SIN, int row, int t, float oscale) {
    float v[8];
#pragma unroll
    for (int s = 0; s < 4; ++s) { const unsigned w = *(const unsigned*)(src + 32 * s + 2 * t); v[2 * s] = bf2f((unsigned short)(w & 0xffff)); v[2 * s + 1] = bf2f((unsigned short)(w >> 16)); }
    float ss = 0.f;
#pragma unroll
    for (int i = 0; i < 8; ++i) ss += v[i] * v[i];
    ss += swz_xor<1>(ss); ss += swz_xor<2>(ss); ss += swz_xor<4>(ss); ss += swz_xor<8>(ss);
    const float rs = rsqrtf(ss * (1.0f / 128.0f) + EPS);
#pragma unroll
    for (int s = 0; s < 4; ++s) { v[2 * s] *= rs * oscale * g[32 * s + 2 * t]; v[2 * s + 1] *= rs * oscale * g[32 * s + 2 * t + 1]; }
    const int pr = row >> 6, pc = row & 63;
    float o[8];
#pragma unroll
    for (int e = 0; e < 2; ++e) { const int i = 2 * t + e;
        { const float c = COS[pr * 32 + i], s = SIN[pr * 32 + i]; const float x1 = v[e], x2 = v[2 + e]; o[e] = x1 * c - x2 * s; o[2 + e] = x2 * c + x1 * s; }
        { const float c = COS[pc * 32 + i], s = SIN[pc * 32 + i]; const float x1 = v[4 + e], x2 = v[6 + e]; o[4 + e] = x1 * c - x2 * s; o[6 + e] = x2 * c + x1 * s; } }
#pragma unroll
    for (int s = 0; s < 4; ++s) *(unsigned*)(dst + 32 * s + 2 * t) = pk2(o[2 * s], o[2 * s + 1]);
}


#define XB_TMO      128
#define XB_XCNT(j)  (256  + 64 * (j))
#define XB_XSUB(j)  (1280 + 64 * (j))
#define XB_XGEN(j)  (2304 + 64 * (j))
#define XB_TOP      3328
#define XB_TOPGEN   3392
#define XCD_BAR_WORDS 3456
#define XB_SPIN_CAP (1u << 18)
__device__ __forceinline__ unsigned xb_ld(unsigned* p)              { return __hip_atomic_load(p, __ATOMIC_RELAXED, __HIP_MEMORY_SCOPE_AGENT); }
__device__ __forceinline__ unsigned xb_add(unsigned* p, unsigned v) { return __hip_atomic_fetch_add(p, v, __ATOMIC_RELAXED, __HIP_MEMORY_SCOPE_AGENT); }
__device__ __forceinline__ unsigned xb_xcc_id() { return (unsigned)__builtin_amdgcn_s_getreg((3 << 11) | 20) & 0xFu; }
#define XB_SPIN(cond, bar) do { unsigned _sp = 0; while (cond) { __builtin_amdgcn_s_sleep(1); \
    if ((++_sp & 255u) == 0u) { if (xb_ld(&(bar)[XB_TMO])) break; if (_sp > XB_SPIN_CAP) { atomicAdd(&(bar)[XB_TMO], 1u); break; } } } } while (0)
__device__ __forceinline__ void xcd_barrier_complete(unsigned* bar, unsigned x, unsigned& nloc, unsigned& nx) {
    const unsigned G = gridDim.x * gridDim.y * gridDim.z;
    unsigned sum, cnt, mine, sp = 0u;
    for (;;) {
        sum = 0u; cnt = 0u; mine = 0u;
#pragma unroll
        for (unsigned j = 0; j < 16; ++j) { const unsigned c = xb_ld(&bar[XB_XCNT(j)]); sum += c; cnt += (c > 0u) ? 1u : 0u; mine = (j == x) ? c : mine; }
        if (sum == G) break;
        __builtin_amdgcn_s_sleep(1);
        if ((++sp & 255u) == 0u) { if (xb_ld(&bar[XB_TMO])) break; if (sp > XB_SPIN_CAP) { atomicAdd(&bar[XB_TMO], 1u); break; } }
    }
    nloc = mine > 0u ? mine : 1u; nx = cnt > 0u ? cnt : 1u;
}
__device__ __forceinline__ void xcd_barrier(unsigned* bar, volatile LAS unsigned* st, bool leader) {
    asm volatile("s_waitcnt vmcnt(0)" ::: "memory");
    __syncthreads();
    if (leader) {
        const unsigned x = xb_xcc_id();
        __builtin_amdgcn_s_waitcnt(0);
        unsigned nloc = st[0], nx = st[1];
        if (nloc == 0u) { xcd_barrier_complete(bar, x, nloc, nx); st[0] = nloc; st[1] = nx; }
        const unsigned old = xb_add(&bar[XB_XSUB(x)], 1u);
        const unsigned gen = old / nloc;
        if (old + 1u == (gen + 1u) * nloc) {
            __builtin_amdgcn_fence(__ATOMIC_RELEASE, "agent");
            asm volatile("s_waitcnt vmcnt(0)" ::: "memory");
            const unsigned og = xb_add(&bar[XB_TOP], 1u);
            const unsigned tg = og / nx;
            if (og + 1u == (tg + 1u) * nx) xb_add(&bar[XB_TOPGEN], 1u);
            else XB_SPIN(xb_ld(&bar[XB_TOPGEN]) == tg, bar);
            __builtin_amdgcn_fence(__ATOMIC_ACQUIRE, "agent");
            xb_add(&bar[XB_XGEN(x)], 1u);
            asm volatile("s_waitcnt vmcnt(0)" ::: "memory");
        } else {
            XB_SPIN(xb_ld(&bar[XB_XGEN(x)]) == gen, bar);
            __builtin_amdgcn_fence(__ATOMIC_ACQUIRE, "agent");
            asm volatile("s_waitcnt vmcnt(0)" ::: "memory");
        }
    }
    __syncthreads();
}

struct Args { const float* in[18]; float* out; unsigned char* wsp; int ph_lo, ph_hi; };

__global__ void __launch_bounds__(512, 2) mega_fwd(Args args) {
    extern __shared__ __attribute__((aligned(16))) unsigned char lds[];
    const int G = gridDim.x, bid = blockIdx.x, NGW = G * 8;
    const int wave0 = __builtin_amdgcn_readfirstlane((int)threadIdx.x >> 6);
    typedef const __attribute__((address_space(4))) Args* KArgP;
    LAS unsigned char* ldsl = (LAS unsigned char*)lds;
#define x_in (kap->in[0])
#define rel_bias (kap->in[1])
#define norm_mix_pre (kap->in[2])
#define norm_mix_post (kap->in[3])
#define norm_ffn_pre (kap->in[4])
#define norm_ffn_post (kap->in[5])
#define w_in (kap->in[6])
#define diff_lambda (kap->in[7])
#define diff_subln (kap->in[8])
#define mla_q_norm (kap->in[9])
#define mla_kv_norm (kap->in[10])
#define mla_w_uq (kap->in[11])
#define mla_w_ukv (kap->in[12])
#define gqa_q_norm (kap->in[13])
#define gqa_k_norm (kap->in[14])
#define w_out (kap->in[15])
#define w_gate_up (kap->in[16])
#define w_down (kap->in[17])
#define xres (kap->out)
#define ws (kap->wsp)
#define PAR ((float*)(ws + WS_PAR))
#define TBLA ((float*)(ws + WS_TBLA))
#define TBLD ((float*)(ws + WS_TBLD))
#define COS ((float*)(ws + WS_COS))
#define SIN ((float*)(ws + WS_SIN))
#define H ((bf16_t*)(ws + WS_H))
#define PROJ ((bf16_t*)(ws + WS_PROJ))
#define CQN ((bf16_t*)(ws + WS_CQN))
#define CKVN ((bf16_t*)(ws + WS_CKVN))
#define KPE ((bf16_t*)(ws + WS_KPE))
#define QC ((bf16_t*)(ws + WS_QC))
#define KC ((bf16_t*)(ws + WS_KC))
#define QB ((bf16_t*)(ws + WS_QB))
#define KVB ((bf16_t*)(ws + WS_KVB))
#define MIX ((bf16_t*)(ws + WS_MIX))
#define Y ((bf16_t*)(ws + WS_Y))
#define HID ((bf16_t*)(ws + WS_HID))
#define TMP ((float*)(ws + WS_TMP))
#define wl (ws + WS_W + (size_t)l * LW)

    volatile LAS unsigned* bst = (volatile LAS unsigned*)(ldsl + LDS_ST_OFF);
    { const bool leader0 = (wave0 == 0) && (lane_id_v() == 0);
      if (leader0) { bst[0] = 0u; bst[1] = 0u; }
      __syncthreads();
      if (leader0 && !MK_MULTI) { KArgP kap0 = (KArgP)__builtin_amdgcn_kernarg_segment_ptr(); (void)xb_add(&((unsigned*)(kap0->wsp + WS_BAR))[XB_XCNT(xb_xcc_id())], 1u); } }
    const int lo = args.ph_lo, hi_ph = args.ph_hi; int ph = 0;
#define PH_BEGIN if (ph >= lo && ph < hi_ph) { KArgP kap = (KArgP)__builtin_amdgcn_kernarg_segment_ptr(); asm volatile("" : "+s"(kap)); \
    int tid_ = wave0 * 64 + lane_id_v(); const int tid = tid_, lane = tid & 63, wave = __builtin_amdgcn_readfirstlane(tid >> 6), gw = bid * 8 + wave; (void)lane; (void)gw;
#define PH_END } if (ph >= lo && ph + 1 < hi_ph) { if (ph == 0) { cg::this_grid().sync(); } else { KArgP kapb = (KArgP)__builtin_amdgcn_kernarg_segment_ptr(); asm volatile("" : "+s"(kapb)); \
      xcd_barrier((unsigned*)(kapb->wsp + WS_BAR), bst, (wave0 == 0) && (lane_id_v() == 0)); } } ++ph;

    PH_BEGIN
    if PHON(0) {
        LAS float* scr = (LAS float*)(ldsl + wave * 16384);
        for (int l = 0; l < DEPTH; ++l) {
            transpose_matrix<2>(w_in + (size_t)l * DM * NPROJ, DM, NPROJ, (bf16_t*)(wl + W_IN), scr, lane, gw, NGW);
            transpose_matrix<3>(mla_w_uq + (size_t)l * 512 * 768, 512, 768, (bf16_t*)(wl + W_UQ), scr, lane, gw, NGW);
            transpose_matrix<0>(mla_w_ukv + (size_t)l * 256 * 1024, 256, 1024, (bf16_t*)(wl + W_UKV), scr, lane, gw, NGW);
            transpose_matrix<0>(w_out + (size_t)l * DM * DM, DM, DM, (bf16_t*)(wl + W_OUT), scr, lane, gw, NGW);
            transpose_matrix<1>(w_gate_up + (size_t)l * DM * NGU, DM, NGU, (bf16_t*)(wl + W_GU), scr, lane, gw, NGW);
            transpose_matrix<0>(w_down + (size_t)l * FF * DM, FF, DM, (bf16_t*)(wl + W_D), scr, lane, gw, NGW);
            { u32x4* z = (u32x4*)((bf16_t*)(wl + W_IN) + (size_t)NPROJ * DM); const int n16 = (LDP - NPROJ) * DM * 2 / 16;
              for (int i = bid * 512 + tid; i < n16; i += G * 512) z[i] = (u32x4){0u, 0u, 0u, 0u}; }
        }
        const int gt = bid * 512 + tid, NT_ = G * 512;
        for (int i = gt; i < 4 * TBLN; i += NT_) { const int h = i / TBLN, d = (i % TBLN) - TOFF; const int b = t5_bucket(d);
            TBLA[i] = rel_bias[b * 8 + h] * 1.4426950408889634f;
            const int n = d < 0 ? -d : d; int mult = (n <= 64 ? 1 : 0) + (((n & 3) == 0 && n <= 256) ? 1 : 0) + (((n & 15) == 0 && n <= 1024) ? 1 : 0);
            TBLD[i] = mult ? (rel_bias[b * 8 + 4 + h] + logf((float)mult)) * 1.4426950408889634f : -1e30f; }
        for (int i = gt; i < S * 32; i += NT_) { const int pos = i >> 5, f = i & 31;
            const float inv = (float)pow(10000.0, -(double)(2 * f) / 64.0); const float ang = (float)pos * inv;
            COS[i] = (float)cos((double)ang); SIN[i] = (float)sin((double)ang); }
        if (bid == 0 && tid < DEPTH) { const float* lv = diff_lambda + tid * 256; float s1 = 0.f, s2 = 0.f;
            for (int i = 0; i < 64; ++i) { s1 += lv[i] * lv[64 + i]; s2 += lv[128 + i] * lv[192 + i]; }
            const float lam_init = 0.8f - 0.6f * expf(-0.3f * (float)tid);
            PAR[tid] = expf(s1) - expf(s2) + lam_init; PAR[4 + tid] = lam_init; }
        for (int row = gw; row < S; row += NGW) norm_row(x_in + (size_t)row * DM, norm_mix_pre, H + (size_t)row * DM, lane);
    }
    PH_END

    for (int l = 0; l < DEPTH; ++l) {
        PH_BEGIN
        if PHON(1) for (int rep_ = 0; rep_ < MK_DUP_GEMM; ++rep_) { pg8::Gemm g{H, (const bf16_t*)(wl + W_IN), S, LDP, DM}; pg8::StaticOrder So; So.init(S, LDP, G, bid);
          pg8::EpiBf16 E{PROJ, LDP};
          pg8::gemm_phase<pg8::EpiBf16, pg8::StaticOrder, true, true>(ldsl, g, So, E, wave0); }
        PH_END
        PH_BEGIN
        if PHON(2) for (int row = gw; row < S; row += NGW) {
            const bf16_t* pr = PROJ + (size_t)row * LDP;
            { const u32x4 raw = *(const u32x4*)(pr + C_BCQ + lane * 8); float v[8];
              v[0] = __uint_as_float(raw.x << 16); v[1] = __uint_as_float(raw.x & 0xffff0000u); v[2] = __uint_as_float(raw.y << 16); v[3] = __uint_as_float(raw.y & 0xffff0000u);
              v[4] = __uint_as_float(raw.z << 16); v[5] = __uint_as_float(raw.z & 0xffff0000u); v[6] = __uint_as_float(raw.w << 16); v[7] = __uint_as_float(raw.w & 0xffff0000u);
              float ss = 0.f;
#pragma unroll
              for (int i = 0; i < 8; ++i) ss += v[i] * v[i];
              const float rs = rsqrtf(wave_sum(ss) * (1.0f / 512.0f) + EPS);
              const f32x4 g0 = *(const f32x4*)(mla_q_norm + l * 512 + lane * 8), g1 = *(const f32x4*)(mla_q_norm + l * 512 + lane * 8 + 4);
              u32x4 w; w.x = pk2(v[0] * rs * g0.x, v[1] * rs * g0.y); w.y = pk2(v[2] * rs * g0.z, v[3] * rs * g0.w); w.z = pk2(v[4] * rs * g1.x, v[5] * rs * g1.y); w.w = pk2(v[6] * rs * g1.z, v[7] * rs * g1.w);
              *(u32x4*)(CQN + (size_t)row * 512 + lane * 8) = w; }
            { const u32x2 raw = *(const u32x2*)(pr + C_BCKV + lane * 4); float v[4];
              v[0] = __uint_as_float(raw.x << 16); v[1] = __uint_as_float(raw.x & 0xffff0000u); v[2] = __uint_as_float(raw.y << 16); v[3] = __uint_as_float(raw.y & 0xffff0000u);
              float ss = v[0] * v[0] + v[1] * v[1] + v[2] * v[2] + v[3] * v[3];
              const float rs = rsqrtf(wave_sum(ss) * (1.0f / 256.0f) + EPS);
              const f32x4 g0 = *(const f32x4*)(mla_kv_norm + l * 256 + lane * 4);
              u32x2 w; w.x = pk2(v[0] * rs * g0.x, v[1] * rs * g0.y); w.y = pk2(v[2] * rs * g0.z, v[3] * rs * g0.w);
              *(u32x2*)(CKVN + (size_t)row * 256 + lane * 4) = w; }
            if (lane < 32) { const float x1 = bf2f(pr[C_BKPE + lane]), x2 = bf2f(pr[C_BKPE + 32 + lane]); const float c = COS[row * 32 + lane], s = SIN[row * 32 + lane];
              KPE[(size_t)row * 64 + lane] = (bf16_t)f2bf(x1 * c - x2 * s); KPE[(size_t)row * 64 + 32 + lane] = (bf16_t)f2bf(x2 * c + x1 * s); }
            { const int hd = lane >> 4, t = lane & 15;
              head_norm_axial(pr + C_CQ + hd * 128, QC + (size_t)row * 512 + hd * 128, gqa_q_norm + l * 128, COS, SIN, row, t, QS_CD);
              const int hk = hd & 1;
              if (lane < 32) head_norm_axial(pr + C_CK + hk * 128, KC + (size_t)row * 256 + hk * 128, gqa_k_norm + l * 128, COS, SIN, row, t, 1.0f); }
        }
        PH_END
        PH_BEGIN
        if PHON(3) { pg8::Gemm g{CQN, (const bf16_t*)(wl + W_UQ), S, 768, 512}; pg8::StaticOrder So; So.init(S, 768, G, bid);
          pg8::EpiBf16 E{QB, 768};
          pg8::gemm_phase<pg8::EpiBf16, pg8::StaticOrder, true, true>(ldsl, g, So, E, wave0); }
        if PHON(4) { pg8::Gemm g{CKVN, (const bf16_t*)(wl + W_UKV), S, 1024, 256}; pg8::StaticOrder So; So.init(S, 1024, G, bid);
          pg8::EpiBf16 E{KVB, 1024};
          pg8::gemm_phase<pg8::EpiBf16, pg8::StaticOrder, true, true>(ldsl, g, So, E, wave0); }
        PH_END
        PH_BEGIN
        for (int rep_ = 0; rep_ < MK_DUP_ATT; ++rep_) {
            const float lam = __int_as_float(__builtin_amdgcn_readfirstlane(__float_as_int(PAR[l]))), lam_init = __int_as_float(__builtin_amdgcn_readfirstlane(__float_as_int(PAR[4 + l])));
            const float L2E = 1.4426950408889634f;
            if PHON(6) for (int u = bid; u < 256; u += G) { const int xq = u & 7, hd = xq & 3, qb = (u >> 3) + 32 * (xq >> 2), q0 = qb * 256;
                { const float cb_lo = rel_bias[15 * 8 + hd] * L2E, cb_hi = rel_bias[31 * 8 + hd] * L2E;
                  att::attn_unit_A2(PROJ + (size_t)q0 * LDP + C_AQ + hd * 128, LDP, PROJ + C_AK + hd * 128, LDP, PROJ + C_AV + hd * 128, LDP, S, q0,
                                    TBLA + hd * TBLN, cb_lo, cb_hi, MIX + (size_t)q0 * DM + hd * 128, DM, lam, diff_subln + l * 128, 1.0f - lam_init, (char*)lds, wave0); }
            }
            if PHON(7) for (int u = bid; u < 256; u += G) { const int xq = u & 7, hd = xq & 3, qb = (u >> 3) + 32 * (xq >> 2), q0 = qb * 256;
                { const float sc = 0.07216878364870322f;
                  att::attn_unit<12, 0, 0, 1, 8, 1>(QB + (size_t)q0 * 768 + hd * 192, 768, KVB + hd * 256, 1024, KPE, 64, KVB + hd * 256 + 128, 1024,
                                            0, S, q0, nullptr, 0.f, 0.f, MIX + (size_t)q0 * DM + 512 + hd * 128, DM, nullptr, 0.f, nullptr, 0.f, (char*)lds, wave0, COS, SIN); }
            }
            if (wave0 < 4) __builtin_amdgcn_s_setprio(1);
            if PHON(8) for (int u = bid; u < 256; u += G) { const int xq = u & 7, hd = xq & 3, qb = (u >> 3) + 32 * (xq >> 2), q0 = qb * 256;
                { const float sc = 0.08838834764831845f;
                  if (wave0 < 4) att::attn_unit<8, 0, 0, 1, 0, 0, 0>(QC + (size_t)q0 * 512 + hd * 128, 512, KC + (hd >> 1) * 128, 256, nullptr, 0, PROJ + C_CV + (hd >> 1) * 128, LDP,
                                           0, S, q0, nullptr, 0.f, 0.f, MIX + (size_t)q0 * DM + 1024 + hd * 128, DM, nullptr, 0.f, nullptr, 0.f, (char*)lds, wave0); else att::attn_unit<8, 0, 0, 1, 0, 0, 1>(QC + (size_t)q0 * 512 + hd * 128, 512, KC + (hd >> 1) * 128, 256, nullptr, 0, PROJ + C_CV + (hd >> 1) * 128, LDP,
                                           0, S, q0, nullptr, 0.f, 0.f, MIX + (size_t)q0 * DM + 1024 + hd * 128, DM, nullptr, 0.f, nullptr, 0.f, (char*)lds, wave0); }
            }
            __builtin_amdgcn_s_setprio(0);
            if PHON(9) for (int u = bid; u < 256; u += G) { const int xq = u & 7, hd = xq & 3, qb = (u >> 3) + 32 * (xq >> 2), q0 = qb * 256;
                { const float sc = 0.08838834764831845f;
                  const int kb = q0 - 1024 < 0 ? 0 : q0 - 1024, ke = q0 + 256 + 1024 > S ? S : q0 + 256 + 1024;
                  att::attn_unit<8, 1, 0, 1>(PROJ + (size_t)q0 * LDP + C_DQ + hd * 128, LDP, PROJ + C_DK + hd * 128, LDP, nullptr, 0, PROJ + C_DV + hd * 128, LDP,
                                           kb, ke - kb, q0, TBLD + hd * TBLN, 0.f, 0.f, MIX + (size_t)q0 * DM + 1536 + hd * 128, DM, nullptr, 0.f, nullptr, 0.f, (char*)lds, wave0); }
            }
            __syncthreads();
        }
        PH_END
        PH_BEGIN
        if PHON(10) for (int rep_ = 0; rep_ < MK_DUP_GEMM; ++rep_) { pg8::Gemm g{MIX, (const bf16_t*)(wl + W_OUT), S, DM, DM}; pg8::StaticOrder So; So.init(S, DM, G, bid);
          pg8::EpiBf16 E{Y, DM};
          pg8::gemm_phase<pg8::EpiBf16, pg8::StaticOrder, true, true>(ldsl, g, So, E, wave0); }
        PH_END
        PH_BEGIN
        if PHON(11) { int row = gw;
            for (; row + NGW < S; row += 2 * NGW) norm_add_rows<2>(Y, (l == 0 ? x_in : xres), xres, norm_mix_post + l * DM, norm_ffn_pre + l * DM, H, row, NGW, lane);
            for (; row < S; row += NGW) norm_add_rows<1>(Y, (l == 0 ? x_in : xres), xres, norm_mix_post + l * DM, norm_ffn_pre + l * DM, H, row, NGW, lane); }
        PH_END
        PH_BEGIN
        if PHON(12) for (int rep_ = 0; rep_ < MK_DUP_GEMM; ++rep_) { pg8::Gemm g{H, (const bf16_t*)(wl + W_GU), S, NGU, DM}; pg8::StaticOrder So; So.init(S, NGU, G, bid);
          pg8::EpiSwiGLU E{HID, FF};
          pg8::gemm_phase<pg8::EpiSwiGLU, pg8::StaticOrder, true, true>(ldsl, g, So, E, wave0); }
        PH_END
        PH_BEGIN
        if PHON(13) for (int rep_ = 0; rep_ < MK_DUP_GEMM; ++rep_) { pg8::Gemm g{HID, (const bf16_t*)(wl + W_D), S, DM, FF}; pg8::StaticOrder So; So.init(S, DM, G, bid);
          pg8::EpiBf16 E{Y, DM};
          pg8::gemm_phase<pg8::EpiBf16, pg8::StaticOrder, true, true>(ldsl, g, So, E, wave0); }
        PH_END
        PH_BEGIN
        if PHON(14) { int row = gw; const float* gnext = (l + 1 < DEPTH) ? norm_mix_pre + (l + 1) * DM : nullptr;
            for (; row + NGW < S; row += 2 * NGW) norm_add_rows<2>(Y, xres, xres, norm_ffn_post + l * DM, gnext, H, row, NGW, lane);
            for (; row < S; row += NGW) norm_add_rows<1>(Y, xres, xres, norm_ffn_post + l * DM, gnext, H, row, NGW, lane); }
        PH_END
    }
#undef PH_BEGIN
#undef PH_END
}
#undef x_in
#undef rel_bias
#undef norm_mix_pre
#undef norm_mix_post
#undef norm_ffn_pre
#undef norm_ffn_post
#undef w_in
#undef diff_lambda
#undef diff_subln
#undef mla_q_norm
#undef mla_kv_norm
#undef mla_w_uq
#undef mla_w_ukv
#undef gqa_q_norm
#undef gqa_k_norm
#undef w_out
#undef w_gate_up
#undef w_down
#undef xres
#undef ws
#undef PAR
#undef TBLA
#undef TBLD
#undef COS
#undef SIN
#undef H
#undef PROJ
#undef CQN
#undef CKVN
#undef KPE
#undef QC
#undef KC
#undef QB
#undef KVB
#undef MIX
#undef Y
#undef HID
#undef TMP
#undef wl

constexpr int N_PHASES = 1 + DEPTH * 9;

extern "C" void kernel_launch(void* const* d_in, const int* in_sizes, int n_in, void* d_out, int out_size, void* d_ws, size_t ws_size, hipStream_t stream) {
    static int grid = 0;
    if (grid == 0) {
        if (n_in != 18 || in_sizes[0] != S * DM || out_size != S * DM || ws_size < WS_END) {
            fprintf(stderr, "kernel_launch: unexpected shapes (n_in %d, in0 %d, out %d, ws %zu < %zu)\n", n_in, n_in > 0 ? in_sizes[0] : -1, out_size, ws_size, (size_t)WS_END); grid = -1; return; }
        int dev = 0, cus = 0, per_cu = 0;
        if (hipGetDevice(&dev) != hipSuccess || hipDeviceGetAttribute(&cus, hipDeviceAttributeMultiprocessorCount, dev) != hipSuccess) { grid = -1; return; }
        if (hipFuncSetAttribute((const void*)mega_fwd, hipFuncAttributeMaxDynamicSharedMemorySize, LDS_BYTES) != hipSuccess) { fprintf(stderr, "kernel_launch: hipFuncSetAttribute failed\n"); grid = -1; return; }
        if (hipOccupancyMaxActiveBlocksPerMultiprocessor(&per_cu, (const void*)mega_fwd, 512, LDS_BYTES) != hipSuccess || per_cu < 1) { fprintf(stderr, "kernel_launch: occupancy query says %d\n", per_cu); per_cu = 1; }
        (void)hipGetLastError();
        grid = cus;
    }
    if (grid < 0) return;
    if (hipMemsetAsync((char*)d_ws + WS_BAR, 0, WS_BAR_BYTES, stream) != hipSuccess) { fprintf(stderr, "kernel_launch: hipMemsetAsync of the barrier words failed\n"); return; }
    Args a{};
    for (int i = 0; i < 18; ++i) a.in[i] = (const float*)d_in[i];
    a.out = (float*)d_out; a.wsp = (unsigned char*)d_ws;
#if MK_MULTI
    for (int p = 0; p < N_PHASES; ++p) { a.ph_lo = p; a.ph_hi = p + 1; hipLaunchKernelGGL(mega_fwd, dim3(grid), dim3(512), LDS_BYTES, stream, a); }
#else
    a.ph_lo = 0; a.ph_hi = N_PHASES;
    void* kargs[] = {&a};
    hipError_t e = hipLaunchCooperativeKernel((const void*)mega_fwd, dim3(grid), dim3(512), kargs, LDS_BYTES, stream);
    if (e != hipSuccess) fprintf(stderr, "kernel_launch: cooperative launch failed: %s (grid %d)\n", hipGetErrorString(e), grid);
#endif
}
```

```cpp
#include <hip/hip_runtime.h>
#include <hip/hip_cooperative_groups.h>
#include <cstdio>
#include <cstdint>
namespace cg = cooperative_groups;

#ifndef MK_MULTI
#define MK_MULTI 0
#endif
#ifndef MK_PHMASK
#define MK_PHMASK 0xFFFFF
#endif
#define PHON(k) constexpr (((MK_PHMASK) >> (k)) & 1)
#ifndef MK_DUP_GEMM
#define MK_DUP_GEMM 1
#endif
#ifndef MK_DUP_ATT
#define MK_DUP_ATT 1
#endif

typedef unsigned short bf16_t;
typedef short bf16x8 __attribute__((ext_vector_type(8)));
typedef short s16x4 __attribute__((ext_vector_type(4)));
typedef float f32x2 __attribute__((ext_vector_type(2)));
typedef float f32x4 __attribute__((ext_vector_type(4)));
typedef float f32x16 __attribute__((ext_vector_type(16)));
typedef unsigned u32x2 __attribute__((ext_vector_type(2)));
typedef unsigned u32x4 __attribute__((ext_vector_type(4)));
#define LAS __attribute__((address_space(3)))

constexpr int S = 16384, DM = 2048, DEPTH = 4, NPROJ = 4928, LDP = 5120, FF = 5632, NGU = 2 * FF;
constexpr float EPS = 1e-6f;
constexpr int C_AQ = 0, C_AK = 512, C_AV = 1024, C_BCQ = 1536, C_BCKV = 2048, C_BKPE = 2304, C_CQ = 2368, C_CK = 2880, C_CV = 3136, C_DQ = 3392, C_DK = 3904, C_DV = 4416;
constexpr int TOFF = 1408, TBLN = 2824;

constexpr size_t MiB = 1u << 20;
constexpr size_t WS_PAR = 0, WS_TBLA = 1 * MiB, WS_TBLD = 1 * MiB + 65536, WS_COS = 2 * MiB, WS_SIN = 4 * MiB;
constexpr size_t WS_BAR = 6 * MiB, WS_BAR_BYTES = 16384;
constexpr size_t WS_W = 8 * MiB, LW = 96 * MiB;
constexpr size_t W_IN = 0, W_UQ = 20 * MiB, W_UKV = 21 * MiB, W_OUT = 22 * MiB, W_GU = 30 * MiB, W_D = 74 * MiB;
constexpr size_t WS_H = 392 * MiB, WS_PROJ = 456 * MiB, WS_CQN = 616 * MiB, WS_CKVN = 632 * MiB, WS_KPE = 640 * MiB, WS_QC = 642 * MiB, WS_KC = 658 * MiB;
constexpr size_t WS_QB = 666 * MiB, WS_KVB = 690 * MiB, WS_MIX = 722 * MiB, WS_Y = 786 * MiB, WS_HID = 914 * MiB, WS_TMP = 1090 * MiB, WS_END = 1122 * MiB;

constexpr int LDS_ST_OFF = 163840 - 16;
constexpr int LDS_BYTES = 163840;

__device__ __forceinline__ float bf2f(unsigned short b) { return __uint_as_float(((unsigned)b) << 16); }
__device__ __forceinline__ unsigned f2bf(float f) { unsigned u = __float_as_uint(f); return (u + 0x7fffu + ((u >> 16) & 1u)) >> 16; }
__device__ __forceinline__ unsigned pk2(float lo, float hi) { return f2bf(lo) | (f2bf(hi) << 16); }
__device__ __forceinline__ unsigned cvt_pk_bf16(float lo, float hi) { unsigned r; asm volatile("v_cvt_pk_bf16_f32 %0, %1, %2" : "=v"(r) : "v"(lo), "v"(hi)); return r; }
__device__ __forceinline__ int lane_id_v() { int l; asm volatile("v_mbcnt_lo_u32_b32 %0, -1, 0\n\tv_mbcnt_hi_u32_b32 %0, -1, %0" : "=v"(l)); return l; }
template <int M> __device__ __forceinline__ float swz_xor(float v) { return __int_as_float(__builtin_amdgcn_ds_swizzle(__float_as_int(v), (M << 10) | 0x1f)); }
__device__ __forceinline__ float wave_sum(float v) {
    v += swz_xor<1>(v); v += swz_xor<2>(v); v += swz_xor<4>(v); v += swz_xor<8>(v); v += swz_xor<16>(v);
    auto rr = __builtin_amdgcn_permlane32_swap(__float_as_uint(v), __float_as_uint(v), false, false);
    return __uint_as_float(rr[0]) + __uint_as_float(rr[1]);
}

namespace pg8 {
constexpr int BM = 256, BK = 64, HALF = 128, HTB = HALF * BK * 2, STAGE_BYTES = 8 * HTB, NXCD = 8, WGM = 8;
__host__ __device__ __forceinline__ int lds_byte(int r, int c) { const int st = (r >> 4) * 2 + (c >> 5), rr = r & 15, cc = c & 31, ob = rr * 64 + cc * 2; return st * 1024 + (ob ^ (((ob >> 9) & 1) << 5)); }
__host__ __device__ __forceinline__ void stage_rc(int b, int& R, int& C) { const int st = b / 1024, sb = b % 1024, swz = sb ^ (((sb >> 9) & 1) << 5); R = (st >> 1) * 16 + swz / 64; C = (st & 1) * 32 + (swz % 64) / 2; }
__host__ __device__ __forceinline__ int perm32(int rho) { const int n = rho >> 4, i = rho & 15; return 8 * (i >> 2) + 4 * n + (i & 3); }

struct Unit { int pm, pn; };
struct Gemm { const bf16_t* A; const bf16_t* Bt; int M, N, K; };

struct StaticOrder {
    int nM, nN, nwg, G, c;
    __host__ __device__ void init(int M, int N, int G_, int c_) { nM = M / BM; nN = N / BM; nwg = nM * nN; G = G_; c = c_; }
    __host__ __device__ bool next(int i, Unit& u) const {
        const long L = (long)i * G + c; if (L >= nwg) return false;
        int wgid = (int)L; { const int q = nwg / NXCD, r = nwg % NXCD, xcd = wgid % NXCD, off = wgid / NXCD; wgid = (xcd < r ? xcd * (q + 1) : r * (q + 1) + (xcd - r) * q) + off; }
        const int nig = WGM * nN, gid = wgid / nig, fm = gid * WGM, gsz = (nM - fm) < WGM ? (nM - fm) : WGM;
        u.pm = fm + ((wgid % nig) % gsz); u.pn = (wgid % nig) / gsz; return true;
    }
    __device__ __forceinline__ void a_ready(const Unit&) const {}
    __device__ __forceinline__ void done(const Unit&) const {}
};

struct EpiBf16 {
    static constexpr bool PERM = true, AFTER_DRAIN = false;
    bf16_t* O; int ldc;
    __device__ __forceinline__ void operator()(const f32x4 (&acc)[2][2][4][2], const Unit& u, int wr, int wc, int fr, int fq) const {
        const int row0 = u.pm * BM + wr * 64 + fr; const int col0 = u.pn * BM + wc * 32 + 8 * fq;
#pragma unroll
        for (int ai = 0; ai < 2; ++ai)
#pragma unroll
            for (int m = 0; m < 4; ++m) { bf16_t* rowp = O + (size_t)(row0 + ai * HALF + m * 16) * ldc + col0;
#pragma unroll
                for (int bj = 0; bj < 2; ++bj) { const f32x4 v0 = acc[ai][bj][m][0], v1 = acc[ai][bj][m][1];
                    u32x4 w; w.x = cvt_pk_bf16(v0[0], v0[1]); w.y = cvt_pk_bf16(v0[2], v0[3]); w.z = cvt_pk_bf16(v1[0], v1[1]); w.w = cvt_pk_bf16(v1[2], v1[3]);
                    *(u32x4*)(rowp + bj * HALF) = w; } }
    }
};
struct EpiF32 {
    static constexpr bool PERM = false, AFTER_DRAIN = false;
    float* O; int ldc;
    __device__ __forceinline__ void operator()(const f32x4 (&acc)[2][2][4][2], const Unit& u, int wr, int wc, int fr, int fq) const {
        const int row0 = u.pm * BM + wr * 64 + fr; const int col0 = u.pn * BM + wc * 32 + 4 * fq;
#pragma unroll
        for (int ai = 0; ai < 2; ++ai)
#pragma unroll
            for (int m = 0; m < 4; ++m) { float* rowp = O + (size_t)(row0 + ai * HALF + m * 16) * ldc + col0;
#pragma unroll
                for (int bj = 0; bj < 2; ++bj)
#pragma unroll
                    for (int n = 0; n < 2; ++n) *(f32x4*)(rowp + bj * HALF + n * 16) = acc[ai][bj][m][n]; }
    }
};
__device__ __forceinline__ float silu_mul(float g, float u) {
    const float e = __builtin_amdgcn_exp2f(-g * 1.4426950408889634f);
    return g * __builtin_amdgcn_rcpf(1.0f + e) * u;
}
struct EpiSwiGLU {
    static constexpr bool PERM = true, AFTER_DRAIN = false;
    bf16_t* O; int ldc;
    __device__ __forceinline__ void operator()(const f32x4 (&acc)[2][2][4][2], const Unit& u, int wr, int wc, int fr, int fq) const {
        const int row0 = u.pm * BM + wr * 64 + fr; const int col0 = u.pn * HALF + wc * 32 + 8 * fq;
#pragma unroll
        for (int ai = 0; ai < 2; ++ai)
#pragma unroll
            for (int m = 0; m < 4; ++m) { bf16_t* rowp = O + (size_t)(row0 + ai * HALF + m * 16) * ldc + col0;
                const f32x4 g0 = acc[ai][0][m][0], g1 = acc[ai][0][m][1], u0 = acc[ai][1][m][0], u1 = acc[ai][1][m][1];
                u32x4 w; w.x = cvt_pk_bf16(silu_mul(g0[0], u0[0]), silu_mul(g0[1], u0[1])); w.y = cvt_pk_bf16(silu_mul(g0[2], u0[2]), silu_mul(g0[3], u0[3]));
                w.z = cvt_pk_bf16(silu_mul(g1[0], u1[0]), silu_mul(g1[1], u1[1])); w.w = cvt_pk_bf16(silu_mul(g1[2], u1[2]), silu_mul(g1[3], u1[3]));
                *(u32x4*)rowp = w; }
    }
};

template <class Epi, class Sched, bool ALIGN_EPI = false, bool SP2 = false>
__device__ __forceinline__ void gemm_phase(LAS unsigned char* lds, const Gemm g, const Sched& S, const Epi& E, const int wave0) {
    int tid_ = wave0 * 64 + lane_id_v();
    const int tid = tid_, wid = __builtin_amdgcn_readfirstlane(tid >> 6), lane = tid & 63, wr = wid >> 2, wc = wid & 3, fr = lane & 15, fq = lane >> 4;
    int K_ = g.K; asm volatile("" : "+s"(K_));
    const int K = K_, nt = K / BK;
    unsigned voffA[2], voffB[2];
#pragma unroll
    for (int i = 0; i < 2; ++i) { int R, C; stage_rc(tid * 16 + i * 8192, R, C); const int Rb = Epi::PERM ? ((R & ~31) + perm32(R & 31)) : R;
        voffA[i] = (unsigned)(R * K + C) * 2u; voffB[i] = (unsigned)(Rb * K + C) * 2u; }
    const size_t kstep = (size_t)(BK * 2);
    const size_t hstep = (size_t)HALF * K * 2;
    const size_t tstep = 2 * hstep;
    const unsigned ldsw = (unsigned)wid * 1024u;
    const int aoff = lds_byte(wr * 64 + fr, fq * 8), boff = lds_byte(wc * 32 + fr, fq * 8);
#define PG8_SA(b, h) (((b) * 2 + (h)) * HTB)
#define PG8_SB(b, h) ((4 + (b) * 2 + (h)) * HTB)
#define PG8_STAGE(bufoff, gbase, voff) do { _Pragma("unroll") for (int _i = 0; _i < 2; ++_i) \
        __builtin_amdgcn_global_load_lds((const unsigned*)((const char*)(gbase) + (voff)[_i]), (LAS unsigned*)(lds + (bufoff) + ldsw + _i * 8192), 16, 0, 0); } while (0)
#define PG8_LDA(dst, b, h) do { _Pragma("unroll") for (int m = 0; m < 4; ++m) _Pragma("unroll") for (int k = 0; k < 2; ++k) dst[m][k] = *(const LAS bf16x8*)(lds + PG8_SA(b, h) + aoff + m * 2048 + k * 1024); } while (0)
#define PG8_LDB(dst, b, h) do { _Pragma("unroll") for (int n = 0; n < 2; ++n) _Pragma("unroll") for (int k = 0; k < 2; ++k) dst[n][k] = *(const LAS bf16x8*)(lds + PG8_SB(b, h) + boff + n * 2048 + k * 1024); } while (0)
#define PG8_MMA(ai, bj, At, Bt) do { __builtin_amdgcn_s_setprio(1); _Pragma("unroll") for (int m = 0; m < 4; ++m) _Pragma("unroll") for (int n = 0; n < 2; ++n) _Pragma("unroll") for (int k = 0; k < 2; ++k) \
        acc[ai][bj][m][n] = __builtin_amdgcn_mfma_f32_16x16x32_bf16(Bt[n][k], At[m][k], acc[ai][bj][m][n], 0, 0, 0); __builtin_amdgcn_s_setprio(0); } while (0)
#define PG8_WAIT_V(n) asm volatile("s_waitcnt vmcnt(" #n ")" ::: "memory")
#define PG8_WAIT_L(n) asm volatile("s_waitcnt lgkmcnt(" #n ")" ::: "memory")
#define PG8_BAR __builtin_amdgcn_s_barrier()
#define PG8_SCHED __builtin_amdgcn_sched_barrier(0)
    Unit cur, nxt; int ui = 0;
    if (!S.next(0, cur)) return;
    f32x4 acc[2][2][4][2];
#pragma unroll
    for (int a = 0; a < 2; ++a)
#pragma unroll
        for (int b = 0; b < 2; ++b)
#pragma unroll
            for (int m = 0; m < 4; ++m)
#pragma unroll
                for (int n = 0; n < 2; ++n) acc[a][b][m][n] = (f32x4){0.f, 0.f, 0.f, 0.f};
    bf16x8 At[4][2], B0[2][2], B1[2][2];
    const char* cA = (const char*)g.A + (size_t)cur.pm * tstep; const char* cB = (const char*)g.Bt + (size_t)cur.pn * tstep;
    S.a_ready(cur);
    if constexpr (SP2) {
        PG8_STAGE(PG8_SB(0, 0), cB, voffB); PG8_STAGE(PG8_SB(0, 1), cB + hstep, voffB); PG8_STAGE(PG8_SA(0, 0), cA, voffA); PG8_STAGE(PG8_SA(0, 1), cA + hstep, voffA);
        if (wr == 1) PG8_BAR;
        PG8_WAIT_V(2); PG8_BAR;
        PG8_STAGE(PG8_SB(1, 0), cB + kstep, voffB); PG8_STAGE(PG8_SA(1, 0), cA + kstep, voffA); PG8_STAGE(PG8_SB(1, 1), cB + hstep + kstep, voffB);
        PG8_WAIT_V(6); PG8_BAR;
    } else {
        PG8_STAGE(PG8_SB(0, 0), cB, voffB); PG8_STAGE(PG8_SA(0, 0), cA, voffA); PG8_STAGE(PG8_SB(0, 1), cB + hstep, voffB); PG8_STAGE(PG8_SA(0, 1), cA + hstep, voffA);
        if (wr == 1) PG8_BAR;
        PG8_WAIT_V(4); PG8_BAR;
        PG8_STAGE(PG8_SB(1, 0), cB + kstep, voffB); PG8_STAGE(PG8_SA(1, 0), cA + kstep, voffA); PG8_STAGE(PG8_SB(1, 1), cB + hstep + kstep, voffB);
        PG8_WAIT_V(6); PG8_BAR;
    }
    for (;;) {
        const bool has_next = S.next(ui + 1, nxt);
        const char* nA = has_next ? (const char*)g.A + (size_t)nxt.pm * tstep : cA; const char* nB = has_next ? (const char*)g.Bt + (size_t)nxt.pn * tstep : cB;
        for (int t = 0; t < nt; t += 2) {
            const bool last = (t == nt - 2);
            const char* a1 = cA + (size_t)(t + 1) * kstep;
            const char* a2 = last ? nA : cA + (size_t)(t + 2) * kstep; const char* b2 = last ? nB : cB + (size_t)(t + 2) * kstep;
            const char* a3 = a2 + kstep; const char* b3 = b2 + kstep;
            if (last && has_next) S.a_ready(nxt);
            if constexpr (SP2) {
            PG8_LDB(B0, 0, 0); PG8_LDB(B1, 0, 1); PG8_SCHED; PG8_LDA(At, 0, 0); PG8_STAGE(PG8_SA(1, 1), a1 + hstep, voffA);
            PG8_WAIT_V(8); PG8_WAIT_L(0); PG8_BAR; PG8_MMA(0, 0, At, B0); PG8_MMA(0, 1, At, B1); PG8_BAR; PG8_SCHED;
            PG8_LDA(At, 0, 1); PG8_STAGE(PG8_SB(0, 0), b2, voffB); PG8_STAGE(PG8_SB(0, 1), b2 + hstep, voffB); PG8_STAGE(PG8_SA(0, 0), a2, voffA);
            PG8_WAIT_V(8); PG8_WAIT_L(0); PG8_BAR; PG8_MMA(1, 0, At, B0); PG8_MMA(1, 1, At, B1); PG8_BAR; PG8_SCHED;
            PG8_LDB(B0, 1, 0); PG8_LDB(B1, 1, 1); PG8_SCHED; PG8_LDA(At, 1, 0); PG8_STAGE(PG8_SA(0, 1), a2 + hstep, voffA);
            PG8_WAIT_V(8); PG8_WAIT_L(0); PG8_BAR; PG8_MMA(0, 0, At, B0); PG8_MMA(0, 1, At, B1); PG8_BAR; PG8_SCHED;
            PG8_LDA(At, 1, 1); PG8_STAGE(PG8_SB(1, 0), b3, voffB); PG8_STAGE(PG8_SB(1, 1), b3 + hstep, voffB); PG8_STAGE(PG8_SA(1, 0), a3, voffA);
            PG8_WAIT_V(8); PG8_WAIT_L(0); PG8_BAR; PG8_MMA(1, 0, At, B0); PG8_MMA(1, 1, At, B1); PG8_BAR; PG8_SCHED;
            } else {
            PG8_LDB(B0, 0, 0); PG8_SCHED; PG8_LDA(At, 0, 0); PG8_STAGE(PG8_SA(1, 1), a1 + hstep, voffA);
            PG8_WAIT_L(8); PG8_BAR; PG8_WAIT_L(0); PG8_MMA(0, 0, At, B0); PG8_BAR; PG8_SCHED;
            PG8_LDB(B1, 0, 1); PG8_STAGE(PG8_SB(0, 0), b2, voffB);
            PG8_BAR; PG8_WAIT_L(0); PG8_MMA(0, 1, At, B1); PG8_BAR;
            PG8_LDA(At, 0, 1); PG8_STAGE(PG8_SA(0, 0), a2, voffA);
            PG8_BAR; PG8_WAIT_L(0); PG8_MMA(1, 0, At, B0); PG8_BAR; PG8_SCHED;
            PG8_STAGE(PG8_SB(0, 1), b2 + hstep, voffB);
            PG8_WAIT_V(6); PG8_BAR; PG8_MMA(1, 1, At, B1); PG8_BAR;
            PG8_LDB(B0, 1, 0); PG8_SCHED; PG8_LDA(At, 1, 0); PG8_STAGE(PG8_SA(0, 1), a2 + hstep, voffA);
            PG8_WAIT_L(8); PG8_BAR; PG8_WAIT_L(0); PG8_MMA(0, 0, At, B0); PG8_BAR; PG8_SCHED;
            PG8_LDB(B1, 1, 1); PG8_STAGE(PG8_SB(1, 0), b3, voffB);
            PG8_BAR; PG8_WAIT_L(0); PG8_MMA(0, 1, At, B1); PG8_BAR;
            PG8_LDA(At, 1, 1); PG8_STAGE(PG8_SA(1, 0), a3, voffA);
            PG8_BAR; PG8_WAIT_L(0); PG8_MMA(1, 0, At, B0); PG8_BAR; PG8_SCHED;
            PG8_STAGE(PG8_SB(1, 1), b3 + hstep, voffB);
            PG8_WAIT_V(6); PG8_BAR; PG8_MMA(1, 1, At, B1); PG8_BAR;
            }
        }
        if constexpr (ALIGN_EPI) { if (wr == 0) PG8_BAR; }
        if constexpr (!Epi::AFTER_DRAIN) { E(acc, cur, wr, wc, fr, fq); S.done(cur); }
        if (!has_next) break;
#pragma unroll
        for (int a = 0; a < 2; ++a)
#pragma unroll
            for (int b = 0; b < 2; ++b)
#pragma unroll
                for (int m = 0; m < 4; ++m)
#pragma unroll
                    for (int n = 0; n < 2; ++n) acc[a][b][m][n] = (f32x4){0.f, 0.f, 0.f, 0.f};
        cur = nxt; cA = nA; cB = nB; ++ui;
        if constexpr (ALIGN_EPI) { if (wr == 1) PG8_BAR; }
    }
    PG8_WAIT_V(0);
    if constexpr (!ALIGN_EPI) { if (wr == 0) PG8_BAR; }
    PG8_BAR;
#undef PG8_SA
#undef PG8_SB
#undef PG8_STAGE
#undef PG8_LDA
#undef PG8_LDB
#undef PG8_MMA
#undef PG8_WAIT_V
#undef PG8_WAIT_L
#undef PG8_BAR
#undef PG8_SCHED
}
}

namespace att {
constexpr int NW = 8, QBLK = 32, KVBLK = 64;
constexpr int SHM_V = KVBLK * 128 * 2;
#define SBAR() __builtin_amdgcn_sched_barrier(0)
__device__ __forceinline__ int crow(int r, int hi) { return (r & 3) + 8 * (r >> 2) + 4 * hi; }
__device__ __forceinline__ unsigned cvtpk(float lo, float hi) { unsigned r; asm volatile("v_cvt_pk_bf16_f32 %0, %1, %2" : "=v"(r) : "v"(lo), "v"(hi)); return r; }

constexpr float THR2 = 8.0f * 1.4426950408889634f;
template <bool FIRST>
__device__ __forceinline__ void partialSM(f32x16& p0, f32x16& p1, float& mC, float& alpha) {
  float mx_[4] = {p0[0], p0[1], p0[2], p0[3]};
#pragma unroll
  for (int r = 4; r < 16; ++r) mx_[r & 3] = fmaxf(mx_[r & 3], p0[r]);
#pragma unroll
  for (int r = 0; r < 16; ++r) mx_[r & 3] = fmaxf(mx_[r & 3], p1[r]);
  float pmax = fmaxf(fmaxf(mx_[0], mx_[1]), fmaxf(mx_[2], mx_[3]));
  { auto rr = __builtin_amdgcn_permlane32_swap(__float_as_uint(pmax), __float_as_uint(pmax), false, false);
    pmax = fmaxf(__uint_as_float(rr[0]), __uint_as_float(rr[1])); }
  if (!FIRST && __builtin_expect(__all(pmax <= THR2), 1)) { alpha = 1.f; }
  else { const float delta = FIRST ? fmaxf(pmax, -200.f) : fmaxf(pmax, 0.f); alpha = FIRST ? 1.f : __builtin_amdgcn_exp2f(-delta); mC += delta;
#pragma unroll
    for (int r = 0; r < 16; ++r) p0[r] -= delta;
#pragma unroll
    for (int r = 0; r < 16; ++r) p1[r] -= delta; }
#pragma unroll
  for (int r = 0; r < 16; ++r) p0[r] = __builtin_amdgcn_exp2f(p0[r]);
}
template <bool EXP1 = true>
__device__ __forceinline__ void finishSM(f32x16& p0, f32x16& p1, float alpha, float& l_reg, bf16x8& pa0, bf16x8& pa1, bf16x8& pa2, bf16x8& pa3) {
  if constexpr (EXP1) {
#pragma unroll
  for (int r = 0; r < 16; ++r) p1[r] = __builtin_amdgcn_exp2f(p1[r]);
  }
  float sm_[4] = {p0[0], p0[1], p0[2], p0[3]};
#pragma unroll
  for (int r = 4; r < 16; ++r) sm_[r & 3] += p0[r];
#pragma unroll
  for (int r = 0; r < 16; ++r) sm_[r & 3] += p1[r];
  float ps = (sm_[0] + sm_[1]) + (sm_[2] + sm_[3]);
  { auto rr = __builtin_amdgcn_permlane32_swap(__float_as_uint(ps), __float_as_uint(ps), false, false);
    ps = __uint_as_float(rr[0]) + __uint_as_float(rr[1]); }
  l_reg = l_reg * alpha + ps;
#define PK4(P, BASE, OUT) do { unsigned a0 = cvtpk(P[BASE + 0], P[BASE + 1]), a1 = cvtpk(P[BASE + 2], P[BASE + 3]);   \
    unsigned b0 = cvtpk(P[BASE + 4], P[BASE + 5]), b1 = cvtpk(P[BASE + 6], P[BASE + 7]);                              \
    auto r0 = __builtin_amdgcn_permlane32_swap(a0, b0, false, false); auto r1 = __builtin_amdgcn_permlane32_swap(a1, b1, false, false); \
    u32x4 w = {r0[0], r1[0], r0[1], r1[1]}; OUT = *reinterpret_cast<bf16x8*>(&w); } while (0)
  PK4(p0, 0, pa0); PK4(p0, 8, pa1); PK4(p1, 0, pa2); PK4(p1, 8, pa3);
#undef PK4
}
template <int NDQ, int NQL>
__device__ __forceinline__ void qkt(f32x16& p0, f32x16& p1, const f32x16& negm, const char* Ks, const bf16x8* qr, const char* qls, int r32, int hi) {
  constexpr int ROWB = NDQ * 32, NQR = NDQ - NQL, SWM = (NDQ == 8) ? 15 : 7;
#pragma unroll
  for (int d0 = 0; d0 < NDQ; ++d0) { const int cb = (d0 * 16 + hi * 8) * 2;
    bf16x8 b0 = *reinterpret_cast<const bf16x8*>(Ks + r32 * ROWB + (cb ^ ((r32 & SWM) << 4)));
    bf16x8 b1 = *reinterpret_cast<const bf16x8*>(Ks + (32 + r32) * ROWB + (cb ^ ((r32 & SWM) << 4)));
    bf16x8 q;
    if constexpr (NQL > 0) { if (d0 < NQR) q = qr[d0 < NQR ? d0 : 0]; else q = *reinterpret_cast<const bf16x8*>(qls + (d0 - NQR) * 1024); }
    else q = qr[d0];
    if (d0 == 0) { p0 = __builtin_amdgcn_mfma_f32_32x32x16_bf16(b0, q, negm, 0, 0, 0); p1 = __builtin_amdgcn_mfma_f32_32x32x16_bf16(b1, q, negm, 0, 0, 0); }
    else { p0 = __builtin_amdgcn_mfma_f32_32x32x16_bf16(b0, q, p0, 0, 0, 0); p1 = __builtin_amdgcn_mfma_f32_32x32x16_bf16(b1, q, p1, 0, 0, 0); } }
}
template <int OFF> __device__ __forceinline__ bf16x8 lds_rd128(int a) { bf16x8 r; asm volatile("ds_read_b128 %0, %1 offset:%2" : "=&v"(r) : "v"(a), "i"(OFF) : "memory"); return r; }
#define SBAR_M() __builtin_amdgcn_sched_barrier(0)
__device__ __forceinline__ void qkt8_roll(f32x16& p0, f32x16& p1, const f32x16& negm, int kb, const bf16x8* qr) {
  const int a0 = kb ^ (0 << 5); const bf16x8 x0 = lds_rd128<0>(a0), y0 = lds_rd128<8192>(a0);
  const int a1 = kb ^ (1 << 5); const bf16x8 x1 = lds_rd128<0>(a1), y1 = lds_rd128<8192>(a1);
  const int a2 = kb ^ (2 << 5); const bf16x8 x2 = lds_rd128<0>(a2), y2 = lds_rd128<8192>(a2);
  asm volatile("s_waitcnt lgkmcnt(4)" ::: "memory"); SBAR_M();
  p0 = __builtin_amdgcn_mfma_f32_32x32x16_bf16(x0, qr[0], negm, 0, 0, 0); p1 = __builtin_amdgcn_mfma_f32_32x32x16_bf16(y0, qr[0], negm, 0, 0, 0);
  const int a3 = kb ^ (3 << 5); const bf16x8 x3 = lds_rd128<0>(a3), y3 = lds_rd128<8192>(a3);
  asm volatile("s_waitcnt lgkmcnt(4)" ::: "memory"); SBAR_M();
  p0 = __builtin_amdgcn_mfma_f32_32x32x16_bf16(x1, qr[1], p0, 0, 0, 0); p1 = __builtin_amdgcn_mfma_f32_32x32x16_bf16(y1, qr[1], p1, 0, 0, 0);
  const int a4 = kb ^ (4 << 5); const bf16x8 x4 = lds_rd128<0>(a4), y4 = lds_rd128<8192>(a4);
  asm volatile("s_waitcnt lgkmcnt(4)" ::: "memory"); SBAR_M();
  p0 = __builtin_amdgcn_mfma_f32_32x32x16_bf16(x2, qr[2], p0, 0, 0, 0); p1 = __builtin_amdgcn_mfma_f32_32x32x16_bf16(y2, qr[2], p1, 0, 0, 0);
  const int a5 = kb ^ (5 << 5); const bf16x8 x5 = lds_rd128<0>(a5), y5 = lds_rd128<8192>(a5);
  asm volatile("s_waitcnt lgkmcnt(4)" ::: "memory"); SBAR_M();
  p0 = __builtin_amdgcn_mfma_f32_32x32x16_bf16(x3, qr[3], p0, 0, 0, 0); p1 = __builtin_amdgcn_mfma_f32_32x32x16_bf16(y3, qr[3], p1, 0, 0, 0);
  const int a6 = kb ^ (6 << 5); const bf16x8 x6 = lds_rd128<0>(a6), y6 = lds_rd128<8192>(a6);
  asm volatile("s_waitcnt lgkmcnt(4)" ::: "memory"); SBAR_M();
  p0 = __builtin_amdgcn_mfma_f32_32x32x16_bf16(x4, qr[4], p0, 0, 0, 0); p1 = __builtin_amdgcn_mfma_f32_32x32x16_bf16(y4, qr[4], p1, 0, 0, 0);
  const int a7 = kb ^ (7 << 5); const bf16x8 x7 = lds_rd128<0>(a7), y7 = lds_rd128<8192>(a7);
  asm volatile("s_waitcnt lgkmcnt(4)" ::: "memory"); SBAR_M();
  p0 = __builtin_amdgcn_mfma_f32_32x32x16_bf16(x5, qr[5], p0, 0, 0, 0); p1 = __builtin_amdgcn_mfma_f32_32x32x16_bf16(y5, qr[5], p1, 0, 0, 0);
  asm volatile("s_waitcnt lgkmcnt(2)" ::: "memory"); SBAR_M();
  p0 = __builtin_amdgcn_mfma_f32_32x32x16_bf16(x6, qr[6], p0, 0, 0, 0); p1 = __builtin_amdgcn_mfma_f32_32x32x16_bf16(y6, qr[6], p1, 0, 0, 0);
  asm volatile("s_waitcnt lgkmcnt(0)" ::: "memory"); SBAR_M();
  p0 = __builtin_amdgcn_mfma_f32_32x32x16_bf16(x7, qr[7], p0, 0, 0, 0); p1 = __builtin_amdgcn_mfma_f32_32x32x16_bf16(y7, qr[7], p1, 0, 0, 0);
}

#define PK4S(P, BASE, OUT) do { unsigned a0 = cvtpk(P[BASE + 0], P[BASE + 1]), a1 = cvtpk(P[BASE + 2], P[BASE + 3]);   \
    unsigned b0 = cvtpk(P[BASE + 4], P[BASE + 5]), b1 = cvtpk(P[BASE + 6], P[BASE + 7]);                              \
    auto r0 = __builtin_amdgcn_permlane32_swap(a0, b0, false, false); auto r1 = __builtin_amdgcn_permlane32_swap(a1, b1, false, false); \
    u32x4 w = {r0[0], r1[0], r0[1], r1[1]}; OUT = *reinterpret_cast<bf16x8*>(&w); } while (0)
template <int K>
__device__ __forceinline__ void fsm_slice(f32x16& p0, f32x16& p1, float alpha, float& l_reg, bf16x8& pa0, bf16x8& pa1, bf16x8& pa2, bf16x8& pa3, float (&sm)[4]) {
  if constexpr (K == 2) {
    sm[0] = p0[0]; sm[1] = p0[1]; sm[2] = p0[2]; sm[3] = p0[3];
#pragma unroll
    for (int r = 4; r < 16; ++r) sm[r & 3] += p0[r];
  } else if constexpr (K == 3) {
#pragma unroll
    for (int r = 0; r < 16; ++r) sm[r & 3] += p1[r];
  } else if constexpr (K == 4) {
    float ps = (sm[0] + sm[1]) + (sm[2] + sm[3]);
    { auto rr = __builtin_amdgcn_permlane32_swap(__float_as_uint(ps), __float_as_uint(ps), false, false);
      ps = __uint_as_float(rr[0]) + __uint_as_float(rr[1]); }
    l_reg = l_reg * alpha + ps;
    PK4S(p0, 0, pa0);
  } else if constexpr (K == 5) { PK4S(p0, 8, pa1);
  } else if constexpr (K == 6) { PK4S(p1, 0, pa2);
  } else if constexpr (K == 7) { PK4S(p1, 8, pa3); }
}
template <int K>
__device__ __forceinline__ void psm_slice(f32x16& p0, f32x16& p1, float& mC, float& alpha, float (&mx)[4]) {
  if constexpr (K == 0) { mx[0] = p0[0]; mx[1] = p0[1]; mx[2] = p0[2]; mx[3] = p0[3]; }
  else if constexpr (K >= 1 && K <= 3) {
#pragma unroll
    for (int r = 4 * K; r < 4 * K + 4; ++r) mx[r & 3] = fmaxf(mx[r & 3], p0[r]);
  } else if constexpr (K >= 4 && K <= 7) {
#pragma unroll
    for (int r = 4 * (K - 4); r < 4 * (K - 4) + 4; ++r) mx[r & 3] = fmaxf(mx[r & 3], p1[r]);
  } else if constexpr (K == 8) {
    float pmax = fmaxf(fmaxf(mx[0], mx[1]), fmaxf(mx[2], mx[3]));
    { auto rr = __builtin_amdgcn_permlane32_swap(__float_as_uint(pmax), __float_as_uint(pmax), false, false);
      pmax = fmaxf(__uint_as_float(rr[0]), __uint_as_float(rr[1])); }
    if (__builtin_expect(__all(pmax <= THR2), 1)) { alpha = 1.f; }
    else { const float delta = fmaxf(pmax, 0.f); alpha = __builtin_amdgcn_exp2f(-delta); mC += delta;
#pragma unroll
      for (int r = 0; r < 16; ++r) p0[r] -= delta;
#pragma unroll
      for (int r = 0; r < 16; ++r) p1[r] -= delta; }
  } else if constexpr (K >= 9 && K <= 12) {
#pragma unroll
    for (int r = 4 * (K - 9); r < 4 * (K - 9) + 4; ++r) p0[r] = __builtin_amdgcn_exp2f(p0[r]);
  } else if constexpr (K >= 13 && K <= 15) {
#pragma unroll
    for (int r = (K == 13 ? 0 : K == 14 ? 6 : 11); r < (K == 13 ? 6 : K == 14 ? 11 : 16); ++r) p1[r] = __builtin_amdgcn_exp2f(p1[r]);
  }
}
__device__ __forceinline__ int v_st(int k, int c) { const int kk = (k & ~0xC) | ((k & 4) << 1) | ((k & 8) >> 1); return ((kk >> 3) * 4 + (c >> 5)) * 512 + ((kk & 7) * 32 + (c & 31)) * 2; }
__device__ __forceinline__ int v_rd_base(int lane) { return ((lane & 3) << 3) | (((lane >> 2) & 3) << 6) | (((lane >> 4) & 1) << 5) | (((lane >> 5) & 1) << 8); }
constexpr int v_rd_off(int d0, int ks, int half) { return d0 * 512 + ks * 4096 + half * 2048; }
template <int OFF> __device__ __forceinline__ s16x4 tr_read(int vb) {
  s16x4 r; asm volatile("ds_read_b64_tr_b16 %0, %1 offset:%2" : "=&v"(r) : "v"(vb), "i"(OFF) : "memory"); return r;
}
template <int D0> __device__ __forceinline__ void pv_one(f32x16& od, int vb, bf16x8 pa0, bf16x8 pa1, bf16x8 pa2, bf16x8 pa3) {
  const s16x4 l0 = tr_read<v_rd_off(D0, 0, 0)>(vb), h0 = tr_read<v_rd_off(D0, 0, 1)>(vb), l1 = tr_read<v_rd_off(D0, 1, 0)>(vb), h1 = tr_read<v_rd_off(D0, 1, 1)>(vb);
  const s16x4 l2 = tr_read<v_rd_off(D0, 2, 0)>(vb), h2 = tr_read<v_rd_off(D0, 2, 1)>(vb), l3 = tr_read<v_rd_off(D0, 3, 0)>(vb), h3 = tr_read<v_rd_off(D0, 3, 1)>(vb);
  asm volatile("s_waitcnt lgkmcnt(0)" ::: "memory"); SBAR();
#define PK(L, H) (bf16x8){L[0], L[1], L[2], L[3], H[0], H[1], H[2], H[3]}
  od = __builtin_amdgcn_mfma_f32_32x32x16_bf16(pa0, PK(l0, h0), od, 0, 0, 0);
  od = __builtin_amdgcn_mfma_f32_32x32x16_bf16(pa1, PK(l1, h1), od, 0, 0, 0);
  od = __builtin_amdgcn_mfma_f32_32x32x16_bf16(pa2, PK(l2, h2), od, 0, 0, 0);
  od = __builtin_amdgcn_mfma_f32_32x32x16_bf16(pa3, PK(l3, h3), od, 0, 0, 0);
#undef PK
}
__device__ __forceinline__ void pv_d0(f32x16* o, int vb, bf16x8 pa0, bf16x8 pa1, bf16x8 pa2, bf16x8 pa3) {
#define PK(L, H) (bf16x8){L[0], L[1], L[2], L[3], H[0], H[1], H[2], H[3]}
  const s16x4 l0 = tr_read<v_rd_off(0, 0, 0)>(vb), h0 = tr_read<v_rd_off(0, 0, 1)>(vb);
  const s16x4 l1 = tr_read<v_rd_off(0, 1, 0)>(vb), h1 = tr_read<v_rd_off(0, 1, 1)>(vb);
  const s16x4 l2 = tr_read<v_rd_off(0, 2, 0)>(vb), h2 = tr_read<v_rd_off(0, 2, 1)>(vb);
  const s16x4 l3 = tr_read<v_rd_off(0, 3, 0)>(vb), h3 = tr_read<v_rd_off(0, 3, 1)>(vb);
  const s16x4 l4 = tr_read<v_rd_off(1, 0, 0)>(vb), h4 = tr_read<v_rd_off(1, 0, 1)>(vb);
  asm volatile("s_waitcnt lgkmcnt(8)" ::: "memory"); SBAR();
  o[0] = __builtin_amdgcn_mfma_f32_32x32x16_bf16(pa0, PK(l0, h0), o[0], 0, 0, 0);
  const s16x4 l5 = tr_read<v_rd_off(1, 1, 0)>(vb), h5 = tr_read<v_rd_off(1, 1, 1)>(vb);
  asm volatile("s_waitcnt lgkmcnt(8)" ::: "memory"); SBAR();
  o[0] = __builtin_amdgcn_mfma_f32_32x32x16_bf16(pa1, PK(l1, h1), o[0], 0, 0, 0);
  const s16x4 l6 = tr_read<v_rd_off(1, 2, 0)>(vb), h6 = tr_read<v_rd_off(1, 2, 1)>(vb);
  asm volatile("s_waitcnt lgkmcnt(8)" ::: "memory"); SBAR();
  o[0] = __builtin_amdgcn_mfma_f32_32x32x16_bf16(pa2, PK(l2, h2), o[0], 0, 0, 0);
  const s16x4 l7 = tr_read<v_rd_off(1, 3, 0)>(vb), h7 = tr_read<v_rd_off(1, 3, 1)>(vb);
  asm volatile("s_waitcnt lgkmcnt(8)" ::: "memory"); SBAR();
  o[0] = __builtin_amdgcn_mfma_f32_32x32x16_bf16(pa3, PK(l3, h3), o[0], 0, 0, 0);
  const s16x4 l8 = tr_read<v_rd_off(2, 0, 0)>(vb), h8 = tr_read<v_rd_off(2, 0, 1)>(vb);
  asm volatile("s_waitcnt lgkmcnt(8)" ::: "memory"); SBAR();
  o[1] = __builtin_amdgcn_mfma_f32_32x32x16_bf16(pa0, PK(l4, h4), o[1], 0, 0, 0);
  const s16x4 l9 = tr_read<v_rd_off(2, 1, 0)>(vb), h9 = tr_read<v_rd_off(2, 1, 1)>(vb);
  asm volatile("s_waitcnt lgkmcnt(8)" ::: "memory"); SBAR();
  o[1] = __builtin_amdgcn_mfma_f32_32x32x16_bf16(pa1, PK(l5, h5), o[1], 0, 0, 0);
  const s16x4 l10 = tr_read<v_rd_off(2, 2, 0)>(vb), h10 = tr_read<v_rd_off(2, 2, 1)>(vb);
  asm volatile("s_waitcnt lgkmcnt(8)" ::: "memory"); SBAR();
  o[1] = __builtin_amdgcn_mfma_f32_32x32x16_bf16(pa2, PK(l6, h6), o[1], 0, 0, 0);
  const s16x4 l11 = tr_read<v_rd_off(2, 3, 0)>(vb), h11 = tr_read<v_rd_off(2, 3, 1)>(vb);
  asm volatile("s_waitcnt lgkmcnt(8)" ::: "memory"); SBAR();
  o[1] = __builtin_amdgcn_mfma_f32_32x32x16_bf16(pa3, PK(l7, h7), o[1], 0, 0, 0);
  const s16x4 l12 = tr_read<v_rd_off(3, 0, 0)>(vb), h12 = tr_read<v_rd_off(3, 0, 1)>(vb);
  asm volatile("s_waitcnt lgkmcnt(8)" ::: "memory"); SBAR();
  o[2] = __builtin_amdgcn_mfma_f32_32x32x16_bf16(pa0, PK(l8, h8), o[2], 0, 0, 0);
  const s16x4 l13 = tr_read<v_rd_off(3, 1, 0)>(vb), h13 = tr_read<v_rd_off(3, 1, 1)>(vb);
  asm volatile("s_waitcnt lgkmcnt(8)" ::: "memory"); SBAR();
  o[2] = __builtin_amdgcn_mfma_f32_32x32x16_bf16(pa1, PK(l9, h9), o[2], 0, 0, 0);
  const s16x4 l14 = tr_read<v_rd_off(3, 2, 0)>(vb), h14 = tr_read<v_rd_off(3, 2, 1)>(vb);
  asm volatile("s_waitcnt lgkmcnt(8)" ::: "memory"); SBAR();
  o[2] = __builtin_amdgcn_mfma_f32_32x32x16_bf16(pa2, PK(l10, h10), o[2], 0, 0, 0);
  const s16x4 l15 = tr_read<v_rd_off(3, 3, 0)>(vb), h15 = tr_read<v_rd_off(3, 3, 1)>(vb);
  asm volatile("s_waitcnt lgkmcnt(8)" ::: "memory"); SBAR();
  o[2] = __builtin_amdgcn_mfma_f32_32x32x16_bf16(pa3, PK(l11, h11), o[2], 0, 0, 0);
  asm volatile("s_waitcnt lgkmcnt(6)" ::: "memory"); SBAR();
  o[3] = __builtin_amdgcn_mfma_f32_32x32x16_bf16(pa0, PK(l12, h12), o[3], 0, 0, 0);
  asm volatile("s_waitcnt lgkmcnt(4)" ::: "memory"); SBAR();
  o[3] = __builtin_amdgcn_mfma_f32_32x32x16_bf16(pa1, PK(l13, h13), o[3], 0, 0, 0);
  asm volatile("s_waitcnt lgkmcnt(2)" ::: "memory"); SBAR();
  o[3] = __builtin_amdgcn_mfma_f32_32x32x16_bf16(pa2, PK(l14, h14), o[3], 0, 0, 0);
  asm volatile("s_waitcnt lgkmcnt(0)" ::: "memory"); SBAR();
  o[3] = __builtin_amdgcn_mfma_f32_32x32x16_bf16(pa3, PK(l15, h15), o[3], 0, 0, 0);
#undef PK
}

__device__ __forceinline__ void qkt12_roll(f32x16& p0, f32x16& p1, const f32x16& negm, int kb, int qa, const bf16x8* qr) {
  const int a0 = kb ^ (0 << 5); const bf16x8 x0 = lds_rd128<0>(a0), y0 = lds_rd128<12288>(a0);
  const int a1 = kb ^ (1 << 5); const bf16x8 x1 = lds_rd128<0>(a1), y1 = lds_rd128<12288>(a1);
  asm volatile("s_waitcnt lgkmcnt(2)" ::: "memory"); SBAR();
  p0 = __builtin_amdgcn_mfma_f32_32x32x16_bf16(x0, qr[0], negm, 0, 0, 0); p1 = __builtin_amdgcn_mfma_f32_32x32x16_bf16(y0, qr[0], negm, 0, 0, 0);
  const int a2 = kb ^ (2 << 5); const bf16x8 x2 = lds_rd128<0>(a2), y2 = lds_rd128<12288>(a2);
  asm volatile("s_waitcnt lgkmcnt(2)" ::: "memory"); SBAR();
  p0 = __builtin_amdgcn_mfma_f32_32x32x16_bf16(x1, qr[1], p0, 0, 0, 0); p1 = __builtin_amdgcn_mfma_f32_32x32x16_bf16(y1, qr[1], p1, 0, 0, 0);
  const int a3 = kb ^ (3 << 5); const bf16x8 x3 = lds_rd128<0>(a3), y3 = lds_rd128<12288>(a3);
  asm volatile("s_waitcnt lgkmcnt(2)" ::: "memory"); SBAR();
  p0 = __builtin_amdgcn_mfma_f32_32x32x16_bf16(x2, qr[2], p0, 0, 0, 0); p1 = __builtin_amdgcn_mfma_f32_32x32x16_bf16(y2, qr[2], p1, 0, 0, 0);
  const int a4 = kb ^ (0 << 5); const bf16x8 x4 = lds_rd128<128>(a4), y4 = lds_rd128<12416>(a4); const bf16x8 z4 = lds_rd128<0>(qa);
  asm volatile("s_waitcnt lgkmcnt(3)" ::: "memory"); SBAR();
  p0 = __builtin_amdgcn_mfma_f32_32x32x16_bf16(x3, qr[3], p0, 0, 0, 0); p1 = __builtin_amdgcn_mfma_f32_32x32x16_bf16(y3, qr[3], p1, 0, 0, 0);
  const int a5 = kb ^ (1 << 5); const bf16x8 x5 = lds_rd128<128>(a5), y5 = lds_rd128<12416>(a5); const bf16x8 z5 = lds_rd128<1024>(qa);
  asm volatile("s_waitcnt lgkmcnt(3)" ::: "memory"); SBAR();
  p0 = __builtin_amdgcn_mfma_f32_32x32x16_bf16(x4, z4, p0, 0, 0, 0); p1 = __builtin_amdgcn_mfma_f32_32x32x16_bf16(y4, z4, p1, 0, 0, 0);
  const int a6 = kb ^ (2 << 5); const bf16x8 x6 = lds_rd128<128>(a6), y6 = lds_rd128<12416>(a6); const bf16x8 z6 = lds_rd128<2048>(qa);
  asm volatile("s_waitcnt lgkmcnt(3)" ::: "memory"); SBAR();
  p0 = __builtin_amdgcn_mfma_f32_32x32x16_bf16(x5, z5, p0, 0, 0, 0); p1 = __builtin_amdgcn_mfma_f32_32x32x16_bf16(y5, z5, p1, 0, 0, 0);
  const int a7 = kb ^ (3 << 5); const bf16x8 x7 = lds_rd128<128>(a7), y7 = lds_rd128<12416>(a7); const bf16x8 z7 = lds_rd128<3072>(qa);
  asm volatile("s_waitcnt lgkmcnt(3)" ::: "memory"); SBAR();
  p0 = __builtin_amdgcn_mfma_f32_32x32x16_bf16(x6, z6, p0, 0, 0, 0); p1 = __builtin_amdgcn_mfma_f32_32x32x16_bf16(y6, z6, p1, 0, 0, 0);
  const int a8 = kb ^ (0 << 5); const bf16x8 x8 = lds_rd128<256>(a8), y8 = lds_rd128<12544>(a8); const bf16x8 z8 = lds_rd128<4096>(qa);
  asm volatile("s_waitcnt lgkmcnt(3)" ::: "memory"); SBAR();
  p0 = __builtin_amdgcn_mfma_f32_32x32x16_bf16(x7, z7, p0, 0, 0, 0); p1 = __builtin_amdgcn_mfma_f32_32x32x16_bf16(y7, z7, p1, 0, 0, 0);
  const int a9 = kb ^ (1 << 5); const bf16x8 x9 = lds_rd128<256>(a9), y9 = lds_rd128<12544>(a9); const bf16x8 z9 = lds_rd128<5120>(qa);
  asm volatile("s_waitcnt lgkmcnt(3)" ::: "memory"); SBAR();
  p0 = __builtin_amdgcn_mfma_f32_32x32x16_bf16(x8, z8, p0, 0, 0, 0); p1 = __builtin_amdgcn_mfma_f32_32x32x16_bf16(y8, z8, p1, 0, 0, 0);
  const int a10 = kb ^ (2 << 5); const bf16x8 x10 = lds_rd128<256>(a10), y10 = lds_rd128<12544>(a10); const bf16x8 z10 = lds_rd128<6144>(qa);
  asm volatile("s_waitcnt lgkmcnt(3)" ::: "memory"); SBAR();
  p0 = __builtin_amdgcn_mfma_f32_32x32x16_bf16(x9, z9, p0, 0, 0, 0); p1 = __builtin_amdgcn_mfma_f32_32x32x16_bf16(y9, z9, p1, 0, 0, 0);
  const int a11 = kb ^ (3 << 5); const bf16x8 x11 = lds_rd128<256>(a11), y11 = lds_rd128<12544>(a11); const bf16x8 z11 = lds_rd128<7168>(qa);
  asm volatile("s_waitcnt lgkmcnt(3)" ::: "memory"); SBAR();
  p0 = __builtin_amdgcn_mfma_f32_32x32x16_bf16(x10, z10, p0, 0, 0, 0); p1 = __builtin_amdgcn_mfma_f32_32x32x16_bf16(y10, z10, p1, 0, 0, 0);
  asm volatile("s_waitcnt lgkmcnt(0)" ::: "memory"); SBAR();
  p0 = __builtin_amdgcn_mfma_f32_32x32x16_bf16(x11, z11, p0, 0, 0, 0); p1 = __builtin_amdgcn_mfma_f32_32x32x16_bf16(y11, z11, p1, 0, 0, 0);
  SBAR();
}
__device__ __forceinline__ void qkt8_fsm(f32x16& p0, f32x16& p1, const f32x16& negm, int kb, const bf16x8* qr, f32x16& q0p, f32x16& q1p, float alpha, float& l_reg, bf16x8& pa0, bf16x8& pa1, bf16x8& pa2, bf16x8& pa3) {
  float sm[4];
  const int a0 = kb ^ (0 << 5); const bf16x8 x0 = lds_rd128<0>(a0), y0 = lds_rd128<8192>(a0);
  const int a1 = kb ^ (1 << 5); const bf16x8 x1 = lds_rd128<0>(a1), y1 = lds_rd128<8192>(a1);
  const int a2 = kb ^ (2 << 5); const bf16x8 x2 = lds_rd128<0>(a2), y2 = lds_rd128<8192>(a2);
  asm volatile("s_waitcnt lgkmcnt(4)" ::: "memory"); SBAR();
  p0 = __builtin_amdgcn_mfma_f32_32x32x16_bf16(x0, qr[0], negm, 0, 0, 0); p1 = __builtin_amdgcn_mfma_f32_32x32x16_bf16(y0, qr[0], negm, 0, 0, 0);
  fsm_slice<0>(q0p, q1p, alpha, l_reg, pa0, pa1, pa2, pa3, sm); SBAR();
  const int a3 = kb ^ (3 << 5); const bf16x8 x3 = lds_rd128<0>(a3), y3 = lds_rd128<8192>(a3);
  asm volatile("s_waitcnt lgkmcnt(4)" ::: "memory"); SBAR();
  p0 = __builtin_amdgcn_mfma_f32_32x32x16_bf16(x1, qr[1], p0, 0, 0, 0); p1 = __builtin_amdgcn_mfma_f32_32x32x16_bf16(y1, qr[1], p1, 0, 0, 0);
  fsm_slice<1>(q0p, q1p, alpha, l_reg, pa0, pa1, pa2, pa3, sm); SBAR();
  const int a4 = kb ^ (4 << 5); const bf16x8 x4 = lds_rd128<0>(a4), y4 = lds_rd128<8192>(a4);
  asm volatile("s_waitcnt lgkmcnt(4)" ::: "memory"); SBAR();
  p0 = __builtin_amdgcn_mfma_f32_32x32x16_bf16(x2, qr[2], p0, 0, 0, 0); p1 = __builtin_amdgcn_mfma_f32_32x32x16_bf16(y2, qr[2], p1, 0, 0, 0);
  fsm_slice<2>(q0p, q1p, alpha, l_reg, pa0, pa1, pa2, pa3, sm); SBAR();
  const int a5 = kb ^ (5 << 5); const bf16x8 x5 = lds_rd128<0>(a5), y5 = lds_rd128<8192>(a5);
  asm volatile("s_waitcnt lgkmcnt(4)" ::: "memory"); SBAR();
  p0 = __builtin_amdgcn_mfma_f32_32x32x16_bf16(x3, qr[3], p0, 0, 0, 0); p1 = __builtin_amdgcn_mfma_f32_32x32x16_bf16(y3, qr[3], p1, 0, 0, 0);
  fsm_slice<3>(q0p, q1p, alpha, l_reg, pa0, pa1, pa2, pa3, sm); SBAR();
  const int a6 = kb ^ (6 << 5); const bf16x8 x6 = lds_rd128<0>(a6), y6 = lds_rd128<8192>(a6);
  asm volatile("s_waitcnt lgkmcnt(4)" ::: "memory"); SBAR();
  p0 = __builtin_amdgcn_mfma_f32_32x32x16_bf16(x4, qr[4], p0, 0, 0, 0); p1 = __builtin_amdgcn_mfma_f32_32x32x16_bf16(y4, qr[4], p1, 0, 0, 0);
  fsm_slice<4>(q0p, q1p, alpha, l_reg, pa0, pa1, pa2, pa3, sm); SBAR();
  const int a7 = kb ^ (7 << 5); const bf16x8 x7 = lds_rd128<0>(a7), y7 = lds_rd128<8192>(a7);
  asm volatile("s_waitcnt lgkmcnt(4)" ::: "memory"); SBAR();
  p0 = __builtin_amdgcn_mfma_f32_32x32x16_bf16(x5, qr[5], p0, 0, 0, 0); p1 = __builtin_amdgcn_mfma_f32_32x32x16_bf16(y5, qr[5], p1, 0, 0, 0);
  fsm_slice<5>(q0p, q1p, alpha, l_reg, pa0, pa1, pa2, pa3, sm); SBAR();
  asm volatile("s_waitcnt lgkmcnt(2)" ::: "memory"); SBAR();
  p0 = __builtin_amdgcn_mfma_f32_32x32x16_bf16(x6, qr[6], p0, 0, 0, 0); p1 = __builtin_amdgcn_mfma_f32_32x32x16_bf16(y6, qr[6], p1, 0, 0, 0);
  fsm_slice<6>(q0p, q1p, alpha, l_reg, pa0, pa1, pa2, pa3, sm); SBAR();
  asm volatile("s_waitcnt lgkmcnt(0)" ::: "memory"); SBAR();
  p0 = __builtin_amdgcn_mfma_f32_32x32x16_bf16(x7, qr[7], p0, 0, 0, 0); p1 = __builtin_amdgcn_mfma_f32_32x32x16_bf16(y7, qr[7], p1, 0, 0, 0);
  fsm_slice<7>(q0p, q1p, alpha, l_reg, pa0, pa1, pa2, pa3, sm); SBAR();
}
__device__ __forceinline__ void pv_psm(f32x16* o, int vb, bf16x8 pa0, bf16x8 pa1, bf16x8 pa2, bf16x8 pa3, f32x16& n0, f32x16& n1, float& mC, float& alpha) {
  float mx[4];
#define PK(L, H) (bf16x8){L[0], L[1], L[2], L[3], H[0], H[1], H[2], H[3]}
  const s16x4 l0 = tr_read<v_rd_off(0, 0, 0)>(vb), h0 = tr_read<v_rd_off(0, 0, 1)>(vb);
  const s16x4 l1 = tr_read<v_rd_off(0, 1, 0)>(vb), h1 = tr_read<v_rd_off(0, 1, 1)>(vb);
  const s16x4 l2 = tr_read<v_rd_off(0, 2, 0)>(vb), h2 = tr_read<v_rd_off(0, 2, 1)>(vb);
  const s16x4 l3 = tr_read<v_rd_off(0, 3, 0)>(vb), h3 = tr_read<v_rd_off(0, 3, 1)>(vb);
  asm volatile("s_waitcnt lgkmcnt(6)" ::: "memory"); SBAR();
  o[0] = __builtin_amdgcn_mfma_f32_32x32x16_bf16(pa0, PK(l0, h0), o[0], 0, 0, 0);
  psm_slice<0>(n0, n1, mC, alpha, mx); SBAR();
  const s16x4 l4 = tr_read<v_rd_off(1, 0, 0)>(vb), h4 = tr_read<v_rd_off(1, 0, 1)>(vb);
  asm volatile("s_waitcnt lgkmcnt(6)" ::: "memory"); SBAR();
  o[0] = __builtin_amdgcn_mfma_f32_32x32x16_bf16(pa1, PK(l1, h1), o[0], 0, 0, 0);
  psm_slice<1>(n0, n1, mC, alpha, mx); SBAR();
  const s16x4 l5 = tr_read<v_rd_off(1, 1, 0)>(vb), h5 = tr_read<v_rd_off(1, 1, 1)>(vb);
  asm volatile("s_waitcnt lgkmcnt(6)" ::: "memory"); SBAR();
  o[0] = __builtin_amdgcn_mfma_f32_32x32x16_bf16(pa2, PK(l2, h2), o[0], 0, 0, 0);
  psm_slice<2>(n0, n1, mC, alpha, mx); SBAR();
  const s16x4 l6 = tr_read<v_rd_off(1, 2, 0)>(vb), h6 = tr_read<v_rd_off(1, 2, 1)>(vb);
  asm volatile("s_waitcnt lgkmcnt(6)" ::: "memory"); SBAR();
  o[0] = __builtin_amdgcn_mfma_f32_32x32x16_bf16(pa3, PK(l3, h3), o[0], 0, 0, 0);
  psm_slice<3>(n0, n1, mC, alpha, mx); SBAR();
  const s16x4 l7 = tr_read<v_rd_off(1, 3, 0)>(vb), h7 = tr_read<v_rd_off(1, 3, 1)>(vb);
  asm volatile("s_waitcnt lgkmcnt(6)" ::: "memory"); SBAR();
  o[1] = __builtin_amdgcn_mfma_f32_32x32x16_bf16(pa0, PK(l4, h4), o[1], 0, 0, 0);
  psm_slice<4>(n0, n1, mC, alpha, mx); SBAR();
  const s16x4 l8 = tr_read<v_rd_off(2, 0, 0)>(vb), h8 = tr_read<v_rd_off(2, 0, 1)>(vb);
  asm volatile("s_waitcnt lgkmcnt(6)" ::: "memory"); SBAR();
  o[1] = __builtin_amdgcn_mfma_f32_32x32x16_bf16(pa1, PK(l5, h5), o[1], 0, 0, 0);
  psm_slice<5>(n0, n1, mC, alpha, mx); SBAR();
  const s16x4 l9 = tr_read<v_rd_off(2, 1, 0)>(vb), h9 = tr_read<v_rd_off(2, 1, 1)>(vb);
  asm volatile("s_waitcnt lgkmcnt(6)" ::: "memory"); SBAR();
  o[1] = __builtin_amdgcn_mfma_f32_32x32x16_bf16(pa2, PK(l6, h6), o[1], 0, 0, 0);
  psm_slice<6>(n0, n1, mC, alpha, mx); SBAR();
  const s16x4 l10 = tr_read<v_rd_off(2, 2, 0)>(vb), h10 = tr_read<v_rd_off(2, 2, 1)>(vb);
  asm volatile("s_waitcnt lgkmcnt(6)" ::: "memory"); SBAR();
  o[1] = __builtin_amdgcn_mfma_f32_32x32x16_bf16(pa3, PK(l7, h7), o[1], 0, 0, 0);
  psm_slice<7>(n0, n1, mC, alpha, mx); SBAR();
  const s16x4 l11 = tr_read<v_rd_off(2, 3, 0)>(vb), h11 = tr_read<v_rd_off(2, 3, 1)>(vb);
  asm volatile("s_waitcnt lgkmcnt(6)" ::: "memory"); SBAR();
  o[2] = __builtin_amdgcn_mfma_f32_32x32x16_bf16(pa0, PK(l8, h8), o[2], 0, 0, 0);
  psm_slice<8>(n0, n1, mC, alpha, mx); SBAR();
  const s16x4 l12 = tr_read<v_rd_off(3, 0, 0)>(vb), h12 = tr_read<v_rd_off(3, 0, 1)>(vb);
  asm volatile("s_waitcnt lgkmcnt(6)" ::: "memory"); SBAR();
  o[2] = __builtin_amdgcn_mfma_f32_32x32x16_bf16(pa1, PK(l9, h9), o[2], 0, 0, 0);
  psm_slice<9>(n0, n1, mC, alpha, mx); SBAR();
  const s16x4 l13 = tr_read<v_rd_off(3, 1, 0)>(vb), h13 = tr_read<v_rd_off(3, 1, 1)>(vb);
  asm volatile("s_waitcnt lgkmcnt(6)" ::: "memory"); SBAR();
  o[2] = __builtin_amdgcn_mfma_f32_32x32x16_bf16(pa2, PK(l10, h10), o[2], 0, 0, 0);
  psm_slice<10>(n0, n1, mC, alpha, mx); SBAR();
  const s16x4 l14 = tr_read<v_rd_off(3, 2, 0)>(vb), h14 = tr_read<v_rd_off(3, 2, 1)>(vb);
  asm volatile("s_waitcnt lgkmcnt(6)" ::: "memory"); SBAR();
  o[2] = __builtin_amdgcn_mfma_f32_32x32x16_bf16(pa3, PK(l11, h11), o[2], 0, 0, 0);
  psm_slice<11>(n0, n1, mC, alpha, mx); SBAR();
  const s16x4 l15 = tr_read<v_rd_off(3, 3, 0)>(vb), h15 = tr_read<v_rd_off(3, 3, 1)>(vb);
  asm volatile("s_waitcnt lgkmcnt(6)" ::: "memory"); SBAR();
  o[3] = __builtin_amdgcn_mfma_f32_32x32x16_bf16(pa0, PK(l12, h12), o[3], 0, 0, 0);
  psm_slice<12>(n0, n1, mC, alpha, mx); SBAR();
  asm volatile("s_waitcnt lgkmcnt(4)" ::: "memory"); SBAR();
  o[3] = __builtin_amdgcn_mfma_f32_32x32x16_bf16(pa1, PK(l13, h13), o[3], 0, 0, 0);
  psm_slice<13>(n0, n1, mC, alpha, mx); SBAR();
  asm volatile("s_waitcnt lgkmcnt(2)" ::: "memory"); SBAR();
  o[3] = __builtin_amdgcn_mfma_f32_32x32x16_bf16(pa2, PK(l14, h14), o[3], 0, 0, 0);
  psm_slice<14>(n0, n1, mC, alpha, mx); SBAR();
  asm volatile("s_waitcnt lgkmcnt(0)" ::: "memory"); SBAR();
  o[3] = __builtin_amdgcn_mfma_f32_32x32x16_bf16(pa3, PK(l15, h15), o[3], 0, 0, 0);
  psm_slice<15>(n0, n1, mC, alpha, mx); SBAR();
#undef PK
}
constexpr int LDS_K_OFF = 2 * SHM_V, LDS_WS_OFF = LDS_K_OFF + 2 * 12 * 2048, LDS_TBL_OFF = LDS_WS_OFF + NW * 64 * 4, LDS_Q_OFF = LDS_TBL_OFF + ((TBLN * 4 + 15) / 16) * 16;
static_assert(LDS_Q_OFF + NW * 8192 <= 163840, "attention LDS map");

template <int NDQ, int BIAS, int EPI, int SDEPTH, int NQL = 0, int ROPEQ = 0, int ORD = 0>
__device__ __forceinline__ void attn_unit(const bf16_t* __restrict__ Qb, int ldq, const bf16_t* __restrict__ Kh, int ldk, const bf16_t* __restrict__ K2, int ldk2,
                                          const bf16_t* __restrict__ Vh, int ldv, int kbeg, int nkeys, int q0, const float* __restrict__ tblg, float cb_lo, float cb_hi,
                                          bf16_t* __restrict__ Obf, int ldo, float* __restrict__ tmp, float lam, const float* __restrict__ subln, float post, char* lds, const int wave0, const float* __restrict__ cosp = nullptr, const float* __restrict__ sinp = nullptr) {
  constexpr int ROWB = NDQ * 32, SHM_K = 64 * ROWB;
  int tid_ = wave0 * 64 + lane_id_v();
  const int tid = tid_, wid = tid >> 6, lane = tid & 63, r32 = lane & 31, hi = lane >> 5;
  char* V_lds = lds; char* K_lds = lds + LDS_K_OFF;
  float* ws = (float*)(lds + LDS_WS_OFF) + wid * 64; float* li_l = ws; float* al_l = ws + 32;
  float* tbl_l = (float*)(lds + LDS_TBL_OFF);
  __syncthreads();
  if constexpr (BIAS) { for (int i = tid; i < TBLN; i += 512) tbl_l[i] = tblg[i]; }
  float mC = 0.f, l_reg = 0, nm_cur = 0.f; f32x16 o[4] = {}; f32x16 negm = {}; bf16x8 qr[NDQ - NQL];
  const bf16_t* Qw = Qb + (long)(wid * QBLK + r32) * ldq + hi * 8;
  char* qls = lds + LDS_Q_OFF + wid * 8192 + lane * 16;
#pragma unroll
  for (int d0 = 0; d0 < NDQ - NQL; ++d0) qr[d0] = *reinterpret_cast<const bf16x8*>(Qw + d0 * 16);
  if constexpr (ROPEQ) {
    static_assert(NDQ == 12 && NQL >= 4, "ROPEQ: MLA layout");
#pragma unroll
    for (int d0 = NDQ - NQL; d0 < 8; ++d0) *reinterpret_cast<bf16x8*>(qls + (d0 - (NDQ - NQL)) * 1024) = *reinterpret_cast<const bf16x8*>(Qw + d0 * 16);
    const int qrow = q0 + wid * QBLK + r32;
#pragma unroll
    for (int pr = 0; pr < 2; ++pr) {
      const bf16x8 xa = *reinterpret_cast<const bf16x8*>(Qw + (8 + pr) * 16), xb = *reinterpret_cast<const bf16x8*>(Qw + (10 + pr) * 16);
      const float* cp = cosp + (size_t)qrow * 32 + pr * 16 + hi * 8; const float* sp = sinp + (size_t)qrow * 32 + pr * 16 + hi * 8;
      const f32x4 c0 = *(const f32x4*)cp, c1 = *(const f32x4*)(cp + 4), s0 = *(const f32x4*)sp, s1 = *(const f32x4*)(sp + 4);
      float ya[8], yb[8];
#pragma unroll
      for (int t = 0; t < 8; ++t) { const float x1 = bf2f((unsigned short)xa[t]), x2 = bf2f((unsigned short)xb[t]); const float c = t < 4 ? c0[t & 3] : c1[t & 3], sn = t < 4 ? s0[t & 3] : s1[t & 3];
        ya[t] = x1 * c - x2 * sn; yb[t] = x2 * c + x1 * sn; }
      u32x4 wa = {pk2(ya[0], ya[1]), pk2(ya[2], ya[3]), pk2(ya[4], ya[5]), pk2(ya[6], ya[7])}, wb = {pk2(yb[0], yb[1]), pk2(yb[2], yb[3]), pk2(yb[4], yb[5]), pk2(yb[6], yb[7])};
      *reinterpret_cast<u32x4*>(qls + (8 + pr - (NDQ - NQL)) * 1024) = wa; *reinterpret_cast<u32x4*>(qls + (10 + pr - (NDQ - NQL)) * 1024) = wb; }
  } else {
#pragma unroll
  for (int d0 = NDQ - NQL; d0 < NDQ; ++d0) *reinterpret_cast<bf16x8*>(qls + (d0 - (NDQ - NQL)) * 1024) = *reinterpret_cast<const bf16x8*>(Qw + d0 * 16);
  }
  const int sr = tid >> 4, sc = (tid & 15) * 8, vst0 = v_st(sr, sc), vst1 = v_st(32 + sr, sc);
  const int sr8 = tid >> 3, sc8 = (tid & 7) * 8;
  const int vb0 = (int)(uintptr_t)V_lds + v_rd_base(lane);
  const int qlane = q0 + wid * QBLK + r32;
  struct { bf16x8 vs0, vs1, ks0, ks1, ks2; } sr_[SDEPTH];
  constexpr int SWM = (NDQ == 8) ? 15 : 7;
#define KSWZ(row, colB) ((row) * ROWB + ((colB) ^ (((row) & SWM) << 4)))
#define SLOAD(i, k0) do { sr_[i].vs0 = *reinterpret_cast<const bf16x8*>(&Vh[(long)((k0) + sr) * ldv + sc]); sr_[i].vs1 = *reinterpret_cast<const bf16x8*>(&Vh[(long)((k0) + 32 + sr) * ldv + sc]); \
    if constexpr (NDQ == 4) { sr_[i].ks0 = *reinterpret_cast<const bf16x8*>(&Kh[(long)((k0) + sr8) * ldk + sc8]); } \
    else { sr_[i].ks0 = *reinterpret_cast<const bf16x8*>(&Kh[(long)((k0) + sr) * ldk + sc]); sr_[i].ks1 = *reinterpret_cast<const bf16x8*>(&Kh[(long)((k0) + 32 + sr) * ldk + sc]); \
      if constexpr (NDQ == 12) { sr_[i].ks2 = *reinterpret_cast<const bf16x8*>(&K2[(long)((k0) + sr8) * ldk2 + sc8]); } } } while (0)
#define SWRITE(b, i) do { *(bf16x8*)(V_lds + (b) * SHM_V + vst0) = sr_[i].vs0; *(bf16x8*)(V_lds + (b) * SHM_V + vst1) = sr_[i].vs1; \
    if constexpr (NDQ == 4) { *(bf16x8*)(K_lds + (b) * SHM_K + KSWZ(sr8, sc8 * 2)) = sr_[i].ks0; } \
    else { *(bf16x8*)(K_lds + (b) * SHM_K + KSWZ(sr, sc * 2)) = sr_[i].ks0; *(bf16x8*)(K_lds + (b) * SHM_K + KSWZ(32 + sr, sc * 2)) = sr_[i].ks1; \
      if constexpr (NDQ == 12) { *(bf16x8*)(K_lds + (b) * SHM_K + KSWZ(sr8, 256 + sc8 * 2)) = sr_[i].ks2; } } } while (0)
#define SWAIT() do { if constexpr (SDEPTH == 2) { if constexpr (NDQ == 4) asm volatile("s_waitcnt vmcnt(3)" ::: "memory"); else if constexpr (NDQ == 8) asm volatile("s_waitcnt vmcnt(4)" ::: "memory"); else asm volatile("s_waitcnt vmcnt(5)" ::: "memory"); } \
    else asm volatile("s_waitcnt vmcnt(0)" ::: "memory"); } while (0)
#define RESC(a) do { if (__any((a) < 1.f)) { if (hi == 0) al_l[r32] = (a); asm volatile("s_waitcnt lgkmcnt(0)" ::: "memory"); \
    _Pragma("unroll") for (int d = 0; d < 4; ++d) _Pragma("unroll") for (int r = 0; r < 16; ++r) o[d][r] *= al_l[crow(r, hi)]; } } while (0)
#define BIASADD(P0, P1, kt0) do { if constexpr (BIAS) { const int dlo_ = (kt0) - q0 - 255, dhi_ = (kt0) + 63 - q0; \
    if (!(dlo_ >= 1024) && !(dhi_ <= -1024)) { const float* tb_ = tbl_l + ((kt0) - qlane + TOFF + 4 * hi); \
      _Pragma("unroll") for (int r = 0; r < 16; ++r) { P0[r] += tb_[(r & 3) + 8 * (r >> 2)]; P1[r] += tb_[32 + (r & 3) + 8 * (r >> 2)]; } } } } while (0)
#define NEGM_UPD(kt0) do { float nmj_ = -mC; if constexpr (BIAS) { const int dlo_ = (kt0) - q0 - 255, dhi_ = (kt0) + 63 - q0; if (dlo_ >= 1024) nmj_ += cb_hi; else if (dhi_ <= -1024) nmj_ += cb_lo; } \
    if (__any(nmj_ != nm_cur)) { nm_cur = nmj_; _Pragma("unroll") for (int r = 0; r < 16; ++r) negm[r] = nmj_; } } while (0)
  f32x16 pA0, pA1, pB0, pB1; float alA, alB; bf16x8 pa0, pa1, pa2, pa3; const int NT = nkeys / KVBLK;
  const int kb0 = (int)(uintptr_t)K_lds + r32 * ROWB + (((r32 & SWM) << 4) ^ (hi << 4));
  const int qa0 = (int)(uintptr_t)qls;
#define QKT(P0, P1, KOFF) do { if constexpr (NDQ == 8 && NQL == 0) qkt8_roll(P0, P1, negm, kb0 + (KOFF), qr); \
    else if constexpr (NDQ == 12 && NQL == 8) qkt12_roll(P0, P1, negm, kb0 + (KOFF), qa0, qr); else qkt<NDQ, NQL>(P0, P1, negm, K_lds + (KOFF), qr, qls, r32, hi); } while (0)
  constexpr int SE = 0, SO = SDEPTH - 1;
  SLOAD(SE, kbeg); asm volatile("s_waitcnt vmcnt(0)" ::: "memory"); SWRITE(0, SE); __syncthreads();
  constexpr bool SLICED = (NDQ == 8 && NQL == 0);
  NEGM_UPD(kbeg); QKT(pA0, pA1, 0); BIASADD(pA0, pA1, kbeg); partialSM<true>(pA0, pA1, mC, alA);
  if constexpr (SLICED) {
#pragma unroll
    for (int r = 0; r < 16; ++r) pA1[r] = __builtin_amdgcn_exp2f(pA1[r]); }
  SLOAD(SO, kbeg + KVBLK); if constexpr (SDEPTH == 2) { if (2 < NT) SLOAD(SE, kbeg + 2 * KVBLK); }
  SWAIT(); SWRITE(1, SO); __syncthreads();
  if constexpr (NDQ == 8 && NQL == 0) {
  for (int j = 1; j + 1 < NT; j += 2) {
    if constexpr (ORD == 0) {
    NEGM_UPD(kbeg + j * KVBLK); SBAR();
    qkt8_fsm(pB0, pB1, negm, kb0 + SHM_K, qr, pA0, pA1, alA, l_reg, pa0, pa1, pa2, pa3);
    SLOAD(SO, kbeg + (j + SDEPTH) * KVBLK); SBAR();
    BIASADD(pB0, pB1, kbeg + j * KVBLK); SBAR();
    pv_psm(o, vb0, pa0, pa1, pa2, pa3, pB0, pB1, mC, alB);
    } else {
    finishSM<false>(pA0, pA1, alA, l_reg, pa0, pa1, pa2, pa3); SBAR();
    NEGM_UPD(kbeg + j * KVBLK); SBAR(); qkt8_roll(pB0, pB1, negm, kb0 + SHM_K, qr); SBAR();
    SLOAD(SO, kbeg + (j + SDEPTH) * KVBLK); SBAR();
    BIASADD(pB0, pB1, kbeg + j * KVBLK); partialSM<false>(pB0, pB1, mC, alB);
    _Pragma("unroll") for (int r = 0; r < 16; ++r) pB1[r] = __builtin_amdgcn_exp2f(pB1[r]);
    SBAR(); pv_d0(o, vb0, pa0, pa1, pa2, pa3);
    }
    __syncthreads(); SWAIT(); SWRITE(0, SE);
    RESC(alB); __syncthreads();
    if constexpr (ORD == 0) {
    NEGM_UPD(kbeg + (j + 1) * KVBLK); SBAR();
    qkt8_fsm(pA0, pA1, negm, kb0, qr, pB0, pB1, alB, l_reg, pa0, pa1, pa2, pa3);
    if (SDEPTH == 1 || j + 3 < NT) SLOAD(SE, kbeg + (j + 1 + SDEPTH) * KVBLK); SBAR();
    BIASADD(pA0, pA1, kbeg + (j + 1) * KVBLK); SBAR();
    pv_psm(o, vb0 + (int)SHM_V, pa0, pa1, pa2, pa3, pA0, pA1, mC, alA);
    } else {
    finishSM<false>(pB0, pB1, alB, l_reg, pa0, pa1, pa2, pa3); SBAR();
    NEGM_UPD(kbeg + (j + 1) * KVBLK); SBAR(); qkt8_roll(pA0, pA1, negm, kb0, qr); SBAR();
    if (SDEPTH == 1 || j + 3 < NT) SLOAD(SE, kbeg + (j + 1 + SDEPTH) * KVBLK); SBAR();
    BIASADD(pA0, pA1, kbeg + (j + 1) * KVBLK); partialSM<false>(pA0, pA1, mC, alA);
    _Pragma("unroll") for (int r = 0; r < 16; ++r) pA1[r] = __builtin_amdgcn_exp2f(pA1[r]);
    SBAR(); pv_d0(o, vb0 + (int)SHM_V, pa0, pa1, pa2, pa3);
    }
    __syncthreads(); SWAIT(); SWRITE(1, SO);
    RESC(alA); __syncthreads();
  }
  } else {
  for (int j = 1; j + 1 < NT; j += 2) {
    NEGM_UPD(kbeg + j * KVBLK); SBAR(); QKT(pB0, pB1, SHM_K);
    finishSM(pA0, pA1, alA, l_reg, pa0, pa1, pa2, pa3); SBAR();
    SLOAD(SO, kbeg + (j + SDEPTH) * KVBLK); SBAR();
    pv_d0(o, vb0, pa0, pa1, pa2, pa3); BIASADD(pB0, pB1, kbeg + j * KVBLK); partialSM<false>(pB0, pB1, mC, alB);
    __syncthreads(); SWAIT(); SWRITE(0, SE);
    RESC(alB); __syncthreads();
    NEGM_UPD(kbeg + (j + 1) * KVBLK); SBAR(); QKT(pA0, pA1, 0);
    finishSM(pB0, pB1, alB, l_reg, pa0, pa1, pa2, pa3); SBAR();
    if (SDEPTH == 1 || j + 3 < NT) SLOAD(SE, kbeg + (j + 1 + SDEPTH) * KVBLK); SBAR();
    pv_d0(o, vb0 + (int)SHM_V, pa0, pa1, pa2, pa3); BIASADD(pA0, pA1, kbeg + (j + 1) * KVBLK); partialSM<false>(pA0, pA1, mC, alA);
    __syncthreads(); SWAIT(); SWRITE(1, SO);
    RESC(alA); __syncthreads();
  }
  }
  NEGM_UPD(kbeg + (NT - 1) * KVBLK); SBAR(); QKT(pB0, pB1, SHM_K);
  finishSM<!SLICED>(pA0, pA1, alA, l_reg, pa0, pa1, pa2, pa3); SBAR();
  pv_d0(o, vb0, pa0, pa1, pa2, pa3); BIASADD(pB0, pB1, kbeg + (NT - 1) * KVBLK); partialSM<false>(pB0, pB1, mC, alB);
  __syncthreads(); RESC(alB);
  finishSM(pB0, pB1, alB, l_reg, pa0, pa1, pa2, pa3); SBAR();
  pv_d0(o, vb0 + (int)SHM_V, pa0, pa1, pa2, pa3);
  if (hi == 0) li_l[r32] = l_reg; asm volatile("s_waitcnt lgkmcnt(0)" ::: "memory");
  float rli[16];
#pragma unroll
  for (int r = 0; r < 16; ++r) rli[r] = __builtin_amdgcn_rcpf(li_l[crow(r, hi)]);
  if constexpr (EPI == 0) {
    bf16_t* Ow = Obf + (long)(wid * QBLK) * ldo;
#pragma unroll
    for (int r = 0; r < 16; ++r) { const int orow = crow(r, hi);
#pragma unroll
      for (int d0 = 0; d0 < 4; ++d0) Ow[(long)orow * ldo + d0 * 32 + r32] = (bf16_t)f2bf(o[d0][r] * rli[r]); }
  } else if constexpr (EPI == 1) {
    float* Tw = tmp + (wid * QBLK) * 128;
#pragma unroll
    for (int r = 0; r < 16; ++r) { const int orow = crow(r, hi);
#pragma unroll
      for (int d0 = 0; d0 < 4; ++d0) Tw[orow * 128 + d0 * 32 + r32] = o[d0][r] * rli[r]; }
  } else {
    const float* Tw = tmp + (wid * QBLK) * 128; bf16_t* Ow = Obf + (long)(wid * QBLK) * ldo;
    float sg[4];
#pragma unroll
    for (int d0 = 0; d0 < 4; ++d0) sg[d0] = subln[d0 * 32 + r32] * post;
#pragma unroll
    for (int r = 0; r < 16; ++r) { const int orow = crow(r, hi); float v[4]; float ss = 0.f;
#pragma unroll
      for (int d0 = 0; d0 < 4; ++d0) { v[d0] = Tw[orow * 128 + d0 * 32 + r32] - lam * (o[d0][r] * rli[r]); ss += v[d0] * v[d0]; }
      ss += swz_xor<1>(ss); ss += swz_xor<2>(ss); ss += swz_xor<4>(ss); ss += swz_xor<8>(ss); ss += swz_xor<16>(ss);
      const float rs = rsqrtf(ss * (1.0f / 128.0f) + EPS);
#pragma unroll
      for (int d0 = 0; d0 < 4; ++d0) Ow[(long)orow * ldo + d0 * 32 + r32] = (bf16_t)f2bf(v[d0] * rs * sg[d0]); }
  }
#undef KSWZ
#undef SLOAD
#undef SWRITE
#undef SWAIT
#undef RESC
#undef BIASADD
#undef NEGM_UPD
#undef QKT
}

template <int M>
__device__ __forceinline__ void qkt_map(f32x16& p0, f32x16& p1, const char* Ks, const char* qls, int r32, int hi) {
  p0 = f32x16{}; p1 = f32x16{};
#pragma unroll
  for (int d0 = 0; d0 < 4; ++d0) { const int cb = (M * 64 + d0 * 16 + hi * 8) * 2;
    bf16x8 b0 = *reinterpret_cast<const bf16x8*>(Ks + r32 * 256 + (cb ^ ((r32 & 15) << 4)));
    bf16x8 b1 = *reinterpret_cast<const bf16x8*>(Ks + (32 + r32) * 256 + (cb ^ ((r32 & 15) << 4)));
    bf16x8 q = *reinterpret_cast<const bf16x8*>(qls + (M * 4 + d0) * 1024);
    p0 = __builtin_amdgcn_mfma_f32_32x32x16_bf16(b0, q, p0, 0, 0, 0);
    p1 = __builtin_amdgcn_mfma_f32_32x32x16_bf16(b1, q, p1, 0, 0, 0);
    if (d0 == 1) SBAR(); }
}
template <int M>
__device__ __forceinline__ void qkt_map_roll(f32x16& p0, f32x16& p1, int kb, int qa) {
  p0 = f32x16{}; p1 = f32x16{};
  const int a0 = kb ^ ((M << 7) | (0 << 5)); const bf16x8 x0 = lds_rd128<0>(a0), y0 = lds_rd128<8192>(a0); const bf16x8 z0 = (M == 0) ? lds_rd128<0>(qa) : lds_rd128<4096>(qa);
  const int a1 = kb ^ ((M << 7) | (1 << 5)); const bf16x8 x1 = lds_rd128<0>(a1), y1 = lds_rd128<8192>(a1); const bf16x8 z1 = (M == 0) ? lds_rd128<1024>(qa) : lds_rd128<5120>(qa);
  asm volatile("s_waitcnt lgkmcnt(3)" ::: "memory"); SBAR();
  p0 = __builtin_amdgcn_mfma_f32_32x32x16_bf16(x0, z0, p0, 0, 0, 0); p1 = __builtin_amdgcn_mfma_f32_32x32x16_bf16(y0, z0, p1, 0, 0, 0);
  const int a2 = kb ^ ((M << 7) | (2 << 5)); const bf16x8 x2 = lds_rd128<0>(a2), y2 = lds_rd128<8192>(a2); const bf16x8 z2 = (M == 0) ? lds_rd128<2048>(qa) : lds_rd128<6144>(qa);
  asm volatile("s_waitcnt lgkmcnt(3)" ::: "memory"); SBAR();
  p0 = __builtin_amdgcn_mfma_f32_32x32x16_bf16(x1, z1, p0, 0, 0, 0); p1 = __builtin_amdgcn_mfma_f32_32x32x16_bf16(y1, z1, p1, 0, 0, 0);
  const int a3 = kb ^ ((M << 7) | (3 << 5)); const bf16x8 x3 = lds_rd128<0>(a3), y3 = lds_rd128<8192>(a3); const bf16x8 z3 = (M == 0) ? lds_rd128<3072>(qa) : lds_rd128<7168>(qa);
  asm volatile("s_waitcnt lgkmcnt(3)" ::: "memory"); SBAR();
  p0 = __builtin_amdgcn_mfma_f32_32x32x16_bf16(x2, z2, p0, 0, 0, 0); p1 = __builtin_amdgcn_mfma_f32_32x32x16_bf16(y2, z2, p1, 0, 0, 0);
  asm volatile("s_waitcnt lgkmcnt(0)" ::: "memory"); SBAR();
  p0 = __builtin_amdgcn_mfma_f32_32x32x16_bf16(x3, z3, p0, 0, 0, 0); p1 = __builtin_amdgcn_mfma_f32_32x32x16_bf16(y3, z3, p1, 0, 0, 0);
  SBAR();
}
__device__ __forceinline__ void softmax_tile(f32x16& p0, f32x16& p1, float& m, float& l, float& alpha, float cb, bf16x8& pa0, bf16x8& pa1, bf16x8& pa2, bf16x8& pa3) {
  float mx_[4] = {p0[0], p0[1], p0[2], p0[3]};
#pragma unroll
  for (int r = 4; r < 16; ++r) mx_[r & 3] = fmaxf(mx_[r & 3], p0[r]);
#pragma unroll
  for (int r = 0; r < 16; ++r) mx_[r & 3] = fmaxf(mx_[r & 3], p1[r]);
  float pmax = fmaxf(fmaxf(mx_[0], mx_[1]), fmaxf(mx_[2], mx_[3]));
  { auto rr = __builtin_amdgcn_permlane32_swap(__float_as_uint(pmax), __float_as_uint(pmax), false, false);
    pmax = fmaxf(__uint_as_float(rr[0]), __uint_as_float(rr[1])); }
  pmax += cb;
  float mn;
  if (__builtin_expect(__all(pmax - m <= THR2), 1)) { mn = m; alpha = 1.f; }
  else { mn = fmaxf(m, pmax); alpha = __builtin_amdgcn_exp2f(m - mn); m = mn; }
  const float off = cb - mn;
#pragma unroll
  for (int r = 0; r < 16; ++r) p0[r] = __builtin_amdgcn_exp2f(p0[r] + off);
#pragma unroll
  for (int r = 0; r < 16; ++r) p1[r] = __builtin_amdgcn_exp2f(p1[r] + off);
  float sm_[4] = {p0[0], p0[1], p0[2], p0[3]};
#pragma unroll
  for (int r = 4; r < 16; ++r) sm_[r & 3] += p0[r];
#pragma unroll
  for (int r = 0; r < 16; ++r) sm_[r & 3] += p1[r];
  float ps = (sm_[0] + sm_[1]) + (sm_[2] + sm_[3]);
  { auto rr = __builtin_amdgcn_permlane32_swap(__float_as_uint(ps), __float_as_uint(ps), false, false);
    ps = __uint_as_float(rr[0]) + __uint_as_float(rr[1]); }
  l = l * alpha + ps;
#define PK4(P, BASE, OUT) do { unsigned a0 = cvtpk(P[BASE + 0], P[BASE + 1]), a1 = cvtpk(P[BASE + 2], P[BASE + 3]);   \
    unsigned b0 = cvtpk(P[BASE + 4], P[BASE + 5]), b1 = cvtpk(P[BASE + 6], P[BASE + 7]);                              \
    auto r0 = __builtin_amdgcn_permlane32_swap(a0, b0, false, false); auto r1 = __builtin_amdgcn_permlane32_swap(a1, b1, false, false); \
    u32x4 w = {r0[0], r1[0], r0[1], r1[1]}; OUT = *reinterpret_cast<bf16x8*>(&w); } while (0)
  PK4(p0, 0, pa0); PK4(p0, 8, pa1); PK4(p1, 0, pa2); PK4(p1, 8, pa3);
#undef PK4
}
template <int D0> __device__ __forceinline__ void pv2_one(f32x16& oa, f32x16& ob, int vb, bf16x8 pa0, bf16x8 pa1, bf16x8 pa2, bf16x8 pa3, bf16x8 pb0, bf16x8 pb1, bf16x8 pb2, bf16x8 pb3) {
  const s16x4 l0 = tr_read<v_rd_off(D0, 0, 0)>(vb), h0 = tr_read<v_rd_off(D0, 0, 1)>(vb), l1 = tr_read<v_rd_off(D0, 1, 0)>(vb), h1 = tr_read<v_rd_off(D0, 1, 1)>(vb);
  const s16x4 l2 = tr_read<v_rd_off(D0, 2, 0)>(vb), h2 = tr_read<v_rd_off(D0, 2, 1)>(vb), l3 = tr_read<v_rd_off(D0, 3, 0)>(vb), h3 = tr_read<v_rd_off(D0, 3, 1)>(vb);
  asm volatile("s_waitcnt lgkmcnt(0)" ::: "memory"); SBAR();
#define PK(L, H) (bf16x8){L[0], L[1], L[2], L[3], H[0], H[1], H[2], H[3]}
  const bf16x8 v0 = PK(l0, h0), v1 = PK(l1, h1), v2 = PK(l2, h2), v3 = PK(l3, h3);
  oa = __builtin_amdgcn_mfma_f32_32x32x16_bf16(pa0, v0, oa, 0, 0, 0);
  ob = __builtin_amdgcn_mfma_f32_32x32x16_bf16(pb0, v0, ob, 0, 0, 0);
  oa = __builtin_amdgcn_mfma_f32_32x32x16_bf16(pa1, v1, oa, 0, 0, 0);
  ob = __builtin_amdgcn_mfma_f32_32x32x16_bf16(pb1, v1, ob, 0, 0, 0);
  oa = __builtin_amdgcn_mfma_f32_32x32x16_bf16(pa2, v2, oa, 0, 0, 0);
  ob = __builtin_amdgcn_mfma_f32_32x32x16_bf16(pb2, v2, ob, 0, 0, 0);
  oa = __builtin_amdgcn_mfma_f32_32x32x16_bf16(pa3, v3, oa, 0, 0, 0);
  ob = __builtin_amdgcn_mfma_f32_32x32x16_bf16(pb3, v3, ob, 0, 0, 0);
#undef PK
}
__device__ __forceinline__ void attn_unit_A2(const bf16_t* __restrict__ Qb, int ldq, const bf16_t* __restrict__ Kh, int ldk, const bf16_t* __restrict__ Vh, int ldv, int nkeys, int q0,
                                             const float* __restrict__ tblg, float cb_lo, float cb_hi, bf16_t* __restrict__ Obf, int ldo, float lam, const float* __restrict__ subln, float post, char* lds, const int wave0) {
  constexpr int ROWB = 256, SHM_K = 64 * ROWB;
  int tid_ = wave0 * 64 + lane_id_v();
  const int tid = tid_, wid = tid >> 6, lane = tid & 63, r32 = lane & 31, hi = lane >> 5;
  char* V_lds = lds; char* K_lds = lds + LDS_K_OFF;
  float* ws = (float*)(lds + LDS_WS_OFF) + wid * 64; float* sl0 = ws; float* sl1 = ws + 32;
  float* tbl_l = (float*)(lds + LDS_TBL_OFF);
  char* qls = lds + LDS_Q_OFF + wid * 8192 + lane * 16;
  __syncthreads();
  for (int i = tid; i < TBLN; i += 512) tbl_l[i] = tblg[i];
  { const bf16_t* Qw = Qb + (long)(wid * QBLK + r32) * ldq + hi * 8;
#pragma unroll
    for (int i = 0; i < 8; ++i) *reinterpret_cast<bf16x8*>(qls + i * 1024) = *reinterpret_cast<const bf16x8*>(Qw + i * 16); }
  float m0 = -1e30f, m1 = -1e30f, l0 = 0.f, l1 = 0.f; f32x16 oa[4] = {}, ob[4] = {};
  const int sr = tid >> 4, sc = (tid & 15) * 8, vst0 = v_st(sr, sc), vst1 = v_st(32 + sr, sc);
  const int vb0 = (int)(uintptr_t)V_lds + v_rd_base(lane);
  const int qlane = q0 + wid * QBLK + r32;
  bf16x8 vs0, vs1, ks0, ks1;
#define KSWZ(row, colB) ((row) * ROWB + ((colB) ^ (((row) & 15) << 4)))
#define SLOAD2(k0) do { vs0 = *reinterpret_cast<const bf16x8*>(&Vh[(long)((k0) + sr) * ldv + sc]); vs1 = *reinterpret_cast<const bf16x8*>(&Vh[(long)((k0) + 32 + sr) * ldv + sc]); \
    ks0 = *reinterpret_cast<const bf16x8*>(&Kh[(long)((k0) + sr) * ldk + sc]); ks1 = *reinterpret_cast<const bf16x8*>(&Kh[(long)((k0) + 32 + sr) * ldk + sc]); } while (0)
#define SWRITE2(b) do { *(bf16x8*)(V_lds + (b) * SHM_V + vst0) = vs0; *(bf16x8*)(V_lds + (b) * SHM_V + vst1) = vs1; \
    *(bf16x8*)(K_lds + (b) * SHM_K + KSWZ(sr, sc * 2)) = ks0; *(bf16x8*)(K_lds + (b) * SHM_K + KSWZ(32 + sr, sc * 2)) = ks1; } while (0)
#define RESC2(O, SL, a) do { if (__any((a) < 1.f)) { if (hi == 0) SL[r32] = (a); asm volatile("s_waitcnt lgkmcnt(0)" ::: "memory"); \
    _Pragma("unroll") for (int d = 0; d < 4; ++d) _Pragma("unroll") for (int r = 0; r < 16; ++r) O[d][r] *= SL[crow(r, hi)]; } } while (0)
  const int NT = nkeys / KVBLK;
  const int kbA = (int)(uintptr_t)K_lds + r32 * 256 + (((r32 & 15) << 4) ^ (hi << 4)), qaA = (int)(uintptr_t)qls;
  SLOAD2(0); asm volatile("s_waitcnt vmcnt(0)" ::: "memory"); SWRITE2(0); __syncthreads();
  for (int j = 0; j < NT; ++j) {
    const int b = j & 1, kt0 = j * KVBLK;
    const int dlo_ = kt0 - q0 - 255, dhi_ = kt0 + 63 - q0;
    float cb = 0.f; const bool nearb = !(dlo_ >= 1024) && !(dhi_ <= -1024);
    if (dlo_ >= 1024) cb = cb_hi; else if (dhi_ <= -1024) cb = cb_lo;
    const float* tb_ = tbl_l + (kt0 - qlane + TOFF + 4 * hi);
    f32x16 s0, s1; bf16x8 pa0, pa1, pa2, pa3; float al0, al1;
    const int vb = vb0 + b * (int)SHM_V;
    qkt_map_roll<0>(s0, s1, kbA + b * SHM_K, qaA);
    SBAR();
    if (nearb) {
#pragma unroll
      for (int r = 0; r < 8; ++r) { s0[r] += tb_[(r & 3) + 8 * (r >> 2)]; s1[r] += tb_[32 + (r & 3) + 8 * (r >> 2)]; }
      SBAR();
#pragma unroll
      for (int r = 8; r < 16; ++r) { s0[r] += tb_[(r & 3) + 8 * (r >> 2)]; s1[r] += tb_[32 + (r & 3) + 8 * (r >> 2)]; } }
    SBAR();
    softmax_tile(s0, s1, m0, l0, al0, cb, pa0, pa1, pa2, pa3);
    RESC2(oa, sl0, al0);
    SBAR();
    pv_d0(oa, vb, pa0, pa1, pa2, pa3);
    SBAR();
    qkt_map_roll<1>(s0, s1, kbA + b * SHM_K, qaA);
    SBAR();
    if (nearb) {
#pragma unroll
      for (int r = 0; r < 8; ++r) { s0[r] += tb_[(r & 3) + 8 * (r >> 2)]; s1[r] += tb_[32 + (r & 3) + 8 * (r >> 2)]; }
      SBAR();
#pragma unroll
      for (int r = 8; r < 16; ++r) { s0[r] += tb_[(r & 3) + 8 * (r >> 2)]; s1[r] += tb_[32 + (r & 3) + 8 * (r >> 2)]; } }
    SBAR();
    softmax_tile(s0, s1, m1, l1, al1, cb, pa0, pa1, pa2, pa3);
    RESC2(ob, sl1, al1);
    SBAR();
    if (j + 1 < NT) SLOAD2(kt0 + KVBLK);
    SBAR();
    pv_d0(ob, vb, pa0, pa1, pa2, pa3);
    if (j + 1 < NT) { asm volatile("s_waitcnt vmcnt(0)" ::: "memory"); SWRITE2(b ^ 1); }
    __syncthreads();
  }
  const int lane_e = lane_id_v(), r32e = lane_e & 31, hie = lane_e >> 5;
  if (hie == 0) { sl0[r32e] = l0; sl1[r32e] = l1; } asm volatile("s_waitcnt lgkmcnt(0)" ::: "memory");
  bf16_t* Ow = Obf + (long)(wid * QBLK) * ldo;
  float sg[4];
#pragma unroll
  for (int d0 = 0; d0 < 4; ++d0) sg[d0] = subln[d0 * 32 + r32e] * post;
#pragma unroll
  for (int r = 0; r < 16; ++r) { const int orow = crow(r, hie); const float ra = __builtin_amdgcn_rcpf(sl0[orow]), rb = lam * __builtin_amdgcn_rcpf(sl1[orow]); float v[4]; float ss = 0.f;
#pragma unroll
    for (int d0 = 0; d0 < 4; ++d0) { v[d0] = oa[d0][r] * ra - ob[d0][r] * rb; ss += v[d0] * v[d0]; }
    ss += swz_xor<1>(ss); ss += swz_xor<2>(ss); ss += swz_xor<4>(ss); ss += swz_xor<8>(ss); ss += swz_xor<16>(ss);
    const float rs = rsqrtf(ss * (1.0f / 128.0f) + EPS);
#pragma unroll
    for (int d0 = 0; d0 < 4; ++d0) Ow[(long)orow * ldo + d0 * 32 + r32e] = (bf16_t)f2bf(v[d0] * rs * sg[d0]); }
#undef KSWZ
#undef SLOAD2
#undef SWRITE2
#undef RESC2
}
}

__device__ __forceinline__ void transpose_item(const float* __restrict__ W, int K, int N, bf16_t* __restrict__ WT, int k0, int n0, int drow0, float wscale, LAS float* scr, int lane) {
    float tv[32];
#pragma unroll
    for (int i = 0; i < 32; ++i) { const int kk = 2 * i + (lane >> 5); tv[i] = W[(size_t)(k0 + kk) * N + n0 + (lane & 31)]; }
#pragma unroll
    for (int i = 0; i < 32; ++i) { const int kk = 2 * i + (lane >> 5); scr[kk * 33 + (lane & 31)] = tv[i] * wscale; }
    asm volatile("s_waitcnt lgkmcnt(0)" ::: "memory");
    const int c = lane & 7;
#pragma unroll
    for (int j = 0; j < 4; ++j) { const int n = (lane >> 3) + 8 * j; const LAS float* s = scr + (8 * c) * 33 + n;
        u32x4 o; o.x = pk2(s[0 * 33], s[1 * 33]); o.y = pk2(s[2 * 33], s[3 * 33]); o.z = pk2(s[4 * 33], s[5 * 33]); o.w = pk2(s[6 * 33], s[7 * 33]);
        *(u32x4*)(WT + (size_t)(drow0 + n) * K + k0 + 8 * c) = o; }
    asm volatile("s_waitcnt lgkmcnt(0)" ::: "memory");
}
constexpr float QS_A = 0.125f * 1.4426950408889634f, QS_B = 0.07216878364870322f * 1.4426950408889634f, QS_CD = 0.08838834764831845f * 1.4426950408889634f;
template <int MODE>
__device__ __forceinline__ void transpose_matrix(const float* __restrict__ W, int K, int N, bf16_t* __restrict__ WT, LAS float* scr, int lane, int gw, int NGW) {
    const int nblk = N / 32, nitems = (K / 64) * nblk;
    for (int it = gw; it < nitems; it += NGW) { const int kb = it / nblk, nb = it % nblk, n0 = 32 * nb; int drow0 = n0;
        if (MODE == 1) { const int c = n0 < FF ? n0 : n0 - FF; drow0 = 256 * (c / 128) + (c % 128) + (n0 < FF ? 0 : 128); }
        float wscale = 1.0f;
        if (MODE == 2) { if (n0 < C_AK) wscale = QS_A; else if (n0 >= C_DQ && n0 < C_DK) wscale = QS_CD; }
        if (MODE == 3) wscale = QS_B;
        transpose_item(W, K, N, WT, 64 * kb, n0, drow0, wscale, scr, lane); }
}
__device__ __forceinline__ int t5_bucket(int d) {
    const int ret = d > 0 ? 16 : 0; const int n = d < 0 ? -d : d;
    if (n < 8) return ret + n;
    const float v = logf((float)n / 8.0f) / 4.852030263919617f * 8.0f;
    int large = 8 + (int)v; if (large > 15) large = 15;
    return ret + large;
}
__device__ __forceinline__ void norm_row(const float* __restrict__ xrow, const float* __restrict__ g, bf16_t* __restrict__ hrow, int lane) {
    f32x4 v[8]; float ss = 0.f;
#pragma unroll
    for (int j = 0; j < 8; ++j) { v[j] = ((const f32x4*)xrow)[lane + 64 * j]; ss += (v[j].x * v[j].x + v[j].y * v[j].y) + (v[j].z * v[j].z + v[j].w * v[j].w); }
    const float rs = rsqrtf(wave_sum(ss) * (1.0f / DM) + EPS);
#pragma unroll
    for (int j = 0; j < 8; ++j) { const f32x4 gg = ((const f32x4*)g)[lane + 64 * j];
        u32x2 w; w.x = pk2(v[j].x * rs * gg.x, v[j].y * rs * gg.y); w.y = pk2(v[j].z * rs * gg.z, v[j].w * rs * gg.w); ((u32x2*)hrow)[lane + 64 * j] = w; }
}
template <int NR>
__device__ __forceinline__ void norm_add_rows(const bf16_t* __restrict__ Yb, const float* xi, float* xo, const float* __restrict__ gpost,
                                              const float* __restrict__ gpre, bf16_t* __restrict__ Hb, int row0, int rstride, int lane) {
    u32x2 yb[NR][8]; f32x4 v[NR][8];
#pragma unroll
    for (int q = 0; q < NR; ++q) { const size_t ro = (size_t)(row0 + q * rstride) * DM;
#pragma unroll
        for (int j = 0; j < 8; ++j) yb[q][j] = ((const u32x2*)(Yb + ro))[lane + 64 * j];
#pragma unroll
        for (int j = 0; j < 8; ++j) v[q][j] = ((const f32x4*)(xi + ro))[lane + 64 * j]; }
    f32x4 gp[8];
#pragma unroll
    for (int j = 0; j < 8; ++j) gp[j] = ((const f32x4*)gpost)[lane + 64 * j];
#pragma unroll
    for (int q = 0; q < NR; ++q) { const size_t ro = (size_t)(row0 + q * rstride) * DM;
        f32x4 y[8]; float ss = 0.f;
#pragma unroll
        for (int j = 0; j < 8; ++j) { y[j].x = __uint_as_float(yb[q][j].x << 16); y[j].y = __uint_as_float(yb[q][j].x & 0xffff0000u); y[j].z = __uint_as_float(yb[q][j].y << 16); y[j].w = __uint_as_float(yb[q][j].y & 0xffff0000u);
            ss += (y[j].x * y[j].x + y[j].y * y[j].y) + (y[j].z * y[j].z + y[j].w * y[j].w); }
        const float rs = rsqrtf(wave_sum(ss) * (1.0f / DM) + EPS);
        float ss2 = 0.f;
#pragma unroll
        for (int j = 0; j < 8; ++j) { v[q][j] = v[q][j] + y[j] * rs * gp[j]; ((f32x4*)(xo + ro))[lane + 64 * j] = v[q][j];
            ss2 += (v[q][j].x * v[q][j].x + v[q][j].y * v[q][j].y) + (v[q][j].z * v[q][j].z + v[q][j].w * v[q][j].w); }
        if (gpre) {
            const float rs2 = rsqrtf(wave_sum(ss2) * (1.0f / DM) + EPS);
#pragma unroll
            for (int j = 0; j < 8; ++j) { const f32x4 gg = ((const f32x4*)gpre)[lane + 64 * j];
                u32x2 w; w.x = pk2(v[q][j].x * rs2 * gg.x, v[q][j].y * rs2 * gg.y); w.y = pk2(v[q][j].z * rs2 * gg.z, v[q][j].w * rs2 * gg.w); ((u32x2*)(Hb + ro))[lane + 64 * j] = w; }
        }
    }
}

__device__ __forceinline__ void head_norm_axial(const bf16_t* __restrict__ src, bf16_t* __restrict__ dst, const float* __restrict__ g, const float* __restrict__ COS, const float* __restrict__ SIN, int row, int t, float oscale) {
    float v[8];
#pragma unroll
    for (int s = 0; s < 4; ++s) { const unsigned w = *(const unsigned*)(src + 32 * s + 2 * t); v[2 * s] = bf2f((unsigned short)(w & 0xffff)); v[2 * s + 1] = bf2f((unsigned short)(w >> 16)); }
    float ss = 0.f;
#pragma unroll
    for (int i = 0; i < 8; ++i) ss += v[i] * v[i];
    ss += swz_xor<1>(ss); ss += swz_xor<2>(ss); ss += swz_xor<4>(ss); ss += swz_xor<8>(ss);
    const float rs = rsqrtf(ss * (1.0f / 128.0f) + EPS);
#pragma unroll
    for (int s = 0; s < 4; ++s) { v[2 * s] *= rs * oscale * g[32 * s + 2 * t]; v[2 * s + 1] *= rs * oscale * g[32 * s + 2 * t + 1]; }
    const int pr = row >> 6, pc = row & 63;
    float o[8];
#pragma unroll
    for (int e = 0; e < 2; ++e) { const int i = 2 * t + e;
        { const float c = COS[pr * 32 + i], s = SIN[pr * 32 + i]; const float x1 = v[e], x2 = v[2 + e]; o[e] = x1 * c - x2 * s; o[2 + e] = x2 * c + x1 * s; }
        { const float c = COS[pc * 32 + i], s = SIN[pc * 32 + i]; const float x1 = v[4 + e], x2 = v[6 + e]; o[4 + e] = x1 * c - x2 * s; o[6 + e] = x2 * c + x1 * s; } }
#pragma unroll
    for (int s = 0; s < 4; ++s) *(unsigned*)(dst + 32 * s + 2 * t) = pk2(o[2 * s], o[2 * s + 1]);
}


#define XB_TMO      128
#define XB_XCNT(j)  (256  + 64 * (j))
#define XB_XSUB(j)  (1280 + 64 * (j))
#define XB_XGEN(j)  (2304 + 64 * (j))
#define XB_TOP      3328
#define XB_TOPGEN   3392
#define XCD_BAR_WORDS 3456
#define XB_SPIN_CAP (1u << 18)
__device__ __forceinline__ unsigned xb_ld(unsigned* p)              { return __hip_atomic_load(p, __ATOMIC_RELAXED, __HIP_MEMORY_SCOPE_AGENT); }
__device__ __forceinline__ unsigned xb_add(unsigned* p, unsigned v) { return __hip_atomic_fetch_add(p, v, __ATOMIC_RELAXED, __HIP_MEMORY_SCOPE_AGENT); }
__device__ __forceinline__ unsigned xb_xcc_id() { return (unsigned)__builtin_amdgcn_s_getreg((3 << 11) | 20) & 0xFu; }
#define XB_SPIN(cond, bar) do { unsigned _sp = 0; while (cond) { __builtin_amdgcn_s_sleep(1); \
    if ((++_sp & 255u) == 0u) { if (xb_ld(&(bar)[XB_TMO])) break; if (_sp > XB_SPIN_CAP) { atomicAdd(&(bar)[XB_TMO], 1u); break; } } } } while (0)
__device__ __forceinline__ void xcd_barrier_complete(unsigned* bar, unsigned x, unsigned& nloc, unsigned& nx) {
    const unsigned G = gridDim.x * gridDim.y * gridDim.z;
    unsigned sum, cnt, mine, sp = 0u;
    for (;;) {
        sum = 0u; cnt = 0u; mine = 0u;
#pragma unroll
        for (unsigned j = 0; j < 16; ++j) { const unsigned c = xb_ld(&bar[XB_XCNT(j)]); sum += c; cnt += (c > 0u) ? 1u : 0u; mine = (j == x) ? c : mine; }
        if (sum == G) break;
        __builtin_amdgcn_s_sleep(1);
        if ((++sp & 255u) == 0u) { if (xb_ld(&bar[XB_TMO])) break; if (sp > XB_SPIN_CAP) { atomicAdd(&bar[XB_TMO], 1u); break; } }
    }
    nloc = mine > 0u ? mine : 1u; nx = cnt > 0u ? cnt : 1u;
}
__device__ __forceinline__ void xcd_barrier(unsigned* bar, volatile LAS unsigned* st, bool leader) {
    asm volatile("s_waitcnt vmcnt(0)" ::: "memory");
    __syncthreads();
    if (leader) {
        const unsigned x = xb_xcc_id();
        __builtin_amdgcn_s_waitcnt(0);
        unsigned nloc = st[0], nx = st[1];
        if (nloc == 0u) { xcd_barrier_complete(bar, x, nloc, nx); st[0] = nloc; st[1] = nx; }
        const unsigned old = xb_add(&bar[XB_XSUB(x)], 1u);
        const unsigned gen = old / nloc;
        if (old + 1u == (gen + 1u) * nloc) {
            __builtin_amdgcn_fence(__ATOMIC_RELEASE, "agent");
            asm volatile("s_waitcnt vmcnt(0)" ::: "memory");
            const unsigned og = xb_add(&bar[XB_TOP], 1u);
            const unsigned tg = og / nx;
            if (og + 1u == (tg + 1u) * nx) xb_add(&bar[XB_TOPGEN], 1u);
            else XB_SPIN(xb_ld(&bar[XB_TOPGEN]) == tg, bar);
            __builtin_amdgcn_fence(__ATOMIC_ACQUIRE, "agent");
            xb_add(&bar[XB_XGEN(x)], 1u);
            asm volatile("s_waitcnt vmcnt(0)" ::: "memory");
        } else {
            XB_SPIN(xb_ld(&bar[XB_XGEN(x)]) == gen, bar);
            __builtin_amdgcn_fence(__ATOMIC_ACQUIRE, "agent");
            asm volatile("s_waitcnt vmcnt(0)" ::: "memory");
        }
    }
    __syncthreads();
}

struct Args { const float* in[18]; float* out; unsigned char* wsp; int ph_lo, ph_hi; };

__global__ void __launch_bounds__(512, 2) mega_fwd(Args args) {
    extern __shared__ __attribute__((aligned(16))) unsigned char lds[];
    const int G = gridDim.x, bid = blockIdx.x, NGW = G * 8;
    const int wave0 = __builtin_amdgcn_readfirstlane((int)threadIdx.x >> 6);
    typedef const __attribute__((address_space(4))) Args* KArgP;
    LAS unsigned char* ldsl = (LAS unsigned char*)lds;
#define x_in (kap->in[0])
#define rel_bias (kap->in[1])
#define norm_mix_pre (kap->in[2])
#define norm_mix_post (kap->in[3])
#define norm_ffn_pre (kap->in[4])
#define norm_ffn_post (kap->in[5])
#define w_in (kap->in[6])
#define diff_lambda (kap->in[7])
#define diff_subln (kap->in[8])
#define mla_q_norm (kap->in[9])
#define mla_kv_norm (kap->in[10])
#define mla_w_uq (kap->in[11])
#define mla_w_ukv (kap->in[12])
#define gqa_q_norm (kap->in[13])
#define gqa_k_norm (kap->in[14])
#define w_out (kap->in[15])
#define w_gate_up (kap->in[16])
#define w_down (kap->in[17])
#define xres (kap->out)
#define ws (kap->wsp)
#define PAR ((float*)(ws + WS_PAR))
#define TBLA ((float*)(ws + WS_TBLA))
#define TBLD ((float*)(ws + WS_TBLD))
#define COS ((float*)(ws + WS_COS))
#define SIN ((float*)(ws + WS_SIN))
#define H ((bf16_t*)(ws + WS_H))
#define PROJ ((bf16_t*)(ws + WS_PROJ))
#define CQN ((bf16_t*)(ws + WS_CQN))
#define CKVN ((bf16_t*)(ws + WS_CKVN))
#define KPE ((bf16_t*)(ws + WS_KPE))
#define QC ((bf16_t*)(ws + WS_QC))
#define KC ((bf16_t*)(ws + WS_KC))
#define QB ((bf16_t*)(ws + WS_QB))
#define KVB ((bf16_t*)(ws + WS_KVB))
#define MIX ((bf16_t*)(ws + WS_MIX))
#define Y ((bf16_t*)(ws + WS_Y))
#define HID ((bf16_t*)(ws + WS_HID))
#define TMP ((float*)(ws + WS_TMP))
#define wl (ws + WS_W + (size_t)l * LW)

    volatile LAS unsigned* bst = (volatile LAS unsigned*)(ldsl + LDS_ST_OFF);
    { const bool leader0 = (wave0 == 0) && (lane_id_v() == 0);
      if (leader0) { bst[0] = 0u; bst[1] = 0u; }
      __syncthreads();
      if (leader0 && !MK_MULTI) { KArgP kap0 = (KArgP)__builtin_amdgcn_kernarg_segment_ptr(); (void)xb_add(&((unsigned*)(kap0->wsp + WS_BAR))[XB_XCNT(xb_xcc_id())], 1u); } }
    const int lo = args.ph_lo, hi_ph = args.ph_hi; int ph = 0;
#define PH_BEGIN if (ph >= lo && ph < hi_ph) { KArgP kap = (KArgP)__builtin_amdgcn_kernarg_segment_ptr(); asm volatile("" : "+s"(kap)); \
    int tid_ = wave0 * 64 + lane_id_v(); const int tid = tid_, lane = tid & 63, wave = __builtin_amdgcn_readfirstlane(tid >> 6), gw = bid * 8 + wave; (void)lane; (void)gw;
#define PH_END } if (ph >= lo && ph + 1 < hi_ph) { if (ph == 0) { cg::this_grid().sync(); } else { KArgP kapb = (KArgP)__builtin_amdgcn_kernarg_segment_ptr(); asm volatile("" : "+s"(kapb)); \
      xcd_barrier((unsigned*)(kapb->wsp + WS_BAR), bst, (wave0 == 0) && (lane_id_v() == 0)); } } ++ph;

    PH_BEGIN
    if PHON(0) {
        LAS float* scr = (LAS float*)(ldsl + wave * 16384);
        for (int l = 0; l < DEPTH; ++l) {
            transpose_matrix<2>(w_in + (size_t)l * DM * NPROJ, DM, NPROJ, (bf16_t*)(wl + W_IN), scr, lane, gw, NGW);
            transpose_matrix<3>(mla_w_uq + (size_t)l * 512 * 768, 512, 768, (bf16_t*)(wl + W_UQ), scr, lane, gw, NGW);
            transpose_matrix<0>(mla_w_ukv + (size_t)l * 256 * 1024, 256, 1024, (bf16_t*)(wl + W_UKV), scr, lane, gw, NGW);
            transpose_matrix<0>(w_out + (size_t)l * DM * DM, DM, DM, (bf16_t*)(wl + W_OUT), scr, lane, gw, NGW);
            transpose_matrix<1>(w_gate_up + (size_t)l * DM * NGU, DM, NGU, (bf16_t*)(wl + W_GU), scr, lane, gw, NGW);
            transpose_matrix<0>(w_down + (size_t)l * FF * DM, FF, DM, (bf16_t*)(wl + W_D), scr, lane, gw, NGW);
            { u32x4* z = (u32x4*)((bf16_t*)(wl + W_IN) + (size_t)NPROJ * DM); const int n16 = (LDP - NPROJ) * DM * 2 / 16;
              for (int i = bid * 512 + tid; i < n16; i += G * 512) z[i] = (u32x4){0u, 0u, 0u, 0u}; }
        }
        const int gt = bid * 512 + tid, NT_ = G * 512;
        for (int i = gt; i < 4 * TBLN; i += NT_) { const int h = i / TBLN, d = (i % TBLN) - TOFF; const int b = t5_bucket(d);
            TBLA[i] = rel_bias[b * 8 + h] * 1.4426950408889634f;
            const int n = d < 0 ? -d : d; int mult = (n <= 64 ? 1 : 0) + (((n & 3) == 0 && n <= 256) ? 1 : 0) + (((n & 15) == 0 && n <= 1024) ? 1 : 0);
            TBLD[i] = mult ? (rel_bias[b * 8 + 4 + h] + logf((float)mult)) * 1.4426950408889634f : -1e30f; }
        for (int i = gt; i < S * 32; i += NT_) { const int pos = i >> 5, f = i & 31;
            const float inv = (float)pow(10000.0, -(double)(2 * f) / 64.0); const float ang = (float)pos * inv;
            COS[i] = (float)cos((double)ang); SIN[i] = (float)sin((double)ang); }
        if (bid == 0 && tid < DEPTH) { const float* lv = diff_lambda + tid * 256; float s1 = 0.f, s2 = 0.f;
            for (int i = 0; i < 64; ++i) { s1 += lv[i] * lv[64 + i]; s2 += lv[128 + i] * lv[192 + i]; }
            const float lam_init = 0.8f - 0.6f * expf(-0.3f * (float)tid);
            PAR[tid] = expf(s1) - expf(s2) + lam_init; PAR[4 + tid] = lam_init; }
        for (int row = gw; row < S; row += NGW) norm_row(x_in + (size_t)row * DM, norm_mix_pre, H + (size_t)row * DM, lane);
    }
    PH_END

    for (int l = 0; l < DEPTH; ++l) {
        PH_BEGIN
        if PHON(1) for (int rep_ = 0; rep_ < MK_DUP_GEMM; ++rep_) { pg8::Gemm g{H, (const bf16_t*)(wl + W_IN), S, LDP, DM}; pg8::StaticOrder So; So.init(S, LDP, G, bid);
          pg8::EpiBf16 E{PROJ, LDP};
          pg8::gemm_phase<pg8::EpiBf16, pg8::StaticOrder, true, true>(ldsl, g, So, E, wave0); }
        PH_END
        PH_BEGIN
        if PHON(2) for (int row = gw; row < S; row += NGW) {
            const bf16_t* pr = PROJ + (size_t)row * LDP;
            { const u32x4 raw = *(const u32x4*)(pr + C_BCQ + lane * 8); float v[8];
              v[0] = __uint_as_float(raw.x << 16); v[1] = __uint_as_float(raw.x & 0xffff0000u); v[2] = __uint_as_float(raw.y << 16); v[3] = __uint_as_float(raw.y & 0xffff0000u);
              v[4] = __uint_as_float(raw.z << 16); v[5] = __uint_as_float(raw.z & 0xffff0000u); v[6] = __uint_as_float(raw.w << 16); v[7] = __uint_as_float(raw.w & 0xffff0000u);
              float ss = 0.f;
#pragma unroll
              for (int i = 0; i < 8; ++i) ss += v[i] * v[i];
              const float rs = rsqrtf(wave_sum(ss) * (1.0f / 512.0f) + EPS);
              const f32x4 g0 = *(const f32x4*)(mla_q_norm + l * 512 + lane * 8), g1 = *(const f32x4*)(mla_q_norm + l * 512 + lane * 8 + 4);
              u32x4 w; w.x = pk2(v[0] * rs * g0.x, v[1] * rs * g0.y); w.y = pk2(v[2] * rs * g0.z, v[3] * rs * g0.w); w.z = pk2(v[4] * rs * g1.x, v[5] * rs * g1.y); w.w = pk2(v[6] * rs * g1.z, v[7] * rs * g1.w);
              *(u32x4*)(CQN + (size_t)row * 512 + lane * 8) = w; }
            { const u32x2 raw = *(const u32x2*)(pr + C_BCKV + lane * 4); float v[4];
              v[0] = __uint_as_float(raw.x << 16); v[1] = __uint_as_float(raw.x & 0xffff0000u); v[2] = __uint_as_float(raw.y << 16); v[3] = __uint_as_float(raw.y & 0xffff0000u);
              float ss = v[0] * v[0] + v[1] * v[1] + v[2] * v[2] + v[3] * v[3];
              const float rs = rsqrtf(wave_sum(ss) * (1.0f / 256.0f) + EPS);
              const f32x4 g0 = *(const f32x4*)(mla_kv_norm + l * 256 + lane * 4);
              u32x2 w; w.x = pk2(v[0] * rs * g0.x, v[1] * rs * g0.y); w.y = pk2(v[2] * rs * g0.z, v[3] * rs * g0.w);
              *(u32x2*)(CKVN + (size_t)row * 256 + lane * 4) = w; }
            if (lane < 32) { const float x1 = bf2f(pr[C_BKPE + lane]), x2 = bf2f(pr[C_BKPE + 32 + lane]); const float c = COS[row * 32 + lane], s = SIN[row * 32 + lane];
              KPE[(size_t)row * 64 + lane] = (bf16_t)f2bf(x1 * c - x2 * s); KPE[(size_t)row * 64 + 32 + lane] = (bf16_t)f2bf(x2 * c + x1 * s); }
            { const int hd = lane >> 4, t = lane & 15;
              head_norm_axial(pr + C_CQ + hd * 128, QC + (size_t)row * 512 + hd * 128, gqa_q_norm + l * 128, COS, SIN, row, t, QS_CD);
              const int hk = hd & 1;
              if (lane < 32) head_norm_axial(pr + C_CK + hk * 128, KC + (size_t)row * 256 + hk * 128, gqa_k_norm + l * 128, COS, SIN, row, t, 1.0f); }
        }
        PH_END
        PH_BEGIN
        if PHON(3) { pg8::Gemm g{CQN, (const bf16_t*)(wl + W_UQ), S, 768, 512}; pg8::StaticOrder So; So.init(S, 768, G, bid);
          pg8::EpiBf16 E{QB, 768};
          pg8::gemm_phase<pg8::EpiBf16, pg8::StaticOrder, true, true>(ldsl, g, So, E, wave0); }
        if PHON(4) { pg8::Gemm g{CKVN, (const bf16_t*)(wl + W_UKV), S, 1024, 256}; pg8::StaticOrder So; So.init(S, 1024, G, bid);
          pg8::EpiBf16 E{KVB, 1024};
          pg8::gemm_phase<pg8::EpiBf16, pg8::StaticOrder, true, true>(ldsl, g, So, E, wave0); }
        PH_END
        PH_BEGIN
        for (int rep_ = 0; rep_ < MK_DUP_ATT; ++rep_) {
            const float lam = __int_as_float(__builtin_amdgcn_readfirstlane(__float_as_int(PAR[l]))), lam_init = __int_as_float(__builtin_amdgcn_readfirstlane(__float_as_int(PAR[4 + l])));
            const float L2E = 1.4426950408889634f;
            if PHON(6) for (int u = bid; u < 256; u += G) { const int xq = u & 7, hd = xq & 3, qb = (u >> 3) + 32 * (xq >> 2), q0 = qb * 256;
                { const float cb_lo = rel_bias[15 * 8 + hd] * L2E, cb_hi = rel_bias[31 * 8 + hd] * L2E;
                  att::attn_unit_A2(PROJ + (size_t)q0 * LDP + C_AQ + hd * 128, LDP, PROJ + C_AK + hd * 128, LDP, PROJ + C_AV + hd * 128, LDP, S, q0,
                                    TBLA + hd * TBLN, cb_lo, cb_hi, MIX + (size_t)q0 * DM + hd * 128, DM, lam, diff_subln + l * 128, 1.0f - lam_init, (char*)lds, wave0); }
            }
            if PHON(7) for (int u = bid; u < 256; u += G) { const int xq = u & 7, hd = xq & 3, qb = (u >> 3) + 32 * (xq >> 2), q0 = qb * 256;
                { const float sc = 0.07216878364870322f;
                  att::attn_unit<12, 0, 0, 1, 8, 1>(QB + (size_t)q0 * 768 + hd * 192, 768, KVB + hd * 256, 1024, KPE, 64, KVB + hd * 256 + 128, 1024,
                                            0, S, q0, nullptr, 0.f, 0.f, MIX + (size_t)q0 * DM + 512 + hd * 128, DM, nullptr, 0.f, nullptr, 0.f, (char*)lds, wave0, COS, SIN); }
            }
            if (wave0 < 4) __builtin_amdgcn_s_setprio(1);
            if PHON(8) for (int u = bid; u < 256; u += G) { const int xq = u & 7, hd = xq & 3, qb = (u >> 3) + 32 * (xq >> 2), q0 = qb * 256;
                { const float sc = 0.08838834764831845f;
                  if (wave0 < 4) att::attn_unit<8, 0, 0, 1, 0, 0, 0>(QC + (size_t)q0 * 512 + hd * 128, 512, KC + (hd >> 1) * 128, 256, nullptr, 0, PROJ + C_CV + (hd >> 1) * 128, LDP,
                                           0, S, q0, nullptr, 0.f, 0.f, MIX + (size_t)q0 * DM + 1024 + hd * 128, DM, nullptr, 0.f, nullptr, 0.f, (char*)lds, wave0); else att::attn_unit<8, 0, 0, 1, 0, 0, 1>(QC + (size_t)q0 * 512 + hd * 128, 512, KC + (hd >> 1) * 128, 256, nullptr, 0, PROJ + C_CV + (hd >> 1) * 128, LDP,
                                           0, S, q0, nullptr, 0.f, 0.f, MIX + (size_t)q0 * DM + 1024 + hd * 128, DM, nullptr, 0.f, nullptr, 0.f, (char*)lds, wave0); }
            }
            __builtin_amdgcn_s_setprio(0);
            if PHON(9) for (int u = bid; u < 256; u += G) { const int xq = u & 7, hd = xq & 3, qb = (u >> 3) + 32 * (xq >> 2), q0 = qb * 256;
                { const float sc = 0.08838834764831845f;
                  const int kb = q0 - 1024 < 0 ? 0 : q0 - 1024, ke = q0 + 256 + 1024 > S ? S : q0 + 256 + 1024;
                  att::attn_unit<8, 1, 0, 1>(PROJ + (size_t)q0 * LDP + C_DQ + hd * 128, LDP, PROJ + C_DK + hd * 128, LDP, nullptr, 0, PROJ + C_DV + hd * 128, LDP,
                                           kb, ke - kb, q0, TBLD + hd * TBLN, 0.f, 0.f, MIX + (size_t)q0 * DM + 1536 + hd * 128, DM, nullptr, 0.f, nullptr, 0.f, (char*)lds, wave0); }
            }
            __syncthreads();
        }
        PH_END
        PH_BEGIN
        if PHON(10) for (int rep_ = 0; rep_ < MK_DUP_GEMM; ++rep_) { pg8::Gemm g{MIX, (const bf16_t*)(wl + W_OUT), S, DM, DM}; pg8::StaticOrder So; So.init(S, DM, G, bid);
          pg8::EpiBf16 E{Y, DM};
          pg8::gemm_phase<pg8::EpiBf16, pg8::StaticOrder, true, true>(ldsl, g, So, E, wave0); }
        PH_END
        PH_BEGIN
        if PHON(11) { int row = gw;
            for (; row + NGW < S; row += 2 * NGW) norm_add_rows<2>(Y, (l == 0 ? x_in : xres), xres, norm_mix_post + l * DM, norm_ffn_pre + l * DM, H, row, NGW, lane);
            for (; row < S; row += NGW) norm_add_rows<1>(Y, (l == 0 ? x_in : xres), xres, norm_mix_post + l * DM, norm_ffn_pre + l * DM, H, row, NGW, lane); }
        PH_END
        PH_BEGIN
        if PHON(12) for (int rep_ = 0; rep_ < MK_DUP_GEMM; ++rep_) { pg8::Gemm g{H, (const bf16_t*)(wl + W_GU), S, NGU, DM}; pg8::StaticOrder So; So.init(S, NGU, G, bid);
          pg8::EpiSwiGLU E{HID, FF};
          pg8::gemm_phase<pg8::EpiSwiGLU, pg8::StaticOrder, true, true>(ldsl, g, So, E, wave0); }
        PH_END
        PH_BEGIN
        if PHON(13) for (int rep_ = 0; rep_ < MK_DUP_GEMM; ++rep_) { pg8::Gemm g{HID, (const bf16_t*)(wl + W_D), S, DM, FF}; pg8::StaticOrder So; So.init(S, DM, G, bid);
          pg8::EpiBf16 E{Y, DM};
          pg8::gemm_phase<pg8::EpiBf16, pg8::StaticOrder, true, true>(ldsl, g, So, E, wave0); }
        PH_END
        PH_BEGIN
        if PHON(14) { int row = gw; const float* gnext = (l + 1 < DEPTH) ? norm_mix_pre + (l + 1) * DM : nullptr;
            for (; row + NGW < S; row += 2 * NGW) norm_add_rows<2>(Y, xres, xres, norm_ffn_post + l * DM, gnext, H, row, NGW, lane);
            for (; row < S; row += NGW) norm_add_rows<1>(Y, xres, xres, norm_ffn_post + l * DM, gnext, H, row, NGW, lane); }
        PH_END
    }
#undef PH_BEGIN
#undef PH_END
}
#undef x_in
#undef rel_bias
#undef norm_mix_pre
#undef norm_mix_post
#undef norm_ffn_pre
#undef norm_ffn_post
#undef w_in
#undef diff_lambda
#undef diff_subln
#undef mla_q_norm
#undef mla_kv_norm
#undef mla_w_uq
#undef mla_w_ukv
#undef gqa_q_norm
#undef gqa_k_norm
#undef w_out
#undef w_gate_up
#undef w_down
#undef xres
#undef ws
#undef PAR
#undef TBLA
#undef TBLD
#undef COS
#undef SIN
#undef H
#undef PROJ
#undef CQN
#undef CKVN
#undef KPE
#undef QC
#undef KC
#undef QB
#undef KVB
#undef MIX
#undef Y
#undef HID
#undef TMP
#undef wl

constexpr int N_PHASES = 1 + DEPTH * 9;

extern "C" void kernel_launch(void* const* d_in, const int* in_sizes, int n_in, void* d_out, int out_size, void* d_ws, size_t ws_size, hipStream_t stream) {
    static int grid = 0;
    if (grid == 0) {
        if (n_in != 18 || in_sizes[0] != S * DM || out_size != S * DM || ws_size < WS_END) {
            fprintf(stderr, "kernel_launch: unexpected shapes (n_in %d, in0 %d, out %d, ws %zu < %zu)\n", n_in, n_in > 0 ? in_sizes[0] : -1, out_size, ws_size, (size_t)WS_END); grid = -1; return; }
        int dev = 0, cus = 0, per_cu = 0;
        if (hipGetDevice(&dev) != hipSuccess || hipDeviceGetAttribute(&cus, hipDeviceAttributeMultiprocessorCount, dev) != hipSuccess) { grid = -1; return; }
        if (hipFuncSetAttribute((const void*)mega_fwd, hipFuncAttributeMaxDynamicSharedMemorySize, LDS_BYTES) != hipSuccess) { fprintf(stderr, "kernel_launch: hipFuncSetAttribute failed\n"); grid = -1; return; }
        if (hipOccupancyMaxActiveBlocksPerMultiprocessor(&per_cu, (const void*)mega_fwd, 512, LDS_BYTES) != hipSuccess || per_cu < 1) { fprintf(stderr, "kernel_launch: occupancy query says %d\n", per_cu); per_cu = 1; }
        (void)hipGetLastError();
        grid = cus;
    }
    if (grid < 0) return;
    if (hipMemsetAsync((char*)d_ws + WS_BAR, 0, WS_BAR_BYTES, stream) != hipSuccess) { fprintf(stderr, "kernel_launch: hipMemsetAsync of the barrier words failed\n"); return; }
    Args a{};
    for (int i = 0; i < 18; ++i) a.in[i] = (const float*)d_in[i];
    a.out = (float*)d_out; a.wsp = (unsigned char*)d_ws;
#if MK_MULTI
    for (int p = 0; p < N_PHASES; ++p) { a.ph_lo = p; a.ph_hi = p + 1; hipLaunchKernelGGL(mega_fwd, dim3(grid), dim3(512), LDS_BYTES, stream, a); }
#else
    a.ph_lo = 0; a.ph_hi = N_PHASES;
    void* kargs[] = {&a};
    hipError_t e = hipLaunchCooperativeKernel((const void*)mega_fwd, dim3(grid), dim3(512), kargs, LDS_BYTES, stream);
    if (e != hipSuccess) fprintf(stderr, "kernel_launch: cooperative launch failed: %s (grid %d)\n", hipGetErrorString(e), grid);
#endif
}
```

```cpp
#include <hip/hip_runtime.h>
#include <hip/hip_cooperative_groups.h>
#include <cstdio>
#include <cstdint>
namespace cg = cooperative_groups;

#ifndef MK_MULTI
#define MK_MULTI 0
#endif
#ifndef MK_PHMASK
#define MK_PHMASK 0xFFFFF
#endif
#define PHON(k) constexpr (((MK_PHMASK) >> (k)) & 1)
#ifndef MK_DUP_GEMM
#define MK_DUP_GEMM 1
#endif
#ifndef MK_DUP_ATT
#define MK_DUP_ATT 1
#endif

typedef unsigned short bf16_t;
typedef short bf16x8 __attribute__((ext_vector_type(8)));
typedef short s16x4 __attribute__((ext_vector_type(4)));
typedef float f32x2 __attribute__((ext_vector_type(2)));
typedef float f32x4 __attribute__((ext_vector_type(4)));
typedef float f32x16 __attribute__((ext_vector_type(16)));
typedef unsigned u32x2 __attribute__((ext_vector_type(2)));
typedef unsigned u32x4 __attribute__((ext_vector_type(4)));
#define LAS __attribute__((address_space(3)))

constexpr int S = 16384, DM = 2048, DEPTH = 4, NPROJ = 4928, LDP = 5120, FF = 5632, NGU = 2 * FF;
constexpr float EPS = 1e-6f;
constexpr int C_AQ = 0, C_AK = 512, C_AV = 1024, C_BCQ = 1536, C_BCKV = 2048, C_BKPE = 2304, C_CQ = 2368, C_CK = 2880, C_CV = 3136, C_DQ = 3392, C_DK = 3904, C_DV = 4416;
constexpr int TOFF = 1408, TBLN = 2824;

constexpr size_t MiB = 1u << 20;
constexpr size_t WS_PAR = 0, WS_TBLA = 1 * MiB, WS_TBLD = 1 * MiB + 65536, WS_COS = 2 * MiB, WS_SIN = 4 * MiB;
constexpr size_t WS_BAR = 6 * MiB, WS_BAR_BYTES = 16384;
constexpr size_t WS_W = 8 * MiB, LW = 96 * MiB;
constexpr size_t W_IN = 0, W_UQ = 20 * MiB, W_UKV = 21 * MiB, W_OUT = 22 * MiB, W_GU = 30 * MiB, W_D = 74 * MiB;
constexpr size_t WS_H = 392 * MiB, WS_PROJ = 456 * MiB, WS_CQN = 616 * MiB, WS_CKVN = 632 * MiB, WS_KPE = 640 * MiB, WS_QC = 642 * MiB, WS_KC = 658 * MiB;
constexpr size_t WS_QB = 666 * MiB, WS_KVB = 690 * MiB, WS_MIX = 722 * MiB, WS_Y = 786 * MiB, WS_HID = 914 * MiB, WS_TMP = 1090 * MiB, WS_END = 1122 * MiB;

constexpr int LDS_ST_OFF = 163840 - 16;
constexpr int LDS_BYTES = 163840;

__device__ __forceinline__ float bf2f(unsigned short b) { return __uint_as_float(((unsigned)b) << 16); }
__device__ __forceinline__ unsigned f2bf(float f) { unsigned u = __float_as_uint(f); return (u + 0x7fffu + ((u >> 16) & 1u)) >> 16; }
__device__ __forceinline__ unsigned pk2(float lo, float hi) { return f2bf(lo) | (f2bf(hi) << 16); }
__device__ __forceinline__ unsigned cvt_pk_bf16(float lo, float hi) { unsigned r; asm volatile("v_cvt_pk_bf16_f32 %0, %1, %2" : "=v"(r) : "v"(lo), "v"(hi)); return r; }
__device__ __forceinline__ int lane_id_v() { int l; asm volatile("v_mbcnt_lo_u32_b32 %0, -1, 0\n\tv_mbcnt_hi_u32_b32 %0, -1, %0" : "=v"(l)); return l; }
template <int M> __device__ __forceinline__ float swz_xor(float v) { return __int_as_float(__builtin_amdgcn_ds_swizzle(__float_as_int(v), (M << 10) | 0x1f)); }
__device__ __forceinline__ float wave_sum(float v) {
    v += swz_xor<1>(v); v += swz_xor<2>(v); v += swz_xor<4>(v); v += swz_xor<8>(v); v += swz_xor<16>(v);
    auto rr = __builtin_amdgcn_permlane32_swap(__float_as_uint(v), __float_as_uint(v), false, false);
    return __uint_as_float(rr[0]) + __uint_as_float(rr[1]);
}

namespace pg8 {
constexpr int BM = 256, BK = 64, HALF = 128, HTB = HALF * BK * 2, STAGE_BYTES = 8 * HTB, NXCD = 8, WGM = 8;
__host__ __device__ __forceinline__ int lds_byte(int r, int c) { const int st = (r >> 4) * 2 + (c >> 5), rr = r & 15, cc = c & 31, ob = rr * 64 + cc * 2; return st * 1024 + (ob ^ (((ob >> 9) & 1) << 5)); }
__host__ __device__ __forceinline__ void stage_rc(int b, int& R, int& C) { const int st = b / 1024, sb = b % 1024, swz = sb ^ (((sb >> 9) & 1) << 5); R = (st >> 1) * 16 + swz / 64; C = (st & 1) * 32 + (swz % 64) / 2; }
__host__ __device__ __forceinline__ int perm32(int rho) { const int n = rho >> 4, i = rho & 15; return 8 * (i >> 2) + 4 * n + (i & 3); }

struct Unit { int pm, pn; };
struct Gemm { const bf16_t* A; const bf16_t* Bt; int M, N, K; };

struct StaticOrder {
    int nM, nN, nwg, G, c;
    __host__ __device__ void init(int M, int N, int G_, int c_) { nM = M / BM; nN = N / BM; nwg = nM * nN; G = G_; c = c_; }
    __host__ __device__ bool next(int i, Unit& u) const {
        const long L = (long)i * G + c; if (L >= nwg) return false;
        int wgid = (int)L; { const int q = nwg / NXCD, r = nwg % NXCD, xcd = wgid % NXCD, off = wgid / NXCD; wgid = (xcd < r ? xcd * (q + 1) : r * (q + 1) + (xcd - r) * q) + off; }
        const int nig = WGM * nN, gid = wgid / nig, fm = gid * WGM, gsz = (nM - fm) < WGM ? (nM - fm) : WGM;
        u.pm = fm + ((wgid % nig) % gsz); u.pn = (wgid % nig) / gsz; return true;
    }
    __device__ __forceinline__ void a_ready(const Unit&) const {}
    __device__ __forceinline__ void done(const Unit&) const {}
};

struct EpiBf16 {
    static constexpr bool PERM = true, AFTER_DRAIN = false;
    bf16_t* O; int ldc;
    __device__ __forceinline__ void operator()(const f32x4 (&acc)[2][2][4][2], const Unit& u, int wr, int wc, int fr, int fq) const {
        const int row0 = u.pm * BM + wr * 64 + fr; const int col0 = u.pn * BM + wc * 32 + 8 * fq;
#pragma unroll
        for (int ai = 0; ai < 2; ++ai)
#pragma unroll
            for (int m = 0; m < 4; ++m) { bf16_t* rowp = O + (size_t)(row0 + ai * HALF + m * 16) * ldc + col0;
#pragma unroll
                for (int bj = 0; bj < 2; ++bj) { const f32x4 v0 = acc[ai][bj][m][0], v1 = acc[ai][bj][m][1];
                    u32x4 w; w.x = cvt_pk_bf16(v0[0], v0[1]); w.y = cvt_pk_bf16(v0[2], v0[3]); w.z = cvt_pk_bf16(v1[0], v1[1]); w.w = cvt_pk_bf16(v1[2], v1[3]);
                    *(u32x4*)(rowp + bj * HALF) = w; } }
    }
};
struct EpiF32 {
    static constexpr bool PERM = false, AFTER_DRAIN = false;
    float* O; int ldc;
    __device__ __forceinline__ void operator()(const f32x4 (&acc)[2][2][4][2], const Unit& u, int wr, int wc, int fr, int fq) const {
        const int row0 = u.pm * BM + wr * 64 + fr; const int col0 = u.pn * BM + wc * 32 + 4 * fq;
#pragma unroll
        for (int ai = 0; ai < 2; ++ai)
#pragma unroll
            for (int m = 0; m < 4; ++m) { float* rowp = O + (size_t)(row0 + ai * HALF + m * 16) * ldc + col0;
#pragma unroll
                for (int bj = 0; bj < 2; ++bj)
#pragma unroll
                    for (int n = 0; n < 2; ++n) *(f32x4*)(rowp + bj * HALF + n * 16) = acc[ai][bj][m][n]; }
    }
};
__device__ __forceinline__ float silu_mul(float g, float u) {
    const float e = __builtin_amdgcn_exp2f(-g * 1.4426950408889634f);
    return g * __builtin_amdgcn_rcpf(1.0f + e) * u;
}
struct EpiSwiGLU {
    static constexpr bool PERM = true, AFTER_DRAIN = false;
    bf16_t* O; int ldc;
    __device__ __forceinline__ void operator()(const f32x4 (&acc)[2][2][4][2], const Unit& u, int wr, int wc, int fr, int fq) const {
        const int row0 = u.pm * BM + wr * 64 + fr; const int col0 = u.pn * HALF + wc * 32 + 8 * fq;
#pragma unroll
        for (int ai = 0; ai < 2; ++ai)
#pragma unroll
            for (int m = 0; m < 4; ++m) { bf16_t* rowp = O + (size_t)(row0 + ai * HALF + m * 16) * ldc + col0;
                const f32x4 g0 = acc[ai][0][m][0], g1 = acc[ai][0][m][1], u0 = acc[ai][1][m][0], u1 = acc[ai][1][m][1];
                u32x4 w; w.x = cvt_pk_bf16(silu_mul(g0[0], u0[0]), silu_mul(g0[1], u0[1])); w.y = cvt_pk_bf16(silu_mul(g0[2], u0[2]), silu_mul(g0[3], u0[3]));
                w.z = cvt_pk_bf16(silu_mul(g1[0], u1[0]), silu_mul(g1[1], u1[1])); w.w = cvt_pk_bf16(silu_mul(g1[2], u1[2]), silu_mul(g1[3], u1[3]));
                *(u32x4*)rowp = w; }
    }
};

template <class Epi, class Sched, bool ALIGN_EPI = false, bool SP2 = false>
__device__ __forceinline__ void gemm_phase(LAS unsigned char* lds, const Gemm g, const Sched& S, const Epi& E, const int wave0) {
    int tid_ = wave0 * 64 + lane_id_v();
    const int tid = tid_, wid = __builtin_amdgcn_readfirstlane(tid >> 6), lane = tid & 63, wr = wid >> 2, wc = wid & 3, fr = lane & 15, fq = lane >> 4;
    int K_ = g.K; asm volatile("" : "+s"(K_));
    const int K = K_, nt = K / BK;
    unsigned voffA[2], voffB[2];
#pragma unroll
    for (int i = 0; i < 2; ++i) { int R, C; stage_rc(tid * 16 + i * 8192, R, C); const int Rb = Epi::PERM ? ((R & ~31) + perm32(R & 31)) : R;
        voffA[i] = (unsigned)(R * K + C) * 2u; voffB[i] = (unsigned)(Rb * K + C) * 2u; }
    const size_t kstep = (size_t)(BK * 2);
    const size_t hstep = (size_t)HALF * K * 2;
    const size_t tstep = 2 * hstep;
    const unsigned ldsw = (unsigned)wid * 1024u;
    const int aoff = lds_byte(wr * 64 + fr, fq * 8), boff = lds_byte(wc * 32 + fr, fq * 8);
#define PG8_SA(b, h) (((b) * 2 + (h)) * HTB)
#define PG8_SB(b, h) ((4 + (b) * 2 + (h)) * HTB)
#define PG8_STAGE(bufoff, gbase, voff) do { _Pragma("unroll") for (int _i = 0; _i < 2; ++_i) \
        __builtin_amdgcn_global_load_lds((const unsigned*)((const char*)(gbase) + (voff)[_i]), (LAS unsigned*)(lds + (bufoff) + ldsw + _i * 8192), 16, 0, 0); } while (0)
#define PG8_LDA(dst, b, h) do { _Pragma("unroll") for (int m = 0; m < 4; ++m) _Pragma("unroll") for (int k = 0; k < 2; ++k) dst[m][k] = *(const LAS bf16x8*)(lds + PG8_SA(b, h) + aoff + m * 2048 + k * 1024); } while (0)
#define PG8_LDB(dst, b, h) do { _Pragma("unroll") for (int n = 0; n < 2; ++n) _Pragma("unroll") for (int k = 0; k < 2; ++k) dst[n][k] = *(const LAS bf16x8*)(lds + PG8_SB(b, h) + boff + n * 2048 + k * 1024); } while (0)
#define PG8_MMA(ai, bj, At, Bt) do { __builtin_amdgcn_s_setprio(1); _Pragma("unroll") for (int m = 0; m < 4; ++m) _Pragma("unroll") for (int n = 0; n < 2; ++n) _Pragma("unroll") for (int k = 0; k < 2; ++k) \
        acc[ai][bj][m][n] = __builtin_amdgcn_mfma_f32_16x16x32_bf16(Bt[n][k], At[m][k], acc[ai][bj][m][n], 0, 0, 0); __builtin_amdgcn_s_setprio(0); } while (0)
#define PG8_WAIT_V(n) asm volatile("s_waitcnt vmcnt(" #n ")" ::: "memory")
#define PG8_WAIT_L(n) asm volatile("s_waitcnt lgkmcnt(" #n ")" ::: "memory")
#define PG8_BAR __builtin_amdgcn_s_barrier()
#define PG8_SCHED __builtin_amdgcn_sched_barrier(0)
    Unit cur, nxt; int ui = 0;
    if (!S.next(0, cur)) return;
    f32x4 acc[2][2][4][2];
#pragma unroll
    for (int a = 0; a < 2; ++a)
#pragma unroll
        for (int b = 0; b < 2; ++b)
#pragma unroll
            for (int m = 0; m < 4; ++m)
#pragma unroll
                for (int n = 0; n < 2; ++n) acc[a][b][m][n] = (f32x4){0.f, 0.f, 0.f, 0.f};
    bf16x8 At[4][2], B0[2][2], B1[2][2];
    const char* cA = (const char*)g.A + (size_t)cur.pm * tstep; const char* cB = (const char*)g.Bt + (size_t)cur.pn * tstep;
    S.a_ready(cur);
    if constexpr (SP2) {
        PG8_STAGE(PG8_SB(0, 0), cB, voffB); PG8_STAGE(PG8_SB(0, 1), cB + hstep, voffB); PG8_STAGE(PG8_SA(0, 0), cA, voffA); PG8_STAGE(PG8_SA(0, 1), cA + hstep, voffA);
        if (wr == 1) PG8_BAR;
        PG8_WAIT_V(2); PG8_BAR;
        PG8_STAGE(PG8_SB(1, 0), cB + kstep, voffB); PG8_STAGE(PG8_SA(1, 0), cA + kstep, voffA); PG8_STAGE(PG8_SB(1, 1), cB + hstep + kstep, voffB);
        PG8_WAIT_V(6); PG8_BAR;
    } else {
        PG8_STAGE(PG8_SB(0, 0), cB, voffB); PG8_STAGE(PG8_SA(0, 0), cA, voffA); PG8_STAGE(PG8_SB(0, 1), cB + hstep, voffB); PG8_STAGE(PG8_SA(0, 1), cA + hstep, voffA);
        if (wr == 1) PG8_BAR;
        PG8_WAIT_V(4); PG8_BAR;
        PG8_STAGE(PG8_SB(1, 0), cB + kstep, voffB); PG8_STAGE(PG8_SA(1, 0), cA + kstep, voffA); PG8_STAGE(PG8_SB(1, 1), cB + hstep + kstep, voffB);
        PG8_WAIT_V(6); PG8_BAR;
    }
    for (;;) {
        const bool has_next = S.next(ui + 1, nxt);
        const char* nA = has_next ? (const char*)g.A + (size_t)nxt.pm * tstep : cA; const char* nB = has_next ? (const char*)g.Bt + (size_t)nxt.pn * tstep : cB;
        for (int t = 0; t < nt; t += 2) {
            const bool last = (t == nt - 2);
            const char* a1 = cA + (size_t)(t + 1) * kstep;
            const char* a2 = last ? nA : cA + (size_t)(t + 2) * kstep; const char* b2 = last ? nB : cB + (size_t)(t + 2) * kstep;
            const char* a3 = a2 + kstep; const char* b3 = b2 + kstep;
            if (last && has_next) S.a_ready(nxt);
            if constexpr (SP2) {
            PG8_LDB(B0, 0, 0); PG8_LDB(B1, 0, 1); PG8_SCHED; PG8_LDA(At, 0, 0); PG8_STAGE(PG8_SA(1, 1), a1 + hstep, voffA);
            PG8_WAIT_V(8); PG8_WAIT_L(0); PG8_BAR; PG8_MMA(0, 0, At, B0); PG8_MMA(0, 1, At, B1); PG8_BAR; PG8_SCHED;
            PG8_LDA(At, 0, 1); PG8_STAGE(PG8_SB(0, 0), b2, voffB); PG8_STAGE(PG8_SB(0, 1), b2 + hstep, voffB); PG8_STAGE(PG8_SA(0, 0), a2, voffA);
            PG8_WAIT_V(8); PG8_WAIT_L(0); PG8_BAR; PG8_MMA(1, 0, At, B0); PG8_MMA(1, 1, At, B1); PG8_BAR; PG8_SCHED;
            PG8_LDB(B0, 1, 0); PG8_LDB(B1, 1, 1); PG8_SCHED; PG8_LDA(At, 1, 0); PG8_STAGE(PG8_SA(0, 1), a2 + hstep, voffA);
            PG8_WAIT_V(8); PG8_WAIT_L(0); PG8_BAR; PG8_MMA(0, 0, At, B0); PG8_MMA(0, 1, At, B1); PG8_BAR; PG8_SCHED;
            PG8_LDA(At, 1, 1); PG8_STAGE(PG8_SB(1, 0), b3, voffB); PG8_STAGE(PG8_SB(1, 1), b3 + hstep, voffB); PG8_STAGE(PG8_SA(1, 0), a3, voffA);
            PG8_WAIT_V(8); PG8_WAIT_L(0); PG8_BAR; PG8_MMA(1, 0, At, B0); PG8_MMA(1, 1, At, B1); PG8_BAR; PG8_SCHED;
            } else {
            PG8_LDB(B0, 0, 0); PG8_SCHED; PG8_LDA(At, 0, 0); PG8_STAGE(PG8_SA(1, 1), a1 + hstep, voffA);
            PG8_WAIT_L(8); PG8_BAR; PG8_WAIT_L(0); PG8_MMA(0, 0, At, B0); PG8_BAR; PG8_SCHED;
            PG8_LDB(B1, 0, 1); PG8_STAGE(PG8_SB(0, 0), b2, voffB);
            PG8_BAR; PG8_WAIT_L(0); PG8_MMA(0, 1, At, B1); PG8_BAR;
            PG8_LDA(At, 0, 1); PG8_STAGE(PG8_SA(0, 0), a2, voffA);
            PG8_BAR; PG8_WAIT_L(0); PG8_MMA(1, 0, At, B0); PG8_BAR; PG8_SCHED;
            PG8_STAGE(PG8_SB(0, 1), b2 + hstep, voffB);
            PG8_WAIT_V(6); PG8_BAR; PG8_MMA(1, 1, At, B1); PG8_BAR;
            PG8_LDB(B0, 1, 0); PG8_SCHED; PG8_LDA(At, 1, 0); PG8_STAGE(PG8_SA(0, 1), a2 + hstep, voffA);
            PG8_WAIT_L(8); PG8_BAR; PG8_WAIT_L(0); PG8_MMA(0, 0, At, B0); PG8_BAR; PG8_SCHED;
            PG8_LDB(B1, 1, 1); PG8_STAGE(PG8_SB(1, 0), b3, voffB);
            PG8_BAR; PG8_WAIT_L(0); PG8_MMA(0, 1, At, B1); PG8_BAR;
            PG8_LDA(At, 1, 1); PG8_STAGE(PG8_SA(1, 0), a3, voffA);
            PG8_BAR; PG8_WAIT_L(0); PG8_MMA(1, 0, At, B0); PG8_BAR; PG8_SCHED;
            PG8_STAGE(PG8_SB(1, 1), b3 + hstep, voffB);
            PG8_WAIT_V(6); PG8_BAR; PG8_MMA(1, 1, At, B1); PG8_BAR;
            }
        }
        if constexpr (ALIGN_EPI) { if (wr == 0) PG8_BAR; }
        if constexpr (!Epi::AFTER_DRAIN) { E(acc, cur, wr, wc, fr, fq); S.done(cur); }
        if (!has_next) break;
#pragma unroll
        for (int a = 0; a < 2; ++a)
#pragma unroll
            for (int b = 0; b < 2; ++b)
#pragma unroll
                for (int m = 0; m < 4; ++m)
#pragma unroll
                    for (int n = 0; n < 2; ++n) acc[a][b][m][n] = (f32x4){0.f, 0.f, 0.f, 0.f};
        cur = nxt; cA = nA; cB = nB; ++ui;
        if constexpr (ALIGN_EPI) { if (wr == 1) PG8_BAR; }
    }
    PG8_WAIT_V(0);
    if constexpr (!ALIGN_EPI) { if (wr == 0) PG8_BAR; }
    PG8_BAR;
#undef PG8_SA
#undef PG8_SB
#undef PG8_STAGE
#undef PG8_LDA
#undef PG8_LDB
#undef PG8_MMA
#undef PG8_WAIT_V
#undef PG8_WAIT_L
#undef PG8_BAR
#undef PG8_SCHED
}
}

namespace att {
constexpr int NW = 8, QBLK = 32, KVBLK = 64;
constexpr int SHM_V = KVBLK * 128 * 2;
#define SBAR() __builtin_amdgcn_sched_barrier(0)
__device__ __forceinline__ int crow(int r, int hi) { return (r & 3) + 8 * (r >> 2) + 4 * hi; }
__device__ __forceinline__ unsigned cvtpk(float lo, float hi) { unsigned r; asm volatile("v_cvt_pk_bf16_f32 %0, %1, %2" : "=v"(r) : "v"(lo), "v"(hi)); return r; }

constexpr float THR2 = 8.0f * 1.4426950408889634f;
template <bool FIRST>
__device__ __forceinline__ void partialSM(f32x16& p0, f32x16& p1, float& mC, float& alpha) {
  float mx_[4] = {p0[0], p0[1], p0[2], p0[3]};
#pragma unroll
  for (int r = 4; r < 16; ++r) mx_[r & 3] = fmaxf(mx_[r & 3], p0[r]);
#pragma unroll
  for (int r = 0; r < 16; ++r) mx_[r & 3] = fmaxf(mx_[r & 3], p1[r]);
  float pmax = fmaxf(fmaxf(mx_[0], mx_[1]), fmaxf(mx_[2], mx_[3]));
  { auto rr = __builtin_amdgcn_permlane32_swap(__float_as_uint(pmax), __float_as_uint(pmax), false, false);
    pmax = fmaxf(__uint_as_float(rr[0]), __uint_as_float(rr[1])); }
  if (!FIRST && __builtin_expect(__all(pmax <= THR2), 1)) { alpha = 1.f; }
  else { const float delta = FIRST ? fmaxf(pmax, -200.f) : fmaxf(pmax, 0.f); alpha = FIRST ? 1.f : __builtin_amdgcn_exp2f(-delta); mC += delta;
#pragma unroll
    for (int r = 0; r < 16; ++r) p0[r] -= delta;
#pragma unroll
    for (int r = 0; r < 16; ++r) p1[r] -= delta; }
#pragma unroll
  for (int r = 0; r < 16; ++r) p0[r] = __builtin_amdgcn_exp2f(p0[r]);
}
template <bool EXP1 = true>
__device__ __forceinline__ void finishSM(f32x16& p0, f32x16& p1, float alpha, float& l_reg, bf16x8& pa0, bf16x8& pa1, bf16x8& pa2, bf16x8& pa3) {
  if constexpr (EXP1) {
#pragma unroll
  for (int r = 0; r < 16; ++r) p1[r] = __builtin_amdgcn_exp2f(p1[r]);
  }
  float sm_[4] = {p0[0], p0[1], p0[2], p0[3]};
#pragma unroll
  for (int r = 4; r < 16; ++r) sm_[r & 3] += p0[r];
#pragma unroll
  for (int r = 0; r < 16; ++r) sm_[r & 3] += p1[r];
  float ps = (sm_[0] + sm_[1]) + (sm_[2] + sm_[3]);
  { auto rr = __builtin_amdgcn_permlane32_swap(__float_as_uint(ps), __float_as_uint(ps), false, false);
    ps = __uint_as_float(rr[0]) + __uint_as_float(rr[1]); }
  l_reg = l_reg * alpha + ps;
#define PK4(P, BASE, OUT) do { unsigned a0 = cvtpk(P[BASE + 0], P[BASE + 1]), a1 = cvtpk(P[BASE + 2], P[BASE + 3]);   \
    unsigned b0 = cvtpk(P[BASE + 4], P[BASE + 5]), b1 = cvtpk(P[BASE + 6], P[BASE + 7]);                              \
    auto r0 = __builtin_amdgcn_permlane32_swap(a0, b0, false, false); auto r1 = __builtin_amdgcn_permlane32_swap(a1, b1, false, false); \
    u32x4 w = {r0[0], r1[0], r0[1], r1[1]}; OUT = *reinterpret_cast<bf16x8*>(&w); } while (0)
  PK4(p0, 0, pa0); PK4(p0, 8, pa1); PK4(p1, 0, pa2); PK4(p1, 8, pa3);
#undef PK4
}
template <int NDQ, int NQL>
__device__ __forceinline__ void qkt(f32x16& p0, f32x16& p1, const f32x16& negm, const char* Ks, const bf16x8* qr, const char* qls, int r32, int hi) {
  constexpr int ROWB = NDQ * 32, NQR = NDQ - NQL, SWM = (NDQ == 8) ? 15 : 7;
#pragma unroll
  for (int d0 = 0; d0 < NDQ; ++d0) { const int cb = (d0 * 16 + hi * 8) * 2;
    bf16x8 b0 = *reinterpret_cast<const bf16x8*>(Ks + r32 * ROWB + (cb ^ ((r32 & SWM) << 4)));
    bf16x8 b1 = *reinterpret_cast<const bf16x8*>(Ks + (32 + r32) * ROWB + (cb ^ ((r32 & SWM) << 4)));
    bf16x8 q;
    if constexpr (NQL > 0) { if (d0 < NQR) q = qr[d0 < NQR ? d0 : 0]; else q = *reinterpret_cast<const bf16x8*>(qls + (d0 - NQR) * 1024); }
    else q = qr[d0];
    if (d0 == 0) { p0 = __builtin_amdgcn_mfma_f32_32x32x16_bf16(b0, q, negm, 0, 0, 0); p1 = __builtin_amdgcn_mfma_f32_32x32x16_bf16(b1, q, negm, 0, 0, 0); }
    else { p0 = __builtin_amdgcn_mfma_f32_32x32x16_bf16(b0, q, p0, 0, 0, 0); p1 = __builtin_amdgcn_mfma_f32_32x32x16_bf16(b1, q, p1, 0, 0, 0); } }
}
template <int OFF> __device__ __forceinline__ bf16x8 lds_rd128(int a) { bf16x8 r; asm volatile("ds_read_b128 %0, %1 offset:%2" : "=&v"(r) : "v"(a), "i"(OFF) : "memory"); return r; }
#define SBAR_M() __builtin_amdgcn_sched_barrier(0)
__device__ __forceinline__ void qkt8_roll(f32x16& p0, f32x16& p1, const f32x16& negm, int kb, const bf16x8* qr) {
  const int a0 = kb ^ (0 << 5); const bf16x8 x0 = lds_rd128<0>(a0), y0 = lds_rd128<8192>(a0);
  const int a1 = kb ^ (1 << 5); const bf16x8 x1 = lds_rd128<0>(a1), y1 = lds_rd128<8192>(a1);
  const int a2 = kb ^ (2 << 5); const bf16x8 x2 = lds_rd128<0>(a2), y2 = lds_rd128<8192>(a2);
  asm volatile("s_waitcnt lgkmcnt(4)" ::: "memory"); SBAR_M();
  p0 = __builtin_amdgcn_mfma_f32_32x32x16_bf16(x0, qr[0], negm, 0, 0, 0); p1 = __builtin_amdgcn_mfma_f32_32x32x16_bf16(y0, qr[0], negm, 0, 0, 0);
  const int a3 = kb ^ (3 << 5); const bf16x8 x3 = lds_rd128<0>(a3), y3 = lds_rd128<8192>(a3);
  asm volatile("s_waitcnt lgkmcnt(4)" ::: "memory"); SBAR_M();
  p0 = __builtin_amdgcn_mfma_f32_32x32x16_bf16(x1, qr[1], p0, 0, 0, 0); p1 = __builtin_amdgcn_mfma_f32_32x32x16_bf16(y1, qr[1], p1, 0, 0, 0);
  const int a4 = kb ^ (4 << 5); const bf16x8 x4 = lds_rd128<0>(a4), y4 = lds_rd128<8192>(a4);
  asm volatile("s_waitcnt lgkmcnt(4)" ::: "memory"); SBAR_M();
  p0 = __builtin_amdgcn_mfma_f32_32x32x16_bf16(x2, qr[2], p0, 0, 0, 0); p1 = __builtin_amdgcn_mfma_f32_32x32x16_bf16(y2, qr[2], p1, 0, 0, 0);
  const int a5 = kb ^ (5 << 5); const bf16x8 x5 = lds_rd128<0>(a5), y5 = lds_rd128<8192>(a5);
  asm volatile("s_waitcnt lgkmcnt(4)" ::: "memory"); SBAR_M();
  p0 = __builtin_amdgcn_mfma_f32_32x32x16_bf16(x3, qr[3], p0, 0, 0, 0); p1 = __builtin_amdgcn_mfma_f32_32x32x16_bf16(y3, qr[3], p1, 0, 0, 0);
  const int a6 = kb ^ (6 << 5); const bf16x8 x6 = lds_rd128<0>(a6), y6 = lds_rd128<8192>(a6);
  asm volatile("s_waitcnt lgkmcnt(4)" ::: "memory"); SBAR_M();
  p0 = __builtin_amdgcn_mfma_f32_32x32x16_bf16(x4, qr[4], p0, 0, 0, 0); p1 = __builtin_amdgcn_mfma_f32_32x32x16_bf16(y4, qr[4], p1, 0, 0, 0);
  const int a7 = kb ^ (7 << 5); const bf16x8 x7 = lds_rd128<0>(a7), y7 = lds_rd128<8192>(a7);
  asm volatile("s_waitcnt lgkmcnt(4)" ::: "memory"); SBAR_M();
  p0 = __builtin_amdgcn_mfma_f32_32x32x16_bf16(x5, qr[5], p0, 0, 0, 0); p1 = __builtin_amdgcn_mfma_f32_32x32x16_bf16(y5, qr[5], p1, 0, 0, 0);
  asm volatile("s_waitcnt lgkmcnt(2)" ::: "memory"); SBAR_M();
  p0 = __builtin_amdgcn_mfma_f32_32x32x16_bf16(x6, qr[6], p0, 0, 0, 0); p1 = __builtin_amdgcn_mfma_f32_32x32x16_bf16(y6, qr[6], p1, 0, 0, 0);
  asm volatile("s_waitcnt lgkmcnt(0)" ::: "memory"); SBAR_M();
  p0 = __builtin_amdgcn_mfma_f32_32x32x16_bf16(x7, qr[7], p0, 0, 0, 0); p1 = __builtin_amdgcn_mfma_f32_32x32x16_bf16(y7, qr[7], p1, 0, 0, 0);
}

#define PK4S(P, BASE, OUT) do { unsigned a0 = cvtpk(P[BASE + 0], P[BASE + 1]), a1 = cvtpk(P[BASE + 2], P[BASE + 3]);   \
    unsigned b0 = cvtpk(P[BASE + 4], P[BASE + 5]), b1 = cvtpk(P[BASE + 6], P[BASE + 7]);                              \
    auto r0 = __builtin_amdgcn_permlane32_swap(a0, b0, false, false); auto r1 = __builtin_amdgcn_permlane32_swap(a1, b1, false, false); \
    u32x4 w = {r0[0], r1[0], r0[1], r1[1]}; OUT = *reinterpret_cast<bf16x8*>(&w); } while (0)
template <int K>
__device__ __forceinline__ void fsm_slice(f32x16& p0, f32x16& p1, float alpha, float& l_reg, bf16x8& pa0, bf16x8& pa1, bf16x8& pa2, bf16x8& pa3, float (&sm)[4]) {
  if constexpr (K == 2) {
    sm[0] = p0[0]; sm[1] = p0[1]; sm[2] = p0[2]; sm[3] = p0[3];
#pragma unroll
    for (int r = 4; r < 16; ++r) sm[r & 3] += p0[r];
  } else if constexpr (K == 3) {
#pragma unroll
    for (int r = 0; r < 16; ++r) sm[r & 3] += p1[r];
  } else if constexpr (K == 4) {
    float ps = (sm[0] + sm[1]) + (sm[2] + sm[3]);
    { auto rr = __builtin_amdgcn_permlane32_swap(__float_as_uint(ps), __float_as_uint(ps), false, false);
      ps = __uint_as_float(rr[0]) + __uint_as_float(rr[1]); }
    l_reg = l_reg * alpha + ps;
    PK4S(p0, 0, pa0);
  } else if constexpr (K == 5) { PK4S(p0, 8, pa1);
  } else if constexpr (K == 6) { PK4S(p1, 0, pa2);
  } else if constexpr (K == 7) { PK4S(p1, 8, pa3); }
}
template <int K>
__device__ __forceinline__ void psm_slice(f32x16& p0, f32x16& p1, float& mC, float& alpha, float (&mx)[4]) {
  if constexpr (K == 0) { mx[0] = p0[0]; mx[1] = p0[1]; mx[2] = p0[2]; mx[3] = p0[3]; }
  else if constexpr (K >= 1 && K <= 3) {
#pragma unroll
    for (int r = 4 * K; r < 4 * K + 4; ++r) mx[r & 3] = fmaxf(mx[r & 3], p0[r]);
  } else if constexpr (K >= 4 && K <= 7) {
#pragma unroll
    for (int r = 4 * (K - 4); r < 4 * (K - 4) + 4; ++r) mx[r & 3] = fmaxf(mx[r & 3], p1[r]);
  } else if constexpr (K == 8) {
    float pmax = fmaxf(fmaxf(mx[0], mx[1]), fmaxf(mx[2], mx[3]));
    { auto rr = __builtin_amdgcn_permlane32_swap(__float_as_uint(pmax), __float_as_uint(pmax), false, false);
      pmax = fmaxf(__uint_as_float(rr[0]), __uint_as_float(rr[1])); }
    if (__builtin_expect(__all(pmax <= THR2), 1)) { alpha = 1.f; }
    else { const float delta = fmaxf(pmax, 0.f); alpha = __builtin_amdgcn_exp2f(-delta); mC += delta;
#pragma unroll
      for (int r = 0; r < 16; ++r) p0[r] -= delta;
#pragma unroll
      for (int r = 0; r < 16; ++r) p1[r] -= delta; }
  } else if constexpr (K >= 9 && K <= 12) {
#pragma unroll
    for (int r = 4 * (K - 9); r < 4 * (K - 9) + 4; ++r) p0[r] = __builtin_amdgcn_exp2f(p0[r]);
  } else if constexpr (K >= 13 && K <= 15) {
#pragma unroll
    for (int r = (K == 13 ? 0 : K == 14 ? 6 : 11); r < (K == 13 ? 6 : K == 14 ? 11 : 16); ++r) p1[r] = __builtin_amdgcn_exp2f(p1[r]);
  }
}
__device__ __forceinline__ int v_st(int k, int c) { const int kk = (k & ~0xC) | ((k & 4) << 1) | ((k & 8) >> 1); return ((kk >> 3) * 4 + (c >> 5)) * 512 + ((kk & 7) * 32 + (c & 31)) * 2; }
__device__ __forceinline__ int v_rd_base(int lane) { return ((lane & 3) << 3) | (((lane >> 2) & 3) << 6) | (((lane >> 4) & 1) << 5) | (((lane >> 5) & 1) << 8); }
constexpr int v_rd_off(int d0, int ks, int half) { return d0 * 512 + ks * 4096 + half * 2048; }
template <int OFF> __device__ __forceinline__ s16x4 tr_read(int vb) {
  s16x4 r; asm volatile("ds_read_b64_tr_b16 %0, %1 offset:%2" : "=&v"(r) : "v"(vb), "i"(OFF) : "memory"); return r;
}
template <int D0> __device__ __forceinline__ void pv_one(f32x16& od, int vb, bf16x8 pa0, bf16x8 pa1, bf16x8 pa2, bf16x8 pa3) {
  const s16x4 l0 = tr_read<v_rd_off(D0, 0, 0)>(vb), h0 = tr_read<v_rd_off(D0, 0, 1)>(vb), l1 = tr_read<v_rd_off(D0, 1, 0)>(vb), h1 = tr_read<v_rd_off(D0, 1, 1)>(vb);
  const s16x4 l2 = tr_read<v_rd_off(D0, 2, 0)>(vb), h2 = tr_read<v_rd_off(D0, 2, 1)>(vb), l3 = tr_read<v_rd_off(D0, 3, 0)>(vb), h3 = tr_read<v_rd_off(D0, 3, 1)>(vb);
  asm volatile("s_waitcnt lgkmcnt(0)" ::: "memory"); SBAR();
#define PK(L, H) (bf16x8){L[0], L[1], L[2], L[3], H[0], H[1], H[2], H[3]}
  od = __builtin_amdgcn_mfma_f32_32x32x16_bf16(pa0, PK(l0, h0), od, 0, 0, 0);
  od = __builtin_amdgcn_mfma_f32_32x32x16_bf16(pa1, PK(l1, h1), od, 0, 0, 0);
  od = __builtin_amdgcn_mfma_f32_32x32x16_bf16(pa2, PK(l2, h2), od, 0, 0, 0);
  od = __builtin_amdgcn_mfma_f32_32x32x16_bf16(pa3, PK(l3, h3), od, 0, 0, 0);
#undef PK
}
__device__ __forceinline__ void pv_d0(f32x16* o, int vb, bf16x8 pa0, bf16x8 pa1, bf16x8 pa2, bf16x8 pa3) {
#define PK(L, H) (bf16x8){L[0], L[1], L[2], L[3], H[0], H[1], H[2], H[3]}
  const s16x4 l0 = tr_read<v_rd_off(0, 0, 0)>(vb), h0 = tr_read<v_rd_off(0, 0, 1)>(vb);
  const s16x4 l1 = tr_read<v_rd_off(0, 1, 0)>(vb), h1 = tr_read<v_rd_off(0, 1, 1)>(vb);
  const s16x4 l2 = tr_read<v_rd_off(0, 2, 0)>(vb), h2 = tr_read<v_rd_off(0, 2, 1)>(vb);
  const s16x4 l3 = tr_read<v_rd_off(0, 3, 0)>(vb), h3 = tr_read<v_rd_off(0, 3, 1)>(vb);
  const s16x4 l4 = tr_read<v_rd_off(1, 0, 0)>(vb), h4 = tr_read<v_rd_off(1, 0, 1)>(vb);
  asm volatile("s_waitcnt lgkmcnt(8)" ::: "memory"); SBAR();
  o[0] = __builtin_amdgcn_mfma_f32_32x32x16_bf16(pa0, PK(l0, h0), o[0], 0, 0, 0);
  const s16x4 l5 = tr_read<v_rd_off(1, 1, 0)>(vb), h5 = tr_read<v_rd_off(1, 1, 1)>(vb);
  asm volatile("s_waitcnt lgkmcnt(8)" ::: "memory"); SBAR();
  o[0] = __builtin_amdgcn_mfma_f32_32x32x16_bf16(pa1, PK(l1, h1), o[0], 0, 0, 0);
  const s16x4 l6 = tr_read<v_rd_off(1, 2, 0)>(vb), h6 = tr_read<v_rd_off(1, 2, 1)>(vb);
  asm volatile("s_waitcnt lgkmcnt(8)" ::: "memory"); SBAR();
  o[0] = __builtin_amdgcn_mfma_f32_32x32x16_bf16(pa2, PK(l2, h2), o[0], 0, 0, 0);
  const s16x4 l7 = tr_read<v_rd_off(1, 3, 0)>(vb), h7 = tr_read<v_rd_off(1, 3, 1)>(vb);
  asm volatile("s_waitcnt lgkmcnt(8)" ::: "memory"); SBAR();
  o[0] = __builtin_amdgcn_mfma_f32_32x32x16_bf16(pa3, PK(l3, h3), o[0], 0, 0, 0);
  const s16x4 l8 = tr_read<v_rd_off(2, 0, 0)>(vb), h8 = tr_read<v_rd_off(2, 0, 1)>(vb);
  asm volatile("s_waitcnt lgkmcnt(8)" ::: "memory"); SBAR();
  o[1] = __builtin_amdgcn_mfma_f32_32x32x16_bf16(pa0, PK(l4, h4), o[1], 0, 0, 0);
  const s16x4 l9 = tr_read<v_rd_off(2, 1, 0)>(vb), h9 = tr_read<v_rd_off(2, 1, 1)>(vb);
  asm volatile("s_waitcnt lgkmcnt(8)" ::: "memory"); SBAR();
  o[1] = __builtin_amdgcn_mfma_f32_32x32x16_bf16(pa1, PK(l5, h5), o[1], 0, 0, 0);
  const s16x4 l10 = tr_read<v_rd_off(2, 2, 0)>(vb), h10 = tr_read<v_rd_off(2, 2, 1)>(vb);
  asm volatile("s_waitcnt lgkmcnt(8)" ::: "memory"); SBAR();
  o[1] = __builtin_amdgcn_mfma_f32_32x32x16_bf16(pa2, PK(l6, h6), o[1], 0, 0, 0);
  const s16x4 l11 = tr_read<v_rd_off(2, 3, 0)>(vb), h11 = tr_read<v_rd_off(2, 3, 1)>(vb);
  asm volatile("s_waitcnt lgkmcnt(8)" ::: "memory"); SBAR();
  o[1] = __builtin_amdgcn_mfma_f32_32x32x16_bf16(pa3, PK(l7, h7), o[1], 0, 0, 0);
  const s16x4 l12 = tr_read<v_rd_off(3, 0, 0)>(vb), h12 = tr_read<v_rd_off(3, 0, 1)>(vb);
  asm volatile("s_waitcnt lgkmcnt(8)" ::: "memory"); SBAR();
  o[2] = __builtin_amdgcn_mfma_f32_32x32x16_bf16(pa0, PK(l8, h8), o[2], 0, 0, 0);
  const s16x4 l13 = tr_read<v_rd_off(3, 1, 0)>(vb), h13 = tr_read<v_rd_off(3, 1, 1)>(vb);
  asm volatile("s_waitcnt lgkmcnt(8)" ::: "memory"); SBAR();
  o[2] = __builtin_amdgcn_mfma_f32_32x32x16_bf16(pa1, PK(l9, h9), o[2], 0, 0, 0);
  const s16x4 l14 = tr_read<v_rd_off(3, 2, 0)>(vb), h14 = tr_read<v_rd_off(3, 2, 1)>(vb);
  asm volatile("s_waitcnt lgkmcnt(8)" ::: "memory"); SBAR();
  o[2] = __builtin_amdgcn_mfma_f32_32x32x16_bf16(pa2, PK(l10, h10), o[2], 0, 0, 0);
  const s16x4 l15 = tr_read<v_rd_off(3, 3, 0)>(vb), h15 = tr_read<v_rd_off(3, 3, 1)>(vb);
  asm volatile("s_waitcnt lgkmcnt(8)" ::: "memory"); SBAR();
  o[2] = __builtin_amdgcn_mfma_f32_32x32x16_bf16(pa3, PK(l11, h11), o[2], 0, 0, 0);
  asm volatile("s_waitcnt lgkmcnt(6)" ::: "memory"); SBAR();
  o[3] = __builtin_amdgcn_mfma_f32_32x32x16_bf16(pa0, PK(l12, h12), o[3], 0, 0, 0);
  asm volatile("s_waitcnt lgkmcnt(4)" ::: "memory"); SBAR();
  o[3] = __builtin_amdgcn_mfma_f32_32x32x16_bf16(pa1, PK(l13, h13), o[3], 0, 0, 0);
  asm volatile("s_waitcnt lgkmcnt(2)" ::: "memory"); SBAR();
  o[3] = __builtin_amdgcn_mfma_f32_32x32x16_bf16(pa2, PK(l14, h14), o[3], 0, 0, 0);
  asm volatile("s_waitcnt lgkmcnt(0)" ::: "memory"); SBAR();
  o[3] = __builtin_amdgcn_mfma_f32_32x32x16_bf16(pa3, PK(l15, h15), o[3], 0, 0, 0);
#undef PK
}

__device__ __forceinline__ void qkt12_roll(f32x16& p0, f32x16& p1, const f32x16& negm, int kb, int qa, const bf16x8* qr) {
  const int a0 = kb ^ (0 << 5); const bf16x8 x0 = lds_rd128<0>(a0), y0 = lds_rd128<12288>(a0);
  const int a1 = kb ^ (1 << 5); const bf16x8 x1 = lds_rd128<0>(a1), y1 = lds_rd128<12288>(a1);
  asm volatile("s_waitcnt lgkmcnt(2)" ::: "memory"); SBAR();
  p0 = __builtin_amdgcn_mfma_f32_32x32x16_bf16(x0, qr[0], negm, 0, 0, 0); p1 = __builtin_amdgcn_mfma_f32_32x32x16_bf16(y0, qr[0], negm, 0, 0, 0);
  const int a2 = kb ^ (2 << 5); const bf16x8 x2 = lds_rd128<0>(a2), y2 = lds_rd128<12288>(a2);
  asm volatile("s_waitcnt lgkmcnt(2)" ::: "memory"); SBAR();
  p0 = __builtin_amdgcn_mfma_f32_32x32x16_bf16(x1, qr[1], p0, 0, 0, 0); p1 = __builtin_amdgcn_mfma_f32_32x32x16_bf16(y1, qr[1], p1, 0, 0, 0);
  const int a3 = kb ^ (3 << 5); const bf16x8 x3 = lds_rd128<0>(a3), y3 = lds_rd128<12288>(a3);
  asm volatile("s_waitcnt lgkmcnt(2)" ::: "memory"); SBAR();
  p0 = __builtin_amdgcn_mfma_f32_32x32x16_bf16(x2, qr[2], p0, 0, 0, 0); p1 = __builtin_amdgcn_mfma_f32_32x32x16_bf16(y2, qr[2], p1, 0, 0, 0);
  const int a4 = kb ^ (0 << 5); const bf16x8 x4 = lds_rd128<128>(a4), y4 = lds_rd128<12416>(a4); const bf16x8 z4 = lds_rd128<0>(qa);
  asm volatile("s_waitcnt lgkmcnt(3)" ::: "memory"); SBAR();
  p0 = __builtin_amdgcn_mfma_f32_32x32x16_bf16(x3, qr[3], p0, 0, 0, 0); p1 = __builtin_amdgcn_mfma_f32_32x32x16_bf16(y3, qr[3], p1, 0, 0, 0);
  const int a5 = kb ^ (1 << 5); const bf16x8 x5 = lds_rd128<128>(a5), y5 = lds_rd128<12416>(a5); const bf16x8 z5 = lds_rd128<1024>(qa);
  asm volatile("s_waitcnt lgkmcnt(3)" ::: "memory"); SBAR();
  p0 = __builtin_amdgcn_mfma_f32_32x32x16_bf16(x4, z4, p0, 0, 0, 0); p1 = __builtin_amdgcn_mfma_f32_32x32x16_bf16(y4, z4, p1, 0, 0, 0);
  const int a6 = kb ^ (2 << 5); const bf16x8 x6 = lds_rd128<128>(a6), y6 = lds_rd128<12416>(a6); const bf16x8 z6 = lds_rd128<2048>(qa);
  asm volatile("s_waitcnt lgkmcnt(3)" ::: "memory"); SBAR();
  p0 = __builtin_amdgcn_mfma_f32_32x32x16_bf16(x5, z5, p0, 0, 0, 0); p1 = __builtin_amdgcn_mfma_f32_32x32x16_bf16(y5, z5, p1, 0, 0, 0);
  const int a7 = kb ^ (3 << 5); const bf16x8 x7 = lds_rd128<128>(a7), y7 = lds_rd128<12416>(a7); const bf16x8 z7 = lds_rd128<3072>(qa);
  asm volatile("s_waitcnt lgkmcnt(3)" ::: "memory"); SBAR();
  p0 = __builtin_amdgcn_mfma_f32_32x32x16_bf16(x6, z6, p0, 0, 0, 0); p1 = __builtin_amdgcn_mfma_f32_32x32x16_bf16(y6, z6, p1, 0, 0, 0);
  const int a8 = kb ^ (0 << 5); const bf16x8 x8 = lds_rd128<256>(a8), y8 = lds_rd128<12544>(a8); const bf16x8 z8 = lds_rd128<4096>(qa);
  asm volatile("s_waitcnt lgkmcnt(3)" ::: "memory"); SBAR();
  p0 = __builtin_amdgcn_mfma_f32_32x32x16_bf16(x7, z7, p0, 0, 0, 0); p1 = __builtin_amdgcn_mfma_f32_32x32x16_bf16(y7, z7, p1, 0, 0, 0);
  const int a9 = kb ^ (1 << 5); const bf16x8 x9 = lds_rd128<256>(a9), y9 = lds_rd128<12544>(a9); const bf16x8 z9 = lds_rd128<5120>(qa);
  asm volatile("s_waitcnt lgkmcnt(3)" ::: "memory"); SBAR();
  p0 = __builtin_amdgcn_mfma_f32_32x32x16_bf16(x8, z8, p0, 0, 0, 0); p1 = __builtin_amdgcn_mfma_f32_32x32x16_bf16(y8, z8, p1, 0, 0, 0);
  const int a10 = kb ^ (2 << 5); const bf16x8 x10 = lds_rd128<256>(a10), y10 = lds_rd128<12544>(a10); const bf16x8 z10 = lds_rd128<6144>(qa);
  asm volatile("s_waitcnt lgkmcnt(3)" ::: "memory"); SBAR();
  p0 = __builtin_amdgcn_mfma_f32_32x32x16_bf16(x9, z9, p0, 0, 0, 0); p1 = __builtin_amdgcn_mfma_f32_32x32x16_bf16(y9, z9, p1, 0, 0, 0);
  const int a11 = kb ^ (3 << 5); const bf16x8 x11 = lds_rd128<256>(a11), y11 = lds_rd128<12544>(a11); const bf16x8 z11 = lds_rd128<7168>(qa);
  asm volatile("s_waitcnt lgkmcnt(3)" ::: "memory"); SBAR();
  p0 = __builtin_amdgcn_mfma_f32_32x32x16_bf16(x10, z10, p0, 0, 0, 0); p1 = __builtin_amdgcn_mfma_f32_32x32x16_bf16(y10, z10, p1, 0, 0, 0);
  asm volatile("s_waitcnt lgkmcnt(0)" ::: "memory"); SBAR();
  p0 = __builtin_amdgcn_mfma_f32_32x32x16_bf16(x11, z11, p0, 0, 0, 0); p1 = __builtin_amdgcn_mfma_f32_32x32x16_bf16(y11, z11, p1, 0, 0, 0);
  SBAR();
}
__device__ __forceinline__ void qkt8_fsm(f32x16& p0, f32x16& p1, const f32x16& negm, int kb, const bf16x8* qr, f32x16& q0p, f32x16& q1p, float alpha, float& l_reg, bf16x8& pa0, bf16x8& pa1, bf16x8& pa2, bf16x8& pa3) {
  float sm[4];
  const int a0 = kb ^ (0 << 5); const bf16x8 x0 = lds_rd128<0>(a0), y0 = lds_rd128<8192>(a0);
  const int a1 = kb ^ (1 << 5); const bf16x8 x1 = lds_rd128<0>(a1), y1 = lds_rd128<8192>(a1);
  const int a2 = kb ^ (2 << 5); const bf16x8 x2 = lds_rd128<0>(a2), y2 = lds_rd128<8192>(a2);
  asm volatile("s_waitcnt lgkmcnt(4)" ::: "memory"); SBAR();
  p0 = __builtin_amdgcn_mfma_f32_32x32x16_bf16(x0, qr[0], negm, 0, 0, 0); p1 = __builtin_amdgcn_mfma_f32_32x32x16_bf16(y0, qr[0], negm, 0, 0, 0);
  fsm_slice<0>(q0p, q1p, alpha, l_reg, pa0, pa1, pa2, pa3, sm); SBAR();
  const int a3 = kb ^ (3 << 5); const bf16x8 x3 = lds_rd128<0>(a3), y3 = lds_rd128<8192>(a3);
  asm volatile("s_waitcnt lgkmcnt(4)" ::: "memory"); SBAR();
  p0 = __builtin_amdgcn_mfma_f32_32x32x16_bf16(x1, qr[1], p0, 0, 0, 0); p1 = __builtin_amdgcn_mfma_f32_32x32x16_bf16(y1, qr[1], p1, 0, 0, 0);
  fsm_slice<1>(q0p, q1p, alpha, l_reg, pa0, pa1, pa2, pa3, sm); SBAR();
  const int a4 = kb ^ (4 << 5); const bf16x8 x4 = lds_rd128<0>(a4), y4 = lds_rd128<8192>(a4);
  asm volatile("s_waitcnt lgkmcnt(4)" ::: "memory"); SBAR();
  p0 = __builtin_amdgcn_mfma_f32_32x32x16_bf16(x2, qr[2], p0, 0, 0, 0); p1 = __builtin_amdgcn_mfma_f32_32x32x16_bf16(y2, qr[2], p1, 0, 0, 0);
  fsm_slice<2>(q0p, q1p, alpha, l_reg, pa0, pa1, pa2, pa3, sm); SBAR();
  const int a5 = kb ^ (5 << 5); const bf16x8 x5 = lds_rd128<0>(a5), y5 = lds_rd128<8192>(a5);
  asm volatile("s_waitcnt lgkmcnt(4)" ::: "memory"); SBAR();
  p0 = __builtin_amdgcn_mfma_f32_32x32x16_bf16(x3, qr[3], p0, 0, 0, 0); p1 = __builtin_amdgcn_mfma_f32_32x32x16_bf16(y3, qr[3], p1, 0, 0, 0);
  fsm_slice<3>(q0p, q1p, alpha, l_reg, pa0, pa1, pa2, pa3, sm); SBAR();
  const int a6 = kb ^ (6 << 5); const bf16x8 x6 = lds_rd128<0>(a6), y6 = lds_rd128<8192>(a6);
  asm volatile("s_waitcnt lgkmcnt(4)" ::: "memory"); SBAR();
  p0 = __builtin_amdgcn_mfma_f32_32x32x16_bf16(x4, qr[4], p0, 0, 0, 0); p1 = __builtin_amdgcn_mfma_f32_32x32x16_bf16(y4, qr[4], p1, 0, 0, 0);
  fsm_slice<4>(q0p, q1p, alpha, l_reg, pa0, pa1, pa2, pa3, sm); SBAR();
  const int a7 = kb ^ (7 << 5); const bf16x8 x7 = lds_rd128<0>(a7), y7 = lds_rd128<8192>(a7);
  asm volatile("s_waitcnt lgkmcnt(4)" ::: "memory"); SBAR();
  p0 = __builtin_amdgcn_mfma_f32_32x32x16_bf16(x5, qr[5], p0, 0, 0, 0); p1 = __builtin_amdgcn_mfma_f32_32x32x16_bf16(y5, qr[5], p1, 0, 0, 0);
  fsm_slice<5>(q0p, q1p, alpha, l_reg, pa0, pa1, pa2, pa3, sm); SBAR();
  asm volatile("s_waitcnt lgkmcnt(2)" ::: "memory"); SBAR();
  p0 = __builtin_amdgcn_mfma_f32_32x32x16_bf16(x6, qr[6], p0, 0, 0, 0); p1 = __builtin_amdgcn_mfma_f32_32x32x16_bf16(y6, qr[6], p1, 0, 0, 0);
  fsm_slice<6>(q0p, q1p, alpha, l_reg, pa0, pa1, pa2, pa3, sm); SBAR();
  asm volatile("s_waitcnt lgkmcnt(0)" ::: "memory"); SBAR();
  p0 = __builtin_amdgcn_mfma_f32_32x32x16_bf16(x7, qr[7], p0, 0, 0, 0); p1 = __builtin_amdgcn_mfma_f32_32x32x16_bf16(y7, qr[7], p1, 0, 0, 0);
  fsm_slice<7>(q0p, q1p, alpha, l_reg, pa0, pa1, pa2, pa3, sm); SBAR();
}
__device__ __forceinline__ void pv_psm(f32x16* o, int vb, bf16x8 pa0, bf16x8 pa1, bf16x8 pa2, bf16x8 pa3, f32x16& n0, f32x16& n1, float& mC, float& alpha) {
  float mx[4];
#define PK(L, H) (bf16x8){L[0], L[1], L[2], L[3], H[0], H[1], H[2], H[3]}
  const s16x4 l0 = tr_read<v_rd_off(0, 0, 0)>(vb), h0 = tr_read<v_rd_off(0, 0, 1)>(vb);
  const s16x4 l1 = tr_read<v_rd_off(0, 1, 0)>(vb), h1 = tr_read<v_rd_off(0, 1, 1)>(vb);
  const s16x4 l2 = tr_read<v_rd_off(0, 2, 0)>(vb), h2 = tr_read<v_rd_off(0, 2, 1)>(vb);
  const s16x4 l3 = tr_read<v_rd_off(0, 3, 0)>(vb), h3 = tr_read<v_rd_off(0, 3, 1)>(vb);
  asm volatile("s_waitcnt lgkmcnt(6)" ::: "memory"); SBAR();
  o[0] = __builtin_amdgcn_mfma_f32_32x32x16_bf16(pa0, PK(l0, h0), o[0], 0, 0, 0);
  psm_slice<0>(n0, n1, mC, alpha, mx); SBAR();
  const s16x4 l4 = tr_read<v_rd_off(1, 0, 0)>(vb), h4 = tr_read<v_rd_off(1, 0, 1)>(vb);
  asm volatile("s_waitcnt lgkmcnt(6)" ::: "memory"); SBAR();
  o[0] = __builtin_amdgcn_mfma_f32_32x32x16_bf16(pa1, PK(l1, h1), o[0], 0, 0, 0);
  psm_slice<1>(n0, n1, mC, alpha, mx); SBAR();
  const s16x4 l5 = tr_read<v_rd_off(1, 1, 0)>(vb), h5 = tr_read<v_rd_off(1, 1, 1)>(vb);
  asm volatile("s_waitcnt lgkmcnt(6)" ::: "memory"); SBAR();
  o[0] = __builtin_amdgcn_mfma_f32_32x32x16_bf16(pa2, PK(l2, h2), o[0], 0, 0, 0);
  psm_slice<2>(n0, n1, mC, alpha, mx); SBAR();
  const s16x4 l6 = tr_read<v_rd_off(1, 2, 0)>(vb), h6 = tr_read<v_rd_off(1, 2, 1)>(vb);
  asm volatile("s_waitcnt lgkmcnt(6)" ::: "memory"); SBAR();
  o[0] = __builtin_amdgcn_mfma_f32_32x32x16_bf16(pa3, PK(l3, h3), o[0], 0, 0, 0);
  psm_slice<3>(n0, n1, mC, alpha, mx); SBAR();
  const s16x4 l7 = tr_read<v_rd_off(1, 3, 0)>(vb), h7 = tr_read<v_rd_off(1, 3, 1)>(vb);
  asm volatile("s_waitcnt lgkmcnt(6)" ::: "memory"); SBAR();
  o[1] = __builtin_amdgcn_mfma_f32_32x32x16_bf16(pa0, PK(l4, h4), o[1], 0, 0, 0);
  psm_slice<4>(n0, n1, mC, alpha, mx); SBAR();
  const s16x4 l8 = tr_read<v_rd_off(2, 0, 0)>(vb), h8 = tr_read<v_rd_off(2, 0, 1)>(vb);
  asm volatile("s_waitcnt lgkmcnt(6)" ::: "memory"); SBAR();
  o[1] = __builtin_amdgcn_mfma_f32_32x32x16_bf16(pa1, PK(l5, h5), o[1], 0, 0, 0);
  psm_slice<5>(n0, n1, mC, alpha, mx); SBAR();
  const s16x4 l9 = tr_read<v_rd_off(2, 1, 0)>(vb), h9 = tr_read<v_rd_off(2, 1, 1)>(vb);
  asm volatile("s_waitcnt lgkmcnt(6)" ::: "memory"); SBAR();
  o[1] = __builtin_amdgcn_mfma_f32_32x32x16_bf16(pa2, PK(l6, h6), o[1], 0, 0, 0);
  psm_slice<6>(n0, n1, mC, alpha, mx); SBAR();
  const s16x4 l10 = tr_read<v_rd_off(2, 2, 0)>(vb), h10 = tr_read<v_rd_off(2, 2, 1)>(vb);
  asm volatile("s_waitcnt lgkmcnt(6)" ::: "memory"); SBAR();
  o[1] = __builtin_amdgcn_mfma_f32_32x32x16_bf16(pa3, PK(l7, h7), o[1], 0, 0, 0);
  psm_slice<7>(n0, n1, mC, alpha, mx); SBAR();
  const s16x4 l11 = tr_read<v_rd_off(2, 3, 0)>(vb), h11 = tr_read<v_rd_off(2, 3, 1)>(vb);
  asm volatile("s_waitcnt lgkmcnt(6)" ::: "memory"); SBAR();
  o[2] = __builtin_amdgcn_mfma_f32_32x32x16_bf16(pa0, PK(l8, h8), o[2], 0, 0, 0);
  psm_slice<8>(n0, n1, mC, alpha, mx); SBAR();
  const s16x4 l12 = tr_read<v_rd_off(3, 0, 0)>(vb), h12 = tr_read<v_rd_off(3, 0, 1)>(vb);
  asm volatile("s_waitcnt lgkmcnt(6)" ::: "memory"); SBAR();
  o[2] = __builtin_amdgcn_mfma_f32_32x32x16_bf16(pa1, PK(l9, h9), o[2], 0, 0, 0);
  psm_slice<9>(n0, n1, mC, alpha, mx); SBAR();
  const s16x4 l13 = tr_read<v_rd_off(3, 1, 0)>(vb), h13 = tr_read<v_rd_off(3, 1, 1)>(vb);
  asm volatile("s_waitcnt lgkmcnt(6)" ::: "memory"); SBAR();
  o[2] = __builtin_amdgcn_mfma_f32_32x32x16_bf16(pa2, PK(l10, h10), o[2], 0, 0, 0);
  psm_slice<10>(n0, n1, mC, alpha, mx); SBAR();
  const s16x4 l14 = tr_read<v_rd_off(3, 2, 0)>(vb), h14 = tr_read<v_rd_off(3, 2, 1)>(vb);
  asm volatile("s_waitcnt lgkmcnt(6)" ::: "memory"); SBAR();
  o[2] = __builtin_amdgcn_mfma_f32_32x32x16_bf16(pa3, PK(l11, h11), o[2], 0, 0, 0);
  psm_slice<11>(n0, n1, mC, alpha, mx); SBAR();
  const s16x4 l15 = tr_read<v_rd_off(3, 3, 0)>(vb), h15 = tr_read<v_rd_off(3, 3, 1)>(vb);
  asm volatile("s_waitcnt lgkmcnt(6)" ::: "memory"); SBAR();
  o[3] = __builtin_amdgcn_mfma_f32_32x32x16_bf16(pa0, PK(l12, h12), o[3], 0, 0, 0);
  psm_slice<12>(n0, n1, mC, alpha, mx); SBAR();
  asm volatile("s_waitcnt lgkmcnt(4)" ::: "memory"); SBAR();
  o[3] = __builtin_amdgcn_mfma_f32_32x32x16_bf16(pa1, PK(l13, h13), o[3], 0, 0, 0);
  psm_slice<13>(n0, n1, mC, alpha, mx); SBAR();
  asm volatile("s_waitcnt lgkmcnt(2)" ::: "memory"); SBAR();
  o[3] = __builtin_amdgcn_mfma_f32_32x32x16_bf16(pa2, PK(l14, h14), o[3], 0, 0, 0);
  psm_slice<14>(n0, n1, mC, alpha, mx); SBAR();
  asm volatile("s_waitcnt lgkmcnt(0)" ::: "memory"); SBAR();
  o[3] = __builtin_amdgcn_mfma_f32_32x32x16_bf16(pa3, PK(l15, h15), o[3], 0, 0, 0);
  psm_slice<15>(n0, n1, mC, alpha, mx); SBAR();
#undef PK
}
constexpr int LDS_K_OFF = 2 * SHM_V, LDS_WS_OFF = LDS_K_OFF + 2 * 12 * 2048, LDS_TBL_OFF = LDS_WS_OFF + NW * 64 * 4, LDS_Q_OFF = LDS_TBL_OFF + ((TBLN * 4 + 15) / 16) * 16;
static_assert(LDS_Q_OFF + NW * 8192 <= 163840, "attention LDS map");

template <int NDQ, int BIAS, int EPI, int SDEPTH, int NQL = 0, int ROPEQ = 0, int ORD = 0>
__device__ __forceinline__ void attn_unit(const bf16_t* __restrict__ Qb, int ldq, const bf16_t* __restrict__ Kh, int ldk, const bf16_t* __restrict__ K2, int ldk2,
                                          const bf16_t* __restrict__ Vh, int ldv, int kbeg, int nkeys, int q0, const float* __restrict__ tblg, float cb_lo, float cb_hi,
                                          bf16_t* __restrict__ Obf, int ldo, float* __restrict__ tmp, float lam, const float* __restrict__ subln, float post, char* lds, const int wave0, const float* __restrict__ cosp = nullptr, const float* __restrict__ sinp = nullptr) {
  constexpr int ROWB = NDQ * 32, SHM_K = 64 * ROWB;
  int tid_ = wave0 * 64 + lane_id_v();
  const int tid = tid_, wid = tid >> 6, lane = tid & 63, r32 = lane & 31, hi = lane >> 5;
  char* V_lds = lds; char* K_lds = lds + LDS_K_OFF;
  float* ws = (float*)(lds + LDS_WS_OFF) + wid * 64; float* li_l = ws; float* al_l = ws + 32;
  float* tbl_l = (float*)(lds + LDS_TBL_OFF);
  __syncthreads();
  if constexpr (BIAS) { for (int i = tid; i < TBLN; i += 512) tbl_l[i] = tblg[i]; }
  float mC = 0.f, l_reg = 0, nm_cur = 0.f; f32x16 o[4] = {}; f32x16 negm = {}; bf16x8 qr[NDQ - NQL];
  const bf16_t* Qw = Qb + (long)(wid * QBLK + r32) * ldq + hi * 8;
  char* qls = lds + LDS_Q_OFF + wid * 8192 + lane * 16;
#pragma unroll
  for (int d0 = 0; d0 < NDQ - NQL; ++d0) qr[d0] = *reinterpret_cast<const bf16x8*>(Qw + d0 * 16);
  if constexpr (ROPEQ) {
    static_assert(NDQ == 12 && NQL >= 4, "ROPEQ: MLA layout");
#pragma unroll
    for (int d0 = NDQ - NQL; d0 < 8; ++d0) *reinterpret_cast<bf16x8*>(qls + (d0 - (NDQ - NQL)) * 1024) = *reinterpret_cast<const bf16x8*>(Qw + d0 * 16);
    const int qrow = q0 + wid * QBLK + r32;
#pragma unroll
    for (int pr = 0; pr < 2; ++pr) {
      const bf16x8 xa = *reinterpret_cast<const bf16x8*>(Qw + (8 + pr) * 16), xb = *reinterpret_cast<const bf16x8*>(Qw + (10 + pr) * 16);
      const float* cp = cosp + (size_t)qrow * 32 + pr * 16 + hi * 8; const float* sp = sinp + (size_t)qrow * 32 + pr * 16 + hi * 8;
      const f32x4 c0 = *(const f32x4*)cp, c1 = *(const f32x4*)(cp + 4), s0 = *(const f32x4*)sp, s1 = *(const f32x4*)(sp + 4);
      float ya[8], yb[8];
#pragma unroll
      for (int t = 0; t < 8; ++t) { const float x1 = bf2f((unsigned short)xa[t]), x2 = bf2f((unsigned short)xb[t]); const float c = t < 4 ? c0[t & 3] : c1[t & 3], sn = t < 4 ? s0[t & 3] : s1[t & 3];
        ya[t] = x1 * c - x2 * sn; yb[t] = x2 * c + x1 * sn; }
      u32x4 wa = {pk2(ya[0], ya[1]), pk2(ya[2], ya[3]), pk2(ya[4], ya[5]), pk2(ya[6], ya[7])}, wb = {pk2(yb[0], yb[1]), pk2(yb[2], yb[3]), pk2(yb[4], yb[5]), pk2(yb[6], yb[7])};
      *reinterpret_cast<u32x4*>(qls + (8 + pr - (NDQ - NQL)) * 1024) = wa; *reinterpret_cast<u32x4*>(qls + (10 + pr - (NDQ - NQL)) * 1024) = wb; }
  } else {
#pragma unroll
  for (int d0 = NDQ - NQL; d0 < NDQ; ++d0) *reinterpret_cast<bf16x8*>(qls + (d0 - (NDQ - NQL)) * 1024) = *reinterpret_cast<const bf16x8*>(Qw + d0 * 16);
  }
  const int sr = tid >> 4, sc = (tid & 15) * 8, vst0 = v_st(sr, sc), vst1 = v_st(32 + sr, sc);
  const int sr8 = tid >> 3, sc8 = (tid & 7) * 8;
  const int vb0 = (int)(uintptr_t)V_lds + v_rd_base(lane);
  const int qlane = q0 + wid * QBLK + r32;
  struct { bf16x8 vs0, vs1, ks0, ks1, ks2; } sr_[SDEPTH];
  constexpr int SWM = (NDQ == 8) ? 15 : 7;
#define KSWZ(row, colB) ((row) * ROWB + ((colB) ^ (((row) & SWM) << 4)))
#define SLOAD(i, k0) do { sr_[i].vs0 = *reinterpret_cast<const bf16x8*>(&Vh[(long)((k0) + sr) * ldv + sc]); sr_[i].vs1 = *reinterpret_cast<const bf16x8*>(&Vh[(long)((k0) + 32 + sr) * ldv + sc]); \
    if constexpr (NDQ == 4) { sr_[i].ks0 = *reinterpret_cast<const bf16x8*>(&Kh[(long)((k0) + sr8) * ldk + sc8]); } \
    else { sr_[i].ks0 = *reinterpret_cast<const bf16x8*>(&Kh[(long)((k0) + sr) * ldk + sc]); sr_[i].ks1 = *reinterpret_cast<const bf16x8*>(&Kh[(long)((k0) + 32 + sr) * ldk + sc]); \
      if constexpr (NDQ == 12) { sr_[i].ks2 = *reinterpret_cast<const bf16x8*>(&K2[(long)((k0) + sr8) * ldk2 + sc8]); } } } while (0)
#define SWRITE(b, i) do { *(bf16x8*)(V_lds + (b) * SHM_V + vst0) = sr_[i].vs0; *(bf16x8*)(V_lds + (b) * SHM_V + vst1) = sr_[i].vs1; \
    if constexpr (NDQ == 4) { *(bf16x8*)(K_lds + (b) * SHM_K + KSWZ(sr8, sc8 * 2)) = sr_[i].ks0; } \
    else { *(bf16x8*)(K_lds + (b) * SHM_K + KSWZ(sr, sc * 2)) = sr_[i].ks0; *(bf16x8*)(K_lds + (b) * SHM_K + KSWZ(32 + sr, sc * 2)) = sr_[i].ks1; \
      if constexpr (NDQ == 12) { *(bf16x8*)(K_lds + (b) * SHM_K + KSWZ(sr8, 256 + sc8 * 2)) = sr_[i].ks2; } } } while (0)
#define SWAIT() do { if constexpr (SDEPTH == 2) { if constexpr (NDQ == 4) asm volatile("s_waitcnt vmcnt(3)" ::: "memory"); else if constexpr (NDQ == 8) asm volatile("s_waitcnt vmcnt(4)" ::: "memory"); else asm volatile("s_waitcnt vmcnt(5)" ::: "memory"); } \
    else asm volatile("s_waitcnt vmcnt(0)" ::: "memory"); } while (0)
#define RESC(a) do { if (__any((a) < 1.f)) { if (hi == 0) al_l[r32] = (a); asm volatile("s_waitcnt lgkmcnt(0)" ::: "memory"); \
    _Pragma("unroll") for (int d = 0; d < 4; ++d) _Pragma("unroll") for (int r = 0; r < 16; ++r) o[d][r] *= al_l[crow(r, hi)]; } } while (0)
#define BIASADD(P0, P1, kt0) do { if constexpr (BIAS) { const int dlo_ = (kt0) - q0 - 255, dhi_ = (kt0) + 63 - q0; \
    if (!(dlo_ >= 1024) && !(dhi_ <= -1024)) { const float* tb_ = tbl_l + ((kt0) - qlane + TOFF + 4 * hi); \
      _Pragma("unroll") for (int r = 0; r < 16; ++r) { P0[r] += tb_[(r & 3) + 8 * (r >> 2)]; P1[r] += tb_[32 + (r & 3) + 8 * (r >> 2)]; } } } } while (0)
#define NEGM_UPD(kt0) do { float nmj_ = -mC; if constexpr (BIAS) { const int dlo_ = (kt0) - q0 - 255, dhi_ = (kt0) + 63 - q0; if (dlo_ >= 1024) nmj_ += cb_hi; else if (dhi_ <= -1024) nmj_ += cb_lo; } \
    if (__any(nmj_ != nm_cur)) { nm_cur = nmj_; _Pragma("unroll") for (int r = 0; r < 16; ++r) negm[r] = nmj_; } } while (0)
  f32x16 pA0, pA1, pB0, pB1; float alA, alB; bf16x8 pa0, pa1, pa2, pa3; const int NT = nkeys / KVBLK;
  const int kb0 = (int)(uintptr_t)K_lds + r32 * ROWB + (((r32 & SWM) << 4) ^ (hi << 4));
  const int qa0 = (int)(uintptr_t)qls;
#define QKT(P0, P1, KOFF) do { if constexpr (NDQ == 8 && NQL == 0) qkt8_roll(P0, P1, negm, kb0 + (KOFF), qr); \
    else if constexpr (NDQ == 12 && NQL == 8) qkt12_roll(P0, P1, negm, kb0 + (KOFF), qa0, qr); else qkt<NDQ, NQL>(P0, P1, negm, K_lds + (KOFF), qr, qls, r32, hi); } while (0)
  constexpr int SE = 0, SO = SDEPTH - 1;
  SLOAD(SE, kbeg); asm volatile("s_waitcnt vmcnt(0)" ::: "memory"); SWRITE(0, SE); __syncthreads();
  constexpr bool SLICED = (NDQ == 8 && NQL == 0);
  NEGM_UPD(kbeg); QKT(pA0, pA1, 0); BIASADD(pA0, pA1, kbeg); partialSM<true>(pA0, pA1, mC, alA);
  if constexpr (SLICED) {
#pragma unroll
    for (int r = 0; r < 16; ++r) pA1[r] = __builtin_amdgcn_exp2f(pA1[r]); }
  SLOAD(SO, kbeg + KVBLK); if constexpr (SDEPTH == 2) { if (2 < NT) SLOAD(SE, kbeg + 2 * KVBLK); }
  SWAIT(); SWRITE(1, SO); __syncthreads();
  if constexpr (NDQ == 8 && NQL == 0) {
  for (int j = 1; j + 1 < NT; j += 2) {
    if constexpr (ORD == 0) {
    NEGM_UPD(kbeg + j * KVBLK); SBAR();
    qkt8_fsm(pB0, pB1, negm, kb0 + SHM_K, qr, pA0, pA1, alA, l_reg, pa0, pa1, pa2, pa3);
    SLOAD(SO, kbeg + (j + SDEPTH) * KVBLK); SBAR();
    BIASADD(pB0, pB1, kbeg + j * KVBLK); SBAR();
    pv_psm(o, vb0, pa0, pa1, pa2, pa3, pB0, pB1, mC, alB);
    } else {
    finishSM<false>(pA0, pA1, alA, l_reg, pa0, pa1, pa2, pa3); SBAR();
    NEGM_UPD(kbeg + j * KVBLK); SBAR(); qkt8_roll(pB0, pB1, negm, kb0 + SHM_K, qr); SBAR();
    SLOAD(SO, kbeg + (j + SDEPTH) * KVBLK); SBAR();
    BIASADD(pB0, pB1, kbeg + j * KVBLK); partialSM<false>(pB0, pB1, mC, alB);
    _Pragma("unroll") for (int r = 0; r < 16; ++r) pB1[r] = __builtin_amdgcn_exp2f(pB1[r]);
    SBAR(); pv_d0(o, vb0, pa0, pa1, pa2, pa3);
    }
    __syncthreads(); SWAIT(); SWRITE(0, SE);
    RESC(alB); __syncthreads();
    if constexpr (ORD == 0) {
    NEGM_UPD(kbeg + (j + 1) * KVBLK); SBAR();
    qkt8_fsm(pA0, pA1, negm, kb0, qr, pB0, pB1, alB, l_reg, pa0, pa1, pa2, pa3);
    if (SDEPTH == 1 || j + 3 < NT) SLOAD(SE, kbeg + (j + 1 + SDEPTH) * KVBLK); SBAR();
    BIASADD(pA0, pA1, kbeg + (j + 1) * KVBLK); SBAR();
    pv_psm(o, vb0 + (int)SHM_V, pa0, pa1, pa2, pa3, pA0, pA1, mC, alA);
    } else {
    finishSM<false>(pB0, pB1, alB, l_reg, pa0, pa1, pa2, pa3); SBAR();
    NEGM_UPD(kbeg + (j + 1) * KVBLK); SBAR(); qkt8_roll(pA0, pA1, negm, kb0, qr); SBAR();
    if (SDEPTH == 1 || j + 3 < NT) SLOAD(SE, kbeg + (j + 1 + SDEPTH) * KVBLK); SBAR();
    BIASADD(pA0, pA1, kbeg + (j + 1) * KVBLK); partialSM<false>(pA0, pA1, mC, alA);
    _Pragma("unroll") for (int r = 0; r < 16; ++r) pA1[r] = __builtin_amdgcn_exp2f(pA1[r]);
    SBAR(); pv_d0(o, vb0 + (int)SHM_V, pa0, pa1, pa2, pa3);
    }
    __syncthreads(); SWAIT(); SWRITE(1, SO);
    RESC(alA); __syncthreads();
  }
  } else {
  for (int j = 1; j + 1 < NT; j += 2) {
    if constexpr (ORD == 0) {
    NEGM_UPD(kbeg + j * KVBLK); SBAR(); QKT(pB0, pB1, SHM_K);
    finishSM(pA0, pA1, alA, l_reg, pa0, pa1, pa2, pa3); SBAR();
    SLOAD(SO, kbeg + (j + SDEPTH) * KVBLK); SBAR();
    pv_d0(o, vb0, pa0, pa1, pa2, pa3); BIASADD(pB0, pB1, kbeg + j * KVBLK); partialSM<false>(pB0, pB1, mC, alB);
    } else {
    finishSM(pA0, pA1, alA, l_reg, pa0, pa1, pa2, pa3); SBAR();
    NEGM_UPD(kbeg + j * KVBLK); SBAR(); QKT(pB0, pB1, SHM_K); SBAR();
    BIASADD(pB0, pB1, kbeg + j * KVBLK); partialSM<false>(pB0, pB1, mC, alB); SBAR();
    SLOAD(SO, kbeg + (j + SDEPTH) * KVBLK); SBAR();
    pv_d0(o, vb0, pa0, pa1, pa2, pa3);
    }
    __syncthreads(); SWAIT(); SWRITE(0, SE);
    RESC(alB); __syncthreads();
    if constexpr (ORD == 0) {
    NEGM_UPD(kbeg + (j + 1) * KVBLK); SBAR(); QKT(pA0, pA1, 0);
    finishSM(pB0, pB1, alB, l_reg, pa0, pa1, pa2, pa3); SBAR();
    if (SDEPTH == 1 || j + 3 < NT) SLOAD(SE, kbeg + (j + 1 + SDEPTH) * KVBLK); SBAR();
    pv_d0(o, vb0 + (int)SHM_V, pa0, pa1, pa2, pa3); BIASADD(pA0, pA1, kbeg + (j + 1) * KVBLK); partialSM<false>(pA0, pA1, mC, alA);
    } else {
    finishSM(pB0, pB1, alB, l_reg, pa0, pa1, pa2, pa3); SBAR();
    NEGM_UPD(kbeg + (j + 1) * KVBLK); SBAR(); QKT(pA0, pA1, 0); SBAR();
    BIASADD(pA0, pA1, kbeg + (j + 1) * KVBLK); partialSM<false>(pA0, pA1, mC, alA); SBAR();
    if (SDEPTH == 1 || j + 3 < NT) SLOAD(SE, kbeg + (j + 1 + SDEPTH) * KVBLK); SBAR();
    pv_d0(o, vb0 + (int)SHM_V, pa0, pa1, pa2, pa3);
    }
    __syncthreads(); SWAIT(); SWRITE(1, SO);
    RESC(alA); __syncthreads();
  }
  }
  NEGM_UPD(kbeg + (NT - 1) * KVBLK); SBAR(); QKT(pB0, pB1, SHM_K);
  finishSM<!SLICED>(pA0, pA1, alA, l_reg, pa0, pa1, pa2, pa3); SBAR();
  pv_d0(o, vb0, pa0, pa1, pa2, pa3); BIASADD(pB0, pB1, kbeg + (NT - 1) * KVBLK); partialSM<false>(pB0, pB1, mC, alB);
  __syncthreads(); RESC(alB);
  finishSM(pB0, pB1, alB, l_reg, pa0, pa1, pa2, pa3); SBAR();
  pv_d0(o, vb0 + (int)SHM_V, pa0, pa1, pa2, pa3);
  if (hi == 0) li_l[r32] = l_reg; asm volatile("s_waitcnt lgkmcnt(0)" ::: "memory");
  float rli[16];
#pragma unroll
  for (int r = 0; r < 16; ++r) rli[r] = __builtin_amdgcn_rcpf(li_l[crow(r, hi)]);
  if constexpr (EPI == 0) {
    bf16_t* Ow = Obf + (long)(wid * QBLK) * ldo;
#pragma unroll
    for (int r = 0; r < 16; ++r) { const int orow = crow(r, hi);
#pragma unroll
      for (int d0 = 0; d0 < 4; ++d0) Ow[(long)orow * ldo + d0 * 32 + r32] = (bf16_t)f2bf(o[d0][r] * rli[r]); }
  } else if constexpr (EPI == 1) {
    float* Tw = tmp + (wid * QBLK) * 128;
#pragma unroll
    for (int r = 0; r < 16; ++r) { const int orow = crow(r, hi);
#pragma unroll
      for (int d0 = 0; d0 < 4; ++d0) Tw[orow * 128 + d0 * 32 + r32] = o[d0][r] * rli[r]; }
  } else {
    const float* Tw = tmp + (wid * QBLK) * 128; bf16_t* Ow = Obf + (long)(wid * QBLK) * ldo;
    float sg[4];
#pragma unroll
    for (int d0 = 0; d0 < 4; ++d0) sg[d0] = subln[d0 * 32 + r32] * post;
#pragma unroll
    for (int r = 0; r < 16; ++r) { const int orow = crow(r, hi); float v[4]; float ss = 0.f;
#pragma unroll
      for (int d0 = 0; d0 < 4; ++d0) { v[d0] = Tw[orow * 128 + d0 * 32 + r32] - lam * (o[d0][r] * rli[r]); ss += v[d0] * v[d0]; }
      ss += swz_xor<1>(ss); ss += swz_xor<2>(ss); ss += swz_xor<4>(ss); ss += swz_xor<8>(ss); ss += swz_xor<16>(ss);
      const float rs = rsqrtf(ss * (1.0f / 128.0f) + EPS);
#pragma unroll
      for (int d0 = 0; d0 < 4; ++d0) Ow[(long)orow * ldo + d0 * 32 + r32] = (bf16_t)f2bf(v[d0] * rs * sg[d0]); }
  }
#undef KSWZ
#undef SLOAD
#undef SWRITE
#undef SWAIT
#undef RESC
#undef BIASADD
#undef NEGM_UPD
#undef QKT
}

template <int M>
__device__ __forceinline__ void qkt_map(f32x16& p0, f32x16& p1, const char* Ks, const char* qls, int r32, int hi) {
  p0 = f32x16{}; p1 = f32x16{};
#pragma unroll
  for (int d0 = 0; d0 < 4; ++d0) { const int cb = (M * 64 + d0 * 16 + hi * 8) * 2;
    bf16x8 b0 = *reinterpret_cast<const bf16x8*>(Ks + r32 * 256 + (cb ^ ((r32 & 15) << 4)));
    bf16x8 b1 = *reinterpret_cast<const bf16x8*>(Ks + (32 + r32) * 256 + (cb ^ ((r32 & 15) << 4)));
    bf16x8 q = *reinterpret_cast<const bf16x8*>(qls + (M * 4 + d0) * 1024);
    p0 = __builtin_amdgcn_mfma_f32_32x32x16_bf16(b0, q, p0, 0, 0, 0);
    p1 = __builtin_amdgcn_mfma_f32_32x32x16_bf16(b1, q, p1, 0, 0, 0);
    if (d0 == 1) SBAR(); }
}
template <int M>
__device__ __forceinline__ void qkt_map_roll(f32x16& p0, f32x16& p1, int kb, int qa) {
  p0 = f32x16{}; p1 = f32x16{};
  const int a0 = kb ^ ((M << 7) | (0 << 5)); const bf16x8 x0 = lds_rd128<0>(a0), y0 = lds_rd128<8192>(a0); const bf16x8 z0 = (M == 0) ? lds_rd128<0>(qa) : lds_rd128<4096>(qa);
  const int a1 = kb ^ ((M << 7) | (1 << 5)); const bf16x8 x1 = lds_rd128<0>(a1), y1 = lds_rd128<8192>(a1); const bf16x8 z1 = (M == 0) ? lds_rd128<1024>(qa) : lds_rd128<5120>(qa);
  asm volatile("s_waitcnt lgkmcnt(3)" ::: "memory"); SBAR();
  p0 = __builtin_amdgcn_mfma_f32_32x32x16_bf16(x0, z0, p0, 0, 0, 0); p1 = __builtin_amdgcn_mfma_f32_32x32x16_bf16(y0, z0, p1, 0, 0, 0);
  const int a2 = kb ^ ((M << 7) | (2 << 5)); const bf16x8 x2 = lds_rd128<0>(a2), y2 = lds_rd128<8192>(a2); const bf16x8 z2 = (M == 0) ? lds_rd128<2048>(qa) : lds_rd128<6144>(qa);
  asm volatile("s_waitcnt lgkmcnt(3)" ::: "memory"); SBAR();
  p0 = __builtin_amdgcn_mfma_f32_32x32x16_bf16(x1, z1, p0, 0, 0, 0); p1 = __builtin_amdgcn_mfma_f32_32x32x16_bf16(y1, z1, p1, 0, 0, 0);
  const int a3 = kb ^ ((M << 7) | (3 << 5)); const bf16x8 x3 = lds_rd128<0>(a3), y3 = lds_rd128<8192>(a3); const bf16x8 z3 = (M == 0) ? lds_rd128<3072>(qa) : lds_rd128<7168>(qa);
  asm volatile("s_waitcnt lgkmcnt(3)" ::: "memory"); SBAR();
  p0 = __builtin_amdgcn_mfma_f32_32x32x16_bf16(x2, z2, p0, 0, 0, 0); p1 = __builtin_amdgcn_mfma_f32_32x32x16_bf16(y2, z2, p1, 0, 0, 0);
  asm volatile("s_waitcnt lgkmcnt(0)" ::: "memory"); SBAR();
  p0 = __builtin_amdgcn_mfma_f32_32x32x16_bf16(x3, z3, p0, 0, 0, 0); p1 = __builtin_amdgcn_mfma_f32_32x32x16_bf16(y3, z3, p1, 0, 0, 0);
  SBAR();
}
__device__ __forceinline__ void softmax_tile(f32x16& p0, f32x16& p1, float& m, float& l, float& alpha, float cb, bf16x8& pa0, bf16x8& pa1, bf16x8& pa2, bf16x8& pa3) {
  float mx_[4] = {p0[0], p0[1], p0[2], p0[3]};
#pragma unroll
  for (int r = 4; r < 16; ++r) mx_[r & 3] = fmaxf(mx_[r & 3], p0[r]);
#pragma unroll
  for (int r = 0; r < 16; ++r) mx_[r & 3] = fmaxf(mx_[r & 3], p1[r]);
  float pmax = fmaxf(fmaxf(mx_[0], mx_[1]), fmaxf(mx_[2], mx_[3]));
  { auto rr = __builtin_amdgcn_permlane32_swap(__float_as_uint(pmax), __float_as_uint(pmax), false, false);
    pmax = fmaxf(__uint_as_float(rr[0]), __uint_as_float(rr[1])); }
  pmax += cb;
  float mn;
  if (__builtin_expect(__all(pmax - m <= THR2), 1)) { mn = m; alpha = 1.f; }
  else { mn = fmaxf(m, pmax); alpha = __builtin_amdgcn_exp2f(m - mn); m = mn; }
  const float off = cb - mn;
#pragma unroll
  for (int r = 0; r < 16; ++r) p0[r] = __builtin_amdgcn_exp2f(p0[r] + off);
#pragma unroll
  for (int r = 0; r < 16; ++r) p1[r] = __builtin_amdgcn_exp2f(p1[r] + off);
  float sm_[4] = {p0[0], p0[1], p0[2], p0[3]};
#pragma unroll
  for (int r = 4; r < 16; ++r) sm_[r & 3] += p0[r];
#pragma unroll
  for (int r = 0; r < 16; ++r) sm_[r & 3] += p1[r];
  float ps = (sm_[0] + sm_[1]) + (sm_[2] + sm_[3]);
  { auto rr = __builtin_amdgcn_permlane32_swap(__float_as_uint(ps), __float_as_uint(ps), false, false);
    ps = __uint_as_float(rr[0]) + __uint_as_float(rr[1]); }
  l = l * alpha + ps;
#define PK4(P, BASE, OUT) do { unsigned a0 = cvtpk(P[BASE + 0], P[BASE + 1]), a1 = cvtpk(P[BASE + 2], P[BASE + 3]);   \
    unsigned b0 = cvtpk(P[BASE + 4], P[BASE + 5]), b1 = cvtpk(P[BASE + 6], P[BASE + 7]);                              \
    auto r0 = __builtin_amdgcn_permlane32_swap(a0, b0, false, false); auto r1 = __builtin_amdgcn_permlane32_swap(a1, b1, false, false); \
    u32x4 w = {r0[0], r1[0], r0[1], r1[1]}; OUT = *reinterpret_cast<bf16x8*>(&w); } while (0)
  PK4(p0, 0, pa0); PK4(p0, 8, pa1); PK4(p1, 0, pa2); PK4(p1, 8, pa3);
#undef PK4
}
template <int D0> __device__ __forceinline__ void pv2_one(f32x16& oa, f32x16& ob, int vb, bf16x8 pa0, bf16x8 pa1, bf16x8 pa2, bf16x8 pa3, bf16x8 pb0, bf16x8 pb1, bf16x8 pb2, bf16x8 pb3) {
  const s16x4 l0 = tr_read<v_rd_off(D0, 0, 0)>(vb), h0 = tr_read<v_rd_off(D0, 0, 1)>(vb), l1 = tr_read<v_rd_off(D0, 1, 0)>(vb), h1 = tr_read<v_rd_off(D0, 1, 1)>(vb);
  const s16x4 l2 = tr_read<v_rd_off(D0, 2, 0)>(vb), h2 = tr_read<v_rd_off(D0, 2, 1)>(vb), l3 = tr_read<v_rd_off(D0, 3, 0)>(vb), h3 = tr_read<v_rd_off(D0, 3, 1)>(vb);
  asm volatile("s_waitcnt lgkmcnt(0)" ::: "memory"); SBAR();
#define PK(L, H) (bf16x8){L[0], L[1], L[2], L[3], H[0], H[1], H[2], H[3]}
  const bf16x8 v0 = PK(l0, h0), v1 = PK(l1, h1), v2 = PK(l2, h2), v3 = PK(l3, h3);
  oa = __builtin_amdgcn_mfma_f32_32x32x16_bf16(pa0, v0, oa, 0, 0, 0);
  ob = __builtin_amdgcn_mfma_f32_32x32x16_bf16(pb0, v0, ob, 0, 0, 0);
  oa = __builtin_amdgcn_mfma_f32_32x32x16_bf16(pa1, v1, oa, 0, 0, 0);
  ob = __builtin_amdgcn_mfma_f32_32x32x16_bf16(pb1, v1, ob, 0, 0, 0);
  oa = __builtin_amdgcn_mfma_f32_32x32x16_bf16(pa2, v2, oa, 0, 0, 0);
  ob = __builtin_amdgcn_mfma_f32_32x32x16_bf16(pb2, v2, ob, 0, 0, 0);
  oa = __builtin_amdgcn_mfma_f32_32x32x16_bf16(pa3, v3, oa, 0, 0, 0);
  ob = __builtin_amdgcn_mfma_f32_32x32x16_bf16(pb3, v3, ob, 0, 0, 0);
#undef PK
}
__device__ __forceinline__ void attn_unit_A2(const bf16_t* __restrict__ Qb, int ldq, const bf16_t* __restrict__ Kh, int ldk, const bf16_t* __restrict__ Vh, int ldv, int nkeys, int q0,
                                             const float* __restrict__ tblg, float cb_lo, float cb_hi, bf16_t* __restrict__ Obf, int ldo, float lam, const float* __restrict__ subln, float post, char* lds, const int wave0) {
  constexpr int ROWB = 256, SHM_K = 64 * ROWB;
  int tid_ = wave0 * 64 + lane_id_v();
  const int tid = tid_, wid = tid >> 6, lane = tid & 63, r32 = lane & 31, hi = lane >> 5;
  char* V_lds = lds; char* K_lds = lds + LDS_K_OFF;
  float* ws = (float*)(lds + LDS_WS_OFF) + wid * 64; float* sl0 = ws; float* sl1 = ws + 32;
  float* tbl_l = (float*)(lds + LDS_TBL_OFF);
  char* qls = lds + LDS_Q_OFF + wid * 8192 + lane * 16;
  __syncthreads();
  for (int i = tid; i < TBLN; i += 512) tbl_l[i] = tblg[i];
  { const bf16_t* Qw = Qb + (long)(wid * QBLK + r32) * ldq + hi * 8;
#pragma unroll
    for (int i = 0; i < 8; ++i) *reinterpret_cast<bf16x8*>(qls + i * 1024) = *reinterpret_cast<const bf16x8*>(Qw + i * 16); }
  float m0 = -1e30f, m1 = -1e30f, l0 = 0.f, l1 = 0.f; f32x16 oa[4] = {}, ob[4] = {};
  const int sr = tid >> 4, sc = (tid & 15) * 8, vst0 = v_st(sr, sc), vst1 = v_st(32 + sr, sc);
  const int vb0 = (int)(uintptr_t)V_lds + v_rd_base(lane);
  const int qlane = q0 + wid * QBLK + r32;
  bf16x8 vs0, vs1, ks0, ks1;
#define KSWZ(row, colB) ((row) * ROWB + ((colB) ^ (((row) & 15) << 4)))
#define SLOAD2(k0) do { vs0 = *reinterpret_cast<const bf16x8*>(&Vh[(long)((k0) + sr) * ldv + sc]); vs1 = *reinterpret_cast<const bf16x8*>(&Vh[(long)((k0) + 32 + sr) * ldv + sc]); \
    ks0 = *reinterpret_cast<const bf16x8*>(&Kh[(long)((k0) + sr) * ldk + sc]); ks1 = *reinterpret_cast<const bf16x8*>(&Kh[(long)((k0) + 32 + sr) * ldk + sc]); } while (0)
#define SWRITE2(b) do { *(bf16x8*)(V_lds + (b) * SHM_V + vst0) = vs0; *(bf16x8*)(V_lds + (b) * SHM_V + vst1) = vs1; \
    *(bf16x8*)(K_lds + (b) * SHM_K + KSWZ(sr, sc * 2)) = ks0; *(bf16x8*)(K_lds + (b) * SHM_K + KSWZ(32 + sr, sc * 2)) = ks1; } while (0)
#define RESC2(O, SL, a) do { if (__any((a) < 1.f)) { if (hi == 0) SL[r32] = (a); asm volatile("s_waitcnt lgkmcnt(0)" ::: "memory"); \
    _Pragma("unroll") for (int d = 0; d < 4; ++d) _Pragma("unroll") for (int r = 0; r < 16; ++r) O[d][r] *= SL[crow(r, hi)]; } } while (0)
  const int NT = nkeys / KVBLK;
  const int kbA = (int)(uintptr_t)K_lds + r32 * 256 + (((r32 & 15) << 4) ^ (hi << 4)), qaA = (int)(uintptr_t)qls;
  SLOAD2(0); asm volatile("s_waitcnt vmcnt(0)" ::: "memory"); SWRITE2(0); __syncthreads();
  for (int j = 0; j < NT; ++j) {
    const int b = j & 1, kt0 = j * KVBLK;
    const int dlo_ = kt0 - q0 - 255, dhi_ = kt0 + 63 - q0;
    float cb = 0.f; const bool nearb = !(dlo_ >= 1024) && !(dhi_ <= -1024);
    if (dlo_ >= 1024) cb = cb_hi; else if (dhi_ <= -1024) cb = cb_lo;
    const float* tb_ = tbl_l + (kt0 - qlane + TOFF + 4 * hi);
    f32x16 s0, s1; bf16x8 pa0, pa1, pa2, pa3; float al0, al1;
    const int vb = vb0 + b * (int)SHM_V;
    qkt_map_roll<0>(s0, s1, kbA + b * SHM_K, qaA);
    SBAR();
    if (nearb) {
#pragma unroll
      for (int r = 0; r < 8; ++r) { s0[r] += tb_[(r & 3) + 8 * (r >> 2)]; s1[r] += tb_[32 + (r & 3) + 8 * (r >> 2)]; }
      SBAR();
#pragma unroll
      for (int r = 8; r < 16; ++r) { s0[r] += tb_[(r & 3) + 8 * (r >> 2)]; s1[r] += tb_[32 + (r & 3) + 8 * (r >> 2)]; } }
    SBAR();
    softmax_tile(s0, s1, m0, l0, al0, cb, pa0, pa1, pa2, pa3);
    RESC2(oa, sl0, al0);
    SBAR();
    pv_d0(oa, vb, pa0, pa1, pa2, pa3);
    SBAR();
    qkt_map_roll<1>(s0, s1, kbA + b * SHM_K, qaA);
    SBAR();
    if (nearb) {
#pragma unroll
      for (int r = 0; r < 8; ++r) { s0[r] += tb_[(r & 3) + 8 * (r >> 2)]; s1[r] += tb_[32 + (r & 3) + 8 * (r >> 2)]; }
      SBAR();
#pragma unroll
      for (int r = 8; r < 16; ++r) { s0[r] += tb_[(r & 3) + 8 * (r >> 2)]; s1[r] += tb_[32 + (r & 3) + 8 * (r >> 2)]; } }
    SBAR();
    softmax_tile(s0, s1, m1, l1, al1, cb, pa0, pa1, pa2, pa3);
    RESC2(ob, sl1, al1);
    SBAR();
    if (j + 1 < NT) SLOAD2(kt0 + KVBLK);
    SBAR();
    pv_d0(ob, vb, pa0, pa1, pa2, pa3);
    if (j + 1 < NT) { asm volatile("s_waitcnt vmcnt(0)" ::: "memory"); SWRITE2(b ^ 1); }
    __syncthreads();
  }
  const int lane_e = lane_id_v(), r32e = lane_e & 31, hie = lane_e >> 5;
  if (hie == 0) { sl0[r32e] = l0; sl1[r32e] = l1; } asm volatile("s_waitcnt lgkmcnt(0)" ::: "memory");
  bf16_t* Ow = Obf + (long)(wid * QBLK) * ldo;
  float sg[4];
#pragma unroll
  for (int d0 = 0; d0 < 4; ++d0) sg[d0] = subln[d0 * 32 + r32e] * post;
#pragma unroll
  for (int r = 0; r < 16; ++r) { const int orow = crow(r, hie); const float ra = __builtin_amdgcn_rcpf(sl0[orow]), rb = lam * __builtin_amdgcn_rcpf(sl1[orow]); float v[4]; float ss = 0.f;
#pragma unroll
    for (int d0 = 0; d0 < 4; ++d0) { v[d0] = oa[d0][r] * ra - ob[d0][r] * rb; ss += v[d0] * v[d0]; }
    ss += swz_xor<1>(ss); ss += swz_xor<2>(ss); ss += swz_xor<4>(ss); ss += swz_xor<8>(ss); ss += swz_xor<16>(ss);
    const float rs = rsqrtf(ss * (1.0f / 128.0f) + EPS);
#pragma unroll
    for (int d0 = 0; d0 < 4; ++d0) Ow[(long)orow * ldo + d0 * 32 + r32e] = (bf16_t)f2bf(v[d0] * rs * sg[d0]); }
#undef KSWZ
#undef SLOAD2
#undef SWRITE2
#undef RESC2
}
}

__device__ __forceinline__ void transpose_item(const float* __restrict__ W, int K, int N, bf16_t* __restrict__ WT, int k0, int n0, int drow0, float wscale, LAS float* scr, int lane) {
    float tv[32];
#pragma unroll
    for (int i = 0; i < 32; ++i) { const int kk = 2 * i + (lane >> 5); tv[i] = W[(size_t)(k0 + kk) * N + n0 + (lane & 31)]; }
#pragma unroll
    for (int i = 0; i < 32; ++i) { const int kk = 2 * i + (lane >> 5); scr[kk * 33 + (lane & 31)] = tv[i] * wscale; }
    asm volatile("s_waitcnt lgkmcnt(0)" ::: "memory");
    const int c = lane & 7;
#pragma unroll
    for (int j = 0; j < 4; ++j) { const int n = (lane >> 3) + 8 * j; const LAS float* s = scr + (8 * c) * 33 + n;
        u32x4 o; o.x = pk2(s[0 * 33], s[1 * 33]); o.y = pk2(s[2 * 33], s[3 * 33]); o.z = pk2(s[4 * 33], s[5 * 33]); o.w = pk2(s[6 * 33], s[7 * 33]);
        *(u32x4*)(WT + (size_t)(drow0 + n) * K + k0 + 8 * c) = o; }
    asm volatile("s_waitcnt lgkmcnt(0)" ::: "memory");
}
constexpr float QS_A = 0.125f * 1.4426950408889634f, QS_B = 0.07216878364870322f * 1.4426950408889634f, QS_CD = 0.08838834764831845f * 1.4426950408889634f;
template <int MODE>
__device__ __forceinline__ void transpose_matrix(const float* __restrict__ W, int K, int N, bf16_t* __restrict__ WT, LAS float* scr, int lane, int gw, int NGW) {
    const int nblk = N / 32, nitems = (K / 64) * nblk;
    for (int it = gw; it < nitems; it += NGW) { const int kb = it / nblk, nb = it % nblk, n0 = 32 * nb; int drow0 = n0;
        if (MODE == 1) { const int c = n0 < FF ? n0 : n0 - FF; drow0 = 256 * (c / 128) + (c % 128) + (n0 < FF ? 0 : 128); }
        float wscale = 1.0f;
        if (MODE == 2) { if (n0 < C_AK) wscale = QS_A; else if (n0 >= C_DQ && n0 < C_DK) wscale = QS_CD; }
        if (MODE == 3) wscale = QS_B;
        transpose_item(W, K, N, WT, 64 * kb, n0, drow0, wscale, scr, lane); }
}
__device__ __forceinline__ int t5_bucket(int d) {
    const int ret = d > 0 ? 16 : 0; const int n = d < 0 ? -d : d;
    if (n < 8) return ret + n;
    const float v = logf((float)n / 8.0f) / 4.852030263919617f * 8.0f;
    int large = 8 + (int)v; if (large > 15) large = 15;
    return ret + large;
}
__device__ __forceinline__ void norm_row(const float* __restrict__ xrow, const float* __restrict__ g, bf16_t* __restrict__ hrow, int lane) {
    f32x4 v[8]; float ss = 0.f;
#pragma unroll
    for (int j = 0; j < 8; ++j) { v[j] = ((const f32x4*)xrow)[lane + 64 * j]; ss += (v[j].x * v[j].x + v[j].y * v[j].y) + (v[j].z * v[j].z + v[j].w * v[j].w); }
    const float rs = rsqrtf(wave_sum(ss) * (1.0f / DM) + EPS);
#pragma unroll
    for (int j = 0; j < 8; ++j) { const f32x4 gg = ((const f32x4*)g)[lane + 64 * j];
        u32x2 w; w.x = pk2(v[j].x * rs * gg.x, v[j].y * rs * gg.y); w.y = pk2(v[j].z * rs * gg.z, v[j].w * rs * gg.w); ((u32x2*)hrow)[lane + 64 * j] = w; }
}
template <int NR>
__device__ __forceinline__ void norm_add_rows(const bf16_t* __restrict__ Yb, const float* xi, float* xo, const float* __restrict__ gpost,
                                              const float* __restrict__ gpre, bf16_t* __restrict__ Hb, int row0, int rstride, int lane) {
    u32x2 yb[NR][8]; f32x4 v[NR][8];
#pragma unroll
    for (int q = 0; q < NR; ++q) { const size_t ro = (size_t)(row0 + q * rstride) * DM;
#pragma unroll
        for (int j = 0; j < 8; ++j) yb[q][j] = ((const u32x2*)(Yb + ro))[lane + 64 * j];
#pragma unroll
        for (int j = 0; j < 8; ++j) v[q][j] = ((const f32x4*)(xi + ro))[lane + 64 * j]; }
    f32x4 gp[8];
#pragma unroll
    for (int j = 0; j < 8; ++j) gp[j] = ((const f32x4*)gpost)[lane + 64 * j];
#pragma unroll
    for (int q = 0; q < NR; ++q) { const size_t ro = (size_t)(row0 + q * rstride) * DM;
        f32x4 y[8]; float ss = 0.f;
#pragma unroll
        for (int j = 0; j < 8; ++j) { y[j].x = __uint_as_float(yb[q][j].x << 16); y[j].y = __uint_as_float(yb[q][j].x & 0xffff0000u); y[j].z = __uint_as_float(yb[q][j].y << 16); y[j].w = __uint_as_float(yb[q][j].y & 0xffff0000u);
            ss += (y[j].x * y[j].x + y[j].y * y[j].y) + (y[j].z * y[j].z + y[j].w * y[j].w); }
        const float rs = rsqrtf(wave_sum(ss) * (1.0f / DM) + EPS);
        float ss2 = 0.f;
#pragma unroll
        for (int j = 0; j < 8; ++j) { v[q][j] = v[q][j] + y[j] * rs * gp[j]; ((f32x4*)(xo + ro))[lane + 64 * j] = v[q][j];
            ss2 += (v[q][j].x * v[q][j].x + v[q][j].y * v[q][j].y) + (v[q][j].z * v[q][j].z + v[q][j].w * v[q][j].w); }
        if (gpre) {
            const float rs2 = rsqrtf(wave_sum(ss2) * (1.0f / DM) + EPS);
#pragma unroll
            for (int j = 0; j < 8; ++j) { const f32x4 gg = ((const f32x4*)gpre)[lane + 64 * j];
                u32x2 w; w.x = pk2(v[q][j].x * rs2 * gg.x, v[q][j].y * rs2 * gg.y); w.y = pk2(v[q][j].z * rs2 * gg.z, v[q][j].w * rs2 * gg.w); ((u32x2*)(Hb + ro))[lane + 64 * j] = w; }
        }
    }
}

__device__ __forceinline__ void head_norm_axial(const bf16_t* __restrict__ src, bf16_t* __restrict__ dst, const float* __restrict__ g, const float* __restrict__ COS, const float* __restrict__ SIN, int row, int t, float oscale) {
    float v[8];
#pragma unroll
    for (int s = 0; s < 4; ++s) { const unsigned w = *(const unsigned*)(src + 32 * s + 2 * t); v[2 * s] = bf2f((unsigned short)(w & 0xffff)); v[2 * s + 1] = bf2f((unsigned short)(w >> 16)); }
    float ss = 0.f;
#pragma unroll
    for (int i = 0; i < 8; ++i) ss += v[i] * v[i];
    ss += swz_xor<1>(ss); ss += swz_xor<2>(ss); ss += swz_xor<4>(ss); ss += swz_xor<8>(ss);
    const float rs = rsqrtf(ss * (1.0f / 128.0f) + EPS);
#pragma unroll
    for (int s = 0; s < 4; ++s) { v[2 * s] *= rs * oscale * g[32 * s + 2 * t]; v[2 * s + 1] *= rs * oscale * g[32 * s + 2 * t + 1]; }
    const int pr = row >> 6, pc = row & 63;
    float o[8];
#pragma unroll
    for (int e = 0; e < 2; ++e) { const int i = 2 * t + e;
        { const float c = COS[pr * 32 + i], s = SIN[pr * 32 + i]; const float x1 = v[e], x2 = v[2 + e]; o[e] = x1 * c - x2 * s; o[2 + e] = x2 * c + x1 * s; }
        { const float c = COS[pc * 32 + i], s = SIN[pc * 32 + i]; const float x1 = v[4 + e], x2 = v[6 + e]; o[4 + e] = x1 * c - x2 * s; o[6 + e] = x2 * c + x1 * s; } }
#pragma unroll
    for (int s = 0; s < 4; ++s) *(unsigned*)(dst + 32 * s + 2 * t) = pk2(o[2 * s], o[2 * s + 1]);
}


#define XB_TMO      128
#define XB_XCNT(j)  (256  + 64 * (j))
#define XB_XSUB(j)  (1280 + 64 * (j))
#define XB_XGEN(j)  (2304 + 64 * (j))
#define XB_TOP      3328
#define XB_TOPGEN   3392
#define XCD_BAR_WORDS 3456
#define XB_SPIN_CAP (1u << 18)
__device__ __forceinline__ unsigned xb_ld(unsigned* p)              { return __hip_atomic_load(p, __ATOMIC_RELAXED, __HIP_MEMORY_SCOPE_AGENT); }
__device__ __forceinline__ unsigned xb_add(unsigned* p, unsigned v) { return __hip_atomic_fetch_add(p, v, __ATOMIC_RELAXED, __HIP_MEMORY_SCOPE_AGENT); }
__device__ __forceinline__ unsigned xb_xcc_id() { return (unsigned)__builtin_amdgcn_s_getreg((3 << 11) | 20) & 0xFu; }
#define XB_SPIN(cond, bar) do { unsigned _sp = 0; while (cond) { __builtin_amdgcn_s_sleep(1); \
    if ((++_sp & 255u) == 0u) { if (xb_ld(&(bar)[XB_TMO])) break; if (_sp > XB_SPIN_CAP) { atomicAdd(&(bar)[XB_TMO], 1u); break; } } } } while (0)
__device__ __forceinline__ void xcd_barrier_complete(unsigned* bar, unsigned x, unsigned& nloc, unsigned& nx) {
    const unsigned G = gridDim.x * gridDim.y * gridDim.z;
    unsigned sum, cnt, mine, sp = 0u;
    for (;;) {
        sum = 0u; cnt = 0u; mine = 0u;
#pragma unroll
        for (unsigned j = 0; j < 16; ++j) { const unsigned c = xb_ld(&bar[XB_XCNT(j)]); sum += c; cnt += (c > 0u) ? 1u : 0u; mine = (j == x) ? c : mine; }
        if (sum == G) break;
        __builtin_amdgcn_s_sleep(1);
        if ((++sp & 255u) == 0u) { if (xb_ld(&bar[XB_TMO])) break; if (sp > XB_SPIN_CAP) { atomicAdd(&bar[XB_TMO], 1u); break; } }
    }
    nloc = mine > 0u ? mine : 1u; nx = cnt > 0u ? cnt : 1u;
}
__device__ __forceinline__ void xcd_barrier(unsigned* bar, volatile LAS unsigned* st, bool leader) {
    asm volatile("s_waitcnt vmcnt(0)" ::: "memory");
    __syncthreads();
    if (leader) {
        const unsigned x = xb_xcc_id();
        __builtin_amdgcn_s_waitcnt(0);
        unsigned nloc = st[0], nx = st[1];
        if (nloc == 0u) { xcd_barrier_complete(bar, x, nloc, nx); st[0] = nloc; st[1] = nx; }
        const unsigned old = xb_add(&bar[XB_XSUB(x)], 1u);
        const unsigned gen = old / nloc;
        if (old + 1u == (gen + 1u) * nloc) {
            __builtin_amdgcn_fence(__ATOMIC_RELEASE, "agent");
            asm volatile("s_waitcnt vmcnt(0)" ::: "memory");
            const unsigned og = xb_add(&bar[XB_TOP], 1u);
            const unsigned tg = og / nx;
            if (og + 1u == (tg + 1u) * nx) xb_add(&bar[XB_TOPGEN], 1u);
            else XB_SPIN(xb_ld(&bar[XB_TOPGEN]) == tg, bar);
            __builtin_amdgcn_fence(__ATOMIC_ACQUIRE, "agent");
            xb_add(&bar[XB_XGEN(x)], 1u);
            asm volatile("s_waitcnt vmcnt(0)" ::: "memory");
        } else {
            XB_SPIN(xb_ld(&bar[XB_XGEN(x)]) == gen, bar);
            __builtin_amdgcn_fence(__ATOMIC_ACQUIRE, "agent");
            asm volatile("s_waitcnt vmcnt(0)" ::: "memory");
        }
    }
    __syncthreads();
}

struct Args { const float* in[18]; float* out; unsigned char* wsp; int ph_lo, ph_hi; };

__global__ void __launch_bounds__(512, 2) mega_fwd(Args args) {
    extern __shared__ __attribute__((aligned(16))) unsigned char lds[];
    const int G = gridDim.x, bid = blockIdx.x, NGW = G * 8;
    const int wave0 = __builtin_amdgcn_readfirstlane((int)threadIdx.x >> 6);
    typedef const __attribute__((address_space(4))) Args* KArgP;
    LAS unsigned char* ldsl = (LAS unsigned char*)lds;
#define x_in (kap->in[0])
#define rel_bias (kap->in[1])
#define norm_mix_pre (kap->in[2])
#define norm_mix_post (kap->in[3])
#define norm_ffn_pre (kap->in[4])
#define norm_ffn_post (kap->in[5])
#define w_in (kap->in[6])
#define diff_lambda (kap->in[7])
#define diff_subln (kap->in[8])
#define mla_q_norm (kap->in[9])
#define mla_kv_norm (kap->in[10])
#define mla_w_uq (kap->in[11])
#define mla_w_ukv (kap->in[12])
#define gqa_q_norm (kap->in[13])
#define gqa_k_norm (kap->in[14])
#define w_out (kap->in[15])
#define w_gate_up (kap->in[16])
#define w_down (kap->in[17])
#define xres (kap->out)
#define ws (kap->wsp)
#define PAR ((float*)(ws + WS_PAR))
#define TBLA ((float*)(ws + WS_TBLA))
#define TBLD ((float*)(ws + WS_TBLD))
#define COS ((float*)(ws + WS_COS))
#define SIN ((float*)(ws + WS_SIN))
#define H ((bf16_t*)(ws + WS_H))
#define PROJ ((bf16_t*)(ws + WS_PROJ))
#define CQN ((bf16_t*)(ws + WS_CQN))
#define CKVN ((bf16_t*)(ws + WS_CKVN))
#define KPE ((bf16_t*)(ws + WS_KPE))
#define QC ((bf16_t*)(ws + WS_QC))
#define KC ((bf16_t*)(ws + WS_KC))
#define QB ((bf16_t*)(ws + WS_QB))
#define KVB ((bf16_t*)(ws + WS_KVB))
#define MIX ((bf16_t*)(ws + WS_MIX))
#define Y ((bf16_t*)(ws + WS_Y))
#define HID ((bf16_t*)(ws + WS_HID))
#define TMP ((float*)(ws + WS_TMP))
#define wl (ws + WS_W + (size_t)l * LW)

    volatile LAS unsigned* bst = (volatile LAS unsigned*)(ldsl + LDS_ST_OFF);
    { const bool leader0 = (wave0 == 0) && (lane_id_v() == 0);
      if (leader0) { bst[0] = 0u; bst[1] = 0u; }
      __syncthreads();
      if (leader0 && !MK_MULTI) { KArgP kap0 = (KArgP)__builtin_amdgcn_kernarg_segment_ptr(); (void)xb_add(&((unsigned*)(kap0->wsp + WS_BAR))[XB_XCNT(xb_xcc_id())], 1u); } }
    const int lo = args.ph_lo, hi_ph = args.ph_hi; int ph = 0;
#define PH_BEGIN if (ph >= lo && ph < hi_ph) { KArgP kap = (KArgP)__builtin_amdgcn_kernarg_segment_ptr(); asm volatile("" : "+s"(kap)); \
    int tid_ = wave0 * 64 + lane_id_v(); const int tid = tid_, lane = tid & 63, wave = __builtin_amdgcn_readfirstlane(tid >> 6), gw = bid * 8 + wave; (void)lane; (void)gw;
#define PH_END } if (ph >= lo && ph + 1 < hi_ph) { if (ph == 0) { cg::this_grid().sync(); } else { KArgP kapb = (KArgP)__builtin_amdgcn_kernarg_segment_ptr(); asm volatile("" : "+s"(kapb)); \
      xcd_barrier((unsigned*)(kapb->wsp + WS_BAR), bst, (wave0 == 0) && (lane_id_v() == 0)); } } ++ph;

    PH_BEGIN
    if PHON(0) {
        LAS float* scr = (LAS float*)(ldsl + wave * 16384);
        for (int l = 0; l < DEPTH; ++l) {
            transpose_matrix<2>(w_in + (size_t)l * DM * NPROJ, DM, NPROJ, (bf16_t*)(wl + W_IN), scr, lane, gw, NGW);
            transpose_matrix<3>(mla_w_uq + (size_t)l * 512 * 768, 512, 768, (bf16_t*)(wl + W_UQ), scr, lane, gw, NGW);
            transpose_matrix<0>(mla_w_ukv + (size_t)l * 256 * 1024, 256, 1024, (bf16_t*)(wl + W_UKV), scr, lane, gw, NGW);
            transpose_matrix<0>(w_out + (size_t)l * DM * DM, DM, DM, (bf16_t*)(wl + W_OUT), scr, lane, gw, NGW);
            transpose_matrix<1>(w_gate_up + (size_t)l * DM * NGU, DM, NGU, (bf16_t*)(wl + W_GU), scr, lane, gw, NGW);
            transpose_matrix<0>(w_down + (size_t)l * FF * DM, FF, DM, (bf16_t*)(wl + W_D), scr, lane, gw, NGW);
            { u32x4* z = (u32x4*)((bf16_t*)(wl + W_IN) + (size_t)NPROJ * DM); const int n16 = (LDP - NPROJ) * DM * 2 / 16;
              for (int i = bid * 512 + tid; i < n16; i += G * 512) z[i] = (u32x4){0u, 0u, 0u, 0u}; }
        }
        const int gt = bid * 512 + tid, NT_ = G * 512;
        for (int i = gt; i < 4 * TBLN; i += NT_) { const int h = i / TBLN, d = (i % TBLN) - TOFF; const int b = t5_bucket(d);
            TBLA[i] = rel_bias[b * 8 + h] * 1.4426950408889634f;
            const int n = d < 0 ? -d : d; int mult = (n <= 64 ? 1 : 0) + (((n & 3) == 0 && n <= 256) ? 1 : 0) + (((n & 15) == 0 && n <= 1024) ? 1 : 0);
            TBLD[i] = mult ? (rel_bias[b * 8 + 4 + h] + logf((float)mult)) * 1.4426950408889634f : -1e30f; }
        for (int i = gt; i < S * 32; i += NT_) { const int pos = i >> 5, f = i & 31;
            const float inv = (float)pow(10000.0, -(double)(2 * f) / 64.0); const float ang = (float)pos * inv;
            COS[i] = (float)cos((double)ang); SIN[i] = (float)sin((double)ang); }
        if (bid == 0 && tid < DEPTH) { const float* lv = diff_lambda + tid * 256; float s1 = 0.f, s2 = 0.f;
            for (int i = 0; i < 64; ++i) { s1 += lv[i] * lv[64 + i]; s2 += lv[128 + i] * lv[192 + i]; }
            const float lam_init = 0.8f - 0.6f * expf(-0.3f * (float)tid);
            PAR[tid] = expf(s1) - expf(s2) + lam_init; PAR[4 + tid] = lam_init; }
        for (int row = gw; row < S; row += NGW) norm_row(x_in + (size_t)row * DM, norm_mix_pre, H + (size_t)row * DM, lane);
    }
    PH_END

    for (int l = 0; l < DEPTH; ++l) {
        PH_BEGIN
        if PHON(1) for (int rep_ = 0; rep_ < MK_DUP_GEMM; ++rep_) { pg8::Gemm g{H, (const bf16_t*)(wl + W_IN), S, LDP, DM}; pg8::StaticOrder So; So.init(S, LDP, G, bid);
          pg8::EpiBf16 E{PROJ, LDP};
          pg8::gemm_phase<pg8::EpiBf16, pg8::StaticOrder, true, true>(ldsl, g, So, E, wave0); }
        PH_END
        PH_BEGIN
        if PHON(2) for (int row = gw; row < S; row += NGW) {
            const bf16_t* pr = PROJ + (size_t)row * LDP;
            { const u32x4 raw = *(const u32x4*)(pr + C_BCQ + lane * 8); float v[8];
              v[0] = __uint_as_float(raw.x << 16); v[1] = __uint_as_float(raw.x & 0xffff0000u); v[2] = __uint_as_float(raw.y << 16); v[3] = __uint_as_float(raw.y & 0xffff0000u);
              v[4] = __uint_as_float(raw.z << 16); v[5] = __uint_as_float(raw.z & 0xffff0000u); v[6] = __uint_as_float(raw.w << 16); v[7] = __uint_as_float(raw.w & 0xffff0000u);
              float ss = 0.f;
#pragma unroll
              for (int i = 0; i < 8; ++i) ss += v[i] * v[i];
              const float rs = rsqrtf(wave_sum(ss) * (1.0f / 512.0f) + EPS);
              const f32x4 g0 = *(const f32x4*)(mla_q_norm + l * 512 + lane * 8), g1 = *(const f32x4*)(mla_q_norm + l * 512 + lane * 8 + 4);
              u32x4 w; w.x = pk2(v[0] * rs * g0.x, v[1] * rs * g0.y); w.y = pk2(v[2] * rs * g0.z, v[3] * rs * g0.w); w.z = pk2(v[4] * rs * g1.x, v[5] * rs * g1.y); w.w = pk2(v[6] * rs * g1.z, v[7] * rs * g1.w);
              *(u32x4*)(CQN + (size_t)row * 512 + lane * 8) = w; }
            { const u32x2 raw = *(const u32x2*)(pr + C_BCKV + lane * 4); float v[4];
              v[0] = __uint_as_float(raw.x << 16); v[1] = __uint_as_float(raw.x & 0xffff0000u); v[2] = __uint_as_float(raw.y << 16); v[3] = __uint_as_float(raw.y & 0xffff0000u);
              float ss = v[0] * v[0] + v[1] * v[1] + v[2] * v[2] + v[3] * v[3];
              const float rs = rsqrtf(wave_sum(ss) * (1.0f / 256.0f) + EPS);
              const f32x4 g0 = *(const f32x4*)(mla_kv_norm + l * 256 + lane * 4);
              u32x2 w; w.x = pk2(v[0] * rs * g0.x, v[1] * rs * g0.y); w.y = pk2(v[2] * rs * g0.z, v[3] * rs * g0.w);
              *(u32x2*)(CKVN + (size_t)row * 256 + lane * 4) = w; }
            if (lane < 32) { const float x1 = bf2f(pr[C_BKPE + lane]), x2 = bf2f(pr[C_BKPE + 32 + lane]); const float c = COS[row * 32 + lane], s = SIN[row * 32 + lane];
              KPE[(size_t)row * 64 + lane] = (bf16_t)f2bf(x1 * c - x2 * s); KPE[(size_t)row * 64 + 32 + lane] = (bf16_t)f2bf(x2 * c + x1 * s); }
            { const int hd = lane >> 4, t = lane & 15;
              head_norm_axial(pr + C_CQ + hd * 128, QC + (size_t)row * 512 + hd * 128, gqa_q_norm + l * 128, COS, SIN, row, t, QS_CD);
              const int hk = hd & 1;
              if (lane < 32) head_norm_axial(pr + C_CK + hk * 128, KC + (size_t)row * 256 + hk * 128, gqa_k_norm + l * 128, COS, SIN, row, t, 1.0f); }
        }
        PH_END
        PH_BEGIN
        if PHON(3) { pg8::Gemm g{CQN, (const bf16_t*)(wl + W_UQ), S, 768, 512}; pg8::StaticOrder So; So.init(S, 768, G, bid);
          pg8::EpiBf16 E{QB, 768};
          pg8::gemm_phase<pg8::EpiBf16, pg8::StaticOrder, true, true>(ldsl, g, So, E, wave0); }
        if PHON(4) { pg8::Gemm g{CKVN, (const bf16_t*)(wl + W_UKV), S, 1024, 256}; pg8::StaticOrder So; So.init(S, 1024, G, bid);
          pg8::EpiBf16 E{KVB, 1024};
          pg8::gemm_phase<pg8::EpiBf16, pg8::StaticOrder, true, true>(ldsl, g, So, E, wave0); }
        PH_END
        PH_BEGIN
        for (int rep_ = 0; rep_ < MK_DUP_ATT; ++rep_) {
            const float lam = __int_as_float(__builtin_amdgcn_readfirstlane(__float_as_int(PAR[l]))), lam_init = __int_as_float(__builtin_amdgcn_readfirstlane(__float_as_int(PAR[4 + l])));
            const float L2E = 1.4426950408889634f;
            if PHON(6) for (int u = bid; u < 256; u += G) { const int xq = u & 7, hd = xq & 3, qb = (u >> 3) + 32 * (xq >> 2), q0 = qb * 256;
                { const float cb_lo = rel_bias[15 * 8 + hd] * L2E, cb_hi = rel_bias[31 * 8 + hd] * L2E;
                  att::attn_unit_A2(PROJ + (size_t)q0 * LDP + C_AQ + hd * 128, LDP, PROJ + C_AK + hd * 128, LDP, PROJ + C_AV + hd * 128, LDP, S, q0,
                                    TBLA + hd * TBLN, cb_lo, cb_hi, MIX + (size_t)q0 * DM + hd * 128, DM, lam, diff_subln + l * 128, 1.0f - lam_init, (char*)lds, wave0); }
            }
            if PHON(7) for (int u = bid; u < 256; u += G) { const int xq = u & 7, hd = xq & 3, qb = (u >> 3) + 32 * (xq >> 2), q0 = qb * 256;
                { const float sc = 0.07216878364870322f;
                  if (wave0 < 4) att::attn_unit<12, 0, 0, 1, 8, 1, 0>(QB + (size_t)q0 * 768 + hd * 192, 768, KVB + hd * 256, 1024, KPE, 64, KVB + hd * 256 + 128, 1024,
                                            0, S, q0, nullptr, 0.f, 0.f, MIX + (size_t)q0 * DM + 512 + hd * 128, DM, nullptr, 0.f, nullptr, 0.f, (char*)lds, wave0, COS, SIN); else att::attn_unit<12, 0, 0, 1, 8, 1, 1>(QB + (size_t)q0 * 768 + hd * 192, 768, KVB + hd * 256, 1024, KPE, 64, KVB + hd * 256 + 128, 1024,
                                            0, S, q0, nullptr, 0.f, 0.f, MIX + (size_t)q0 * DM + 512 + hd * 128, DM, nullptr, 0.f, nullptr, 0.f, (char*)lds, wave0, COS, SIN); }
            }
            if (wave0 < 4) __builtin_amdgcn_s_setprio(1);
            if PHON(8) for (int u = bid; u < 256; u += G) { const int xq = u & 7, hd = xq & 3, qb = (u >> 3) + 32 * (xq >> 2), q0 = qb * 256;
                { const float sc = 0.08838834764831845f;
                  if (wave0 < 4) att::attn_unit<8, 0, 0, 1, 0, 0, 0>(QC + (size_t)q0 * 512 + hd * 128, 512, KC + (hd >> 1) * 128, 256, nullptr, 0, PROJ + C_CV + (hd >> 1) * 128, LDP,
                                           0, S, q0, nullptr, 0.f, 0.f, MIX + (size_t)q0 * DM + 1024 + hd * 128, DM, nullptr, 0.f, nullptr, 0.f, (char*)lds, wave0); else att::attn_unit<8, 0, 0, 1, 0, 0, 1>(QC + (size_t)q0 * 512 + hd * 128, 512, KC + (hd >> 1) * 128, 256, nullptr, 0, PROJ + C_CV + (hd >> 1) * 128, LDP,
                                           0, S, q0, nullptr, 0.f, 0.f, MIX + (size_t)q0 * DM + 1024 + hd * 128, DM, nullptr, 0.f, nullptr, 0.f, (char*)lds, wave0); }
            }
            __builtin_amdgcn_s_setprio(0);
            if PHON(9) for (int u = bid; u < 256; u += G) { const int xq = u & 7, hd = xq & 3, qb = (u >> 3) + 32 * (xq >> 2), q0 = qb * 256;
                { const float sc = 0.08838834764831845f;
                  const int kb = q0 - 1024 < 0 ? 0 : q0 - 1024, ke = q0 + 256 + 1024 > S ? S : q0 + 256 + 1024;
                  att::attn_unit<8, 1, 0, 1>(PROJ + (size_t)q0 * LDP + C_DQ + hd * 128, LDP, PROJ + C_DK + hd * 128, LDP, nullptr, 0, PROJ + C_DV + hd * 128, LDP,
                                           kb, ke - kb, q0, TBLD + hd * TBLN, 0.f, 0.f, MIX + (size_t)q0 * DM + 1536 + hd * 128, DM, nullptr, 0.f, nullptr, 0.f, (char*)lds, wave0); }
            }
            __syncthreads();
        }
        PH_END
        PH_BEGIN
        if PHON(10) for (int rep_ = 0; rep_ < MK_DUP_GEMM; ++rep_) { pg8::Gemm g{MIX, (const bf16_t*)(wl + W_OUT), S, DM, DM}; pg8::StaticOrder So; So.init(S, DM, G, bid);
          pg8::EpiBf16 E{Y, DM};
          pg8::gemm_phase<pg8::EpiBf16, pg8::StaticOrder, true, true>(ldsl, g, So, E, wave0); }
        PH_END
        PH_BEGIN
        if PHON(11) { int row = gw;
            for (; row + NGW < S; row += 2 * NGW) norm_add_rows<2>(Y, (l == 0 ? x_in : xres), xres, norm_mix_post + l * DM, norm_ffn_pre + l * DM, H, row, NGW, lane);
            for (; row < S; row += NGW) norm_add_rows<1>(Y, (l == 0 ? x_in : xres), xres, norm_mix_post + l * DM, norm_ffn_pre + l * DM, H, row, NGW, lane); }
        PH_END
        PH_BEGIN
        if PHON(12) for (int rep_ = 0; rep_ < MK_DUP_GEMM; ++rep_) { pg8::Gemm g{H, (const bf16_t*)(wl + W_GU), S, NGU, DM}; pg8::StaticOrder So; So.init(S, NGU, G, bid);
          pg8::EpiSwiGLU E{HID, FF};
          pg8::gemm_phase<pg8::EpiSwiGLU, pg8::StaticOrder, true, true>(ldsl, g, So, E, wave0); }
        PH_END
        PH_BEGIN
        if PHON(13) for (int rep_ = 0; rep_ < MK_DUP_GEMM; ++rep_) { pg8::Gemm g{HID, (const bf16_t*)(wl + W_D), S, DM, FF}; pg8::StaticOrder So; So.init(S, DM, G, bid);
          pg8::EpiBf16 E{Y, DM};
          pg8::gemm_phase<pg8::EpiBf16, pg8::StaticOrder, true, true>(ldsl, g, So, E, wave0); }
        PH_END
        PH_BEGIN
        if PHON(14) { int row = gw; const float* gnext = (l + 1 < DEPTH) ? norm_mix_pre + (l + 1) * DM : nullptr;
            for (; row + NGW < S; row += 2 * NGW) norm_add_rows<2>(Y, xres, xres, norm_ffn_post + l * DM, gnext, H, row, NGW, lane);
            for (; row < S; row += NGW) norm_add_rows<1>(Y, xres, xres, norm_ffn_post + l * DM, gnext, H, row, NGW, lane); }
        PH_END
    }
#undef PH_BEGIN
#undef PH_END
}
#undef x_in
#undef rel_bias
#undef norm_mix_pre
#undef norm_mix_post
#undef norm_ffn_pre
#undef norm_ffn_post
#undef w_in
#undef diff_lambda
#undef diff_subln
#undef mla_q_norm
#undef mla_kv_norm
#undef mla_w_uq
#undef mla_w_ukv
#undef gqa_q_norm
#undef gqa_k_norm
#undef w_out
#undef w_gate_up
#undef w_down
#undef xres
#undef ws
#undef PAR
#undef TBLA
#undef TBLD
#undef COS
#undef SIN
#undef H
#undef PROJ
#undef CQN
#undef CKVN
#undef KPE
#undef QC
#undef KC
#undef QB
#undef KVB
#undef MIX
#undef Y
#undef HID
#undef TMP
#undef wl

constexpr int N_PHASES = 1 + DEPTH * 9;

extern "C" void kernel_launch(void* const* d_in, const int* in_sizes, int n_in, void* d_out, int out_size, void* d_ws, size_t ws_size, hipStream_t stream) {
    static int grid = 0;
    if (grid == 0) {
        if (n_in != 18 || in_sizes[0] != S * DM || out_size != S * DM || ws_size < WS_END) {
            fprintf(stderr, "kernel_launch: unexpected shapes (n_in %d, in0 %d, out %d, ws %zu < %zu)\n", n_in, n_in > 0 ? in_sizes[0] : -1, out_size, ws_size, (size_t)WS_END); grid = -1; return; }
        int dev = 0, cus = 0, per_cu = 0;
        if (hipGetDevice(&dev) != hipSuccess || hipDeviceGetAttribute(&cus, hipDeviceAttributeMultiprocessorCount, dev) != hipSuccess) { grid = -1; return; }
        if (hipFuncSetAttribute((const void*)mega_fwd, hipFuncAttributeMaxDynamicSharedMemorySize, LDS_BYTES) != hipSuccess) { fprintf(stderr, "kernel_launch: hipFuncSetAttribute failed\n"); grid = -1; return; }
        if (hipOccupancyMaxActiveBlocksPerMultiprocessor(&per_cu, (const void*)mega_fwd, 512, LDS_BYTES) != hipSuccess || per_cu < 1) { fprintf(stderr, "kernel_launch: occupancy query says %d\n", per_cu); per_cu = 1; }
        (void)hipGetLastError();
        grid = cus;
    }
    if (grid < 0) return;
    if (hipMemsetAsync((char*)d_ws + WS_BAR, 0, WS_BAR_BYTES, stream) != hipSuccess) { fprintf(stderr, "kernel_launch: hipMemsetAsync of the barrier words failed\n"); return; }
    Args a{};
    for (int i = 0; i < 18; ++i) a.in[i] = (const float*)d_in[i];
    a.out = (float*)d_out; a.wsp = (unsigned char*)d_ws;
#if MK_MULTI
    for (int p = 0; p < N_PHASES; ++p) { a.ph_lo = p; a.ph_hi = p + 1; hipLaunchKernelGGL(mega_fwd, dim3(grid), dim3(512), LDS_BYTES, stream, a); }
#else
    a.ph_lo = 0; a.ph_hi = N_PHASES;
    void* kargs[] = {&a};
    hipError_t e = hipLaunchCooperativeKernel((const void*)mega_fwd, dim3(grid), dim3(512), kargs, LDS_BYTES, stream);
    if (e != hipSuccess) fprintf(stderr, "kernel_launch: cooperative launch failed: %s (grid %d)\n", hipGetErrorString(e), grid);
#endif
}
```

```cpp
#include <hip/hip_runtime.h>
#include <hip/hip_cooperative_groups.h>
#include <cstdio>
#include <cstdint>
namespace cg = cooperative_groups;

#ifndef MK_MULTI
#define MK_MULTI 0
#endif
#ifndef MK_PHMASK
#define MK_PHMASK 0xFFFFF
#endif
#define PHON(k) constexpr (((MK_PHMASK) >> (k)) & 1)
#ifndef MK_DUP_GEMM
#define MK_DUP_GEMM 1
#endif
#ifndef MK_DUP_ATT
#define MK_DUP_ATT 1
#endif

typedef unsigned short bf16_t;
typedef short bf16x8 __attribute__((ext_vector_type(8)));
typedef short s16x4 __attribute__((ext_vector_type(4)));
typedef float f32x2 __attribute__((ext_vector_type(2)));
typedef float f32x4 __attribute__((ext_vector_type(4)));
typedef float f32x16 __attribute__((ext_vector_type(16)));
typedef unsigned u32x2 __attribute__((ext_vector_type(2)));
typedef unsigned u32x4 __attribute__((ext_vector_type(4)));
#define LAS __attribute__((address_space(3)))

constexpr int S = 16384, DM = 2048, DEPTH = 4, NPROJ = 4928, LDP = 5120, FF = 5632, NGU = 2 * FF;
constexpr float EPS = 1e-6f;
constexpr int C_AQ = 0, C_AK = 512, C_AV = 1024, C_BCQ = 1536, C_BCKV = 2048, C_BKPE = 2304, C_CQ = 2368, C_CK = 2880, C_CV = 3136, C_DQ = 3392, C_DK = 3904, C_DV = 4416;
constexpr int TOFF = 1408, TBLN = 2824;

constexpr size_t MiB = 1u << 20;
constexpr size_t WS_PAR = 0, WS_TBLA = 1 * MiB, WS_TBLD = 1 * MiB + 65536, WS_COS = 2 * MiB, WS_SIN = 4 * MiB;
constexpr size_t WS_BAR = 6 * MiB, WS_BAR_BYTES = 16384;
constexpr size_t WS_W = 8 * MiB, LW = 96 * MiB;
constexpr size_t W_IN = 0, W_UQ = 20 * MiB, W_UKV = 21 * MiB, W_OUT = 22 * MiB, W_GU = 30 * MiB, W_D = 74 * MiB;
constexpr size_t WS_H = 392 * MiB, WS_PROJ = 456 * MiB, WS_CQN = 616 * MiB, WS_CKVN = 632 * MiB, WS_KPE = 640 * MiB, WS_QC = 642 * MiB, WS_KC = 658 * MiB;
constexpr size_t WS_QB = 666 * MiB, WS_KVB = 690 * MiB, WS_MIX = 722 * MiB, WS_Y = 786 * MiB, WS_HID = 914 * MiB, WS_TMP = 1090 * MiB, WS_END = 1122 * MiB;

constexpr int LDS_ST_OFF = 163840 - 16;
constexpr int LDS_BYTES = 163840;

__device__ __forceinline__ float bf2f(unsigned short b) { return __uint_as_float(((unsigned)b) << 16); }
__device__ __forceinline__ unsigned f2bf(float f) { unsigned u = __float_as_uint(f); return (u + 0x7fffu + ((u >> 16) & 1u)) >> 16; }
__device__ __forceinline__ unsigned pk2(float lo, float hi) { return f2bf(lo) | (f2bf(hi) << 16); }
__device__ __forceinline__ unsigned cvt_pk_bf16(float lo, float hi) { unsigned r; asm volatile("v_cvt_pk_bf16_f32 %0, %1, %2" : "=v"(r) : "v"(lo), "v"(hi)); return r; }
__device__ __forceinline__ int lane_id_v() { int l; asm volatile("v_mbcnt_lo_u32_b32 %0, -1, 0\n\tv_mbcnt_hi_u32_b32 %0, -1, %0" : "=v"(l)); return l; }
template <int M> __device__ __forceinline__ float swz_xor(float v) { return __int_as_float(__builtin_amdgcn_ds_swizzle(__float_as_int(v), (M << 10) | 0x1f)); }
__device__ __forceinline__ float wave_sum(float v) {
    v += swz_xor<1>(v); v += swz_xor<2>(v); v += swz_xor<4>(v); v += swz_xor<8>(v); v += swz_xor<16>(v);
    auto rr = __builtin_amdgcn_permlane32_swap(__float_as_uint(v), __float_as_uint(v), false, false);
    return __uint_as_float(rr[0]) + __uint_as_float(rr[1]);
}

namespace pg8 {
constexpr int BM = 256, BK = 64, HALF = 128, HTB = HALF * BK * 2, STAGE_BYTES = 8 * HTB, NXCD = 8, WGM = 8;
__host__ __device__ __forceinline__ int lds_byte(int r, int c) { const int st = (r >> 4) * 2 + (c >> 5), rr = r & 15, cc = c & 31, ob = rr * 64 + cc * 2; return st * 1024 + (ob ^ (((ob >> 9) & 1) << 5)); }
__host__ __device__ __forceinline__ void stage_rc(int b, int& R, int& C) { const int st = b / 1024, sb = b % 1024, swz = sb ^ (((sb >> 9) & 1) << 5); R = (st >> 1) * 16 + swz / 64; C = (st & 1) * 32 + (swz % 64) / 2; }
__host__ __device__ __forceinline__ int perm32(int rho) { const int n = rho >> 4, i = rho & 15; return 8 * (i >> 2) + 4 * n + (i & 3); }

struct Unit { int pm, pn; };
struct Gemm { const bf16_t* A; const bf16_t* Bt; int M, N, K; };

struct StaticOrder {
    int nM, nN, nwg, G, c;
    __host__ __device__ void init(int M, int N, int G_, int c_) { nM = M / BM; nN = N / BM; nwg = nM * nN; G = G_; c = c_; }
    __host__ __device__ bool next(int i, Unit& u) const {
        const long L = (long)i * G + c; if (L >= nwg) return false;
        int wgid = (int)L; { const int q = nwg / NXCD, r = nwg % NXCD, xcd = wgid % NXCD, off = wgid / NXCD; wgid = (xcd < r ? xcd * (q + 1) : r * (q + 1) + (xcd - r) * q) + off; }
        const int nig = WGM * nN, gid = wgid / nig, fm = gid * WGM, gsz = (nM - fm) < WGM ? (nM - fm) : WGM;
        u.pm = fm + ((wgid % nig) % gsz); u.pn = (wgid % nig) / gsz; return true;
    }
    __device__ __forceinline__ void a_ready(const Unit&) const {}
    __device__ __forceinline__ void done(const Unit&) const {}
};

struct EpiBf16 {
    static constexpr bool PERM = true, AFTER_DRAIN = false;
    bf16_t* O; int ldc;
    __device__ __forceinline__ void operator()(const f32x4 (&acc)[2][2][4][2], const Unit& u, int wr, int wc, int fr, int fq) const {
        const int row0 = u.pm * BM + wr * 64 + fr; const int col0 = u.pn * BM + wc * 32 + 8 * fq;
#pragma unroll
        for (int ai = 0; ai < 2; ++ai)
#pragma unroll
            for (int m = 0; m < 4; ++m) { bf16_t* rowp = O + (size_t)(row0 + ai * HALF + m * 16) * ldc + col0;
#pragma unroll
                for (int bj = 0; bj < 2; ++bj) { const f32x4 v0 = acc[ai][bj][m][0], v1 = acc[ai][bj][m][1];
                    u32x4 w; w.x = cvt_pk_bf16(v0[0], v0[1]); w.y = cvt_pk_bf16(v0[2], v0[3]); w.z = cvt_pk_bf16(v1[0], v1[1]); w.w = cvt_pk_bf16(v1[2], v1[3]);
                    *(u32x4*)(rowp + bj * HALF) = w; } }
    }
};
struct EpiF32 {
    static constexpr bool PERM = false, AFTER_DRAIN = false;
    float* O; int ldc;
    __device__ __forceinline__ void operator()(const f32x4 (&acc)[2][2][4][2], const Unit& u, int wr, int wc, int fr, int fq) const {
        const int row0 = u.pm * BM + wr * 64 + fr; const int col0 = u.pn * BM + wc * 32 + 4 * fq;
#pragma unroll
        for (int ai = 0; ai < 2; ++ai)
#pragma unroll
            for (int m = 0; m < 4; ++m) { float* rowp = O + (size_t)(row0 + ai * HALF + m * 16) * ldc + col0;
#pragma unroll
                for (int bj = 0; bj < 2; ++bj)
#pragma unroll
                    for (int n = 0; n < 2; ++n) *(f32x4*)(rowp + bj * HALF + n * 16) = acc[ai][bj][m][n]; }
    }
};
__device__ __forceinline__ float silu_mul(float g, float u) {
    const float e = __builtin_amdgcn_exp2f(-g * 1.4426950408889634f);
    return g * __builtin_amdgcn_rcpf(1.0f + e) * u;
}
struct EpiSwiGLU {
    static constexpr bool PERM = true, AFTER_DRAIN = false;
    bf16_t* O; int ldc;
    __device__ __forceinline__ void operator()(const f32x4 (&acc)[2][2][4][2], const Unit& u, int wr, int wc, int fr, int fq) const {
        const int row0 = u.pm * BM + wr * 64 + fr; const int col0 = u.pn * HALF + wc * 32 + 8 * fq;
#pragma unroll
        for (int ai = 0; ai < 2; ++ai)
#pragma unroll
            for (int m = 0; m < 4; ++m) { bf16_t* rowp = O + (size_t)(row0 + ai * HALF + m * 16) * ldc + col0;
                const f32x4 g0 = acc[ai][0][m][0], g1 = acc[ai][0][m][1], u0 = acc[ai][1][m][0], u1 = acc[ai][1][m][1];
                u32x4 w; w.x = cvt_pk_bf16(silu_mul(g0[0], u0[0]), silu_mul(g0[1], u0[1])); w.y = cvt_pk_bf16(silu_mul(g0[2], u0[2]), silu_mul(g0[3], u0[3]));
                w.z = cvt_pk_bf16(silu_mul(g1[0], u1[0]), silu_mul(g1[1], u1[1])); w.w = cvt_pk_bf16(silu_mul(g1[2], u1[2]), silu_mul(g1[3], u1[3]));
                *(u32x4*)rowp = w; }
    }
};

template <class Epi, class Sched, bool ALIGN_EPI = false, bool SP2 = false>
__device__ __forceinline__ void gemm_phase(LAS unsigned char* lds, const Gemm g, const Sched& S, const Epi& E, const int wave0) {
    int tid_ = wave0 * 64 + lane_id_v();
    const int tid = tid_, wid = __builtin_amdgcn_readfirstlane(tid >> 6), lane = tid & 63, wr = wid >> 2, wc = wid & 3, fr = lane & 15, fq = lane >> 4;
    int K_ = g.K; asm volatile("" : "+s"(K_));
    const int K = K_, nt = K / BK;
    unsigned voffA[2], voffB[2];
#pragma unroll
    for (int i = 0; i < 2; ++i) { int R, C; stage_rc(tid * 16 + i * 8192, R, C); const int Rb = Epi::PERM ? ((R & ~31) + perm32(R & 31)) : R;
        voffA[i] = (unsigned)(R * K + C) * 2u; voffB[i] = (unsigned)(Rb * K + C) * 2u; }
    const size_t kstep = (size_t)(BK * 2);
    const size_t hstep = (size_t)HALF * K * 2;
    const size_t tstep = 2 * hstep;
    const unsigned ldsw = (unsigned)wid * 1024u;
    const int aoff = lds_byte(wr * 64 + fr, fq * 8), boff = lds_byte(wc * 32 + fr, fq * 8);
#define PG8_SA(b, h) (((b) * 2 + (h)) * HTB)
#define PG8_SB(b, h) ((4 + (b) * 2 + (h)) * HTB)
#define PG8_STAGE(bufoff, gbase, voff) do { _Pragma("unroll") for (int _i = 0; _i < 2; ++_i) \
        __builtin_amdgcn_global_load_lds((const unsigned*)((const char*)(gbase) + (voff)[_i]), (LAS unsigned*)(lds + (bufoff) + ldsw + _i * 8192), 16, 0, 0); } while (0)
#define PG8_LDA(dst, b, h) do { _Pragma("unroll") for (int m = 0; m < 4; ++m) _Pragma("unroll") for (int k = 0; k < 2; ++k) dst[m][k] = *(const LAS bf16x8*)(lds + PG8_SA(b, h) + aoff + m * 2048 + k * 1024); } while (0)
#define PG8_LDB(dst, b, h) do { _Pragma("unroll") for (int n = 0; n < 2; ++n) _Pragma("unroll") for (int k = 0; k < 2; ++k) dst[n][k] = *(const LAS bf16x8*)(lds + PG8_SB(b, h) + boff + n * 2048 + k * 1024); } while (0)
#define PG8_MMA(ai, bj, At, Bt) do { __builtin_amdgcn_s_setprio(1); _Pragma("unroll") for (int m = 0; m < 4; ++m) _Pragma("unroll") for (int n = 0; n < 2; ++n) _Pragma("unroll") for (int k = 0; k < 2; ++k) \
        acc[ai][bj][m][n] = __builtin_amdgcn_mfma_f32_16x16x32_bf16(Bt[n][k], At[m][k], acc[ai][bj][m][n], 0, 0, 0); __builtin_amdgcn_s_setprio(0); } while (0)
#define PG8_WAIT_V(n) asm volatile("s_waitcnt vmcnt(" #n ")" ::: "memory")
#define PG8_WAIT_L(n) asm volatile("s_waitcnt lgkmcnt(" #n ")" ::: "memory")
#define PG8_BAR __builtin_amdgcn_s_barrier()
#define PG8_SCHED __builtin_amdgcn_sched_barrier(0)
    Unit cur, nxt; int ui = 0;
    if (!S.next(0, cur)) return;
    f32x4 acc[2][2][4][2];
#pragma unroll
    for (int a = 0; a < 2; ++a)
#pragma unroll
        for (int b = 0; b < 2; ++b)
#pragma unroll
            for (int m = 0; m < 4; ++m)
#pragma unroll
                for (int n = 0; n < 2; ++n) acc[a][b][m][n] = (f32x4){0.f, 0.f, 0.f, 0.f};
    bf16x8 At[4][2], B0[2][2], B1[2][2];
    const char* cA = (const char*)g.A + (size_t)cur.pm * tstep; const char* cB = (const char*)g.Bt + (size_t)cur.pn * tstep;
    S.a_ready(cur);
    if constexpr (SP2) {
        PG8_STAGE(PG8_SB(0, 0), cB, voffB); PG8_STAGE(PG8_SB(0, 1), cB + hstep, voffB); PG8_STAGE(PG8_SA(0, 0), cA, voffA); PG8_STAGE(PG8_SA(0, 1), cA + hstep, voffA);
        if (wr == 1) PG8_BAR;
        PG8_WAIT_V(2); PG8_BAR;
        PG8_STAGE(PG8_SB(1, 0), cB + kstep, voffB); PG8_STAGE(PG8_SA(1, 0), cA + kstep, voffA); PG8_STAGE(PG8_SB(1, 1), cB + hstep + kstep, voffB);
        PG8_WAIT_V(6); PG8_BAR;
    } else {
        PG8_STAGE(PG8_SB(0, 0), cB, voffB); PG8_STAGE(PG8_SA(0, 0), cA, voffA); PG8_STAGE(PG8_SB(0, 1), cB + hstep, voffB); PG8_STAGE(PG8_SA(0, 1), cA + hstep, voffA);
        if (wr == 1) PG8_BAR;
        PG8_WAIT_V(4); PG8_BAR;
        PG8_STAGE(PG8_SB(1, 0), cB + kstep, voffB); PG8_STAGE(PG8_SA(1, 0), cA + kstep, voffA); PG8_STAGE(PG8_SB(1, 1), cB + hstep + kstep, voffB);
        PG8_WAIT_V(6); PG8_BAR;
    }
    for (;;) {
        const bool has_next = S.next(ui + 1, nxt);
        const char* nA = has_next ? (const char*)g.A + (size_t)nxt.pm * tstep : cA; const char* nB = has_next ? (const char*)g.Bt + (size_t)nxt.pn * tstep : cB;
        for (int t = 0; t < nt; t += 2) {
            const bool last = (t == nt - 2);
            const char* a1 = cA + (size_t)(t + 1) * kstep;
            const char* a2 = last ? nA : cA + (size_t)(t + 2) * kstep; const char* b2 = last ? nB : cB + (size_t)(t + 2) * kstep;
            const char* a3 = a2 + kstep; const char* b3 = b2 + kstep;
            if (last && has_next) S.a_ready(nxt);
            if constexpr (SP2) {
            PG8_LDB(B0, 0, 0); PG8_LDB(B1, 0, 1); PG8_SCHED; PG8_LDA(At, 0, 0); PG8_STAGE(PG8_SA(1, 1), a1 + hstep, voffA);
            PG8_WAIT_V(8); PG8_WAIT_L(0); PG8_BAR; PG8_MMA(0, 0, At, B0); PG8_MMA(0, 1, At, B1); PG8_BAR; PG8_SCHED;
            PG8_LDA(At, 0, 1); PG8_STAGE(PG8_SB(0, 0), b2, voffB); PG8_STAGE(PG8_SB(0, 1), b2 + hstep, voffB); PG8_STAGE(PG8_SA(0, 0), a2, voffA);
            PG8_WAIT_V(8); PG8_WAIT_L(0); PG8_BAR; PG8_MMA(1, 0, At, B0); PG8_MMA(1, 1, At, B1); PG8_BAR; PG8_SCHED;
            PG8_LDB(B0, 1, 0); PG8_LDB(B1, 1, 1); PG8_SCHED; PG8_LDA(At, 1, 0); PG8_STAGE(PG8_SA(0, 1), a2 + hstep, voffA);
            PG8_WAIT_V(8); PG8_WAIT_L(0); PG8_BAR; PG8_MMA(0, 0, At, B0); PG8_MMA(0, 1, At, B1); PG8_BAR; PG8_SCHED;
            PG8_LDA(At, 1, 1); PG8_STAGE(PG8_SB(1, 0), b3, voffB); PG8_STAGE(PG8_SB(1, 1), b3 + hstep, voffB); PG8_STAGE(PG8_SA(1, 0), a3, voffA);
            PG8_WAIT_V(8); PG8_WAIT_L(0); PG8_BAR; PG8_MMA(1, 0, At, B0); PG8_MMA(1, 1, At, B1); PG8_BAR; PG8_SCHED;
            } else {
            PG8_LDB(B0, 0, 0); PG8_SCHED; PG8_LDA(At, 0, 0); PG8_STAGE(PG8_SA(1, 1), a1 + hstep, voffA);
            PG8_WAIT_L(8); PG8_BAR; PG8_WAIT_L(0); PG8_MMA(0, 0, At, B0); PG8_BAR; PG8_SCHED;
            PG8_LDB(B1, 0, 1); PG8_STAGE(PG8_SB(0, 0), b2, voffB);
            PG8_BAR; PG8_WAIT_L(0); PG8_MMA(0, 1, At, B1); PG8_BAR;
            PG8_LDA(At, 0, 1); PG8_STAGE(PG8_SA(0, 0), a2, voffA);
            PG8_BAR; PG8_WAIT_L(0); PG8_MMA(1, 0, At, B0); PG8_BAR; PG8_SCHED;
            PG8_STAGE(PG8_SB(0, 1), b2 + hstep, voffB);
            PG8_WAIT_V(6); PG8_BAR; PG8_MMA(1, 1, At, B1); PG8_BAR;
            PG8_LDB(B0, 1, 0); PG8_SCHED; PG8_LDA(At, 1, 0); PG8_STAGE(PG8_SA(0, 1), a2 + hstep, voffA);
            PG8_WAIT_L(8); PG8_BAR; PG8_WAIT_L(0); PG8_MMA(0, 0, At, B0); PG8_BAR; PG8_SCHED;
            PG8_LDB(B1, 1, 1); PG8_STAGE(PG8_SB(1, 0), b3, voffB);
            PG8_BAR; PG8_WAIT_L(0); PG8_MMA(0, 1, At, B1); PG8_BAR;
            PG8_LDA(At, 1, 1); PG8_STAGE(PG8_SA(1, 0), a3, voffA);
            PG8_BAR; PG8_WAIT_L(0); PG8_MMA(1, 0, At, B0); PG8_BAR; PG8_SCHED;
            PG8_STAGE(PG8_SB(1, 1), b3 + hstep, voffB);
            PG8_WAIT_V(6); PG8_BAR; PG8_MMA(1, 1, At, B1); PG8_BAR;
            }
        }
        if constexpr (ALIGN_EPI) { if (wr == 0) PG8_BAR; }
        if constexpr (!Epi::AFTER_DRAIN) { E(acc, cur, wr, wc, fr, fq); S.done(cur); }
        if (!has_next) break;
#pragma unroll
        for (int a = 0; a < 2; ++a)
#pragma unroll
            for (int b = 0; b < 2; ++b)
#pragma unroll
                for (int m = 0; m < 4; ++m)
#pragma unroll
                    for (int n = 0; n < 2; ++n) acc[a][b][m][n] = (f32x4){0.f, 0.f, 0.f, 0.f};
        cur = nxt; cA = nA; cB = nB; ++ui;
        if constexpr (ALIGN_EPI) { if (wr == 1) PG8_BAR; }
    }
    PG8_WAIT_V(0);
    if constexpr (!ALIGN_EPI) { if (wr == 0) PG8_BAR; }
    PG8_BAR;
#undef PG8_SA
#undef PG8_SB
#undef PG8_STAGE
#undef PG8_LDA
#undef PG8_LDB
#undef PG8_MMA
#undef PG8_WAIT_V
#undef PG8_WAIT_L
#undef PG8_BAR
#undef PG8_SCHED
}
}

namespace att {
constexpr int NW = 8, QBLK = 32, KVBLK = 64;
constexpr int SHM_V = KVBLK * 128 * 2;
#define SBAR() __builtin_amdgcn_sched_barrier(0)
__device__ __forceinline__ int crow(int r, int hi) { return (r & 3) + 8 * (r >> 2) + 4 * hi; }
__device__ __forceinline__ unsigned cvtpk(float lo, float hi) { unsigned r; asm volatile("v_cvt_pk_bf16_f32 %0, %1, %2" : "=v"(r) : "v"(lo), "v"(hi)); return r; }

constexpr float THR2 = 8.0f * 1.4426950408889634f;
template <bool FIRST>
__device__ __forceinline__ void partialSM(f32x16& p0, f32x16& p1, float& mC, float& alpha) {
  float mx_[4] = {p0[0], p0[1], p0[2], p0[3]};
#pragma unroll
  for (int r = 4; r < 16; ++r) mx_[r & 3] = fmaxf(mx_[r & 3], p0[r]);
#pragma unroll
  for (int r = 0; r < 16; ++r) mx_[r & 3] = fmaxf(mx_[r & 3], p1[r]);
  float pmax = fmaxf(fmaxf(mx_[0], mx_[1]), fmaxf(mx_[2], mx_[3]));
  { auto rr = __builtin_amdgcn_permlane32_swap(__float_as_uint(pmax), __float_as_uint(pmax), false, false);
    pmax = fmaxf(__uint_as_float(rr[0]), __uint_as_float(rr[1])); }
  if (!FIRST && __builtin_expect(__all(pmax <= THR2), 1)) { alpha = 1.f; }
  else { const float delta = FIRST ? fmaxf(pmax, -200.f) : fmaxf(pmax, 0.f); alpha = FIRST ? 1.f : __builtin_amdgcn_exp2f(-delta); mC += delta;
#pragma unroll
    for (int r = 0; r < 16; ++r) p0[r] -= delta;
#pragma unroll
    for (int r = 0; r < 16; ++r) p1[r] -= delta; }
#pragma unroll
  for (int r = 0; r < 16; ++r) p0[r] = __builtin_amdgcn_exp2f(p0[r]);
}
template <bool EXP1 = true>
__device__ __forceinline__ void finishSM(f32x16& p0, f32x16& p1, float alpha, float& l_reg, bf16x8& pa0, bf16x8& pa1, bf16x8& pa2, bf16x8& pa3) {
  if constexpr (EXP1) {
#pragma unroll
  for (int r = 0; r < 16; ++r) p1[r] = __builtin_amdgcn_exp2f(p1[r]);
  }
  float sm_[4] = {p0[0], p0[1], p0[2], p0[3]};
#pragma unroll
  for (int r = 4; r < 16; ++r) sm_[r & 3] += p0[r];
#pragma unroll
  for (int r = 0; r < 16; ++r) sm_[r & 3] += p1[r];
  float ps = (sm_[0] + sm_[1]) + (sm_[2] + sm_[3]);
  { auto rr = __builtin_amdgcn_permlane32_swap(__float_as_uint(ps), __float_as_uint(ps), false, false);
    ps = __uint_as_float(rr[0]) + __uint_as_float(rr[1]); }
  l_reg = l_reg * alpha + ps;
#define PK4(P, BASE, OUT) do { unsigned a0 = cvtpk(P[BASE + 0], P[BASE + 1]), a1 = cvtpk(P[BASE + 2], P[BASE + 3]);   \
    unsigned b0 = cvtpk(P[BASE + 4], P[BASE + 5]), b1 = cvtpk(P[BASE + 6], P[BASE + 7]);                              \
    auto r0 = __builtin_amdgcn_permlane32_swap(a0, b0, false, false); auto r1 = __builtin_amdgcn_permlane32_swap(a1, b1, false, false); \
    u32x4 w = {r0[0], r1[0], r0[1], r1[1]}; OUT = *reinterpret_cast<bf16x8*>(&w); } while (0)
  PK4(p0, 0, pa0); PK4(p0, 8, pa1); PK4(p1, 0, pa2); PK4(p1, 8, pa3);
#undef PK4
}
template <int NDQ, int NQL>
__device__ __forceinline__ void qkt(f32x16& p0, f32x16& p1, const f32x16& negm, const char* Ks, const bf16x8* qr, const char* qls, int r32, int hi) {
  constexpr int ROWB = NDQ * 32, NQR = NDQ - NQL, SWM = (NDQ == 8) ? 15 : 7;
#pragma unroll
  for (int d0 = 0; d0 < NDQ; ++d0) { const int cb = (d0 * 16 + hi * 8) * 2;
    bf16x8 b0 = *reinterpret_cast<const bf16x8*>(Ks + r32 * ROWB + (cb ^ ((r32 & SWM) << 4)));
    bf16x8 b1 = *reinterpret_cast<const bf16x8*>(Ks + (32 + r32) * ROWB + (cb ^ ((r32 & SWM) << 4)));
    bf16x8 q;
    if constexpr (NQL > 0) { if (d0 < NQR) q = qr[d0 < NQR ? d0 : 0]; else q = *reinterpret_cast<const bf16x8*>(qls + (d0 - NQR) * 1024); }
    else q = qr[d0];
    if (d0 == 0) { p0 = __builtin_amdgcn_mfma_f32_32x32x16_bf16(b0, q, negm, 0, 0, 0); p1 = __builtin_amdgcn_mfma_f32_32x32x16_bf16(b1, q, negm, 0, 0, 0); }
    else { p0 = __builtin_amdgcn_mfma_f32_32x32x16_bf16(b0, q, p0, 0, 0, 0); p1 = __builtin_amdgcn_mfma_f32_32x32x16_bf16(b1, q, p1, 0, 0, 0); } }
}
template <int OFF> __device__ __forceinline__ bf16x8 lds_rd128(int a) { bf16x8 r; asm volatile("ds_read_b128 %0, %1 offset:%2" : "=&v"(r) : "v"(a), "i"(OFF) : "memory"); return r; }
#define SBAR_M() __builtin_amdgcn_sched_barrier(0)
__device__ __forceinline__ void qkt8_roll(f32x16& p0, f32x16& p1, const f32x16& negm, int kb, const bf16x8* qr) {
  const int a0 = kb ^ (0 << 5); const bf16x8 x0 = lds_rd128<0>(a0), y0 = lds_rd128<8192>(a0);
  const int a1 = kb ^ (1 << 5); const bf16x8 x1 = lds_rd128<0>(a1), y1 = lds_rd128<8192>(a1);
  const int a2 = kb ^ (2 << 5); const bf16x8 x2 = lds_rd128<0>(a2), y2 = lds_rd128<8192>(a2);
  asm volatile("s_waitcnt lgkmcnt(4)" ::: "memory"); SBAR_M();
  p0 = __builtin_amdgcn_mfma_f32_32x32x16_bf16(x0, qr[0], negm, 0, 0, 0); p1 = __builtin_amdgcn_mfma_f32_32x32x16_bf16(y0, qr[0], negm, 0, 0, 0);
  const int a3 = kb ^ (3 << 5); const bf16x8 x3 = lds_rd128<0>(a3), y3 = lds_rd128<8192>(a3);
  asm volatile("s_waitcnt lgkmcnt(4)" ::: "memory"); SBAR_M();
  p0 = __builtin_amdgcn_mfma_f32_32x32x16_bf16(x1, qr[1], p0, 0, 0, 0); p1 = __builtin_amdgcn_mfma_f32_32x32x16_bf16(y1, qr[1], p1, 0, 0, 0);
  const int a4 = kb ^ (4 << 5); const bf16x8 x4 = lds_rd128<0>(a4), y4 = lds_rd128<8192>(a4);
  asm volatile("s_waitcnt lgkmcnt(4)" ::: "memory"); SBAR_M();
  p0 = __builtin_amdgcn_mfma_f32_32x32x16_bf16(x2, qr[2], p0, 0, 0, 0); p1 = __builtin_amdgcn_mfma_f32_32x32x16_bf16(y2, qr[2], p1, 0, 0, 0);
  const int a5 = kb ^ (5 << 5); const bf16x8 x5 = lds_rd128<0>(a5), y5 = lds_rd128<8192>(a5);
  asm volatile("s_waitcnt lgkmcnt(4)" ::: "memory"); SBAR_M();
  p0 = __builtin_amdgcn_mfma_f32_32x32x16_bf16(x3, qr[3], p0, 0, 0, 0); p1 = __builtin_amdgcn_mfma_f32_32x32x16_bf16(y3, qr[3], p1, 0, 0, 0);
  const int a6 = kb ^ (6 << 5); const bf16x8 x6 = lds_rd128<0>(a6), y6 = lds_rd128<8192>(a6);
  asm volatile("s_waitcnt lgkmcnt(4)" ::: "memory"); SBAR_M();
  p0 = __builtin_amdgcn_mfma_f32_32x32x16_bf16(x4, qr[4], p0, 0, 0, 0); p1 = __builtin_amdgcn_mfma_f32_32x32x16_bf16(y4, qr[4], p1, 0, 0, 0);
  const int a7 = kb ^ (7 << 5); const bf16x8 x7 = lds_rd128<0>(a7), y7 = lds_rd128<8192>(a7);
  asm volatile("s_waitcnt lgkmcnt(4)" ::: "memory"); SBAR_M();
  p0 = __builtin_amdgcn_mfma_f32_32x32x16_bf16(x5, qr[5], p0, 0, 0, 0); p1 = __builtin_amdgcn_mfma_f32_32x32x16_bf16(y5, qr[5], p1, 0, 0, 0);
  asm volatile("s_waitcnt lgkmcnt(2)" ::: "memory"); SBAR_M();
  p0 = __builtin_amdgcn_mfma_f32_32x32x16_bf16(x6, qr[6], p0, 0, 0, 0); p1 = __builtin_amdgcn_mfma_f32_32x32x16_bf16(y6, qr[6], p1, 0, 0, 0);
  asm volatile("s_waitcnt lgkmcnt(0)" ::: "memory"); SBAR_M();
  p0 = __builtin_amdgcn_mfma_f32_32x32x16_bf16(x7, qr[7], p0, 0, 0, 0); p1 = __builtin_amdgcn_mfma_f32_32x32x16_bf16(y7, qr[7], p1, 0, 0, 0);
}

#define PK4S(P, BASE, OUT) do { unsigned a0 = cvtpk(P[BASE + 0], P[BASE + 1]), a1 = cvtpk(P[BASE + 2], P[BASE + 3]);   \
    unsigned b0 = cvtpk(P[BASE + 4], P[BASE + 5]), b1 = cvtpk(P[BASE + 6], P[BASE + 7]);                              \
    auto r0 = __builtin_amdgcn_permlane32_swap(a0, b0, false, false); auto r1 = __builtin_amdgcn_permlane32_swap(a1, b1, false, false); \
    u32x4 w = {r0[0], r1[0], r0[1], r1[1]}; OUT = *reinterpret_cast<bf16x8*>(&w); } while (0)
template <int K>
__device__ __forceinline__ void fsm_slice(f32x16& p0, f32x16& p1, float alpha, float& l_reg, bf16x8& pa0, bf16x8& pa1, bf16x8& pa2, bf16x8& pa3, float (&sm)[4]) {
  if constexpr (K == 2) {
    sm[0] = p0[0]; sm[1] = p0[1]; sm[2] = p0[2]; sm[3] = p0[3];
#pragma unroll
    for (int r = 4; r < 16; ++r) sm[r & 3] += p0[r];
  } else if constexpr (K == 3) {
#pragma unroll
    for (int r = 0; r < 16; ++r) sm[r & 3] += p1[r];
  } else if constexpr (K == 4) {
    float ps = (sm[0] + sm[1]) + (sm[2] + sm[3]);
    { auto rr = __builtin_amdgcn_permlane32_swap(__float_as_uint(ps), __float_as_uint(ps), false, false);
      ps = __uint_as_float(rr[0]) + __uint_as_float(rr[1]); }
    l_reg = l_reg * alpha + ps;
    PK4S(p0, 0, pa0);
  } else if constexpr (K == 5) { PK4S(p0, 8, pa1);
  } else if constexpr (K == 6) { PK4S(p1, 0, pa2);
  } else if constexpr (K == 7) { PK4S(p1, 8, pa3); }
}
template <int K>
__device__ __forceinline__ void psm_slice(f32x16& p0, f32x16& p1, float& mC, float& alpha, float (&mx)[4]) {
  if constexpr (K == 0) { mx[0] = p0[0]; mx[1] = p0[1]; mx[2] = p0[2]; mx[3] = p0[3]; }
  else if constexpr (K >= 1 && K <= 3) {
#pragma unroll
    for (int r = 4 * K; r < 4 * K + 4; ++r) mx[r & 3] = fmaxf(mx[r & 3], p0[r]);
  } else if constexpr (K >= 4 && K <= 7) {
#pragma unroll
    for (int r = 4 * (K - 4); r < 4 * (K - 4) + 4; ++r) mx[r & 3] = fmaxf(mx[r & 3], p1[r]);
  } else if constexpr (K == 8) {
    float pmax = fmaxf(fmaxf(mx[0], mx[1]), fmaxf(mx[2], mx[3]));
    { auto rr = __builtin_amdgcn_permlane32_swap(__float_as_uint(pmax), __float_as_uint(pmax), false, false);
      pmax = fmaxf(__uint_as_float(rr[0]), __uint_as_float(rr[1])); }
    if (__builtin_expect(__all(pmax <= THR2), 1)) { alpha = 1.f; }
    else { const float delta = fmaxf(pmax, 0.f); alpha = __builtin_amdgcn_exp2f(-delta); mC += delta;
#pragma unroll
      for (int r = 0; r < 16; ++r) p0[r] -= delta;
#pragma unroll
      for (int r = 0; r < 16; ++r) p1[r] -= delta; }
  } else if constexpr (K >= 9 && K <= 12) {
#pragma unroll
    for (int r = 4 * (K - 9); r < 4 * (K - 9) + 4; ++r) p0[r] = __builtin_amdgcn_exp2f(p0[r]);
  } else if constexpr (K >= 13 && K <= 15) {
#pragma unroll
    for (int r = (K == 13 ? 0 : K == 14 ? 6 : 11); r < (K == 13 ? 6 : K == 14 ? 11 : 16); ++r) p1[r] = __builtin_amdgcn_exp2f(p1[r]);
  }
}
__device__ __forceinline__ int v_st(int k, int c) { const int kk = (k & ~0xC) | ((k & 4) << 1) | ((k & 8) >> 1); return ((kk >> 3) * 4 + (c >> 5)) * 512 + ((kk & 7) * 32 + (c & 31)) * 2; }
__device__ __forceinline__ int v_rd_base(int lane) { return ((lane & 3) << 3) | (((lane >> 2) & 3) << 6) | (((lane >> 4) & 1) << 5) | (((lane >> 5) & 1) << 8); }
constexpr int v_rd_off(int d0, int ks, int half) { return d0 * 512 + ks * 4096 + half * 2048; }
template <int OFF> __device__ __forceinline__ s16x4 tr_read(int vb) {
  s16x4 r; asm volatile("ds_read_b64_tr_b16 %0, %1 offset:%2" : "=&v"(r) : "v"(vb), "i"(OFF) : "memory"); return r;
}
template <int D0> __device__ __forceinline__ void pv_one(f32x16& od, int vb, bf16x8 pa0, bf16x8 pa1, bf16x8 pa2, bf16x8 pa3) {
  const s16x4 l0 = tr_read<v_rd_off(D0, 0, 0)>(vb), h0 = tr_read<v_rd_off(D0, 0, 1)>(vb), l1 = tr_read<v_rd_off(D0, 1, 0)>(vb), h1 = tr_read<v_rd_off(D0, 1, 1)>(vb);
  const s16x4 l2 = tr_read<v_rd_off(D0, 2, 0)>(vb), h2 = tr_read<v_rd_off(D0, 2, 1)>(vb), l3 = tr_read<v_rd_off(D0, 3, 0)>(vb), h3 = tr_read<v_rd_off(D0, 3, 1)>(vb);
  asm volatile("s_waitcnt lgkmcnt(0)" ::: "memory"); SBAR();
#define PK(L, H) (bf16x8){L[0], L[1], L[2], L[3], H[0], H[1], H[2], H[3]}
  od = __builtin_amdgcn_mfma_f32_32x32x16_bf16(pa0, PK(l0, h0), od, 0, 0, 0);
  od = __builtin_amdgcn_mfma_f32_32x32x16_bf16(pa1, PK(l1, h1), od, 0, 0, 0);
  od = __builtin_amdgcn_mfma_f32_32x32x16_bf16(pa2, PK(l2, h2), od, 0, 0, 0);
  od = __builtin_amdgcn_mfma_f32_32x32x16_bf16(pa3, PK(l3, h3), od, 0, 0, 0);
#undef PK
}
__device__ __forceinline__ void pv_d0(f32x16* o, int vb, bf16x8 pa0, bf16x8 pa1, bf16x8 pa2, bf16x8 pa3) {
#define PK(L, H) (bf16x8){L[0], L[1], L[2], L[3], H[0], H[1], H[2], H[3]}
  const s16x4 l0 = tr_read<v_rd_off(0, 0, 0)>(vb), h0 = tr_read<v_rd_off(0, 0, 1)>(vb);
  const s16x4 l1 = tr_read<v_rd_off(0, 1, 0)>(vb), h1 = tr_read<v_rd_off(0, 1, 1)>(vb);
  const s16x4 l2 = tr_read<v_rd_off(0, 2, 0)>(vb), h2 = tr_read<v_rd_off(0, 2, 1)>(vb);
  const s16x4 l3 = tr_read<v_rd_off(0, 3, 0)>(vb), h3 = tr_read<v_rd_off(0, 3, 1)>(vb);
  const s16x4 l4 = tr_read<v_rd_off(1, 0, 0)>(vb), h4 = tr_read<v_rd_off(1, 0, 1)>(vb);
  asm volatile("s_waitcnt lgkmcnt(8)" ::: "memory"); SBAR();
  o[0] = __builtin_amdgcn_mfma_f32_32x32x16_bf16(pa0, PK(l0, h0), o[0], 0, 0, 0);
  const s16x4 l5 = tr_read<v_rd_off(1, 1, 0)>(vb), h5 = tr_read<v_rd_off(1, 1, 1)>(vb);
  asm volatile("s_waitcnt lgkmcnt(8)" ::: "memory"); SBAR();
  o[0] = __builtin_amdgcn_mfma_f32_32x32x16_bf16(pa1, PK(l1, h1), o[0], 0, 0, 0);
  const s16x4 l6 = tr_read<v_rd_off(1, 2, 0)>(vb), h6 = tr_read<v_rd_off(1, 2, 1)>(vb);
  asm volatile("s_waitcnt lgkmcnt(8)" ::: "memory"); SBAR();
  o[0] = __builtin_amdgcn_mfma_f32_32x32x16_bf16(pa2, PK(l2, h2), o[0], 0, 0, 0);
  const s16x4 l7 = tr_read<v_rd_off(1, 3, 0)>(vb), h7 = tr_read<v_rd_off(1, 3, 1)>(vb);
  asm volatile("s_waitcnt lgkmcnt(8)" ::: "memory"); SBAR();
  o[0] = __builtin_amdgcn_mfma_f32_32x32x16_bf16(pa3, PK(l3, h3), o[0], 0, 0, 0);
  const s16x4 l8 = tr_read<v_rd_off(2, 0, 0)>(vb), h8 = tr_read<v_rd_off(2, 0, 1)>(vb);
  asm volatile("s_waitcnt lgkmcnt(8)" ::: "memory"); SBAR();
  o[1] = __builtin_amdgcn_mfma_f32_32x32x16_bf16(pa0, PK(l4, h4), o[1], 0, 0, 0);
  const s16x4 l9 = tr_read<v_rd_off(2, 1, 0)>(vb), h9 = tr_read<v_rd_off(2, 1, 1)>(vb);
  asm volatile("s_waitcnt lgkmcnt(8)" ::: "memory"); SBAR();
  o[1] = __builtin_amdgcn_mfma_f32_32x32x16_bf16(pa1, PK(l5, h5), o[1], 0, 0, 0);
  const s16x4 l10 = tr_read<v_rd_off(2, 2, 0)>(vb), h10 = tr_read<v_rd_off(2, 2, 1)>(vb);
  asm volatile("s_waitcnt lgkmcnt(8)" ::: "memory"); SBAR();
  o[1] = __builtin_amdgcn_mfma_f32_32x32x16_bf16(pa2, PK(l6, h6), o[1], 0, 0, 0);
  const s16x4 l11 = tr_read<v_rd_off(2, 3, 0)>(vb), h11 = tr_read<v_rd_off(2, 3, 1)>(vb);
  asm volatile("s_waitcnt lgkmcnt(8)" ::: "memory"); SBAR();
  o[1] = __builtin_amdgcn_mfma_f32_32x32x16_bf16(pa3, PK(l7, h7), o[1], 0, 0, 0);
  const s16x4 l12 = tr_read<v_rd_off(3, 0, 0)>(vb), h12 = tr_read<v_rd_off(3, 0, 1)>(vb);
  asm volatile("s_waitcnt lgkmcnt(8)" ::: "memory"); SBAR();
  o[2] = __builtin_amdgcn_mfma_f32_32x32x16_bf16(pa0, PK(l8, h8), o[2], 0, 0, 0);
  const s16x4 l13 = tr_read<v_rd_off(3, 1, 0)>(vb), h13 = tr_read<v_rd_off(3, 1, 1)>(vb);
  asm volatile("s_waitcnt lgkmcnt(8)" ::: "memory"); SBAR();
  o[2] = __builtin_amdgcn_mfma_f32_32x32x16_bf16(pa1, PK(l9, h9), o[2], 0, 0, 0);
  const s16x4 l14 = tr_read<v_rd_off(3, 2, 0)>(vb), h14 = tr_read<v_rd_off(3, 2, 1)>(vb);
  asm volatile("s_waitcnt lgkmcnt(8)" ::: "memory"); SBAR();
  o[2] = __builtin_amdgcn_mfma_f32_32x32x16_bf16(pa2, PK(l10, h10), o[2], 0, 0, 0);
  const s16x4 l15 = tr_read<v_rd_off(3, 3, 0)>(vb), h15 = tr_read<v_rd_off(3, 3, 1)>(vb);
  asm volatile("s_waitcnt lgkmcnt(8)" ::: "memory"); SBAR();
  o[2] = __builtin_amdgcn_mfma_f32_32x32x16_bf16(pa3, PK(l11, h11), o[2], 0, 0, 0);
  asm volatile("s_waitcnt lgkmcnt(6)" ::: "memory"); SBAR();
  o[3] = __builtin_amdgcn_mfma_f32_32x32x16_bf16(pa0, PK(l12, h12), o[3], 0, 0, 0);
  asm volatile("s_waitcnt lgkmcnt(4)" ::: "memory"); SBAR();
  o[3] = __builtin_amdgcn_mfma_f32_32x32x16_bf16(pa1, PK(l13, h13), o[3], 0, 0, 0);
  asm volatile("s_waitcnt lgkmcnt(2)" ::: "memory"); SBAR();
  o[3] = __builtin_amdgcn_mfma_f32_32x32x16_bf16(pa2, PK(l14, h14), o[3], 0, 0, 0);
  asm volatile("s_waitcnt lgkmcnt(0)" ::: "memory"); SBAR();
  o[3] = __builtin_amdgcn_mfma_f32_32x32x16_bf16(pa3, PK(l15, h15), o[3], 0, 0, 0);
#undef PK
}

__device__ __forceinline__ void qkt12_roll(f32x16& p0, f32x16& p1, const f32x16& negm, int kb, int qa, const bf16x8* qr) {
  const int a0 = kb ^ (0 << 5); const bf16x8 x0 = lds_rd128<0>(a0), y0 = lds_rd128<12288>(a0);
  const int a1 = kb ^ (1 << 5); const bf16x8 x1 = lds_rd128<0>(a1), y1 = lds_rd128<12288>(a1);
  asm volatile("s_waitcnt lgkmcnt(2)" ::: "memory"); SBAR();
  p0 = __builtin_amdgcn_mfma_f32_32x32x16_bf16(x0, qr[0], negm, 0, 0, 0); p1 = __builtin_amdgcn_mfma_f32_32x32x16_bf16(y0, qr[0], negm, 0, 0, 0);
  const int a2 = kb ^ (2 << 5); const bf16x8 x2 = lds_rd128<0>(a2), y2 = lds_rd128<12288>(a2);
  asm volatile("s_waitcnt lgkmcnt(2)" ::: "memory"); SBAR();
  p0 = __builtin_amdgcn_mfma_f32_32x32x16_bf16(x1, qr[1], p0, 0, 0, 0); p1 = __builtin_amdgcn_mfma_f32_32x32x16_bf16(y1, qr[1], p1, 0, 0, 0);
  const int a3 = kb ^ (3 << 5); const bf16x8 x3 = lds_rd128<0>(a3), y3 = lds_rd128<12288>(a3);
  asm volatile("s_waitcnt lgkmcnt(2)" ::: "memory"); SBAR();
  p0 = __builtin_amdgcn_mfma_f32_32x32x16_bf16(x2, qr[2], p0, 0, 0, 0); p1 = __builtin_amdgcn_mfma_f32_32x32x16_bf16(y2, qr[2], p1, 0, 0, 0);
  const int a4 = kb ^ (0 << 5); const bf16x8 x4 = lds_rd128<128>(a4), y4 = lds_rd128<12416>(a4); const bf16x8 z4 = lds_rd128<0>(qa);
  asm volatile("s_waitcnt lgkmcnt(3)" ::: "memory"); SBAR();
  p0 = __builtin_amdgcn_mfma_f32_32x32x16_bf16(x3, qr[3], p0, 0, 0, 0); p1 = __builtin_amdgcn_mfma_f32_32x32x16_bf16(y3, qr[3], p1, 0, 0, 0);
  const int a5 = kb ^ (1 << 5); const bf16x8 x5 = lds_rd128<128>(a5), y5 = lds_rd128<12416>(a5); const bf16x8 z5 = lds_rd128<1024>(qa);
  asm volatile("s_waitcnt lgkmcnt(3)" ::: "memory"); SBAR();
  p0 = __builtin_amdgcn_mfma_f32_32x32x16_bf16(x4, z4, p0, 0, 0, 0); p1 = __builtin_amdgcn_mfma_f32_32x32x16_bf16(y4, z4, p1, 0, 0, 0);
  const int a6 = kb ^ (2 << 5); const bf16x8 x6 = lds_rd128<128>(a6), y6 = lds_rd128<12416>(a6); const bf16x8 z6 = lds_rd128<2048>(qa);
  asm volatile("s_waitcnt lgkmcnt(3)" ::: "memory"); SBAR();
  p0 = __builtin_amdgcn_mfma_f32_32x32x16_bf16(x5, z5, p0, 0, 0, 0); p1 = __builtin_amdgcn_mfma_f32_32x32x16_bf16(y5, z5, p1, 0, 0, 0);
  const int a7 = kb ^ (3 << 5); const bf16x8 x7 = lds_rd128<128>(a7), y7 = lds_rd128<12416>(a7); const bf16x8 z7 = lds_rd128<3072>(qa);
  asm volatile("s_waitcnt lgkmcnt(3)" ::: "memory"); SBAR();
  p0 = __builtin_amdgcn_mfma_f32_32x32x16_bf16(x6, z6, p0, 0, 0, 0); p1 = __builtin_amdgcn_mfma_f32_32x32x16_bf16(y6, z6, p1, 0, 0, 0);
  const int a8 = kb ^ (0 << 5); const bf16x8 x8 = lds_rd128<256>(a8), y8 = lds_rd128<12544>(a8); const bf16x8 z8 = lds_rd128<4096>(qa);
  asm volatile("s_waitcnt lgkmcnt(3)" ::: "memory"); SBAR();
  p0 = __builtin_amdgcn_mfma_f32_32x32x16_bf16(x7, z7, p0, 0, 0, 0); p1 = __builtin_amdgcn_mfma_f32_32x32x16_bf16(y7, z7, p1, 0, 0, 0);
  const int a9 = kb ^ (1 << 5); const bf16x8 x9 = lds_rd128<256>(a9), y9 = lds_rd128<12544>(a9); const bf16x8 z9 = lds_rd128<5120>(qa);
  asm volatile("s_waitcnt lgkmcnt(3)" ::: "memory"); SBAR();
  p0 = __builtin_amdgcn_mfma_f32_32x32x16_bf16(x8, z8, p0, 0, 0, 0); p1 = __builtin_amdgcn_mfma_f32_32x32x16_bf16(y8, z8, p1, 0, 0, 0);
  const int a10 = kb ^ (2 << 5); const bf16x8 x10 = lds_rd128<256>(a10), y10 = lds_rd128<12544>(a10); const bf16x8 z10 = lds_rd128<6144>(qa);
  asm volatile("s_waitcnt lgkmcnt(3)" ::: "memory"); SBAR();
  p0 = __builtin_amdgcn_mfma_f32_32x32x16_bf16(x9, z9, p0, 0, 0, 0); p1 = __builtin_amdgcn_mfma_f32_32x32x16_bf16(y9, z9, p1, 0, 0, 0);
  const int a11 = kb ^ (3 << 5); const bf16x8 x11 = lds_rd128<256>(a11), y11 = lds_rd128<12544>(a11); const bf16x8 z11 = lds_rd128<7168>(qa);
  asm volatile("s_waitcnt lgkmcnt(3)" ::: "memory"); SBAR();
  p0 = __builtin_amdgcn_mfma_f32_32x32x16_bf16(x10, z10, p0, 0, 0, 0); p1 = __builtin_amdgcn_mfma_f32_32x32x16_bf16(y10, z10, p1, 0, 0, 0);
  asm volatile("s_waitcnt lgkmcnt(0)" ::: "memory"); SBAR();
  p0 = __builtin_amdgcn_mfma_f32_32x32x16_bf16(x11, z11, p0, 0, 0, 0); p1 = __builtin_amdgcn_mfma_f32_32x32x16_bf16(y11, z11, p1, 0, 0, 0);
  SBAR();
}
__device__ __forceinline__ void qkt8_fsm(f32x16& p0, f32x16& p1, const f32x16& negm, int kb, const bf16x8* qr, f32x16& q0p, f32x16& q1p, float alpha, float& l_reg, bf16x8& pa0, bf16x8& pa1, bf16x8& pa2, bf16x8& pa3) {
  float sm[4];
  const int a0 = kb ^ (0 << 5); const bf16x8 x0 = lds_rd128<0>(a0), y0 = lds_rd128<8192>(a0);
  const int a1 = kb ^ (1 << 5); const bf16x8 x1 = lds_rd128<0>(a1), y1 = lds_rd128<8192>(a1);
  const int a2 = kb ^ (2 << 5); const bf16x8 x2 = lds_rd128<0>(a2), y2 = lds_rd128<8192>(a2);
  asm volatile("s_waitcnt lgkmcnt(4)" ::: "memory"); SBAR();
  p0 = __builtin_amdgcn_mfma_f32_32x32x16_bf16(x0, qr[0], negm, 0, 0, 0); p1 = __builtin_amdgcn_mfma_f32_32x32x16_bf16(y0, qr[0], negm, 0, 0, 0);
  fsm_slice<0>(q0p, q1p, alpha, l_reg, pa0, pa1, pa2, pa3, sm); SBAR();
  const int a3 = kb ^ (3 << 5); const bf16x8 x3 = lds_rd128<0>(a3), y3 = lds_rd128<8192>(a3);
  asm volatile("s_waitcnt lgkmcnt(4)" ::: "memory"); SBAR();
  p0 = __builtin_amdgcn_mfma_f32_32x32x16_bf16(x1, qr[1], p0, 0, 0, 0); p1 = __builtin_amdgcn_mfma_f32_32x32x16_bf16(y1, qr[1], p1, 0, 0, 0);
  fsm_slice<1>(q0p, q1p, alpha, l_reg, pa0, pa1, pa2, pa3, sm); SBAR();
  const int a4 = kb ^ (4 << 5); const bf16x8 x4 = lds_rd128<0>(a4), y4 = lds_rd128<8192>(a4);
  asm volatile("s_waitcnt lgkmcnt(4)" ::: "memory"); SBAR();
  p0 = __builtin_amdgcn_mfma_f32_32x32x16_bf16(x2, qr[2], p0, 0, 0, 0); p1 = __builtin_amdgcn_mfma_f32_32x32x16_bf16(y2, qr[2], p1, 0, 0, 0);
  fsm_slice<2>(q0p, q1p, alpha, l_reg, pa0, pa1, pa2, pa3, sm); SBAR();
  const int a5 = kb ^ (5 << 5); const bf16x8 x5 = lds_rd128<0>(a5), y5 = lds_rd128<8192>(a5);
  asm volatile("s_waitcnt lgkmcnt(4)" ::: "memory"); SBAR();
  p0 = __builtin_amdgcn_mfma_f32_32x32x16_bf16(x3, qr[3], p0, 0, 0, 0); p1 = __builtin_amdgcn_mfma_f32_32x32x16_bf16(y3, qr[3], p1, 0, 0, 0);
  fsm_slice<3>(q0p, q1p, alpha, l_reg, pa0, pa1, pa2, pa3, sm); SBAR();
  const int a6 = kb ^ (6 << 5); const bf16x8 x6 = lds_rd128<0>(a6), y6 = lds_rd128<8192>(a6);
  asm volatile("s_waitcnt lgkmcnt(4)" ::: "memory"); SBAR();
  p0 = __builtin_amdgcn_mfma_f32_32x32x16_bf16(x4, qr[4], p0, 0, 0, 0); p1 = __builtin_amdgcn_mfma_f32_32x32x16_bf16(y4, qr[4], p1, 0, 0, 0);
  fsm_slice<4>(q0p, q1p, alpha, l_reg, pa0, pa1, pa2, pa3, sm); SBAR();
  const int a7 = kb ^ (7 << 5); const bf16x8 x7 = lds_rd128<0>(a7), y7 = lds_rd128<8192>(a7);
  asm volatile("s_waitcnt lgkmcnt(4)" ::: "memory"); SBAR();
  p0 = __builtin_amdgcn_mfma_f32_32x32x16_bf16(x5, qr[5], p0, 0, 0, 0); p1 = __builtin_amdgcn_mfma_f32_32x32x16_bf16(y5, qr[5], p1, 0, 0, 0);
  fsm_slice<5>(q0p, q1p, alpha, l_reg, pa0, pa1, pa2, pa3, sm); SBAR();
  asm volatile("s_waitcnt lgkmcnt(2)" ::: "memory"); SBAR();
  p0 = __builtin_amdgcn_mfma_f32_32x32x16_bf16(x6, qr[6], p0, 0, 0, 0); p1 = __builtin_amdgcn_mfma_f32_32x32x16_bf16(y6, qr[6], p1, 0, 0, 0);
  fsm_slice<6>(q0p, q1p, alpha, l_reg, pa0, pa1, pa2, pa3, sm); SBAR();
  asm volatile("s_waitcnt lgkmcnt(0)" ::: "memory"); SBAR();
  p0 = __builtin_amdgcn_mfma_f32_32x32x16_bf16(x7, qr[7], p0, 0, 0, 0); p1 = __builtin_amdgcn_mfma_f32_32x32x16_bf16(y7, qr[7], p1, 0, 0, 0);
  fsm_slice<7>(q0p, q1p, alpha, l_reg, pa0, pa1, pa2, pa3, sm); SBAR();
}
__device__ __forceinline__ void pv_psm(f32x16* o, int vb, bf16x8 pa0, bf16x8 pa1, bf16x8 pa2, bf16x8 pa3, f32x16& n0, f32x16& n1, float& mC, float& alpha) {
  float mx[4];
#define PK(L, H) (bf16x8){L[0], L[1], L[2], L[3], H[0], H[1], H[2], H[3]}
  const s16x4 l0 = tr_read<v_rd_off(0, 0, 0)>(vb), h0 = tr_read<v_rd_off(0, 0, 1)>(vb);
  const s16x4 l1 = tr_read<v_rd_off(0, 1, 0)>(vb), h1 = tr_read<v_rd_off(0, 1, 1)>(vb);
  const s16x4 l2 = tr_read<v_rd_off(0, 2, 0)>(vb), h2 = tr_read<v_rd_off(0, 2, 1)>(vb);
  const s16x4 l3 = tr_read<v_rd_off(0, 3, 0)>(vb), h3 = tr_read<v_rd_off(0, 3, 1)>(vb);
  asm volatile("s_waitcnt lgkmcnt(6)" ::: "memory"); SBAR();
  o[0] = __builtin_amdgcn_mfma_f32_32x32x16_bf16(pa0, PK(l0, h0), o[0], 0, 0, 0);
  psm_slice<0>(n0, n1, mC, alpha, mx); SBAR();
  const s16x4 l4 = tr_read<v_rd_off(1, 0, 0)>(vb), h4 = tr_read<v_rd_off(1, 0, 1)>(vb);
  asm volatile("s_waitcnt lgkmcnt(6)" ::: "memory"); SBAR();
  o[0] = __builtin_amdgcn_mfma_f32_32x32x16_bf16(pa1, PK(l1, h1), o[0], 0, 0, 0);
  psm_slice<1>(n0, n1, mC, alpha, mx); SBAR();
  const s16x4 l5 = tr_read<v_rd_off(1, 1, 0)>(vb), h5 = tr_read<v_rd_off(1, 1, 1)>(vb);
  asm volatile("s_waitcnt lgkmcnt(6)" ::: "memory"); SBAR();
  o[0] = __builtin_amdgcn_mfma_f32_32x32x16_bf16(pa2, PK(l2, h2), o[0], 0, 0, 0);
  psm_slice<2>(n0, n1, mC, alpha, mx); SBAR();
  const s16x4 l6 = tr_read<v_rd_off(1, 2, 0)>(vb), h6 = tr_read<v_rd_off(1, 2, 1)>(vb);
  asm volatile("s_waitcnt lgkmcnt(6)" ::: "memory"); SBAR();
  o[0] = __builtin_amdgcn_mfma_f32_32x32x16_bf16(pa3, PK(l3, h3), o[0], 0, 0, 0);
  psm_slice<3>(n0, n1, mC, alpha, mx); SBAR();
  const s16x4 l7 = tr_read<v_rd_off(1, 3, 0)>(vb), h7 = tr_read<v_rd_off(1, 3, 1)>(vb);
  asm volatile("s_waitcnt lgkmcnt(6)" ::: "memory"); SBAR();
  o[1] = __builtin_amdgcn_mfma_f32_32x32x16_bf16(pa0, PK(l4, h4), o[1], 0, 0, 0);
  psm_slice<4>(n0, n1, mC, alpha, mx); SBAR();
  const s16x4 l8 = tr_read<v_rd_off(2, 0, 0)>(vb), h8 = tr_read<v_rd_off(2, 0, 1)>(vb);
  asm volatile("s_waitcnt lgkmcnt(6)" ::: "memory"); SBAR();
  o[1] = __builtin_amdgcn_mfma_f32_32x32x16_bf16(pa1, PK(l5, h5), o[1], 0, 0, 0);
  psm_slice<5>(n0, n1, mC, alpha, mx); SBAR();
  const s16x4 l9 = tr_read<v_rd_off(2, 1, 0)>(vb), h9 = tr_read<v_rd_off(2, 1, 1)>(vb);
  asm volatile("s_waitcnt lgkmcnt(6)" ::: "memory"); SBAR();
  o[1] = __builtin_amdgcn_mfma_f32_32x32x16_bf16(pa2, PK(l6, h6), o[1], 0, 0, 0);
  psm_slice<6>(n0, n1, mC, alpha, mx); SBAR();
  const s16x4 l10 = tr_read<v_rd_off(2, 2, 0)>(vb), h10 = tr_read<v_rd_off(2, 2, 1)>(vb);
  asm volatile("s_waitcnt lgkmcnt(6)" ::: "memory"); SBAR();
  o[1] = __builtin_amdgcn_mfma_f32_32x32x16_bf16(pa3, PK(l7, h7), o[1], 0, 0, 0);
  psm_slice<7>(n0, n1, mC, alpha, mx); SBAR();
  const s16x4 l11 = tr_read<v_rd_off(2, 3, 0)>(vb), h11 = tr_read<v_rd_off(2, 3, 1)>(vb);
  asm volatile("s_waitcnt lgkmcnt(6)" ::: "memory"); SBAR();
  o[2] = __builtin_amdgcn_mfma_f32_32x32x16_bf16(pa0, PK(l8, h8), o[2], 0, 0, 0);
  psm_slice<8>(n0, n1, mC, alpha, mx); SBAR();
  const s16x4 l12 = tr_read<v_rd_off(3, 0, 0)>(vb), h12 = tr_read<v_rd_off(3, 0, 1)>(vb);
  asm volatile("s_waitcnt lgkmcnt(6)" ::: "memory"); SBAR();
  o[2] = __builtin_amdgcn_mfma_f32_32x32x16_bf16(pa1, PK(l9, h9), o[2], 0, 0, 0);
  psm_slice<9>(n0, n1, mC, alpha, mx); SBAR();
  const s16x4 l13 = tr_read<v_rd_off(3, 1, 0)>(vb), h13 = tr_read<v_rd_off(3, 1, 1)>(vb);
  asm volatile("s_waitcnt lgkmcnt(6)" ::: "memory"); SBAR();
  o[2] = __builtin_amdgcn_mfma_f32_32x32x16_bf16(pa2, PK(l10, h10), o[2], 0, 0, 0);
  psm_slice<10>(n0, n1, mC, alpha, mx); SBAR();
  const s16x4 l14 = tr_read<v_rd_off(3, 2, 0)>(vb), h14 = tr_read<v_rd_off(3, 2, 1)>(vb);
  asm volatile("s_waitcnt lgkmcnt(6)" ::: "memory"); SBAR();
  o[2] = __builtin_amdgcn_mfma_f32_32x32x16_bf16(pa3, PK(l11, h11), o[2], 0, 0, 0);
  psm_slice<11>(n0, n1, mC, alpha, mx); SBAR();
  const s16x4 l15 = tr_read<v_rd_off(3, 3, 0)>(vb), h15 = tr_read<v_rd_off(3, 3, 1)>(vb);
  asm volatile("s_waitcnt lgkmcnt(6)" ::: "memory"); SBAR();
  o[3] = __builtin_amdgcn_mfma_f32_32x32x16_bf16(pa0, PK(l12, h12), o[3], 0, 0, 0);
  psm_slice<12>(n0, n1, mC, alpha, mx); SBAR();
  asm volatile("s_waitcnt lgkmcnt(4)" ::: "memory"); SBAR();
  o[3] = __builtin_amdgcn_mfma_f32_32x32x16_bf16(pa1, PK(l13, h13), o[3], 0, 0, 0);
  psm_slice<13>(n0, n1, mC, alpha, mx); SBAR();
  asm volatile("s_waitcnt lgkmcnt(2)" ::: "memory"); SBAR();
  o[3] = __builtin_amdgcn_mfma_f32_32x32x16_bf16(pa2, PK(l14, h14), o[3], 0, 0, 0);
  psm_slice<14>(n0, n1, mC, alpha, mx); SBAR();
  asm volatile("s_waitcnt lgkmcnt(0)" ::: "memory"); SBAR();
  o[3] = __builtin_amdgcn_mfma_f32_32x32x16_bf16(pa3, PK(l15, h15), o[3], 0, 0, 0);
  psm_slice<15>(n0, n1, mC, alpha, mx); SBAR();
#undef PK
}
constexpr int LDS_K_OFF = 2 * SHM_V, LDS_WS_OFF = LDS_K_OFF + 2 * 12 * 2048, LDS_TBL_OFF = LDS_WS_OFF + NW * 64 * 4, LDS_Q_OFF = LDS_TBL_OFF + ((TBLN * 4 + 15) / 16) * 16;
static_assert(LDS_Q_OFF + NW * 8192 <= 163840, "attention LDS map");

template <int NDQ, int BIAS, int EPI, int SDEPTH, int NQL = 0, int ROPEQ = 0, int ORD = 0>
__device__ __forceinline__ void attn_unit(const bf16_t* __restrict__ Qb, int ldq, const bf16_t* __restrict__ Kh, int ldk, const bf16_t* __restrict__ K2, int ldk2,
                                          const bf16_t* __restrict__ Vh, int ldv, int kbeg, int nkeys, int q0, const float* __restrict__ tblg, float cb_lo, float cb_hi,
                                          bf16_t* __restrict__ Obf, int ldo, float* __restrict__ tmp, float lam, const float* __restrict__ subln, float post, char* lds, const int wave0, const float* __restrict__ cosp = nullptr, const float* __restrict__ sinp = nullptr) {
  constexpr int ROWB = NDQ * 32, SHM_K = 64 * ROWB;
  int tid_ = wave0 * 64 + lane_id_v();
  const int tid = tid_, wid = tid >> 6, lane = tid & 63, r32 = lane & 31, hi = lane >> 5;
  char* V_lds = lds; char* K_lds = lds + LDS_K_OFF;
  float* ws = (float*)(lds + LDS_WS_OFF) + wid * 64; float* li_l = ws; float* al_l = ws + 32;
  float* tbl_l = (float*)(lds + LDS_TBL_OFF);
  __syncthreads();
  if constexpr (BIAS) { for (int i = tid; i < TBLN; i += 512) tbl_l[i] = tblg[i]; }
  float mC = 0.f, l_reg = 0, nm_cur = 0.f; f32x16 o[4] = {}; f32x16 negm = {}; bf16x8 qr[NDQ - NQL];
  const bf16_t* Qw = Qb + (long)(wid * QBLK + r32) * ldq + hi * 8;
  char* qls = lds + LDS_Q_OFF + wid * 8192 + lane * 16;
#pragma unroll
  for (int d0 = 0; d0 < NDQ - NQL; ++d0) qr[d0] = *reinterpret_cast<const bf16x8*>(Qw + d0 * 16);
  if constexpr (ROPEQ) {
    static_assert(NDQ == 12 && NQL >= 4, "ROPEQ: MLA layout");
#pragma unroll
    for (int d0 = NDQ - NQL; d0 < 8; ++d0) *reinterpret_cast<bf16x8*>(qls + (d0 - (NDQ - NQL)) * 1024) = *reinterpret_cast<const bf16x8*>(Qw + d0 * 16);
    const int qrow = q0 + wid * QBLK + r32;
#pragma unroll
    for (int pr = 0; pr < 2; ++pr) {
      const bf16x8 xa = *reinterpret_cast<const bf16x8*>(Qw + (8 + pr) * 16), xb = *reinterpret_cast<const bf16x8*>(Qw + (10 + pr) * 16);
      const float* cp = cosp + (size_t)qrow * 32 + pr * 16 + hi * 8; const float* sp = sinp + (size_t)qrow * 32 + pr * 16 + hi * 8;
      const f32x4 c0 = *(const f32x4*)cp, c1 = *(const f32x4*)(cp + 4), s0 = *(const f32x4*)sp, s1 = *(const f32x4*)(sp + 4);
      float ya[8], yb[8];
#pragma unroll
      for (int t = 0; t < 8; ++t) { const float x1 = bf2f((unsigned short)xa[t]), x2 = bf2f((unsigned short)xb[t]); const float c = t < 4 ? c0[t & 3] : c1[t & 3], sn = t < 4 ? s0[t & 3] : s1[t & 3];
        ya[t] = x1 * c - x2 * sn; yb[t] = x2 * c + x1 * sn; }
      u32x4 wa = {pk2(ya[0], ya[1]), pk2(ya[2], ya[3]), pk2(ya[4], ya[5]), pk2(ya[6], ya[7])}, wb = {pk2(yb[0], yb[1]), pk2(yb[2], yb[3]), pk2(yb[4], yb[5]), pk2(yb[6], yb[7])};
      *reinterpret_cast<u32x4*>(qls + (8 + pr - (NDQ - NQL)) * 1024) = wa; *reinterpret_cast<u32x4*>(qls + (10 + pr - (NDQ - NQL)) * 1024) = wb; }
  } else {
#pragma unroll
  for (int d0 = NDQ - NQL; d0 < NDQ; ++d0) *reinterpret_cast<bf16x8*>(qls + (d0 - (NDQ - NQL)) * 1024) = *reinterpret_cast<const bf16x8*>(Qw + d0 * 16);
  }
  const int sr = tid >> 4, sc = (tid & 15) * 8, vst0 = v_st(sr, sc), vst1 = v_st(32 + sr, sc);
  const int sr8 = tid >> 3, sc8 = (tid & 7) * 8;
  const int vb0 = (int)(uintptr_t)V_lds + v_rd_base(lane);
  const int qlane = q0 + wid * QBLK + r32;
  struct { bf16x8 vs0, vs1, ks0, ks1, ks2; } sr_[SDEPTH];
  constexpr int SWM = (NDQ == 8) ? 15 : 7;
#define KSWZ(row, colB) ((row) * ROWB + ((colB) ^ (((row) & SWM) << 4)))
#define SLOAD(i, k0) do { sr_[i].vs0 = *reinterpret_cast<const bf16x8*>(&Vh[(long)((k0) + sr) * ldv + sc]); sr_[i].vs1 = *reinterpret_cast<const bf16x8*>(&Vh[(long)((k0) + 32 + sr) * ldv + sc]); \
    if constexpr (NDQ == 4) { sr_[i].ks0 = *reinterpret_cast<const bf16x8*>(&Kh[(long)((k0) + sr8) * ldk + sc8]); } \
    else { sr_[i].ks0 = *reinterpret_cast<const bf16x8*>(&Kh[(long)((k0) + sr) * ldk + sc]); sr_[i].ks1 = *reinterpret_cast<const bf16x8*>(&Kh[(long)((k0) + 32 + sr) * ldk + sc]); \
      if constexpr (NDQ == 12) { sr_[i].ks2 = *reinterpret_cast<const bf16x8*>(&K2[(long)((k0) + sr8) * ldk2 + sc8]); } } } while (0)
#define SWRITE(b, i) do { *(bf16x8*)(V_lds + (b) * SHM_V + vst0) = sr_[i].vs0; *(bf16x8*)(V_lds + (b) * SHM_V + vst1) = sr_[i].vs1; \
    if constexpr (NDQ == 4) { *(bf16x8*)(K_lds + (b) * SHM_K + KSWZ(sr8, sc8 * 2)) = sr_[i].ks0; } \
    else { *(bf16x8*)(K_lds + (b) * SHM_K + KSWZ(sr, sc * 2)) = sr_[i].ks0; *(bf16x8*)(K_lds + (b) * SHM_K + KSWZ(32 + sr, sc * 2)) = sr_[i].ks1; \
      if constexpr (NDQ == 12) { *(bf16x8*)(K_lds + (b) * SHM_K + KSWZ(sr8, 256 + sc8 * 2)) = sr_[i].ks2; } } } while (0)
#define SWAIT() do { if constexpr (SDEPTH == 2) { if constexpr (NDQ == 4) asm volatile("s_waitcnt vmcnt(3)" ::: "memory"); else if constexpr (NDQ == 8) asm volatile("s_waitcnt vmcnt(4)" ::: "memory"); else asm volatile("s_waitcnt vmcnt(5)" ::: "memory"); } \
    else asm volatile("s_waitcnt vmcnt(0)" ::: "memory"); } while (0)
#define RESC(a) do { if (__any((a) < 1.f)) { if (hi == 0) al_l[r32] = (a); asm volatile("s_waitcnt lgkmcnt(0)" ::: "memory"); \
    _Pragma("unroll") for (int d = 0; d < 4; ++d) _Pragma("unroll") for (int r = 0; r < 16; ++r) o[d][r] *= al_l[crow(r, hi)]; } } while (0)
#define BIASADD(P0, P1, kt0) do { if constexpr (BIAS) { const int dlo_ = (kt0) - q0 - 255, dhi_ = (kt0) + 63 - q0; \
    if (!(dlo_ >= 1024) && !(dhi_ <= -1024)) { const float* tb_ = tbl_l + ((kt0) - qlane + TOFF + 4 * hi); \
      _Pragma("unroll") for (int r = 0; r < 16; ++r) { P0[r] += tb_[(r & 3) + 8 * (r >> 2)]; P1[r] += tb_[32 + (r & 3) + 8 * (r >> 2)]; } } } } while (0)
#define NEGM_UPD(kt0) do { float nmj_ = -mC; if constexpr (BIAS) { const int dlo_ = (kt0) - q0 - 255, dhi_ = (kt0) + 63 - q0; if (dlo_ >= 1024) nmj_ += cb_hi; else if (dhi_ <= -1024) nmj_ += cb_lo; } \
    if (__any(nmj_ != nm_cur)) { nm_cur = nmj_; _Pragma("unroll") for (int r = 0; r < 16; ++r) negm[r] = nmj_; } } while (0)
  f32x16 pA0, pA1, pB0, pB1; float alA, alB; bf16x8 pa0, pa1, pa2, pa3; const int NT = nkeys / KVBLK;
  const int kb0 = (int)(uintptr_t)K_lds + r32 * ROWB + (((r32 & SWM) << 4) ^ (hi << 4));
  const int qa0 = (int)(uintptr_t)qls;
#define QKT(P0, P1, KOFF) do { if constexpr (NDQ == 8 && NQL == 0) qkt8_roll(P0, P1, negm, kb0 + (KOFF), qr); \
    else if constexpr (NDQ == 12 && NQL == 8) qkt12_roll(P0, P1, negm, kb0 + (KOFF), qa0, qr); else qkt<NDQ, NQL>(P0, P1, negm, K_lds + (KOFF), qr, qls, r32, hi); } while (0)
  constexpr int SE = 0, SO = SDEPTH - 1;
  SLOAD(SE, kbeg); asm volatile("s_waitcnt vmcnt(0)" ::: "memory"); SWRITE(0, SE); __syncthreads();
  constexpr bool SLICED = (NDQ == 8 && NQL == 0 && BIAS == 1);
  NEGM_UPD(kbeg); QKT(pA0, pA1, 0); BIASADD(pA0, pA1, kbeg); partialSM<true>(pA0, pA1, mC, alA);
  if constexpr (SLICED) {
#pragma unroll
    for (int r = 0; r < 16; ++r) pA1[r] = __builtin_amdgcn_exp2f(pA1[r]); }
  SLOAD(SO, kbeg + KVBLK); if constexpr (SDEPTH == 2) { if (2 < NT) SLOAD(SE, kbeg + 2 * KVBLK); }
  SWAIT(); SWRITE(1, SO); __syncthreads();
  if constexpr (NDQ == 8 && NQL == 0 && BIAS == 1) {
  for (int j = 1; j + 1 < NT; j += 2) {
    if constexpr (ORD == 0) {
    NEGM_UPD(kbeg + j * KVBLK); SBAR();
    qkt8_fsm(pB0, pB1, negm, kb0 + SHM_K, qr, pA0, pA1, alA, l_reg, pa0, pa1, pa2, pa3);
    SLOAD(SO, kbeg + (j + SDEPTH) * KVBLK); SBAR();
    BIASADD(pB0, pB1, kbeg + j * KVBLK); SBAR();
    pv_psm(o, vb0, pa0, pa1, pa2, pa3, pB0, pB1, mC, alB);
    } else {
    finishSM<false>(pA0, pA1, alA, l_reg, pa0, pa1, pa2, pa3); SBAR();
    NEGM_UPD(kbeg + j * KVBLK); SBAR(); qkt8_roll(pB0, pB1, negm, kb0 + SHM_K, qr); SBAR();
    SLOAD(SO, kbeg + (j + SDEPTH) * KVBLK); SBAR();
    BIASADD(pB0, pB1, kbeg + j * KVBLK); partialSM<false>(pB0, pB1, mC, alB);
    _Pragma("unroll") for (int r = 0; r < 16; ++r) pB1[r] = __builtin_amdgcn_exp2f(pB1[r]);
    SBAR(); pv_d0(o, vb0, pa0, pa1, pa2, pa3);
    }
    __syncthreads(); SWAIT(); SWRITE(0, SE);
    RESC(alB); __syncthreads();
    if constexpr (ORD == 0) {
    NEGM_UPD(kbeg + (j + 1) * KVBLK); SBAR();
    qkt8_fsm(pA0, pA1, negm, kb0, qr, pB0, pB1, alB, l_reg, pa0, pa1, pa2, pa3);
    if (SDEPTH == 1 || j + 3 < NT) SLOAD(SE, kbeg + (j + 1 + SDEPTH) * KVBLK); SBAR();
    BIASADD(pA0, pA1, kbeg + (j + 1) * KVBLK); SBAR();
    pv_psm(o, vb0 + (int)SHM_V, pa0, pa1, pa2, pa3, pA0, pA1, mC, alA);
    } else {
    finishSM<false>(pB0, pB1, alB, l_reg, pa0, pa1, pa2, pa3); SBAR();
    NEGM_UPD(kbeg + (j + 1) * KVBLK); SBAR(); qkt8_roll(pA0, pA1, negm, kb0, qr); SBAR();
    if (SDEPTH == 1 || j + 3 < NT) SLOAD(SE, kbeg + (j + 1 + SDEPTH) * KVBLK); SBAR();
    BIASADD(pA0, pA1, kbeg + (j + 1) * KVBLK); partialSM<false>(pA0, pA1, mC, alA);
    _Pragma("unroll") for (int r = 0; r < 16; ++r) pA1[r] = __builtin_amdgcn_exp2f(pA1[r]);
    SBAR(); pv_d0(o, vb0 + (int)SHM_V, pa0, pa1, pa2, pa3);
    }
    __syncthreads(); SWAIT(); SWRITE(1, SO);
    RESC(alA); __syncthreads();
  }
  } else {
  for (int j = 1; j + 1 < NT; j += 2) {
    if constexpr (ORD == 0) {
    NEGM_UPD(kbeg + j * KVBLK); SBAR(); QKT(pB0, pB1, SHM_K);
    finishSM(pA0, pA1, alA, l_reg, pa0, pa1, pa2, pa3); SBAR();
    SLOAD(SO, kbeg + (j + SDEPTH) * KVBLK); SBAR();
    pv_d0(o, vb0, pa0, pa1, pa2, pa3); BIASADD(pB0, pB1, kbeg + j * KVBLK); partialSM<false>(pB0, pB1, mC, alB);
    } else {
    finishSM(pA0, pA1, alA, l_reg, pa0, pa1, pa2, pa3); SBAR();
    NEGM_UPD(kbeg + j * KVBLK); SBAR(); QKT(pB0, pB1, SHM_K); SBAR();
    BIASADD(pB0, pB1, kbeg + j * KVBLK); partialSM<false>(pB0, pB1, mC, alB); SBAR();
    SLOAD(SO, kbeg + (j + SDEPTH) * KVBLK); SBAR();
    pv_d0(o, vb0, pa0, pa1, pa2, pa3);
    }
    __syncthreads(); SWAIT(); SWRITE(0, SE);
    RESC(alB); __syncthreads();
    if constexpr (ORD == 0) {
    NEGM_UPD(kbeg + (j + 1) * KVBLK); SBAR(); QKT(pA0, pA1, 0);
    finishSM(pB0, pB1, alB, l_reg, pa0, pa1, pa2, pa3); SBAR();
    if (SDEPTH == 1 || j + 3 < NT) SLOAD(SE, kbeg + (j + 1 + SDEPTH) * KVBLK); SBAR();
    pv_d0(o, vb0 + (int)SHM_V, pa0, pa1, pa2, pa3); BIASADD(pA0, pA1, kbeg + (j + 1) * KVBLK); partialSM<false>(pA0, pA1, mC, alA);
    } else {
    finishSM(pB0, pB1, alB, l_reg, pa0, pa1, pa2, pa3); SBAR();
    NEGM_UPD(kbeg + (j + 1) * KVBLK); SBAR(); QKT(pA0, pA1, 0); SBAR();
    BIASADD(pA0, pA1, kbeg + (j + 1) * KVBLK); partialSM<false>(pA0, pA1, mC, alA); SBAR();
    if (SDEPTH == 1 || j + 3 < NT) SLOAD(SE, kbeg + (j + 1 + SDEPTH) * KVBLK); SBAR();
    pv_d0(o, vb0 + (int)SHM_V, pa0, pa1, pa2, pa3);
    }
    __syncthreads(); SWAIT(); SWRITE(1, SO);
    RESC(alA); __syncthreads();
  }
  }
  NEGM_UPD(kbeg + (NT - 1) * KVBLK); SBAR(); QKT(pB0, pB1, SHM_K);
  finishSM<!SLICED>(pA0, pA1, alA, l_reg, pa0, pa1, pa2, pa3); SBAR();
  pv_d0(o, vb0, pa0, pa1, pa2, pa3); BIASADD(pB0, pB1, kbeg + (NT - 1) * KVBLK); partialSM<false>(pB0, pB1, mC, alB);
  __syncthreads(); RESC(alB);
  finishSM(pB0, pB1, alB, l_reg, pa0, pa1, pa2, pa3); SBAR();
  pv_d0(o, vb0 + (int)SHM_V, pa0, pa1, pa2, pa3);
  if (hi == 0) li_l[r32] = l_reg; asm volatile("s_waitcnt lgkmcnt(0)" ::: "memory");
  float rli[16];
#pragma unroll
  for (int r = 0; r < 16; ++r) rli[r] = __builtin_amdgcn_rcpf(li_l[crow(r, hi)]);
  if constexpr (EPI == 0) {
    bf16_t* Ow = Obf + (long)(wid * QBLK) * ldo;
#pragma unroll
    for (int r = 0; r < 16; ++r) { const int orow = crow(r, hi);
#pragma unroll
      for (int d0 = 0; d0 < 4; ++d0) Ow[(long)orow * ldo + d0 * 32 + r32] = (bf16_t)f2bf(o[d0][r] * rli[r]); }
  } else if constexpr (EPI == 1) {
    float* Tw = tmp + (wid * QBLK) * 128;
#pragma unroll
    for (int r = 0; r < 16; ++r) { const int orow = crow(r, hi);
#pragma unroll
      for (int d0 = 0; d0 < 4; ++d0) Tw[orow * 128 + d0 * 32 + r32] = o[d0][r] * rli[r]; }
  } else {
    const float* Tw = tmp + (wid * QBLK) * 128; bf16_t* Ow = Obf + (long)(wid * QBLK) * ldo;
    float sg[4];
#pragma unroll
    for (int d0 = 0; d0 < 4; ++d0) sg[d0] = subln[d0 * 32 + r32] * post;
#pragma unroll
    for (int r = 0; r < 16; ++r) { const int orow = crow(r, hi); float v[4]; float ss = 0.f;
#pragma unroll
      for (int d0 = 0; d0 < 4; ++d0) { v[d0] = Tw[orow * 128 + d0 * 32 + r32] - lam * (o[d0][r] * rli[r]); ss += v[d0] * v[d0]; }
      ss += swz_xor<1>(ss); ss += swz_xor<2>(ss); ss += swz_xor<4>(ss); ss += swz_xor<8>(ss); ss += swz_xor<16>(ss);
      const float rs = rsqrtf(ss * (1.0f / 128.0f) + EPS);
#pragma unroll
      for (int d0 = 0; d0 < 4; ++d0) Ow[(long)orow * ldo + d0 * 32 + r32] = (bf16_t)f2bf(v[d0] * rs * sg[d0]); }
  }
#undef KSWZ
#undef SLOAD
#undef SWRITE
#undef SWAIT
#undef RESC
#undef BIASADD
#undef NEGM_UPD
#undef QKT
}

template <int M>
__device__ __forceinline__ void qkt_map(f32x16& p0, f32x16& p1, const char* Ks, const char* qls, int r32, int hi) {
  p0 = f32x16{}; p1 = f32x16{};
#pragma unroll
  for (int d0 = 0; d0 < 4; ++d0) { const int cb = (M * 64 + d0 * 16 + hi * 8) * 2;
    bf16x8 b0 = *reinterpret_cast<const bf16x8*>(Ks + r32 * 256 + (cb ^ ((r32 & 15) << 4)));
    bf16x8 b1 = *reinterpret_cast<const bf16x8*>(Ks + (32 + r32) * 256 + (cb ^ ((r32 & 15) << 4)));
    bf16x8 q = *reinterpret_cast<const bf16x8*>(qls + (M * 4 + d0) * 1024);
    p0 = __builtin_amdgcn_mfma_f32_32x32x16_bf16(b0, q, p0, 0, 0, 0);
    p1 = __builtin_amdgcn_mfma_f32_32x32x16_bf16(b1, q, p1, 0, 0, 0);
    if (d0 == 1) SBAR(); }
}
template <int M>
__device__ __forceinline__ void qkt_map_roll(f32x16& p0, f32x16& p1, int kb, int qa) {
  p0 = f32x16{}; p1 = f32x16{};
  const int a0 = kb ^ ((M << 7) | (0 << 5)); const bf16x8 x0 = lds_rd128<0>(a0), y0 = lds_rd128<8192>(a0); const bf16x8 z0 = (M == 0) ? lds_rd128<0>(qa) : lds_rd128<4096>(qa);
  const int a1 = kb ^ ((M << 7) | (1 << 5)); const bf16x8 x1 = lds_rd128<0>(a1), y1 = lds_rd128<8192>(a1); const bf16x8 z1 = (M == 0) ? lds_rd128<1024>(qa) : lds_rd128<5120>(qa);
  asm volatile("s_waitcnt lgkmcnt(3)" ::: "memory"); SBAR();
  p0 = __builtin_amdgcn_mfma_f32_32x32x16_bf16(x0, z0, p0, 0, 0, 0); p1 = __builtin_amdgcn_mfma_f32_32x32x16_bf16(y0, z0, p1, 0, 0, 0);
  const int a2 = kb ^ ((M << 7) | (2 << 5)); const bf16x8 x2 = lds_rd128<0>(a2), y2 = lds_rd128<8192>(a2); const bf16x8 z2 = (M == 0) ? lds_rd128<2048>(qa) : lds_rd128<6144>(qa);
  asm volatile("s_waitcnt lgkmcnt(3)" ::: "memory"); SBAR();
  p0 = __builtin_amdgcn_mfma_f32_32x32x16_bf16(x1, z1, p0, 0, 0, 0); p1 = __builtin_amdgcn_mfma_f32_32x32x16_bf16(y1, z1, p1, 0, 0, 0);
  const int a3 = kb ^ ((M << 7) | (3 << 5)); const bf16x8 x3 = lds_rd128<0>(a3), y3 = lds_rd128<8192>(a3); const bf16x8 z3 = (M == 0) ? lds_rd128<3072>(qa) : lds_rd128<7168>(qa);
  asm volatile("s_waitcnt lgkmcnt(3)" ::: "memory"); SBAR();
  p0 = __builtin_amdgcn_mfma_f32_32x32x16_bf16(x2, z2, p0, 0, 0, 0); p1 = __builtin_amdgcn_mfma_f32_32x32x16_bf16(y2, z2, p1, 0, 0, 0);
  asm volatile("s_waitcnt lgkmcnt(0)" ::: "memory"); SBAR();
  p0 = __builtin_amdgcn_mfma_f32_32x32x16_bf16(x3, z3, p0, 0, 0, 0); p1 = __builtin_amdgcn_mfma_f32_32x32x16_bf16(y3, z3, p1, 0, 0, 0);
  SBAR();
}
__device__ __forceinline__ void softmax_tile(f32x16& p0, f32x16& p1, float& m, float& l, float& alpha, float cb, bf16x8& pa0, bf16x8& pa1, bf16x8& pa2, bf16x8& pa3) {
  float mx_[4] = {p0[0], p0[1], p0[2], p0[3]};
#pragma unroll
  for (int r = 4; r < 16; ++r) mx_[r & 3] = fmaxf(mx_[r & 3], p0[r]);
#pragma unroll
  for (int r = 0; r < 16; ++r) mx_[r & 3] = fmaxf(mx_[r & 3], p1[r]);
  float pmax = fmaxf(fmaxf(mx_[0], mx_[1]), fmaxf(mx_[2], mx_[3]));
  { auto rr = __builtin_amdgcn_permlane32_swap(__float_as_uint(pmax), __float_as_uint(pmax), false, false);
    pmax = fmaxf(__uint_as_float(rr[0]), __uint_as_float(rr[1])); }
  pmax += cb;
  float mn;
  if (__builtin_expect(__all(pmax - m <= THR2), 1)) { mn = m; alpha = 1.f; }
  else { mn = fmaxf(m, pmax); alpha = __builtin_amdgcn_exp2f(m - mn); m = mn; }
  const float off = cb - mn;
#pragma unroll
  for (int r = 0; r < 16; ++r) p0[r] = __builtin_amdgcn_exp2f(p0[r] + off);
#pragma unroll
  for (int r = 0; r < 16; ++r) p1[r] = __builtin_amdgcn_exp2f(p1[r] + off);
  float sm_[4] = {p0[0], p0[1], p0[2], p0[3]};
#pragma unroll
  for (int r = 4; r < 16; ++r) sm_[r & 3] += p0[r];
#pragma unroll
  for (int r = 0; r < 16; ++r) sm_[r & 3] += p1[r];
  float ps = (sm_[0] + sm_[1]) + (sm_[2] + sm_[3]);
  { auto rr = __builtin_amdgcn_permlane32_swap(__float_as_uint(ps), __float_as_uint(ps), false, false);
    ps = __uint_as_float(rr[0]) + __uint_as_float(rr[1]); }
  l = l * alpha + ps;
#define PK4(P, BASE, OUT) do { unsigned a0 = cvtpk(P[BASE + 0], P[BASE + 1]), a1 = cvtpk(P[BASE + 2], P[BASE + 3]);   \
    unsigned b0 = cvtpk(P[BASE + 4], P[BASE + 5]), b1 = cvtpk(P[BASE + 6], P[BASE + 7]);                              \
    auto r0 = __builtin_amdgcn_permlane32_swap(a0, b0, false, false); auto r1 = __builtin_amdgcn_permlane32_swap(a1, b1, false, false); \
    u32x4 w = {r0[0], r1[0], r0[1], r1[1]}; OUT = *reinterpret_cast<bf16x8*>(&w); } while (0)
  PK4(p0, 0, pa0); PK4(p0, 8, pa1); PK4(p1, 0, pa2); PK4(p1, 8, pa3);
#undef PK4
}
template <int D0> __device__ __forceinline__ void pv2_one(f32x16& oa, f32x16& ob, int vb, bf16x8 pa0, bf16x8 pa1, bf16x8 pa2, bf16x8 pa3, bf16x8 pb0, bf16x8 pb1, bf16x8 pb2, bf16x8 pb3) {
  const s16x4 l0 = tr_read<v_rd_off(D0, 0, 0)>(vb), h0 = tr_read<v_rd_off(D0, 0, 1)>(vb), l1 = tr_read<v_rd_off(D0, 1, 0)>(vb), h1 = tr_read<v_rd_off(D0, 1, 1)>(vb);
  const s16x4 l2 = tr_read<v_rd_off(D0, 2, 0)>(vb), h2 = tr_read<v_rd_off(D0, 2, 1)>(vb), l3 = tr_read<v_rd_off(D0, 3, 0)>(vb), h3 = tr_read<v_rd_off(D0, 3, 1)>(vb);
  asm volatile("s_waitcnt lgkmcnt(0)" ::: "memory"); SBAR();
#define PK(L, H) (bf16x8){L[0], L[1], L[2], L[3], H[0], H[1], H[2], H[3]}
  const bf16x8 v0 = PK(l0, h0), v1 = PK(l1, h1), v2 = PK(l2, h2), v3 = PK(l3, h3);
  oa = __builtin_amdgcn_mfma_f32_32x32x16_bf16(pa0, v0, oa, 0, 0, 0);
  ob = __builtin_amdgcn_mfma_f32_32x32x16_bf16(pb0, v0, ob, 0, 0, 0);
  oa = __builtin_amdgcn_mfma_f32_32x32x16_bf16(pa1, v1, oa, 0, 0, 0);
  ob = __builtin_amdgcn_mfma_f32_32x32x16_bf16(pb1, v1, ob, 0, 0, 0);
  oa = __builtin_amdgcn_mfma_f32_32x32x16_bf16(pa2, v2, oa, 0, 0, 0);
  ob = __builtin_amdgcn_mfma_f32_32x32x16_bf16(pb2, v2, ob, 0, 0, 0);
  oa = __builtin_amdgcn_mfma_f32_32x32x16_bf16(pa3, v3, oa, 0, 0, 0);
  ob = __builtin_amdgcn_mfma_f32_32x32x16_bf16(pb3, v3, ob, 0, 0, 0);
#undef PK
}
__device__ __forceinline__ void attn_unit_A2(const bf16_t* __restrict__ Qb, int ldq, const bf16_t* __restrict__ Kh, int ldk, const bf16_t* __restrict__ Vh, int ldv, int nkeys, int q0,
                                             const float* __restrict__ tblg, float cb_lo, float cb_hi, bf16_t* __restrict__ Obf, int ldo, float lam, const float* __restrict__ subln, float post, char* lds, const int wave0) {
  constexpr int ROWB = 256, SHM_K = 64 * ROWB;
  int tid_ = wave0 * 64 + lane_id_v();
  const int tid = tid_, wid = tid >> 6, lane = tid & 63, r32 = lane & 31, hi = lane >> 5;
  char* V_lds = lds; char* K_lds = lds + LDS_K_OFF;
  float* ws = (float*)(lds + LDS_WS_OFF) + wid * 64; float* sl0 = ws; float* sl1 = ws + 32;
  float* tbl_l = (float*)(lds + LDS_TBL_OFF);
  char* qls = lds + LDS_Q_OFF + wid * 8192 + lane * 16;
  __syncthreads();
  for (int i = tid; i < TBLN; i += 512) tbl_l[i] = tblg[i];
  { const bf16_t* Qw = Qb + (long)(wid * QBLK + r32) * ldq + hi * 8;
#pragma unroll
    for (int i = 0; i < 8; ++i) *reinterpret_cast<bf16x8*>(qls + i * 1024) = *reinterpret_cast<const bf16x8*>(Qw + i * 16); }
  float m0 = -1e30f, m1 = -1e30f, l0 = 0.f, l1 = 0.f; f32x16 oa[4] = {}, ob[4] = {};
  const int sr = tid >> 4, sc = (tid & 15) * 8, vst0 = v_st(sr, sc), vst1 = v_st(32 + sr, sc);
  const int vb0 = (int)(uintptr_t)V_lds + v_rd_base(lane);
  const int qlane = q0 + wid * QBLK + r32;
  bf16x8 vs0, vs1, ks0, ks1;
#define KSWZ(row, colB) ((row) * ROWB + ((colB) ^ (((row) & 15) << 4)))
#define SLOAD2(k0) do { vs0 = *reinterpret_cast<const bf16x8*>(&Vh[(long)((k0) + sr) * ldv + sc]); vs1 = *reinterpret_cast<const bf16x8*>(&Vh[(long)((k0) + 32 + sr) * ldv + sc]); \
    ks0 = *reinterpret_cast<const bf16x8*>(&Kh[(long)((k0) + sr) * ldk + sc]); ks1 = *reinterpret_cast<const bf16x8*>(&Kh[(long)((k0) + 32 + sr) * ldk + sc]); } while (0)
#define SWRITE2(b) do { *(bf16x8*)(V_lds + (b) * SHM_V + vst0) = vs0; *(bf16x8*)(V_lds + (b) * SHM_V + vst1) = vs1; \
    *(bf16x8*)(K_lds + (b) * SHM_K + KSWZ(sr, sc * 2)) = ks0; *(bf16x8*)(K_lds + (b) * SHM_K + KSWZ(32 + sr, sc * 2)) = ks1; } while (0)
#define RESC2(O, SL, a) do { if (__any((a) < 1.f)) { if (hi == 0) SL[r32] = (a); asm volatile("s_waitcnt lgkmcnt(0)" ::: "memory"); \
    _Pragma("unroll") for (int d = 0; d < 4; ++d) _Pragma("unroll") for (int r = 0; r < 16; ++r) O[d][r] *= SL[crow(r, hi)]; } } while (0)
  const int NT = nkeys / KVBLK;
  const int kbA = (int)(uintptr_t)K_lds + r32 * 256 + (((r32 & 15) << 4) ^ (hi << 4)), qaA = (int)(uintptr_t)qls;
  SLOAD2(0); asm volatile("s_waitcnt vmcnt(0)" ::: "memory"); SWRITE2(0); __syncthreads();
  for (int j = 0; j < NT; ++j) {
    const int b = j & 1, kt0 = j * KVBLK;
    const int dlo_ = kt0 - q0 - 255, dhi_ = kt0 + 63 - q0;
    float cb = 0.f; const bool nearb = !(dlo_ >= 1024) && !(dhi_ <= -1024);
    if (dlo_ >= 1024) cb = cb_hi; else if (dhi_ <= -1024) cb = cb_lo;
    const float* tb_ = tbl_l + (kt0 - qlane + TOFF + 4 * hi);
    f32x16 s0, s1; bf16x8 pa0, pa1, pa2, pa3; float al0, al1;
    const int vb = vb0 + b * (int)SHM_V;
    qkt_map_roll<0>(s0, s1, kbA + b * SHM_K, qaA);
    SBAR();
    if (nearb) {
#pragma unroll
      for (int r = 0; r < 8; ++r) { s0[r] += tb_[(r & 3) + 8 * (r >> 2)]; s1[r] += tb_[32 + (r & 3) + 8 * (r >> 2)]; }
      SBAR();
#pragma unroll
      for (int r = 8; r < 16; ++r) { s0[r] += tb_[(r & 3) + 8 * (r >> 2)]; s1[r] += tb_[32 + (r & 3) + 8 * (r >> 2)]; } }
    SBAR();
    softmax_tile(s0, s1, m0, l0, al0, cb, pa0, pa1, pa2, pa3);
    RESC2(oa, sl0, al0);
    SBAR();
    pv_d0(oa, vb, pa0, pa1, pa2, pa3);
    SBAR();
    qkt_map_roll<1>(s0, s1, kbA + b * SHM_K, qaA);
    SBAR();
    if (nearb) {
#pragma unroll
      for (int r = 0; r < 8; ++r) { s0[r] += tb_[(r & 3) + 8 * (r >> 2)]; s1[r] += tb_[32 + (r & 3) + 8 * (r >> 2)]; }
      SBAR();
#pragma unroll
      for (int r = 8; r < 16; ++r) { s0[r] += tb_[(r & 3) + 8 * (r >> 2)]; s1[r] += tb_[32 + (r & 3) + 8 * (r >> 2)]; } }
    SBAR();
    softmax_tile(s0, s1, m1, l1, al1, cb, pa0, pa1, pa2, pa3);
    RESC2(ob, sl1, al1);
    SBAR();
    if (j + 1 < NT) SLOAD2(kt0 + KVBLK);
    SBAR();
    pv_d0(ob, vb, pa0, pa1, pa2, pa3);
    if (j + 1 < NT) { asm volatile("s_waitcnt vmcnt(0)" ::: "memory"); SWRITE2(b ^ 1); }
    __syncthreads();
  }
  const int lane_e = lane_id_v(), r32e = lane_e & 31, hie = lane_e >> 5;
  if (hie == 0) { sl0[r32e] = l0; sl1[r32e] = l1; } asm volatile("s_waitcnt lgkmcnt(0)" ::: "memory");
  bf16_t* Ow = Obf + (long)(wid * QBLK) * ldo;
  float sg[4];
#pragma unroll
  for (int d0 = 0; d0 < 4; ++d0) sg[d0] = subln[d0 * 32 + r32e] * post;
#pragma unroll
  for (int r = 0; r < 16; ++r) { const int orow = crow(r, hie); const float ra = __builtin_amdgcn_rcpf(sl0[orow]), rb = lam * __builtin_amdgcn_rcpf(sl1[orow]); float v[4]; float ss = 0.f;
#pragma unroll
    for (int d0 = 0; d0 < 4; ++d0) { v[d0] = oa[d0][r] * ra - ob[d0][r] * rb; ss += v[d0] * v[d0]; }
    ss += swz_xor<1>(ss); ss += swz_xor<2>(ss); ss += swz_xor<4>(ss); ss += swz_xor<8>(ss); ss += swz_xor<16>(ss);
    const float rs = rsqrtf(ss * (1.0f / 128.0f) + EPS);
#pragma unroll
    for (int d0 = 0; d0 < 4; ++d0) Ow[(long)orow * ldo + d0 * 32 + r32e] = (bf16_t)f2bf(v[d0] * rs * sg[d0]); }
#undef KSWZ
#undef SLOAD2
#undef SWRITE2
#undef RESC2
}
}

__device__ __forceinline__ void transpose_item(const float* __restrict__ W, int K, int N, bf16_t* __restrict__ WT, int k0, int n0, int drow0, float wscale, LAS float* scr, int lane) {
    float tv[32];
#pragma unroll
    for (int i = 0; i < 32; ++i) { const int kk = 2 * i + (lane >> 5); tv[i] = W[(size_t)(k0 + kk) * N + n0 + (lane & 31)]; }
#pragma unroll
    for (int i = 0; i < 32; ++i) { const int kk = 2 * i + (lane >> 5); scr[kk * 33 + (lane & 31)] = tv[i] * wscale; }
    asm volatile("s_waitcnt lgkmcnt(0)" ::: "memory");
    const int c = lane & 7;
#pragma unroll
    for (int j = 0; j < 4; ++j) { const int n = (lane >> 3) + 8 * j; const LAS float* s = scr + (8 * c) * 33 + n;
        u32x4 o; o.x = pk2(s[0 * 33], s[1 * 33]); o.y = pk2(s[2 * 33], s[3 * 33]); o.z = pk2(s[4 * 33], s[5 * 33]); o.w = pk2(s[6 * 33], s[7 * 33]);
        *(u32x4*)(WT + (size_t)(drow0 + n) * K + k0 + 8 * c) = o; }
    asm volatile("s_waitcnt lgkmcnt(0)" ::: "memory");
}
constexpr float QS_A = 0.125f * 1.4426950408889634f, QS_B = 0.07216878364870322f * 1.4426950408889634f, QS_CD = 0.08838834764831845f * 1.4426950408889634f;
template <int MODE>
__device__ __forceinline__ void transpose_matrix(const float* __restrict__ W, int K, int N, bf16_t* __restrict__ WT, LAS float* scr, int lane, int gw, int NGW) {
    const int nblk = N / 32, nitems = (K / 64) * nblk;
    for (int it = gw; it < nitems; it += NGW) { const int kb = it / nblk, nb = it % nblk, n0 = 32 * nb; int drow0 = n0;
        if (MODE == 1) { const int c = n0 < FF ? n0 : n0 - FF; drow0 = 256 * (c / 128) + (c % 128) + (n0 < FF ? 0 : 128); }
        float wscale = 1.0f;
        if (MODE == 2) { if (n0 < C_AK) wscale = QS_A; else if (n0 >= C_DQ && n0 < C_DK) wscale = QS_CD; }
        if (MODE == 3) wscale = QS_B;
        transpose_item(W, K, N, WT, 64 * kb, n0, drow0, wscale, scr, lane); }
}
__device__ __forceinline__ int t5_bucket(int d) {
    const int ret = d > 0 ? 16 : 0; const int n = d < 0 ? -d : d;
    if (n < 8) return ret + n;
    const float v = logf((float)n / 8.0f) / 4.852030263919617f * 8.0f;
    int large = 8 + (int)v; if (large > 15) large = 15;
    return ret + large;
}
__device__ __forceinline__ void norm_row(const float* __restrict__ xrow, const float* __restrict__ g, bf16_t* __restrict__ hrow, int lane) {
    f32x4 v[8]; float ss = 0.f;
#pragma unroll
    for (int j = 0; j < 8; ++j) { v[j] = ((const f32x4*)xrow)[lane + 64 * j]; ss += (v[j].x * v[j].x + v[j].y * v[j].y) + (v[j].z * v[j].z + v[j].w * v[j].w); }
    const float rs = rsqrtf(wave_sum(ss) * (1.0f / DM) + EPS);
#pragma unroll
    for (int j = 0; j < 8; ++j) { const f32x4 gg = ((const f32x4*)g)[lane + 64 * j];
        u32x2 w; w.x = pk2(v[j].x * rs * gg.x, v[j].y * rs * gg.y); w.y = pk2(v[j].z * rs * gg.z, v[j].w * rs * gg.w); ((u32x2*)hrow)[lane + 64 * j] = w; }
}
template <int NR>
__device__ __forceinline__ void norm_add_rows(const bf16_t* __restrict__ Yb, const float* xi, float* xo, const float* __restrict__ gpost,
                                              const float* __restrict__ gpre, bf16_t* __restrict__ Hb, int row0, int rstride, int lane) {
    u32x2 yb[NR][8]; f32x4 v[NR][8];
#pragma unroll
    for (int q = 0; q < NR; ++q) { const size_t ro = (size_t)(row0 + q * rstride) * DM;
#pragma unroll
        for (int j = 0; j < 8; ++j) yb[q][j] = ((const u32x2*)(Yb + ro))[lane + 64 * j];
#pragma unroll
        for (int j = 0; j < 8; ++j) v[q][j] = ((const f32x4*)(xi + ro))[lane + 64 * j]; }
    f32x4 gp[8];
#pragma unroll
    for (int j = 0; j < 8; ++j) gp[j] = ((const f32x4*)gpost)[lane + 64 * j];
#pragma unroll
    for (int q = 0; q < NR; ++q) { const size_t ro = (size_t)(row0 + q * rstride) * DM;
        f32x4 y[8]; float ss = 0.f;
#pragma unroll
        for (int j = 0; j < 8; ++j) { y[j].x = __uint_as_float(yb[q][j].x << 16); y[j].y = __uint_as_float(yb[q][j].x & 0xffff0000u); y[j].z = __uint_as_float(yb[q][j].y << 16); y[j].w = __uint_as_float(yb[q][j].y & 0xffff0000u);
            ss += (y[j].x * y[j].x + y[j].y * y[j].y) + (y[j].z * y[j].z + y[j].w * y[j].w); }
        const float rs = rsqrtf(wave_sum(ss) * (1.0f / DM) + EPS);
        float ss2 = 0.f;
#pragma unroll
        for (int j = 0; j < 8; ++j) { v[q][j] = v[q][j] + y[j] * rs * gp[j]; ((f32x4*)(xo + ro))[lane + 64 * j] = v[q][j];
            ss2 += (v[q][j].x * v[q][j].x + v[q][j].y * v[q][j].y) + (v[q][j].z * v[q][j].z + v[q][j].w * v[q][j].w); }
        if (gpre) {
            const float rs2 = rsqrtf(wave_sum(ss2) * (1.0f / DM) + EPS);
#pragma unroll
            for (int j = 0; j < 8; ++j) { const f32x4 gg = ((const f32x4*)gpre)[lane + 64 * j];
                u32x2 w; w.x = pk2(v[q][j].x * rs2 * gg.x, v[q][j].y * rs2 * gg.y); w.y = pk2(v[q][j].z * rs2 * gg.z, v[q][j].w * rs2 * gg.w); ((u32x2*)(Hb + ro))[lane + 64 * j] = w; }
        }
    }
}

__device__ __forceinline__ void head_norm_axial(const bf16_t* __restrict__ src, bf16_t* __restrict__ dst, const float* __restrict__ g, const float* __restrict__ COS, const float* __restrict__ SIN, int row, int t, float oscale) {
    float v[8];
#pragma unroll
    for (int s = 0; s < 4; ++s) { const unsigned w = *(const unsigned*)(src + 32 * s + 2 * t); v[2 * s] = bf2f((unsigned short)(w & 0xffff)); v[2 * s + 1] = bf2f((unsigned short)(w >> 16)); }
    float ss = 0.f;
#pragma unroll
    for (int i = 0; i < 8; ++i) ss += v[i] * v[i];
    ss += swz_xor<1>(ss); ss += swz_xor<2>(ss); ss += swz_xor<4>(ss); ss += swz_xor<8>(ss);
    const float rs = rsqrtf(ss * (1.0f / 128.0f) + EPS);
#pragma unroll
    for (int s = 0; s < 4; ++s) { v[2 * s] *= rs * oscale * g[32 * s + 2 * t]; v[2 * s + 1] *= rs * oscale * g[32 * s + 2 * t + 1]; }
    const int pr = row >> 6, pc = row & 63;
    float o[8];
#pragma unroll
    for (int e = 0; e < 2; ++e) { const int i = 2 * t + e;
        { const float c = COS[pr * 32 + i], s = SIN[pr * 32 + i]; const float x1 = v[e], x2 = v[2 + e]; o[e] = x1 * c - x2 * s; o[2 + e] = x2 * c + x1 * s; }
        { const float c = COS[pc * 32 + i], s = SIN[pc * 32 + i]; const float x1 = v[4 + e], x2 = v[6 + e]; o[4 + e] = x1 * c - x2 * s; o[6 + e] = x2 * c + x1 * s; } }
#pragma unroll
    for (int s = 0; s < 4; ++s) *(unsigned*)(dst + 32 * s + 2 * t) = pk2(o[2 * s], o[2 * s + 1]);
}


#define XB_TMO      128
#define XB_XCNT(j)  (256  + 64 * (j))
#define XB_XSUB(j)  (1280 + 64 * (j))
#define XB_XGEN(j)  (2304 + 64 * (j))
#define XB_TOP      3328
#define XB_TOPGEN   3392
#define XCD_BAR_WORDS 3456
#define XB_SPIN_CAP (1u << 18)
__device__ __forceinline__ unsigned xb_ld(unsigned* p)              { return __hip_atomic_load(p, __ATOMIC_RELAXED, __HIP_MEMORY_SCOPE_AGENT); }
__device__ __forceinline__ unsigned xb_add(unsigned* p, unsigned v) { return __hip_atomic_fetch_add(p, v, __ATOMIC_RELAXED, __HIP_MEMORY_SCOPE_AGENT); }
__device__ __forceinline__ unsigned xb_xcc_id() { return (unsigned)__builtin_amdgcn_s_getreg((3 << 11) | 20) & 0xFu; }
#define XB_SPIN(cond, bar) do { unsigned _sp = 0; while (cond) { __builtin_amdgcn_s_sleep(1); \
    if ((++_sp & 255u) == 0u) { if (xb_ld(&(bar)[XB_TMO])) break; if (_sp > XB_SPIN_CAP) { atomicAdd(&(bar)[XB_TMO], 1u); break; } } } } while (0)
__device__ __forceinline__ void xcd_barrier_complete(unsigned* bar, unsigned x, unsigned& nloc, unsigned& nx) {
    const unsigned G = gridDim.x * gridDim.y * gridDim.z;
    unsigned sum, cnt, mine, sp = 0u;
    for (;;) {
        sum = 0u; cnt = 0u; mine = 0u;
#pragma unroll
        for (unsigned j = 0; j < 16; ++j) { const unsigned c = xb_ld(&bar[XB_XCNT(j)]); sum += c; cnt += (c > 0u) ? 1u : 0u; mine = (j == x) ? c : mine; }
        if (sum == G) break;
        __builtin_amdgcn_s_sleep(1);
        if ((++sp & 255u) == 0u) { if (xb_ld(&bar[XB_TMO])) break; if (sp > XB_SPIN_CAP) { atomicAdd(&bar[XB_TMO], 1u); break; } }
    }
    nloc = mine > 0u ? mine : 1u; nx = cnt > 0u ? cnt : 1u;
}
__device__ __forceinline__ void xcd_barrier(unsigned* bar, volatile LAS unsigned* st, bool leader) {
    asm volatile("s_waitcnt vmcnt(0)" ::: "memory");
    __syncthreads();
    if (leader) {
        const unsigned x = xb_xcc_id();
        __builtin_amdgcn_s_waitcnt(0);
        unsigned nloc = st[0], nx = st[1];
        if (nloc == 0u) { xcd_barrier_complete(bar, x, nloc, nx); st[0] = nloc; st[1] = nx; }
        const unsigned old = xb_add(&bar[XB_XSUB(x)], 1u);
        const unsigned gen = old / nloc;
        if (old + 1u == (gen + 1u) * nloc) {
            __builtin_amdgcn_fence(__ATOMIC_RELEASE, "agent");
            asm volatile("s_waitcnt vmcnt(0)" ::: "memory");
            const unsigned og = xb_add(&bar[XB_TOP], 1u);
            const unsigned tg = og / nx;
            if (og + 1u == (tg + 1u) * nx) xb_add(&bar[XB_TOPGEN], 1u);
            else XB_SPIN(xb_ld(&bar[XB_TOPGEN]) == tg, bar);
            __builtin_amdgcn_fence(__ATOMIC_ACQUIRE, "agent");
            xb_add(&bar[XB_XGEN(x)], 1u);
            asm volatile("s_waitcnt vmcnt(0)" ::: "memory");
        } else {
            XB_SPIN(xb_ld(&bar[XB_XGEN(x)]) == gen, bar);
            __builtin_amdgcn_fence(__ATOMIC_ACQUIRE, "agent");
            asm volatile("s_waitcnt vmcnt(0)" ::: "memory");
        }
    }
    __syncthreads();
}

struct Args { const float* in[18]; float* out; unsigned char* wsp; int ph_lo, ph_hi; };

__global__ void __launch_bounds__(512, 2) mega_fwd(Args args) {
    extern __shared__ __attribute__((aligned(16))) unsigned char lds[];
    const int G = gridDim.x, bid = blockIdx.x, NGW = G * 8;
    const int wave0 = __builtin_amdgcn_readfirstlane((int)threadIdx.x >> 6);
    typedef const __attribute__((address_space(4))) Args* KArgP;
    LAS unsigned char* ldsl = (LAS unsigned char*)lds;
#define x_in (kap->in[0])
#define rel_bias (kap->in[1])
#define norm_mix_pre (kap->in[2])
#define norm_mix_post (kap->in[3])
#define norm_ffn_pre (kap->in[4])
#define norm_ffn_post (kap->in[5])
#define w_in (kap->in[6])
#define diff_lambda (kap->in[7])
#define diff_subln (kap->in[8])
#define mla_q_norm (kap->in[9])
#define mla_kv_norm (kap->in[10])
#define mla_w_uq (kap->in[11])
#define mla_w_ukv (kap->in[12])
#define gqa_q_norm (kap->in[13])
#define gqa_k_norm (kap->in[14])
#define w_out (kap->in[15])
#define w_gate_up (kap->in[16])
#define w_down (kap->in[17])
#define xres (kap->out)
#define ws (kap->wsp)
#define PAR ((float*)(ws + WS_PAR))
#define TBLA ((float*)(ws + WS_TBLA))
#define TBLD ((float*)(ws + WS_TBLD))
#define COS ((float*)(ws + WS_COS))
#define SIN ((float*)(ws + WS_SIN))
#define H ((bf16_t*)(ws + WS_H))
#define PROJ ((bf16_t*)(ws + WS_PROJ))
#define CQN ((bf16_t*)(ws + WS_CQN))
#define CKVN ((bf16_t*)(ws + WS_CKVN))
#define KPE ((bf16_t*)(ws + WS_KPE))
#define QC ((bf16_t*)(ws + WS_QC))
#define KC ((bf16_t*)(ws + WS_KC))
#define QB ((bf16_t*)(ws + WS_QB))
#define KVB ((bf16_t*)(ws + WS_KVB))
#define MIX ((bf16_t*)(ws + WS_MIX))
#define Y ((bf16_t*)(ws + WS_Y))
#define HID ((bf16_t*)(ws + WS_HID))
#define TMP ((float*)(ws + WS_TMP))
#define wl (ws + WS_W + (size_t)l * LW)

    volatile LAS unsigned* bst = (volatile LAS unsigned*)(ldsl + LDS_ST_OFF);
    { const bool leader0 = (wave0 == 0) && (lane_id_v() == 0);
      if (leader0) { bst[0] = 0u; bst[1] = 0u; }
      __syncthreads();
      if (leader0 && !MK_MULTI) { KArgP kap0 = (KArgP)__builtin_amdgcn_kernarg_segment_ptr(); (void)xb_add(&((unsigned*)(kap0->wsp + WS_BAR))[XB_XCNT(xb_xcc_id())], 1u); } }
    const int lo = args.ph_lo, hi_ph = args.ph_hi; int ph = 0;
#define PH_BEGIN if (ph >= lo && ph < hi_ph) { KArgP kap = (KArgP)__builtin_amdgcn_kernarg_segment_ptr(); asm volatile("" : "+s"(kap)); \
    int tid_ = wave0 * 64 + lane_id_v(); const int tid = tid_, lane = tid & 63, wave = __builtin_amdgcn_readfirstlane(tid >> 6), gw = bid * 8 + wave; (void)lane; (void)gw;
#define PH_END } if (ph >= lo && ph + 1 < hi_ph) { if (ph == 0) { cg::this_grid().sync(); } else { KArgP kapb = (KArgP)__builtin_amdgcn_kernarg_segment_ptr(); asm volatile("" : "+s"(kapb)); \
      xcd_barrier((unsigned*)(kapb->wsp + WS_BAR), bst, (wave0 == 0) && (lane_id_v() == 0)); } } ++ph;

    PH_BEGIN
    if PHON(0) {
        LAS float* scr = (LAS float*)(ldsl + wave * 16384);
        for (int l = 0; l < DEPTH; ++l) {
            transpose_matrix<2>(w_in + (size_t)l * DM * NPROJ, DM, NPROJ, (bf16_t*)(wl + W_IN), scr, lane, gw, NGW);
            transpose_matrix<3>(mla_w_uq + (size_t)l * 512 * 768, 512, 768, (bf16_t*)(wl + W_UQ), scr, lane, gw, NGW);
            transpose_matrix<0>(mla_w_ukv + (size_t)l * 256 * 1024, 256, 1024, (bf16_t*)(wl + W_UKV), scr, lane, gw, NGW);
            transpose_matrix<0>(w_out + (size_t)l * DM * DM, DM, DM, (bf16_t*)(wl + W_OUT), scr, lane, gw, NGW);
            transpose_matrix<1>(w_gate_up + (size_t)l * DM * NGU, DM, NGU, (bf16_t*)(wl + W_GU), scr, lane, gw, NGW);
            transpose_matrix<0>(w_down + (size_t)l * FF * DM, FF, DM, (bf16_t*)(wl + W_D), scr, lane, gw, NGW);
            { u32x4* z = (u32x4*)((bf16_t*)(wl + W_IN) + (size_t)NPROJ * DM); const int n16 = (LDP - NPROJ) * DM * 2 / 16;
              for (int i = bid * 512 + tid; i < n16; i += G * 512) z[i] = (u32x4){0u, 0u, 0u, 0u}; }
        }
        const int gt = bid * 512 + tid, NT_ = G * 512;
        for (int i = gt; i < 4 * TBLN; i += NT_) { const int h = i / TBLN, d = (i % TBLN) - TOFF; const int b = t5_bucket(d);
            TBLA[i] = rel_bias[b * 8 + h] * 1.4426950408889634f;
            const int n = d < 0 ? -d : d; int mult = (n <= 64 ? 1 : 0) + (((n & 3) == 0 && n <= 256) ? 1 : 0) + (((n & 15) == 0 && n <= 1024) ? 1 : 0);
            TBLD[i] = mult ? (rel_bias[b * 8 + 4 + h] + logf((float)mult)) * 1.4426950408889634f : -1e30f; }
        for (int i = gt; i < S * 32; i += NT_) { const int pos = i >> 5, f = i & 31;
            const float inv = (float)pow(10000.0, -(double)(2 * f) / 64.0); const float ang = (float)pos * inv;
            COS[i] = (float)cos((double)ang); SIN[i] = (float)sin((double)ang); }
        if (bid == 0 && tid < DEPTH) { const float* lv = diff_lambda + tid * 256; float s1 = 0.f, s2 = 0.f;
            for (int i = 0; i < 64; ++i) { s1 += lv[i] * lv[64 + i]; s2 += lv[128 + i] * lv[192 + i]; }
            const float lam_init = 0.8f - 0.6f * expf(-0.3f * (float)tid);
            PAR[tid] = expf(s1) - expf(s2) + lam_init; PAR[4 + tid] = lam_init; }
        for (int row = gw; row < S; row += NGW) norm_row(x_in + (size_t)row * DM, norm_mix_pre, H + (size_t)row * DM, lane);
    }
    PH_END

    for (int l = 0; l < DEPTH; ++l) {
        PH_BEGIN
        if PHON(1) for (int rep_ = 0; rep_ < MK_DUP_GEMM; ++rep_) { pg8::Gemm g{H, (const bf16_t*)(wl + W_IN), S, LDP, DM}; pg8::StaticOrder So; So.init(S, LDP, G, bid);
          pg8::EpiBf16 E{PROJ, LDP};
          pg8::gemm_phase<pg8::EpiBf16, pg8::StaticOrder, true, true>(ldsl, g, So, E, wave0); }
        PH_END
        PH_BEGIN
        if PHON(2) for (int row = gw; row < S; row += NGW) {
            const bf16_t* pr = PROJ + (size_t)row * LDP;
            { const u32x4 raw = *(const u32x4*)(pr + C_BCQ + lane * 8); float v[8];
              v[0] = __uint_as_float(raw.x << 16); v[1] = __uint_as_float(raw.x & 0xffff0000u); v[2] = __uint_as_float(raw.y << 16); v[3] = __uint_as_float(raw.y & 0xffff0000u);
              v[4] = __uint_as_float(raw.z << 16); v[5] = __uint_as_float(raw.z & 0xffff0000u); v[6] = __uint_as_float(raw.w << 16); v[7] = __uint_as_float(raw.w & 0xffff0000u);
              float ss = 0.f;
#pragma unroll
              for (int i = 0; i < 8; ++i) ss += v[i] * v[i];
              const float rs = rsqrtf(wave_sum(ss) * (1.0f / 512.0f) + EPS);
              const f32x4 g0 = *(const f32x4*)(mla_q_norm + l * 512 + lane * 8), g1 = *(const f32x4*)(mla_q_norm + l * 512 + lane * 8 + 4);
              u32x4 w; w.x = pk2(v[0] * rs * g0.x, v[1] * rs * g0.y); w.y = pk2(v[2] * rs * g0.z, v[3] * rs * g0.w); w.z = pk2(v[4] * rs * g1.x, v[5] * rs * g1.y); w.w = pk2(v[6] * rs * g1.z, v[7] * rs * g1.w);
              *(u32x4*)(CQN + (size_t)row * 512 + lane * 8) = w; }
            { const u32x2 raw = *(const u32x2*)(pr + C_BCKV + lane * 4); float v[4];
              v[0] = __uint_as_float(raw.x << 16); v[1] = __uint_as_float(raw.x & 0xffff0000u); v[2] = __uint_as_float(raw.y << 16); v[3] = __uint_as_float(raw.y & 0xffff0000u);
              float ss = v[0] * v[0] + v[1] * v[1] + v[2] * v[2] + v[3] * v[3];
              const float rs = rsqrtf(wave_sum(ss) * (1.0f / 256.0f) + EPS);
              const f32x4 g0 = *(const f32x4*)(mla_kv_norm + l * 256 + lane * 4);
              u32x2 w; w.x = pk2(v[0] * rs * g0.x, v[1] * rs * g0.y); w.y = pk2(v[2] * rs * g0.z, v[3] * rs * g0.w);
              *(u32x2*)(CKVN + (size_t)row * 256 + lane * 4) = w; }
            if (lane < 32) { const float x1 = bf2f(pr[C_BKPE + lane]), x2 = bf2f(pr[C_BKPE + 32 + lane]); const float c = COS[row * 32 + lane], s = SIN[row * 32 + lane];
              KPE[(size_t)row * 64 + lane] = (bf16_t)f2bf(x1 * c - x2 * s); KPE[(size_t)row * 64 + 32 + lane] = (bf16_t)f2bf(x2 * c + x1 * s); }
            { const int hd = lane >> 4, t = lane & 15;
              head_norm_axial(pr + C_CQ + hd * 128, QC + (size_t)row * 512 + hd * 128, gqa_q_norm + l * 128, COS, SIN, row, t, QS_CD);
              const int hk = hd & 1;
              if (lane < 32) head_norm_axial(pr + C_CK + hk * 128, KC + (size_t)row * 256 + hk * 128, gqa_k_norm + l * 128, COS, SIN, row, t, 1.0f); }
        }
        PH_END
        PH_BEGIN
        if PHON(3) { pg8::Gemm g{CQN, (const bf16_t*)(wl + W_UQ), S, 768, 512}; pg8::StaticOrder So; So.init(S, 768, G, bid);
          pg8::EpiBf16 E{QB, 768};
          pg8::gemm_phase<pg8::EpiBf16, pg8::StaticOrder, true, true>(ldsl, g, So, E, wave0); }
        if PHON(4) { pg8::Gemm g{CKVN, (const bf16_t*)(wl + W_UKV), S, 1024, 256}; pg8::StaticOrder So; So.init(S, 1024, G, bid);
          pg8::EpiBf16 E{KVB, 1024};
          pg8::gemm_phase<pg8::EpiBf16, pg8::StaticOrder, true, true>(ldsl, g, So, E, wave0); }
        PH_END
        PH_BEGIN
        for (int rep_ = 0; rep_ < MK_DUP_ATT; ++rep_) {
            const float lam = __int_as_float(__builtin_amdgcn_readfirstlane(__float_as_int(PAR[l]))), lam_init = __int_as_float(__builtin_amdgcn_readfirstlane(__float_as_int(PAR[4 + l])));
            const float L2E = 1.4426950408889634f;
            if PHON(6) for (int u = bid; u < 256; u += G) { const int xq = u & 7, hd = xq & 3, qb = (u >> 3) + 32 * (xq >> 2), q0 = qb * 256;
                { const float cb_lo = rel_bias[15 * 8 + hd] * L2E, cb_hi = rel_bias[31 * 8 + hd] * L2E;
                  att::attn_unit_A2(PROJ + (size_t)q0 * LDP + C_AQ + hd * 128, LDP, PROJ + C_AK + hd * 128, LDP, PROJ + C_AV + hd * 128, LDP, S, q0,
                                    TBLA + hd * TBLN, cb_lo, cb_hi, MIX + (size_t)q0 * DM + hd * 128, DM, lam, diff_subln + l * 128, 1.0f - lam_init, (char*)lds, wave0); }
            }
            if PHON(7) for (int u = bid; u < 256; u += G) { const int xq = u & 7, hd = xq & 3, qb = (u >> 3) + 32 * (xq >> 2), q0 = qb * 256;
                { const float sc = 0.07216878364870322f;
                  if (wave0 < 4) att::attn_unit<12, 0, 0, 1, 8, 1, 0>(QB + (size_t)q0 * 768 + hd * 192, 768, KVB + hd * 256, 1024, KPE, 64, KVB + hd * 256 + 128, 1024,
                                            0, S, q0, nullptr, 0.f, 0.f, MIX + (size_t)q0 * DM + 512 + hd * 128, DM, nullptr, 0.f, nullptr, 0.f, (char*)lds, wave0, COS, SIN); else att::attn_unit<12, 0, 0, 1, 8, 1, 1>(QB + (size_t)q0 * 768 + hd * 192, 768, KVB + hd * 256, 1024, KPE, 64, KVB + hd * 256 + 128, 1024,
                                            0, S, q0, nullptr, 0.f, 0.f, MIX + (size_t)q0 * DM + 512 + hd * 128, DM, nullptr, 0.f, nullptr, 0.f, (char*)lds, wave0, COS, SIN); }
            }
            if (wave0 < 4) __builtin_amdgcn_s_setprio(1);
            if PHON(8) for (int u = bid; u < 256; u += G) { const int xq = u & 7, hd = xq & 3, qb = (u >> 3) + 32 * (xq >> 2), q0 = qb * 256;
                { const float sc = 0.08838834764831845f;
                  if (wave0 < 4) att::attn_unit<8, 0, 0, 1, 0, 0, 0>(QC + (size_t)q0 * 512 + hd * 128, 512, KC + (hd >> 1) * 128, 256, nullptr, 0, PROJ + C_CV + (hd >> 1) * 128, LDP,
                                           0, S, q0, nullptr, 0.f, 0.f, MIX + (size_t)q0 * DM + 1024 + hd * 128, DM, nullptr, 0.f, nullptr, 0.f, (char*)lds, wave0); else att::attn_unit<8, 0, 0, 1, 0, 0, 1>(QC + (size_t)q0 * 512 + hd * 128, 512, KC + (hd >> 1) * 128, 256, nullptr, 0, PROJ + C_CV + (hd >> 1) * 128, LDP,
                                           0, S, q0, nullptr, 0.f, 0.f, MIX + (size_t)q0 * DM + 1024 + hd * 128, DM, nullptr, 0.f, nullptr, 0.f, (char*)lds, wave0); }
            }
            __builtin_amdgcn_s_setprio(0);
            if PHON(9) for (int u = bid; u < 256; u += G) { const int xq = u & 7, hd = xq & 3, qb = (u >> 3) + 32 * (xq >> 2), q0 = qb * 256;
                { const float sc = 0.08838834764831845f;
                  const int kb = q0 - 1024 < 0 ? 0 : q0 - 1024, ke = q0 + 256 + 1024 > S ? S : q0 + 256 + 1024;
                  att::attn_unit<8, 1, 0, 1>(PROJ + (size_t)q0 * LDP + C_DQ + hd * 128, LDP, PROJ + C_DK + hd * 128, LDP, nullptr, 0, PROJ + C_DV + hd * 128, LDP,
                                           kb, ke - kb, q0, TBLD + hd * TBLN, 0.f, 0.f, MIX + (size_t)q0 * DM + 1536 + hd * 128, DM, nullptr, 0.f, nullptr, 0.f, (char*)lds, wave0); }
            }
            __syncthreads();
        }
        PH_END
        PH_BEGIN
        if PHON(10) for (int rep_ = 0; rep_ < MK_DUP_GEMM; ++rep_) { pg8::Gemm g{MIX, (const bf16_t*)(wl + W_OUT), S, DM, DM}; pg8::StaticOrder So; So.init(S, DM, G, bid);
          pg8::EpiBf16 E{Y, DM};
          pg8::gemm_phase<pg8::EpiBf16, pg8::StaticOrder, true, true>(ldsl, g, So, E, wave0); }
        PH_END
        PH_BEGIN
        if PHON(11) { int row = gw;
            for (; row + NGW < S; row += 2 * NGW) norm_add_rows<2>(Y, (l == 0 ? x_in : xres), xres, norm_mix_post + l * DM, norm_ffn_pre + l * DM, H, row, NGW, lane);
            for (; row < S; row += NGW) norm_add_rows<1>(Y, (l == 0 ? x_in : xres), xres, norm_mix_post + l * DM, norm_ffn_pre + l * DM, H, row, NGW, lane); }
        PH_END
        PH_BEGIN
        if PHON(12) for (int rep_ = 0; rep_ < MK_DUP_GEMM; ++rep_) { pg8::Gemm g{H, (const bf16_t*)(wl + W_GU), S, NGU, DM}; pg8::StaticOrder So; So.init(S, NGU, G, bid);
          pg8::EpiSwiGLU E{HID, FF};
          pg8::gemm_phase<pg8::EpiSwiGLU, pg8::StaticOrder, true, true>(ldsl, g, So, E, wave0); }
        PH_END
        PH_BEGIN
        if PHON(13) for (int rep_ = 0; rep_ < MK_DUP_GEMM; ++rep_) { pg8::Gemm g{HID, (const bf16_t*)(wl + W_D), S, DM, FF}; pg8::StaticOrder So; So.init(S, DM, G, bid);
          pg8::EpiBf16 E{Y, DM};
          pg8::gemm_phase<pg8::EpiBf16, pg8::StaticOrder, true, true>(ldsl, g, So, E, wave0); }
        PH_END
        PH_BEGIN
        if PHON(14) { int row = gw; const float* gnext = (l + 1 < DEPTH) ? norm_mix_pre + (l + 1) * DM : nullptr;
            for (; row + NGW < S; row += 2 * NGW) norm_add_rows<2>(Y, xres, xres, norm_ffn_post + l * DM, gnext, H, row, NGW, lane);
            for (; row < S; row += NGW) norm_add_rows<1>(Y, xres, xres, norm_ffn_post + l * DM, gnext, H, row, NGW, lane); }
        PH_END
    }
#undef PH_BEGIN
#undef PH_END
}
#undef x_in
#undef rel_bias
#undef norm_mix_pre
#undef norm_mix_post
#undef norm_ffn_pre
#undef norm_ffn_post
#undef w_in
#undef diff_lambda
#undef diff_subln
#undef mla_q_norm
#undef mla_kv_norm
#undef mla_w_uq
#undef mla_w_ukv
#undef gqa_q_norm
#undef gqa_k_norm
#undef w_out
#undef w_gate_up
#undef w_down
#undef xres
#undef ws
#undef PAR
#undef TBLA
#undef TBLD
#undef COS
#undef SIN
#undef H
#undef PROJ
#undef CQN
#undef CKVN
#undef KPE
#undef QC
#undef KC
#undef QB
#undef KVB
#undef MIX
#undef Y
#undef HID
#undef TMP
#undef wl

constexpr int N_PHASES = 1 + DEPTH * 9;

extern "C" void kernel_launch(void* const* d_in, const int* in_sizes, int n_in, void* d_out, int out_size, void* d_ws, size_t ws_size, hipStream_t stream) {
    static int grid = 0;
    if (grid == 0) {
        if (n_in != 18 || in_sizes[0] != S * DM || out_size != S * DM || ws_size < WS_END) {
            fprintf(stderr, "kernel_launch: unexpected shapes (n_in %d, in0 %d, out %d, ws %zu < %zu)\n", n_in, n_in > 0 ? in_sizes[0] : -1, out_size, ws_size, (size_t)WS_END); grid = -1; return; }
        int dev = 0, cus = 0, per_cu = 0;
        if (hipGetDevice(&dev) != hipSuccess || hipDeviceGetAttribute(&cus, hipDeviceAttributeMultiprocessorCount, dev) != hipSuccess) { grid = -1; return; }
        if (hipFuncSetAttribute((const void*)mega_fwd, hipFuncAttributeMaxDynamicSharedMemorySize, LDS_BYTES) != hipSuccess) { fprintf(stderr, "kernel_launch: hipFuncSetAttribute failed\n"); grid = -1; return; }
        if (hipOccupancyMaxActiveBlocksPerMultiprocessor(&per_cu, (const void*)mega_fwd, 512, LDS_BYTES) != hipSuccess || per_cu < 1) { fprintf(stderr, "kernel_launch: occupancy query says %d\n", per_cu); per_cu = 1; }
        (void)hipGetLastError();
        grid = cus;
    }
    if (grid < 0) return;
    if (hipMemsetAsync((char*)d_ws + WS_BAR, 0, WS_BAR_BYTES, stream) != hipSuccess) { fprintf(stderr, "kernel_launch: hipMemsetAsync of the barrier words failed\n"); return; }
    Args a{};
    for (int i = 0; i < 18; ++i) a.in[i] = (const float*)d_in[i];
    a.out = (float*)d_out; a.wsp = (unsigned char*)d_ws;
#if MK_MULTI
    for (int p = 0; p < N_PHASES; ++p) { a.ph_lo = p; a.ph_hi = p + 1; hipLaunchKernelGGL(mega_fwd, dim3(grid), dim3(512), LDS_BYTES, stream, a); }
#else
    a.ph_lo = 0; a.ph_hi = N_PHASES;
    void* kargs[] = {&a};
    hipError_t e = hipLaunchCooperativeKernel((const void*)mega_fwd, dim3(grid), dim3(512), kargs, LDS_BYTES, stream);
    if (e != hipSuccess) fprintf(stderr, "kernel_launch: cooperative launch failed: %s (grid %d)\n", hipGetErrorString(e), grid);
#endif
}
```
